# Optimizing an MI355X kernel written in HIP

```python
import math
import jax
import jax.numpy as jnp
from jax import lax
import numpy as np

D_MODEL = 1024
BATCH = 4
SEQ = 4096
DEPTH = 4

GRID_W = 64
CTX_LEN = 256
EPS = 1e-6
N_BRANCH = 3
BRANCH_W = D_MODEL // 2
N_MOD = 9
D_FF = ((8 * D_MODEL // 3 + 255) // 256) * 256
CONV_W = 4
CONV_LEFT = 2
ML_HEADS = 4
ML_DV = BRANCH_W // ML_HEADS
ML_DK = ML_DV // 2
ML_QK = ML_HEADS * ML_DK
ML_V = BRANCH_W
ML_CHUNK = 64
LRU_WIDTH = BRANCH_W
LRU_BLOCKS = 8
LRU_BLOCK = LRU_WIDTH // LRU_BLOCKS
LRU_C = 8.0
DN_HEADS = 4
DN_DV = BRANCH_W // DN_HEADS
DN_DK = DN_DV
DN_K = DN_HEADS * DN_DK
DN_V = BRANCH_W
DN_CHUNK = 64
IN_WIDTHS = (ML_QK, ML_QK, ML_V, ML_V, 4 * ML_HEADS,
             LRU_WIDTH, LRU_WIDTH,
             DN_K, DN_K, DN_V, DN_V, 4 * DN_HEADS,
             N_BRANCH * D_MODEL)
D_IN = sum(IN_WIDTHS)

kernel_name = "hybrid_mlstm_rglru_gdn_prefix_dit"


def rmsnorm(x, g):
    x32 = x.astype(jnp.float32)
    y = x32 * lax.rsqrt(jnp.mean(x32 * x32, axis=-1, keepdims=True) + EPS)
    return (y * g.astype(jnp.float32)).astype(x.dtype)


def l2norm(x):
    x32 = x.astype(jnp.float32)
    return (x32 * lax.rsqrt(jnp.sum(x32 * x32, axis=-1, keepdims=True) + EPS)).astype(x.dtype)


def modulate(x, g, shift, scale):
    return rmsnorm(x, g) * (1 + scale) + shift


def centred_conv(x, w):
    L = x.shape[1]
    xp = jnp.pad(x, ((0, 0), (CONV_LEFT, CONV_W - 1 - CONV_LEFT), (0, 0)))
    return sum(xp[:, j:j + L] * w[j] for j in range(CONV_W))


def to_chunks(a, T):
    B, L = a.shape[:2]
    return jnp.moveaxis(a.reshape((B, L // T, T) + a.shape[2:]), 1, 0)


def from_chunks(a):
    nc, B, T = a.shape[:3]
    return jnp.moveaxis(a, 0, 1).reshape((B, nc * T) + a.shape[3:])


def to_colmajor(a):
    B, S = a.shape[:2]
    rows = S // GRID_W
    a = a.reshape((B, rows, GRID_W) + a.shape[2:])
    return jnp.swapaxes(a, 1, 2).reshape((B, S) + a.shape[3:])


def from_colmajor(a):
    B, S = a.shape[:2]
    rows = S // GRID_W
    a = a.reshape((B, GRID_W, rows) + a.shape[2:])
    return jnp.swapaxes(a, 1, 2).reshape((B, S) + a.shape[3:])


def bidir_prefix(scan_fn, ctx_f, ctx_b, lat_f, lat_b, init):
    flip = lambda t: tuple(jnp.flip(a, axis=1) for a in t)
    st_f, yc_f = scan_fn(ctx_f, init)
    _, yl_f = scan_fn(lat_f, st_f)
    st_b, yc_b = scan_fn(flip(ctx_b), init)
    _, yl_b = scan_fn(flip(lat_b), st_b)
    return yc_f + jnp.flip(yc_b, axis=1), yl_f + jnp.flip(yl_b, axis=1)


def mlstm_scan(inp, state):
    dtype = inp[0].dtype
    q, k, v, ig, fg = (a.astype(jnp.float32) for a in inp)
    T = ML_CHUNK
    causal = jnp.tril(jnp.ones((T, T), dtype=bool))

    def step(carry, blk):
        C, n, m = carry
        qc, kc, vc, ic, fc = blk
        b = jnp.cumsum(jax.nn.log_sigmoid(fc), axis=1)
        logD = b[:, :, None, :] - b[:, None, :, :] + ic[:, None, :, :]
        logD = jnp.where(causal[None, :, :, None], logD, -jnp.inf)
        inter = b + m[:, None, :]
        m_t = jnp.maximum(inter, jnp.max(logD, axis=2))
        w_in = jnp.exp(inter - m_t)
        s = jnp.einsum('bthd,bshd->btsh', qc, kc) * jnp.exp(logD - m_t[:, :, None, :])
        num = jnp.einsum('btsh,bshv->bthv', s, vc) + w_in[..., None] * jnp.einsum('bthd,bhdv->bthv', qc, C)
        den = jnp.sum(s, axis=2) + w_in * jnp.einsum('bthd,bhd->bth', qc, n)
        h = num / jnp.maximum(jnp.abs(den), jnp.exp(-m_t))[..., None]
        bT = b[:, -1]
        log_ws = bT[:, None, :] - b + ic
        m_new = jnp.maximum(bT + m, jnp.max(log_ws, axis=1))
        ws = jnp.exp(log_ws - m_new[:, None, :])
        dec = jnp.exp(bT + m - m_new)
        C = dec[..., None, None] * C + jnp.einsum('bth,bthd,bthv->bhdv', ws, kc, vc)
        n = dec[..., None] * n + jnp.einsum('bth,bthd->bhd', ws, kc)
        return (C, n, m_new), h

    state, h = lax.scan(step, state, tuple(to_chunks(a, T) for a in (q, k, v, ig, fg)))
    return state, from_chunks(h).astype(dtype)


def _mlstm_prep(q, k, v, gt, gate_b):
    B, L, _ = q.shape
    q = q.reshape(B, L, ML_HEADS, ML_DK) * (ML_DK ** -0.5)
    k = k.reshape(B, L, ML_HEADS, ML_DK)
    v = v.reshape(B, L, ML_HEADS, ML_DV)
    gt = gt.reshape(B, L, 4, ML_HEADS) + gate_b
    return (q, k, v, gt[:, :, 0], gt[:, :, 2]), (q, k, v, gt[:, :, 1], gt[:, :, 3])


def _mlstm_out(h, o, norm_g):
    B, L = h.shape[:2]
    h = rmsnorm(h, norm_g.reshape(ML_HEADS, ML_DV)).reshape(B, L, ML_V)
    return h * jax.nn.sigmoid(o)


def mlstm_branch(pc, pl, gate_b, norm_g, with_ctx_out):
    fc, bc = _mlstm_prep(pc[0], pc[1], pc[2], pc[4], gate_b)
    fl, bl = _mlstm_prep(pl[0], pl[1], pl[2], pl[4], gate_b)
    B = pl[0].shape[0]
    init = (jnp.zeros((B, ML_HEADS, ML_DK, ML_DV), jnp.float32),
            jnp.zeros((B, ML_HEADS, ML_DK), jnp.float32),
            jnp.zeros((B, ML_HEADS), jnp.float32))
    hc, hl = bidir_prefix(mlstm_scan, fc, bc, fl, bl, init)
    yc = _mlstm_out(hc, pc[3], norm_g) if with_ctx_out else None
    return yc, _mlstm_out(hl, pl[3], norm_g)


def blockdiag(x, w):
    B, L, C = x.shape
    return jnp.einsum('blni,nij->blnj', x.reshape(B, L, LRU_BLOCKS, LRU_BLOCK), w).reshape(B, L, C)


def lru_scan(inp, h0):
    dtype = inp[1].dtype
    log_a, bx = (a.astype(jnp.float32) for a in inp)
    a = jnp.exp(log_a)
    bx = bx.at[:, 0].add(a[:, 0] * h0)
    comb = lambda l, r: (l[0] * r[0], r[0] * l[1] + r[1])
    _, h = lax.associative_scan(comb, (a, bx), axis=1)
    return h[:, -1], h.astype(dtype)


def _lru_prep(xb, conv_w, conv_b, w_a, b_a, w_x, b_x, lam):
    xc = centred_conv(xb, conv_w) + conv_b

    def direction(d):
        r = jax.nn.sigmoid(blockdiag(xc, w_a[d]) + b_a[d])
        i = jax.nn.sigmoid(blockdiag(xc, w_x[d]) + b_x[d])
        log_a = -LRU_C * jax.nn.softplus(-lam[d]) * r
        return (log_a, jnp.sqrt(-jnp.expm1(2 * log_a)) * (i * xc))

    return direction(0), direction(1)


def lru_branch(pc, pl, conv_w, conv_b, w_a, b_a, w_x, b_x, lam, with_ctx_out):
    fc, bc = _lru_prep(pc[0], conv_w, conv_b, w_a, b_a, w_x, b_x, lam)
    fl, bl = _lru_prep(pl[0], conv_w, conv_b, w_a, b_a, w_x, b_x, lam)
    init = jnp.zeros((pl[0].shape[0], LRU_WIDTH), jnp.float32)
    hc, hl = bidir_prefix(lru_scan, fc, bc, fl, bl, init)
    yc = hc * jax.nn.gelu(pc[1]) if with_ctx_out else None
    return yc, hl * jax.nn.gelu(pl[1])


def gdn_scan(inp, S0):
    dtype = inp[0].dtype
    q, k, v, g, beta = (a.astype(jnp.float32) for a in inp)
    T = DN_CHUNK
    incl = jnp.tril(jnp.ones((T, T), dtype=bool))
    strict = jnp.tril(jnp.ones((T, T), dtype=bool), -1)
    eye = jnp.eye(T, dtype=jnp.float32)

    def step(S, blk):
        qc, kc, vc, gc, bc = blk
        qc, kc, vc = (jnp.swapaxes(a, 1, 2) for a in (qc, kc, vc))
        gc, bc = jnp.swapaxes(gc, 1, 2), jnp.swapaxes(bc, 1, 2)
        G = jnp.cumsum(gc, axis=-1)
        diff = G[..., :, None] - G[..., None, :]
        gam = jnp.where(incl, jnp.exp(jnp.where(incl, diff, 0.0)), 0.0)
        A = jnp.where(strict, bc[..., :, None] * jnp.einsum('bhtd,bhsd->bhts', kc, kc) * gam, 0.0)
        rhs = jnp.concatenate([bc[..., None] * vc, bc[..., None] * kc * jnp.exp(G)[..., None]], axis=-1)
        sol = lax.linalg.triangular_solve(eye + A, rhs, left_side=True, lower=True, unit_diagonal=True)
        u, w = sol[..., :DN_DV], sol[..., DN_DV:]
        vnew = u - jnp.einsum('bhtk,bhkv->bhtv', w, S)
        o = (jnp.exp(G)[..., None] * jnp.einsum('bhtk,bhkv->bhtv', qc, S)
             + jnp.einsum('bhts,bhsv->bhtv', jnp.einsum('bhtk,bhsk->bhts', qc, kc) * gam, vnew))
        GT = G[..., -1]
        S = (jnp.exp(GT)[..., None, None] * S
             + jnp.einsum('bhs,bhsk,bhsv->bhkv', jnp.exp(GT[..., None] - G), kc, vnew))
        return S, jnp.swapaxes(o, 1, 2)

    S, o = lax.scan(step, S0, tuple(to_chunks(a, T) for a in (q, k, v, g, beta)))
    return S, from_chunks(o).astype(dtype)


def _gdn_prep(q, k, v, ba, conv_w, a_log, dt_bias):
    B, L, _ = q.shape
    qkv = jax.nn.silu(centred_conv(jnp.concatenate([q, k, v], axis=-1), conv_w))
    q, k, v = jnp.split(qkv, [DN_K, 2 * DN_K], axis=-1)
    q = l2norm(q.reshape(B, L, DN_HEADS, DN_DK)) * (DN_DK ** -0.5)
    k = l2norm(k.reshape(B, L, DN_HEADS, DN_DK))
    v = v.reshape(B, L, DN_HEADS, DN_DV)
    ba = ba.reshape(B, L, 4, DN_HEADS).astype(jnp.float32)
    beta = jax.nn.sigmoid(ba[:, :, 0:2])
    g = -jnp.exp(a_log.astype(jnp.float32)) * jax.nn.softplus(ba[:, :, 2:4] + dt_bias.astype(jnp.float32))
    return (q, k, v, g[:, :, 0], beta[:, :, 0]), (q, k, v, g[:, :, 1], beta[:, :, 1])


def _gdn_out(o, z, norm_g):
    B, L = o.shape[:2]
    z = z.reshape(B, L, DN_HEADS, DN_DV)
    return (rmsnorm(o, norm_g) * jax.nn.silu(z)).reshape(B, L, DN_V)


def dn_branch(pc, pl, conv_w, a_log, dt_bias, norm_g, with_ctx_out):
    fc, bc = _gdn_prep(pc[0], pc[1], pc[2], pc[4], conv_w, a_log, dt_bias)
    fl, bl = _gdn_prep(to_colmajor(pl[0]), to_colmajor(pl[1]), to_colmajor(pl[2]), to_colmajor(pl[4]),
                       conv_w, a_log, dt_bias)
    init = jnp.zeros((pl[0].shape[0], DN_HEADS, DN_DK, DN_DV), jnp.float32)
    oc, ol = bidir_prefix(gdn_scan, fc, bc, fl, bl, init)
    yc = _gdn_out(oc, pc[3], norm_g) if with_ctx_out else None
    return yc, _gdn_out(from_colmajor(ol), pl[3], norm_g)


def _split_in(p):
    idx = np.cumsum(IN_WIDTHS)[:-1].tolist()
    return jnp.split(p, idx, axis=-1)


def merge(ys, gate_cols, w_branch, w_out):
    B, L, _ = gate_cols.shape
    gates = jax.nn.sigmoid(gate_cols.reshape(B, L, N_BRANCH, D_MODEL))
    proj = jnp.einsum('blnc,ncd->blnd', jnp.stack(ys, axis=2), w_branch)
    return jnp.sum(gates * proj, axis=2) @ w_out


def mixer(hc, hl, w_in, ml_gate_b, ml_norm_g, lru_conv_w, lru_conv_b, lru_w_a, lru_b_a, lru_w_x, lru_b_x,
          lru_lambda, dn_conv_w, dn_a_log, dn_dt_bias, dn_norm_g, w_branch, w_out, with_ctx_out):
    sc = _split_in(hc @ w_in)
    sl = _split_in(hl @ w_in)
    ml_c, ml_l = mlstm_branch(sc[0:5], sl[0:5], ml_gate_b, ml_norm_g, with_ctx_out)
    lr_c, lr_l = lru_branch(sc[5:7], sl[5:7], lru_conv_w, lru_conv_b, lru_w_a, lru_b_a, lru_w_x, lru_b_x,
                            lru_lambda, with_ctx_out)
    dn_c, dn_l = dn_branch(sc[7:12], sl[7:12], dn_conv_w, dn_a_log, dn_dt_bias, dn_norm_g, with_ctx_out)
    yl = merge((ml_l, lr_l, dn_l), sl[12], w_branch, w_out)
    yc = merge((ml_c, lr_c, dn_c), sc[12], w_branch, w_out) if with_ctx_out else None
    return yc, yl


def ffn_sub(x, mod, j, g_pre, g_post, w_gu, w_down):
    h = modulate(x, g_pre, mod[:, 3 * j], mod[:, 3 * j + 1])
    gu = h @ w_gu
    y = (jax.nn.silu(gu[..., :D_FF]) * gu[..., D_FF:]) @ w_down
    return x + 0.5 * mod[:, 3 * j + 2] * rmsnorm(y, g_post)


def setup_inputs(seed: int = 0) -> dict:
    key = jax.random.key(seed)
    ks = jax.random.split(key, 32)
    f32 = jnp.float32
    nrm = lambda i, shape, s: jax.random.normal(ks[i], shape, f32) * s
    x = nrm(0, (BATCH, SEQ, D_MODEL), 1.0)
    c = nrm(1, (BATCH, D_MODEL), 1.0)
    ctx = nrm(2, (BATCH, CTX_LEN, D_MODEL), 1.0)
    c_ctx = nrm(3, (D_MODEL,), 1.0)
    w_mod = nrm(4, (DEPTH, D_MODEL, N_MOD * D_MODEL), D_MODEL ** -0.5)
    b_mod = nrm(5, (DEPTH, N_MOD * D_MODEL), 0.02)
    norm_g = 1.0 + nrm(6, (DEPTH, 6, D_MODEL), 0.02)
    ffn_w_gu = nrm(7, (DEPTH, 2, D_MODEL, 2 * D_FF), D_MODEL ** -0.5)
    ffn_w_down = nrm(8, (DEPTH, 2, D_FF, D_MODEL), D_FF ** -0.5)
    w_in = nrm(9, (DEPTH, D_MODEL, D_IN), D_MODEL ** -0.5)
    ig_b = -2.0 + nrm(10, (DEPTH, 2, ML_HEADS), 0.1)
    fg_b = jnp.linspace(3.0, 6.0, ML_HEADS, dtype=f32) + nrm(11, (DEPTH, 2, ML_HEADS), 0.1)
    ml_gate_b = jnp.concatenate([ig_b, fg_b], axis=1)
    ml_norm_g = 1.0 + nrm(12, (DEPTH, ML_V), 0.02)
    lru_conv_w = nrm(13, (DEPTH, CONV_W, LRU_WIDTH), CONV_W ** -0.5)
    lru_conv_b = nrm(14, (DEPTH, LRU_WIDTH), 0.02)
    lru_w_a = nrm(15, (DEPTH, 2, LRU_BLOCKS, LRU_BLOCK, LRU_BLOCK), LRU_BLOCK ** -0.5)
    lru_b_a = nrm(16, (DEPTH, 2, LRU_WIDTH), 0.02)
    lru_w_x = nrm(17, (DEPTH, 2, LRU_BLOCKS, LRU_BLOCK, LRU_BLOCK), LRU_BLOCK ** -0.5)
    lru_b_x = nrm(18, (DEPTH, 2, LRU_WIDTH), 0.02)
    u = jax.random.uniform(ks[19], (DEPTH, 2, LRU_WIDTH), f32, 0.9, 0.999)
    sig = u ** (1.0 / LRU_C)
    lru_lambda = jnp.log(sig) - jnp.log1p(-sig)
    dn_conv_w = nrm(20, (DEPTH, CONV_W, 2 * DN_K + DN_V), CONV_W ** -0.5)
    dn_a_log = jnp.log(jax.random.uniform(ks[21], (DEPTH, 2, DN_HEADS), f32, 1.0, 16.0))
    dt = jnp.exp(jax.random.uniform(ks[22], (DEPTH, 2, DN_HEADS), f32, math.log(1e-3), math.log(0.1)))
    dn_dt_bias = dt + jnp.log(-jnp.expm1(-dt))
    dn_norm_g = 1.0 + nrm(23, (DEPTH, DN_DV), 0.02)
    w_branch = nrm(24, (DEPTH, N_BRANCH, BRANCH_W, D_MODEL), BRANCH_W ** -0.5)
    w_out = nrm(25, (DEPTH, D_MODEL, D_MODEL), D_MODEL ** -0.5)
    return {"x": x, "c": c, "ctx": ctx, "c_ctx": c_ctx, "w_mod": w_mod, "b_mod": b_mod,
            "norm_g": norm_g, "ffn_w_gu": ffn_w_gu, "ffn_w_down": ffn_w_down, "w_in": w_in,
            "ml_gate_b": ml_gate_b, "ml_norm_g": ml_norm_g, "lru_conv_w": lru_conv_w,
            "lru_conv_b": lru_conv_b, "lru_w_a": lru_w_a, "lru_b_a": lru_b_a, "lru_w_x": lru_w_x,
            "lru_b_x": lru_b_x, "lru_lambda": lru_lambda, "dn_conv_w": dn_conv_w,
            "dn_a_log": dn_a_log, "dn_dt_bias": dn_dt_bias, "dn_norm_g": dn_norm_g,
            "w_branch": w_branch, "w_out": w_out}


def reference(x, c, ctx, c_ctx, w_mod, b_mod, norm_g, ffn_w_gu, ffn_w_down, w_in, ml_gate_b, ml_norm_g,
              lru_conv_w, lru_conv_b, lru_w_a, lru_b_a, lru_w_x, lru_b_x, lru_lambda, dn_conv_w,
              dn_a_log, dn_dt_bias, dn_norm_g, w_branch, w_out):
    B = x.shape[0]
    z = ctx
    for l in range(DEPTH):
        last = l == DEPTH - 1
        mod_l = (jax.nn.silu(c) @ w_mod[l] + b_mod[l]).reshape(B, N_MOD, 1, D_MODEL)
        mod_c = (jax.nn.silu(c_ctx) @ w_mod[l] + b_mod[l]).reshape(1, N_MOD, 1, D_MODEL)
        x = ffn_sub(x, mod_l, 0, norm_g[l, 0], norm_g[l, 1], ffn_w_gu[l, 0], ffn_w_down[l, 0])
        z = ffn_sub(z, mod_c, 0, norm_g[l, 0], norm_g[l, 1], ffn_w_gu[l, 0], ffn_w_down[l, 0])
        hl = modulate(x, norm_g[l, 2], mod_l[:, 3], mod_l[:, 4])
        hc = modulate(z, norm_g[l, 2], mod_c[:, 3], mod_c[:, 4])
        yc, yl = mixer(hc, hl, w_in[l], ml_gate_b[l], ml_norm_g[l], lru_conv_w[l], lru_conv_b[l],
                       lru_w_a[l], lru_b_a[l], lru_w_x[l], lru_b_x[l], lru_lambda[l], dn_conv_w[l],
                       dn_a_log[l], dn_dt_bias[l], dn_norm_g[l], w_branch[l], w_out[l], not last)
        x = x + mod_l[:, 5] * rmsnorm(yl, norm_g[l, 3])
        x = ffn_sub(x, mod_l, 2, norm_g[l, 4], norm_g[l, 5], ffn_w_gu[l, 1], ffn_w_down[l, 1])
        if not last:
            z = z + mod_c[:, 5] * rmsnorm(yc, norm_g[l, 3])
            z = ffn_sub(z, mod_c, 2, norm_g[l, 4], norm_g[l, 5], ffn_w_gu[l, 1], ffn_w_down[l, 1])
    return x
```

```cpp
#include <hip/hip_runtime.h>
#include <hip/hip_cooperative_groups.h>
#include <cstdio>
namespace cg = cooperative_groups;

#define LAS __attribute__((address_space(3)))
#define DEVI __device__ __forceinline__
typedef unsigned short bf16_t;
typedef short bf16x8 __attribute__((ext_vector_type(8)));
typedef float f32x4 __attribute__((ext_vector_type(4)));
typedef float f32x2 __attribute__((ext_vector_type(2)));
typedef unsigned u32x4 __attribute__((ext_vector_type(4)));
typedef unsigned u32x2 __attribute__((ext_vector_type(2)));

constexpr int D = 1024, NBATCH = 4, SEQ = 4096, CTXL = 256, DEPTH = 4, DFF = 2816, DINP = 7936;
constexpr int MLAT = NBATCH * SEQ, MTOT = MLAT + NBATCH * CTXL;
constexpr int NCH = 68;
constexpr int C_MLQ = 0, C_MLK = 256, C_MLV = 512, C_MLO = 1024, C_MLG = 1536, C_LRX = 1552, C_LRY = 2064,
              C_DNQ = 2576, C_DNZ = 4112, C_DNBA = 4624, C_GATE = 4640, C_END = 7712;
constexpr float EPS = 1e-6f;

constexpr size_t SZ_WGU = (size_t)2 * DFF * D * 2, SZ_WDN = (size_t)D * DFF * 2;
constexpr size_t WS_MOD = 4096;
constexpr size_t WS_WGU = 1u << 20;
constexpr size_t WS_WDN = WS_WGU + 2 * SZ_WGU;
constexpr size_t WS_WIN = WS_WDN + 2 * SZ_WDN;
constexpr size_t WS_WBR = WS_WIN + (size_t)DINP * D * 2;
constexpr size_t WS_WOUT = WS_WBR + (size_t)3 * D * 512 * 2;
constexpr size_t WS_WLRU = WS_WOUT + (size_t)D * D * 2;
constexpr size_t WS_X = WS_WLRU + (size_t)32 * 64 * 64 * 2;
constexpr size_t WS_H = WS_X + (size_t)MTOT * D * 4;
constexpr size_t WS_Y = WS_H + (size_t)MTOT * D * 2;
constexpr size_t WS_P = WS_Y + (size_t)MTOT * D * 4;
constexpr size_t WS_GU = WS_P + (size_t)MTOT * DINP * 2;
constexpr size_t WS_GB = WS_GU + (size_t)2176 * 64 * 128 * 2;
constexpr size_t WS_GN = WS_GB + (size_t)2176 * 128 * 128 * 2;
constexpr size_t WS_SM = WS_GN + (size_t)2176 * 128 * 128 * 2;
constexpr size_t SM_GDEC = 0, SM_MN = 16384, SM_MSC = SM_MN + 2176 * 64 * 4, SM_MM = SM_MSC + 2176 * 8, SM_LAGG = SM_MM + 2176 * 4 + 1024;
constexpr size_t WS_END = WS_SM + SM_LAGG + (size_t)2 * 4 * NCH * 512 * 2 * 4 + 4096;
constexpr int LDS_BYTES = 155648;

struct Params { const float* in[25]; float* out; unsigned char* ws; };

#define CAS __attribute__((address_space(4)))
DEVI const float* pin(int i) { const CAS char* k = (const CAS char*)__builtin_amdgcn_kernarg_segment_ptr(); return *(const float* const volatile CAS*)(k + 8 * i); }
DEVI int opaque(int v) { asm volatile("" : "+v"(v)); return v; }
#define MYTID opaque(wv * 64 + (int)__builtin_amdgcn_mbcnt_hi(~0u, __builtin_amdgcn_mbcnt_lo(~0u, 0u)))
DEVI float bf2f(bf16_t v) { return __uint_as_float(((unsigned)v) << 16); }
DEVI unsigned f2bf(float f) { unsigned u = __float_as_uint(f); return (u + 0x7fffu + ((u >> 16) & 1u)) >> 16; }
DEVI unsigned pk2(float lo, float hi) { return f2bf(lo) | (f2bf(hi) << 16); }
DEVI float sigm(float x) { return 1.f / (1.f + __expf(-x)); }
DEVI float silu(float x) { return x * sigm(x); }
DEVI float softplus(float x) { return x > 20.f ? x : log1pf(__expf(x)); }
DEVI float logsig(float x) { return fminf(x, 0.f) - log1pf(__expf(-fabsf(x))); }
DEVI float gelu_t(float x) { float u = 0.7978845608f * (x + 0.044715f * x * x * x); float e = __expf(2.f * u); return 0.5f * x * (2.f - 2.f / (e + 1.f)); }
DEVI float wsum(float v) { for (int o = 32; o > 0; o >>= 1) v += __shfl_xor(v, o, 64); return v; }
DEVI float wmax(float v) { for (int o = 32; o > 0; o >>= 1) v = fmaxf(v, __shfl_xor(v, o, 64)); return v; }
DEVI void unpack8(u32x4 r, float* f) {
    f[0] = __uint_as_float(r[0] << 16); f[1] = __uint_as_float(r[0] & 0xffff0000u); f[2] = __uint_as_float(r[1] << 16); f[3] = __uint_as_float(r[1] & 0xffff0000u);
    f[4] = __uint_as_float(r[2] << 16); f[5] = __uint_as_float(r[2] & 0xffff0000u); f[6] = __uint_as_float(r[3] << 16); f[7] = __uint_as_float(r[3] & 0xffff0000u);
}
DEVI u32x4 pack8(const float* f) { u32x4 r; r[0] = pk2(f[0], f[1]); r[1] = pk2(f[2], f[3]); r[2] = pk2(f[4], f[5]); r[3] = pk2(f[6], f[7]); return r; }
DEVI bf16x8 ldfrag(const bf16_t* base, int ld, int row0, int k0, int lane) { return *(const bf16x8*)(base + (row0 + (lane & 15)) * ld + k0 + (lane >> 4) * 8); }
#define MFMA16(a, b, c) __builtin_amdgcn_mfma_f32_16x16x32_bf16(a, b, c, 0, 0, 0)

namespace pg8 {
constexpr int BM = 256, BK = 64, HALF = 128, HTB = HALF * BK * 2, NXCD = 8, WGM = 8;
DEVI int lds_byte(int r, int c) { const int st = (r >> 4) * 2 + (c >> 5), rr = r & 15, cc = c & 31, ob = rr * 64 + cc * 2; return st * 1024 + (ob ^ (((ob >> 9) & 1) << 5)); }
DEVI void stage_rc(int b, int& R, int& C) { const int st = b / 1024, sb = b % 1024, swz = sb ^ (((sb >> 9) & 1) << 5); R = (st >> 1) * 16 + swz / 64; C = (st & 1) * 32 + (swz % 64) / 2; }
DEVI int perm32(int rho) { const int n = rho >> 4, i = rho & 15; return 8 * (i >> 2) + 4 * n + (i & 3); }
struct Unit { int pm, pn, z; };
struct Gemm { const bf16_t* A; const bf16_t* Bt; int nM, nN, K, lda, nz, zA0, zA1, zA2, zB; };
struct Order {
    int nM, nN, nwg, G, c, nz;
    DEVI void init(int nM_, int nN_, int nz_, int G_, int c_) { nM = nM_; nN = nN_; nwg = nM * nN; G = G_; c = c_; nz = nz_; }
    DEVI bool next(int i, Unit& u) const {
        int ti = i, z = 0; if (nz == 3) { ti = i / 3; z = i - ti * 3; }
        const long L = (long)ti * G + c; if (L >= nwg) return false;
        int wgid = (int)L; { const int q = nwg / NXCD, r = nwg % NXCD, xcd = wgid % NXCD, off = wgid / NXCD; wgid = (xcd < r ? xcd * (q + 1) : r * (q + 1) + (xcd - r) * q) + off; }
        const int nig = WGM * nN, gid = wgid / nig, fm = gid * WGM, gsz = (nM - fm) < WGM ? (nM - fm) : WGM;
        u.pm = fm + ((wgid % nig) % gsz); u.pn = (wgid % nig) / gsz; u.z = z; return true;
    }
};

template <class Epi>
DEVI void gemm_phase(LAS unsigned char* lds, const Gemm g, const Order& S, const Epi& E, int wv) {
    const int tid = MYTID, wid = __builtin_amdgcn_readfirstlane(tid >> 6), lane = tid & 63, wr = wid >> 2, wc = wid & 3, fr = lane & 15, fq = lane >> 4;
    const int K = g.K, nt = K / BK, lda = g.lda;
    unsigned voffA[2], voffB[2];
#pragma unroll
    for (int i = 0; i < 2; ++i) { int R, C; stage_rc(tid * 16 + i * 8192, R, C); const int Rb = Epi::PERM ? ((R & ~31) + perm32(R & 31)) : R;
        voffA[i] = (unsigned)(R * lda + C) * 2u; voffB[i] = (unsigned)(Rb * K + C) * 2u; }
    const size_t kstep = (size_t)(BK * 2);
    const size_t hstepA = (size_t)HALF * lda * 2, hstepB = (size_t)HALF * K * 2;
    const unsigned ldsw = (unsigned)wid * 1024u;
    const int aoff = lds_byte(wr * 64 + fr, fq * 8), boff = lds_byte(wc * 32 + fr, fq * 8);
#define PG8_SA(b, h) (((b) * 2 + (h)) * HTB)
#define PG8_SB(b, h) ((4 + (b) * 2 + (h)) * HTB)
#define PG8_STAGE(bufoff, gbase, voff) do { _Pragma("unroll") for (int _i = 0; _i < 2; ++_i) \
        __builtin_amdgcn_global_load_lds((const unsigned*)((const char*)(gbase) + (voff)[_i]), (LAS unsigned*)(lds + (bufoff) + ldsw + _i * 8192), 16, 0, 0); } while (0)
#define PG8_LDA(dst, b, h) do { _Pragma("unroll") for (int m = 0; m < 4; ++m) _Pragma("unroll") for (int k = 0; k < 2; ++k) dst[m][k] = *(const LAS bf16x8*)(lds + PG8_SA(b, h) + aoff + m * 2048 + k * 1024); } while (0)
#define PG8_LDB(dst, b, h) do { _Pragma("unroll") for (int n = 0; n < 2; ++n) _Pragma("unroll") for (int k = 0; k < 2; ++k) dst[n][k] = *(const LAS bf16x8*)(lds + PG8_SB(b, h) + boff + n * 2048 + k * 1024); } while (0)
#define PG8_MMA(ai, bj, At, Bt) do { __builtin_amdgcn_s_setprio(1); _Pragma("unroll") for (int m = 0; m < 4; ++m) _Pragma("unroll") for (int n = 0; n < 2; ++n) _Pragma("unroll") for (int k = 0; k < 2; ++k) \
        acc[ai][bj][m][n] = __builtin_amdgcn_mfma_f32_16x16x32_bf16(Bt[n][k], At[m][k], acc[ai][bj][m][n], 0, 0, 0); __builtin_amdgcn_s_setprio(0); } while (0)
#define PG8_WAIT_V(n) asm volatile("s_waitcnt vmcnt(" #n ")" ::: "memory")
#define PG8_WAIT_L(n) asm volatile("s_waitcnt lgkmcnt(" #n ")" ::: "memory")
#define PG8_BAR __builtin_amdgcn_s_barrier()
#define PG8_SCHED __builtin_amdgcn_sched_barrier(0)
#define PG8_PA(u) ((const char*)g.A + ((size_t)((u).z == 0 ? g.zA0 : ((u).z == 1 ? g.zA1 : g.zA2)) + (size_t)(u).pm * BM * lda) * 2)
#define PG8_PB(u) ((const char*)g.Bt + ((size_t)(u).z * g.zB + (size_t)(u).pn * BM * K) * 2)
    Unit cur, nxt; int ui = 0;
    if (!S.next(0, cur)) return;
    f32x4 acc[2][2][4][2];
#pragma unroll
    for (int a = 0; a < 2; ++a)
#pragma unroll
        for (int b = 0; b < 2; ++b)
#pragma unroll
            for (int m = 0; m < 4; ++m)
#pragma unroll
                for (int n = 0; n < 2; ++n) acc[a][b][m][n] = (f32x4){0.f, 0.f, 0.f, 0.f};
    bf16x8 At[4][2], B0[2][2], B1[2][2];
    const char* cA = PG8_PA(cur); const char* cB = PG8_PB(cur);
    PG8_STAGE(PG8_SB(0, 0), cB, voffB); PG8_STAGE(PG8_SA(0, 0), cA, voffA); PG8_STAGE(PG8_SB(0, 1), cB + hstepB, voffB); PG8_STAGE(PG8_SA(0, 1), cA + hstepA, voffA);
    if (wr == 1) PG8_BAR;
    PG8_WAIT_V(4); PG8_BAR;
    PG8_STAGE(PG8_SB(1, 0), cB + kstep, voffB); PG8_STAGE(PG8_SA(1, 0), cA + kstep, voffA); PG8_STAGE(PG8_SB(1, 1), cB + hstepB + kstep, voffB);
    PG8_WAIT_V(6); PG8_BAR;
    for (;;) {
        const bool has_next = S.next(ui + 1, nxt);
        const char* nA = has_next ? PG8_PA(nxt) : cA; const char* nB = has_next ? PG8_PB(nxt) : cB;
        for (int t = 0; t < nt; t += 2) {
            const bool last = (t == nt - 2);
            const char* a1 = cA + (size_t)(t + 1) * kstep;
            const char* a2 = last ? nA : cA + (size_t)(t + 2) * kstep; const char* b2 = last ? nB : cB + (size_t)(t + 2) * kstep;
            const char* a3 = a2 + kstep; const char* b3 = b2 + kstep;
            PG8_LDB(B0, 0, 0); PG8_SCHED; PG8_LDA(At, 0, 0); PG8_STAGE(PG8_SA(1, 1), a1 + hstepA, voffA);
            PG8_WAIT_L(8); PG8_BAR; PG8_WAIT_L(0); PG8_MMA(0, 0, At, B0); PG8_BAR; PG8_SCHED;
            PG8_LDB(B1, 0, 1); PG8_STAGE(PG8_SB(0, 0), b2, voffB);
            PG8_BAR; PG8_WAIT_L(0); PG8_MMA(0, 1, At, B1); PG8_BAR;
            PG8_LDA(At, 0, 1); PG8_STAGE(PG8_SA(0, 0), a2, voffA);
            PG8_BAR; PG8_WAIT_L(0); PG8_MMA(1, 0, At, B0); PG8_BAR; PG8_SCHED;
            PG8_STAGE(PG8_SB(0, 1), b2 + hstepB, voffB);
            PG8_WAIT_V(6); PG8_BAR; PG8_MMA(1, 1, At, B1); PG8_BAR;
            PG8_LDB(B0, 1, 0); PG8_SCHED; PG8_LDA(At, 1, 0); PG8_STAGE(PG8_SA(0, 1), a2 + hstepA, voffA);
            PG8_WAIT_L(8); PG8_BAR; PG8_WAIT_L(0); PG8_MMA(0, 0, At, B0); PG8_BAR; PG8_SCHED;
            PG8_LDB(B1, 1, 1); PG8_STAGE(PG8_SB(1, 0), b3, voffB);
            PG8_BAR; PG8_WAIT_L(0); PG8_MMA(0, 1, At, B1); PG8_BAR;
            PG8_LDA(At, 1, 1); PG8_STAGE(PG8_SA(1, 0), a3, voffA);
            PG8_BAR; PG8_WAIT_L(0); PG8_MMA(1, 0, At, B0); PG8_BAR; PG8_SCHED;
            PG8_STAGE(PG8_SB(1, 1), b3 + hstepB, voffB);
            PG8_WAIT_V(6); PG8_BAR; PG8_MMA(1, 1, At, B1); PG8_BAR;
        }
        E(acc, cur, wr, wc, fr, fq);
        if (!has_next) break;
#pragma unroll
        for (int a = 0; a < 2; ++a)
#pragma unroll
            for (int b = 0; b < 2; ++b)
#pragma unroll
                for (int m = 0; m < 4; ++m)
#pragma unroll
                    for (int n = 0; n < 2; ++n) acc[a][b][m][n] = (f32x4){0.f, 0.f, 0.f, 0.f};
        cur = nxt; cA = nA; cB = nB; ++ui;
    }
    PG8_WAIT_V(0);
    if (wr == 0) PG8_BAR;
    PG8_BAR;
#undef PG8_SA
#undef PG8_SB
#undef PG8_STAGE
#undef PG8_LDA
#undef PG8_LDB
#undef PG8_MMA
#undef PG8_WAIT_V
#undef PG8_WAIT_L
#undef PG8_BAR
#undef PG8_SCHED
#undef PG8_PA
#undef PG8_PB
}

struct EpiF32 {
    static constexpr bool PERM = false;
    float* C; int ldc;
    DEVI void operator()(const f32x4 (&acc)[2][2][4][2], const Unit& u, int wr, int wc, int fr, int fq) const {
        const int row0 = u.pm * BM + wr * 64 + fr, col0 = u.pn * BM + wc * 32 + 4 * fq;
#pragma unroll
        for (int ai = 0; ai < 2; ++ai)
#pragma unroll
            for (int m = 0; m < 4; ++m) { float* rowp = C + (size_t)(row0 + ai * HALF + m * 16) * ldc + col0;
#pragma unroll
                for (int bj = 0; bj < 2; ++bj)
#pragma unroll
                    for (int n = 0; n < 2; ++n) *(f32x4*)(rowp + bj * HALF + n * 16) = acc[ai][bj][m][n]; }
    }
};
struct EpiSwiGLU {
    static constexpr bool PERM = false;
    bf16_t* O; int ldc;
    DEVI void operator()(const f32x4 (&acc)[2][2][4][2], const Unit& u, int wr, int wc, int fr, int fq) const {
        const int row0 = u.pm * BM + wr * 64 + fr, col0 = u.pn * 128 + wc * 32 + 8 * fq;
#pragma unroll
        for (int ai = 0; ai < 2; ++ai)
#pragma unroll
            for (int m = 0; m < 4; ++m) {
                float v[8];
#pragma unroll
                for (int bj = 0; bj < 2; ++bj)
#pragma unroll
                    for (int i = 0; i < 4; ++i) { const float gt = acc[ai][bj][m][0][i], up = acc[ai][bj][m][1][i]; v[bj * 4 + i] = silu(gt) * up; }
                *(u32x4*)(O + (size_t)(row0 + ai * HALF + m * 16) * ldc + col0) = pack8(v);
            }
    }
};
struct EpiInProj {
    static constexpr bool PERM = true;
    bf16_t* O; int ldc;
    DEVI void operator()(const f32x4 (&acc)[2][2][4][2], const Unit& u, int wr, int wc, int fr, int fq) const {
        const int row0 = u.pm * BM + wr * 64 + fr;
#pragma unroll
        for (int bj = 0; bj < 2; ++bj) {
            const int c0 = u.pn * BM + bj * HALF + wc * 32 + 8 * fq;
            int kind = 0;
            if (c0 >= C_MLO && c0 < C_MLG) kind = 1; else if (c0 >= C_LRY && c0 < C_DNQ) kind = 2; else if (c0 >= C_DNZ && c0 < C_DNBA) kind = 3; else if (c0 >= C_GATE) kind = 1;
#pragma unroll
            for (int ai = 0; ai < 2; ++ai)
#pragma unroll
                for (int m = 0; m < 4; ++m) {
                    float v[8];
#pragma unroll
                    for (int n = 0; n < 2; ++n)
#pragma unroll
                        for (int i = 0; i < 4; ++i) { float x = acc[ai][bj][m][n][i]; v[n * 4 + i] = kind == 0 ? x : (kind == 1 ? sigm(x) : (kind == 2 ? gelu_t(x) : silu(x))); }
                    *(u32x4*)(O + (size_t)(row0 + ai * HALF + m * 16) * ldc + c0) = pack8(v);
                }
        }
    }
};
struct EpiBranch {
    static constexpr bool PERM = false;
    const bf16_t* P; float* T; bf16_t* U;
    DEVI void operator()(const f32x4 (&acc)[2][2][4][2], const Unit& u, int wr, int wc, int fr, int fq) const {
        const int row0 = u.pm * BM + wr * 64 + fr, col0 = u.pn * BM + wc * 32 + 4 * fq; const int z = u.z;
#pragma unroll
        for (int ai = 0; ai < 2; ++ai)
#pragma unroll
            for (int m = 0; m < 4; ++m) { const size_t row = (size_t)(row0 + ai * HALF + m * 16);
#pragma unroll
                for (int bj = 0; bj < 2; ++bj)
#pragma unroll
                    for (int n = 0; n < 2; ++n) { const int col = col0 + bj * HALF + n * 16;
                        const u32x2 gr = *(const u32x2*)(P + row * DINP + C_GATE + z * D + col);
                        f32x4 a = acc[ai][bj][m][n];
                        a[0] *= __uint_as_float(gr[0] << 16); a[1] *= __uint_as_float(gr[0] & 0xffff0000u); a[2] *= __uint_as_float(gr[1] << 16); a[3] *= __uint_as_float(gr[1] & 0xffff0000u);
                        float* tp = T + row * D + col;
                        if (z == 0) *(f32x4*)tp = a;
                        else if (z == 1) { f32x4 o = *(f32x4*)tp; *(f32x4*)tp = o + a; }
                        else { f32x4 o = *(f32x4*)tp; o = o + a; u32x2 w; w[0] = pk2(o[0], o[1]); w[1] = pk2(o[2], o[3]); *(u32x2*)(U + row * D + col) = w; }
                    } }
    }
};
}

DEVI int tok_row(bool gdn, int dir, int b, int c, int t) {
    if (c < 4) { int p = c * 64 + t; if (dir) p = 255 - p; return MLAT + b * 256 + p; }
    int p = (c - 4) * 64 + t; if (dir) p = 4095 - p;
    const int s = gdn ? ((p & 63) * 64 + (p >> 6)) : p;
    return b * 4096 + s;
}
DEVI int pos_row(bool gdn, int b, bool isctx, int p) {
    if (isctx) { if (p < 0 || p >= 256) return -1; return MLAT + b * 256 + p; }
    if (p < 0 || p >= 4096) return -1;
    const int s = gdn ? ((p & 63) * 64 + (p >> 6)) : p;
    return b * 4096 + s;
}
DEVI int dir_chunk(int dir, int j) { return dir ? (j < 4 ? 3 - j : 71 - j) : j; }

DEVI int gu_rowmap(int s) {
    const int n = s >= DFF ? 1 : 0, a = s - n * DFF, pn = a >> 7, r = a & 127, wc = r >> 5, fq = (r >> 3) & 3, bj = (r >> 2) & 1, i = r & 3;
    return 256 * pn + 128 * bj + 32 * wc + 16 * n + 4 * fq + i;
}
DEVI void cvt_tile(const float* src, int ldsrc, int Nvalid, int k0, int n0, bf16_t* dst, int lddst, int mode, float* buf, int lane) {
#pragma unroll 4
    for (int it = 0; it < 16; ++it) {
        const int row = it * 4 + (lane >> 4), c4 = (lane & 15) * 4;
        f32x4 v = (f32x4){0.f, 0.f, 0.f, 0.f};
        if (n0 + c4 < Nvalid) v = *(const f32x4*)(src + (size_t)(k0 + row) * ldsrc + n0 + c4);
        float* bp = buf + row * 65 + c4; bp[0] = v[0]; bp[1] = v[1]; bp[2] = v[2]; bp[3] = v[3];
    }
    asm volatile("s_waitcnt lgkmcnt(0)" ::: "memory"); __builtin_amdgcn_wave_barrier();
#pragma unroll 2
    for (int it = 0; it < 8; ++it) {
        const int nc = it * 8 + (lane >> 3), kk = (lane & 7) * 8;
        float f[8];
#pragma unroll
        for (int e = 0; e < 8; ++e) f[e] = buf[(kk + e) * 65 + nc];
        const int drow = mode == 1 ? gu_rowmap(n0 + nc) : (n0 + nc);
        *(u32x4*)(dst + (size_t)drow * lddst + k0 + kk) = pack8(f);
    }
    asm volatile("s_waitcnt lgkmcnt(0)" ::: "memory"); __builtin_amdgcn_wave_barrier();
}
DEVI void convert_phase(const Params& p, int l, unsigned char* shm, int gwave, int nwaves, int wid, int lane) {
    float* buf = (float*)shm + wid * (64 * 65);
    unsigned char* ws = p.ws;
    for (int t = gwave; t < 6880; t += nwaves) {
        int r = t;
        if (r < 2816) { const int f = r / 1408; r -= f * 1408; const int kt = r / 88, ntl = r % 88;
            cvt_tile(pin(7) + ((size_t)(l * 2 + f)) * D * 2 * DFF, 2 * DFF, 2 * DFF, kt * 64, ntl * 64, (bf16_t*)(ws + WS_WGU + f * SZ_WGU), D, 1, buf, lane); continue; }
        r -= 2816;
        if (r < 1408) { const int f = r / 704; r -= f * 704; const int kt = r / 16, ntl = r % 16;
            cvt_tile(pin(8) + ((size_t)(l * 2 + f)) * DFF * D, D, D, kt * 64, ntl * 64, (bf16_t*)(ws + WS_WDN + f * SZ_WDN), DFF, 0, buf, lane); continue; }
        r -= 1408;
        if (r < 1984) { const int kt = r / 124, ntl = r % 124;
            cvt_tile(pin(9) + (size_t)l * D * C_END, C_END, C_END, kt * 64, ntl * 64, (bf16_t*)(ws + WS_WIN), D, 0, buf, lane); continue; }
        r -= 1984;
        if (r < 384) { const int n = r / 128; r -= n * 128; const int kt = r / 16, ntl = r % 16;
            cvt_tile(pin(23) + ((size_t)(l * 3 + n)) * 512 * D, D, D, kt * 64, ntl * 64, (bf16_t*)(ws + WS_WBR) + (size_t)n * D * 512, 512, 0, buf, lane); continue; }
        r -= 384;
        if (r < 256) { const int kt = r / 16, ntl = r % 16;
            cvt_tile(pin(24) + (size_t)l * D * D, D, D, kt * 64, ntl * 64, (bf16_t*)(ws + WS_WOUT), D, 0, buf, lane); continue; }
        r -= 256;
        { const int gate = r >> 4, dn = r & 15;
            cvt_tile(pin(gate ? 16 : 14) + ((size_t)l * 16 + dn) * 4096, 64, 64, 0, 0, (bf16_t*)(ws + WS_WLRU) + (size_t)(gate * 16 + dn) * 4096, 64, 0, buf, lane); }
    }
}

DEVI void mod_phase(const Params& p, unsigned char* shm, int wv) {
    float* sC = (float*)shm;
    float* red = sC + 5 * 1024;
    const int tid = MYTID;
    for (int i = tid; i < 5 * 1024; i += 512) { const int v = i >> 10, k = i & 1023; const float x = v < 4 ? pin(1)[v * 1024 + k] : pin(3)[k]; sC[i] = silu(x); }
    __syncthreads();
    float* MOD = (float*)(p.ws + WS_MOD);
    const int cgp = tid & 15, is = tid >> 4;
    for (int task = blockIdx.x; task < DEPTH * 144; task += gridDim.x) {
        const int l = task / 144, col0 = (task % 144) * 64;
        float acc[5][4];
#pragma unroll
        for (int v = 0; v < 5; ++v)
#pragma unroll
            for (int e = 0; e < 4; ++e) acc[v][e] = 0.f;
        const float* wp = pin(4) + ((size_t)l * 1024 + is * 32) * 9216 + col0 + cgp * 4;
#pragma unroll 8
        for (int r = 0; r < 32; ++r) {
            const f32x4 w = *(const f32x4*)(wp + (size_t)r * 9216);
#pragma unroll
            for (int v = 0; v < 5; ++v) { const float s = sC[v * 1024 + is * 32 + r];
#pragma unroll
                for (int e = 0; e < 4; ++e) acc[v][e] += s * w[e]; }
        }
#pragma unroll
        for (int v = 0; v < 5; ++v)
#pragma unroll
            for (int e = 0; e < 4; ++e) red[tid * 20 + v * 4 + e] = acc[v][e];
        __syncthreads();
        if (tid < 320) { const int v = tid >> 6, c = tid & 63; float s = 0.f;
            for (int k = 0; k < 32; ++k) s += red[(k * 16 + (c >> 2)) * 20 + v * 4 + (c & 3)];
            MOD[((size_t)(l * 5 + v)) * 9216 + col0 + c] = s + pin(5)[(size_t)l * 9216 + col0 + c]; }
        __syncthreads();
    }
}

DEVI void rowwise_phase(const Params& p, int mode, int nrows, int l, int kgate, float coef, int gpost_i, int ln, int gpre_i, int kshift, int gwave, int nwaves, int lane) {
    float* X = (float*)(p.ws + WS_X); const float* Y = (const float*)(p.ws + WS_Y); bf16_t* H = (bf16_t*)(p.ws + WS_H);
    const float* MOD = (const float*)(p.ws + WS_MOD);
    for (int row = gwave; row < nrows; row += nwaves) {
        const int v = row < MLAT ? (row >> 12) : 4;
        f32x4 x[4];
        if (mode == 0) {
            const float* src = row < MLAT ? pin(0) + (size_t)row * D : pin(2) + (size_t)(row - MLAT) * D;
#pragma unroll
            for (int i = 0; i < 4; ++i) x[i] = *(const f32x4*)(src + lane * 4 + 256 * i);
        } else {
            f32x4 y[4]; float ss = 0.f;
#pragma unroll
            for (int i = 0; i < 4; ++i) { y[i] = *(const f32x4*)(Y + (size_t)row * D + lane * 4 + 256 * i); x[i] = *(const f32x4*)(X + (size_t)row * D + lane * 4 + 256 * i); }
#pragma unroll
            for (int i = 0; i < 4; ++i) ss += y[i][0] * y[i][0] + y[i][1] * y[i][1] + y[i][2] * y[i][2] + y[i][3] * y[i][3];
            ss = wsum(ss); const float rs = rsqrtf(ss * (1.f / D) + EPS) * coef;
            const float* gp = pin(6) + ((size_t)l * 6 + gpost_i) * D; const float* gt = MOD + ((size_t)(l * 5 + v) * 9 + kgate) * D;
#pragma unroll
            for (int i = 0; i < 4; ++i) { const f32x4 g = *(const f32x4*)(gp + lane * 4 + 256 * i), m = *(const f32x4*)(gt + lane * 4 + 256 * i);
                x[i] = x[i] + m * (y[i] * rs * g); }
        }
        if (mode == 2) {
#pragma unroll
            for (int i = 0; i < 4; ++i) *(f32x4*)((float*)pin(25) + (size_t)row * D + lane * 4 + 256 * i) = x[i];
            continue;
        }
#pragma unroll
        for (int i = 0; i < 4; ++i) *(f32x4*)(X + (size_t)row * D + lane * 4 + 256 * i) = x[i];
        float ss = 0.f;
#pragma unroll
        for (int i = 0; i < 4; ++i) ss += x[i][0] * x[i][0] + x[i][1] * x[i][1] + x[i][2] * x[i][2] + x[i][3] * x[i][3];
        ss = wsum(ss); const float rs = rsqrtf(ss * (1.f / D) + EPS);
        const float* gp = pin(6) + ((size_t)ln * 6 + gpre_i) * D; const float* sh = MOD + ((size_t)(ln * 5 + v) * 9 + kshift) * D; const float* sc = sh + D;
#pragma unroll
        for (int i = 0; i < 4; ++i) { const f32x4 g = *(const f32x4*)(gp + lane * 4 + 256 * i), a = *(const f32x4*)(sh + lane * 4 + 256 * i), s = *(const f32x4*)(sc + lane * 4 + 256 * i);
            const f32x4 h = x[i] * rs * g * (s + 1.f) + a; u32x2 w; w[0] = pk2(h[0], h[1]); w[1] = pk2(h[2], h[3]);
            *(u32x2*)(H + (size_t)row * D + lane * 4 + 256 * i) = w; }
    }
}

DEVI void gdn_load(const bf16_t* P, const float* convw, int b, int c, int h, int dir, int want, bf16_t* sQ, bf16_t* sK, bf16_t* sKT, bf16_t* sVT, int tid) {
    const bool isctx = c < 4;
#pragma unroll 1
    for (int r = 0; r < 6; ++r) {
        const int task = tid + 512 * r, seg = task >> 10, rem = task & 1023, t = rem >> 4, cgp = rem & 15;
        if (seg == 0 && !(want & 1)) continue;
        if (seg == 1 && !(want & 6)) continue;
        if (seg == 2 && !(want & 8)) continue;
        int p = (isctx ? c : c - 4) * 64 + t; if (dir) p = (isctx ? 255 : 4095) - p;
        const int ch = seg * 512 + h * 128 + cgp * 8;
        float a[8];
#pragma unroll
        for (int e = 0; e < 8; ++e) a[e] = 0.f;
#pragma unroll
        for (int j = 0; j < 4; ++j) {
            const int row = pos_row(true, b, isctx, p + j - 2);
            if (row >= 0) {
                const u32x4 raw = *(const u32x4*)(P + (size_t)row * DINP + C_DNQ + ch); float x[8]; unpack8(raw, x);
                const f32x4 w0 = *(const f32x4*)(convw + j * 1536 + ch), w1 = *(const f32x4*)(convw + j * 1536 + ch + 4);
                a[0] += w0[0] * x[0]; a[1] += w0[1] * x[1]; a[2] += w0[2] * x[2]; a[3] += w0[3] * x[3];
                a[4] += w1[0] * x[4]; a[5] += w1[1] * x[5]; a[6] += w1[2] * x[6]; a[7] += w1[3] * x[7];
            }
        }
        float ss = 0.f;
#pragma unroll
        for (int e = 0; e < 8; ++e) { a[e] = silu(a[e]); ss += a[e] * a[e]; }
        if (seg < 2) {
            ss += __shfl_xor(ss, 1, 64); ss += __shfl_xor(ss, 2, 64); ss += __shfl_xor(ss, 4, 64); ss += __shfl_xor(ss, 8, 64);
            float inv = rsqrtf(ss + EPS); if (seg == 0) inv *= 0.08838834764831845f;
#pragma unroll
            for (int e = 0; e < 8; ++e) a[e] *= inv;
        }
        if (seg == 0) *(u32x4*)(sQ + t * 136 + cgp * 8) = pack8(a);
        else if (seg == 1) {
            if (want & 2) *(u32x4*)(sK + t * 136 + cgp * 8) = pack8(a);
            if (want & 4) {
#pragma unroll
                for (int e = 0; e < 8; ++e) sKT[(cgp * 8 + e) * 72 + t] = (bf16_t)f2bf(a[e]); }
        } else {
#pragma unroll
            for (int e = 0; e < 8; ++e) sVT[(cgp * 8 + e) * 72 + t] = (bf16_t)f2bf(a[e]);
        }
    }
}
DEVI void gdn_gates(const Params& p, const bf16_t* P, int l, int b, int c, int h, int dir, float* sc, int lane) {
    const int row = tok_row(true, dir, b, c, lane);
    const float bb = bf2f(P[(size_t)row * DINP + C_DNBA + dir * 4 + h]), aa = bf2f(P[(size_t)row * DINP + C_DNBA + 8 + dir * 4 + h]);
    const float beta = sigm(bb);
    const float g = -__expf(pin(20)[l * 8 + dir * 4 + h]) * softplus(aa + pin(21)[l * 8 + dir * 4 + h]);
    float G = g;
#pragma unroll
    for (int o = 1; o < 64; o <<= 1) { const float t = __shfl_up(G, o, 64); if (lane >= o) G += t; }
    const float GT = __shfl(G, 63, 64);
    sc[lane] = G; sc[64 + lane] = beta; sc[128 + lane] = __expf(G); sc[192 + lane] = __expf(GT - G); if (lane == 0) sc[256] = __expf(GT);
}

DEVI void gdn_prep_item(const Params& p, int l, int item, unsigned char* shm, int wv) {
    const int tid = MYTID, wid = __builtin_amdgcn_readfirstlane(tid >> 6), lane = tid & 63, fr = lane & 15, fq = lane >> 4;
    const int c = item % NCH, h = (item / NCH) & 3, b = (item / (NCH * 4)) & 3, dir = item / (NCH * 16);
    const bf16_t* P = (const bf16_t*)(p.ws + WS_P);
    bf16_t* sK = (bf16_t*)shm;
    bf16_t* sKT = (bf16_t*)(shm + 17408);
    bf16_t* sVT = (bf16_t*)(shm + 35840);
    float* sTm = (float*)(shm + 54272);
    bf16_t* sT1 = (bf16_t*)(shm + 71680);
    bf16_t* sT2 = (bf16_t*)(shm + 80896);
    bf16_t* sWT = (bf16_t*)(shm + 90112);
    bf16_t* sUT = (bf16_t*)(shm + 108544);
    float* sc = (float*)(shm + 126976);
    if (wid == 0) gdn_gates(p, P, l, b, c, h, dir, sc, lane);
    gdn_load(P, pin(19) + (size_t)l * 4 * 1536, b, c, h, dir, 2 | 4 | 8, nullptr, sK, sKT, sVT, tid);
    __syncthreads();
#pragma unroll
    for (int ti = 0; ti < 2; ++ti) {
        const int tile = wid * 2 + ti, mt = tile >> 2, nt = tile & 3;
        f32x4 acc = (f32x4){0.f, 0.f, 0.f, 0.f};
#pragma unroll
        for (int kk = 0; kk < 4; ++kk) acc = MFMA16(ldfrag(sK, 136, mt * 16, kk * 32, lane), ldfrag(sK, 136, nt * 16, kk * 32, lane), acc);
        const int s = nt * 16 + fr;
#pragma unroll
        for (int j = 0; j < 4; ++j) { const int t = mt * 16 + fq * 4 + j; sTm[t * 68 + s] = s < t ? sc[64 + t] * acc[j] * __expf(sc[t] - sc[s]) : 0.f; }
    }
    __syncthreads();
    if (wid == 0) {
        float x[64];
        int lz; asm volatile("v_mov_b32 %0, 0" : "=v"(lz));
        const float* tm = sTm + lz;
        const float b1 = sc[64 + lane] * sc[128 + lane], b2 = sc[64 + lane];
#pragma unroll
        for (int t = 0; t < 64; ++t) {
            float v = -sTm[t * 68 + lane];
#pragma unroll
            for (int s4 = 0; s4 < (t + 3) / 4; ++s4) {
                const f32x4 a = *(const f32x4*)(tm + t * 68 + s4 * 4);
#pragma unroll
                for (int e = 0; e < 4; ++e) if (s4 * 4 + e < t) v -= a[e] * x[s4 * 4 + e];
            }
            x[t] = v;
            sT1[t * 72 + lane] = (bf16_t)f2bf(v * b1); sT2[t * 72 + lane] = (bf16_t)f2bf(v * b2);
            __builtin_amdgcn_sched_barrier(0);
        }
        asm volatile("s_waitcnt lgkmcnt(0)" ::: "memory");
        sT1[lane * 72 + lane] = (bf16_t)f2bf(b1); sT2[lane * 72 + lane] = (bf16_t)f2bf(b2);
    }
    __syncthreads();
    bf16_t* GW = (bf16_t*)(p.ws + WS_H) + (size_t)item * 64 * 128;
    bf16_t* GU = (bf16_t*)(p.ws + WS_GU) + (size_t)item * 64 * 128;
    {
        const int tid2 = opaque(tid), lane = tid2 & 63, fr = lane & 15, fq = lane >> 4;
        const int mt = wid;
#pragma unroll
        for (int nt = 0; nt < 4; ++nt) {
            f32x4 aw = (f32x4){0.f, 0.f, 0.f, 0.f}, au = aw;
#pragma unroll
            for (int kk = 0; kk < 2; ++kk) { aw = MFMA16(ldfrag(sKT, 72, mt * 16, kk * 32, lane), ldfrag(sT1, 72, nt * 16, kk * 32, lane), aw);
                au = MFMA16(ldfrag(sVT, 72, mt * 16, kk * 32, lane), ldfrag(sT2, 72, nt * 16, kk * 32, lane), au); }
            const int t = nt * 16 + fr, r0 = mt * 16 + fq * 4; const float dec = sc[192 + t];
            u32x2 w; w[0] = pk2(aw[0], aw[1]); w[1] = pk2(aw[2], aw[3]); *(u32x2*)(GW + t * 128 + r0) = w;
            w[0] = pk2(au[0], au[1]); w[1] = pk2(au[2], au[3]); *(u32x2*)(GU + t * 128 + r0) = w;
#pragma unroll
            for (int j = 0; j < 4; ++j) { sWT[(r0 + j) * 72 + t] = (bf16_t)f2bf(aw[j] * dec); sUT[(r0 + j) * 72 + t] = (bf16_t)f2bf(au[j] * dec); }
        }
    }
    __syncthreads();
    bf16_t* GB = (bf16_t*)(p.ws + WS_GB) + (size_t)item * 128 * 128;
    bf16_t* GN = (bf16_t*)(p.ws + WS_GN) + (size_t)item * 128 * 128;
    {
        const int tid2 = opaque(tid), lane = tid2 & 63, fr = lane & 15, fq = lane >> 4;
        const int mt = wid;
#pragma unroll
        for (int nt = 0; nt < 8; ++nt) {
            f32x4 ab = (f32x4){0.f, 0.f, 0.f, 0.f}, an = ab;
#pragma unroll
            for (int kk = 0; kk < 2; ++kk) { ab = MFMA16(ldfrag(sWT, 72, mt * 16, kk * 32, lane), ldfrag(sKT, 72, nt * 16, kk * 32, lane), ab);
                an = MFMA16(ldfrag(sKT, 72, mt * 16, kk * 32, lane), ldfrag(sUT, 72, nt * 16, kk * 32, lane), an); }
            const int cc = nt * 16 + fr, r0 = mt * 16 + fq * 4;
            u32x2 w; w[0] = pk2(-ab[0], -ab[1]); w[1] = pk2(-ab[2], -ab[3]); *(u32x2*)(GB + cc * 128 + r0) = w;
            w[0] = pk2(an[0], an[1]); w[1] = pk2(an[2], an[3]); *(u32x2*)(GN + cc * 128 + r0) = w;
        }
    }
    if (tid == 0) ((float*)(p.ws + WS_SM + SM_GDEC))[item] = sc[256];
    __syncthreads();
}

DEVI void gdn_seq_unit(const Params& p, int unit, unsigned char* shm, int wv) {
    const int tid = MYTID, wid = __builtin_amdgcn_readfirstlane(tid >> 6), lane = tid & 63, fr = lane & 15, fq = lane >> 4;
    const int chain = unit >> 3, es = unit & 7;
    bf16_t* sS = (bf16_t*)shm;
    const bf16_t* GB = (const bf16_t*)(p.ws + WS_GB) + (size_t)chain * NCH * 16384;
    bf16_t* GN = (bf16_t*)(p.ws + WS_GN) + (size_t)chain * NCH * 16384;
    const float* GDEC = (const float*)(p.ws + WS_SM + SM_GDEC) + chain * NCH;
    f32x4 acc = (f32x4){0.f, 0.f, 0.f, 0.f};
    bf16x8 an[4]; u32x2 nn; float dn;
    const size_t aoff = (size_t)(wid * 16 + fr) * 128 + fq * 8, noff = (size_t)(es * 16 + fr) * 128 + wid * 16 + fq * 4;
#pragma unroll
    for (int kk = 0; kk < 4; ++kk) an[kk] = *(const bf16x8*)(GB + aoff + kk * 32);
    nn = *(const u32x2*)(GN + noff); dn = GDEC[0];
#pragma unroll 1
    for (int c = 0; c < NCH; ++c) {
        bf16x8 a[4]; u32x2 ncur = nn; const float dcur = dn;
#pragma unroll
        for (int kk = 0; kk < 4; ++kk) a[kk] = an[kk];
        u32x2 sw; sw[0] = pk2(acc[0], acc[1]); sw[1] = pk2(acc[2], acc[3]);
        bf16_t* sb = sS + (c & 1) * (16 * 136);
        *(u32x2*)(sb + fr * 136 + wid * 16 + fq * 4) = sw;
        *(u32x2*)(GN + (size_t)c * 16384 + noff) = sw;
        if (c + 1 < NCH) {
#pragma unroll
            for (int kk = 0; kk < 4; ++kk) an[kk] = *(const bf16x8*)(GB + (size_t)(c + 1) * 16384 + aoff + kk * 32);
            nn = *(const u32x2*)(GN + (size_t)(c + 1) * 16384 + noff); dn = GDEC[c + 1];
        }
        __syncthreads();
        acc[0] = dcur * acc[0] + __uint_as_float(ncur[0] << 16); acc[1] = dcur * acc[1] + __uint_as_float(ncur[0] & 0xffff0000u);
        acc[2] = dcur * acc[2] + __uint_as_float(ncur[1] << 16); acc[3] = dcur * acc[3] + __uint_as_float(ncur[1] & 0xffff0000u);
#pragma unroll
        for (int kk = 0; kk < 4; ++kk) acc = MFMA16(a[kk], ldfrag(sb, 136, 0, kk * 32, lane), acc);
    }
    __syncthreads();
}

DEVI void gdn_out_item(const Params& p, int l, int item, unsigned char* shm, int wv) {
    const int tid = MYTID, wid = __builtin_amdgcn_readfirstlane(tid >> 6), lane = tid & 63, fr = lane & 15, fq = lane >> 4;
    const int j = item % NCH, h = (item / NCH) & 3, b = item / (NCH * 4);
    bf16_t* P = (bf16_t*)(p.ws + WS_P);
    bf16_t* sQ = (bf16_t*)shm;
    bf16_t* sK = (bf16_t*)(shm + 17408);
    bf16_t* sST = (bf16_t*)(shm + 34816);
    bf16_t* sW = (bf16_t*)(shm + 69632);
    bf16_t* sVN = (bf16_t*)(shm + 87040);
    bf16_t* sA2 = (bf16_t*)(shm + 105472);
    float* sO = (float*)(shm + 114688);
    float* sc = (float*)(shm + 148480);
#pragma unroll 1
    for (int dir = 0; dir < 2; ++dir) {
        const int c = dir_chunk(dir, j);
        const int it2 = ((dir * 4 + b) * 4 + h) * NCH + c;
        if (wid == 0) gdn_gates(p, P, l, b, c, h, dir, sc, lane);
        gdn_load(P, pin(19) + (size_t)l * 4 * 1536, b, c, h, dir, 1 | 2, sQ, sK, nullptr, nullptr, tid);
        const bf16_t* GS = (const bf16_t*)(p.ws + WS_GN) + (size_t)it2 * 16384;
        const bf16_t* GW = (const bf16_t*)(p.ws + WS_H) + (size_t)it2 * 8192;
        const bf16_t* GU = (const bf16_t*)(p.ws + WS_GU) + (size_t)it2 * 8192;
#pragma unroll
        for (int r = 0; r < 4; ++r) { const int idx = tid + 512 * r, row = idx >> 4, cg8 = (idx & 15) * 8; *(u32x4*)(sST + row * 136 + cg8) = *(const u32x4*)(GS + row * 128 + cg8); }
#pragma unroll
        for (int r = 0; r < 2; ++r) { const int idx = tid + 512 * r, row = idx >> 4, cg8 = (idx & 15) * 8; *(u32x4*)(sW + row * 136 + cg8) = *(const u32x4*)(GW + row * 128 + cg8); }
        __syncthreads();
        {
            const int mt = wid;
#pragma unroll
            for (int nt = 0; nt < 4; ++nt) {
                f32x4 a = (f32x4){0.f, 0.f, 0.f, 0.f};
#pragma unroll
                for (int kk = 0; kk < 4; ++kk) a = MFMA16(ldfrag(sST, 136, mt * 16, kk * 32, lane), ldfrag(sW, 136, nt * 16, kk * 32, lane), a);
                const int t = nt * 16 + fr, e0 = mt * 16 + fq * 4;
                const u32x2 ur = *(const u32x2*)(GU + t * 128 + e0);
                sVN[(e0 + 0) * 72 + t] = (bf16_t)f2bf(__uint_as_float(ur[0] << 16) - a[0]); sVN[(e0 + 1) * 72 + t] = (bf16_t)f2bf(__uint_as_float(ur[0] & 0xffff0000u) - a[1]);
                sVN[(e0 + 2) * 72 + t] = (bf16_t)f2bf(__uint_as_float(ur[1] << 16) - a[2]); sVN[(e0 + 3) * 72 + t] = (bf16_t)f2bf(__uint_as_float(ur[1] & 0xffff0000u) - a[3]);
            }
#pragma unroll
            for (int ti = 0; ti < 2; ++ti) {
                const int tile = wid * 2 + ti, m2 = tile >> 2, n2 = tile & 3;
                f32x4 a = (f32x4){0.f, 0.f, 0.f, 0.f};
#pragma unroll
                for (int kk = 0; kk < 4; ++kk) a = MFMA16(ldfrag(sQ, 136, m2 * 16, kk * 32, lane), ldfrag(sK, 136, n2 * 16, kk * 32, lane), a);
                const int s = n2 * 16 + fr;
#pragma unroll
                for (int jj = 0; jj < 4; ++jj) { const int t = m2 * 16 + fq * 4 + jj; sA2[t * 72 + s] = (bf16_t)f2bf(s <= t ? a[jj] * __expf(sc[t] - sc[s]) : 0.f); }
            }
        }
        __syncthreads();
        {
            const int nt = wid;
#pragma unroll
            for (int mt = 0; mt < 4; ++mt) {
                f32x4 a = (f32x4){0.f, 0.f, 0.f, 0.f};
#pragma unroll
                for (int kk = 0; kk < 4; ++kk) a = MFMA16(ldfrag(sQ, 136, mt * 16, kk * 32, lane), ldfrag(sST, 136, nt * 16, kk * 32, lane), a);
#pragma unroll
                for (int jj = 0; jj < 4; ++jj) a[jj] *= sc[128 + mt * 16 + fq * 4 + jj];
#pragma unroll
                for (int kk = 0; kk < 2; ++kk) a = MFMA16(ldfrag(sA2, 72, mt * 16, kk * 32, lane), ldfrag(sVN, 72, nt * 16, kk * 32, lane), a);
                const int e = nt * 16 + fr;
#pragma unroll
                for (int jj = 0; jj < 4; ++jj) { const int t = mt * 16 + fq * 4 + jj; const int i = dir ? 63 - t : t; if (dir) sO[i * 132 + e] += a[jj]; else sO[i * 132 + e] = a[jj]; }
            }
        }
        __syncthreads();
    }
    {
        const int i = tid >> 3, e0 = (tid & 7) * 16;
        float v[16], ss = 0.f;
#pragma unroll
        for (int e = 0; e < 16; ++e) { v[e] = sO[i * 132 + e0 + e]; ss += v[e] * v[e]; }
        ss += __shfl_xor(ss, 1, 64); ss += __shfl_xor(ss, 2, 64); ss += __shfl_xor(ss, 4, 64);
        const float rs = rsqrtf(ss * (1.f / 128.f) + EPS);
        const int row = tok_row(true, 0, b, j, i);
        bf16_t* zp = P + (size_t)row * DINP + C_DNZ + h * 128 + e0;
        const float* g = pin(22) + l * 128 + e0;
#pragma unroll
        for (int half = 0; half < 2; ++half) {
            float z[8]; unpack8(*(const u32x4*)(zp + half * 8), z); float o[8];
#pragma unroll
            for (int e = 0; e < 8; ++e) o[e] = v[half * 8 + e] * rs * g[half * 8 + e] * z[e];
            *(u32x4*)(zp + half * 8) = pack8(o);
        }
    }
    __syncthreads();
}

DEVI float ml_gates(const Params& p, const bf16_t* P, int l, int b, int c, int h, int dir, float* sc, int lane) {
    const int row = tok_row(false, dir, b, c, lane);
    const float ig = bf2f(P[(size_t)row * DINP + C_MLG + dir * 4 + h]) + pin(10)[l * 16 + dir * 4 + h];
    const float fg = bf2f(P[(size_t)row * DINP + C_MLG + (2 + dir) * 4 + h]) + pin(10)[l * 16 + (2 + dir) * 4 + h];
    float bb = logsig(fg);
#pragma unroll
    for (int o = 1; o < 64; o <<= 1) { const float t = __shfl_up(bb, o, 64); if (lane >= o) bb += t; }
    sc[lane] = bb; sc[64 + lane] = ig;
    return __shfl(bb, 63, 64);
}
DEVI void ml_prep_item(const Params& p, int l, int item, unsigned char* shm, int wv) {
    const int tid = MYTID, wid = __builtin_amdgcn_readfirstlane(tid >> 6), lane = tid & 63, fr = lane & 15, fq = lane >> 4;
    const int c = item % NCH, h = (item / NCH) & 3, b = (item / (NCH * 4)) & 3, dir = item / (NCH * 16);
    const bf16_t* P = (const bf16_t*)(p.ws + WS_P);
    bf16_t* sKT = (bf16_t*)shm;
    bf16_t* sVT = (bf16_t*)(shm + 9216);
    float* sc = (float*)(shm + 27648);
    if (wid == 0) {
        const float bT = ml_gates(p, P, l, b, c, h, dir, sc, lane);
        const float lw = bT - sc[lane] + sc[64 + lane];
        const float Mc = wmax(lw);
        sc[128 + lane] = __expf(lw - Mc);
        if (lane == 0) { float* msc = (float*)(p.ws + WS_SM + SM_MSC) + item * 2; msc[0] = bT; msc[1] = Mc; }
    }
    __syncthreads();
    {
        const int t = tid >> 3, cg8 = (tid & 7) * 8; const int row = tok_row(false, dir, b, c, t);
        float x[8]; unpack8(*(const u32x4*)(P + (size_t)row * DINP + C_MLK + h * 64 + cg8), x);
#pragma unroll
        for (int e = 0; e < 8; ++e) sKT[(cg8 + e) * 72 + t] = (bf16_t)f2bf(x[e]);
    }
#pragma unroll
    for (int r = 0; r < 2; ++r) {
        const int idx = tid + 512 * r, t = idx >> 4, cg8 = (idx & 15) * 8; const int row = tok_row(false, dir, b, c, t);
        float x[8]; unpack8(*(const u32x4*)(P + (size_t)row * DINP + C_MLV + h * 128 + cg8), x); const float w = sc[128 + t];
#pragma unroll
        for (int e = 0; e < 8; ++e) sVT[(cg8 + e) * 72 + t] = (bf16_t)f2bf(x[e] * w);
    }
    __syncthreads();
    float* KV = (float*)(p.ws + WS_Y) + (size_t)item * 8192;
    {
        const int nt = wid;
#pragma unroll
        for (int mt = 0; mt < 4; ++mt) {
            f32x4 a = (f32x4){0.f, 0.f, 0.f, 0.f};
#pragma unroll
            for (int kk = 0; kk < 2; ++kk) a = MFMA16(ldfrag(sKT, 72, mt * 16, kk * 32, lane), ldfrag(sVT, 72, nt * 16, kk * 32, lane), a);
            *(f32x4*)(KV + (nt * 16 + fr) * 64 + mt * 16 + fq * 4) = a;
        }
    }
    if (tid < 64) { float s = 0.f;
        for (int t = 0; t < 64; ++t) s += sc[128 + t] * bf2f(sKT[tid * 72 + t]);
        ((float*)(p.ws + WS_SM + SM_MN))[item * 64 + tid] = s; }
    __syncthreads();
}
DEVI void ml_seq(const Params& p, int gtid, int nthreads) {
    const float* MSC = (const float*)(p.ws + WS_SM + SM_MSC);
    float* MM = (float*)(p.ws + WS_SM + SM_MM);
    for (int g = gtid; g < 32 * 4096 + 32 * 32; g += nthreads) {
        const bool isn = g >= 32 * 4096; const int gg = isn ? g - 32 * 4096 : g;
        const int chain = isn ? gg >> 5 : gg >> 12, e2 = isn ? gg & 31 : gg & 4095;
        float* base = isn ? (float*)(p.ws + WS_SM + SM_MN) + (size_t)chain * NCH * 64 + e2 * 2 : (float*)(p.ws + WS_Y) + (size_t)chain * NCH * 8192 + e2 * 2;
        const int stride = isn ? 64 : 8192;
        float m = 0.f; f32x2 C = (f32x2){0.f, 0.f};
        for (int c0 = 0; c0 < NCH; c0 += 4) {
            f32x2 kv[4]; f32x2 sc[4];
#pragma unroll
            for (int u = 0; u < 4; ++u) { kv[u] = *(const f32x2*)(base + (size_t)(c0 + u) * stride); sc[u] = *(const f32x2*)(MSC + (chain * NCH + c0 + u) * 2); }
#pragma unroll
            for (int u = 0; u < 4; ++u) {
                *(f32x2*)(base + (size_t)(c0 + u) * stride) = C;
                if (!isn && e2 == 0) MM[chain * NCH + c0 + u] = m;
                const float mn = fmaxf(sc[u][0] + m, sc[u][1]);
                const float a = __expf(sc[u][0] + m - mn), s = __expf(sc[u][1] - mn);
                C = C * a + kv[u] * s; m = mn;
            }
        }
    }
}
DEVI void ml_out_item(const Params& p, int l, int item, unsigned char* shm, int wv) {
    const int tid = MYTID, wid = __builtin_amdgcn_readfirstlane(tid >> 6), lane = tid & 63, fr = lane & 15, fq = lane >> 4;
    const int j = item % NCH, h = (item / NCH) & 3, b = item / (NCH * 4);
    bf16_t* P = (bf16_t*)(p.ws + WS_P);
    bf16_t* sQ = (bf16_t*)shm;
    bf16_t* sK = (bf16_t*)(shm + 9216);
    bf16_t* sVT = (bf16_t*)(shm + 18432);
    bf16_t* sCT = (bf16_t*)(shm + 36864);
    bf16_t* sS = (bf16_t*)(shm + 55296);
    float* sO = (float*)(shm + 64512);
    float* sc = (float*)(shm + 98304);
#pragma unroll 1
    for (int dir = 0; dir < 2; ++dir) {
        const int c = dir_chunk(dir, j);
        const int it2 = ((dir * 4 + b) * 4 + h) * NCH + c;
        if (wid == 0) {
            ml_gates(p, P, l, b, c, h, dir, sc, lane);
            const float m = ((const float*)(p.ws + WS_SM + SM_MM))[it2];
            const float bb = sc[lane];
            float pm = sc[64 + lane] - bb;
#pragma unroll
            for (int o = 1; o < 64; o <<= 1) { const float t = __shfl_up(pm, o, 64); if (lane >= o) pm = fmaxf(pm, t); }
            const float mt = bb + fmaxf(m, pm);
            sc[128 + lane] = mt; sc[192 + lane] = __expf(bb + m - mt);
            sc[320 + lane] = ((const float*)(p.ws + WS_SM + SM_MN))[it2 * 64 + lane];
        }
        {
            const int t = tid >> 3, cg8 = (tid & 7) * 8; const int row = tok_row(false, dir, b, c, t);
            float x[8]; unpack8(*(const u32x4*)(P + (size_t)row * DINP + C_MLQ + h * 64 + cg8), x);
#pragma unroll
            for (int e = 0; e < 8; ++e) x[e] *= 0.125f;
            *(u32x4*)(sQ + t * 72 + cg8) = pack8(x);
            *(u32x4*)(sK + t * 72 + cg8) = *(const u32x4*)(P + (size_t)row * DINP + C_MLK + h * 64 + cg8);
        }
#pragma unroll
        for (int r = 0; r < 2; ++r) {
            const int idx = tid + 512 * r, t = idx >> 4, cg8 = (idx & 15) * 8; const int row = tok_row(false, dir, b, c, t);
            float x[8]; unpack8(*(const u32x4*)(P + (size_t)row * DINP + C_MLV + h * 128 + cg8), x);
#pragma unroll
            for (int e = 0; e < 8; ++e) sVT[(cg8 + e) * 72 + t] = (bf16_t)f2bf(x[e]);
        }
        {
            const float* CT = (const float*)(p.ws + WS_Y) + (size_t)it2 * 8192;
#pragma unroll
            for (int r = 0; r < 4; ++r) { const int idx = tid + 512 * r, e = idx >> 4, d4 = (idx & 15) * 4; const f32x4 v = *(const f32x4*)(CT + e * 64 + d4);
                u32x2 w; w[0] = pk2(v[0], v[1]); w[1] = pk2(v[2], v[3]); *(u32x2*)(sCT + e * 72 + d4) = w; }
        }
        __syncthreads();
#pragma unroll
        for (int ti = 0; ti < 2; ++ti) {
            const int tile = wid * 2 + ti, m2 = tile >> 2, n2 = tile & 3;
            f32x4 a = (f32x4){0.f, 0.f, 0.f, 0.f};
#pragma unroll
            for (int kk = 0; kk < 2; ++kk) a = MFMA16(ldfrag(sQ, 72, m2 * 16, kk * 32, lane), ldfrag(sK, 72, n2 * 16, kk * 32, lane), a);
            const int s = n2 * 16 + fr;
#pragma unroll
            for (int jj = 0; jj < 4; ++jj) { const int t = m2 * 16 + fq * 4 + jj;
                sS[t * 72 + s] = (bf16_t)f2bf(s <= t ? a[jj] * __expf(sc[t] - sc[s] + sc[64 + s] - sc[128 + t]) : 0.f); }
        }
        __syncthreads();
        if (tid < 64) {
            float ds = 0.f, qn = 0.f;
            for (int s = 0; s < 64; ++s) { ds += bf2f(sS[tid * 72 + s]); qn += bf2f(sQ[tid * 72 + s]) * sc[320 + s]; }
            const float den = ds + sc[192 + tid] * qn;
            sc[256 + tid] = 1.f / fmaxf(fabsf(den), __expf(-sc[128 + tid]));
        }
        __syncthreads();
        {
            const int nt = wid;
#pragma unroll
            for (int mt = 0; mt < 4; ++mt) {
                f32x4 a = (f32x4){0.f, 0.f, 0.f, 0.f};
#pragma unroll
                for (int kk = 0; kk < 2; ++kk) a = MFMA16(ldfrag(sQ, 72, mt * 16, kk * 32, lane), ldfrag(sCT, 72, nt * 16, kk * 32, lane), a);
#pragma unroll
                for (int jj = 0; jj < 4; ++jj) a[jj] *= sc[192 + mt * 16 + fq * 4 + jj];
#pragma unroll
                for (int kk = 0; kk < 2; ++kk) a = MFMA16(ldfrag(sS, 72, mt * 16, kk * 32, lane), ldfrag(sVT, 72, nt * 16, kk * 32, lane), a);
                const int e = nt * 16 + fr;
#pragma unroll
                for (int jj = 0; jj < 4; ++jj) { const int t = mt * 16 + fq * 4 + jj; const int i = dir ? 63 - t : t; const float hv = a[jj] * sc[256 + t];
                    if (dir) sO[i * 132 + e] += hv; else sO[i * 132 + e] = hv; }
            }
        }
        __syncthreads();
    }
    {
        const int i = tid >> 3, e0 = (tid & 7) * 16;
        float v[16], ss = 0.f;
#pragma unroll
        for (int e = 0; e < 16; ++e) { v[e] = sO[i * 132 + e0 + e]; ss += v[e] * v[e]; }
        ss += __shfl_xor(ss, 1, 64); ss += __shfl_xor(ss, 2, 64); ss += __shfl_xor(ss, 4, 64);
        const float rs = rsqrtf(ss * (1.f / 128.f) + EPS);
        const int row = tok_row(false, 0, b, j, i);
        bf16_t* op = P + (size_t)row * DINP + C_MLO + h * 128 + e0;
        const float* g = pin(11) + l * 512 + h * 128 + e0;
#pragma unroll
        for (int half = 0; half < 2; ++half) {
            float z[8]; unpack8(*(const u32x4*)(op + half * 8), z); float o[8];
#pragma unroll
            for (int e = 0; e < 8; ++e) o[e] = v[half * 8 + e] * rs * g[half * 8 + e] * z[e];
            *(u32x4*)(op + half * 8) = pack8(o);
        }
    }
    __syncthreads();
}

DEVI void lru_item(const Params& p, int l, int item, int mode, unsigned char* shm, int wv) {
    const int tid = MYTID, wid = __builtin_amdgcn_readfirstlane(tid >> 6), lane = tid & 63, fr = lane & 15, fq = lane >> 4;
    const int j = item % NCH, b = item / NCH; const bool isctx = j < 4;
    bf16_t* P = (bf16_t*)(p.ws + WS_P);
    bf16_t* sX = (bf16_t*)shm;
    const int p0 = (isctx ? j : j - 4) * 64;
    const float* cw = pin(12) + (size_t)l * 4 * 512; const float* cb = pin(13) + (size_t)l * 512;
#pragma unroll 1
    for (int r = 0; r < 8; ++r) {
        const int task = tid + 512 * r, i = task >> 6, ch = (task & 63) * 8;
        float a[8];
        { const f32x4 b0 = *(const f32x4*)(cb + ch), b1 = *(const f32x4*)(cb + ch + 4); a[0] = b0[0]; a[1] = b0[1]; a[2] = b0[2]; a[3] = b0[3]; a[4] = b1[0]; a[5] = b1[1]; a[6] = b1[2]; a[7] = b1[3]; }
#pragma unroll
        for (int jj = 0; jj < 4; ++jj) {
            const int row = pos_row(false, b, isctx, p0 + i + jj - 2);
            if (row >= 0) { float x[8]; unpack8(*(const u32x4*)(P + (size_t)row * DINP + C_LRX + ch), x);
                const f32x4 w0 = *(const f32x4*)(cw + jj * 512 + ch), w1 = *(const f32x4*)(cw + jj * 512 + ch + 4);
                a[0] += w0[0] * x[0]; a[1] += w0[1] * x[1]; a[2] += w0[2] * x[2]; a[3] += w0[3] * x[3]; a[4] += w1[0] * x[4]; a[5] += w1[1] * x[5]; a[6] += w1[2] * x[6]; a[7] += w1[3] * x[7]; }
        }
        *(u32x4*)(sX + i * 520 + ch) = pack8(a);
    }
    __syncthreads();
    const int blk = wid;
    const bf16_t* WL = (const bf16_t*)(p.ws + WS_WLRU);
    float* LAGG = (float*)(p.ws + WS_SM + SM_LAGG);
#pragma unroll 1
    for (int n4 = 0; n4 < 4; ++n4) {
        const int ch = blk * 64 + n4 * 16 + fr;
        float hsum[4][4];
#pragma unroll
        for (int mt = 0; mt < 4; ++mt)
#pragma unroll
            for (int jj = 0; jj < 4; ++jj) hsum[mt][jj] = 0.f;
#pragma unroll
        for (int dir = 0; dir < 2; ++dir) {
            const bf16_t* wa = WL + (size_t)(0 * 16 + dir * 8 + blk) * 4096 + (n4 * 16 + fr) * 64 + fq * 8;
            const bf16_t* wx = WL + (size_t)(1 * 16 + dir * 8 + blk) * 4096 + (n4 * 16 + fr) * 64 + fq * 8;
            bf16x8 ba[2], bx[2];
#pragma unroll
            for (int kk = 0; kk < 2; ++kk) { ba[kk] = *(const bf16x8*)(wa + kk * 32); bx[kk] = *(const bf16x8*)(wx + kk * 32); }
            const float bias_a = pin(15)[(size_t)l * 1024 + dir * 512 + ch], bias_x = pin(17)[(size_t)l * 1024 + dir * 512 + ch];
            const float cl = -8.f * softplus(-pin(18)[(size_t)l * 1024 + dir * 512 + ch]);
            float av[4][4], bv[4][4];
#pragma unroll
            for (int mt = 0; mt < 4; ++mt) {
                f32x4 aa = (f32x4){0.f, 0.f, 0.f, 0.f}, ax = aa;
#pragma unroll
                for (int kk = 0; kk < 2; ++kk) { const bf16x8 af = ldfrag(sX, 520, mt * 16, blk * 64 + kk * 32, lane); aa = MFMA16(af, ba[kk], aa); ax = MFMA16(af, bx[kk], ax); }
#pragma unroll
                for (int jj = 0; jj < 4; ++jj) {
                    const int t = mt * 16 + fq * 4 + jj;
                    const float rr = sigm(aa[jj] + bias_a), ii = sigm(ax[jj] + bias_x), la = cl * rr;
                    av[mt][jj] = __expf(la);
                    bv[mt][jj] = sqrtf(fmaxf(-expm1f(2.f * la), 0.f)) * ii * bf2f(sX[t * 520 + ch]);
                }
            }
            const int c = dir_chunk(dir, j);
            const size_t aidx = (((size_t)dir * 4 + b) * NCH + c) * 512 + ch;
            float hin = mode ? LAGG[aidx * 2] : 0.f;
            float Pc = 1.f, Hc = 0.f;
#pragma unroll
            for (int mi = 0; mi < 4; ++mi) {
                const int mt = dir ? 3 - mi : mi;
                float Pl = 1.f, Hl = 0.f;
#pragma unroll
                for (int ji = 0; ji < 4; ++ji) { const int jj = dir ? 3 - ji : ji; Pl = av[mt][jj] * Pl; Hl = av[mt][jj] * Hl + bv[mt][jj]; }
                float Pq[4], Hq[4];
#pragma unroll
                for (int q = 0; q < 4; ++q) { Pq[q] = __shfl(Pl, fr + 16 * q, 64); Hq[q] = __shfl(Hl, fr + 16 * q, 64); }
                if (mode == 0) {
#pragma unroll
                    for (int qi = 0; qi < 4; ++qi) { const int q = dir ? 3 - qi : qi; Hc = Pq[q] * Hc + Hq[q]; Pc = Pq[q] * Pc; }
                } else {
                    float hh = hin;
                    float hme = hin;
#pragma unroll
                    for (int qi = 0; qi < 4; ++qi) { const int q = dir ? 3 - qi : qi; if (q == fq) hme = hh; hh = Pq[q] * hh + Hq[q]; }
                    hin = hh;
#pragma unroll
                    for (int ji = 0; ji < 4; ++ji) { const int jj = dir ? 3 - ji : ji; hme = av[mt][jj] * hme + bv[mt][jj]; hsum[mt][jj] += hme; }
                }
            }
            if (mode == 0 && fq == 0) { LAGG[aidx * 2] = Pc; LAGG[aidx * 2 + 1] = Hc; }
        }
        if (mode == 1) {
#pragma unroll
            for (int mt = 0; mt < 4; ++mt)
#pragma unroll
                for (int jj = 0; jj < 4; ++jj) { const int i = mt * 16 + fq * 4 + jj; const int row = pos_row(false, b, isctx, p0 + i);
                    bf16_t* yp = P + (size_t)row * DINP + C_LRY + ch; *yp = (bf16_t)f2bf(hsum[mt][jj] * bf2f(*yp)); }
        }
    }
    __syncthreads();
}
DEVI void lru_seq(const Params& p, int gtid, int nthreads) {
    float* LAGG = (float*)(p.ws + WS_SM + SM_LAGG);
    for (int g = gtid; g < 4096; g += nthreads) {
        const int ch = g & 511, db = g >> 9;
        float h = 0.f;
        for (int c0 = 0; c0 < NCH; c0 += 4) {
            f32x2 v[4];
#pragma unroll
            for (int u = 0; u < 4; ++u) v[u] = *(const f32x2*)(LAGG + (((size_t)db * NCH + c0 + u) * 512 + ch) * 2);
#pragma unroll
            for (int u = 0; u < 4; ++u) { LAGG[(((size_t)db * NCH + c0 + u) * 512 + ch) * 2] = h; h = v[u][0] * h + v[u][1]; }
        }
    }
}

DEVI void gsync(unsigned* bar, unsigned& epoch, int G, int wv) {
    __syncthreads();
    epoch += 1u;
    if (wv == 0) {
        const int ln = (int)__builtin_amdgcn_mbcnt_hi(~0u, __builtin_amdgcn_mbcnt_lo(~0u, 0u));
        if (ln == 0) {
            __builtin_amdgcn_fence(__ATOMIC_RELEASE, "agent");
            __hip_atomic_fetch_add(bar, 1u, __ATOMIC_RELAXED, __HIP_MEMORY_SCOPE_AGENT);
            const unsigned target = epoch * (unsigned)G;
            while (__hip_atomic_load(bar, __ATOMIC_RELAXED, __HIP_MEMORY_SCOPE_AGENT) < target) __builtin_amdgcn_s_sleep(1);
            __builtin_amdgcn_fence(__ATOMIC_ACQUIRE, "agent");
        }
    }
    __syncthreads();
}

__global__ void __launch_bounds__(512) mega(Params p) {
    extern __shared__ __attribute__((aligned(16))) unsigned char shm[];
    cg::grid_group grid = cg::this_grid();
    const int wv = __builtin_amdgcn_readfirstlane(threadIdx.x >> 6);
    const int G = gridDim.x, nwaves = G * 8, nthreads = G * 512;
#define TIDS const int tid = MYTID, wid = tid >> 6, lane = tid & 63, gwave = blockIdx.x * 8 + wid, gtid = blockIdx.x * 512 + tid; (void)gtid; (void)gwave; (void)lane;
    LAS unsigned char* lds = (LAS unsigned char*)shm;
    unsigned char* ws = p.ws;
    bf16_t* Hb = (bf16_t*)(ws + WS_H); bf16_t* Pb = (bf16_t*)(ws + WS_P); float* Yb = (float*)(ws + WS_Y);

    unsigned* bar = (unsigned*)ws; unsigned epoch = 0u;
    mod_phase(p, shm, wv);
    { TIDS convert_phase(p, 0, shm, gwave, nwaves, wid, lane); }
    grid.sync();
    { TIDS rowwise_phase(p, 0, MTOT, 0, 0, 0.f, 0, 0, 0, 0, gwave, nwaves, lane); }
    gsync(bar, epoch, G, wv);

#pragma unroll 1
    for (int l = 0; l < DEPTH; ++l) {
        const bool last = l == DEPTH - 1;
#pragma unroll 1
        for (int f = 0; f < 2; ++f) {
            if (f == 1) {
                { pg8::Gemm g{Hb, (const bf16_t*)(ws + WS_WIN), 68, 31, D, D, 1, 0, 0, 0, 0}; pg8::Order S; S.init(68, 31, 1, G, blockIdx.x);
                  pg8::EpiInProj E{Pb, DINP}; pg8::gemm_phase(lds, g, S, E, wv); }
                gsync(bar, epoch, G, wv);
                for (int it = blockIdx.x; it < 2176 + 2176 + 272; it += G) {
                    if (it < 2176) gdn_prep_item(p, l, it, shm, wv);
                    else if (it < 4352) ml_prep_item(p, l, it - 2176, shm, wv);
                    else lru_item(p, l, it - 4352, 0, shm, wv);
                }
                gsync(bar, epoch, G, wv);
                for (int u = blockIdx.x; u < 256; u += G) gdn_seq_unit(p, u, shm, wv);
                { TIDS ml_seq(p, gtid, nthreads); }
                { TIDS lru_seq(p, gtid, nthreads); }
                gsync(bar, epoch, G, wv);
                for (int it = blockIdx.x; it < 1088 + 1088 + 272; it += G) {
                    int ii = it, kind = 0; if (ii >= 1088) { ii -= 1088; kind = 1; if (ii >= 1088) { ii -= 1088; kind = 2; } }
                    const int jj = ii % NCH;
                    if (last && jj < 4) continue;
                    if (kind == 0) gdn_out_item(p, l, ii, shm, wv); else if (kind == 1) ml_out_item(p, l, ii, shm, wv); else lru_item(p, l, ii, 1, shm, wv);
                }
                gsync(bar, epoch, G, wv);
                const int nM = last ? 64 : 68;
                { pg8::Gemm g{Pb, (const bf16_t*)(ws + WS_WBR), nM, 4, 512, DINP, 3, C_MLO, C_LRY, C_DNZ, D * 512}; pg8::Order S; S.init(nM, 4, 3, G, blockIdx.x);
                  pg8::EpiBranch E{Pb, Yb, Hb}; pg8::gemm_phase(lds, g, S, E, wv); }
                gsync(bar, epoch, G, wv);
                { pg8::Gemm g{Hb, (const bf16_t*)(ws + WS_WOUT), nM, 4, D, D, 1, 0, 0, 0, 0}; pg8::Order S; S.init(nM, 4, 1, G, blockIdx.x);
                  pg8::EpiF32 E{Yb, D}; pg8::gemm_phase(lds, g, S, E, wv); }
                gsync(bar, epoch, G, wv);
                { TIDS rowwise_phase(p, 1, nM * 256, l, 5, 1.f, 3, l, 4, 6, gwave, nwaves, lane); }
                gsync(bar, epoch, G, wv);
            }
            const int nM = (last && f == 1) ? 64 : 68;
            { pg8::Gemm g{Hb, (const bf16_t*)(ws + WS_WGU + f * SZ_WGU), nM, 22, D, D, 1, 0, 0, 0, 0}; pg8::Order S; S.init(nM, 22, 1, G, blockIdx.x);
              pg8::EpiSwiGLU E{Pb, DFF}; pg8::gemm_phase(lds, g, S, E, wv); }
            gsync(bar, epoch, G, wv);
            { pg8::Gemm g{Pb, (const bf16_t*)(ws + WS_WDN + f * SZ_WDN), nM, 4, DFF, DFF, 1, 0, 0, 0, 0}; pg8::Order S; S.init(nM, 4, 1, G, blockIdx.x);
              pg8::EpiF32 E{Yb, D}; pg8::gemm_phase(lds, g, S, E, wv); }
            gsync(bar, epoch, G, wv);
            if (f == 0) { TIDS rowwise_phase(p, 1, nM * 256, l, 2, 0.5f, 1, l, 2, 3, gwave, nwaves, lane); }
            else if (!last) { { TIDS rowwise_phase(p, 1, nM * 256, l, 8, 0.5f, 5, l + 1, 0, 0, gwave, nwaves, lane); } { TIDS convert_phase(p, l + 1, shm, gwave, nwaves, wid, lane); } }
            else { TIDS rowwise_phase(p, 2, MLAT, l, 8, 0.5f, 5, 0, 0, 0, gwave, nwaves, lane); }
            gsync(bar, epoch, G, wv);
        }
    }
}

extern "C" void kernel_launch(void* const* d_in, const int* in_sizes, int n_in, void* d_out, int out_size, void* d_ws, size_t ws_size, hipStream_t stream) {
    static int grid = 0;
    if (grid == 0) {
        if (n_in != 25 || ws_size < WS_END) { fprintf(stderr, "kernel_launch: unexpected n_in %d or ws_size %zu (need %zu)\n", n_in, ws_size, (size_t)WS_END); grid = -1; return; }
        int dev = 0, cus = 0, per_cu = 0;
        hipGetDevice(&dev); hipDeviceGetAttribute(&cus, hipDeviceAttributeMultiprocessorCount, dev);
        if (hipFuncSetAttribute((const void*)mega, hipFuncAttributeMaxDynamicSharedMemorySize, LDS_BYTES) != hipSuccess) { fprintf(stderr, "kernel_launch: hipFuncSetAttribute failed\n"); grid = -1; return; }
        if (hipOccupancyMaxActiveBlocksPerMultiprocessor(&per_cu, (const void*)mega, 512, LDS_BYTES) != hipSuccess || per_cu < 1) { fprintf(stderr, "kernel_launch: occupancy query failed (%d)\n", per_cu); per_cu = 1; }
        (void)hipGetLastError();
        grid = cus * per_cu;
    }
    if (grid < 0) return;
    if (hipMemsetAsync(d_ws, 0, 256, stream) != hipSuccess) { fprintf(stderr, "kernel_launch: memset failed\n"); return; }
    Params p{};
    for (int i = 0; i < 25; ++i) p.in[i] = (const float*)d_in[i];
    p.out = (float*)d_out; p.ws = (unsigned char*)d_ws;
    void* args[] = {&p};
    hipError_t e = hipLaunchCooperativeKernel((const void*)mega, dim3(grid), dim3(512), args, LDS_BYTES, stream);
    if (e != hipSuccess) fprintf(stderr, "cooperative launch failed: %s (grid %d)\n", hipGetErrorString(e), grid);
}
```

```cpp
#include <hip/hip_runtime.h>
#include <hip/hip_cooperative_groups.h>
#include <cstdio>
namespace cg = cooperative_groups;

#define LAS __attribute__((address_space(3)))
#define DEVI __device__ __forceinline__
typedef unsigned short bf16_t;
typedef short bf16x8 __attribute__((ext_vector_type(8)));
typedef float f32x4 __attribute__((ext_vector_type(4)));
typedef float f32x2 __attribute__((ext_vector_type(2)));
typedef unsigned u32x4 __attribute__((ext_vector_type(4)));
typedef unsigned u32x2 __attribute__((ext_vector_type(2)));

constexpr int D = 1024, NBATCH = 4, SEQ = 4096, CTXL = 256, DEPTH = 4, DFF = 2816, DINP = 7936;
constexpr int MLAT = NBATCH * SEQ, MTOT = MLAT + NBATCH * CTXL;
constexpr int NCH = 68;
constexpr int C_MLQ = 0, C_MLK = 256, C_MLV = 512, C_MLO = 1024, C_MLG = 1536, C_LRX = 1552, C_LRY = 2064,
              C_DNQ = 2576, C_DNZ = 4112, C_DNBA = 4624, C_GATE = 4640, C_END = 7712;
constexpr float EPS = 1e-6f;

constexpr size_t SZ_WGU = (size_t)2 * DFF * D * 2, SZ_WDN = (size_t)D * DFF * 2;
constexpr size_t WS_MOD = 4096;
constexpr size_t WS_WGU = 1u << 20;
constexpr size_t WS_WDN = WS_WGU + 2 * SZ_WGU;
constexpr size_t WS_WIN = WS_WDN + 2 * SZ_WDN;
constexpr size_t WS_WBR = WS_WIN + (size_t)DINP * D * 2;
constexpr size_t WS_WOUT = WS_WBR + (size_t)3 * D * 512 * 2;
constexpr size_t WS_WLRU = WS_WOUT + (size_t)D * D * 2;
constexpr size_t WS_X = WS_WLRU + (size_t)32 * 64 * 64 * 2;
constexpr size_t WS_H = WS_X + (size_t)MTOT * D * 4;
constexpr size_t WS_Y = WS_H + (size_t)MTOT * D * 2;
constexpr size_t WS_P = WS_Y + (size_t)MTOT * D * 4;
constexpr size_t WS_GU = WS_P + (size_t)MTOT * DINP * 2;
constexpr size_t WS_GB = WS_GU + (size_t)2176 * 64 * 128 * 2;
constexpr size_t WS_GN = WS_GB + (size_t)2176 * 128 * 128 * 2;
constexpr size_t WS_SM = WS_GN + (size_t)2176 * 128 * 128 * 2;
constexpr size_t SM_GDEC = 0, SM_MN = 16384, SM_MSC = SM_MN + 2176 * 64 * 4, SM_MM = SM_MSC + 2176 * 8, SM_LAGG = SM_MM + 2176 * 4 + 1024;
constexpr size_t WS_END = WS_SM + SM_LAGG + (size_t)2 * 4 * NCH * 512 * 2 * 4 + 4096;
constexpr int LDS_BYTES = 155648;
constexpr int REP_GEMM = 1, REP_PREP = 1, REP_PREPSEQ = 1, REP_CVT = 1;

struct Params { const float* in[25]; float* out; unsigned char* ws; };
struct PW { unsigned char* ws; };

#define CAS __attribute__((address_space(4)))
DEVI const float* pin(int i) { const CAS char* k = (const CAS char*)__builtin_amdgcn_kernarg_segment_ptr(); return *(const float* const volatile CAS*)(k + 8 * i); }
DEVI int opaque(int v) { asm volatile("" : "+v"(v)); return v; }
DEVI unsigned char* opq(unsigned char* p) { unsigned v = (unsigned)(size_t)(LAS unsigned char*)p; asm volatile("" : "+s"(v)); return (unsigned char*)(LAS unsigned char*)(size_t)v; }
DEVI LAS unsigned char* opql(LAS unsigned char* p) { unsigned v = (unsigned)(size_t)p; asm volatile("" : "+s"(v)); return (LAS unsigned char*)(size_t)v; }
DEVI unsigned char* opq64(unsigned char* p) { unsigned long long v = (unsigned long long)p; asm volatile("" : "+s"(v)); return (unsigned char*)v; }
#define MYTID opaque(wv * 64 + (int)__builtin_amdgcn_mbcnt_hi(~0u, __builtin_amdgcn_mbcnt_lo(~0u, 0u)))
DEVI float bf2f(bf16_t v) { return __uint_as_float(((unsigned)v) << 16); }
DEVI unsigned f2bf(float f) { unsigned u = __float_as_uint(f); return (u + 0x7fffu + ((u >> 16) & 1u)) >> 16; }
DEVI unsigned pk2(float lo, float hi) { return f2bf(lo) | (f2bf(hi) << 16); }
DEVI float sigm(float x) { return 1.f / (1.f + __expf(-x)); }
DEVI float silu(float x) { return x * sigm(x); }
DEVI float softplus(float x) { return x > 20.f ? x : log1pf(__expf(x)); }
DEVI float logsig(float x) { return fminf(x, 0.f) - log1pf(__expf(-fabsf(x))); }
DEVI float gelu_t(float x) { float u = 0.7978845608f * (x + 0.044715f * x * x * x); float e = __expf(2.f * u); return 0.5f * x * (2.f - 2.f / (e + 1.f)); }
DEVI float wsum(float v) { for (int o = 32; o > 0; o >>= 1) v += __shfl_xor(v, o, 64); return v; }
DEVI float wmax(float v) { for (int o = 32; o > 0; o >>= 1) v = fmaxf(v, __shfl_xor(v, o, 64)); return v; }
DEVI void unpack8(u32x4 r, float* f) {
    f[0] = __uint_as_float(r[0] << 16); f[1] = __uint_as_float(r[0] & 0xffff0000u); f[2] = __uint_as_float(r[1] << 16); f[3] = __uint_as_float(r[1] & 0xffff0000u);
    f[4] = __uint_as_float(r[2] << 16); f[5] = __uint_as_float(r[2] & 0xffff0000u); f[6] = __uint_as_float(r[3] << 16); f[7] = __uint_as_float(r[3] & 0xffff0000u);
}
DEVI u32x4 pack8(const float* f) { u32x4 r; r[0] = pk2(f[0], f[1]); r[1] = pk2(f[2], f[3]); r[2] = pk2(f[4], f[5]); r[3] = pk2(f[6], f[7]); return r; }
DEVI bf16x8 ldfrag(const bf16_t* base, int ld, int row0, int k0, int lane) { return *(const bf16x8*)(base + (row0 + (lane & 15)) * ld + k0 + (lane >> 4) * 8); }
#define MFMA16(a, b, c) __builtin_amdgcn_mfma_f32_16x16x32_bf16(a, b, c, 0, 0, 0)

namespace pg8 {
constexpr int BM = 256, BK = 64, HALF = 128, HTB = HALF * BK * 2, NXCD = 8, WGM = 8;
DEVI int lds_byte(int r, int c) { const int st = (r >> 4) * 2 + (c >> 5), rr = r & 15, cc = c & 31, ob = rr * 64 + cc * 2; return st * 1024 + (ob ^ (((ob >> 9) & 1) << 5)); }
DEVI void stage_rc(int b, int& R, int& C) { const int st = b / 1024, sb = b % 1024, swz = sb ^ (((sb >> 9) & 1) << 5); R = (st >> 1) * 16 + swz / 64; C = (st & 1) * 32 + (swz % 64) / 2; }
DEVI int perm32(int rho) { const int n = rho >> 4, i = rho & 15; return 8 * (i >> 2) + 4 * n + (i & 3); }
struct Unit { int pm, pn, z; };
struct Gemm { const bf16_t* A; const bf16_t* Bt; int nM, nN, K, lda, nz, zA0, zA1, zA2, zB; };
struct Order {
    int nM, nN, nwg, G, c, nz;
    DEVI void init(int nM_, int nN_, int nz_, int G_, int c_) { nM = nM_; nN = nN_; nwg = nM * nN; G = G_; c = c_; nz = nz_; }
    DEVI bool next(int i, Unit& u) const {
        int ti = i, z = 0; if (nz == 3) { ti = i / 3; z = i - ti * 3; }
        const long L = (long)ti * G + c; if (L >= nwg) return false;
        int wgid = (int)L; { const int q = nwg / NXCD, r = nwg % NXCD, xcd = wgid % NXCD, off = wgid / NXCD; wgid = (xcd < r ? xcd * (q + 1) : r * (q + 1) + (xcd - r) * q) + off; }
        const int nig = WGM * nN, gid = wgid / nig, fm = gid * WGM, gsz = (nM - fm) < WGM ? (nM - fm) : WGM;
        u.pm = fm + ((wgid % nig) % gsz); u.pn = (wgid % nig) / gsz; u.z = z; return true;
    }
};

template <class Epi>
DEVI void gemm_phase(LAS unsigned char* lds_in, const Gemm g, const Order& S, const Epi& E, int wv) {
    LAS unsigned char* lds = opql(lds_in);
    const int tid = MYTID, wid = __builtin_amdgcn_readfirstlane(tid >> 6), lane = tid & 63, wr = wid >> 2, wc = wid & 3, fr = lane & 15, fq = lane >> 4;
    const int K = g.K, nt = K / BK, lda = g.lda;
    unsigned voffA[2], voffB[2];
#pragma unroll
    for (int i = 0; i < 2; ++i) { int R, C; stage_rc(tid * 16 + i * 8192, R, C); const int Rb = Epi::PERM ? ((R & ~31) + perm32(R & 31)) : R;
        voffA[i] = (unsigned)(R * lda + C) * 2u; voffB[i] = (unsigned)(Rb * K + C) * 2u; }
    const size_t kstep = (size_t)(BK * 2);
    const size_t hstepA = (size_t)HALF * lda * 2, hstepB = (size_t)HALF * K * 2;
    const unsigned ldsw = (unsigned)wid * 1024u;
    const int aoff = lds_byte(wr * 64 + fr, fq * 8), boff = lds_byte(wc * 32 + fr, fq * 8);
#define PG8_SA(b, h) (((b) * 2 + (h)) * HTB)
#define PG8_SB(b, h) ((4 + (b) * 2 + (h)) * HTB)
#define PG8_STAGE(bufoff, gbase, voff) do { _Pragma("unroll") for (int _i = 0; _i < 2; ++_i) \
        __builtin_amdgcn_global_load_lds((const unsigned*)((const char*)(gbase) + (voff)[_i]), (LAS unsigned*)(lds + (bufoff) + ldsw + _i * 8192), 16, 0, 0); } while (0)
#define PG8_LDA(dst, b, h) do { _Pragma("unroll") for (int m = 0; m < 4; ++m) _Pragma("unroll") for (int k = 0; k < 2; ++k) dst[m][k] = *(const LAS bf16x8*)(lds + PG8_SA(b, h) + aoff + m * 2048 + k * 1024); } while (0)
#define PG8_LDB(dst, b, h) do { _Pragma("unroll") for (int n = 0; n < 2; ++n) _Pragma("unroll") for (int k = 0; k < 2; ++k) dst[n][k] = *(const LAS bf16x8*)(lds + PG8_SB(b, h) + boff + n * 2048 + k * 1024); } while (0)
#define PG8_MMA(ai, bj, At, Bt) do { __builtin_amdgcn_s_setprio(1); _Pragma("unroll") for (int m = 0; m < 4; ++m) _Pragma("unroll") for (int n = 0; n < 2; ++n) _Pragma("unroll") for (int k = 0; k < 2; ++k) \
        acc[ai][bj][m][n] = __builtin_amdgcn_mfma_f32_16x16x32_bf16(Bt[n][k], At[m][k], acc[ai][bj][m][n], 0, 0, 0); __builtin_amdgcn_s_setprio(0); } while (0)
#define PG8_WAIT_V(n) asm volatile("s_waitcnt vmcnt(" #n ")" ::: "memory")
#define PG8_WAIT_L(n) asm volatile("s_waitcnt lgkmcnt(" #n ")" ::: "memory")
#define PG8_BAR __builtin_amdgcn_s_barrier()
#define PG8_SCHED __builtin_amdgcn_sched_barrier(0)
#define PG8_PA(u) ((const char*)g.A + ((size_t)((u).z == 0 ? g.zA0 : ((u).z == 1 ? g.zA1 : g.zA2)) + (size_t)(u).pm * BM * lda) * 2)
#define PG8_PB(u) ((const char*)g.Bt + ((size_t)(u).z * g.zB + (size_t)(u).pn * BM * K) * 2)
    Unit cur, nxt; int ui = 0;
    if (!S.next(0, cur)) return;
    f32x4 acc[2][2][4][2];
#pragma unroll
    for (int a = 0; a < 2; ++a)
#pragma unroll
        for (int b = 0; b < 2; ++b)
#pragma unroll
            for (int m = 0; m < 4; ++m)
#pragma unroll
                for (int n = 0; n < 2; ++n) acc[a][b][m][n] = (f32x4){0.f, 0.f, 0.f, 0.f};
    bf16x8 At[4][2], B0[2][2], B1[2][2];
    const char* cA = PG8_PA(cur); const char* cB = PG8_PB(cur);
    PG8_STAGE(PG8_SB(0, 0), cB, voffB); PG8_STAGE(PG8_SA(0, 0), cA, voffA); PG8_STAGE(PG8_SB(0, 1), cB + hstepB, voffB); PG8_STAGE(PG8_SA(0, 1), cA + hstepA, voffA);
    if (wr == 1) PG8_BAR;
    PG8_WAIT_V(4); PG8_BAR;
    PG8_STAGE(PG8_SB(1, 0), cB + kstep, voffB); PG8_STAGE(PG8_SA(1, 0), cA + kstep, voffA); PG8_STAGE(PG8_SB(1, 1), cB + hstepB + kstep, voffB);
    PG8_WAIT_V(6); PG8_BAR;
    for (;;) {
        const bool has_next = S.next(ui + 1, nxt);
        const char* nA = has_next ? PG8_PA(nxt) : cA; const char* nB = has_next ? PG8_PB(nxt) : cB;
        for (int t = 0; t < nt; t += 2) {
            const bool last = (t == nt - 2);
            const char* a1 = cA + (size_t)(t + 1) * kstep;
            const char* a2 = last ? nA : cA + (size_t)(t + 2) * kstep; const char* b2 = last ? nB : cB + (size_t)(t + 2) * kstep;
            const char* a3 = a2 + kstep; const char* b3 = b2 + kstep;
            PG8_LDB(B0, 0, 0); PG8_SCHED; PG8_LDA(At, 0, 0); PG8_STAGE(PG8_SA(1, 1), a1 + hstepA, voffA);
            PG8_WAIT_L(8); PG8_BAR; PG8_WAIT_L(0); PG8_MMA(0, 0, At, B0); PG8_BAR; PG8_SCHED;
            PG8_LDB(B1, 0, 1); PG8_STAGE(PG8_SB(0, 0), b2, voffB);
            PG8_BAR; PG8_WAIT_L(0); PG8_MMA(0, 1, At, B1); PG8_BAR;
            PG8_LDA(At, 0, 1); PG8_STAGE(PG8_SA(0, 0), a2, voffA);
            PG8_BAR; PG8_WAIT_L(0); PG8_MMA(1, 0, At, B0); PG8_BAR; PG8_SCHED;
            PG8_STAGE(PG8_SB(0, 1), b2 + hstepB, voffB);
            PG8_WAIT_V(6); PG8_BAR; PG8_MMA(1, 1, At, B1); PG8_BAR;
            PG8_LDB(B0, 1, 0); PG8_SCHED; PG8_LDA(At, 1, 0); PG8_STAGE(PG8_SA(0, 1), a2 + hstepA, voffA);
            PG8_WAIT_L(8); PG8_BAR; PG8_WAIT_L(0); PG8_MMA(0, 0, At, B0); PG8_BAR; PG8_SCHED;
            PG8_LDB(B1, 1, 1); PG8_STAGE(PG8_SB(1, 0), b3, voffB);
            PG8_BAR; PG8_WAIT_L(0); PG8_MMA(0, 1, At, B1); PG8_BAR;
            PG8_LDA(At, 1, 1); PG8_STAGE(PG8_SA(1, 0), a3, voffA);
            PG8_BAR; PG8_WAIT_L(0); PG8_MMA(1, 0, At, B0); PG8_BAR; PG8_SCHED;
            PG8_STAGE(PG8_SB(1, 1), b3 + hstepB, voffB);
            PG8_WAIT_V(6); PG8_BAR; PG8_MMA(1, 1, At, B1); PG8_BAR;
        }
        E(acc, cur, wr, wc, fr, fq);
        if (!has_next) break;
#pragma unroll
        for (int a = 0; a < 2; ++a)
#pragma unroll
            for (int b = 0; b < 2; ++b)
#pragma unroll
                for (int m = 0; m < 4; ++m)
#pragma unroll
                    for (int n = 0; n < 2; ++n) acc[a][b][m][n] = (f32x4){0.f, 0.f, 0.f, 0.f};
        cur = nxt; cA = nA; cB = nB; ++ui;
    }
    PG8_WAIT_V(0);
    if (wr == 0) PG8_BAR;
    PG8_BAR;
#undef PG8_SA
#undef PG8_SB
#undef PG8_STAGE
#undef PG8_LDA
#undef PG8_LDB
#undef PG8_MMA
#undef PG8_WAIT_V
#undef PG8_WAIT_L
#undef PG8_BAR
#undef PG8_SCHED
#undef PG8_PA
#undef PG8_PB
}

struct EpiF32 {
    static constexpr bool PERM = false;
    float* C; int ldc;
    DEVI void operator()(const f32x4 (&acc)[2][2][4][2], const Unit& u, int wr, int wc, int fr, int fq) const {
        const int row0 = u.pm * BM + wr * 64 + fr, col0 = u.pn * BM + wc * 32 + 4 * fq;
#pragma unroll
        for (int ai = 0; ai < 2; ++ai)
#pragma unroll
            for (int m = 0; m < 4; ++m) { float* rowp = C + (size_t)(row0 + ai * HALF + m * 16) * ldc + col0;
#pragma unroll
                for (int bj = 0; bj < 2; ++bj)
#pragma unroll
                    for (int n = 0; n < 2; ++n) *(f32x4*)(rowp + bj * HALF + n * 16) = acc[ai][bj][m][n]; }
    }
};
struct EpiSwiGLU {
    static constexpr bool PERM = false;
    bf16_t* O; int ldc;
    DEVI void operator()(const f32x4 (&acc)[2][2][4][2], const Unit& u, int wr, int wc, int fr, int fq) const {
        const int row0 = u.pm * BM + wr * 64 + fr, col0 = u.pn * 128 + wc * 32 + 8 * fq;
#pragma unroll
        for (int ai = 0; ai < 2; ++ai)
#pragma unroll
            for (int m = 0; m < 4; ++m) {
                float v[8];
#pragma unroll
                for (int bj = 0; bj < 2; ++bj)
#pragma unroll
                    for (int i = 0; i < 4; ++i) { const float gt = acc[ai][bj][m][0][i], up = acc[ai][bj][m][1][i]; v[bj * 4 + i] = silu(gt) * up; }
                *(u32x4*)(O + (size_t)(row0 + ai * HALF + m * 16) * ldc + col0) = pack8(v);
            }
    }
};
struct EpiInProj {
    static constexpr bool PERM = true;
    bf16_t* O; int ldc;
    DEVI void operator()(const f32x4 (&acc)[2][2][4][2], const Unit& u, int wr, int wc, int fr, int fq) const {
        const int row0 = u.pm * BM + wr * 64 + fr;
#pragma unroll
        for (int bj = 0; bj < 2; ++bj) {
            const int c0 = u.pn * BM + bj * HALF + wc * 32 + 8 * fq;
            int kind = 0;
            if (c0 >= C_MLO && c0 < C_MLG) kind = 1; else if (c0 >= C_LRY && c0 < C_DNQ) kind = 2; else if (c0 >= C_DNZ && c0 < C_DNBA) kind = 3; else if (c0 >= C_GATE) kind = 1;
#define INPROJ_STORE(FN) _Pragma("unroll") for (int ai = 0; ai < 2; ++ai) _Pragma("unroll") for (int m = 0; m < 4; ++m) { float v[8]; \
                _Pragma("unroll") for (int n = 0; n < 2; ++n) _Pragma("unroll") for (int i = 0; i < 4; ++i) { const float x = acc[ai][bj][m][n][i]; v[n * 4 + i] = FN; } \
                *(u32x4*)(O + (size_t)(row0 + ai * HALF + m * 16) * ldc + c0) = pack8(v); }
            if (kind == 0) { INPROJ_STORE(x) } else if (kind == 1) { INPROJ_STORE(sigm(x)) } else if (kind == 2) { INPROJ_STORE(gelu_t(x)) } else { INPROJ_STORE(silu(x)) }
#undef INPROJ_STORE
        }
    }
};
struct EpiBranch {
    static constexpr bool PERM = false;
    const bf16_t* P; float* T; bf16_t* U;
    DEVI void operator()(const f32x4 (&acc)[2][2][4][2], const Unit& u, int wr, int wc, int fr, int fq) const {
        const int row0 = u.pm * BM + wr * 64 + fr, col0 = u.pn * BM + wc * 32 + 4 * fq; const int z = u.z;
#pragma unroll
        for (int ai = 0; ai < 2; ++ai)
#pragma unroll
            for (int m = 0; m < 4; ++m) { const size_t row = (size_t)(row0 + ai * HALF + m * 16);
#pragma unroll
                for (int bj = 0; bj < 2; ++bj)
#pragma unroll
                    for (int n = 0; n < 2; ++n) { const int col = col0 + bj * HALF + n * 16;
                        const u32x2 gr = *(const u32x2*)(P + row * DINP + C_GATE + z * D + col);
                        f32x4 a = acc[ai][bj][m][n];
                        a[0] *= __uint_as_float(gr[0] << 16); a[1] *= __uint_as_float(gr[0] & 0xffff0000u); a[2] *= __uint_as_float(gr[1] << 16); a[3] *= __uint_as_float(gr[1] & 0xffff0000u);
                        float* tp = T + row * D + col;
                        if (z == 0) *(f32x4*)tp = a;
                        else if (z == 1) { f32x4 o = *(f32x4*)tp; *(f32x4*)tp = o + a; }
                        else { f32x4 o = *(f32x4*)tp; o = o + a; u32x2 w; w[0] = pk2(o[0], o[1]); w[1] = pk2(o[2], o[3]); *(u32x2*)(U + row * D + col) = w; }
                    } }
    }
};
}

DEVI int tok_row(bool gdn, int dir, int b, int c, int t) {
    if (c < 4) { int p = c * 64 + t; if (dir) p = 255 - p; return MLAT + b * 256 + p; }
    int p = (c - 4) * 64 + t; if (dir) p = 4095 - p;
    const int s = gdn ? ((p & 63) * 64 + (p >> 6)) : p;
    return b * 4096 + s;
}
DEVI int pos_row(bool gdn, int b, bool isctx, int p) {
    if (isctx) { if (p < 0 || p >= 256) return -1; return MLAT + b * 256 + p; }
    if (p < 0 || p >= 4096) return -1;
    const int s = gdn ? ((p & 63) * 64 + (p >> 6)) : p;
    return b * 4096 + s;
}
DEVI int dir_chunk(int dir, int j) { return dir ? (j < 4 ? 3 - j : 71 - j) : j; }

DEVI int gu_rowmap(int s) {
    const int n = s >= DFF ? 1 : 0, a = s - n * DFF, pn = a >> 7, r = a & 127, wc = r >> 5, fq = (r >> 3) & 3, bj = (r >> 2) & 1, i = r & 3;
    return 256 * pn + 128 * bj + 32 * wc + 16 * n + 4 * fq + i;
}
DEVI void cvt_tile(const float* src, int ldsrc, int Nvalid, int k0, int n0, bf16_t* dst, int lddst, int mode, float* buf, int lane) {
#pragma unroll 4
    for (int it = 0; it < 16; ++it) {
        const int row = it * 4 + (lane >> 4), c4 = (lane & 15) * 4;
        f32x4 v = (f32x4){0.f, 0.f, 0.f, 0.f};
        if (n0 + c4 < Nvalid) v = *(const f32x4*)(src + (size_t)(k0 + row) * ldsrc + n0 + c4);
        float* bp = buf + row * 65 + c4; bp[0] = v[0]; bp[1] = v[1]; bp[2] = v[2]; bp[3] = v[3];
    }
    asm volatile("s_waitcnt lgkmcnt(0)" ::: "memory"); __builtin_amdgcn_wave_barrier();
#pragma unroll 2
    for (int it = 0; it < 8; ++it) {
        const int nc = it * 8 + (lane >> 3), kk = (lane & 7) * 8;
        float f[8];
#pragma unroll
        for (int e = 0; e < 8; ++e) f[e] = buf[(kk + e) * 65 + nc];
        const int drow = mode == 1 ? gu_rowmap(n0 + nc) : (n0 + nc);
        *(u32x4*)(dst + (size_t)drow * lddst + k0 + kk) = pack8(f);
    }
    asm volatile("s_waitcnt lgkmcnt(0)" ::: "memory"); __builtin_amdgcn_wave_barrier();
}
DEVI void convert_phase(const PW& pw0, int l, unsigned char* shm_in, int gwave, int nwaves, int wid, int lane) {
    const PW p{opq64(pw0.ws)};
    unsigned char* shm = opq(shm_in);
    float* buf = (float*)shm + wid * (64 * 65);
    unsigned char* ws = p.ws;
    for (int t = gwave; t < 6880; t += nwaves) {
        int r = t;
        if (r < 2816) { const int f = r / 1408; r -= f * 1408; const int kt = r / 88, ntl = r % 88;
            cvt_tile(pin(7) + ((size_t)(l * 2 + f)) * D * 2 * DFF, 2 * DFF, 2 * DFF, kt * 64, ntl * 64, (bf16_t*)(ws + WS_WGU + f * SZ_WGU), D, 1, buf, lane); continue; }
        r -= 2816;
        if (r < 1408) { const int f = r / 704; r -= f * 704; const int kt = r / 16, ntl = r % 16;
            cvt_tile(pin(8) + ((size_t)(l * 2 + f)) * DFF * D, D, D, kt * 64, ntl * 64, (bf16_t*)(ws + WS_WDN + f * SZ_WDN), DFF, 0, buf, lane); continue; }
        r -= 1408;
        if (r < 1984) { const int kt = r / 124, ntl = r % 124;
            cvt_tile(pin(9) + (size_t)l * D * C_END, C_END, C_END, kt * 64, ntl * 64, (bf16_t*)(ws + WS_WIN), D, 0, buf, lane); continue; }
        r -= 1984;
        if (r < 384) { const int n = r / 128; r -= n * 128; const int kt = r / 16, ntl = r % 16;
            cvt_tile(pin(23) + ((size_t)(l * 3 + n)) * 512 * D, D, D, kt * 64, ntl * 64, (bf16_t*)(ws + WS_WBR) + (size_t)n * D * 512, 512, 0, buf, lane); continue; }
        r -= 384;
        if (r < 256) { const int kt = r / 16, ntl = r % 16;
            cvt_tile(pin(24) + (size_t)l * D * D, D, D, kt * 64, ntl * 64, (bf16_t*)(ws + WS_WOUT), D, 0, buf, lane); continue; }
        r -= 256;
        { const int gate = r >> 4, dn = r & 15;
            cvt_tile(pin(gate ? 16 : 14) + ((size_t)l * 16 + dn) * 4096, 64, 64, 0, 0, (bf16_t*)(ws + WS_WLRU) + (size_t)(gate * 16 + dn) * 4096, 64, 0, buf, lane); }
    }
}

DEVI void mod_phase(const PW& pw0, unsigned char* shm_in, int wv) {
    const PW p{opq64(pw0.ws)};
    unsigned char* shm = opq(shm_in);
    float* sC = (float*)shm;
    float* red = sC + 5 * 1024;
    const int tid = MYTID;
    __syncthreads();
    for (int i = tid; i < 5 * 1024; i += 512) { const int v = i >> 10, k = i & 1023; const float x = v < 4 ? pin(1)[v * 1024 + k] : pin(3)[k]; sC[i] = silu(x); }
    __syncthreads();
    float* MOD = (float*)(p.ws + WS_MOD);
    const int cgp = tid & 15, is = tid >> 4;
    for (int task = blockIdx.x; task < DEPTH * 144; task += gridDim.x) {
        const int l = task / 144, col0 = (task % 144) * 64;
        float acc[5][4];
#pragma unroll
        for (int v = 0; v < 5; ++v)
#pragma unroll
            for (int e = 0; e < 4; ++e) acc[v][e] = 0.f;
        const float* wp = pin(4) + ((size_t)l * 1024 + is * 32) * 9216 + col0 + cgp * 4;
#pragma unroll 8
        for (int r = 0; r < 32; ++r) {
            const f32x4 w = *(const f32x4*)(wp + (size_t)r * 9216);
#pragma unroll
            for (int v = 0; v < 5; ++v) { const float s = sC[v * 1024 + is * 32 + r];
#pragma unroll
                for (int e = 0; e < 4; ++e) acc[v][e] += s * w[e]; }
        }
#pragma unroll
        for (int v = 0; v < 5; ++v)
#pragma unroll
            for (int e = 0; e < 4; ++e) red[tid * 20 + v * 4 + e] = acc[v][e];
        __syncthreads();
        if (tid < 320) { const int v = tid >> 6, c = tid & 63; float s = 0.f;
            for (int k = 0; k < 32; ++k) s += red[(k * 16 + (c >> 2)) * 20 + v * 4 + (c & 3)];
            MOD[((size_t)(l * 5 + v)) * 9216 + col0 + c] = s + pin(5)[(size_t)l * 9216 + col0 + c]; }
        __syncthreads();
    }
}

DEVI void rowwise_phase(const PW& pw0, int mode, int nrows, int l, int kgate, float coef, int gpost_i, int ln, int gpre_i, int kshift, int gwave, int nwaves, int lane) {
    const PW p{opq64(pw0.ws)};
    float* X = (float*)(p.ws + WS_X); const float* Y = (const float*)(p.ws + WS_Y); bf16_t* H = (bf16_t*)(p.ws + WS_H);
    const float* MOD = (const float*)(p.ws + WS_MOD);
    for (int row = gwave; row < nrows; row += nwaves) {
        const int v = row < MLAT ? (row >> 12) : 4;
        f32x4 x[4];
        if (mode == 0) {
            const float* src = row < MLAT ? pin(0) + (size_t)row * D : pin(2) + (size_t)(row - MLAT) * D;
#pragma unroll
            for (int i = 0; i < 4; ++i) x[i] = *(const f32x4*)(src + lane * 4 + 256 * i);
        } else {
            f32x4 y[4]; float ss = 0.f;
#pragma unroll
            for (int i = 0; i < 4; ++i) { y[i] = *(const f32x4*)(Y + (size_t)row * D + lane * 4 + 256 * i); x[i] = *(const f32x4*)(X + (size_t)row * D + lane * 4 + 256 * i); }
#pragma unroll
            for (int i = 0; i < 4; ++i) ss += y[i][0] * y[i][0] + y[i][1] * y[i][1] + y[i][2] * y[i][2] + y[i][3] * y[i][3];
            ss = wsum(ss); const float rs = rsqrtf(ss * (1.f / D) + EPS) * coef;
            const float* gp = pin(6) + ((size_t)l * 6 + gpost_i) * D; const float* gt = MOD + ((size_t)(l * 5 + v) * 9 + kgate) * D;
#pragma unroll
            for (int i = 0; i < 4; ++i) { const f32x4 g = *(const f32x4*)(gp + lane * 4 + 256 * i), m = *(const f32x4*)(gt + lane * 4 + 256 * i);
                x[i] = x[i] + m * (y[i] * rs * g); }
        }
        if (mode == 2) {
#pragma unroll
            for (int i = 0; i < 4; ++i) *(f32x4*)((float*)pin(25) + (size_t)row * D + lane * 4 + 256 * i) = x[i];
            continue;
        }
#pragma unroll
        for (int i = 0; i < 4; ++i) *(f32x4*)(X + (size_t)row * D + lane * 4 + 256 * i) = x[i];
        float ss = 0.f;
#pragma unroll
        for (int i = 0; i < 4; ++i) ss += x[i][0] * x[i][0] + x[i][1] * x[i][1] + x[i][2] * x[i][2] + x[i][3] * x[i][3];
        ss = wsum(ss); const float rs = rsqrtf(ss * (1.f / D) + EPS);
        const float* gp = pin(6) + ((size_t)ln * 6 + gpre_i) * D; const float* sh = MOD + ((size_t)(ln * 5 + v) * 9 + kshift) * D; const float* sc = sh + D;
#pragma unroll
        for (int i = 0; i < 4; ++i) { const f32x4 g = *(const f32x4*)(gp + lane * 4 + 256 * i), a = *(const f32x4*)(sh + lane * 4 + 256 * i), s = *(const f32x4*)(sc + lane * 4 + 256 * i);
            const f32x4 h = x[i] * rs * g * (s + 1.f) + a; u32x2 w; w[0] = pk2(h[0], h[1]); w[1] = pk2(h[2], h[3]);
            *(u32x2*)(H + (size_t)row * D + lane * 4 + 256 * i) = w; }
    }
}

DEVI void gdn_load(const bf16_t* P, const float* convw, int b, int c, int h, int dir, int want, bf16_t* sQ, bf16_t* sK, bf16_t* sKT, bf16_t* sVT, int tid) {
    const bool isctx = c < 4;
#pragma unroll
    for (int r = 0; r < 6; ++r) {
        const int task = tid + 512 * r, seg = r >> 1, rem = task & 1023, t = rem >> 4, cgp = rem & 15;
        if (seg == 0 && !(want & 1)) continue;
        if (seg == 1 && !(want & 6)) continue;
        if (seg == 2 && !(want & 8)) continue;
        int p = (isctx ? c : c - 4) * 64 + t; if (dir) p = (isctx ? 255 : 4095) - p;
        const int ch = seg * 512 + h * 128 + cgp * 8;
        float a[8];
#pragma unroll
        for (int e = 0; e < 8; ++e) a[e] = 0.f;
#pragma unroll
        for (int j = 0; j < 4; ++j) {
            const int row = pos_row(true, b, isctx, p + j - 2);
            if (row >= 0) {
                const u32x4 raw = *(const u32x4*)(P + (size_t)row * DINP + C_DNQ + ch); float x[8]; unpack8(raw, x);
                const f32x4 w0 = *(const f32x4*)(convw + j * 1536 + ch), w1 = *(const f32x4*)(convw + j * 1536 + ch + 4);
                a[0] += w0[0] * x[0]; a[1] += w0[1] * x[1]; a[2] += w0[2] * x[2]; a[3] += w0[3] * x[3];
                a[4] += w1[0] * x[4]; a[5] += w1[1] * x[5]; a[6] += w1[2] * x[6]; a[7] += w1[3] * x[7];
            }
        }
        float ss = 0.f;
#pragma unroll
        for (int e = 0; e < 8; ++e) { a[e] = silu(a[e]); ss += a[e] * a[e]; }
        if (seg < 2) {
            ss += __shfl_xor(ss, 1, 64); ss += __shfl_xor(ss, 2, 64); ss += __shfl_xor(ss, 4, 64); ss += __shfl_xor(ss, 8, 64);
            float inv = rsqrtf(ss + EPS); if (seg == 0) inv *= 0.08838834764831845f;
#pragma unroll
            for (int e = 0; e < 8; ++e) a[e] *= inv;
        }
        if (seg == 0) *(u32x4*)(sQ + t * 136 + cgp * 8) = pack8(a);
        else if (seg == 1) {
            if (want & 2) *(u32x4*)(sK + t * 136 + cgp * 8) = pack8(a);
            if (want & 4) {
#pragma unroll
                for (int e = 0; e < 8; ++e) sKT[(cgp * 8 + e) * 72 + t] = (bf16_t)f2bf(a[e]); }
        } else {
#pragma unroll
            for (int e = 0; e < 8; ++e) sVT[(cgp * 8 + e) * 72 + t] = (bf16_t)f2bf(a[e]);
        }
    }
}
DEVI void gdn_gates(const PW& p, const bf16_t* P, int l, int b, int c, int h, int dir, float* sc, int lane) {
    const int row = tok_row(true, dir, b, c, lane);
    const float bb = bf2f(P[(size_t)row * DINP + C_DNBA + dir * 4 + h]), aa = bf2f(P[(size_t)row * DINP + C_DNBA + 8 + dir * 4 + h]);
    const float beta = sigm(bb);
    const float g = -__expf(pin(20)[l * 8 + dir * 4 + h]) * softplus(aa + pin(21)[l * 8 + dir * 4 + h]);
    float G = g;
#pragma unroll
    for (int o = 1; o < 64; o <<= 1) { const float t = __shfl_up(G, o, 64); if (lane >= o) G += t; }
    const float GT = __shfl(G, 63, 64);
    sc[lane] = G; sc[64 + lane] = beta; sc[128 + lane] = __expf(G); sc[192 + lane] = __expf(GT - G); if (lane == 0) sc[256] = __expf(GT);
}

DEVI void gdn_prep_item(const PW& pw0, int l, int item, unsigned char* shm_in, int wv) {
    const PW p{opq64(pw0.ws)};
    unsigned char* shm = opq(shm_in);
    const int tid = MYTID, wid = __builtin_amdgcn_readfirstlane(tid >> 6), lane = tid & 63, fr = lane & 15, fq = lane >> 4;
    const int c = item % NCH, h = (item / NCH) & 3, b = (item / (NCH * 4)) & 3, dir = item / (NCH * 16);
    const bf16_t* P = (const bf16_t*)(p.ws + WS_P);
    bf16_t* sK = (bf16_t*)shm;
    bf16_t* sKT = (bf16_t*)(shm + 17408);
    bf16_t* sVT = (bf16_t*)(shm + 35840);
    float* sTm = (float*)(shm + 54272);
    bf16_t* sT1 = (bf16_t*)(shm + 71680);
    bf16_t* sT2 = (bf16_t*)(shm + 80896);
    bf16_t* sWT = (bf16_t*)(shm + 90112);
    bf16_t* sUT = (bf16_t*)(shm + 108544);
    float* sc = (float*)(shm + 126976);
    if (wid == 0) gdn_gates(p, P, l, b, c, h, dir, sc, lane);
    gdn_load(P, pin(19) + (size_t)l * 4 * 1536, b, c, h, dir, 2 | 4 | 8, nullptr, sK, sKT, sVT, tid);
    __syncthreads();
#pragma unroll
    for (int ti = 0; ti < 2; ++ti) {
        const int tile = wid * 2 + ti, mt = tile >> 2, nt = tile & 3;
        f32x4 acc = (f32x4){0.f, 0.f, 0.f, 0.f};
#pragma unroll
        for (int kk = 0; kk < 4; ++kk) acc = MFMA16(ldfrag(sK, 136, mt * 16, kk * 32, lane), ldfrag(sK, 136, nt * 16, kk * 32, lane), acc);
        const int s = nt * 16 + fr;
#pragma unroll
        for (int j = 0; j < 4; ++j) { const int t = mt * 16 + fq * 4 + j; sTm[t * 68 + s] = s < t ? sc[64 + t] * acc[j] * __expf(sc[t] - sc[s]) : 0.f; }
    }
    __syncthreads();
    float* tmpY = (float*)sWT;
    if (wid < 4) {
        const int o = wid * 16, c = lane & 15;
        int lz; asm volatile("v_mov_b32 %0, 0" : "=v"(lz));
        const float* tm = sTm + lz;
        float x[16];
#pragma unroll
        for (int t = 0; t < 16; ++t) {
            float v = -sTm[(o + t) * 68 + o + c];
#pragma unroll
            for (int s4 = 0; s4 < (t + 3) / 4; ++s4) {
                const f32x4 a = *(const f32x4*)(tm + (o + t) * 68 + o + s4 * 4);
#pragma unroll
                for (int e = 0; e < 4; ++e) if (s4 * 4 + e < t) v -= a[e] * x[s4 * 4 + e];
            }
            x[t] = v;
        }
        asm volatile("s_waitcnt lgkmcnt(0)" ::: "memory");
        if (lane < 16) {
#pragma unroll
            for (int t = 0; t < 16; ++t) sTm[(o + t) * 68 + o + c] = x[t] + (t == c ? 1.f : 0.f);
        }
    }
    __syncthreads();
    {
        const int blk = tid >> 8, r = (tid >> 4) & 15, c = tid & 15, ib = (blk ? 3 : 1) * 16, jb = ib - 16;
        float y = 0.f;
#pragma unroll
        for (int s2 = 0; s2 < 16; ++s2) y += sTm[(ib + r) * 68 + jb + s2] * sTm[(jb + s2) * 68 + jb + c];
        tmpY[blk * 272 + r * 17 + c] = y;
        __syncthreads();
        float z = 0.f;
#pragma unroll
        for (int s2 = 0; s2 < 16; ++s2) z += sTm[(ib + r) * 68 + ib + s2] * tmpY[blk * 272 + s2 * 17 + c];
        __syncthreads();
        sTm[(ib + r) * 68 + jb + c] = -z;
    }
    __syncthreads();
    {
        float y[2];
#pragma unroll
        for (int u = 0; u < 2; ++u) { const int o = tid + 512 * u, r = o >> 5, c = o & 31; float a = 0.f;
#pragma unroll 8
            for (int s2 = 0; s2 < 32; ++s2) a += sTm[(32 + r) * 68 + s2] * sTm[s2 * 68 + c];
            y[u] = a; }
#pragma unroll
        for (int u = 0; u < 2; ++u) { const int o = tid + 512 * u, r = o >> 5, c = o & 31; tmpY[r * 33 + c] = y[u]; }
        __syncthreads();
#pragma unroll
        for (int u = 0; u < 2; ++u) { const int o = tid + 512 * u, r = o >> 5, c = o & 31; float a = 0.f;
#pragma unroll 8
            for (int s2 = 0; s2 < 32; ++s2) a += sTm[(32 + r) * 68 + 32 + s2] * tmpY[s2 * 33 + c];
            y[u] = a; }
#pragma unroll
        for (int u = 0; u < 2; ++u) { const int o = tid + 512 * u, r = o >> 5, c = o & 31; sTm[(32 + r) * 68 + c] = -y[u]; }
    }
    __syncthreads();
#pragma unroll
    for (int u = 0; u < 8; ++u) {
        const int o = tid + 512 * u, t = o >> 6, s2 = o & 63; const float xv = sTm[t * 68 + s2], bt = sc[64 + s2];
        sT1[t * 72 + s2] = (bf16_t)f2bf(xv * bt * sc[128 + s2]); sT2[t * 72 + s2] = (bf16_t)f2bf(xv * bt);
    }
    __syncthreads();
    bf16_t* GW = (bf16_t*)(p.ws + WS_H) + (size_t)item * 64 * 128;
    bf16_t* GU = (bf16_t*)(p.ws + WS_GU) + (size_t)item * 64 * 128;
    {
        const int tid2 = opaque(tid), lane = tid2 & 63, fr = lane & 15, fq = lane >> 4;
        const int mt = wid;
#pragma unroll
        for (int nt = 0; nt < 4; ++nt) {
            f32x4 aw = (f32x4){0.f, 0.f, 0.f, 0.f}, au = aw;
#pragma unroll
            for (int kk = 0; kk < 2; ++kk) { aw = MFMA16(ldfrag(sKT, 72, mt * 16, kk * 32, lane), ldfrag(sT1, 72, nt * 16, kk * 32, lane), aw);
                au = MFMA16(ldfrag(sVT, 72, mt * 16, kk * 32, lane), ldfrag(sT2, 72, nt * 16, kk * 32, lane), au); }
            const int t = nt * 16 + fr, r0 = mt * 16 + fq * 4; const float dec = sc[192 + t];
            u32x2 w; w[0] = pk2(aw[0], aw[1]); w[1] = pk2(aw[2], aw[3]); *(u32x2*)(GW + t * 128 + r0) = w;
            w[0] = pk2(au[0], au[1]); w[1] = pk2(au[2], au[3]); *(u32x2*)(GU + t * 128 + r0) = w;
#pragma unroll
            for (int j = 0; j < 4; ++j) { sWT[(r0 + j) * 72 + t] = (bf16_t)f2bf(aw[j] * dec); sUT[(r0 + j) * 72 + t] = (bf16_t)f2bf(au[j] * dec); }
        }
    }
    __syncthreads();
    bf16_t* GB = (bf16_t*)(p.ws + WS_GB) + (size_t)item * 128 * 128;
    bf16_t* GN = (bf16_t*)(p.ws + WS_GN) + (size_t)item * 128 * 128;
    {
        const int tid2 = opaque(tid), lane = tid2 & 63, fr = lane & 15, fq = lane >> 4;
        const int mt = wid;
#pragma unroll
        for (int nt = 0; nt < 8; ++nt) {
            f32x4 ab = (f32x4){0.f, 0.f, 0.f, 0.f}, an = ab;
#pragma unroll
            for (int kk = 0; kk < 2; ++kk) { ab = MFMA16(ldfrag(sWT, 72, mt * 16, kk * 32, lane), ldfrag(sKT, 72, nt * 16, kk * 32, lane), ab);
                an = MFMA16(ldfrag(sKT, 72, mt * 16, kk * 32, lane), ldfrag(sUT, 72, nt * 16, kk * 32, lane), an); }
            const int cc = nt * 16 + fr, r0 = mt * 16 + fq * 4;
            u32x2 w; w[0] = pk2(-ab[0], -ab[1]); w[1] = pk2(-ab[2], -ab[3]); *(u32x2*)(GB + cc * 128 + r0) = w;
            w[0] = pk2(an[0], an[1]); w[1] = pk2(an[2], an[3]); *(u32x2*)(GN + cc * 128 + r0) = w;
        }
    }
    if (tid == 0) ((float*)(p.ws + WS_SM + SM_GDEC))[item] = sc[256];
    __syncthreads();
}

DEVI void gdn_seq_unit(const PW& pw0, int unit, unsigned char* shm_in, int wv) {
    const PW p{opq64(pw0.ws)};
    unsigned char* shm = opq(shm_in);
    const int tid = MYTID, wid = __builtin_amdgcn_readfirstlane(tid >> 6), lane = tid & 63, fr = lane & 15, fq = lane >> 4;
    const int chain = unit >> 3, es = unit & 7;
    bf16_t* sS = (bf16_t*)shm;
    const bf16_t* GB = (const bf16_t*)(p.ws + WS_GB) + (size_t)chain * NCH * 16384;
    bf16_t* GN = (bf16_t*)(p.ws + WS_GN) + (size_t)chain * NCH * 16384;
    const float* GDEC = (const float*)(p.ws + WS_SM + SM_GDEC) + chain * NCH;
    f32x4 acc = (f32x4){0.f, 0.f, 0.f, 0.f};
    bf16x8 an[4]; u32x2 nn; float dn;
    const size_t aoff = (size_t)(wid * 16 + fr) * 128 + fq * 8, noff = (size_t)(es * 16 + fr) * 128 + wid * 16 + fq * 4;
#pragma unroll
    for (int kk = 0; kk < 4; ++kk) an[kk] = *(const bf16x8*)(GB + aoff + kk * 32);
    nn = *(const u32x2*)(GN + noff); dn = GDEC[0];
#pragma unroll 1
    for (int c = 0; c < NCH; ++c) {
        bf16x8 a[4]; u32x2 ncur = nn; const float dcur = dn;
#pragma unroll
        for (int kk = 0; kk < 4; ++kk) a[kk] = an[kk];
        u32x2 sw; sw[0] = pk2(acc[0], acc[1]); sw[1] = pk2(acc[2], acc[3]);
        bf16_t* sb = sS + (c & 1) * (16 * 136);
        *(u32x2*)(sb + fr * 136 + wid * 16 + fq * 4) = sw;
        *(u32x2*)(GN + (size_t)c * 16384 + noff) = sw;
        if (c + 1 < NCH) {
#pragma unroll
            for (int kk = 0; kk < 4; ++kk) an[kk] = *(const bf16x8*)(GB + (size_t)(c + 1) * 16384 + aoff + kk * 32);
            nn = *(const u32x2*)(GN + (size_t)(c + 1) * 16384 + noff); dn = GDEC[c + 1];
        }
        __syncthreads();
        acc[0] = dcur * acc[0] + __uint_as_float(ncur[0] << 16); acc[1] = dcur * acc[1] + __uint_as_float(ncur[0] & 0xffff0000u);
        acc[2] = dcur * acc[2] + __uint_as_float(ncur[1] << 16); acc[3] = dcur * acc[3] + __uint_as_float(ncur[1] & 0xffff0000u);
#pragma unroll
        for (int kk = 0; kk < 4; ++kk) acc = MFMA16(a[kk], ldfrag(sb, 136, 0, kk * 32, lane), acc);
    }
    __syncthreads();
}

DEVI void gdn_out_item(const PW& pw0, int l, int item, unsigned char* shm_in, int wv) {
    const PW p{opq64(pw0.ws)};
    unsigned char* shm = opq(shm_in);
    const int tid = MYTID, wid = __builtin_amdgcn_readfirstlane(tid >> 6), lane = tid & 63, fr = lane & 15, fq = lane >> 4;
    const int j = item % NCH, h = (item / NCH) & 3, b = item / (NCH * 4);
    bf16_t* P = (bf16_t*)(p.ws + WS_P);
    bf16_t* sQ = (bf16_t*)shm;
    bf16_t* sK = (bf16_t*)(shm + 17408);
    bf16_t* sST = (bf16_t*)(shm + 34816);
    bf16_t* sW = (bf16_t*)(shm + 69632);
    bf16_t* sVN = (bf16_t*)(shm + 87040);
    bf16_t* sA2 = (bf16_t*)(shm + 105472);
    float* sO = (float*)(shm + 114688);
    float* sc = (float*)(shm + 148480);
#pragma unroll 1
    for (int dir = 0; dir < 2; ++dir) {
        const int c = dir_chunk(dir, j);
        const int it2 = ((dir * 4 + b) * 4 + h) * NCH + c;
        if (wid == 0) gdn_gates(p, P, l, b, c, h, dir, sc, lane);
        gdn_load(P, pin(19) + (size_t)l * 4 * 1536, b, c, h, dir, 1 | 2, sQ, sK, nullptr, nullptr, tid);
        const bf16_t* GS = (const bf16_t*)(p.ws + WS_GN) + (size_t)it2 * 16384;
        const bf16_t* GW = (const bf16_t*)(p.ws + WS_H) + (size_t)it2 * 8192;
        const bf16_t* GU = (const bf16_t*)(p.ws + WS_GU) + (size_t)it2 * 8192;
#pragma unroll
        for (int r = 0; r < 4; ++r) { const int idx = tid + 512 * r, row = idx >> 4, cg8 = (idx & 15) * 8; *(u32x4*)(sST + row * 136 + cg8) = *(const u32x4*)(GS + row * 128 + cg8); }
#pragma unroll
        for (int r = 0; r < 2; ++r) { const int idx = tid + 512 * r, row = idx >> 4, cg8 = (idx & 15) * 8; *(u32x4*)(sW + row * 136 + cg8) = *(const u32x4*)(GW + row * 128 + cg8); }
        __syncthreads();
        {
            const int mt = wid;
#pragma unroll
            for (int nt = 0; nt < 4; ++nt) {
                f32x4 a = (f32x4){0.f, 0.f, 0.f, 0.f};
#pragma unroll
                for (int kk = 0; kk < 4; ++kk) a = MFMA16(ldfrag(sST, 136, mt * 16, kk * 32, lane), ldfrag(sW, 136, nt * 16, kk * 32, lane), a);
                const int t = nt * 16 + fr, e0 = mt * 16 + fq * 4;
                const u32x2 ur = *(const u32x2*)(GU + t * 128 + e0);
                sVN[(e0 + 0) * 72 + t] = (bf16_t)f2bf(__uint_as_float(ur[0] << 16) - a[0]); sVN[(e0 + 1) * 72 + t] = (bf16_t)f2bf(__uint_as_float(ur[0] & 0xffff0000u) - a[1]);
                sVN[(e0 + 2) * 72 + t] = (bf16_t)f2bf(__uint_as_float(ur[1] << 16) - a[2]); sVN[(e0 + 3) * 72 + t] = (bf16_t)f2bf(__uint_as_float(ur[1] & 0xffff0000u) - a[3]);
            }
#pragma unroll
            for (int ti = 0; ti < 2; ++ti) {
                const int tile = wid * 2 + ti, m2 = tile >> 2, n2 = tile & 3;
                f32x4 a = (f32x4){0.f, 0.f, 0.f, 0.f};
#pragma unroll
                for (int kk = 0; kk < 4; ++kk) a = MFMA16(ldfrag(sQ, 136, m2 * 16, kk * 32, lane), ldfrag(sK, 136, n2 * 16, kk * 32, lane), a);
                const int s = n2 * 16 + fr;
#pragma unroll
                for (int jj = 0; jj < 4; ++jj) { const int t = m2 * 16 + fq * 4 + jj; sA2[t * 72 + s] = (bf16_t)f2bf(s <= t ? a[jj] * __expf(sc[t] - sc[s]) : 0.f); }
            }
        }
        __syncthreads();
        {
            const int nt = wid;
#pragma unroll
            for (int mt = 0; mt < 4; ++mt) {
                f32x4 a = (f32x4){0.f, 0.f, 0.f, 0.f};
#pragma unroll
                for (int kk = 0; kk < 4; ++kk) a = MFMA16(ldfrag(sQ, 136, mt * 16, kk * 32, lane), ldfrag(sST, 136, nt * 16, kk * 32, lane), a);
#pragma unroll
                for (int jj = 0; jj < 4; ++jj) a[jj] *= sc[128 + mt * 16 + fq * 4 + jj];
#pragma unroll
                for (int kk = 0; kk < 2; ++kk) a = MFMA16(ldfrag(sA2, 72, mt * 16, kk * 32, lane), ldfrag(sVN, 72, nt * 16, kk * 32, lane), a);
                const int e = nt * 16 + fr;
#pragma unroll
                for (int jj = 0; jj < 4; ++jj) { const int t = mt * 16 + fq * 4 + jj; const int i = dir ? 63 - t : t; if (dir) sO[i * 132 + e] += a[jj]; else sO[i * 132 + e] = a[jj]; }
            }
        }
        __syncthreads();
    }
    {
        const int i = tid >> 3, e0 = (tid & 7) * 16;
        float v[16], ss = 0.f;
#pragma unroll
        for (int e = 0; e < 16; ++e) { v[e] = sO[i * 132 + e0 + e]; ss += v[e] * v[e]; }
        ss += __shfl_xor(ss, 1, 64); ss += __shfl_xor(ss, 2, 64); ss += __shfl_xor(ss, 4, 64);
        const float rs = rsqrtf(ss * (1.f / 128.f) + EPS);
        const int row = tok_row(true, 0, b, j, i);
        bf16_t* zp = P + (size_t)row * DINP + C_DNZ + h * 128 + e0;
        const float* g = pin(22) + l * 128 + e0;
#pragma unroll
        for (int half = 0; half < 2; ++half) {
            float z[8]; unpack8(*(const u32x4*)(zp + half * 8), z); float o[8];
#pragma unroll
            for (int e = 0; e < 8; ++e) o[e] = v[half * 8 + e] * rs * g[half * 8 + e] * z[e];
            *(u32x4*)(zp + half * 8) = pack8(o);
        }
    }
    __syncthreads();
}

DEVI float ml_gates(const PW& p, const bf16_t* P, int l, int b, int c, int h, int dir, float* sc, int lane) {
    const int row = tok_row(false, dir, b, c, lane);
    const float ig = bf2f(P[(size_t)row * DINP + C_MLG + dir * 4 + h]) + pin(10)[l * 16 + dir * 4 + h];
    const float fg = bf2f(P[(size_t)row * DINP + C_MLG + (2 + dir) * 4 + h]) + pin(10)[l * 16 + (2 + dir) * 4 + h];
    float bb = logsig(fg);
#pragma unroll
    for (int o = 1; o < 64; o <<= 1) { const float t = __shfl_up(bb, o, 64); if (lane >= o) bb += t; }
    sc[lane] = bb; sc[64 + lane] = ig;
    return __shfl(bb, 63, 64);
}
DEVI void ml_prep_item(const PW& pw0, int l, int item, unsigned char* shm_in, int wv) {
    const PW p{opq64(pw0.ws)};
    unsigned char* shm = opq(shm_in);
    const int tid = MYTID, wid = __builtin_amdgcn_readfirstlane(tid >> 6), lane = tid & 63, fr = lane & 15, fq = lane >> 4;
    const int c = item % NCH, h = (item / NCH) & 3, b = (item / (NCH * 4)) & 3, dir = item / (NCH * 16);
    const bf16_t* P = (const bf16_t*)(p.ws + WS_P);
    bf16_t* sKT = (bf16_t*)shm;
    bf16_t* sVT = (bf16_t*)(shm + 9216);
    float* sc = (float*)(shm + 27648);
    if (wid == 0) {
        const float bT = ml_gates(p, P, l, b, c, h, dir, sc, lane);
        const float lw = bT - sc[lane] + sc[64 + lane];
        const float Mc = wmax(lw);
        sc[128 + lane] = __expf(lw - Mc);
        if (lane == 0) { float* msc = (float*)(p.ws + WS_SM + SM_MSC) + item * 2; msc[0] = bT; msc[1] = Mc; }
    }
    __syncthreads();
    {
        const int t = tid >> 3, cg8 = (tid & 7) * 8; const int row = tok_row(false, dir, b, c, t);
        float x[8]; unpack8(*(const u32x4*)(P + (size_t)row * DINP + C_MLK + h * 64 + cg8), x);
#pragma unroll
        for (int e = 0; e < 8; ++e) sKT[(cg8 + e) * 72 + t] = (bf16_t)f2bf(x[e]);
    }
#pragma unroll
    for (int r = 0; r < 2; ++r) {
        const int idx = tid + 512 * r, t = idx >> 4, cg8 = (idx & 15) * 8; const int row = tok_row(false, dir, b, c, t);
        float x[8]; unpack8(*(const u32x4*)(P + (size_t)row * DINP + C_MLV + h * 128 + cg8), x); const float w = sc[128 + t];
#pragma unroll
        for (int e = 0; e < 8; ++e) sVT[(cg8 + e) * 72 + t] = (bf16_t)f2bf(x[e] * w);
    }
    __syncthreads();
    float* KV = (float*)(p.ws + WS_Y) + (size_t)item * 8192;
    {
        const int nt = wid;
#pragma unroll
        for (int mt = 0; mt < 4; ++mt) {
            f32x4 a = (f32x4){0.f, 0.f, 0.f, 0.f};
#pragma unroll
            for (int kk = 0; kk < 2; ++kk) a = MFMA16(ldfrag(sKT, 72, mt * 16, kk * 32, lane), ldfrag(sVT, 72, nt * 16, kk * 32, lane), a);
            *(f32x4*)(KV + (nt * 16 + fr) * 64 + mt * 16 + fq * 4) = a;
        }
    }
    if (tid < 64) { float s = 0.f;
        for (int t = 0; t < 64; ++t) s += sc[128 + t] * bf2f(sKT[tid * 72 + t]);
        ((float*)(p.ws + WS_SM + SM_MN))[item * 64 + tid] = s; }
    __syncthreads();
}
DEVI void ml_seq(const PW& pw0, int gtid, int nthreads) {
    const PW p{opq64(pw0.ws)};
    const float* MSC = (const float*)(p.ws + WS_SM + SM_MSC);
    float* MM = (float*)(p.ws + WS_SM + SM_MM);
    for (int g = gtid; g < 32 * 4096 + 32 * 32; g += nthreads) {
        const bool isn = g >= 32 * 4096; const int gg = isn ? g - 32 * 4096 : g;
        const int chain = isn ? gg >> 5 : gg >> 12, e2 = isn ? gg & 31 : gg & 4095;
        float* base = isn ? (float*)(p.ws + WS_SM + SM_MN) + (size_t)chain * NCH * 64 + e2 * 2 : (float*)(p.ws + WS_Y) + (size_t)chain * NCH * 8192 + e2 * 2;
        const int stride = isn ? 64 : 8192;
        float m = 0.f; f32x2 C = (f32x2){0.f, 0.f};
        for (int c0 = 0; c0 < NCH; c0 += 4) {
            f32x2 kv[4]; f32x2 sc[4];
#pragma unroll
            for (int u = 0; u < 4; ++u) { kv[u] = *(const f32x2*)(base + (size_t)(c0 + u) * stride); sc[u] = *(const f32x2*)(MSC + (chain * NCH + c0 + u) * 2); }
#pragma unroll
            for (int u = 0; u < 4; ++u) {
                *(f32x2*)(base + (size_t)(c0 + u) * stride) = C;
                if (!isn && e2 == 0) MM[chain * NCH + c0 + u] = m;
                const float mn = fmaxf(sc[u][0] + m, sc[u][1]);
                const float a = __expf(sc[u][0] + m - mn), s = __expf(sc[u][1] - mn);
                C = C * a + kv[u] * s; m = mn;
            }
        }
    }
}
DEVI void ml_out_item(const PW& pw0, int l, int item, unsigned char* shm_in, int wv) {
    const PW p{opq64(pw0.ws)};
    unsigned char* shm = opq(shm_in);
    const int tid = MYTID, wid = __builtin_amdgcn_readfirstlane(tid >> 6), lane = tid & 63, fr = lane & 15, fq = lane >> 4;
    const int j = item % NCH, h = (item / NCH) & 3, b = item / (NCH * 4);
    bf16_t* P = (bf16_t*)(p.ws + WS_P);
    bf16_t* sQ = (bf16_t*)shm;
    bf16_t* sK = (bf16_t*)(shm + 9216);
    bf16_t* sVT = (bf16_t*)(shm + 18432);
    bf16_t* sCT = (bf16_t*)(shm + 36864);
    bf16_t* sS = (bf16_t*)(shm + 55296);
    float* sO = (float*)(shm + 64512);
    float* sc = (float*)(shm + 98304);
#pragma unroll 1
    for (int dir = 0; dir < 2; ++dir) {
        const int c = dir_chunk(dir, j);
        const int it2 = ((dir * 4 + b) * 4 + h) * NCH + c;
        if (wid == 0) {
            ml_gates(p, P, l, b, c, h, dir, sc, lane);
            const float m = ((const float*)(p.ws + WS_SM + SM_MM))[it2];
            const float bb = sc[lane];
            float pm = sc[64 + lane] - bb;
#pragma unroll
            for (int o = 1; o < 64; o <<= 1) { const float t = __shfl_up(pm, o, 64); if (lane >= o) pm = fmaxf(pm, t); }
            const float mt = bb + fmaxf(m, pm);
            sc[128 + lane] = mt; sc[192 + lane] = __expf(bb + m - mt);
            sc[320 + lane] = ((const float*)(p.ws + WS_SM + SM_MN))[it2 * 64 + lane];
        }
        {
            const int t = tid >> 3, cg8 = (tid & 7) * 8; const int row = tok_row(false, dir, b, c, t);
            float x[8]; unpack8(*(const u32x4*)(P + (size_t)row * DINP + C_MLQ + h * 64 + cg8), x);
#pragma unroll
            for (int e = 0; e < 8; ++e) x[e] *= 0.125f;
            *(u32x4*)(sQ + t * 72 + cg8) = pack8(x);
            *(u32x4*)(sK + t * 72 + cg8) = *(const u32x4*)(P + (size_t)row * DINP + C_MLK + h * 64 + cg8);
        }
#pragma unroll
        for (int r = 0; r < 2; ++r) {
            const int idx = tid + 512 * r, t = idx >> 4, cg8 = (idx & 15) * 8; const int row = tok_row(false, dir, b, c, t);
            float x[8]; unpack8(*(const u32x4*)(P + (size_t)row * DINP + C_MLV + h * 128 + cg8), x);
#pragma unroll
            for (int e = 0; e < 8; ++e) sVT[(cg8 + e) * 72 + t] = (bf16_t)f2bf(x[e]);
        }
        {
            const float* CT = (const float*)(p.ws + WS_Y) + (size_t)it2 * 8192;
#pragma unroll
            for (int r = 0; r < 4; ++r) { const int idx = tid + 512 * r, e = idx >> 4, d4 = (idx & 15) * 4; const f32x4 v = *(const f32x4*)(CT + e * 64 + d4);
                u32x2 w; w[0] = pk2(v[0], v[1]); w[1] = pk2(v[2], v[3]); *(u32x2*)(sCT + e * 72 + d4) = w; }
        }
        __syncthreads();
#pragma unroll
        for (int ti = 0; ti < 2; ++ti) {
            const int tile = wid * 2 + ti, m2 = tile >> 2, n2 = tile & 3;
            f32x4 a = (f32x4){0.f, 0.f, 0.f, 0.f};
#pragma unroll
            for (int kk = 0; kk < 2; ++kk) a = MFMA16(ldfrag(sQ, 72, m2 * 16, kk * 32, lane), ldfrag(sK, 72, n2 * 16, kk * 32, lane), a);
            const int s = n2 * 16 + fr;
#pragma unroll
            for (int jj = 0; jj < 4; ++jj) { const int t = m2 * 16 + fq * 4 + jj;
                sS[t * 72 + s] = (bf16_t)f2bf(s <= t ? a[jj] * __expf(sc[t] - sc[s] + sc[64 + s] - sc[128 + t]) : 0.f); }
        }
        __syncthreads();
        if (tid < 64) {
            float ds = 0.f, qn = 0.f;
            for (int s = 0; s < 64; ++s) { ds += bf2f(sS[tid * 72 + s]); qn += bf2f(sQ[tid * 72 + s]) * sc[320 + s]; }
            const float den = ds + sc[192 + tid] * qn;
            sc[256 + tid] = 1.f / fmaxf(fabsf(den), __expf(-sc[128 + tid]));
        }
        __syncthreads();
        {
            const int nt = wid;
#pragma unroll
            for (int mt = 0; mt < 4; ++mt) {
                f32x4 a = (f32x4){0.f, 0.f, 0.f, 0.f};
#pragma unroll
                for (int kk = 0; kk < 2; ++kk) a = MFMA16(ldfrag(sQ, 72, mt * 16, kk * 32, lane), ldfrag(sCT, 72, nt * 16, kk * 32, lane), a);
#pragma unroll
                for (int jj = 0; jj < 4; ++jj) a[jj] *= sc[192 + mt * 16 + fq * 4 + jj];
#pragma unroll
                for (int kk = 0; kk < 2; ++kk) a = MFMA16(ldfrag(sS, 72, mt * 16, kk * 32, lane), ldfrag(sVT, 72, nt * 16, kk * 32, lane), a);
                const int e = nt * 16 + fr;
#pragma unroll
                for (int jj = 0; jj < 4; ++jj) { const int t = mt * 16 + fq * 4 + jj; const int i = dir ? 63 - t : t; const float hv = a[jj] * sc[256 + t];
                    if (dir) sO[i * 132 + e] += hv; else sO[i * 132 + e] = hv; }
            }
        }
        __syncthreads();
    }
    {
        const int i = tid >> 3, e0 = (tid & 7) * 16;
        float v[16], ss = 0.f;
#pragma unroll
        for (int e = 0; e < 16; ++e) { v[e] = sO[i * 132 + e0 + e]; ss += v[e] * v[e]; }
        ss += __shfl_xor(ss, 1, 64); ss += __shfl_xor(ss, 2, 64); ss += __shfl_xor(ss, 4, 64);
        const float rs = rsqrtf(ss * (1.f / 128.f) + EPS);
        const int row = tok_row(false, 0, b, j, i);
        bf16_t* op = P + (size_t)row * DINP + C_MLO + h * 128 + e0;
        const float* g = pin(11) + l * 512 + h * 128 + e0;
#pragma unroll
        for (int half = 0; half < 2; ++half) {
            float z[8]; unpack8(*(const u32x4*)(op + half * 8), z); float o[8];
#pragma unroll
            for (int e = 0; e < 8; ++e) o[e] = v[half * 8 + e] * rs * g[half * 8 + e] * z[e];
            *(u32x4*)(op + half * 8) = pack8(o);
        }
    }
    __syncthreads();
}

DEVI void lru_item(const PW& pw0, int l, int item, int mode, unsigned char* shm_in, int wv) {
    const PW p{opq64(pw0.ws)};
    unsigned char* shm = opq(shm_in);
    const int tid = MYTID, wid = __builtin_amdgcn_readfirstlane(tid >> 6), lane = tid & 63, fr = lane & 15, fq = lane >> 4;
    const int j = item % NCH, b = item / NCH; const bool isctx = j < 4;
    bf16_t* P = (bf16_t*)(p.ws + WS_P);
    bf16_t* sX = (bf16_t*)shm;
    const int p0 = (isctx ? j : j - 4) * 64;
    const float* cw = pin(12) + (size_t)l * 4 * 512; const float* cb = pin(13) + (size_t)l * 512;
#pragma unroll 1
    for (int r = 0; r < 8; ++r) {
        const int task = tid + 512 * r, i = task >> 6, ch = (task & 63) * 8;
        float a[8];
        { const f32x4 b0 = *(const f32x4*)(cb + ch), b1 = *(const f32x4*)(cb + ch + 4); a[0] = b0[0]; a[1] = b0[1]; a[2] = b0[2]; a[3] = b0[3]; a[4] = b1[0]; a[5] = b1[1]; a[6] = b1[2]; a[7] = b1[3]; }
#pragma unroll
        for (int jj = 0; jj < 4; ++jj) {
            const int row = pos_row(false, b, isctx, p0 + i + jj - 2);
            if (row >= 0) { float x[8]; unpack8(*(const u32x4*)(P + (size_t)row * DINP + C_LRX + ch), x);
                const f32x4 w0 = *(const f32x4*)(cw + jj * 512 + ch), w1 = *(const f32x4*)(cw + jj * 512 + ch + 4);
                a[0] += w0[0] * x[0]; a[1] += w0[1] * x[1]; a[2] += w0[2] * x[2]; a[3] += w0[3] * x[3]; a[4] += w1[0] * x[4]; a[5] += w1[1] * x[5]; a[6] += w1[2] * x[6]; a[7] += w1[3] * x[7]; }
        }
        *(u32x4*)(sX + i * 520 + ch) = pack8(a);
    }
    __syncthreads();
    const int blk = wid;
    const bf16_t* WL = (const bf16_t*)(p.ws + WS_WLRU);
    float* LAGG = (float*)(p.ws + WS_SM + SM_LAGG);
#pragma unroll 1
    for (int n4 = 0; n4 < 4; ++n4) {
        const int ch = blk * 64 + n4 * 16 + fr;
        float hsum[4][4];
#pragma unroll
        for (int mt = 0; mt < 4; ++mt)
#pragma unroll
            for (int jj = 0; jj < 4; ++jj) hsum[mt][jj] = 0.f;
#pragma unroll
        for (int dir = 0; dir < 2; ++dir) {
            const bf16_t* wa = WL + (size_t)(0 * 16 + dir * 8 + blk) * 4096 + (n4 * 16 + fr) * 64 + fq * 8;
            const bf16_t* wx = WL + (size_t)(1 * 16 + dir * 8 + blk) * 4096 + (n4 * 16 + fr) * 64 + fq * 8;
            bf16x8 ba[2], bx[2];
#pragma unroll
            for (int kk = 0; kk < 2; ++kk) { ba[kk] = *(const bf16x8*)(wa + kk * 32); bx[kk] = *(const bf16x8*)(wx + kk * 32); }
            const float bias_a = pin(15)[(size_t)l * 1024 + dir * 512 + ch], bias_x = pin(17)[(size_t)l * 1024 + dir * 512 + ch];
            const float cl = -8.f * softplus(-pin(18)[(size_t)l * 1024 + dir * 512 + ch]);
            float av[4][4], bv[4][4];
#pragma unroll
            for (int mt = 0; mt < 4; ++mt) {
                f32x4 aa = (f32x4){0.f, 0.f, 0.f, 0.f}, ax = aa;
#pragma unroll
                for (int kk = 0; kk < 2; ++kk) { const bf16x8 af = ldfrag(sX, 520, mt * 16, blk * 64 + kk * 32, lane); aa = MFMA16(af, ba[kk], aa); ax = MFMA16(af, bx[kk], ax); }
#pragma unroll
                for (int jj = 0; jj < 4; ++jj) {
                    const int t = mt * 16 + fq * 4 + jj;
                    const float rr = sigm(aa[jj] + bias_a), ii = sigm(ax[jj] + bias_x), la = cl * rr;
                    av[mt][jj] = __expf(la);
                    bv[mt][jj] = sqrtf(fmaxf(-expm1f(2.f * la), 0.f)) * ii * bf2f(sX[t * 520 + ch]);
                }
            }
            const int c = dir_chunk(dir, j);
            const size_t aidx = (((size_t)dir * 4 + b) * NCH + c) * 512 + ch;
            float hin = mode ? LAGG[aidx * 2] : 0.f;
            float Pc = 1.f, Hc = 0.f;
#pragma unroll
            for (int mi = 0; mi < 4; ++mi) {
                const int mt = dir ? 3 - mi : mi;
                float Pl = 1.f, Hl = 0.f;
#pragma unroll
                for (int ji = 0; ji < 4; ++ji) { const int jj = dir ? 3 - ji : ji; Pl = av[mt][jj] * Pl; Hl = av[mt][jj] * Hl + bv[mt][jj]; }
                float Pq[4], Hq[4];
#pragma unroll
                for (int q = 0; q < 4; ++q) { Pq[q] = __shfl(Pl, fr + 16 * q, 64); Hq[q] = __shfl(Hl, fr + 16 * q, 64); }
                if (mode == 0) {
#pragma unroll
                    for (int qi = 0; qi < 4; ++qi) { const int q = dir ? 3 - qi : qi; Hc = Pq[q] * Hc + Hq[q]; Pc = Pq[q] * Pc; }
                } else {
                    float hh = hin;
                    float hme = hin;
#pragma unroll
                    for (int qi = 0; qi < 4; ++qi) { const int q = dir ? 3 - qi : qi; if (q == fq) hme = hh; hh = Pq[q] * hh + Hq[q]; }
                    hin = hh;
#pragma unroll
                    for (int ji = 0; ji < 4; ++ji) { const int jj = dir ? 3 - ji : ji; hme = av[mt][jj] * hme + bv[mt][jj]; hsum[mt][jj] += hme; }
                }
            }
            if (mode == 0 && fq == 0) { LAGG[aidx * 2] = Pc; LAGG[aidx * 2 + 1] = Hc; }
        }
        if (mode == 1) {
#pragma unroll
            for (int mt = 0; mt < 4; ++mt)
#pragma unroll
                for (int jj = 0; jj < 4; ++jj) { const int i = mt * 16 + fq * 4 + jj; const int row = pos_row(false, b, isctx, p0 + i);
                    bf16_t* yp = P + (size_t)row * DINP + C_LRY + ch; *yp = (bf16_t)f2bf(hsum[mt][jj] * bf2f(*yp)); }
        }
    }
    __syncthreads();
}
DEVI void lru_seq(const PW& pw0, int gtid, int nthreads) {
    const PW p{opq64(pw0.ws)};
    float* LAGG = (float*)(p.ws + WS_SM + SM_LAGG);
    for (int g = gtid; g < 4096; g += nthreads) {
        const int ch = g & 511, db = g >> 9;
        float h = 0.f;
        for (int c0 = 0; c0 < NCH; c0 += 4) {
            f32x2 v[4];
#pragma unroll
            for (int u = 0; u < 4; ++u) v[u] = *(const f32x2*)(LAGG + (((size_t)db * NCH + c0 + u) * 512 + ch) * 2);
#pragma unroll
            for (int u = 0; u < 4; ++u) { LAGG[(((size_t)db * NCH + c0 + u) * 512 + ch) * 2] = h; h = v[u][0] * h + v[u][1]; }
        }
    }
}

DEVI void gsync(unsigned* bar, unsigned& epoch, int G, int wv) {
    __syncthreads();
    epoch += 1u;
    if (wv == 0) {
        const int ln = (int)__builtin_amdgcn_mbcnt_hi(~0u, __builtin_amdgcn_mbcnt_lo(~0u, 0u));
        if (ln == 0) {
            __builtin_amdgcn_fence(__ATOMIC_RELEASE, "agent");
            __hip_atomic_fetch_add(bar, 1u, __ATOMIC_RELAXED, __HIP_MEMORY_SCOPE_AGENT);
            const unsigned target = epoch * (unsigned)G;
            while (__hip_atomic_load(bar, __ATOMIC_RELAXED, __HIP_MEMORY_SCOPE_AGENT) < target) __builtin_amdgcn_s_sleep(1);
            __builtin_amdgcn_fence(__ATOMIC_ACQUIRE, "agent");
        }
    }
    __syncthreads();
}

__global__ void __launch_bounds__(512) mega(Params p) {
    extern __shared__ __attribute__((aligned(16))) unsigned char shm[];
    cg::grid_group grid = cg::this_grid();
    const int wv = __builtin_amdgcn_readfirstlane(threadIdx.x >> 6);
    const int G = gridDim.x, nwaves = G * 8, nthreads = G * 512;
#define TIDS const int tid = MYTID, wid = tid >> 6, lane = tid & 63, gwave = blockIdx.x * 8 + wid, gtid = blockIdx.x * 512 + tid; (void)gtid; (void)gwave; (void)lane;
    LAS unsigned char* lds = (LAS unsigned char*)shm;
#define WSQ unsigned char* ws = opq64(pw.ws); bf16_t* Hb = (bf16_t*)(ws + WS_H); bf16_t* Pb = (bf16_t*)(ws + WS_P); float* Yb = (float*)(ws + WS_Y); (void)Hb; (void)Pb; (void)Yb;

    const PW pw{p.ws};
    unsigned* bar = (unsigned*)p.ws; unsigned epoch = 0u;
    for (int rep = 0; rep < REP_CVT; ++rep) {
    mod_phase(pw, shm, wv);
    { TIDS convert_phase(pw, 0, shm, gwave, nwaves, wid, lane); }
    }
    grid.sync();
    { TIDS rowwise_phase(pw, 0, MTOT, 0, 0, 0.f, 0, 0, 0, 0, gwave, nwaves, lane); }
    gsync(bar, epoch, G, wv);

#pragma unroll 1
    for (int l = 0; l < DEPTH; ++l) {
        const bool last = l == DEPTH - 1;
#pragma unroll 1
        for (int f = 0; f < 2; ++f) {
            if (f == 1) {
                { WSQ pg8::Gemm g{Hb, (const bf16_t*)(ws + WS_WIN), 68, 31, D, D, 1, 0, 0, 0, 0}; pg8::Order S; S.init(68, 31, 1, G, blockIdx.x);
                  pg8::EpiInProj E{Pb, DINP}; for (int rep = 0; rep < REP_GEMM; ++rep) pg8::gemm_phase(lds, g, S, E, wv); }
                gsync(bar, epoch, G, wv);
#pragma unroll 1
                for (int rep2 = 0; rep2 < REP_PREPSEQ; ++rep2) {
#pragma unroll 1
                for (int rep = 0; rep < REP_PREP; ++rep)
                for (int it = blockIdx.x; it < 2176 + 2176 + 272; it += G) {
                    if (it < 2176) gdn_prep_item(pw, l, it, shm, wv);
                    else if (it < 4352) ml_prep_item(pw, l, it - 2176, shm, wv);
                    else lru_item(pw, l, it - 4352, 0, shm, wv);
                }
                gsync(bar, epoch, G, wv);
                for (int u = blockIdx.x; u < 256; u += G) gdn_seq_unit(pw, u, shm, wv);
                { TIDS ml_seq(pw, gtid, nthreads); }
                { TIDS lru_seq(pw, gtid, nthreads); }
                gsync(bar, epoch, G, wv);
                }
                for (int it = blockIdx.x; it < 1088 + 1088 + 272; it += G) {
                    int ii = it, kind = 0; if (ii >= 1088) { ii -= 1088; kind = 1; if (ii >= 1088) { ii -= 1088; kind = 2; } }
                    const int jj = ii % NCH;
                    if (last && jj < 4) continue;
                    if (kind == 0) gdn_out_item(pw, l, ii, shm, wv); else if (kind == 1) ml_out_item(pw, l, ii, shm, wv); else lru_item(pw, l, ii, 1, shm, wv);
                }
                gsync(bar, epoch, G, wv);
                const int nM = last ? 64 : 68;
                { WSQ pg8::Gemm g{Pb, (const bf16_t*)(ws + WS_WBR), nM, 4, 512, DINP, 3, C_MLO, C_LRY, C_DNZ, D * 512}; pg8::Order S; S.init(nM, 4, 3, G, blockIdx.x);
                  pg8::EpiBranch E{Pb, Yb, Hb}; for (int rep = 0; rep < REP_GEMM; ++rep) pg8::gemm_phase(lds, g, S, E, wv); }
                gsync(bar, epoch, G, wv);
                { WSQ pg8::Gemm g{Hb, (const bf16_t*)(ws + WS_WOUT), nM, 4, D, D, 1, 0, 0, 0, 0}; pg8::Order S; S.init(nM, 4, 1, G, blockIdx.x);
                  pg8::EpiF32 E{Yb, D}; for (int rep = 0; rep < REP_GEMM; ++rep) pg8::gemm_phase(lds, g, S, E, wv); }
                gsync(bar, epoch, G, wv);
                { TIDS rowwise_phase(pw, 1, nM * 256, l, 5, 1.f, 3, l, 4, 6, gwave, nwaves, lane); }
                gsync(bar, epoch, G, wv);
            }
            const int nM = (last && f == 1) ? 64 : 68;
            { WSQ pg8::Gemm g{Hb, (const bf16_t*)(ws + WS_WGU + f * SZ_WGU), nM, 22, D, D, 1, 0, 0, 0, 0}; pg8::Order S; S.init(nM, 22, 1, G, blockIdx.x);
              pg8::EpiSwiGLU E{Pb, DFF}; for (int rep = 0; rep < REP_GEMM; ++rep) pg8::gemm_phase(lds, g, S, E, wv); }
            gsync(bar, epoch, G, wv);
            { WSQ pg8::Gemm g{Pb, (const bf16_t*)(ws + WS_WDN + f * SZ_WDN), nM, 4, DFF, DFF, 1, 0, 0, 0, 0}; pg8::Order S; S.init(nM, 4, 1, G, blockIdx.x);
              pg8::EpiF32 E{Yb, D}; for (int rep = 0; rep < REP_GEMM; ++rep) pg8::gemm_phase(lds, g, S, E, wv); }
            gsync(bar, epoch, G, wv);
            if (f == 0) { TIDS rowwise_phase(pw, 1, nM * 256, l, 2, 0.5f, 1, l, 2, 3, gwave, nwaves, lane); }
            else if (!last) { { TIDS rowwise_phase(pw, 1, nM * 256, l, 8, 0.5f, 5, l + 1, 0, 0, gwave, nwaves, lane); } for (int rep = 0; rep < REP_CVT; ++rep) { TIDS convert_phase(pw, l + 1, shm, gwave, nwaves, wid, lane); } }
            else { TIDS rowwise_phase(pw, 2, MLAT, l, 8, 0.5f, 5, 0, 0, 0, gwave, nwaves, lane); }
            gsync(bar, epoch, G, wv);
        }
    }
}

extern "C" void kernel_launch(void* const* d_in, const int* in_sizes, int n_in, void* d_out, int out_size, void* d_ws, size_t ws_size, hipStream_t stream) {
    static int grid = 0;
    if (grid == 0) {
        if (n_in != 25 || ws_size < WS_END) { fprintf(stderr, "kernel_launch: unexpected n_in %d or ws_size %zu (need %zu)\n", n_in, ws_size, (size_t)WS_END); grid = -1; return; }
        int dev = 0, cus = 0, per_cu = 0;
        hipGetDevice(&dev); hipDeviceGetAttribute(&cus, hipDeviceAttributeMultiprocessorCount, dev);
        if (hipFuncSetAttribute((const void*)mega, hipFuncAttributeMaxDynamicSharedMemorySize, LDS_BYTES) != hipSuccess) { fprintf(stderr, "kernel_launch: hipFuncSetAttribute failed\n"); grid = -1; return; }
        if (hipOccupancyMaxActiveBlocksPerMultiprocessor(&per_cu, (const void*)mega, 512, LDS_BYTES) != hipSuccess || per_cu < 1) { fprintf(stderr, "kernel_launch: occupancy query failed (%d)\n", per_cu); per_cu = 1; }
        (void)hipGetLastError();
        grid = cus * per_cu;
    }
    if (grid < 0) return;
    if (hipMemsetAsync(d_ws, 0, 256, stream) != hipSuccess) { fprintf(stderr, "kernel_launch: memset failed\n"); return; }
    Params p{};
    for (int i = 0; i < 25; ++i) p.in[i] = (const float*)d_in[i];
    p.out = (float*)d_out; p.ws = (unsigned char*)d_ws;
    void* args[] = {&p};
    hipError_t e = hipLaunchCooperativeKernel((const void*)mega, dim3(grid), dim3(512), args, LDS_BYTES, stream);
    if (e != hipSuccess) fprintf(stderr, "cooperative launch failed: %s (grid %d)\n", hipGetErrorString(e), grid);
}
```

```cpp
#include <hip/hip_runtime.h>
#include <hip/hip_cooperative_groups.h>
#include <cstdio>
namespace cg = cooperative_groups;

#define LAS __attribute__((address_space(3)))
#define DEVI __device__ __forceinline__
typedef unsigned short bf16_t;
typedef short bf16x8 __attribute__((ext_vector_type(8)));
typedef float f32x4 __attribute__((ext_vector_type(4)));
typedef float f32x2 __attribute__((ext_vector_type(2)));
typedef unsigned u32x4 __attribute__((ext_vector_type(4)));
typedef unsigned u32x2 __attribute__((ext_vector_type(2)));

constexpr int D = 1024, NBATCH = 4, SEQ = 4096, CTXL = 256, DEPTH = 4, DFF = 2816, DINP = 7936;
constexpr int MLAT = NBATCH * SEQ, MTOT = MLAT + NBATCH * CTXL;
constexpr int NCH = 68;
constexpr int C_MLQ = 0, C_MLK = 256, C_MLV = 512, C_MLO = 1024, C_MLG = 1536, C_LRX = 1552, C_LRY = 2064,
              C_DNQ = 2576, C_DNZ = 4112, C_DNBA = 4624, C_GATE = 4640, C_END = 7712;
constexpr float EPS = 1e-6f;

constexpr size_t SZ_WGU = (size_t)2 * DFF * D * 2, SZ_WDN = (size_t)D * DFF * 2;
constexpr size_t WS_MOD = 4096;
constexpr size_t WS_WGU = 1u << 20;
constexpr size_t WS_WDN = WS_WGU + 2 * SZ_WGU;
constexpr size_t WS_WIN = WS_WDN + 2 * SZ_WDN;
constexpr size_t WS_WBR = WS_WIN + (size_t)DINP * D * 2;
constexpr size_t WS_WOUT = WS_WBR + (size_t)3 * D * 512 * 2;
constexpr size_t WS_WLRU = WS_WOUT + (size_t)D * D * 2;
constexpr size_t WS_X = WS_WLRU + (size_t)32 * 64 * 64 * 2;
constexpr size_t WS_H = WS_X + (size_t)MTOT * D * 4;
constexpr size_t WS_Y = WS_H + (size_t)MTOT * D * 2;
constexpr size_t WS_P = WS_Y + (size_t)MTOT * D * 4;
constexpr size_t WS_GU = WS_P + (size_t)MTOT * DINP * 2;
constexpr size_t WS_GB = WS_GU + (size_t)2176 * 64 * 128 * 2;
constexpr size_t WS_GN = WS_GB + (size_t)2176 * 128 * 128 * 2;
constexpr size_t WS_SM = WS_GN + (size_t)2176 * 128 * 128 * 2;
constexpr size_t SM_GDEC = 0, SM_MN = 16384, SM_MSC = SM_MN + 2176 * 64 * 4, SM_MM = SM_MSC + 2176 * 8, SM_LAGG = SM_MM + 2176 * 4 + 1024;
constexpr size_t WS_END = WS_SM + SM_LAGG + (size_t)2 * 4 * NCH * 512 * 2 * 4 + 4096;
constexpr int LDS_BYTES = 155648;
constexpr int REP_GEMM = 1, REP_PREP = 1, REP_PREPSEQ = 1, REP_CVT = 1, REP_GDNP = 1, REP_MLP = 1, REP_LRU0 = 1;

struct Params { const float* in[25]; float* out; unsigned char* ws; };
struct PW { unsigned char* ws; };

#define CAS __attribute__((address_space(4)))
DEVI const float* pin(int i) { const CAS char* k = (const CAS char*)__builtin_amdgcn_kernarg_segment_ptr(); return *(const float* const volatile CAS*)(k + 8 * i); }
DEVI int opaque(int v) { asm volatile("" : "+v"(v)); return v; }
DEVI unsigned char* opq(unsigned char* p) { unsigned v = (unsigned)(size_t)(LAS unsigned char*)p; asm volatile("" : "+s"(v)); return (unsigned char*)(LAS unsigned char*)(size_t)v; }
DEVI LAS unsigned char* opql(LAS unsigned char* p) { unsigned v = (unsigned)(size_t)p; asm volatile("" : "+s"(v)); return (LAS unsigned char*)(size_t)v; }
DEVI unsigned char* opq64(unsigned char* p) { unsigned long long v = (unsigned long long)p; asm volatile("" : "+s"(v)); return (unsigned char*)v; }
#define MYTID opaque(wv * 64 + (int)__builtin_amdgcn_mbcnt_hi(~0u, __builtin_amdgcn_mbcnt_lo(~0u, 0u)))
DEVI float bf2f(bf16_t v) { return __uint_as_float(((unsigned)v) << 16); }
DEVI unsigned f2bf(float f) { unsigned u = __float_as_uint(f); return (u + 0x7fffu + ((u >> 16) & 1u)) >> 16; }
DEVI unsigned pk2(float lo, float hi) { return f2bf(lo) | (f2bf(hi) << 16); }
DEVI float sigm(float x) { return __builtin_amdgcn_rcpf(1.f + __expf(-x)); }
DEVI float silu(float x) { return x * sigm(x); }
DEVI float softplus(float x) { return x > 20.f ? x : log1pf(__expf(x)); }
DEVI float logsig(float x) { return fminf(x, 0.f) - log1pf(__expf(-fabsf(x))); }
DEVI float gelu_t(float x) { float u = 0.7978845608f * (x + 0.044715f * x * x * x); float e = __expf(2.f * u); return x * (1.f - __builtin_amdgcn_rcpf(e + 1.f)); }
DEVI float wsum(float v) { for (int o = 32; o > 0; o >>= 1) v += __shfl_xor(v, o, 64); return v; }
DEVI float wmax(float v) { for (int o = 32; o > 0; o >>= 1) v = fmaxf(v, __shfl_xor(v, o, 64)); return v; }
DEVI void unpack8(u32x4 r, float* f) {
    f[0] = __uint_as_float(r[0] << 16); f[1] = __uint_as_float(r[0] & 0xffff0000u); f[2] = __uint_as_float(r[1] << 16); f[3] = __uint_as_float(r[1] & 0xffff0000u);
    f[4] = __uint_as_float(r[2] << 16); f[5] = __uint_as_float(r[2] & 0xffff0000u); f[6] = __uint_as_float(r[3] << 16); f[7] = __uint_as_float(r[3] & 0xffff0000u);
}
DEVI u32x4 pack8(const float* f) { u32x4 r; r[0] = pk2(f[0], f[1]); r[1] = pk2(f[2], f[3]); r[2] = pk2(f[4], f[5]); r[3] = pk2(f[6], f[7]); return r; }
DEVI bf16x8 ldfrag(const bf16_t* base, int ld, int row0, int k0, int lane) { return *(const bf16x8*)(base + (row0 + (lane & 15)) * ld + k0 + (lane >> 4) * 8); }
#define MFMA16(a, b, c) __builtin_amdgcn_mfma_f32_16x16x32_bf16(a, b, c, 0, 0, 0)

namespace pg8 {
constexpr int BM = 256, BK = 64, HALF = 128, HTB = HALF * BK * 2, NXCD = 8, WGM = 8;
DEVI int lds_byte(int r, int c) { const int st = (r >> 4) * 2 + (c >> 5), rr = r & 15, cc = c & 31, ob = rr * 64 + cc * 2; return st * 1024 + (ob ^ (((ob >> 9) & 1) << 5)); }
DEVI void stage_rc(int b, int& R, int& C) { const int st = b / 1024, sb = b % 1024, swz = sb ^ (((sb >> 9) & 1) << 5); R = (st >> 1) * 16 + swz / 64; C = (st & 1) * 32 + (swz % 64) / 2; }
DEVI int perm32(int rho) { const int n = rho >> 4, i = rho & 15; return 8 * (i >> 2) + 4 * n + (i & 3); }
struct Unit { int pm, pn, z; };
struct Gemm { const bf16_t* A; const bf16_t* Bt; int nM, nN, K, lda, nz, zA0, zA1, zA2, zB; };
struct Order {
    int nM, nN, nwg, G, c, nz;
    DEVI void init(int nM_, int nN_, int nz_, int G_, int c_) { nM = nM_; nN = nN_; nwg = nM * nN; G = G_; c = c_; nz = nz_; }
    DEVI bool next(int i, Unit& u) const {
        int ti = i, z = 0; if (nz == 3) { ti = i / 3; z = i - ti * 3; }
        const long L = (long)ti * G + c; if (L >= nwg) return false;
        int wgid = (int)L; { const int q = nwg / NXCD, r = nwg % NXCD, xcd = wgid % NXCD, off = wgid / NXCD; wgid = (xcd < r ? xcd * (q + 1) : r * (q + 1) + (xcd - r) * q) + off; }
        const int nig = WGM * nN, gid = wgid / nig, fm = gid * WGM, gsz = (nM - fm) < WGM ? (nM - fm) : WGM;
        u.pm = fm + ((wgid % nig) % gsz); u.pn = (wgid % nig) / gsz; u.z = z; return true;
    }
};

template <class Epi>
DEVI void gemm_phase(LAS unsigned char* lds_in, const Gemm g, const Order& S, const Epi& E, int wv) {
    LAS unsigned char* lds = opql(lds_in);
    const int tid = MYTID, wid = __builtin_amdgcn_readfirstlane(tid >> 6), lane = tid & 63, wr = wid >> 2, wc = wid & 3, fr = lane & 15, fq = lane >> 4;
    const int K = g.K, nt = K / BK, lda = g.lda;
    unsigned voffA[2], voffB[2];
#pragma unroll
    for (int i = 0; i < 2; ++i) { int R, C; stage_rc(tid * 16 + i * 8192, R, C); const int Rb = Epi::PERM ? ((R & ~31) + perm32(R & 31)) : R;
        voffA[i] = (unsigned)(R * lda + C) * 2u; voffB[i] = (unsigned)(Rb * K + C) * 2u; }
    const size_t kstep = (size_t)(BK * 2);
    const size_t hstepA = (size_t)HALF * lda * 2, hstepB = (size_t)HALF * K * 2;
    const unsigned ldsw = (unsigned)wid * 1024u;
    const int aoff = lds_byte(wr * 64 + fr, fq * 8), boff = lds_byte(wc * 32 + fr, fq * 8);
#define PG8_SA(b, h) (((b) * 2 + (h)) * HTB)
#define PG8_SB(b, h) ((4 + (b) * 2 + (h)) * HTB)
#define PG8_STAGE(bufoff, gbase, voff) do { _Pragma("unroll") for (int _i = 0; _i < 2; ++_i) \
        __builtin_amdgcn_global_load_lds((const unsigned*)((const char*)(gbase) + (voff)[_i]), (LAS unsigned*)(lds + (bufoff) + ldsw + _i * 8192), 16, 0, 0); } while (0)
#define PG8_LDA(dst, b, h) do { _Pragma("unroll") for (int m = 0; m < 4; ++m) _Pragma("unroll") for (int k = 0; k < 2; ++k) dst[m][k] = *(const LAS bf16x8*)(lds + PG8_SA(b, h) + aoff + m * 2048 + k * 1024); } while (0)
#define PG8_LDB(dst, b, h) do { _Pragma("unroll") for (int n = 0; n < 2; ++n) _Pragma("unroll") for (int k = 0; k < 2; ++k) dst[n][k] = *(const LAS bf16x8*)(lds + PG8_SB(b, h) + boff + n * 2048 + k * 1024); } while (0)
#define PG8_MMA(ai, bj, At, Bt) do { __builtin_amdgcn_s_setprio(1); _Pragma("unroll") for (int m = 0; m < 4; ++m) _Pragma("unroll") for (int n = 0; n < 2; ++n) _Pragma("unroll") for (int k = 0; k < 2; ++k) \
        acc[ai][bj][m][n] = __builtin_amdgcn_mfma_f32_16x16x32_bf16(Bt[n][k], At[m][k], acc[ai][bj][m][n], 0, 0, 0); __builtin_amdgcn_s_setprio(0); } while (0)
#define PG8_WAIT_V(n) asm volatile("s_waitcnt vmcnt(" #n ")" ::: "memory")
#define PG8_WAIT_L(n) asm volatile("s_waitcnt lgkmcnt(" #n ")" ::: "memory")
#define PG8_BAR __builtin_amdgcn_s_barrier()
#define PG8_SCHED __builtin_amdgcn_sched_barrier(0)
#define PG8_PA(u) ((const char*)g.A + ((size_t)((u).z == 0 ? g.zA0 : ((u).z == 1 ? g.zA1 : g.zA2)) + (size_t)(u).pm * BM * lda) * 2)
#define PG8_PB(u) ((const char*)g.Bt + ((size_t)(u).z * g.zB + (size_t)(u).pn * BM * K) * 2)
    Unit cur, nxt; int ui = 0;
    if (!S.next(0, cur)) return;
    f32x4 acc[2][2][4][2];
#pragma unroll
    for (int a = 0; a < 2; ++a)
#pragma unroll
        for (int b = 0; b < 2; ++b)
#pragma unroll
            for (int m = 0; m < 4; ++m)
#pragma unroll
                for (int n = 0; n < 2; ++n) acc[a][b][m][n] = (f32x4){0.f, 0.f, 0.f, 0.f};
    bf16x8 At[4][2], B0[2][2], B1[2][2];
    const char* cA = PG8_PA(cur); const char* cB = PG8_PB(cur);
    PG8_STAGE(PG8_SB(0, 0), cB, voffB); PG8_STAGE(PG8_SA(0, 0), cA, voffA); PG8_STAGE(PG8_SB(0, 1), cB + hstepB, voffB); PG8_STAGE(PG8_SA(0, 1), cA + hstepA, voffA);
    if (wr == 1) PG8_BAR;
    PG8_WAIT_V(4); PG8_BAR;
    PG8_STAGE(PG8_SB(1, 0), cB + kstep, voffB); PG8_STAGE(PG8_SA(1, 0), cA + kstep, voffA); PG8_STAGE(PG8_SB(1, 1), cB + hstepB + kstep, voffB);
    PG8_WAIT_V(6); PG8_BAR;
    for (;;) {
        const bool has_next = S.next(ui + 1, nxt);
        const char* nA = has_next ? PG8_PA(nxt) : cA; const char* nB = has_next ? PG8_PB(nxt) : cB;
        for (int t = 0; t < nt; t += 2) {
            const bool last = (t == nt - 2);
            const char* a1 = cA + (size_t)(t + 1) * kstep;
            const char* a2 = last ? nA : cA + (size_t)(t + 2) * kstep; const char* b2 = last ? nB : cB + (size_t)(t + 2) * kstep;
            const char* a3 = a2 + kstep; const char* b3 = b2 + kstep;
            PG8_LDB(B0, 0, 0); PG8_SCHED; PG8_LDA(At, 0, 0); PG8_STAGE(PG8_SA(1, 1), a1 + hstepA, voffA);
            PG8_WAIT_L(8); PG8_BAR; PG8_WAIT_L(0); PG8_MMA(0, 0, At, B0); PG8_BAR; PG8_SCHED;
            PG8_LDB(B1, 0, 1); PG8_STAGE(PG8_SB(0, 0), b2, voffB);
            PG8_BAR; PG8_WAIT_L(0); PG8_MMA(0, 1, At, B1); PG8_BAR;
            PG8_LDA(At, 0, 1); PG8_STAGE(PG8_SA(0, 0), a2, voffA);
            PG8_BAR; PG8_WAIT_L(0); PG8_MMA(1, 0, At, B0); PG8_BAR; PG8_SCHED;
            PG8_STAGE(PG8_SB(0, 1), b2 + hstepB, voffB);
            PG8_WAIT_V(6); PG8_BAR; PG8_MMA(1, 1, At, B1); PG8_BAR;
            PG8_LDB(B0, 1, 0); PG8_SCHED; PG8_LDA(At, 1, 0); PG8_STAGE(PG8_SA(0, 1), a2 + hstepA, voffA);
            PG8_WAIT_L(8); PG8_BAR; PG8_WAIT_L(0); PG8_MMA(0, 0, At, B0); PG8_BAR; PG8_SCHED;
            PG8_LDB(B1, 1, 1); PG8_STAGE(PG8_SB(1, 0), b3, voffB);
            PG8_BAR; PG8_WAIT_L(0); PG8_MMA(0, 1, At, B1); PG8_BAR;
            PG8_LDA(At, 1, 1); PG8_STAGE(PG8_SA(1, 0), a3, voffA);
            PG8_BAR; PG8_WAIT_L(0); PG8_MMA(1, 0, At, B0); PG8_BAR; PG8_SCHED;
            PG8_STAGE(PG8_SB(1, 1), b3 + hstepB, voffB);
            PG8_WAIT_V(6); PG8_BAR; PG8_MMA(1, 1, At, B1); PG8_BAR;
        }
        E(acc, cur, wr, wc, fr, fq);
        if (!has_next) break;
#pragma unroll
        for (int a = 0; a < 2; ++a)
#pragma unroll
            for (int b = 0; b < 2; ++b)
#pragma unroll
                for (int m = 0; m < 4; ++m)
#pragma unroll
                    for (int n = 0; n < 2; ++n) acc[a][b][m][n] = (f32x4){0.f, 0.f, 0.f, 0.f};
        cur = nxt; cA = nA; cB = nB; ++ui;
    }
    PG8_WAIT_V(0);
    if (wr == 0) PG8_BAR;
    PG8_BAR;
#undef PG8_SA
#undef PG8_SB
#undef PG8_STAGE
#undef PG8_LDA
#undef PG8_LDB
#undef PG8_MMA
#undef PG8_WAIT_V
#undef PG8_WAIT_L
#undef PG8_BAR
#undef PG8_SCHED
#undef PG8_PA
#undef PG8_PB
}

struct EpiF32 {
    static constexpr bool PERM = false;
    float* C; int ldc;
    DEVI void operator()(const f32x4 (&acc)[2][2][4][2], const Unit& u, int wr, int wc, int fr, int fq) const {
        const int row0 = u.pm * BM + wr * 64 + fr, col0 = u.pn * BM + wc * 32 + 4 * fq;
#pragma unroll
        for (int ai = 0; ai < 2; ++ai)
#pragma unroll
            for (int m = 0; m < 4; ++m) { float* rowp = C + (size_t)(row0 + ai * HALF + m * 16) * ldc + col0;
#pragma unroll
                for (int bj = 0; bj < 2; ++bj)
#pragma unroll
                    for (int n = 0; n < 2; ++n) *(f32x4*)(rowp + bj * HALF + n * 16) = acc[ai][bj][m][n]; }
    }
};
struct EpiSwiGLU {
    static constexpr bool PERM = false;
    bf16_t* O; int ldc;
    DEVI void operator()(const f32x4 (&acc)[2][2][4][2], const Unit& u, int wr, int wc, int fr, int fq) const {
        const int row0 = u.pm * BM + wr * 64 + fr, col0 = u.pn * 128 + wc * 32 + 8 * fq;
#pragma unroll
        for (int ai = 0; ai < 2; ++ai)
#pragma unroll
            for (int m = 0; m < 4; ++m) {
                float v[8];
#pragma unroll
                for (int bj = 0; bj < 2; ++bj)
#pragma unroll
                    for (int i = 0; i < 4; ++i) { const float gt = acc[ai][bj][m][0][i], up = acc[ai][bj][m][1][i]; v[bj * 4 + i] = silu(gt) * up; }
                *(u32x4*)(O + (size_t)(row0 + ai * HALF + m * 16) * ldc + col0) = pack8(v);
            }
    }
};
struct EpiInProj {
    static constexpr bool PERM = true;
    bf16_t* O; int ldc;
    DEVI void operator()(const f32x4 (&acc)[2][2][4][2], const Unit& u, int wr, int wc, int fr, int fq) const {
        const int row0 = u.pm * BM + wr * 64 + fr;
#pragma unroll
        for (int bj = 0; bj < 2; ++bj) {
            const int c0 = u.pn * BM + bj * HALF + wc * 32 + 8 * fq;
            int kind = 0;
            if (c0 >= C_MLO && c0 < C_MLG) kind = 1; else if (c0 >= C_LRY && c0 < C_DNQ) kind = 2; else if (c0 >= C_DNZ && c0 < C_DNBA) kind = 3; else if (c0 >= C_GATE) kind = 1;
#define INPROJ_STORE(FN) _Pragma("unroll") for (int ai = 0; ai < 2; ++ai) _Pragma("unroll") for (int m = 0; m < 4; ++m) { float v[8]; \
                _Pragma("unroll") for (int n = 0; n < 2; ++n) _Pragma("unroll") for (int i = 0; i < 4; ++i) { const float x = acc[ai][bj][m][n][i]; v[n * 4 + i] = FN; } \
                *(u32x4*)(O + (size_t)(row0 + ai * HALF + m * 16) * ldc + c0) = pack8(v); }
            if (kind == 0) { INPROJ_STORE(x) } else if (kind == 1) { INPROJ_STORE(sigm(x)) } else if (kind == 2) { INPROJ_STORE(gelu_t(x)) } else { INPROJ_STORE(silu(x)) }
#undef INPROJ_STORE
        }
    }
};
struct EpiBranch {
    static constexpr bool PERM = false;
    const bf16_t* P; float* T; bf16_t* U;
    DEVI void operator()(const f32x4 (&acc)[2][2][4][2], const Unit& u, int wr, int wc, int fr, int fq) const {
        const int row0 = u.pm * BM + wr * 64 + fr, col0 = u.pn * BM + wc * 32 + 4 * fq; const int z = u.z;
#pragma unroll
        for (int ai = 0; ai < 2; ++ai)
#pragma unroll
            for (int m = 0; m < 4; ++m) { const size_t row = (size_t)(row0 + ai * HALF + m * 16);
#pragma unroll
                for (int bj = 0; bj < 2; ++bj)
#pragma unroll
                    for (int n = 0; n < 2; ++n) { const int col = col0 + bj * HALF + n * 16;
                        const u32x2 gr = *(const u32x2*)(P + row * DINP + C_GATE + z * D + col);
                        f32x4 a = acc[ai][bj][m][n];
                        a[0] *= __uint_as_float(gr[0] << 16); a[1] *= __uint_as_float(gr[0] & 0xffff0000u); a[2] *= __uint_as_float(gr[1] << 16); a[3] *= __uint_as_float(gr[1] & 0xffff0000u);
                        float* tp = T + row * D + col;
                        if (z == 0) *(f32x4*)tp = a;
                        else if (z == 1) { f32x4 o = *(f32x4*)tp; *(f32x4*)tp = o + a; }
                        else { f32x4 o = *(f32x4*)tp; o = o + a; u32x2 w; w[0] = pk2(o[0], o[1]); w[1] = pk2(o[2], o[3]); *(u32x2*)(U + row * D + col) = w; }
                    } }
    }
};
}

DEVI int tok_row(bool gdn, int dir, int b, int c, int t) {
    if (c < 4) { int p = c * 64 + t; if (dir) p = 255 - p; return MLAT + b * 256 + p; }
    int p = (c - 4) * 64 + t; if (dir) p = 4095 - p;
    const int s = gdn ? ((p & 63) * 64 + (p >> 6)) : p;
    return b * 4096 + s;
}
DEVI int pos_row(bool gdn, int b, bool isctx, int p) {
    if (isctx) { if (p < 0 || p >= 256) return -1; return MLAT + b * 256 + p; }
    if (p < 0 || p >= 4096) return -1;
    const int s = gdn ? ((p & 63) * 64 + (p >> 6)) : p;
    return b * 4096 + s;
}
DEVI int dir_chunk(int dir, int j) { return dir ? (j < 4 ? 3 - j : 71 - j) : j; }

DEVI int gu_rowmap(int s) {
    const int n = s >= DFF ? 1 : 0, a = s - n * DFF, pn = a >> 7, r = a & 127, wc = r >> 5, fq = (r >> 3) & 3, bj = (r >> 2) & 1, i = r & 3;
    return 256 * pn + 128 * bj + 32 * wc + 16 * n + 4 * fq + i;
}
DEVI void cvt_tile(const float* src, int ldsrc, int Nvalid, int k0, int n0, bf16_t* dst, int lddst, int mode, float* buf, int lane) {
#pragma unroll 4
    for (int it = 0; it < 16; ++it) {
        const int row = it * 4 + (lane >> 4), c4 = (lane & 15) * 4;
        f32x4 v = (f32x4){0.f, 0.f, 0.f, 0.f};
        if (n0 + c4 < Nvalid) v = *(const f32x4*)(src + (size_t)(k0 + row) * ldsrc + n0 + c4);
        float* bp = buf + row * 65 + c4; bp[0] = v[0]; bp[1] = v[1]; bp[2] = v[2]; bp[3] = v[3];
    }
    asm volatile("s_waitcnt lgkmcnt(0)" ::: "memory"); __builtin_amdgcn_wave_barrier();
#pragma unroll 2
    for (int it = 0; it < 8; ++it) {
        const int nc = it * 8 + (lane >> 3), kk = (lane & 7) * 8;
        float f[8];
#pragma unroll
        for (int e = 0; e < 8; ++e) f[e] = buf[(kk + e) * 65 + nc];
        const int drow = mode == 1 ? gu_rowmap(n0 + nc) : (n0 + nc);
        *(u32x4*)(dst + (size_t)drow * lddst + k0 + kk) = pack8(f);
    }
    asm volatile("s_waitcnt lgkmcnt(0)" ::: "memory"); __builtin_amdgcn_wave_barrier();
}
DEVI void convert_phase(const PW& pw0, int l, unsigned char* shm_in, int gwave, int nwaves, int wid, int lane) {
    const PW p{opq64(pw0.ws)};
    unsigned char* shm = opq(shm_in);
    float* buf = (float*)shm + wid * (64 * 65);
    unsigned char* ws = p.ws;
    for (int t = gwave; t < 6880; t += nwaves) {
        int r = t;
        if (r < 2816) { const int f = r / 1408; r -= f * 1408; const int kt = r / 88, ntl = r % 88;
            cvt_tile(pin(7) + ((size_t)(l * 2 + f)) * D * 2 * DFF, 2 * DFF, 2 * DFF, kt * 64, ntl * 64, (bf16_t*)(ws + WS_WGU + f * SZ_WGU), D, 1, buf, lane); continue; }
        r -= 2816;
        if (r < 1408) { const int f = r / 704; r -= f * 704; const int kt = r / 16, ntl = r % 16;
            cvt_tile(pin(8) + ((size_t)(l * 2 + f)) * DFF * D, D, D, kt * 64, ntl * 64, (bf16_t*)(ws + WS_WDN + f * SZ_WDN), DFF, 0, buf, lane); continue; }
        r -= 1408;
        if (r < 1984) { const int kt = r / 124, ntl = r % 124;
            cvt_tile(pin(9) + (size_t)l * D * C_END, C_END, C_END, kt * 64, ntl * 64, (bf16_t*)(ws + WS_WIN), D, 0, buf, lane); continue; }
        r -= 1984;
        if (r < 384) { const int n = r / 128; r -= n * 128; const int kt = r / 16, ntl = r % 16;
            cvt_tile(pin(23) + ((size_t)(l * 3 + n)) * 512 * D, D, D, kt * 64, ntl * 64, (bf16_t*)(ws + WS_WBR) + (size_t)n * D * 512, 512, 0, buf, lane); continue; }
        r -= 384;
        if (r < 256) { const int kt = r / 16, ntl = r % 16;
            cvt_tile(pin(24) + (size_t)l * D * D, D, D, kt * 64, ntl * 64, (bf16_t*)(ws + WS_WOUT), D, 0, buf, lane); continue; }
        r -= 256;
        { const int gate = r >> 4, dn = r & 15;
            cvt_tile(pin(gate ? 16 : 14) + ((size_t)l * 16 + dn) * 4096, 64, 64, 0, 0, (bf16_t*)(ws + WS_WLRU) + (size_t)(gate * 16 + dn) * 4096, 64, 0, buf, lane); }
    }
}

DEVI void mod_phase(const PW& pw0, unsigned char* shm_in, int wv) {
    const PW p{opq64(pw0.ws)};
    unsigned char* shm = opq(shm_in);
    float* sC = (float*)shm;
    float* red = sC + 5 * 1024;
    const int tid = MYTID;
    __syncthreads();
    for (int i = tid; i < 5 * 1024; i += 512) { const int v = i >> 10, k = i & 1023; const float x = v < 4 ? pin(1)[v * 1024 + k] : pin(3)[k]; sC[i] = silu(x); }
    __syncthreads();
    float* MOD = (float*)(p.ws + WS_MOD);
    const int cgp = tid & 15, is = tid >> 4;
    for (int task = blockIdx.x; task < DEPTH * 144; task += gridDim.x) {
        const int l = task / 144, col0 = (task % 144) * 64;
        float acc[5][4];
#pragma unroll
        for (int v = 0; v < 5; ++v)
#pragma unroll
            for (int e = 0; e < 4; ++e) acc[v][e] = 0.f;
        const float* wp = pin(4) + ((size_t)l * 1024 + is * 32) * 9216 + col0 + cgp * 4;
#pragma unroll 8
        for (int r = 0; r < 32; ++r) {
            const f32x4 w = *(const f32x4*)(wp + (size_t)r * 9216);
#pragma unroll
            for (int v = 0; v < 5; ++v) { const float s = sC[v * 1024 + is * 32 + r];
#pragma unroll
                for (int e = 0; e < 4; ++e) acc[v][e] += s * w[e]; }
        }
#pragma unroll
        for (int v = 0; v < 5; ++v)
#pragma unroll
            for (int e = 0; e < 4; ++e) red[tid * 20 + v * 4 + e] = acc[v][e];
        __syncthreads();
        if (tid < 320) { const int v = tid >> 6, c = tid & 63; float s = 0.f;
            for (int k = 0; k < 32; ++k) s += red[(k * 16 + (c >> 2)) * 20 + v * 4 + (c & 3)];
            MOD[((size_t)(l * 5 + v)) * 9216 + col0 + c] = s + pin(5)[(size_t)l * 9216 + col0 + c]; }
        __syncthreads();
    }
}

DEVI void rowwise_phase(const PW& pw0, int mode, int nrows, int l, int kgate, float coef, int gpost_i, int ln, int gpre_i, int kshift, int gwave, int nwaves, int lane) {
    const PW p{opq64(pw0.ws)};
    float* X = (float*)(p.ws + WS_X); const float* Y = (const float*)(p.ws + WS_Y); bf16_t* H = (bf16_t*)(p.ws + WS_H);
    const float* MOD = (const float*)(p.ws + WS_MOD);
    for (int row = gwave; row < nrows; row += nwaves) {
        const int v = row < MLAT ? (row >> 12) : 4;
        f32x4 x[4];
        if (mode == 0) {
            const float* src = row < MLAT ? pin(0) + (size_t)row * D : pin(2) + (size_t)(row - MLAT) * D;
#pragma unroll
            for (int i = 0; i < 4; ++i) x[i] = *(const f32x4*)(src + lane * 4 + 256 * i);
        } else {
            f32x4 y[4]; float ss = 0.f;
#pragma unroll
            for (int i = 0; i < 4; ++i) { y[i] = *(const f32x4*)(Y + (size_t)row * D + lane * 4 + 256 * i); x[i] = *(const f32x4*)(X + (size_t)row * D + lane * 4 + 256 * i); }
#pragma unroll
            for (int i = 0; i < 4; ++i) ss += y[i][0] * y[i][0] + y[i][1] * y[i][1] + y[i][2] * y[i][2] + y[i][3] * y[i][3];
            ss = wsum(ss); const float rs = rsqrtf(ss * (1.f / D) + EPS) * coef;
            const float* gp = pin(6) + ((size_t)l * 6 + gpost_i) * D; const float* gt = MOD + ((size_t)(l * 5 + v) * 9 + kgate) * D;
#pragma unroll
            for (int i = 0; i < 4; ++i) { const f32x4 g = *(const f32x4*)(gp + lane * 4 + 256 * i), m = *(const f32x4*)(gt + lane * 4 + 256 * i);
                x[i] = x[i] + m * (y[i] * rs * g); }
        }
        if (mode == 2) {
#pragma unroll
            for (int i = 0; i < 4; ++i) *(f32x4*)((float*)pin(25) + (size_t)row * D + lane * 4 + 256 * i) = x[i];
            continue;
        }
#pragma unroll
        for (int i = 0; i < 4; ++i) *(f32x4*)(X + (size_t)row * D + lane * 4 + 256 * i) = x[i];
        float ss = 0.f;
#pragma unroll
        for (int i = 0; i < 4; ++i) ss += x[i][0] * x[i][0] + x[i][1] * x[i][1] + x[i][2] * x[i][2] + x[i][3] * x[i][3];
        ss = wsum(ss); const float rs = rsqrtf(ss * (1.f / D) + EPS);
        const float* gp = pin(6) + ((size_t)ln * 6 + gpre_i) * D; const float* sh = MOD + ((size_t)(ln * 5 + v) * 9 + kshift) * D; const float* sc = sh + D;
#pragma unroll
        for (int i = 0; i < 4; ++i) { const f32x4 g = *(const f32x4*)(gp + lane * 4 + 256 * i), a = *(const f32x4*)(sh + lane * 4 + 256 * i), s = *(const f32x4*)(sc + lane * 4 + 256 * i);
            const f32x4 h = x[i] * rs * g * (s + 1.f) + a; u32x2 w; w[0] = pk2(h[0], h[1]); w[1] = pk2(h[2], h[3]);
            *(u32x2*)(H + (size_t)row * D + lane * 4 + 256 * i) = w; }
    }
}

DEVI void gdn_load(const bf16_t* P, const float* convw, int b, int c, int h, int dir, int want, bf16_t* sQ, bf16_t* sK, bf16_t* sKT, bf16_t* sVT, int tid) {
    const bool isctx = c < 4;
#pragma unroll
    for (int r = 0; r < 6; ++r) {
        const int task = tid + 512 * r, seg = r >> 1, rem = task & 1023, t = rem >> 4, cgp = rem & 15;
        if (seg == 0 && !(want & 1)) continue;
        if (seg == 1 && !(want & 6)) continue;
        if (seg == 2 && !(want & 8)) continue;
        int p = (isctx ? c : c - 4) * 64 + t; if (dir) p = (isctx ? 255 : 4095) - p;
        const int ch = seg * 512 + h * 128 + cgp * 8;
        float a[8];
#pragma unroll
        for (int e = 0; e < 8; ++e) a[e] = 0.f;
#pragma unroll
        for (int j = 0; j < 4; ++j) {
            const int row = pos_row(true, b, isctx, p + j - 2);
            if (row >= 0) {
                const u32x4 raw = *(const u32x4*)(P + (size_t)row * DINP + C_DNQ + ch); float x[8]; unpack8(raw, x);
                const f32x4 w0 = *(const f32x4*)(convw + j * 1536 + ch), w1 = *(const f32x4*)(convw + j * 1536 + ch + 4);
                a[0] += w0[0] * x[0]; a[1] += w0[1] * x[1]; a[2] += w0[2] * x[2]; a[3] += w0[3] * x[3];
                a[4] += w1[0] * x[4]; a[5] += w1[1] * x[5]; a[6] += w1[2] * x[6]; a[7] += w1[3] * x[7];
            }
        }
        float ss = 0.f;
#pragma unroll
        for (int e = 0; e < 8; ++e) { a[e] = silu(a[e]); ss += a[e] * a[e]; }
        if (seg < 2) {
            ss += __shfl_xor(ss, 1, 64); ss += __shfl_xor(ss, 2, 64); ss += __shfl_xor(ss, 4, 64); ss += __shfl_xor(ss, 8, 64);
            float inv = rsqrtf(ss + EPS); if (seg == 0) inv *= 0.08838834764831845f;
#pragma unroll
            for (int e = 0; e < 8; ++e) a[e] *= inv;
        }
        if (seg == 0) *(u32x4*)(sQ + t * 136 + cgp * 8) = pack8(a);
        else if (seg == 1) {
            if (want & 2) *(u32x4*)(sK + t * 136 + cgp * 8) = pack8(a);
            if (want & 4) {
#pragma unroll
                for (int e = 0; e < 8; ++e) sKT[(cgp * 8 + e) * 72 + t] = (bf16_t)f2bf(a[e]); }
        } else {
#pragma unroll
            for (int e = 0; e < 8; ++e) sVT[(cgp * 8 + e) * 72 + t] = (bf16_t)f2bf(a[e]);
        }
    }
}
DEVI void gdn_gates(const PW& p, const bf16_t* P, int l, int b, int c, int h, int dir, float* sc, int lane) {
    const int row = tok_row(true, dir, b, c, lane);
    const float bb = bf2f(P[(size_t)row * DINP + C_DNBA + dir * 4 + h]), aa = bf2f(P[(size_t)row * DINP + C_DNBA + 8 + dir * 4 + h]);
    const float beta = sigm(bb);
    const float g = -__expf(pin(20)[l * 8 + dir * 4 + h]) * softplus(aa + pin(21)[l * 8 + dir * 4 + h]);
    float G = g;
#pragma unroll
    for (int o = 1; o < 64; o <<= 1) { const float t = __shfl_up(G, o, 64); if (lane >= o) G += t; }
    const float GT = __shfl(G, 63, 64);
    sc[lane] = G; sc[64 + lane] = beta; sc[128 + lane] = __expf(G); sc[192 + lane] = __expf(GT - G); if (lane == 0) sc[256] = __expf(GT);
}

DEVI void gdn_prep_item(const PW& pw0, int l, int item, unsigned char* shm_in, int wv) {
    const PW p{opq64(pw0.ws)};
    unsigned char* shm = opq(shm_in);
    const int tid = MYTID, wid = __builtin_amdgcn_readfirstlane(tid >> 6), lane = tid & 63, fr = lane & 15, fq = lane >> 4;
    const int c = item % NCH, h = (item / NCH) & 3, b = (item / (NCH * 4)) & 3, dir = item / (NCH * 16);
    const bf16_t* P = (const bf16_t*)(p.ws + WS_P);
    bf16_t* sK = (bf16_t*)shm;
    bf16_t* sKT = (bf16_t*)(shm + 17408);
    bf16_t* sVT = (bf16_t*)(shm + 35840);
    float* sTm = (float*)(shm + 54272);
    bf16_t* sT1 = (bf16_t*)(shm + 71680);
    bf16_t* sT2 = (bf16_t*)(shm + 80896);
    bf16_t* sWT = (bf16_t*)(shm + 90112);
    bf16_t* sUT = (bf16_t*)(shm + 108544);
    float* sc = (float*)(shm + 126976);
    if (wid == 0) gdn_gates(p, P, l, b, c, h, dir, sc, lane);
    gdn_load(P, pin(19) + (size_t)l * 4 * 1536, b, c, h, dir, 2 | 4 | 8, nullptr, sK, sKT, sVT, tid);
    __syncthreads();
#pragma unroll
    for (int ti = 0; ti < 2; ++ti) {
        const int tile = wid * 2 + ti, mt = tile >> 2, nt = tile & 3;
        f32x4 acc = (f32x4){0.f, 0.f, 0.f, 0.f};
#pragma unroll
        for (int kk = 0; kk < 4; ++kk) acc = MFMA16(ldfrag(sK, 136, mt * 16, kk * 32, lane), ldfrag(sK, 136, nt * 16, kk * 32, lane), acc);
        const int s = nt * 16 + fr;
#pragma unroll
        for (int j = 0; j < 4; ++j) { const int t = mt * 16 + fq * 4 + j; sTm[t * 68 + s] = s < t ? sc[64 + t] * acc[j] * __expf(sc[t] - sc[s]) : 0.f; }
    }
    __syncthreads();
    float* tmpY = (float*)sWT;
    if (wid < 4) {
        const int o = wid * 16, c = lane & 15;
        int lz; asm volatile("v_mov_b32 %0, 0" : "=v"(lz));
        const float* tm = sTm + lz;
        float x[16];
#pragma unroll
        for (int t = 0; t < 16; ++t) {
            float v = -sTm[(o + t) * 68 + o + c];
#pragma unroll
            for (int s4 = 0; s4 < (t + 3) / 4; ++s4) {
                const f32x4 a = *(const f32x4*)(tm + (o + t) * 68 + o + s4 * 4);
#pragma unroll
                for (int e = 0; e < 4; ++e) if (s4 * 4 + e < t) v -= a[e] * x[s4 * 4 + e];
            }
            x[t] = v;
        }
        asm volatile("s_waitcnt lgkmcnt(0)" ::: "memory");
        if (lane < 16) {
#pragma unroll
            for (int t = 0; t < 16; ++t) sTm[(o + t) * 68 + o + c] = x[t] + (t == c ? 1.f : 0.f);
        }
    }
    __syncthreads();
    {
        const int blk = tid >> 8, r = (tid >> 4) & 15, c = tid & 15, ib = (blk ? 3 : 1) * 16, jb = ib - 16;
        float y = 0.f;
#pragma unroll
        for (int s2 = 0; s2 < 16; ++s2) y += sTm[(ib + r) * 68 + jb + s2] * sTm[(jb + s2) * 68 + jb + c];
        tmpY[blk * 272 + r * 17 + c] = y;
        __syncthreads();
        float z = 0.f;
#pragma unroll
        for (int s2 = 0; s2 < 16; ++s2) z += sTm[(ib + r) * 68 + ib + s2] * tmpY[blk * 272 + s2 * 17 + c];
        __syncthreads();
        sTm[(ib + r) * 68 + jb + c] = -z;
    }
    __syncthreads();
    {
        float y[2];
#pragma unroll
        for (int u = 0; u < 2; ++u) { const int o = tid + 512 * u, r = o >> 5, c = o & 31; float a = 0.f;
#pragma unroll 8
            for (int s2 = 0; s2 < 32; ++s2) a += sTm[(32 + r) * 68 + s2] * sTm[s2 * 68 + c];
            y[u] = a; }
#pragma unroll
        for (int u = 0; u < 2; ++u) { const int o = tid + 512 * u, r = o >> 5, c = o & 31; tmpY[r * 33 + c] = y[u]; }
        __syncthreads();
#pragma unroll
        for (int u = 0; u < 2; ++u) { const int o = tid + 512 * u, r = o >> 5, c = o & 31; float a = 0.f;
#pragma unroll 8
            for (int s2 = 0; s2 < 32; ++s2) a += sTm[(32 + r) * 68 + 32 + s2] * tmpY[s2 * 33 + c];
            y[u] = a; }
#pragma unroll
        for (int u = 0; u < 2; ++u) { const int o = tid + 512 * u, r = o >> 5, c = o & 31; sTm[(32 + r) * 68 + c] = -y[u]; }
    }
    __syncthreads();
#pragma unroll
    for (int u = 0; u < 8; ++u) {
        const int o = tid + 512 * u, t = o >> 6, s2 = o & 63; const float xv = sTm[t * 68 + s2], bt = sc[64 + s2];
        sT1[t * 72 + s2] = (bf16_t)f2bf(xv * bt * sc[128 + s2]); sT2[t * 72 + s2] = (bf16_t)f2bf(xv * bt);
    }
    __syncthreads();
    bf16_t* GW = (bf16_t*)(p.ws + WS_H) + (size_t)item * 64 * 128;
    bf16_t* GU = (bf16_t*)(p.ws + WS_GU) + (size_t)item * 64 * 128;
    {
        const int tid2 = opaque(tid), lane = tid2 & 63, fr = lane & 15, fq = lane >> 4;
        const int mt = wid;
#pragma unroll
        for (int nt = 0; nt < 4; ++nt) {
            f32x4 aw = (f32x4){0.f, 0.f, 0.f, 0.f}, au = aw;
#pragma unroll
            for (int kk = 0; kk < 2; ++kk) { aw = MFMA16(ldfrag(sKT, 72, mt * 16, kk * 32, lane), ldfrag(sT1, 72, nt * 16, kk * 32, lane), aw);
                au = MFMA16(ldfrag(sVT, 72, mt * 16, kk * 32, lane), ldfrag(sT2, 72, nt * 16, kk * 32, lane), au); }
            const int t = nt * 16 + fr, r0 = mt * 16 + fq * 4; const float dec = sc[192 + t];
            u32x2 w; w[0] = pk2(aw[0], aw[1]); w[1] = pk2(aw[2], aw[3]); *(u32x2*)(GW + t * 128 + r0) = w;
            w[0] = pk2(au[0], au[1]); w[1] = pk2(au[2], au[3]); *(u32x2*)(GU + t * 128 + r0) = w;
#pragma unroll
            for (int j = 0; j < 4; ++j) { sWT[(r0 + j) * 72 + t] = (bf16_t)f2bf(aw[j] * dec); sUT[(r0 + j) * 72 + t] = (bf16_t)f2bf(au[j] * dec); }
        }
    }
    __syncthreads();
    bf16_t* GB = (bf16_t*)(p.ws + WS_GB) + (size_t)item * 128 * 128;
    bf16_t* GN = (bf16_t*)(p.ws + WS_GN) + (size_t)item * 128 * 128;
    {
        const int tid2 = opaque(tid), lane = tid2 & 63, fr = lane & 15, fq = lane >> 4;
        const int mt = wid;
#pragma unroll
        for (int nt = 0; nt < 8; ++nt) {
            f32x4 ab = (f32x4){0.f, 0.f, 0.f, 0.f}, an = ab;
#pragma unroll
            for (int kk = 0; kk < 2; ++kk) { ab = MFMA16(ldfrag(sWT, 72, mt * 16, kk * 32, lane), ldfrag(sKT, 72, nt * 16, kk * 32, lane), ab);
                an = MFMA16(ldfrag(sKT, 72, mt * 16, kk * 32, lane), ldfrag(sUT, 72, nt * 16, kk * 32, lane), an); }
            const int cc = nt * 16 + fr, r0 = mt * 16 + fq * 4;
            u32x2 w; w[0] = pk2(-ab[0], -ab[1]); w[1] = pk2(-ab[2], -ab[3]); *(u32x2*)(GB + cc * 128 + r0) = w;
            w[0] = pk2(an[0], an[1]); w[1] = pk2(an[2], an[3]); *(u32x2*)(GN + cc * 128 + r0) = w;
        }
    }
    if (tid == 0) ((float*)(p.ws + WS_SM + SM_GDEC))[item] = sc[256];
    __syncthreads();
}

DEVI void gdn_seq_unit(const PW& pw0, int unit, unsigned char* shm_in, int wv) {
    const PW p{opq64(pw0.ws)};
    unsigned char* shm = opq(shm_in);
    const int tid = MYTID, wid = __builtin_amdgcn_readfirstlane(tid >> 6), lane = tid & 63, fr = lane & 15, fq = lane >> 4;
    const int chain = unit >> 3, es = unit & 7;
    bf16_t* sS = (bf16_t*)shm;
    const bf16_t* GB = (const bf16_t*)(p.ws + WS_GB) + (size_t)chain * NCH * 16384;
    bf16_t* GN = (bf16_t*)(p.ws + WS_GN) + (size_t)chain * NCH * 16384;
    const float* GDEC = (const float*)(p.ws + WS_SM + SM_GDEC) + chain * NCH;
    f32x4 acc = (f32x4){0.f, 0.f, 0.f, 0.f};
    constexpr int PF = 4;
    bf16x8 an[PF][4]; u32x2 nn[PF]; float dn[PF];
    const size_t aoff = (size_t)(wid * 16 + fr) * 128 + fq * 8, noff = (size_t)(es * 16 + fr) * 128 + wid * 16 + fq * 4;
#pragma unroll
    for (int u = 0; u < PF; ++u) {
#pragma unroll
        for (int kk = 0; kk < 4; ++kk) an[u][kk] = *(const bf16x8*)(GB + (size_t)u * 16384 + aoff + kk * 32);
        nn[u] = *(const u32x2*)(GN + (size_t)u * 16384 + noff); dn[u] = GDEC[u];
    }
#pragma unroll 1
    for (int c0 = 0; c0 < NCH; c0 += PF) {
#pragma unroll
        for (int u = 0; u < PF; ++u) {
            const int c = c0 + u;
            bf16x8 a[4]; const u32x2 ncur = nn[u]; const float dcur = dn[u];
#pragma unroll
            for (int kk = 0; kk < 4; ++kk) a[kk] = an[u][kk];
            u32x2 sw; sw[0] = pk2(acc[0], acc[1]); sw[1] = pk2(acc[2], acc[3]);
            bf16_t* sb = sS + (c & 1) * (16 * 136);
            *(u32x2*)(sb + fr * 136 + wid * 16 + fq * 4) = sw;
            *(u32x2*)(GN + (size_t)c * 16384 + noff) = sw;
            if (c + PF < NCH) {
#pragma unroll
                for (int kk = 0; kk < 4; ++kk) an[u][kk] = *(const bf16x8*)(GB + (size_t)(c + PF) * 16384 + aoff + kk * 32);
                nn[u] = *(const u32x2*)(GN + (size_t)(c + PF) * 16384 + noff); dn[u] = GDEC[c + PF];
            }
            __syncthreads();
            acc[0] = dcur * acc[0] + __uint_as_float(ncur[0] << 16); acc[1] = dcur * acc[1] + __uint_as_float(ncur[0] & 0xffff0000u);
            acc[2] = dcur * acc[2] + __uint_as_float(ncur[1] << 16); acc[3] = dcur * acc[3] + __uint_as_float(ncur[1] & 0xffff0000u);
#pragma unroll
            for (int kk = 0; kk < 4; ++kk) acc = MFMA16(a[kk], ldfrag(sb, 136, 0, kk * 32, lane), acc);
        }
    }
    __syncthreads();
}

DEVI void gdn_out_item(const PW& pw0, int l, int item, unsigned char* shm_in, int wv) {
    const PW p{opq64(pw0.ws)};
    unsigned char* shm = opq(shm_in);
    const int tid = MYTID, wid = __builtin_amdgcn_readfirstlane(tid >> 6), lane = tid & 63, fr = lane & 15, fq = lane >> 4;
    const int j = item % NCH, h = (item / NCH) & 3, b = item / (NCH * 4);
    bf16_t* P = (bf16_t*)(p.ws + WS_P);
    bf16_t* sQ = (bf16_t*)shm;
    bf16_t* sK = (bf16_t*)(shm + 17408);
    bf16_t* sST = (bf16_t*)(shm + 34816);
    bf16_t* sW = (bf16_t*)(shm + 69632);
    bf16_t* sVN = (bf16_t*)(shm + 87040);
    bf16_t* sA2 = (bf16_t*)(shm + 105472);
    float* sO = (float*)(shm + 114688);
    float* sc = (float*)(shm + 148480);
#pragma unroll 1
    for (int dir = 0; dir < 2; ++dir) {
        const int c = dir_chunk(dir, j);
        const int it2 = ((dir * 4 + b) * 4 + h) * NCH + c;
        if (wid == 0) gdn_gates(p, P, l, b, c, h, dir, sc, lane);
        gdn_load(P, pin(19) + (size_t)l * 4 * 1536, b, c, h, dir, 1 | 2, sQ, sK, nullptr, nullptr, tid);
        const bf16_t* GS = (const bf16_t*)(p.ws + WS_GN) + (size_t)it2 * 16384;
        const bf16_t* GW = (const bf16_t*)(p.ws + WS_H) + (size_t)it2 * 8192;
        const bf16_t* GU = (const bf16_t*)(p.ws + WS_GU) + (size_t)it2 * 8192;
#pragma unroll
        for (int r = 0; r < 4; ++r) { const int idx = tid + 512 * r, row = idx >> 4, cg8 = (idx & 15) * 8; *(u32x4*)(sST + row * 136 + cg8) = *(const u32x4*)(GS + row * 128 + cg8); }
#pragma unroll
        for (int r = 0; r < 2; ++r) { const int idx = tid + 512 * r, row = idx >> 4, cg8 = (idx & 15) * 8; *(u32x4*)(sW + row * 136 + cg8) = *(const u32x4*)(GW + row * 128 + cg8); }
        __syncthreads();
        {
            const int mt = wid;
#pragma unroll
            for (int nt = 0; nt < 4; ++nt) {
                f32x4 a = (f32x4){0.f, 0.f, 0.f, 0.f};
#pragma unroll
                for (int kk = 0; kk < 4; ++kk) a = MFMA16(ldfrag(sST, 136, mt * 16, kk * 32, lane), ldfrag(sW, 136, nt * 16, kk * 32, lane), a);
                const int t = nt * 16 + fr, e0 = mt * 16 + fq * 4;
                const u32x2 ur = *(const u32x2*)(GU + t * 128 + e0);
                sVN[(e0 + 0) * 72 + t] = (bf16_t)f2bf(__uint_as_float(ur[0] << 16) - a[0]); sVN[(e0 + 1) * 72 + t] = (bf16_t)f2bf(__uint_as_float(ur[0] & 0xffff0000u) - a[1]);
                sVN[(e0 + 2) * 72 + t] = (bf16_t)f2bf(__uint_as_float(ur[1] << 16) - a[2]); sVN[(e0 + 3) * 72 + t] = (bf16_t)f2bf(__uint_as_float(ur[1] & 0xffff0000u) - a[3]);
            }
#pragma unroll
            for (int ti = 0; ti < 2; ++ti) {
                const int tile = wid * 2 + ti, m2 = tile >> 2, n2 = tile & 3;
                f32x4 a = (f32x4){0.f, 0.f, 0.f, 0.f};
#pragma unroll
                for (int kk = 0; kk < 4; ++kk) a = MFMA16(ldfrag(sQ, 136, m2 * 16, kk * 32, lane), ldfrag(sK, 136, n2 * 16, kk * 32, lane), a);
                const int s = n2 * 16 + fr;
#pragma unroll
                for (int jj = 0; jj < 4; ++jj) { const int t = m2 * 16 + fq * 4 + jj; sA2[t * 72 + s] = (bf16_t)f2bf(s <= t ? a[jj] * __expf(sc[t] - sc[s]) : 0.f); }
            }
        }
        __syncthreads();
        {
            const int nt = wid;
#pragma unroll
            for (int mt = 0; mt < 4; ++mt) {
                f32x4 a = (f32x4){0.f, 0.f, 0.f, 0.f};
#pragma unroll
                for (int kk = 0; kk < 4; ++kk) a = MFMA16(ldfrag(sQ, 136, mt * 16, kk * 32, lane), ldfrag(sST, 136, nt * 16, kk * 32, lane), a);
#pragma unroll
                for (int jj = 0; jj < 4; ++jj) a[jj] *= sc[128 + mt * 16 + fq * 4 + jj];
#pragma unroll
                for (int kk = 0; kk < 2; ++kk) a = MFMA16(ldfrag(sA2, 72, mt * 16, kk * 32, lane), ldfrag(sVN, 72, nt * 16, kk * 32, lane), a);
                const int e = nt * 16 + fr;
#pragma unroll
                for (int jj = 0; jj < 4; ++jj) { const int t = mt * 16 + fq * 4 + jj; const int i = dir ? 63 - t : t; if (dir) sO[i * 132 + e] += a[jj]; else sO[i * 132 + e] = a[jj]; }
            }
        }
        __syncthreads();
    }
    {
        const int i = tid >> 3, e0 = (tid & 7) * 16;
        float v[16], ss = 0.f;
#pragma unroll
        for (int e = 0; e < 16; ++e) { v[e] = sO[i * 132 + e0 + e]; ss += v[e] * v[e]; }
        ss += __shfl_xor(ss, 1, 64); ss += __shfl_xor(ss, 2, 64); ss += __shfl_xor(ss, 4, 64);
        const float rs = rsqrtf(ss * (1.f / 128.f) + EPS);
        const int row = tok_row(true, 0, b, j, i);
        bf16_t* zp = P + (size_t)row * DINP + C_DNZ + h * 128 + e0;
        const float* g = pin(22) + l * 128 + e0;
#pragma unroll
        for (int half = 0; half < 2; ++half) {
            float z[8]; unpack8(*(const u32x4*)(zp + half * 8), z); float o[8];
#pragma unroll
            for (int e = 0; e < 8; ++e) o[e] = v[half * 8 + e] * rs * g[half * 8 + e] * z[e];
            *(u32x4*)(zp + half * 8) = pack8(o);
        }
    }
    __syncthreads();
}

DEVI float ml_gates(const PW& p, const bf16_t* P, int l, int b, int c, int h, int dir, float* sc, int lane) {
    const int row = tok_row(false, dir, b, c, lane);
    const float ig = bf2f(P[(size_t)row * DINP + C_MLG + dir * 4 + h]) + pin(10)[l * 16 + dir * 4 + h];
    const float fg = bf2f(P[(size_t)row * DINP + C_MLG + (2 + dir) * 4 + h]) + pin(10)[l * 16 + (2 + dir) * 4 + h];
    float bb = logsig(fg);
#pragma unroll
    for (int o = 1; o < 64; o <<= 1) { const float t = __shfl_up(bb, o, 64); if (lane >= o) bb += t; }
    sc[lane] = bb; sc[64 + lane] = ig;
    return __shfl(bb, 63, 64);
}
DEVI void ml_prep_item(const PW& pw0, int l, int item, unsigned char* shm_in, int wv) {
    const PW p{opq64(pw0.ws)};
    unsigned char* shm = opq(shm_in);
    const int tid = MYTID, wid = __builtin_amdgcn_readfirstlane(tid >> 6), lane = tid & 63, fr = lane & 15, fq = lane >> 4;
    const int c = item % NCH, h = (item / NCH) & 3, b = (item / (NCH * 4)) & 3, dir = item / (NCH * 16);
    const bf16_t* P = (const bf16_t*)(p.ws + WS_P);
    bf16_t* sKT = (bf16_t*)shm;
    bf16_t* sVT = (bf16_t*)(shm + 9216);
    float* sc = (float*)(shm + 27648);
    if (wid == 0) {
        const float bT = ml_gates(p, P, l, b, c, h, dir, sc, lane);
        const float lw = bT - sc[lane] + sc[64 + lane];
        const float Mc = wmax(lw);
        sc[128 + lane] = __expf(lw - Mc);
        if (lane == 0) { float* msc = (float*)(p.ws + WS_SM + SM_MSC) + item * 2; msc[0] = bT; msc[1] = Mc; }
    }
    __syncthreads();
    {
        const int t = tid >> 3, cg8 = (tid & 7) * 8; const int row = tok_row(false, dir, b, c, t);
        float x[8]; unpack8(*(const u32x4*)(P + (size_t)row * DINP + C_MLK + h * 64 + cg8), x);
#pragma unroll
        for (int e = 0; e < 8; ++e) sKT[(cg8 + e) * 72 + t] = (bf16_t)f2bf(x[e]);
    }
#pragma unroll
    for (int r = 0; r < 2; ++r) {
        const int idx = tid + 512 * r, t = idx >> 4, cg8 = (idx & 15) * 8; const int row = tok_row(false, dir, b, c, t);
        float x[8]; unpack8(*(const u32x4*)(P + (size_t)row * DINP + C_MLV + h * 128 + cg8), x); const float w = sc[128 + t];
#pragma unroll
        for (int e = 0; e < 8; ++e) sVT[(cg8 + e) * 72 + t] = (bf16_t)f2bf(x[e] * w);
    }
    __syncthreads();
    float* KV = (float*)(p.ws + WS_Y) + (size_t)item * 8192;
    {
        const int nt = wid;
#pragma unroll
        for (int mt = 0; mt < 4; ++mt) {
            f32x4 a = (f32x4){0.f, 0.f, 0.f, 0.f};
#pragma unroll
            for (int kk = 0; kk < 2; ++kk) a = MFMA16(ldfrag(sKT, 72, mt * 16, kk * 32, lane), ldfrag(sVT, 72, nt * 16, kk * 32, lane), a);
            *(f32x4*)(KV + (nt * 16 + fr) * 64 + mt * 16 + fq * 4) = a;
        }
    }
    if (tid < 64) { float s = 0.f;
        for (int t = 0; t < 64; ++t) s += sc[128 + t] * bf2f(sKT[tid * 72 + t]);
        ((float*)(p.ws + WS_SM + SM_MN))[item * 64 + tid] = s; }
    __syncthreads();
}
DEVI void ml_seq(const PW& pw0, int gtid, int nthreads) {
    const PW p{opq64(pw0.ws)};
    const float* MSC = (const float*)(p.ws + WS_SM + SM_MSC);
    float* MM = (float*)(p.ws + WS_SM + SM_MM);
    for (int g = gtid; g < 32 * 4096 + 32 * 32; g += nthreads) {
        const bool isn = g >= 32 * 4096; const int gg = isn ? g - 32 * 4096 : g;
        const int chain = isn ? gg >> 5 : gg >> 12, e2 = isn ? gg & 31 : gg & 4095;
        float* base = isn ? (float*)(p.ws + WS_SM + SM_MN) + (size_t)chain * NCH * 64 + e2 * 2 : (float*)(p.ws + WS_Y) + (size_t)chain * NCH * 8192 + e2 * 2;
        const int stride = isn ? 64 : 8192;
        float m = 0.f; f32x2 C = (f32x2){0.f, 0.f};
        for (int c0 = 0; c0 < NCH; c0 += 17) {
            f32x2 kv[17]; f32x2 sc[17];
#pragma unroll
            for (int u = 0; u < 17; ++u) { kv[u] = *(const f32x2*)(base + (size_t)(c0 + u) * stride); sc[u] = *(const f32x2*)(MSC + (chain * NCH + c0 + u) * 2); }
#pragma unroll
            for (int u = 0; u < 17; ++u) {
                *(f32x2*)(base + (size_t)(c0 + u) * stride) = C;
                if (!isn && e2 == 0) MM[chain * NCH + c0 + u] = m;
                const float mn = fmaxf(sc[u][0] + m, sc[u][1]);
                const float a = __expf(sc[u][0] + m - mn), s = __expf(sc[u][1] - mn);
                C = C * a + kv[u] * s; m = mn;
            }
        }
    }
}
DEVI void ml_out_item(const PW& pw0, int l, int item, unsigned char* shm_in, int wv) {
    const PW p{opq64(pw0.ws)};
    unsigned char* shm = opq(shm_in);
    const int tid = MYTID, wid = __builtin_amdgcn_readfirstlane(tid >> 6), lane = tid & 63, fr = lane & 15, fq = lane >> 4;
    const int j = item % NCH, h = (item / NCH) & 3, b = item / (NCH * 4);
    bf16_t* P = (bf16_t*)(p.ws + WS_P);
    bf16_t* sQ = (bf16_t*)shm;
    bf16_t* sK = (bf16_t*)(shm + 9216);
    bf16_t* sVT = (bf16_t*)(shm + 18432);
    bf16_t* sCT = (bf16_t*)(shm + 36864);
    bf16_t* sS = (bf16_t*)(shm + 55296);
    float* sO = (float*)(shm + 64512);
    float* sc = (float*)(shm + 98304);
#pragma unroll 1
    for (int dir = 0; dir < 2; ++dir) {
        const int c = dir_chunk(dir, j);
        const int it2 = ((dir * 4 + b) * 4 + h) * NCH + c;
        if (wid == 0) {
            ml_gates(p, P, l, b, c, h, dir, sc, lane);
            const float m = ((const float*)(p.ws + WS_SM + SM_MM))[it2];
            const float bb = sc[lane];
            float pm = sc[64 + lane] - bb;
#pragma unroll
            for (int o = 1; o < 64; o <<= 1) { const float t = __shfl_up(pm, o, 64); if (lane >= o) pm = fmaxf(pm, t); }
            const float mt = bb + fmaxf(m, pm);
            sc[128 + lane] = mt; sc[192 + lane] = __expf(bb + m - mt);
            sc[320 + lane] = ((const float*)(p.ws + WS_SM + SM_MN))[it2 * 64 + lane];
        }
        {
            const int t = tid >> 3, cg8 = (tid & 7) * 8; const int row = tok_row(false, dir, b, c, t);
            float x[8]; unpack8(*(const u32x4*)(P + (size_t)row * DINP + C_MLQ + h * 64 + cg8), x);
#pragma unroll
            for (int e = 0; e < 8; ++e) x[e] *= 0.125f;
            *(u32x4*)(sQ + t * 72 + cg8) = pack8(x);
            *(u32x4*)(sK + t * 72 + cg8) = *(const u32x4*)(P + (size_t)row * DINP + C_MLK + h * 64 + cg8);
        }
#pragma unroll
        for (int r = 0; r < 2; ++r) {
            const int idx = tid + 512 * r, t = idx >> 4, cg8 = (idx & 15) * 8; const int row = tok_row(false, dir, b, c, t);
            float x[8]; unpack8(*(const u32x4*)(P + (size_t)row * DINP + C_MLV + h * 128 + cg8), x);
#pragma unroll
            for (int e = 0; e < 8; ++e) sVT[(cg8 + e) * 72 + t] = (bf16_t)f2bf(x[e]);
        }
        {
            const float* CT = (const float*)(p.ws + WS_Y) + (size_t)it2 * 8192;
#pragma unroll
            for (int r = 0; r < 4; ++r) { const int idx = tid + 512 * r, e = idx >> 4, d4 = (idx & 15) * 4; const f32x4 v = *(const f32x4*)(CT + e * 64 + d4);
                u32x2 w; w[0] = pk2(v[0], v[1]); w[1] = pk2(v[2], v[3]); *(u32x2*)(sCT + e * 72 + d4) = w; }
        }
        __syncthreads();
#pragma unroll
        for (int ti = 0; ti < 2; ++ti) {
            const int tile = wid * 2 + ti, m2 = tile >> 2, n2 = tile & 3;
            f32x4 a = (f32x4){0.f, 0.f, 0.f, 0.f};
#pragma unroll
            for (int kk = 0; kk < 2; ++kk) a = MFMA16(ldfrag(sQ, 72, m2 * 16, kk * 32, lane), ldfrag(sK, 72, n2 * 16, kk * 32, lane), a);
            const int s = n2 * 16 + fr;
#pragma unroll
            for (int jj = 0; jj < 4; ++jj) { const int t = m2 * 16 + fq * 4 + jj;
                sS[t * 72 + s] = (bf16_t)f2bf(s <= t ? a[jj] * __expf(sc[t] - sc[s] + sc[64 + s] - sc[128 + t]) : 0.f); }
        }
        __syncthreads();
        if (tid < 64) {
            float ds = 0.f, qn = 0.f;
            for (int s = 0; s < 64; ++s) { ds += bf2f(sS[tid * 72 + s]); qn += bf2f(sQ[tid * 72 + s]) * sc[320 + s]; }
            const float den = ds + sc[192 + tid] * qn;
            sc[256 + tid] = 1.f / fmaxf(fabsf(den), __expf(-sc[128 + tid]));
        }
        __syncthreads();
        {
            const int nt = wid;
#pragma unroll
            for (int mt = 0; mt < 4; ++mt) {
                f32x4 a = (f32x4){0.f, 0.f, 0.f, 0.f};
#pragma unroll
                for (int kk = 0; kk < 2; ++kk) a = MFMA16(ldfrag(sQ, 72, mt * 16, kk * 32, lane), ldfrag(sCT, 72, nt * 16, kk * 32, lane), a);
#pragma unroll
                for (int jj = 0; jj < 4; ++jj) a[jj] *= sc[192 + mt * 16 + fq * 4 + jj];
#pragma unroll
                for (int kk = 0; kk < 2; ++kk) a = MFMA16(ldfrag(sS, 72, mt * 16, kk * 32, lane), ldfrag(sVT, 72, nt * 16, kk * 32, lane), a);
                const int e = nt * 16 + fr;
#pragma unroll
                for (int jj = 0; jj < 4; ++jj) { const int t = mt * 16 + fq * 4 + jj; const int i = dir ? 63 - t : t; const float hv = a[jj] * sc[256 + t];
                    if (dir) sO[i * 132 + e] += hv; else sO[i * 132 + e] = hv; }
            }
        }
        __syncthreads();
    }
    {
        const int i = tid >> 3, e0 = (tid & 7) * 16;
        float v[16], ss = 0.f;
#pragma unroll
        for (int e = 0; e < 16; ++e) { v[e] = sO[i * 132 + e0 + e]; ss += v[e] * v[e]; }
        ss += __shfl_xor(ss, 1, 64); ss += __shfl_xor(ss, 2, 64); ss += __shfl_xor(ss, 4, 64);
        const float rs = rsqrtf(ss * (1.f / 128.f) + EPS);
        const int row = tok_row(false, 0, b, j, i);
        bf16_t* op = P + (size_t)row * DINP + C_MLO + h * 128 + e0;
        const float* g = pin(11) + l * 512 + h * 128 + e0;
#pragma unroll
        for (int half = 0; half < 2; ++half) {
            float z[8]; unpack8(*(const u32x4*)(op + half * 8), z); float o[8];
#pragma unroll
            for (int e = 0; e < 8; ++e) o[e] = v[half * 8 + e] * rs * g[half * 8 + e] * z[e];
            *(u32x4*)(op + half * 8) = pack8(o);
        }
    }
    __syncthreads();
}

DEVI void lru_item(const PW& pw0, int l, int item, int mode, unsigned char* shm_in, int wv) {
    const PW p{opq64(pw0.ws)};
    unsigned char* shm = opq(shm_in);
    const int tid = MYTID, wid = __builtin_amdgcn_readfirstlane(tid >> 6), lane = tid & 63, fr = lane & 15, fq = lane >> 4;
    const int j = item % NCH, b = item / NCH; const bool isctx = j < 4;
    bf16_t* P = (bf16_t*)(p.ws + WS_P);
    bf16_t* sX = (bf16_t*)shm;
    const int p0 = (isctx ? j : j - 4) * 64;
    const float* cw = pin(12) + (size_t)l * 4 * 512; const float* cb = pin(13) + (size_t)l * 512;
    {
        const int ch = lane * 8, i0 = wid * 8;
        f32x4 w[4][2];
#pragma unroll
        for (int jj = 0; jj < 4; ++jj) { w[jj][0] = *(const f32x4*)(cw + jj * 512 + ch); w[jj][1] = *(const f32x4*)(cw + jj * 512 + ch + 4); }
        const f32x4 b0 = *(const f32x4*)(cb + ch), b1 = *(const f32x4*)(cb + ch + 4);
        u32x4 raw[11];
#pragma unroll
        for (int r = 0; r < 11; ++r) { const int row = pos_row(false, b, isctx, p0 + i0 + r - 2);
            raw[r] = (u32x4){0u, 0u, 0u, 0u}; if (row >= 0) raw[r] = *(const u32x4*)(P + (size_t)row * DINP + C_LRX + ch); }
#pragma unroll
        for (int i = 0; i < 8; ++i) {
            float a[8] = {b0[0], b0[1], b0[2], b0[3], b1[0], b1[1], b1[2], b1[3]};
#pragma unroll
            for (int jj = 0; jj < 4; ++jj) { float x[8]; unpack8(raw[i + jj], x);
#pragma unroll
                for (int e = 0; e < 4; ++e) { a[e] += w[jj][0][e] * x[e]; a[4 + e] += w[jj][1][e] * x[4 + e]; } }
            *(u32x4*)(sX + (i0 + i) * 520 + ch) = pack8(a);
        }
    }
    __syncthreads();
    const int blk = wid;
    const bf16_t* WL = (const bf16_t*)(p.ws + WS_WLRU);
    float* LAGG = (float*)(p.ws + WS_SM + SM_LAGG);
#pragma unroll 1
    for (int n4 = 0; n4 < 4; ++n4) {
        const int ch = blk * 64 + n4 * 16 + fr;
        float hsum[4][4];
#pragma unroll
        for (int mt = 0; mt < 4; ++mt)
#pragma unroll
            for (int jj = 0; jj < 4; ++jj) hsum[mt][jj] = 0.f;
#pragma unroll
        for (int dir = 0; dir < 2; ++dir) {
            const bf16_t* wa = WL + (size_t)(0 * 16 + dir * 8 + blk) * 4096 + (n4 * 16 + fr) * 64 + fq * 8;
            const bf16_t* wx = WL + (size_t)(1 * 16 + dir * 8 + blk) * 4096 + (n4 * 16 + fr) * 64 + fq * 8;
            bf16x8 ba[2], bx[2];
#pragma unroll
            for (int kk = 0; kk < 2; ++kk) { ba[kk] = *(const bf16x8*)(wa + kk * 32); bx[kk] = *(const bf16x8*)(wx + kk * 32); }
            const float bias_a = pin(15)[(size_t)l * 1024 + dir * 512 + ch], bias_x = pin(17)[(size_t)l * 1024 + dir * 512 + ch];
            const float cl = -8.f * softplus(-pin(18)[(size_t)l * 1024 + dir * 512 + ch]);
            float av[4][4], bv[4][4];
#pragma unroll
            for (int mt = 0; mt < 4; ++mt) {
                f32x4 aa = (f32x4){0.f, 0.f, 0.f, 0.f}, ax = aa;
#pragma unroll
                for (int kk = 0; kk < 2; ++kk) { const bf16x8 af = ldfrag(sX, 520, mt * 16, blk * 64 + kk * 32, lane); aa = MFMA16(af, ba[kk], aa); ax = MFMA16(af, bx[kk], ax); }
#pragma unroll
                for (int jj = 0; jj < 4; ++jj) {
                    const int t = mt * 16 + fq * 4 + jj;
                    const float rr = sigm(aa[jj] + bias_a), ii = sigm(ax[jj] + bias_x), la = cl * rr;
                    const float ea = __expf(la);
                    av[mt][jj] = ea;
                    bv[mt][jj] = __builtin_amdgcn_sqrtf(fmaxf(1.f - ea * ea, 0.f)) * ii * bf2f(sX[t * 520 + ch]);
                }
            }
            const int c = dir_chunk(dir, j);
            const size_t aidx = (((size_t)dir * 4 + b) * NCH + c) * 512 + ch;
            float hin = mode ? LAGG[aidx * 2] : 0.f;
            float Pc = 1.f, Hc = 0.f;
#pragma unroll
            for (int mi = 0; mi < 4; ++mi) {
                const int mt = dir ? 3 - mi : mi;
                float Pl = 1.f, Hl = 0.f;
#pragma unroll
                for (int ji = 0; ji < 4; ++ji) { const int jj = dir ? 3 - ji : ji; Pl = av[mt][jj] * Pl; Hl = av[mt][jj] * Hl + bv[mt][jj]; }
                float Pq[4], Hq[4];
#pragma unroll
                for (int q = 0; q < 4; ++q) { Pq[q] = __shfl(Pl, fr + 16 * q, 64); Hq[q] = __shfl(Hl, fr + 16 * q, 64); }
                if (mode == 0) {
#pragma unroll
                    for (int qi = 0; qi < 4; ++qi) { const int q = dir ? 3 - qi : qi; Hc = Pq[q] * Hc + Hq[q]; Pc = Pq[q] * Pc; }
                } else {
                    float hh = hin;
                    float hme = hin;
#pragma unroll
                    for (int qi = 0; qi < 4; ++qi) { const int q = dir ? 3 - qi : qi; if (q == fq) hme = hh; hh = Pq[q] * hh + Hq[q]; }
                    hin = hh;
#pragma unroll
                    for (int ji = 0; ji < 4; ++ji) { const int jj = dir ? 3 - ji : ji; hme = av[mt][jj] * hme + bv[mt][jj]; hsum[mt][jj] += hme; }
                }
            }
            if (mode == 0 && fq == 0) { LAGG[aidx * 2] = Pc; LAGG[aidx * 2 + 1] = Hc; }
        }
        if (mode == 1) {
#pragma unroll
            for (int mt = 0; mt < 4; ++mt)
#pragma unroll
                for (int jj = 0; jj < 4; ++jj) { const int i = mt * 16 + fq * 4 + jj; const int row = pos_row(false, b, isctx, p0 + i);
                    bf16_t* yp = P + (size_t)row * DINP + C_LRY + ch; *yp = (bf16_t)f2bf(hsum[mt][jj] * bf2f(*yp)); }
        }
    }
    __syncthreads();
}
DEVI void lru_seq(const PW& pw0, int gtid, int nthreads) {
    const PW p{opq64(pw0.ws)};
    float* LAGG = (float*)(p.ws + WS_SM + SM_LAGG);
    for (int g = gtid; g < 4096; g += nthreads) {
        const int ch = g & 511, db = g >> 9;
        float h = 0.f;
        for (int c0 = 0; c0 < NCH; c0 += 17) {
            f32x2 v[17];
#pragma unroll
            for (int u = 0; u < 17; ++u) v[u] = *(const f32x2*)(LAGG + (((size_t)db * NCH + c0 + u) * 512 + ch) * 2);
#pragma unroll
            for (int u = 0; u < 17; ++u) { LAGG[(((size_t)db * NCH + c0 + u) * 512 + ch) * 2] = h; h = v[u][0] * h + v[u][1]; }
        }
    }
}

DEVI void gsync(unsigned* bar, unsigned& epoch, int G, int wv) {
    __syncthreads();
    epoch += 1u;
    if (wv == 0) {
        const int ln = (int)__builtin_amdgcn_mbcnt_hi(~0u, __builtin_amdgcn_mbcnt_lo(~0u, 0u));
        if (ln == 0) {
            __builtin_amdgcn_fence(__ATOMIC_RELEASE, "agent");
            __hip_atomic_fetch_add(bar, 1u, __ATOMIC_RELAXED, __HIP_MEMORY_SCOPE_AGENT);
            const unsigned target = epoch * (unsigned)G;
            while (__hip_atomic_load(bar, __ATOMIC_RELAXED, __HIP_MEMORY_SCOPE_AGENT) < target) __builtin_amdgcn_s_sleep(1);
            __builtin_amdgcn_fence(__ATOMIC_ACQUIRE, "agent");
        }
    }
    __syncthreads();
}

__global__ void __launch_bounds__(512) mega(Params p) {
    extern __shared__ __attribute__((aligned(16))) unsigned char shm[];
    cg::grid_group grid = cg::this_grid();
    const int wv = __builtin_amdgcn_readfirstlane(threadIdx.x >> 6);
    const int G = gridDim.x, nwaves = G * 8, nthreads = G * 512;
#define TIDS const int tid = MYTID, wid = tid >> 6, lane = tid & 63, gwave = blockIdx.x * 8 + wid, gtid = blockIdx.x * 512 + tid; (void)gtid; (void)gwave; (void)lane;
    LAS unsigned char* lds = (LAS unsigned char*)shm;
#define WSQ unsigned char* ws = opq64(pw.ws); bf16_t* Hb = (bf16_t*)(ws + WS_H); bf16_t* Pb = (bf16_t*)(ws + WS_P); float* Yb = (float*)(ws + WS_Y); (void)Hb; (void)Pb; (void)Yb;

    const PW pw{p.ws};
    unsigned* bar = (unsigned*)p.ws; unsigned epoch = 0u;
    for (int rep = 0; rep < REP_CVT; ++rep) {
    mod_phase(pw, shm, wv);
    { TIDS convert_phase(pw, 0, shm, gwave, nwaves, wid, lane); }
    }
    grid.sync();
    { TIDS rowwise_phase(pw, 0, MTOT, 0, 0, 0.f, 0, 0, 0, 0, gwave, nwaves, lane); }
    gsync(bar, epoch, G, wv);

#pragma unroll 1
    for (int l = 0; l < DEPTH; ++l) {
        const bool last = l == DEPTH - 1;
#pragma unroll 1
        for (int f = 0; f < 2; ++f) {
            if (f == 1) {
                { WSQ pg8::Gemm g{Hb, (const bf16_t*)(ws + WS_WIN), 68, 31, D, D, 1, 0, 0, 0, 0}; pg8::Order S; S.init(68, 31, 1, G, blockIdx.x);
                  pg8::EpiInProj E{Pb, DINP}; for (int rep = 0; rep < REP_GEMM; ++rep) pg8::gemm_phase(lds, g, S, E, wv); }
                gsync(bar, epoch, G, wv);
#pragma unroll 1
                for (int rep2 = 0; rep2 < REP_PREPSEQ; ++rep2) {
#pragma unroll 1
                for (int rep = 0; rep < REP_PREP; ++rep)
                for (int it = blockIdx.x; it < 2176 + 2176 + 272; it += G) {
                    if (it < 2176) { for (int r3 = 0; r3 < REP_GDNP; ++r3) gdn_prep_item(pw, l, it, shm, wv); }
                    else if (it < 4352) { for (int r3 = 0; r3 < REP_MLP; ++r3) ml_prep_item(pw, l, it - 2176, shm, wv); }
                    else { for (int r3 = 0; r3 < REP_LRU0; ++r3) lru_item(pw, l, it - 4352, 0, shm, wv); }
                }
                gsync(bar, epoch, G, wv);
                for (int u = blockIdx.x; u < 256; u += G) gdn_seq_unit(pw, u, shm, wv);
                { TIDS ml_seq(pw, gtid, nthreads); }
                { TIDS lru_seq(pw, gtid, nthreads); }
                gsync(bar, epoch, G, wv);
                }
                for (int it = blockIdx.x; it < 1088 + 1088 + 272; it += G) {
                    int ii = it, kind = 0; if (ii >= 1088) { ii -= 1088; kind = 1; if (ii >= 1088) { ii -= 1088; kind = 2; } }
                    const int jj = ii % NCH;
                    if (last && jj < 4) continue;
                    if (kind == 0) gdn_out_item(pw, l, ii, shm, wv); else if (kind == 1) ml_out_item(pw, l, ii, shm, wv); else lru_item(pw, l, ii, 1, shm, wv);
                }
                gsync(bar, epoch, G, wv);
                const int nM = last ? 64 : 68;
                { WSQ pg8::Gemm g{Pb, (const bf16_t*)(ws + WS_WBR), nM, 4, 512, DINP, 3, C_MLO, C_LRY, C_DNZ, D * 512}; pg8::Order S; S.init(nM, 4, 3, G, blockIdx.x);
                  pg8::EpiBranch E{Pb, Yb, Hb}; for (int rep = 0; rep < REP_GEMM; ++rep) pg8::gemm_phase(lds, g, S, E, wv); }
                gsync(bar, epoch, G, wv);
                { WSQ pg8::Gemm g{Hb, (const bf16_t*)(ws + WS_WOUT), nM, 4, D, D, 1, 0, 0, 0, 0}; pg8::Order S; S.init(nM, 4, 1, G, blockIdx.x);
                  pg8::EpiF32 E{Yb, D}; for (int rep = 0; rep < REP_GEMM; ++rep) pg8::gemm_phase(lds, g, S, E, wv); }
                gsync(bar, epoch, G, wv);
                { TIDS rowwise_phase(pw, 1, nM * 256, l, 5, 1.f, 3, l, 4, 6, gwave, nwaves, lane); }
                gsync(bar, epoch, G, wv);
            }
            const int nM = (last && f == 1) ? 64 : 68;
            { WSQ pg8::Gemm g{Hb, (const bf16_t*)(ws + WS_WGU + f * SZ_WGU), nM, 22, D, D, 1, 0, 0, 0, 0}; pg8::Order S; S.init(nM, 22, 1, G, blockIdx.x);
              pg8::EpiSwiGLU E{Pb, DFF}; for (int rep = 0; rep < REP_GEMM; ++rep) pg8::gemm_phase(lds, g, S, E, wv); }
            gsync(bar, epoch, G, wv);
            { WSQ pg8::Gemm g{Pb, (const bf16_t*)(ws + WS_WDN + f * SZ_WDN), nM, 4, DFF, DFF, 1, 0, 0, 0, 0}; pg8::Order S; S.init(nM, 4, 1, G, blockIdx.x);
              pg8::EpiF32 E{Yb, D}; for (int rep = 0; rep < REP_GEMM; ++rep) pg8::gemm_phase(lds, g, S, E, wv); }
            gsync(bar, epoch, G, wv);
            if (f == 0) { TIDS rowwise_phase(pw, 1, nM * 256, l, 2, 0.5f, 1, l, 2, 3, gwave, nwaves, lane); }
            else if (!last) { { TIDS rowwise_phase(pw, 1, nM * 256, l, 8, 0.5f, 5, l + 1, 0, 0, gwave, nwaves, lane); } for (int rep = 0; rep < REP_CVT; ++rep) { TIDS convert_phase(pw, l + 1, shm, gwave, nwaves, wid, lane); } }
            else { TIDS rowwise_phase(pw, 2, MLAT, l, 8, 0.5f, 5, 0, 0, 0, gwave, nwaves, lane); }
            gsync(bar, epoch, G, wv);
        }
    }
}

extern "C" void kernel_launch(void* const* d_in, const int* in_sizes, int n_in, void* d_out, int out_size, void* d_ws, size_t ws_size, hipStream_t stream) {
    static int grid = 0;
    if (grid == 0) {
        if (n_in != 25 || ws_size < WS_END) { fprintf(stderr, "kernel_launch: unexpected n_in %d or ws_size %zu (need %zu)\n", n_in, ws_size, (size_t)WS_END); grid = -1; return; }
        int dev = 0, cus = 0, per_cu = 0;
        hipGetDevice(&dev); hipDeviceGetAttribute(&cus, hipDeviceAttributeMultiprocessorCount, dev);
        if (hipFuncSetAttribute((const void*)mega, hipFuncAttributeMaxDynamicSharedMemorySize, LDS_BYTES) != hipSuccess) { fprintf(stderr, "kernel_launch: hipFuncSetAttribute failed\n"); grid = -1; return; }
        if (hipOccupancyMaxActiveBlocksPerMultiprocessor(&per_cu, (const void*)mega, 512, LDS_BYTES) != hipSuccess || per_cu < 1) { fprintf(stderr, "kernel_launch: occupancy query failed (%d)\n", per_cu); per_cu = 1; }
        (void)hipGetLastError();
        grid = cus * per_cu;
    }
    if (grid < 0) return;
    if (hipMemsetAsync(d_ws, 0, 256, stream) != hipSuccess) { fprintf(stderr, "kernel_launch: memset failed\n"); return; }
    Params p{};
    for (int i = 0; i < 25; ++i) p.in[i] = (const float*)d_in[i];
    p.out = (float*)d_out; p.ws = (unsigned char*)d_ws;
    void* args[] = {&p};
    hipError_t e = hipLaunchCooperativeKernel((const void*)mega, dim3(grid), dim3(512), args, LDS_BYTES, stream);
    if (e != hipSuccess) fprintf(stderr, "cooperative launch failed: %s (grid %d)\n", hipGetErrorString(e), grid);
}
```

```cpp
#include <hip/hip_runtime.h>
#include <hip/hip_cooperative_groups.h>
#include <cstdio>
namespace cg = cooperative_groups;

#define LAS __attribute__((address_space(3)))
#define DEVI __device__ __forceinline__
typedef unsigned short bf16_t;
typedef short bf16x8 __attribute__((ext_vector_type(8)));
typedef float f32x4 __attribute__((ext_vector_type(4)));
typedef float f32x2 __attribute__((ext_vector_type(2)));
typedef unsigned u32x4 __attribute__((ext_vector_type(4)));
typedef unsigned u32x2 __attribute__((ext_vector_type(2)));

constexpr int D = 1024, NBATCH = 4, SEQ = 4096, CTXL = 256, DEPTH = 4, DFF = 2816, DINP = 7936;
constexpr int MLAT = NBATCH * SEQ, MTOT = MLAT + NBATCH * CTXL;
constexpr int NCH = 68;
constexpr int C_MLQ = 0, C_MLK = 256, C_MLV = 512, C_MLO = 1024, C_MLG = 1536, C_LRX = 1552, C_LRY = 2064,
              C_DNQ = 2576, C_DNZ = 4112, C_DNBA = 4624, C_GATE = 4640, C_END = 7712;
constexpr float EPS = 1e-6f;

constexpr size_t SZ_WGU = (size_t)2 * DFF * D * 2, SZ_WDN = (size_t)D * DFF * 2;
constexpr size_t WS_MOD = 16384;
constexpr size_t WS_WGU = 1u << 20;
constexpr size_t WS_WDN = WS_WGU + 2 * SZ_WGU;
constexpr size_t WS_WIN = WS_WDN + 2 * SZ_WDN;
constexpr size_t WS_WBR = WS_WIN + (size_t)DINP * D * 2;
constexpr size_t WS_WOUT = WS_WBR + (size_t)3 * D * 512 * 2;
constexpr size_t WS_WLRU = WS_WOUT + (size_t)D * D * 2;
constexpr size_t WS_X = WS_WLRU + (size_t)32 * 64 * 64 * 2;
constexpr size_t WS_H = WS_X + (size_t)MTOT * D * 4;
constexpr size_t WS_Y = WS_H + (size_t)MTOT * D * 2;
constexpr size_t WS_P = WS_Y + (size_t)MTOT * D * 4;
constexpr size_t WS_GU = WS_P + (size_t)MTOT * DINP * 2;
constexpr size_t WS_GB = WS_GU + (size_t)2176 * 64 * 128 * 2;
constexpr size_t WS_GN = WS_GB + (size_t)2176 * 128 * 128 * 2;
constexpr size_t WS_SM = WS_GN + (size_t)2176 * 128 * 128 * 2;
constexpr size_t SM_GDEC = 0, SM_MN = 16384, SM_MSC = SM_MN + 2176 * 64 * 4, SM_MM = SM_MSC + 2176 * 8, SM_LAGG = SM_MM + 2176 * 4 + 1024;
constexpr size_t WS_YC = WS_SM + SM_LAGG + (size_t)2 * 4 * NCH * 512 * 2 * 4 + 4096;
constexpr size_t WS_END = WS_YC + (size_t)1024 * D * 4;
constexpr int LDS_BYTES = 155648;
constexpr int REP_GU = 1, REP_DN = 1, REP_DNC = 1, REP_GEMM = 1, REP_PREP = 1, REP_PREPSEQ = 1, REP_CVT = 1, REP_GDNP = 1, REP_MLP = 1, REP_LRU0 = 1;

struct Params { const float* in[25]; float* out; unsigned char* ws; };
struct PW { unsigned char* ws; };

#define CAS __attribute__((address_space(4)))
DEVI const float* pin(int i) { const CAS char* k = (const CAS char*)__builtin_amdgcn_kernarg_segment_ptr(); return *(const float* const volatile CAS*)(k + 8 * i); }
DEVI int opaque(int v) { asm volatile("" : "+v"(v)); return v; }
DEVI unsigned char* opq(unsigned char* p) { unsigned v = (unsigned)(size_t)(LAS unsigned char*)p; asm volatile("" : "+s"(v)); return (unsigned char*)(LAS unsigned char*)(size_t)v; }
DEVI LAS unsigned char* opql(LAS unsigned char* p) { unsigned v = (unsigned)(size_t)p; asm volatile("" : "+s"(v)); return (LAS unsigned char*)(size_t)v; }
DEVI unsigned char* opq64(unsigned char* p) { unsigned long long v = (unsigned long long)p; asm volatile("" : "+s"(v)); return (unsigned char*)v; }
#define MYTID opaque(wv * 64 + (int)__builtin_amdgcn_mbcnt_hi(~0u, __builtin_amdgcn_mbcnt_lo(~0u, 0u)))
DEVI float bf2f(bf16_t v) { return __uint_as_float(((unsigned)v) << 16); }
DEVI unsigned f2bf(float f) { unsigned u = __float_as_uint(f); return (u + 0x7fffu + ((u >> 16) & 1u)) >> 16; }
DEVI unsigned pk2(float lo, float hi) { return f2bf(lo) | (f2bf(hi) << 16); }
DEVI float sigm(float x) { return __builtin_amdgcn_rcpf(1.f + __expf(-x)); }
DEVI float silu(float x) { return x * sigm(x); }
DEVI float softplus(float x) { return x > 20.f ? x : log1pf(__expf(x)); }
DEVI float logsig(float x) { return fminf(x, 0.f) - log1pf(__expf(-fabsf(x))); }
DEVI float gelu_t(float x) { float u = 0.7978845608f * (x + 0.044715f * x * x * x); float e = __expf(2.f * u); return x * (1.f - __builtin_amdgcn_rcpf(e + 1.f)); }
DEVI float wsum(float v) { for (int o = 32; o > 0; o >>= 1) v += __shfl_xor(v, o, 64); return v; }
DEVI float wmax(float v) { for (int o = 32; o > 0; o >>= 1) v = fmaxf(v, __shfl_xor(v, o, 64)); return v; }
DEVI void unpack8(u32x4 r, float* f) {
    f[0] = __uint_as_float(r[0] << 16); f[1] = __uint_as_float(r[0] & 0xffff0000u); f[2] = __uint_as_float(r[1] << 16); f[3] = __uint_as_float(r[1] & 0xffff0000u);
    f[4] = __uint_as_float(r[2] << 16); f[5] = __uint_as_float(r[2] & 0xffff0000u); f[6] = __uint_as_float(r[3] << 16); f[7] = __uint_as_float(r[3] & 0xffff0000u);
}
DEVI u32x4 pack8(const float* f) { u32x4 r; r[0] = pk2(f[0], f[1]); r[1] = pk2(f[2], f[3]); r[2] = pk2(f[4], f[5]); r[3] = pk2(f[6], f[7]); return r; }
DEVI bf16x8 ldfrag(const bf16_t* base, int ld, int row0, int k0, int lane) { return *(const bf16x8*)(base + (row0 + (lane & 15)) * ld + k0 + (lane >> 4) * 8); }
#define MFMA16(a, b, c) __builtin_amdgcn_mfma_f32_16x16x32_bf16(a, b, c, 0, 0, 0)

namespace pg8 {
constexpr int BM = 256, BK = 64, HALF = 128, HTB = HALF * BK * 2, NXCD = 8, WGM = 8;
DEVI int lds_byte(int r, int c) { const int st = (r >> 4) * 2 + (c >> 5), rr = r & 15, cc = c & 31, ob = rr * 64 + cc * 2; return st * 1024 + (ob ^ (((ob >> 9) & 1) << 5)); }
DEVI void stage_rc(int b, int& R, int& C) { const int st = b / 1024, sb = b % 1024, swz = sb ^ (((sb >> 9) & 1) << 5); R = (st >> 1) * 16 + swz / 64; C = (st & 1) * 32 + (swz % 64) / 2; }
DEVI int perm32(int rho) { const int n = rho >> 4, i = rho & 15; return 8 * (i >> 2) + 4 * n + (i & 3); }
struct Unit { int pm, pn, z; };
struct Gemm { const bf16_t* A; const bf16_t* Bt; int nM, nN, K, lda, nz, zA0, zA1, zA2, zB; int ldb, zAstep; };
struct Order {
    int nM, nN, nwg, G, c, nz, pm0, spread;
    DEVI void init(int nM_, int nN_, int nz_, int G_, int c_, int pm0_ = 0, int spread_ = 0) { nM = nM_; nN = nN_; nwg = nM * nN; G = G_; c = c_; nz = nz_; pm0 = pm0_; spread = spread_; }
    DEVI bool next(int i, Unit& u) const {
        int ti = i, z = 0; long L;
        if (spread) { L = (long)i * G + c; if (L >= (long)nwg * nz) return false; z = (int)(L / nwg); L -= (long)z * nwg; }
        else { if (nz == 3) { ti = i / 3; z = i - ti * 3; } L = (long)ti * G + c; if (L >= nwg) return false; }
        int wgid = (int)L; { const int q = nwg / NXCD, r = nwg % NXCD, xcd = wgid % NXCD, off = wgid / NXCD; wgid = (xcd < r ? xcd * (q + 1) : r * (q + 1) + (xcd - r) * q) + off; }
        const int nig = WGM * nN, gid = wgid / nig, fm = gid * WGM, gsz = (nM - fm) < WGM ? (nM - fm) : WGM;
        u.pm = pm0 + fm + ((wgid % nig) % gsz); u.pn = (wgid % nig) / gsz; u.z = z; return true;
    }
};

template <class Epi>
DEVI void gemm_phase(LAS unsigned char* lds_in, const Gemm g, const Order& S, const Epi& E, int wv) {
    LAS unsigned char* lds = opql(lds_in);
    const int tid = MYTID, wid = __builtin_amdgcn_readfirstlane(tid >> 6), lane = tid & 63, wr = wid >> 2, wc = wid & 3, fr = lane & 15, fq = lane >> 4;
    const int K = g.K, nt = K / BK, lda = g.lda, ldb = g.ldb;
    unsigned voffA[2], voffB[2];
#pragma unroll
    for (int i = 0; i < 2; ++i) { int R, C; stage_rc(tid * 16 + i * 8192, R, C); const int Rb = Epi::PERM ? ((R & ~31) + perm32(R & 31)) : R;
        voffA[i] = (unsigned)(R * lda + C) * 2u; voffB[i] = (unsigned)(Rb * ldb + C) * 2u; }
    const size_t kstep = (size_t)(BK * 2);
    const size_t hstepA = (size_t)HALF * lda * 2, hstepB = (size_t)HALF * ldb * 2;
    const unsigned ldsw = (unsigned)wid * 1024u;
    const int aoff = lds_byte(wr * 64 + fr, fq * 8), boff = lds_byte(wc * 32 + fr, fq * 8);
#define PG8_SA(b, h) (((b) * 2 + (h)) * HTB)
#define PG8_SB(b, h) ((4 + (b) * 2 + (h)) * HTB)
#define PG8_STAGE(bufoff, gbase, voff) do { _Pragma("unroll") for (int _i = 0; _i < 2; ++_i) \
        __builtin_amdgcn_global_load_lds((const unsigned*)((const char*)(gbase) + (voff)[_i]), (LAS unsigned*)(lds + (bufoff) + ldsw + _i * 8192), 16, 0, 0); } while (0)
#define PG8_LDA(dst, b, h) do { _Pragma("unroll") for (int m = 0; m < 4; ++m) _Pragma("unroll") for (int k = 0; k < 2; ++k) dst[m][k] = *(const LAS bf16x8*)(lds + PG8_SA(b, h) + aoff + m * 2048 + k * 1024); } while (0)
#define PG8_LDB(dst, b, h) do { _Pragma("unroll") for (int n = 0; n < 2; ++n) _Pragma("unroll") for (int k = 0; k < 2; ++k) dst[n][k] = *(const LAS bf16x8*)(lds + PG8_SB(b, h) + boff + n * 2048 + k * 1024); } while (0)
#define PG8_MMA(ai, bj, At, Bt) do { __builtin_amdgcn_s_setprio(1); _Pragma("unroll") for (int m = 0; m < 4; ++m) _Pragma("unroll") for (int n = 0; n < 2; ++n) _Pragma("unroll") for (int k = 0; k < 2; ++k) \
        acc[ai][bj][m][n] = __builtin_amdgcn_mfma_f32_16x16x32_bf16(Bt[n][k], At[m][k], acc[ai][bj][m][n], 0, 0, 0); __builtin_amdgcn_s_setprio(0); } while (0)
#define PG8_WAIT_V(n) asm volatile("s_waitcnt vmcnt(" #n ")" ::: "memory")
#define PG8_WAIT_L(n) asm volatile("s_waitcnt lgkmcnt(" #n ")" ::: "memory")
#define PG8_BAR __builtin_amdgcn_s_barrier()
#define PG8_SCHED __builtin_amdgcn_sched_barrier(0)
#define PG8_PA(u) ((const char*)g.A + ((size_t)(g.nz == 3 ? ((u).z == 0 ? g.zA0 : ((u).z == 1 ? g.zA1 : g.zA2)) : (u).z * g.zAstep) + (size_t)(u).pm * BM * lda) * 2)
#define PG8_PB(u) ((const char*)g.Bt + ((size_t)(u).z * g.zB + (size_t)(u).pn * BM * ldb) * 2)
    Unit cur, nxt; int ui = 0;
    if (!S.next(0, cur)) return;
    f32x4 acc[2][2][4][2];
#pragma unroll
    for (int a = 0; a < 2; ++a)
#pragma unroll
        for (int b = 0; b < 2; ++b)
#pragma unroll
            for (int m = 0; m < 4; ++m)
#pragma unroll
                for (int n = 0; n < 2; ++n) acc[a][b][m][n] = (f32x4){0.f, 0.f, 0.f, 0.f};
    bf16x8 At[4][2], B0[2][2], B1[2][2];
    const char* cA = PG8_PA(cur); const char* cB = PG8_PB(cur);
    PG8_STAGE(PG8_SB(0, 0), cB, voffB); PG8_STAGE(PG8_SA(0, 0), cA, voffA); PG8_STAGE(PG8_SB(0, 1), cB + hstepB, voffB); PG8_STAGE(PG8_SA(0, 1), cA + hstepA, voffA);
    if (wr == 1) PG8_BAR;
    PG8_WAIT_V(4); PG8_BAR;
    PG8_STAGE(PG8_SB(1, 0), cB + kstep, voffB); PG8_STAGE(PG8_SA(1, 0), cA + kstep, voffA); PG8_STAGE(PG8_SB(1, 1), cB + hstepB + kstep, voffB);
    PG8_WAIT_V(6); PG8_BAR;
    for (;;) {
        const bool has_next = S.next(ui + 1, nxt);
        const char* nA = has_next ? PG8_PA(nxt) : cA; const char* nB = has_next ? PG8_PB(nxt) : cB;
        for (int t = 0; t < nt; t += 2) {
            const bool last = (t == nt - 2);
            const char* a1 = cA + (size_t)(t + 1) * kstep;
            const char* a2 = last ? nA : cA + (size_t)(t + 2) * kstep; const char* b2 = last ? nB : cB + (size_t)(t + 2) * kstep;
            const char* a3 = a2 + kstep; const char* b3 = b2 + kstep;
            PG8_LDB(B0, 0, 0); PG8_SCHED; PG8_LDA(At, 0, 0); PG8_STAGE(PG8_SA(1, 1), a1 + hstepA, voffA);
            PG8_WAIT_L(8); PG8_BAR; PG8_WAIT_L(0); PG8_MMA(0, 0, At, B0); PG8_BAR; PG8_SCHED;
            PG8_LDB(B1, 0, 1); PG8_STAGE(PG8_SB(0, 0), b2, voffB);
            PG8_BAR; PG8_WAIT_L(0); PG8_MMA(0, 1, At, B1); PG8_BAR;
            PG8_LDA(At, 0, 1); PG8_STAGE(PG8_SA(0, 0), a2, voffA);
            PG8_BAR; PG8_WAIT_L(0); PG8_MMA(1, 0, At, B0); PG8_BAR; PG8_SCHED;
            PG8_STAGE(PG8_SB(0, 1), b2 + hstepB, voffB);
            PG8_WAIT_V(6); PG8_BAR; PG8_MMA(1, 1, At, B1); PG8_BAR;
            PG8_LDB(B0, 1, 0); PG8_SCHED; PG8_LDA(At, 1, 0); PG8_STAGE(PG8_SA(0, 1), a2 + hstepA, voffA);
            PG8_WAIT_L(8); PG8_BAR; PG8_WAIT_L(0); PG8_MMA(0, 0, At, B0); PG8_BAR; PG8_SCHED;
            PG8_LDB(B1, 1, 1); PG8_STAGE(PG8_SB(1, 0), b3, voffB);
            PG8_BAR; PG8_WAIT_L(0); PG8_MMA(0, 1, At, B1); PG8_BAR;
            PG8_LDA(At, 1, 1); PG8_STAGE(PG8_SA(1, 0), a3, voffA);
            PG8_BAR; PG8_WAIT_L(0); PG8_MMA(1, 0, At, B0); PG8_BAR; PG8_SCHED;
            PG8_STAGE(PG8_SB(1, 1), b3 + hstepB, voffB);
            PG8_WAIT_V(6); PG8_BAR; PG8_MMA(1, 1, At, B1); PG8_BAR;
        }
        E(acc, cur, wr, wc, fr, fq);
        if (!has_next) break;
#pragma unroll
        for (int a = 0; a < 2; ++a)
#pragma unroll
            for (int b = 0; b < 2; ++b)
#pragma unroll
                for (int m = 0; m < 4; ++m)
#pragma unroll
                    for (int n = 0; n < 2; ++n) acc[a][b][m][n] = (f32x4){0.f, 0.f, 0.f, 0.f};
        cur = nxt; cA = nA; cB = nB; ++ui;
    }
    PG8_WAIT_V(0);
    if (wr == 0) PG8_BAR;
    PG8_BAR;
#undef PG8_SA
#undef PG8_SB
#undef PG8_STAGE
#undef PG8_LDA
#undef PG8_LDB
#undef PG8_MMA
#undef PG8_WAIT_V
#undef PG8_WAIT_L
#undef PG8_BAR
#undef PG8_SCHED
#undef PG8_PA
#undef PG8_PB
}

struct EpiF32 {
    static constexpr bool PERM = false;
    float* C; int ldc; int row_base; size_t zstride;
    DEVI void operator()(const f32x4 (&acc)[2][2][4][2], const Unit& u, int wr, int wc, int fr, int fq) const {
        const int row0 = u.pm * BM + wr * 64 + fr - row_base, col0 = u.pn * BM + wc * 32 + 4 * fq;
#pragma unroll
        for (int ai = 0; ai < 2; ++ai)
#pragma unroll
            for (int m = 0; m < 4; ++m) { float* rowp = C + (size_t)u.z * zstride + (size_t)(row0 + ai * HALF + m * 16) * ldc + col0;
#pragma unroll
                for (int bj = 0; bj < 2; ++bj)
#pragma unroll
                    for (int n = 0; n < 2; ++n) *(f32x4*)(rowp + bj * HALF + n * 16) = acc[ai][bj][m][n]; }
    }
};
struct EpiAtomic {
    static constexpr bool PERM = false;
    float* C; int ldc; int row_base;
    DEVI void operator()(const f32x4 (&acc)[2][2][4][2], const Unit& u, int wr, int wc, int fr, int fq) const {
        const int row0 = u.pm * BM + wr * 64 + fr - row_base, col0 = u.pn * BM + wc * 32 + 4 * fq;
#pragma unroll
        for (int ai = 0; ai < 2; ++ai)
#pragma unroll
            for (int m = 0; m < 4; ++m) { float* rowp = C + (size_t)(row0 + ai * HALF + m * 16) * ldc + col0;
#pragma unroll
                for (int bj = 0; bj < 2; ++bj)
#pragma unroll
                    for (int n = 0; n < 2; ++n)
#pragma unroll
                        for (int e = 0; e < 4; ++e) __hip_atomic_fetch_add(rowp + bj * HALF + n * 16 + e, acc[ai][bj][m][n][e], __ATOMIC_RELAXED, __HIP_MEMORY_SCOPE_AGENT); }
    }
};
struct EpiSwiGLU {
    static constexpr bool PERM = false;
    bf16_t* O; int ldc;
    DEVI void operator()(const f32x4 (&acc)[2][2][4][2], const Unit& u, int wr, int wc, int fr, int fq) const {
        const int row0 = u.pm * BM + wr * 64 + fr, col0 = u.pn * 128 + wc * 32 + 8 * fq;
#pragma unroll
        for (int ai = 0; ai < 2; ++ai)
#pragma unroll
            for (int m = 0; m < 4; ++m) {
                float v[8];
#pragma unroll
                for (int bj = 0; bj < 2; ++bj)
#pragma unroll
                    for (int i = 0; i < 4; ++i) { const float gt = acc[ai][bj][m][0][i], up = acc[ai][bj][m][1][i]; v[bj * 4 + i] = silu(gt) * up; }
                *(u32x4*)(O + (size_t)(row0 + ai * HALF + m * 16) * ldc + col0) = pack8(v);
            }
    }
};
struct EpiInProj {
    static constexpr bool PERM = true;
    bf16_t* O; int ldc;
    DEVI void operator()(const f32x4 (&acc)[2][2][4][2], const Unit& u, int wr, int wc, int fr, int fq) const {
        const int row0 = u.pm * BM + wr * 64 + fr;
#pragma unroll
        for (int bj = 0; bj < 2; ++bj) {
            const int c0 = u.pn * BM + bj * HALF + wc * 32 + 8 * fq;
            int kind = 0;
            if (c0 >= C_MLO && c0 < C_MLG) kind = 1; else if (c0 >= C_LRY && c0 < C_DNQ) kind = 2; else if (c0 >= C_DNZ && c0 < C_DNBA) kind = 3; else if (c0 >= C_GATE) kind = 1;
#define INPROJ_STORE(FN) _Pragma("unroll") for (int ai = 0; ai < 2; ++ai) _Pragma("unroll") for (int m = 0; m < 4; ++m) { float v[8]; \
                _Pragma("unroll") for (int n = 0; n < 2; ++n) _Pragma("unroll") for (int i = 0; i < 4; ++i) { const float x = acc[ai][bj][m][n][i]; v[n * 4 + i] = FN; } \
                *(u32x4*)(O + (size_t)(row0 + ai * HALF + m * 16) * ldc + c0) = pack8(v); }
            if (kind == 0) { INPROJ_STORE(x) } else if (kind == 1) { INPROJ_STORE(sigm(x)) } else if (kind == 2) { INPROJ_STORE(gelu_t(x)) } else { INPROJ_STORE(silu(x)) }
#undef INPROJ_STORE
        }
    }
};
struct EpiBranch {
    static constexpr bool PERM = false;
    const bf16_t* P; float* T; bf16_t* U;
    DEVI void operator()(const f32x4 (&acc)[2][2][4][2], const Unit& u, int wr, int wc, int fr, int fq) const {
        const int row0 = u.pm * BM + wr * 64 + fr, col0 = u.pn * BM + wc * 32 + 4 * fq; const int z = u.z;
#pragma unroll
        for (int ai = 0; ai < 2; ++ai)
#pragma unroll
            for (int m = 0; m < 4; ++m) { const size_t row = (size_t)(row0 + ai * HALF + m * 16);
#pragma unroll
                for (int bj = 0; bj < 2; ++bj)
#pragma unroll
                    for (int n = 0; n < 2; ++n) { const int col = col0 + bj * HALF + n * 16;
                        const u32x2 gr = *(const u32x2*)(P + row * DINP + C_GATE + z * D + col);
                        f32x4 a = acc[ai][bj][m][n];
                        a[0] *= __uint_as_float(gr[0] << 16); a[1] *= __uint_as_float(gr[0] & 0xffff0000u); a[2] *= __uint_as_float(gr[1] << 16); a[3] *= __uint_as_float(gr[1] & 0xffff0000u);
                        float* tp = T + row * D + col;
                        if (z == 0) *(f32x4*)tp = a;
                        else if (z == 1) { f32x4 o = *(f32x4*)tp; *(f32x4*)tp = o + a; }
                        else { f32x4 o = *(f32x4*)tp; o = o + a; u32x2 w; w[0] = pk2(o[0], o[1]); w[1] = pk2(o[2], o[3]); *(u32x2*)(U + row * D + col) = w; }
                    } }
    }
};
}

DEVI int tok_row(bool gdn, int dir, int b, int c, int t) {
    if (c < 4) { int p = c * 64 + t; if (dir) p = 255 - p; return MLAT + b * 256 + p; }
    int p = (c - 4) * 64 + t; if (dir) p = 4095 - p;
    const int s = gdn ? ((p & 63) * 64 + (p >> 6)) : p;
    return b * 4096 + s;
}
DEVI int pos_row(bool gdn, int b, bool isctx, int p) {
    if (isctx) { if (p < 0 || p >= 256) return -1; return MLAT + b * 256 + p; }
    if (p < 0 || p >= 4096) return -1;
    const int s = gdn ? ((p & 63) * 64 + (p >> 6)) : p;
    return b * 4096 + s;
}
DEVI int dir_chunk(int dir, int j) { return dir ? (j < 4 ? 3 - j : 71 - j) : j; }

DEVI int gu_rowmap(int s) {
    const int n = s >= DFF ? 1 : 0, a = s - n * DFF, pn = a >> 7, r = a & 127, wc = r >> 5, fq = (r >> 3) & 3, bj = (r >> 2) & 1, i = r & 3;
    return 256 * pn + 128 * bj + 32 * wc + 16 * n + 4 * fq + i;
}
DEVI void cvt_tile(const float* src, int ldsrc, int Nvalid, int k0, int n0, bf16_t* dst, int lddst, int mode, float* buf, int lane) {
#pragma unroll 4
    for (int it = 0; it < 16; ++it) {
        const int row = it * 4 + (lane >> 4), c4 = (lane & 15) * 4;
        f32x4 v = (f32x4){0.f, 0.f, 0.f, 0.f};
        if (n0 + c4 < Nvalid) v = *(const f32x4*)(src + (size_t)(k0 + row) * ldsrc + n0 + c4);
        float* bp = buf + row * 65 + c4; bp[0] = v[0]; bp[1] = v[1]; bp[2] = v[2]; bp[3] = v[3];
    }
    asm volatile("s_waitcnt lgkmcnt(0)" ::: "memory"); __builtin_amdgcn_wave_barrier();
#pragma unroll 2
    for (int it = 0; it < 8; ++it) {
        const int nc = it * 8 + (lane >> 3), kk = (lane & 7) * 8;
        float f[8];
#pragma unroll
        for (int e = 0; e < 8; ++e) f[e] = buf[(kk + e) * 65 + nc];
        const int drow = mode == 1 ? gu_rowmap(n0 + nc) : (n0 + nc);
        *(u32x4*)(dst + (size_t)drow * lddst + k0 + kk) = pack8(f);
    }
    asm volatile("s_waitcnt lgkmcnt(0)" ::: "memory"); __builtin_amdgcn_wave_barrier();
}
DEVI void convert_phase(const PW& pw0, int l, unsigned char* shm_in, int gwave, int nwaves, int wid, int lane) {
    const PW p{opq64(pw0.ws)};
    unsigned char* shm = opq(shm_in);
    float* buf = (float*)shm + wid * (64 * 65);
    unsigned char* ws = p.ws;
    for (int t = gwave; t < 6880; t += nwaves) {
        int r = t;
        if (r < 2816) { const int f = r / 1408; r -= f * 1408; const int kt = r / 88, ntl = r % 88;
            cvt_tile(pin(7) + ((size_t)(l * 2 + f)) * D * 2 * DFF, 2 * DFF, 2 * DFF, kt * 64, ntl * 64, (bf16_t*)(ws + WS_WGU + f * SZ_WGU), D, 1, buf, lane); continue; }
        r -= 2816;
        if (r < 1408) { const int f = r / 704; r -= f * 704; const int kt = r / 16, ntl = r % 16;
            cvt_tile(pin(8) + ((size_t)(l * 2 + f)) * DFF * D, D, D, kt * 64, ntl * 64, (bf16_t*)(ws + WS_WDN + f * SZ_WDN), DFF, 0, buf, lane); continue; }
        r -= 1408;
        if (r < 1984) { const int kt = r / 124, ntl = r % 124;
            cvt_tile(pin(9) + (size_t)l * D * C_END, C_END, C_END, kt * 64, ntl * 64, (bf16_t*)(ws + WS_WIN), D, 0, buf, lane); continue; }
        r -= 1984;
        if (r < 384) { const int n = r / 128; r -= n * 128; const int kt = r / 16, ntl = r % 16;
            cvt_tile(pin(23) + ((size_t)(l * 3 + n)) * 512 * D, D, D, kt * 64, ntl * 64, (bf16_t*)(ws + WS_WBR) + (size_t)n * D * 512, 512, 0, buf, lane); continue; }
        r -= 384;
        if (r < 256) { const int kt = r / 16, ntl = r % 16;
            cvt_tile(pin(24) + (size_t)l * D * D, D, D, kt * 64, ntl * 64, (bf16_t*)(ws + WS_WOUT), D, 0, buf, lane); continue; }
        r -= 256;
        { const int gate = r >> 4, dn = r & 15;
            cvt_tile(pin(gate ? 16 : 14) + ((size_t)l * 16 + dn) * 4096, 64, 64, 0, 0, (bf16_t*)(ws + WS_WLRU) + (size_t)(gate * 16 + dn) * 4096, 64, 0, buf, lane); }
    }
}

DEVI void mod_phase(const PW& pw0, unsigned char* shm_in, int wv) {
    const PW p{opq64(pw0.ws)};
    unsigned char* shm = opq(shm_in);
    float* sC = (float*)shm;
    float* red = sC + 5 * 1024;
    const int tid = MYTID;
    __syncthreads();
    for (int i = tid; i < 5 * 1024; i += 512) { const int v = i >> 10, k = i & 1023; const float x = v < 4 ? pin(1)[v * 1024 + k] : pin(3)[k]; sC[i] = silu(x); }
    __syncthreads();
    float* MOD = (float*)(p.ws + WS_MOD);
    const int cgp = tid & 15, is = tid >> 4;
    for (int task = blockIdx.x; task < DEPTH * 144; task += gridDim.x) {
        const int l = task / 144, col0 = (task % 144) * 64;
        float acc[5][4];
#pragma unroll
        for (int v = 0; v < 5; ++v)
#pragma unroll
            for (int e = 0; e < 4; ++e) acc[v][e] = 0.f;
        const float* wp = pin(4) + ((size_t)l * 1024 + is * 32) * 9216 + col0 + cgp * 4;
#pragma unroll 8
        for (int r = 0; r < 32; ++r) {
            const f32x4 w = *(const f32x4*)(wp + (size_t)r * 9216);
#pragma unroll
            for (int v = 0; v < 5; ++v) { const float s = sC[v * 1024 + is * 32 + r];
#pragma unroll
                for (int e = 0; e < 4; ++e) acc[v][e] += s * w[e]; }
        }
#pragma unroll
        for (int v = 0; v < 5; ++v)
#pragma unroll
            for (int e = 0; e < 4; ++e) red[tid * 20 + v * 4 + e] = acc[v][e];
        __syncthreads();
        if (tid < 320) { const int v = tid >> 6, c = tid & 63; float s = 0.f;
            for (int k = 0; k < 32; ++k) s += red[(k * 16 + (c >> 2)) * 20 + v * 4 + (c & 3)];
            MOD[((size_t)(l * 5 + v)) * 9216 + col0 + c] = s + pin(5)[(size_t)l * 9216 + col0 + c]; }
        __syncthreads();
    }
}

DEVI void rowwise_phase(const PW& pw0, int mode, int nrows, int l, int kgate, float coef, int gpost_i, int ln, int gpre_i, int kshift, int nzc, int gwave, int nwaves, int lane) {
    const PW p{opq64(pw0.ws)};
    float* X = (float*)(p.ws + WS_X); const float* Y0 = (const float*)(p.ws + WS_Y); const float* YC = (const float*)(p.ws + WS_GB); bf16_t* H = (bf16_t*)(p.ws + WS_H);
    const float* MOD = (const float*)(p.ws + WS_MOD);
    for (int row = gwave; row < nrows; row += nwaves) {
        const int v = row < MLAT ? (row >> 12) : 4;
        f32x4 x[4];
        if (mode == 0) {
            const float* src = row < MLAT ? pin(0) + (size_t)row * D : pin(2) + (size_t)(row - MLAT) * D;
#pragma unroll
            for (int i = 0; i < 4; ++i) x[i] = *(const f32x4*)(src + lane * 4 + 256 * i);
        } else {
            f32x4 y[4]; float ss = 0.f;
            const float* Y = row < MLAT ? Y0 + (size_t)row * D : YC + (size_t)(row - MLAT) * D;
            if (row >= MLAT) {
#pragma unroll
                for (int ih = 0; ih < 2; ++ih) {
                    f32x4 t[11][2];
#pragma unroll
                    for (int z = 0; z < 11; ++z)
#pragma unroll
                        for (int i2 = 0; i2 < 2; ++i2) t[z][i2] = z < nzc ? *(const f32x4*)(Y + (size_t)z * 1024 * D + lane * 4 + 256 * (ih * 2 + i2)) : (f32x4){0.f, 0.f, 0.f, 0.f};
#pragma unroll
                    for (int i2 = 0; i2 < 2; ++i2) { f32x4 a = t[0][i2];
#pragma unroll
                        for (int z = 1; z < 11; ++z) a = a + t[z][i2];
                        y[ih * 2 + i2] = a; }
                }
            }
#pragma unroll
            for (int i = 0; i < 4; ++i) { if (row < MLAT) y[i] = *(const f32x4*)(Y + lane * 4 + 256 * i); x[i] = *(const f32x4*)(X + (size_t)row * D + lane * 4 + 256 * i); }
#pragma unroll
            for (int i = 0; i < 4; ++i) ss += y[i][0] * y[i][0] + y[i][1] * y[i][1] + y[i][2] * y[i][2] + y[i][3] * y[i][3];
            ss = wsum(ss); const float rs = rsqrtf(ss * (1.f / D) + EPS) * coef;
            const float* gp = pin(6) + ((size_t)l * 6 + gpost_i) * D; const float* gt = MOD + ((size_t)(l * 5 + v) * 9 + kgate) * D;
#pragma unroll
            for (int i = 0; i < 4; ++i) { const f32x4 g = *(const f32x4*)(gp + lane * 4 + 256 * i), m = *(const f32x4*)(gt + lane * 4 + 256 * i);
                x[i] = x[i] + m * (y[i] * rs * g); }
        }
        if (mode == 2) {
#pragma unroll
            for (int i = 0; i < 4; ++i) *(f32x4*)((float*)pin(25) + (size_t)row * D + lane * 4 + 256 * i) = x[i];
            continue;
        }
#pragma unroll
        for (int i = 0; i < 4; ++i) *(f32x4*)(X + (size_t)row * D + lane * 4 + 256 * i) = x[i];
        float ss = 0.f;
#pragma unroll
        for (int i = 0; i < 4; ++i) ss += x[i][0] * x[i][0] + x[i][1] * x[i][1] + x[i][2] * x[i][2] + x[i][3] * x[i][3];
        ss = wsum(ss); const float rs = rsqrtf(ss * (1.f / D) + EPS);
        const float* gp = pin(6) + ((size_t)ln * 6 + gpre_i) * D; const float* sh = MOD + ((size_t)(ln * 5 + v) * 9 + kshift) * D; const float* sc = sh + D;
#pragma unroll
        for (int i = 0; i < 4; ++i) { const f32x4 g = *(const f32x4*)(gp + lane * 4 + 256 * i), a = *(const f32x4*)(sh + lane * 4 + 256 * i), s = *(const f32x4*)(sc + lane * 4 + 256 * i);
            const f32x4 h = x[i] * rs * g * (s + 1.f) + a; u32x2 w; w[0] = pk2(h[0], h[1]); w[1] = pk2(h[2], h[3]);
            *(u32x2*)(H + (size_t)row * D + lane * 4 + 256 * i) = w; }
    }
}

DEVI void gdn_load(const bf16_t* P, const float* convw, int b, int c, int h, int dir, int want, bf16_t* sQ, bf16_t* sK, bf16_t* sKT, bf16_t* sVT, int tid) {
    const bool isctx = c < 4;
#pragma unroll
    for (int r = 0; r < 6; ++r) {
        const int task = tid + 512 * r, seg = r >> 1, rem = task & 1023, t = rem >> 4, cgp = rem & 15;
        if (seg == 0 && !(want & 1)) continue;
        if (seg == 1 && !(want & 6)) continue;
        if (seg == 2 && !(want & 8)) continue;
        int p = (isctx ? c : c - 4) * 64 + t; if (dir) p = (isctx ? 255 : 4095) - p;
        const int ch = seg * 512 + h * 128 + cgp * 8;
        float a[8];
#pragma unroll
        for (int e = 0; e < 8; ++e) a[e] = 0.f;
#pragma unroll
        for (int j = 0; j < 4; ++j) {
            const int row = pos_row(true, b, isctx, p + j - 2);
            if (row >= 0) {
                const u32x4 raw = *(const u32x4*)(P + (size_t)row * DINP + C_DNQ + ch); float x[8]; unpack8(raw, x);
                const f32x4 w0 = *(const f32x4*)(convw + j * 1536 + ch), w1 = *(const f32x4*)(convw + j * 1536 + ch + 4);
                a[0] += w0[0] * x[0]; a[1] += w0[1] * x[1]; a[2] += w0[2] * x[2]; a[3] += w0[3] * x[3];
                a[4] += w1[0] * x[4]; a[5] += w1[1] * x[5]; a[6] += w1[2] * x[6]; a[7] += w1[3] * x[7];
            }
        }
        float ss = 0.f;
#pragma unroll
        for (int e = 0; e < 8; ++e) { a[e] = silu(a[e]); ss += a[e] * a[e]; }
        if (seg < 2) {
            ss += __shfl_xor(ss, 1, 64); ss += __shfl_xor(ss, 2, 64); ss += __shfl_xor(ss, 4, 64); ss += __shfl_xor(ss, 8, 64);
            float inv = rsqrtf(ss + EPS); if (seg == 0) inv *= 0.08838834764831845f;
#pragma unroll
            for (int e = 0; e < 8; ++e) a[e] *= inv;
        }
        if (seg == 0) *(u32x4*)(sQ + t * 136 + cgp * 8) = pack8(a);
        else if (seg == 1) {
            if (want & 2) *(u32x4*)(sK + t * 136 + cgp * 8) = pack8(a);
            if (want & 4) {
#pragma unroll
                for (int e = 0; e < 8; ++e) sKT[(cgp * 8 + e) * 72 + t] = (bf16_t)f2bf(a[e]); }
        } else {
#pragma unroll
            for (int e = 0; e < 8; ++e) sVT[(cgp * 8 + e) * 72 + t] = (bf16_t)f2bf(a[e]);
        }
    }
}
DEVI void gdn_gates(const PW& p, const bf16_t* P, int l, int b, int c, int h, int dir, float* sc, int lane) {
    const int row = tok_row(true, dir, b, c, lane);
    const float bb = bf2f(P[(size_t)row * DINP + C_DNBA + dir * 4 + h]), aa = bf2f(P[(size_t)row * DINP + C_DNBA + 8 + dir * 4 + h]);
    const float beta = sigm(bb);
    const float g = -__expf(pin(20)[l * 8 + dir * 4 + h]) * softplus(aa + pin(21)[l * 8 + dir * 4 + h]);
    float G = g;
#pragma unroll
    for (int o = 1; o < 64; o <<= 1) { const float t = __shfl_up(G, o, 64); if (lane >= o) G += t; }
    const float GT = __shfl(G, 63, 64);
    sc[lane] = G; sc[64 + lane] = beta; sc[128 + lane] = __expf(G); sc[192 + lane] = __expf(GT - G); if (lane == 0) sc[256] = __expf(GT);
}

DEVI void gdn_prep_item(const PW& pw0, int l, int item, unsigned char* shm_in, int wv) {
    const PW p{opq64(pw0.ws)};
    unsigned char* shm = opq(shm_in);
    const int tid = MYTID, wid = __builtin_amdgcn_readfirstlane(tid >> 6), lane = tid & 63, fr = lane & 15, fq = lane >> 4;
    const int c = item % NCH, h = (item / NCH) & 3, b = (item / (NCH * 4)) & 3, dir = item / (NCH * 16);
    const bf16_t* P = (const bf16_t*)(p.ws + WS_P);
    bf16_t* sK = (bf16_t*)shm;
    bf16_t* sKT = (bf16_t*)(shm + 17408);
    bf16_t* sVT = (bf16_t*)(shm + 35840);
    float* sTm = (float*)(shm + 54272);
    bf16_t* sT1 = (bf16_t*)(shm + 71680);
    bf16_t* sT2 = (bf16_t*)(shm + 80896);
    bf16_t* sWT = (bf16_t*)(shm + 90112);
    bf16_t* sUT = (bf16_t*)(shm + 108544);
    float* sc = (float*)(shm + 126976);
    if (wid == 0) gdn_gates(p, P, l, b, c, h, dir, sc, lane);
    gdn_load(P, pin(19) + (size_t)l * 4 * 1536, b, c, h, dir, 2 | 4 | 8, nullptr, sK, sKT, sVT, tid);
    __syncthreads();
#pragma unroll
    for (int ti = 0; ti < 2; ++ti) {
        const int tile = wid * 2 + ti, mt = tile >> 2, nt = tile & 3;
        f32x4 acc = (f32x4){0.f, 0.f, 0.f, 0.f};
#pragma unroll
        for (int kk = 0; kk < 4; ++kk) acc = MFMA16(ldfrag(sK, 136, mt * 16, kk * 32, lane), ldfrag(sK, 136, nt * 16, kk * 32, lane), acc);
        const int s = nt * 16 + fr;
#pragma unroll
        for (int j = 0; j < 4; ++j) { const int t = mt * 16 + fq * 4 + j; sTm[t * 68 + s] = s < t ? sc[64 + t] * acc[j] * __expf(sc[t] - sc[s]) : 0.f; }
    }
    __syncthreads();
    float* tmpY = (float*)sWT;
    if (wid < 4) {
        const int o = wid * 16, c = lane & 15;
        int lz; asm volatile("v_mov_b32 %0, 0" : "=v"(lz));
        const float* tm = sTm + lz;
        float x[16];
#pragma unroll
        for (int t = 0; t < 16; ++t) {
            float v = -sTm[(o + t) * 68 + o + c];
#pragma unroll
            for (int s4 = 0; s4 < (t + 3) / 4; ++s4) {
                const f32x4 a = *(const f32x4*)(tm + (o + t) * 68 + o + s4 * 4);
#pragma unroll
                for (int e = 0; e < 4; ++e) if (s4 * 4 + e < t) v -= a[e] * x[s4 * 4 + e];
            }
            x[t] = v;
        }
        asm volatile("s_waitcnt lgkmcnt(0)" ::: "memory");
        if (lane < 16) {
#pragma unroll
            for (int t = 0; t < 16; ++t) sTm[(o + t) * 68 + o + c] = x[t] + (t == c ? 1.f : 0.f);
        }
    }
    __syncthreads();
    {
        const int blk = tid >> 8, r = (tid >> 4) & 15, c = tid & 15, ib = (blk ? 3 : 1) * 16, jb = ib - 16;
        float y = 0.f;
#pragma unroll
        for (int s2 = 0; s2 < 16; ++s2) y += sTm[(ib + r) * 68 + jb + s2] * sTm[(jb + s2) * 68 + jb + c];
        tmpY[blk * 272 + r * 17 + c] = y;
        __syncthreads();
        float z = 0.f;
#pragma unroll
        for (int s2 = 0; s2 < 16; ++s2) z += sTm[(ib + r) * 68 + ib + s2] * tmpY[blk * 272 + s2 * 17 + c];
        __syncthreads();
        sTm[(ib + r) * 68 + jb + c] = -z;
    }
    __syncthreads();
    {
        float y[2];
#pragma unroll
        for (int u = 0; u < 2; ++u) { const int o = tid + 512 * u, r = o >> 5, c = o & 31; float a = 0.f;
#pragma unroll 8
            for (int s2 = 0; s2 < 32; ++s2) a += sTm[(32 + r) * 68 + s2] * sTm[s2 * 68 + c];
            y[u] = a; }
#pragma unroll
        for (int u = 0; u < 2; ++u) { const int o = tid + 512 * u, r = o >> 5, c = o & 31; tmpY[r * 33 + c] = y[u]; }
        __syncthreads();
#pragma unroll
        for (int u = 0; u < 2; ++u) { const int o = tid + 512 * u, r = o >> 5, c = o & 31; float a = 0.f;
#pragma unroll 8
            for (int s2 = 0; s2 < 32; ++s2) a += sTm[(32 + r) * 68 + 32 + s2] * tmpY[s2 * 33 + c];
            y[u] = a; }
#pragma unroll
        for (int u = 0; u < 2; ++u) { const int o = tid + 512 * u, r = o >> 5, c = o & 31; sTm[(32 + r) * 68 + c] = -y[u]; }
    }
    __syncthreads();
#pragma unroll
    for (int u = 0; u < 8; ++u) {
        const int o = tid + 512 * u, t = o >> 6, s2 = o & 63; const float xv = sTm[t * 68 + s2], bt = sc[64 + s2];
        sT1[t * 72 + s2] = (bf16_t)f2bf(xv * bt * sc[128 + s2]); sT2[t * 72 + s2] = (bf16_t)f2bf(xv * bt);
    }
    __syncthreads();
    bf16_t* GW = (bf16_t*)(p.ws + WS_H) + (size_t)item * 64 * 128;
    bf16_t* GU = (bf16_t*)(p.ws + WS_GU) + (size_t)item * 64 * 128;
    {
        const int tid2 = opaque(tid), lane = tid2 & 63, fr = lane & 15, fq = lane >> 4;
        const int mt = wid;
#pragma unroll
        for (int nt = 0; nt < 4; ++nt) {
            f32x4 aw = (f32x4){0.f, 0.f, 0.f, 0.f}, au = aw;
#pragma unroll
            for (int kk = 0; kk < 2; ++kk) { aw = MFMA16(ldfrag(sKT, 72, mt * 16, kk * 32, lane), ldfrag(sT1, 72, nt * 16, kk * 32, lane), aw);
                au = MFMA16(ldfrag(sVT, 72, mt * 16, kk * 32, lane), ldfrag(sT2, 72, nt * 16, kk * 32, lane), au); }
            const int t = nt * 16 + fr, r0 = mt * 16 + fq * 4; const float dec = sc[192 + t];
            u32x2 w; w[0] = pk2(aw[0], aw[1]); w[1] = pk2(aw[2], aw[3]); *(u32x2*)(GW + t * 128 + r0) = w;
            w[0] = pk2(au[0], au[1]); w[1] = pk2(au[2], au[3]); *(u32x2*)(GU + t * 128 + r0) = w;
#pragma unroll
            for (int j = 0; j < 4; ++j) { sWT[(r0 + j) * 72 + t] = (bf16_t)f2bf(aw[j] * dec); sUT[(r0 + j) * 72 + t] = (bf16_t)f2bf(au[j] * dec); }
        }
    }
    __syncthreads();
    bf16_t* GB = (bf16_t*)(p.ws + WS_GB) + (size_t)item * 128 * 128;
    bf16_t* GN = (bf16_t*)(p.ws + WS_GN) + (size_t)item * 128 * 128;
    {
        const int tid2 = opaque(tid), lane = tid2 & 63, fr = lane & 15, fq = lane >> 4;
        const int mt = wid;
#pragma unroll
        for (int nt = 0; nt < 8; ++nt) {
            f32x4 ab = (f32x4){0.f, 0.f, 0.f, 0.f}, an = ab;
#pragma unroll
            for (int kk = 0; kk < 2; ++kk) { ab = MFMA16(ldfrag(sWT, 72, mt * 16, kk * 32, lane), ldfrag(sKT, 72, nt * 16, kk * 32, lane), ab);
                an = MFMA16(ldfrag(sKT, 72, mt * 16, kk * 32, lane), ldfrag(sUT, 72, nt * 16, kk * 32, lane), an); }
            const int cc = nt * 16 + fr, r0 = mt * 16 + fq * 4;
            u32x2 w; w[0] = pk2(-ab[0], -ab[1]); w[1] = pk2(-ab[2], -ab[3]); *(u32x2*)(GB + cc * 128 + r0) = w;
            w[0] = pk2(an[0], an[1]); w[1] = pk2(an[2], an[3]); *(u32x2*)(GN + cc * 128 + r0) = w;
        }
    }
    if (tid == 0) ((float*)(p.ws + WS_SM + SM_GDEC))[item] = sc[256];
    __syncthreads();
}

DEVI void gdn_seq_unit(const PW& pw0, int unit, unsigned char* shm_in, int wv) {
    const PW p{opq64(pw0.ws)};
    unsigned char* shm = opq(shm_in);
    const int tid = MYTID, wid = __builtin_amdgcn_readfirstlane(tid >> 6), lane = tid & 63, fr = lane & 15, fq = lane >> 4;
    const int chain = unit >> 3, es = unit & 7;
    bf16_t* sS = (bf16_t*)shm;
    const bf16_t* GB = (const bf16_t*)(p.ws + WS_GB) + (size_t)chain * NCH * 16384;
    bf16_t* GN = (bf16_t*)(p.ws + WS_GN) + (size_t)chain * NCH * 16384;
    const float* GDEC = (const float*)(p.ws + WS_SM + SM_GDEC) + chain * NCH;
    f32x4 acc = (f32x4){0.f, 0.f, 0.f, 0.f};
    constexpr int PF = 4;
    bf16x8 an[PF][4]; u32x2 nn[PF]; float dn[PF];
    const size_t aoff = (size_t)(wid * 16 + fr) * 128 + fq * 8, noff = (size_t)(es * 16 + fr) * 128 + wid * 16 + fq * 4;
#pragma unroll
    for (int u = 0; u < PF; ++u) {
#pragma unroll
        for (int kk = 0; kk < 4; ++kk) an[u][kk] = *(const bf16x8*)(GB + (size_t)u * 16384 + aoff + kk * 32);
        nn[u] = *(const u32x2*)(GN + (size_t)u * 16384 + noff); dn[u] = GDEC[u];
    }
#pragma unroll 1
    for (int c0 = 0; c0 < NCH; c0 += PF) {
#pragma unroll
        for (int u = 0; u < PF; ++u) {
            const int c = c0 + u;
            bf16x8 a[4]; const u32x2 ncur = nn[u]; const float dcur = dn[u];
#pragma unroll
            for (int kk = 0; kk < 4; ++kk) a[kk] = an[u][kk];
            u32x2 sw; sw[0] = pk2(acc[0], acc[1]); sw[1] = pk2(acc[2], acc[3]);
            bf16_t* sb = sS + (c & 1) * (16 * 136);
            *(u32x2*)(sb + fr * 136 + wid * 16 + fq * 4) = sw;
            *(u32x2*)(GN + (size_t)c * 16384 + noff) = sw;
            if (c + PF < NCH) {
#pragma unroll
                for (int kk = 0; kk < 4; ++kk) an[u][kk] = *(const bf16x8*)(GB + (size_t)(c + PF) * 16384 + aoff + kk * 32);
                nn[u] = *(const u32x2*)(GN + (size_t)(c + PF) * 16384 + noff); dn[u] = GDEC[c + PF];
            }
            __syncthreads();
            acc[0] = dcur * acc[0] + __uint_as_float(ncur[0] << 16); acc[1] = dcur * acc[1] + __uint_as_float(ncur[0] & 0xffff0000u);
            acc[2] = dcur * acc[2] + __uint_as_float(ncur[1] << 16); acc[3] = dcur * acc[3] + __uint_as_float(ncur[1] & 0xffff0000u);
#pragma unroll
            for (int kk = 0; kk < 4; ++kk) acc = MFMA16(a[kk], ldfrag(sb, 136, 0, kk * 32, lane), acc);
        }
    }
    __syncthreads();
}

DEVI void gdn_out_item(const PW& pw0, int l, int item, unsigned char* shm_in, int wv) {
    const PW p{opq64(pw0.ws)};
    unsigned char* shm = opq(shm_in);
    const int tid = MYTID, wid = __builtin_amdgcn_readfirstlane(tid >> 6), lane = tid & 63, fr = lane & 15, fq = lane >> 4;
    const int j = item % NCH, h = (item / NCH) & 3, b = item / (NCH * 4);
    bf16_t* P = (bf16_t*)(p.ws + WS_P);
    bf16_t* sQ = (bf16_t*)shm;
    bf16_t* sK = (bf16_t*)(shm + 17408);
    bf16_t* sST = (bf16_t*)(shm + 34816);
    bf16_t* sW = (bf16_t*)(shm + 69632);
    bf16_t* sVN = (bf16_t*)(shm + 87040);
    bf16_t* sA2 = (bf16_t*)(shm + 105472);
    float* sO = (float*)(shm + 114688);
    float* sc = (float*)(shm + 148480);
#pragma unroll 1
    for (int dir = 0; dir < 2; ++dir) {
        const int c = dir_chunk(dir, j);
        const int it2 = ((dir * 4 + b) * 4 + h) * NCH + c;
        if (wid == 0) gdn_gates(p, P, l, b, c, h, dir, sc, lane);
        gdn_load(P, pin(19) + (size_t)l * 4 * 1536, b, c, h, dir, 1 | 2, sQ, sK, nullptr, nullptr, tid);
        const bf16_t* GS = (const bf16_t*)(p.ws + WS_GN) + (size_t)it2 * 16384;
        const bf16_t* GW = (const bf16_t*)(p.ws + WS_H) + (size_t)it2 * 8192;
        const bf16_t* GU = (const bf16_t*)(p.ws + WS_GU) + (size_t)it2 * 8192;
#pragma unroll
        for (int r = 0; r < 4; ++r) { const int idx = tid + 512 * r, row = idx >> 4, cg8 = (idx & 15) * 8; *(u32x4*)(sST + row * 136 + cg8) = *(const u32x4*)(GS + row * 128 + cg8); }
#pragma unroll
        for (int r = 0; r < 2; ++r) { const int idx = tid + 512 * r, row = idx >> 4, cg8 = (idx & 15) * 8; *(u32x4*)(sW + row * 136 + cg8) = *(const u32x4*)(GW + row * 128 + cg8); }
        __syncthreads();
        {
            const int mt = wid;
#pragma unroll
            for (int nt = 0; nt < 4; ++nt) {
                f32x4 a = (f32x4){0.f, 0.f, 0.f, 0.f};
#pragma unroll
                for (int kk = 0; kk < 4; ++kk) a = MFMA16(ldfrag(sST, 136, mt * 16, kk * 32, lane), ldfrag(sW, 136, nt * 16, kk * 32, lane), a);
                const int t = nt * 16 + fr, e0 = mt * 16 + fq * 4;
                const u32x2 ur = *(const u32x2*)(GU + t * 128 + e0);
                sVN[(e0 + 0) * 72 + t] = (bf16_t)f2bf(__uint_as_float(ur[0] << 16) - a[0]); sVN[(e0 + 1) * 72 + t] = (bf16_t)f2bf(__uint_as_float(ur[0] & 0xffff0000u) - a[1]);
                sVN[(e0 + 2) * 72 + t] = (bf16_t)f2bf(__uint_as_float(ur[1] << 16) - a[2]); sVN[(e0 + 3) * 72 + t] = (bf16_t)f2bf(__uint_as_float(ur[1] & 0xffff0000u) - a[3]);
            }
#pragma unroll
            for (int ti = 0; ti < 2; ++ti) {
                const int tile = wid * 2 + ti, m2 = tile >> 2, n2 = tile & 3;
                f32x4 a = (f32x4){0.f, 0.f, 0.f, 0.f};
#pragma unroll
                for (int kk = 0; kk < 4; ++kk) a = MFMA16(ldfrag(sQ, 136, m2 * 16, kk * 32, lane), ldfrag(sK, 136, n2 * 16, kk * 32, lane), a);
                const int s = n2 * 16 + fr;
#pragma unroll
                for (int jj = 0; jj < 4; ++jj) { const int t = m2 * 16 + fq * 4 + jj; sA2[t * 72 + s] = (bf16_t)f2bf(s <= t ? a[jj] * __expf(sc[t] - sc[s]) : 0.f); }
            }
        }
        __syncthreads();
        {
            const int nt = wid;
#pragma unroll
            for (int mt = 0; mt < 4; ++mt) {
                f32x4 a = (f32x4){0.f, 0.f, 0.f, 0.f};
#pragma unroll
                for (int kk = 0; kk < 4; ++kk) a = MFMA16(ldfrag(sQ, 136, mt * 16, kk * 32, lane), ldfrag(sST, 136, nt * 16, kk * 32, lane), a);
#pragma unroll
                for (int jj = 0; jj < 4; ++jj) a[jj] *= sc[128 + mt * 16 + fq * 4 + jj];
#pragma unroll
                for (int kk = 0; kk < 2; ++kk) a = MFMA16(ldfrag(sA2, 72, mt * 16, kk * 32, lane), ldfrag(sVN, 72, nt * 16, kk * 32, lane), a);
                const int e = nt * 16 + fr;
#pragma unroll
                for (int jj = 0; jj < 4; ++jj) { const int t = mt * 16 + fq * 4 + jj; const int i = dir ? 63 - t : t; if (dir) sO[i * 132 + e] += a[jj]; else sO[i * 132 + e] = a[jj]; }
            }
        }
        __syncthreads();
    }
    {
        const int i = tid >> 3, e0 = (tid & 7) * 16;
        float v[16], ss = 0.f;
#pragma unroll
        for (int e = 0; e < 16; ++e) { v[e] = sO[i * 132 + e0 + e]; ss += v[e] * v[e]; }
        ss += __shfl_xor(ss, 1, 64); ss += __shfl_xor(ss, 2, 64); ss += __shfl_xor(ss, 4, 64);
        const float rs = rsqrtf(ss * (1.f / 128.f) + EPS);
        const int row = tok_row(true, 0, b, j, i);
        bf16_t* zp = P + (size_t)row * DINP + C_DNZ + h * 128 + e0;
        const float* g = pin(22) + l * 128 + e0;
#pragma unroll
        for (int half = 0; half < 2; ++half) {
            float z[8]; unpack8(*(const u32x4*)(zp + half * 8), z); float o[8];
#pragma unroll
            for (int e = 0; e < 8; ++e) o[e] = v[half * 8 + e] * rs * g[half * 8 + e] * z[e];
            *(u32x4*)(zp + half * 8) = pack8(o);
        }
    }
    __syncthreads();
}

DEVI float ml_gates(const PW& p, const bf16_t* P, int l, int b, int c, int h, int dir, float* sc, int lane) {
    const int row = tok_row(false, dir, b, c, lane);
    const float ig = bf2f(P[(size_t)row * DINP + C_MLG + dir * 4 + h]) + pin(10)[l * 16 + dir * 4 + h];
    const float fg = bf2f(P[(size_t)row * DINP + C_MLG + (2 + dir) * 4 + h]) + pin(10)[l * 16 + (2 + dir) * 4 + h];
    float bb = logsig(fg);
#pragma unroll
    for (int o = 1; o < 64; o <<= 1) { const float t = __shfl_up(bb, o, 64); if (lane >= o) bb += t; }
    sc[lane] = bb; sc[64 + lane] = ig;
    return __shfl(bb, 63, 64);
}
DEVI void ml_prep_item(const PW& pw0, int l, int item, unsigned char* shm_in, int wv) {
    const PW p{opq64(pw0.ws)};
    unsigned char* shm = opq(shm_in);
    const int tid = MYTID, wid = __builtin_amdgcn_readfirstlane(tid >> 6), lane = tid & 63, fr = lane & 15, fq = lane >> 4;
    const int c = item % NCH, h = (item / NCH) & 3, b = (item / (NCH * 4)) & 3, dir = item / (NCH * 16);
    const bf16_t* P = (const bf16_t*)(p.ws + WS_P);
    bf16_t* sKT = (bf16_t*)shm;
    bf16_t* sVT = (bf16_t*)(shm + 9216);
    float* sc = (float*)(shm + 27648);
    if (wid == 0) {
        const float bT = ml_gates(p, P, l, b, c, h, dir, sc, lane);
        const float lw = bT - sc[lane] + sc[64 + lane];
        const float Mc = wmax(lw);
        sc[128 + lane] = __expf(lw - Mc);
        if (lane == 0) { float* msc = (float*)(p.ws + WS_SM + SM_MSC) + item * 2; msc[0] = bT; msc[1] = Mc; }
    }
    __syncthreads();
    {
        const int t = tid >> 3, cg8 = (tid & 7) * 8; const int row = tok_row(false, dir, b, c, t);
        float x[8]; unpack8(*(const u32x4*)(P + (size_t)row * DINP + C_MLK + h * 64 + cg8), x);
#pragma unroll
        for (int e = 0; e < 8; ++e) sKT[(cg8 + e) * 72 + t] = (bf16_t)f2bf(x[e]);
    }
#pragma unroll
    for (int r = 0; r < 2; ++r) {
        const int idx = tid + 512 * r, t = idx >> 4, cg8 = (idx & 15) * 8; const int row = tok_row(false, dir, b, c, t);
        float x[8]; unpack8(*(const u32x4*)(P + (size_t)row * DINP + C_MLV + h * 128 + cg8), x); const float w = sc[128 + t];
#pragma unroll
        for (int e = 0; e < 8; ++e) sVT[(cg8 + e) * 72 + t] = (bf16_t)f2bf(x[e] * w);
    }
    __syncthreads();
    float* KV = (float*)(p.ws + WS_Y) + (size_t)item * 8192;
    {
        const int nt = wid;
#pragma unroll
        for (int mt = 0; mt < 4; ++mt) {
            f32x4 a = (f32x4){0.f, 0.f, 0.f, 0.f};
#pragma unroll
            for (int kk = 0; kk < 2; ++kk) a = MFMA16(ldfrag(sKT, 72, mt * 16, kk * 32, lane), ldfrag(sVT, 72, nt * 16, kk * 32, lane), a);
            *(f32x4*)(KV + (nt * 16 + fr) * 64 + mt * 16 + fq * 4) = a;
        }
    }
    if (tid < 64) { float s = 0.f;
        for (int t = 0; t < 64; ++t) s += sc[128 + t] * bf2f(sKT[tid * 72 + t]);
        ((float*)(p.ws + WS_SM + SM_MN))[item * 64 + tid] = s; }
    __syncthreads();
}
DEVI void ml_seq(const PW& pw0, int gtid, int nthreads) {
    const PW p{opq64(pw0.ws)};
    const float* MSC = (const float*)(p.ws + WS_SM + SM_MSC);
    float* MM = (float*)(p.ws + WS_SM + SM_MM);
    for (int g = gtid; g < 32 * 4096 + 32 * 32; g += nthreads) {
        const bool isn = g >= 32 * 4096; const int gg = isn ? g - 32 * 4096 : g;
        const int chain = isn ? gg >> 5 : gg >> 12, e2 = isn ? gg & 31 : gg & 4095;
        float* base = isn ? (float*)(p.ws + WS_SM + SM_MN) + (size_t)chain * NCH * 64 + e2 * 2 : (float*)(p.ws + WS_Y) + (size_t)chain * NCH * 8192 + e2 * 2;
        const int stride = isn ? 64 : 8192;
        float m = 0.f; f32x2 C = (f32x2){0.f, 0.f};
        for (int c0 = 0; c0 < NCH; c0 += 17) {
            f32x2 kv[17]; f32x2 sc[17];
#pragma unroll
            for (int u = 0; u < 17; ++u) { kv[u] = *(const f32x2*)(base + (size_t)(c0 + u) * stride); sc[u] = *(const f32x2*)(MSC + (chain * NCH + c0 + u) * 2); }
#pragma unroll
            for (int u = 0; u < 17; ++u) {
                *(f32x2*)(base + (size_t)(c0 + u) * stride) = C;
                if (!isn && e2 == 0) MM[chain * NCH + c0 + u] = m;
                const float mn = fmaxf(sc[u][0] + m, sc[u][1]);
                const float a = __expf(sc[u][0] + m - mn), s = __expf(sc[u][1] - mn);
                C = C * a + kv[u] * s; m = mn;
            }
        }
    }
}
DEVI void ml_out_item(const PW& pw0, int l, int item, unsigned char* shm_in, int wv) {
    const PW p{opq64(pw0.ws)};
    unsigned char* shm = opq(shm_in);
    const int tid = MYTID, wid = __builtin_amdgcn_readfirstlane(tid >> 6), lane = tid & 63, fr = lane & 15, fq = lane >> 4;
    const int j = item % NCH, h = (item / NCH) & 3, b = item / (NCH * 4);
    bf16_t* P = (bf16_t*)(p.ws + WS_P);
    bf16_t* sQ = (bf16_t*)shm;
    bf16_t* sK = (bf16_t*)(shm + 9216);
    bf16_t* sVT = (bf16_t*)(shm + 18432);
    bf16_t* sCT = (bf16_t*)(shm + 36864);
    bf16_t* sS = (bf16_t*)(shm + 55296);
    float* sO = (float*)(shm + 64512);
    float* sc = (float*)(shm + 98304);
#pragma unroll 1
    for (int dir = 0; dir < 2; ++dir) {
        const int c = dir_chunk(dir, j);
        const int it2 = ((dir * 4 + b) * 4 + h) * NCH + c;
        if (wid == 0) {
            ml_gates(p, P, l, b, c, h, dir, sc, lane);
            const float m = ((const float*)(p.ws + WS_SM + SM_MM))[it2];
            const float bb = sc[lane];
            float pm = sc[64 + lane] - bb;
#pragma unroll
            for (int o = 1; o < 64; o <<= 1) { const float t = __shfl_up(pm, o, 64); if (lane >= o) pm = fmaxf(pm, t); }
            const float mt = bb + fmaxf(m, pm);
            sc[128 + lane] = mt; sc[192 + lane] = __expf(bb + m - mt);
            sc[320 + lane] = ((const float*)(p.ws + WS_SM + SM_MN))[it2 * 64 + lane];
        }
        {
            const int t = tid >> 3, cg8 = (tid & 7) * 8; const int row = tok_row(false, dir, b, c, t);
            float x[8]; unpack8(*(const u32x4*)(P + (size_t)row * DINP + C_MLQ + h * 64 + cg8), x);
#pragma unroll
            for (int e = 0; e < 8; ++e) x[e] *= 0.125f;
            *(u32x4*)(sQ + t * 72 + cg8) = pack8(x);
            *(u32x4*)(sK + t * 72 + cg8) = *(const u32x4*)(P + (size_t)row * DINP + C_MLK + h * 64 + cg8);
        }
#pragma unroll
        for (int r = 0; r < 2; ++r) {
            const int idx = tid + 512 * r, t = idx >> 4, cg8 = (idx & 15) * 8; const int row = tok_row(false, dir, b, c, t);
            float x[8]; unpack8(*(const u32x4*)(P + (size_t)row * DINP + C_MLV + h * 128 + cg8), x);
#pragma unroll
            for (int e = 0; e < 8; ++e) sVT[(cg8 + e) * 72 + t] = (bf16_t)f2bf(x[e]);
        }
        {
            const float* CT = (const float*)(p.ws + WS_Y) + (size_t)it2 * 8192;
#pragma unroll
            for (int r = 0; r < 4; ++r) { const int idx = tid + 512 * r, e = idx >> 4, d4 = (idx & 15) * 4; const f32x4 v = *(const f32x4*)(CT + e * 64 + d4);
                u32x2 w; w[0] = pk2(v[0], v[1]); w[1] = pk2(v[2], v[3]); *(u32x2*)(sCT + e * 72 + d4) = w; }
        }
        __syncthreads();
#pragma unroll
        for (int ti = 0; ti < 2; ++ti) {
            const int tile = wid * 2 + ti, m2 = tile >> 2, n2 = tile & 3;
            f32x4 a = (f32x4){0.f, 0.f, 0.f, 0.f};
#pragma unroll
            for (int kk = 0; kk < 2; ++kk) a = MFMA16(ldfrag(sQ, 72, m2 * 16, kk * 32, lane), ldfrag(sK, 72, n2 * 16, kk * 32, lane), a);
            const int s = n2 * 16 + fr;
#pragma unroll
            for (int jj = 0; jj < 4; ++jj) { const int t = m2 * 16 + fq * 4 + jj;
                sS[t * 72 + s] = (bf16_t)f2bf(s <= t ? a[jj] * __expf(sc[t] - sc[s] + sc[64 + s] - sc[128 + t]) : 0.f); }
        }
        __syncthreads();
        if (tid < 64) {
            float ds = 0.f, qn = 0.f;
            for (int s = 0; s < 64; ++s) { ds += bf2f(sS[tid * 72 + s]); qn += bf2f(sQ[tid * 72 + s]) * sc[320 + s]; }
            const float den = ds + sc[192 + tid] * qn;
            sc[256 + tid] = 1.f / fmaxf(fabsf(den), __expf(-sc[128 + tid]));
        }
        __syncthreads();
        {
            const int nt = wid;
#pragma unroll
            for (int mt = 0; mt < 4; ++mt) {
                f32x4 a = (f32x4){0.f, 0.f, 0.f, 0.f};
#pragma unroll
                for (int kk = 0; kk < 2; ++kk) a = MFMA16(ldfrag(sQ, 72, mt * 16, kk * 32, lane), ldfrag(sCT, 72, nt * 16, kk * 32, lane), a);
#pragma unroll
                for (int jj = 0; jj < 4; ++jj) a[jj] *= sc[192 + mt * 16 + fq * 4 + jj];
#pragma unroll
                for (int kk = 0; kk < 2; ++kk) a = MFMA16(ldfrag(sS, 72, mt * 16, kk * 32, lane), ldfrag(sVT, 72, nt * 16, kk * 32, lane), a);
                const int e = nt * 16 + fr;
#pragma unroll
                for (int jj = 0; jj < 4; ++jj) { const int t = mt * 16 + fq * 4 + jj; const int i = dir ? 63 - t : t; const float hv = a[jj] * sc[256 + t];
                    if (dir) sO[i * 132 + e] += hv; else sO[i * 132 + e] = hv; }
            }
        }
        __syncthreads();
    }
    {
        const int i = tid >> 3, e0 = (tid & 7) * 16;
        float v[16], ss = 0.f;
#pragma unroll
        for (int e = 0; e < 16; ++e) { v[e] = sO[i * 132 + e0 + e]; ss += v[e] * v[e]; }
        ss += __shfl_xor(ss, 1, 64); ss += __shfl_xor(ss, 2, 64); ss += __shfl_xor(ss, 4, 64);
        const float rs = rsqrtf(ss * (1.f / 128.f) + EPS);
        const int row = tok_row(false, 0, b, j, i);
        bf16_t* op = P + (size_t)row * DINP + C_MLO + h * 128 + e0;
        const float* g = pin(11) + l * 512 + h * 128 + e0;
#pragma unroll
        for (int half = 0; half < 2; ++half) {
            float z[8]; unpack8(*(const u32x4*)(op + half * 8), z); float o[8];
#pragma unroll
            for (int e = 0; e < 8; ++e) o[e] = v[half * 8 + e] * rs * g[half * 8 + e] * z[e];
            *(u32x4*)(op + half * 8) = pack8(o);
        }
    }
    __syncthreads();
}

DEVI void lru_item(const PW& pw0, int l, int item, int mode, unsigned char* shm_in, int wv) {
    const PW p{opq64(pw0.ws)};
    unsigned char* shm = opq(shm_in);
    const int tid = MYTID, wid = __builtin_amdgcn_readfirstlane(tid >> 6), lane = tid & 63, fr = lane & 15, fq = lane >> 4;
    const int j = item % NCH, b = item / NCH; const bool isctx = j < 4;
    bf16_t* P = (bf16_t*)(p.ws + WS_P);
    bf16_t* sX = (bf16_t*)shm;
    const int p0 = (isctx ? j : j - 4) * 64;
    const float* cw = pin(12) + (size_t)l * 4 * 512; const float* cb = pin(13) + (size_t)l * 512;
    {
        const int ch = lane * 8, i0 = wid * 8;
        f32x4 w[4][2];
#pragma unroll
        for (int jj = 0; jj < 4; ++jj) { w[jj][0] = *(const f32x4*)(cw + jj * 512 + ch); w[jj][1] = *(const f32x4*)(cw + jj * 512 + ch + 4); }
        const f32x4 b0 = *(const f32x4*)(cb + ch), b1 = *(const f32x4*)(cb + ch + 4);
        u32x4 raw[11];
#pragma unroll
        for (int r = 0; r < 11; ++r) { const int row = pos_row(false, b, isctx, p0 + i0 + r - 2);
            raw[r] = (u32x4){0u, 0u, 0u, 0u}; if (row >= 0) raw[r] = *(const u32x4*)(P + (size_t)row * DINP + C_LRX + ch); }
#pragma unroll
        for (int i = 0; i < 8; ++i) {
            float a[8] = {b0[0], b0[1], b0[2], b0[3], b1[0], b1[1], b1[2], b1[3]};
#pragma unroll
            for (int jj = 0; jj < 4; ++jj) { float x[8]; unpack8(raw[i + jj], x);
#pragma unroll
                for (int e = 0; e < 4; ++e) { a[e] += w[jj][0][e] * x[e]; a[4 + e] += w[jj][1][e] * x[4 + e]; } }
            *(u32x4*)(sX + (i0 + i) * 520 + ch) = pack8(a);
        }
    }
    __syncthreads();
    const int blk = wid;
    const bf16_t* WL = (const bf16_t*)(p.ws + WS_WLRU);
    float* LAGG = (float*)(p.ws + WS_SM + SM_LAGG);
#pragma unroll 1
    for (int n4 = 0; n4 < 4; ++n4) {
        const int ch = blk * 64 + n4 * 16 + fr;
        float hsum[4][4];
#pragma unroll
        for (int mt = 0; mt < 4; ++mt)
#pragma unroll
            for (int jj = 0; jj < 4; ++jj) hsum[mt][jj] = 0.f;
#pragma unroll
        for (int dir = 0; dir < 2; ++dir) {
            const bf16_t* wa = WL + (size_t)(0 * 16 + dir * 8 + blk) * 4096 + (n4 * 16 + fr) * 64 + fq * 8;
            const bf16_t* wx = WL + (size_t)(1 * 16 + dir * 8 + blk) * 4096 + (n4 * 16 + fr) * 64 + fq * 8;
            bf16x8 ba[2], bx[2];
#pragma unroll
            for (int kk = 0; kk < 2; ++kk) { ba[kk] = *(const bf16x8*)(wa + kk * 32); bx[kk] = *(const bf16x8*)(wx + kk * 32); }
            const float bias_a = pin(15)[(size_t)l * 1024 + dir * 512 + ch], bias_x = pin(17)[(size_t)l * 1024 + dir * 512 + ch];
            const float cl = -8.f * softplus(-pin(18)[(size_t)l * 1024 + dir * 512 + ch]);
            float av[4][4], bv[4][4];
#pragma unroll
            for (int mt = 0; mt < 4; ++mt) {
                f32x4 aa = (f32x4){0.f, 0.f, 0.f, 0.f}, ax = aa;
#pragma unroll
                for (int kk = 0; kk < 2; ++kk) { const bf16x8 af = ldfrag(sX, 520, mt * 16, blk * 64 + kk * 32, lane); aa = MFMA16(af, ba[kk], aa); ax = MFMA16(af, bx[kk], ax); }
#pragma unroll
                for (int jj = 0; jj < 4; ++jj) {
                    const int t = mt * 16 + fq * 4 + jj;
                    const float rr = sigm(aa[jj] + bias_a), ii = sigm(ax[jj] + bias_x), la = cl * rr;
                    const float ea = __expf(la);
                    av[mt][jj] = ea;
                    bv[mt][jj] = __builtin_amdgcn_sqrtf(fmaxf(1.f - ea * ea, 0.f)) * ii * bf2f(sX[t * 520 + ch]);
                }
            }
            const int c = dir_chunk(dir, j);
            const size_t aidx = (((size_t)dir * 4 + b) * NCH + c) * 512 + ch;
            float hin = mode ? LAGG[aidx * 2] : 0.f;
            float Pc = 1.f, Hc = 0.f;
#pragma unroll
            for (int mi = 0; mi < 4; ++mi) {
                const int mt = dir ? 3 - mi : mi;
                float Pl = 1.f, Hl = 0.f;
#pragma unroll
                for (int ji = 0; ji < 4; ++ji) { const int jj = dir ? 3 - ji : ji; Pl = av[mt][jj] * Pl; Hl = av[mt][jj] * Hl + bv[mt][jj]; }
                float Pq[4], Hq[4];
#pragma unroll
                for (int q = 0; q < 4; ++q) { Pq[q] = __shfl(Pl, fr + 16 * q, 64); Hq[q] = __shfl(Hl, fr + 16 * q, 64); }
                if (mode == 0) {
#pragma unroll
                    for (int qi = 0; qi < 4; ++qi) { const int q = dir ? 3 - qi : qi; Hc = Pq[q] * Hc + Hq[q]; Pc = Pq[q] * Pc; }
                } else {
                    float hh = hin;
                    float hme = hin;
#pragma unroll
                    for (int qi = 0; qi < 4; ++qi) { const int q = dir ? 3 - qi : qi; if (q == fq) hme = hh; hh = Pq[q] * hh + Hq[q]; }
                    hin = hh;
#pragma unroll
                    for (int ji = 0; ji < 4; ++ji) { const int jj = dir ? 3 - ji : ji; hme = av[mt][jj] * hme + bv[mt][jj]; hsum[mt][jj] += hme; }
                }
            }
            if (mode == 0 && fq == 0) { LAGG[aidx * 2] = Pc; LAGG[aidx * 2 + 1] = Hc; }
        }
        if (mode == 1) {
#pragma unroll
            for (int mt = 0; mt < 4; ++mt)
#pragma unroll
                for (int jj = 0; jj < 4; ++jj) { const int i = mt * 16 + fq * 4 + jj; const int row = pos_row(false, b, isctx, p0 + i);
                    bf16_t* yp = P + (size_t)row * DINP + C_LRY + ch; *yp = (bf16_t)f2bf(hsum[mt][jj] * bf2f(*yp)); }
        }
    }
    __syncthreads();
}
DEVI void lru_seq(const PW& pw0, int gtid, int nthreads) {
    const PW p{opq64(pw0.ws)};
    float* LAGG = (float*)(p.ws + WS_SM + SM_LAGG);
    for (int g = gtid; g < 4096; g += nthreads) {
        const int ch = g & 511, db = g >> 9;
        float h = 0.f;
        for (int c0 = 0; c0 < NCH; c0 += 17) {
            f32x2 v[17];
#pragma unroll
            for (int u = 0; u < 17; ++u) v[u] = *(const f32x2*)(LAGG + (((size_t)db * NCH + c0 + u) * 512 + ch) * 2);
#pragma unroll
            for (int u = 0; u < 17; ++u) { LAGG[(((size_t)db * NCH + c0 + u) * 512 + ch) * 2] = h; h = v[u][0] * h + v[u][1]; }
        }
    }
}

#define XB_TMO      128
#define XB_XCNT(j)  (256  + 64 * (j))
#define XB_XSUB(j)  (1280 + 64 * (j))
#define XB_XGEN(j)  (2304 + 64 * (j))
#define XB_TOP      3328
#define XB_TOPGEN   3392
#define XCD_BAR_WORDS 3456
#define XB_SPIN_CAP (1u << 22)
DEVI unsigned xb_ld(unsigned* p)              { return __hip_atomic_load(p, __ATOMIC_RELAXED, __HIP_MEMORY_SCOPE_AGENT); }
DEVI unsigned xb_add(unsigned* p, unsigned v) { return __hip_atomic_fetch_add(p, v, __ATOMIC_RELAXED, __HIP_MEMORY_SCOPE_AGENT); }
DEVI unsigned xb_xcc_id() { return (unsigned)__builtin_amdgcn_s_getreg((3 << 11) | 20) & 0xFu; }
#define XB_SPIN(cond, bar) do { unsigned _sp = 0; while (cond) { __builtin_amdgcn_s_sleep(1); \
    if ((++_sp & 255u) == 0u) { if (xb_ld(&(bar)[XB_TMO])) break; if (_sp > XB_SPIN_CAP) { atomicAdd(&(bar)[XB_TMO], 1u); break; } } } } while (0)
DEVI void xcd_barrier_complete(unsigned* bar, unsigned x, unsigned G, unsigned& nloc, unsigned& nx) {
    unsigned sum, cnt, mine, sp = 0u;
    for (;;) {
        sum = 0u; cnt = 0u; mine = 0u;
#pragma unroll
        for (unsigned j = 0; j < 16; ++j) { const unsigned c = xb_ld(&bar[XB_XCNT(j)]); sum += c; cnt += (c > 0u) ? 1u : 0u; mine = (j == x) ? c : mine; }
        if (sum == G) break;
        __builtin_amdgcn_s_sleep(1);
        if ((++sp & 255u) == 0u) { if (xb_ld(&bar[XB_TMO])) break; if (sp > XB_SPIN_CAP) { atomicAdd(&bar[XB_TMO], 1u); break; } }
    }
    nloc = mine > 0u ? mine : 1u; nx = cnt > 0u ? cnt : 1u;
}
DEVI void gsync(unsigned* bar, volatile LAS unsigned* st, int G, int wv) {
    asm volatile("s_waitcnt vmcnt(0)" ::: "memory");
    __syncthreads();
    const int ln = (int)__builtin_amdgcn_mbcnt_hi(~0u, __builtin_amdgcn_mbcnt_lo(~0u, 0u));
    if (wv == 0 && ln == 0) {
        __builtin_amdgcn_s_waitcnt(0);
        const unsigned x = xb_xcc_id();
        unsigned nloc = st[0], nx = st[1];
        if (nloc == 0u) { xcd_barrier_complete(bar, x, (unsigned)G, nloc, nx); st[0] = nloc; st[1] = nx; }
        const unsigned old = xb_add(&bar[XB_XSUB(x)], 1u);
        const unsigned gen = old / nloc;
        if (old + 1u == (gen + 1u) * nloc) {
            __builtin_amdgcn_fence(__ATOMIC_RELEASE, "agent");
            asm volatile("s_waitcnt vmcnt(0)" ::: "memory");
            const unsigned og = xb_add(&bar[XB_TOP], 1u);
            const unsigned tg = og / nx;
            if (og + 1u == (tg + 1u) * nx) xb_add(&bar[XB_TOPGEN], 1u);
            else XB_SPIN(xb_ld(&bar[XB_TOPGEN]) == tg, bar);
            __builtin_amdgcn_fence(__ATOMIC_ACQUIRE, "agent");
            xb_add(&bar[XB_XGEN(x)], 1u);
            asm volatile("s_waitcnt vmcnt(0)" ::: "memory");
        } else {
            XB_SPIN(xb_ld(&bar[XB_XGEN(x)]) == gen, bar);
            __builtin_amdgcn_fence(__ATOMIC_ACQUIRE, "agent");
            asm volatile("s_waitcnt vmcnt(0)" ::: "memory");
        }
    }
    __syncthreads();
}

__global__ void __launch_bounds__(512) mega(Params p) {
    extern __shared__ __attribute__((aligned(16))) unsigned char shm[];
    cg::grid_group grid = cg::this_grid();
    const int wv = __builtin_amdgcn_readfirstlane(threadIdx.x >> 6);
    const int G = gridDim.x, nwaves = G * 8, nthreads = G * 512;
#define TIDS const int tid = MYTID, wid = tid >> 6, lane = tid & 63, gwave = blockIdx.x * 8 + wid, gtid = blockIdx.x * 512 + tid; (void)gtid; (void)gwave; (void)lane;
    LAS unsigned char* lds = (LAS unsigned char*)shm;
#define WSQ unsigned char* ws = opq64(pw.ws); bf16_t* Hb = (bf16_t*)(ws + WS_H); bf16_t* Pb = (bf16_t*)(ws + WS_P); float* Yb = (float*)(ws + WS_Y); (void)Hb; (void)Pb; (void)Yb;

    const PW pw{p.ws};
    unsigned* bar = (unsigned*)p.ws;
    volatile LAS unsigned* xst = (volatile LAS unsigned*)((LAS unsigned char*)shm + (LDS_BYTES - 16));
    if (threadIdx.x == 0) { xst[0] = 0u; xst[1] = 0u; (void)xb_add(&bar[XB_XCNT(xb_xcc_id())], 1u); }
    __syncthreads();
    for (int rep = 0; rep < REP_CVT; ++rep) {
    mod_phase(pw, shm, wv);
    { TIDS convert_phase(pw, 0, shm, gwave, nwaves, wid, lane); }
    }
    grid.sync();
    { TIDS rowwise_phase(pw, 0, MTOT, 0, 0, 0.f, 0, 0, 0, 0, 0, gwave, nwaves, lane); }
    gsync(bar, xst, G, wv);

#pragma unroll 1
    for (int l = 0; l < DEPTH; ++l) {
        const bool last = l == DEPTH - 1;
#pragma unroll 1
        for (int f = 0; f < 2; ++f) {
            if (f == 1) {
                { WSQ pg8::Gemm g{Hb, (const bf16_t*)(ws + WS_WIN), 68, 31, D, D, 1, 0, 0, 0, 0, D, 0}; pg8::Order S; S.init(68, 31, 1, G, blockIdx.x);
                  pg8::EpiInProj E{Pb, DINP}; for (int rep = 0; rep < REP_GEMM; ++rep) pg8::gemm_phase(lds, g, S, E, wv); }
                gsync(bar, xst, G, wv);
#pragma unroll 1
                for (int rep2 = 0; rep2 < REP_PREPSEQ; ++rep2) {
#pragma unroll 1
                for (int rep = 0; rep < REP_PREP; ++rep)
                for (int it = blockIdx.x; it < 2176 + 2176 + 272; it += G) {
                    if (it < 2176) { for (int r3 = 0; r3 < REP_GDNP; ++r3) gdn_prep_item(pw, l, it, shm, wv); }
                    else if (it < 4352) { for (int r3 = 0; r3 < REP_MLP; ++r3) ml_prep_item(pw, l, it - 2176, shm, wv); }
                    else { for (int r3 = 0; r3 < REP_LRU0; ++r3) lru_item(pw, l, it - 4352, 0, shm, wv); }
                }
                gsync(bar, xst, G, wv);
                for (int u = blockIdx.x; u < 256; u += G) gdn_seq_unit(pw, u, shm, wv);
                { TIDS ml_seq(pw, gtid, nthreads); }
                { TIDS lru_seq(pw, gtid, nthreads); }
                gsync(bar, xst, G, wv);
                }
                for (int it = blockIdx.x; it < 1088 + 1088 + 272; it += G) {
                    int ii = it, kind = 0; if (ii >= 1088) { ii -= 1088; kind = 1; if (ii >= 1088) { ii -= 1088; kind = 2; } }
                    const int jj = ii % NCH;
                    if (last && jj < 4) continue;
                    if (kind == 0) gdn_out_item(pw, l, ii, shm, wv); else if (kind == 1) ml_out_item(pw, l, ii, shm, wv); else lru_item(pw, l, ii, 1, shm, wv);
                }
                gsync(bar, xst, G, wv);
                const int nM = last ? 64 : 68;
                { WSQ pg8::Gemm g{Pb, (const bf16_t*)(ws + WS_WBR), nM, 4, 512, DINP, 3, C_MLO, C_LRY, C_DNZ, D * 512, 512, 0}; pg8::Order S; S.init(nM, 4, 3, G, blockIdx.x);
                  pg8::EpiBranch E{Pb, Yb, Hb}; for (int rep = 0; rep < REP_GEMM; ++rep) pg8::gemm_phase(lds, g, S, E, wv); }
                gsync(bar, xst, G, wv);
                { WSQ pg8::Gemm g{Hb, (const bf16_t*)(ws + WS_WOUT), 64, 4, D, D, 1, 0, 0, 0, 0, D, 0}; pg8::Order S; S.init(64, 4, 1, G, blockIdx.x);
                  pg8::EpiF32 E{Yb, D, 0, 0}; for (int rep = 0; rep < REP_GEMM; ++rep) pg8::gemm_phase(lds, g, S, E, wv); }
                if (!last) { WSQ pg8::Gemm g{Hb, (const bf16_t*)(ws + WS_WOUT), 4, 4, 256, D, 4, 0, 0, 0, 256, D, 256}; pg8::Order S; S.init(4, 4, 4, G, blockIdx.x, 64, 1);
                  pg8::EpiF32 E{(float*)(ws + WS_GB), D, MLAT, (size_t)1024 * D}; pg8::gemm_phase(lds, g, S, E, wv); }
                gsync(bar, xst, G, wv);
                { TIDS rowwise_phase(pw, 1, nM * 256, l, 5, 1.f, 3, l, 4, 6, 4, gwave, nwaves, lane); }
                gsync(bar, xst, G, wv);
            }
            const int nM = (last && f == 1) ? 64 : 68;
            { WSQ pg8::Gemm g{Hb, (const bf16_t*)(ws + WS_WGU + f * SZ_WGU), nM, 22, D, D, 1, 0, 0, 0, 0, D, 0}; pg8::Order S; S.init(nM, 22, 1, G, blockIdx.x);
              pg8::EpiSwiGLU E{Pb, DFF}; for (int rep = 0; rep < REP_GU; ++rep) pg8::gemm_phase(lds, g, S, E, wv); }
            gsync(bar, xst, G, wv);
            { WSQ pg8::Gemm g{Pb, (const bf16_t*)(ws + WS_WDN + f * SZ_WDN), 64, 4, DFF, DFF, 1, 0, 0, 0, 0, DFF, 0}; pg8::Order S; S.init(64, 4, 1, G, blockIdx.x);
              pg8::EpiF32 E{Yb, D, 0, 0}; for (int rep = 0; rep < REP_DN; ++rep) pg8::gemm_phase(lds, g, S, E, wv); }
            if (nM == 68) { WSQ pg8::Gemm g{Pb, (const bf16_t*)(ws + WS_WDN + f * SZ_WDN), 4, 4, 256, DFF, 11, 0, 0, 0, 256, DFF, 256}; pg8::Order S; S.init(4, 4, 11, G, blockIdx.x, 64, 1);
              pg8::EpiF32 E{(float*)(ws + WS_GB), D, MLAT, (size_t)1024 * D}; for (int rep = 0; rep < REP_DNC; ++rep) pg8::gemm_phase(lds, g, S, E, wv); }
            gsync(bar, xst, G, wv);
            if (f == 0) { TIDS rowwise_phase(pw, 1, nM * 256, l, 2, 0.5f, 1, l, 2, 3, 11, gwave, nwaves, lane); }
            else if (!last) { { TIDS rowwise_phase(pw, 1, nM * 256, l, 8, 0.5f, 5, l + 1, 0, 0, 11, gwave, nwaves, lane); } for (int rep = 0; rep < REP_CVT; ++rep) { TIDS convert_phase(pw, l + 1, shm, gwave, nwaves, wid, lane); } }
            else { TIDS rowwise_phase(pw, 2, MLAT, l, 8, 0.5f, 5, 0, 0, 0, 0, gwave, nwaves, lane); }
            gsync(bar, xst, G, wv);
        }
    }
}

extern "C" void kernel_launch(void* const* d_in, const int* in_sizes, int n_in, void* d_out, int out_size, void* d_ws, size_t ws_size, hipStream_t stream) {
    static int grid = 0;
    if (grid == 0) {
        if (n_in != 25 || ws_size < WS_END) { fprintf(stderr, "kernel_launch: unexpected n_in %d or ws_size %zu (need %zu)\n", n_in, ws_size, (size_t)WS_END); grid = -1; return; }
        int dev = 0, cus = 0, per_cu = 0;
        hipGetDevice(&dev); hipDeviceGetAttribute(&cus, hipDeviceAttributeMultiprocessorCount, dev);
        if (hipFuncSetAttribute((const void*)mega, hipFuncAttributeMaxDynamicSharedMemorySize, LDS_BYTES) != hipSuccess) { fprintf(stderr, "kernel_launch: hipFuncSetAttribute failed\n"); grid = -1; return; }
        if (hipOccupancyMaxActiveBlocksPerMultiprocessor(&per_cu, (const void*)mega, 512, LDS_BYTES) != hipSuccess || per_cu < 1) { fprintf(stderr, "kernel_launch: occupancy query failed (%d)\n", per_cu); per_cu = 1; }
        (void)hipGetLastError();
        grid = cus * per_cu;
    }
    if (grid < 0) return;
    if (hipMemsetAsync(d_ws, 0, 16384, stream) != hipSuccess) { fprintf(stderr, "kernel_launch: memset failed\n"); return; }
    Params p{};
    for (int i = 0; i < 25; ++i) p.in[i] = (const float*)d_in[i];
    p.out = (float*)d_out; p.ws = (unsigned char*)d_ws;
    void* args[] = {&p};
    hipError_t e = hipLaunchCooperativeKernel((const void*)mega, dim3(grid), dim3(512), args, LDS_BYTES, stream);
    if (e != hipSuccess) fprintf(stderr, "cooperative launch failed: %s (grid %d)\n", hipGetErrorString(e), grid);
}
```

```cpp
#include <hip/hip_runtime.h>
#include <hip/hip_cooperative_groups.h>
#include <cstdio>
namespace cg = cooperative_groups;

#define LAS __attribute__((address_space(3)))
#define DEVI __device__ __forceinline__
typedef unsigned short bf16_t;
typedef short bf16x8 __attribute__((ext_vector_type(8)));
typedef float f32x4 __attribute__((ext_vector_type(4)));
typedef float f32x2 __attribute__((ext_vector_type(2)));
typedef unsigned u32x4 __attribute__((ext_vector_type(4)));
typedef unsigned u32x2 __attribute__((ext_vector_type(2)));

constexpr int D = 1024, NBATCH = 4, SEQ = 4096, CTXL = 256, DEPTH = 4, DFF = 2816, DINP = 7936;
constexpr int MLAT = NBATCH * SEQ, MTOT = MLAT + NBATCH * CTXL;
constexpr int NCH = 68;
constexpr int C_MLQ = 0, C_MLK = 256, C_MLV = 512, C_MLO = 1024, C_MLG = 1536, C_LRX = 1552, C_LRY = 2064,
              C_DNQ = 2576, C_DNZ = 4112, C_DNBA = 4624, C_GATE = 4640, C_END = 7712;
constexpr float EPS = 1e-6f;

constexpr size_t SZ_WGU = (size_t)2 * DFF * D * 2, SZ_WDN = (size_t)D * DFF * 2;
constexpr size_t WS_MOD = 16384;
constexpr size_t WS_WGU = 1u << 20;
constexpr size_t WS_WDN = WS_WGU + 2 * SZ_WGU;
constexpr size_t WS_WIN = WS_WDN + 2 * SZ_WDN;
constexpr size_t WS_WBR = WS_WIN + (size_t)DINP * D * 2;
constexpr size_t WS_WOUT = WS_WBR + (size_t)3 * D * 512 * 2;
constexpr size_t WS_WLRU = WS_WOUT + (size_t)D * D * 2;
constexpr size_t WS_X = WS_WLRU + (size_t)32 * 64 * 64 * 2;
constexpr size_t WS_H = WS_X + (size_t)MTOT * D * 4;
constexpr size_t WS_Y = WS_H + (size_t)MTOT * D * 2;
constexpr size_t WS_P = WS_Y + (size_t)MTOT * D * 4;
constexpr size_t WS_GU = WS_P + (size_t)MTOT * DINP * 2;
constexpr size_t WS_GB = WS_GU + (size_t)2176 * 64 * 128 * 2;
constexpr size_t WS_GN = WS_GB + (size_t)2176 * 128 * 128 * 2;
constexpr size_t WS_SM = WS_GN + (size_t)2176 * 128 * 128 * 2;
constexpr size_t SM_GDEC = 0, SM_MN = 16384, SM_MSC = SM_MN + 2176 * 64 * 4, SM_MM = SM_MSC + 2176 * 8, SM_LAGG = SM_MM + 2176 * 4 + 1024;
constexpr size_t WS_YC = WS_SM + SM_LAGG + (size_t)2 * 4 * NCH * 512 * 2 * 4 + 4096;
constexpr size_t WS_END = WS_YC + (size_t)1024 * D * 4;
constexpr int LDS_BYTES = 155648;
constexpr int REP_GU = 1, REP_DN = 1, REP_DNC = 1, REP_GEMM = 1, DRY_ROW = 0, REP_PREP = 1, REP_PREPSEQ = 1, REP_CVT = 1, REP_GDNP = 1, REP_MLP = 1, REP_LRU0 = 1;

struct Params { const float* in[25]; float* out; unsigned char* ws; };
struct PW { unsigned char* ws; };

#define CAS __attribute__((address_space(4)))
DEVI const float* pin(int i) { const CAS char* k = (const CAS char*)__builtin_amdgcn_kernarg_segment_ptr(); return *(const float* const volatile CAS*)(k + 8 * i); }
DEVI int opaque(int v) { asm volatile("" : "+v"(v)); return v; }
DEVI unsigned char* opq(unsigned char* p) { unsigned v = (unsigned)(size_t)(LAS unsigned char*)p; asm volatile("" : "+s"(v)); return (unsigned char*)(LAS unsigned char*)(size_t)v; }
DEVI LAS unsigned char* opql(LAS unsigned char* p) { unsigned v = (unsigned)(size_t)p; asm volatile("" : "+s"(v)); return (LAS unsigned char*)(size_t)v; }
DEVI unsigned char* opq64(unsigned char* p) { unsigned long long v = (unsigned long long)p; asm volatile("" : "+s"(v)); return (unsigned char*)v; }
#define MYTID opaque(wv * 64 + (int)__builtin_amdgcn_mbcnt_hi(~0u, __builtin_amdgcn_mbcnt_lo(~0u, 0u)))
DEVI float bf2f(bf16_t v) { return __uint_as_float(((unsigned)v) << 16); }
DEVI unsigned f2bf(float f) { unsigned u = __float_as_uint(f); return (u + 0x7fffu + ((u >> 16) & 1u)) >> 16; }
DEVI unsigned pk2(float lo, float hi) { return f2bf(lo) | (f2bf(hi) << 16); }
DEVI float sigm(float x) { return __builtin_amdgcn_rcpf(1.f + __expf(-x)); }
DEVI float silu(float x) { return x * sigm(x); }
DEVI float softplus(float x) { return x > 20.f ? x : log1pf(__expf(x)); }
DEVI float logsig(float x) { return fminf(x, 0.f) - log1pf(__expf(-fabsf(x))); }
DEVI float gelu_t(float x) { float u = 0.7978845608f * (x + 0.044715f * x * x * x); float e = __expf(2.f * u); return x * (1.f - __builtin_amdgcn_rcpf(e + 1.f)); }
DEVI float wsum(float v) { for (int o = 32; o > 0; o >>= 1) v += __shfl_xor(v, o, 64); return v; }
DEVI float wmax(float v) { for (int o = 32; o > 0; o >>= 1) v = fmaxf(v, __shfl_xor(v, o, 64)); return v; }
DEVI void unpack8(u32x4 r, float* f) {
    f[0] = __uint_as_float(r[0] << 16); f[1] = __uint_as_float(r[0] & 0xffff0000u); f[2] = __uint_as_float(r[1] << 16); f[3] = __uint_as_float(r[1] & 0xffff0000u);
    f[4] = __uint_as_float(r[2] << 16); f[5] = __uint_as_float(r[2] & 0xffff0000u); f[6] = __uint_as_float(r[3] << 16); f[7] = __uint_as_float(r[3] & 0xffff0000u);
}
DEVI u32x4 pack8(const float* f) { u32x4 r; r[0] = pk2(f[0], f[1]); r[1] = pk2(f[2], f[3]); r[2] = pk2(f[4], f[5]); r[3] = pk2(f[6], f[7]); return r; }
DEVI bf16x8 ldfrag(const bf16_t* base, int ld, int row0, int k0, int lane) { return *(const bf16x8*)(base + (row0 + (lane & 15)) * ld + k0 + (lane >> 4) * 8); }
DEVI int tix(int row, int col) { return row * 72 + ((((col >> 3) + (row >> 3)) & 7) << 3) + (col & 7); }
DEVI bf16x8 ldfragT(const bf16_t* base, int row0, int k0, int lane) { const int r = row0 + (lane & 15), lg = (k0 >> 3) + (lane >> 4); return *(const bf16x8*)(base + r * 72 + (((lg + (r >> 3)) & 7) << 3)); }
DEVI void lbar() { asm volatile("s_waitcnt lgkmcnt(0)" ::: "memory"); __builtin_amdgcn_s_barrier(); asm volatile("" ::: "memory"); }
#define MFMA16(a, b, c) __builtin_amdgcn_mfma_f32_16x16x32_bf16(a, b, c, 0, 0, 0)

namespace pg8 {
constexpr int BM = 256, BK = 64, HALF = 128, HTB = HALF * BK * 2, NXCD = 8, WGM = 8;
DEVI int lds_byte(int r, int c) { const int st = (r >> 4) * 2 + (c >> 5), rr = r & 15, cc = c & 31, ob = rr * 64 + cc * 2; return st * 1024 + (ob ^ (((ob >> 9) & 1) << 5)); }
DEVI void stage_rc(int b, int& R, int& C) { const int st = b / 1024, sb = b % 1024, swz = sb ^ (((sb >> 9) & 1) << 5); R = (st >> 1) * 16 + swz / 64; C = (st & 1) * 32 + (swz % 64) / 2; }
DEVI int perm32(int rho) { const int n = rho >> 4, i = rho & 15; return 8 * (i >> 2) + 4 * n + (i & 3); }
struct Unit { int pm, pn, z; };
struct Gemm { const bf16_t* A; const bf16_t* Bt; int nM, nN, K, lda, nz, zA0, zA1, zA2, zB; int ldb, zAstep; };
struct Order {
    int nM, nN, nwg, G, c, nz, pm0, spread;
    DEVI void init(int nM_, int nN_, int nz_, int G_, int c_, int pm0_ = 0, int spread_ = 0) { nM = nM_; nN = nN_; nwg = nM * nN; G = G_; c = c_; nz = nz_; pm0 = pm0_; spread = spread_; }
    DEVI bool next(int i, Unit& u) const {
        int ti = i, z = 0; long L;
        if (spread) { L = (long)i * G + c; if (L >= (long)nwg * nz) return false; z = (int)(L / nwg); L -= (long)z * nwg; }
        else { if (nz == 3) { ti = i / 3; z = i - ti * 3; } L = (long)ti * G + c; if (L >= nwg) return false; }
        int wgid = (int)L; { const int q = nwg / NXCD, r = nwg % NXCD, xcd = wgid % NXCD, off = wgid / NXCD; wgid = (xcd < r ? xcd * (q + 1) : r * (q + 1) + (xcd - r) * q) + off; }
        const int nig = WGM * nN, gid = wgid / nig, fm = gid * WGM, gsz = (nM - fm) < WGM ? (nM - fm) : WGM;
        u.pm = pm0 + fm + ((wgid % nig) % gsz); u.pn = (wgid % nig) / gsz; u.z = z; return true;
    }
};

template <class Epi>
DEVI void gemm_phase(LAS unsigned char* lds_in, const Gemm g, const Order& S, const Epi& E, int wv) {
    LAS unsigned char* lds = opql(lds_in);
    const int tid = MYTID, wid = __builtin_amdgcn_readfirstlane(tid >> 6), lane = tid & 63, wr = wid >> 2, wc = wid & 3, fr = lane & 15, fq = lane >> 4;
    const int K = g.K, nt = K / BK, lda = g.lda, ldb = g.ldb;
    unsigned voffA[2], voffB[2];
#pragma unroll
    for (int i = 0; i < 2; ++i) { int R, C; stage_rc(tid * 16 + i * 8192, R, C); const int Rb = Epi::PERM ? ((R & ~31) + perm32(R & 31)) : R;
        voffA[i] = (unsigned)(R * lda + C) * 2u; voffB[i] = (unsigned)(Rb * ldb + C) * 2u; }
    const size_t kstep = (size_t)(BK * 2);
    const size_t hstepA = (size_t)HALF * lda * 2, hstepB = (size_t)HALF * ldb * 2;
    const unsigned ldsw = (unsigned)wid * 1024u;
    const int aoff = lds_byte(wr * 64 + fr, fq * 8), boff = lds_byte(wc * 32 + fr, fq * 8);
#define PG8_SA(b, h) (((b) * 2 + (h)) * HTB)
#define PG8_SB(b, h) ((4 + (b) * 2 + (h)) * HTB)
#define PG8_STAGE(bufoff, gbase, voff) do { _Pragma("unroll") for (int _i = 0; _i < 2; ++_i) \
        __builtin_amdgcn_global_load_lds((const unsigned*)((const char*)(gbase) + (voff)[_i]), (LAS unsigned*)(lds + (bufoff) + ldsw + _i * 8192), 16, 0, 0); } while (0)
#define PG8_LDA(dst, b, h) do { _Pragma("unroll") for (int m = 0; m < 4; ++m) _Pragma("unroll") for (int k = 0; k < 2; ++k) dst[m][k] = *(const LAS bf16x8*)(lds + PG8_SA(b, h) + aoff + m * 2048 + k * 1024); } while (0)
#define PG8_LDB(dst, b, h) do { _Pragma("unroll") for (int n = 0; n < 2; ++n) _Pragma("unroll") for (int k = 0; k < 2; ++k) dst[n][k] = *(const LAS bf16x8*)(lds + PG8_SB(b, h) + boff + n * 2048 + k * 1024); } while (0)
#define PG8_MMA(ai, bj, At, Bt) do { __builtin_amdgcn_s_setprio(1); _Pragma("unroll") for (int m = 0; m < 4; ++m) _Pragma("unroll") for (int n = 0; n < 2; ++n) _Pragma("unroll") for (int k = 0; k < 2; ++k) \
        acc[ai][bj][m][n] = __builtin_amdgcn_mfma_f32_16x16x32_bf16(Bt[n][k], At[m][k], acc[ai][bj][m][n], 0, 0, 0); __builtin_amdgcn_s_setprio(0); } while (0)
#define PG8_WAIT_V(n) asm volatile("s_waitcnt vmcnt(" #n ")" ::: "memory")
#define PG8_WAIT_L(n) asm volatile("s_waitcnt lgkmcnt(" #n ")" ::: "memory")
#define PG8_BAR __builtin_amdgcn_s_barrier()
#define PG8_SCHED __builtin_amdgcn_sched_barrier(0)
#define PG8_PA(u) ((const char*)g.A + ((size_t)(g.nz == 3 ? ((u).z == 0 ? g.zA0 : ((u).z == 1 ? g.zA1 : g.zA2)) : (u).z * g.zAstep) + (size_t)(u).pm * BM * lda) * 2)
#define PG8_PB(u) ((const char*)g.Bt + ((size_t)(u).z * g.zB + (size_t)(u).pn * BM * ldb) * 2)
    Unit cur, nxt; int ui = 0;
    if (!S.next(0, cur)) return;
    f32x4 acc[2][2][4][2];
#pragma unroll
    for (int a = 0; a < 2; ++a)
#pragma unroll
        for (int b = 0; b < 2; ++b)
#pragma unroll
            for (int m = 0; m < 4; ++m)
#pragma unroll
                for (int n = 0; n < 2; ++n) acc[a][b][m][n] = (f32x4){0.f, 0.f, 0.f, 0.f};
    bf16x8 At[4][2], B0[2][2], B1[2][2];
    const char* cA = PG8_PA(cur); const char* cB = PG8_PB(cur);
    PG8_STAGE(PG8_SB(0, 0), cB, voffB); PG8_STAGE(PG8_SA(0, 0), cA, voffA); PG8_STAGE(PG8_SB(0, 1), cB + hstepB, voffB); PG8_STAGE(PG8_SA(0, 1), cA + hstepA, voffA);
    if (wr == 1) PG8_BAR;
    PG8_WAIT_V(4); PG8_BAR;
    PG8_STAGE(PG8_SB(1, 0), cB + kstep, voffB); PG8_STAGE(PG8_SA(1, 0), cA + kstep, voffA); PG8_STAGE(PG8_SB(1, 1), cB + hstepB + kstep, voffB);
    PG8_WAIT_V(6); PG8_BAR;
    for (;;) {
        const bool has_next = S.next(ui + 1, nxt);
        const char* nA = has_next ? PG8_PA(nxt) : cA; const char* nB = has_next ? PG8_PB(nxt) : cB;
        for (int t = 0; t < nt; t += 2) {
            const bool last = (t == nt - 2);
            const char* a1 = cA + (size_t)(t + 1) * kstep;
            const char* a2 = last ? nA : cA + (size_t)(t + 2) * kstep; const char* b2 = last ? nB : cB + (size_t)(t + 2) * kstep;
            const char* a3 = a2 + kstep; const char* b3 = b2 + kstep;
            PG8_LDB(B0, 0, 0); PG8_SCHED; PG8_LDA(At, 0, 0); PG8_STAGE(PG8_SA(1, 1), a1 + hstepA, voffA);
            PG8_WAIT_L(8); PG8_BAR; PG8_WAIT_L(0); PG8_MMA(0, 0, At, B0); PG8_BAR; PG8_SCHED;
            PG8_LDB(B1, 0, 1); PG8_STAGE(PG8_SB(0, 0), b2, voffB);
            PG8_BAR; PG8_WAIT_L(0); PG8_MMA(0, 1, At, B1); PG8_BAR;
            PG8_LDA(At, 0, 1); PG8_STAGE(PG8_SA(0, 0), a2, voffA);
            PG8_BAR; PG8_WAIT_L(0); PG8_MMA(1, 0, At, B0); PG8_BAR; PG8_SCHED;
            PG8_STAGE(PG8_SB(0, 1), b2 + hstepB, voffB);
            PG8_WAIT_V(6); PG8_BAR; PG8_MMA(1, 1, At, B1); PG8_BAR;
            PG8_LDB(B0, 1, 0); PG8_SCHED; PG8_LDA(At, 1, 0); PG8_STAGE(PG8_SA(0, 1), a2 + hstepA, voffA);
            PG8_WAIT_L(8); PG8_BAR; PG8_WAIT_L(0); PG8_MMA(0, 0, At, B0); PG8_BAR; PG8_SCHED;
            PG8_LDB(B1, 1, 1); PG8_STAGE(PG8_SB(1, 0), b3, voffB);
            PG8_BAR; PG8_WAIT_L(0); PG8_MMA(0, 1, At, B1); PG8_BAR;
            PG8_LDA(At, 1, 1); PG8_STAGE(PG8_SA(1, 0), a3, voffA);
            PG8_BAR; PG8_WAIT_L(0); PG8_MMA(1, 0, At, B0); PG8_BAR; PG8_SCHED;
            PG8_STAGE(PG8_SB(1, 1), b3 + hstepB, voffB);
            PG8_WAIT_V(6); PG8_BAR; PG8_MMA(1, 1, At, B1); PG8_BAR;
        }
        E(acc, cur, wr, wc, fr, fq);
        if (!has_next) break;
#pragma unroll
        for (int a = 0; a < 2; ++a)
#pragma unroll
            for (int b = 0; b < 2; ++b)
#pragma unroll
                for (int m = 0; m < 4; ++m)
#pragma unroll
                    for (int n = 0; n < 2; ++n) acc[a][b][m][n] = (f32x4){0.f, 0.f, 0.f, 0.f};
        cur = nxt; cA = nA; cB = nB; ++ui;
    }
    PG8_WAIT_V(0);
    if (wr == 0) PG8_BAR;
    PG8_BAR;
#undef PG8_SA
#undef PG8_SB
#undef PG8_STAGE
#undef PG8_LDA
#undef PG8_LDB
#undef PG8_MMA
#undef PG8_WAIT_V
#undef PG8_WAIT_L
#undef PG8_BAR
#undef PG8_SCHED
#undef PG8_PA
#undef PG8_PB
}

struct EpiF32 {
    static constexpr bool PERM = false;
    float* C; int ldc; int row_base; size_t zstride;
    DEVI void operator()(const f32x4 (&acc)[2][2][4][2], const Unit& u, int wr, int wc, int fr, int fq) const {
        const int row0 = u.pm * BM + wr * 64 + fr - row_base, col0 = u.pn * BM + wc * 32 + 4 * fq;
#pragma unroll
        for (int ai = 0; ai < 2; ++ai)
#pragma unroll
            for (int m = 0; m < 4; ++m) { float* rowp = C + (size_t)u.z * zstride + (size_t)(row0 + ai * HALF + m * 16) * ldc + col0;
#pragma unroll
                for (int bj = 0; bj < 2; ++bj)
#pragma unroll
                    for (int n = 0; n < 2; ++n) *(f32x4*)(rowp + bj * HALF + n * 16) = acc[ai][bj][m][n]; }
    }
};
struct EpiBf16Y {
    static constexpr bool PERM = true;
    bf16_t* O; int ldc;
    DEVI void operator()(const f32x4 (&acc)[2][2][4][2], const Unit& u, int wr, int wc, int fr, int fq) const {
        const int row0 = u.pm * BM + wr * 64 + fr;
#pragma unroll
        for (int bj = 0; bj < 2; ++bj) { const int c0 = u.pn * BM + bj * HALF + wc * 32 + 8 * fq;
#pragma unroll
            for (int ai = 0; ai < 2; ++ai)
#pragma unroll
                for (int m = 0; m < 4; ++m) { float v[8];
#pragma unroll
                    for (int n = 0; n < 2; ++n)
#pragma unroll
                        for (int i = 0; i < 4; ++i) v[n * 4 + i] = acc[ai][bj][m][n][i];
                    *(u32x4*)(O + (size_t)(row0 + ai * HALF + m * 16) * ldc + c0) = pack8(v); } }
    }
};
struct EpiAtomic {
    static constexpr bool PERM = false;
    float* C; int ldc; int row_base;
    DEVI void operator()(const f32x4 (&acc)[2][2][4][2], const Unit& u, int wr, int wc, int fr, int fq) const {
        const int row0 = u.pm * BM + wr * 64 + fr - row_base, col0 = u.pn * BM + wc * 32 + 4 * fq;
#pragma unroll
        for (int ai = 0; ai < 2; ++ai)
#pragma unroll
            for (int m = 0; m < 4; ++m) { float* rowp = C + (size_t)(row0 + ai * HALF + m * 16) * ldc + col0;
#pragma unroll
                for (int bj = 0; bj < 2; ++bj)
#pragma unroll
                    for (int n = 0; n < 2; ++n)
#pragma unroll
                        for (int e = 0; e < 4; ++e) __hip_atomic_fetch_add(rowp + bj * HALF + n * 16 + e, acc[ai][bj][m][n][e], __ATOMIC_RELAXED, __HIP_MEMORY_SCOPE_AGENT); }
    }
};
struct EpiSwiGLU {
    static constexpr bool PERM = false;
    bf16_t* O; int ldc;
    DEVI void operator()(const f32x4 (&acc)[2][2][4][2], const Unit& u, int wr, int wc, int fr, int fq) const {
        const int row0 = u.pm * BM + wr * 64 + fr, col0 = u.pn * 128 + wc * 32 + 8 * fq;
#pragma unroll
        for (int ai = 0; ai < 2; ++ai)
#pragma unroll
            for (int m = 0; m < 4; ++m) {
                float v[8];
#pragma unroll
                for (int bj = 0; bj < 2; ++bj)
#pragma unroll
                    for (int i = 0; i < 4; ++i) { const float gt = acc[ai][bj][m][0][i], up = acc[ai][bj][m][1][i]; v[bj * 4 + i] = silu(gt) * up; }
                *(u32x4*)(O + (size_t)(row0 + ai * HALF + m * 16) * ldc + col0) = pack8(v);
            }
    }
};
struct EpiInProj {
    static constexpr bool PERM = true;
    bf16_t* O; int ldc;
    DEVI void operator()(const f32x4 (&acc)[2][2][4][2], const Unit& u, int wr, int wc, int fr, int fq) const {
        const int row0 = u.pm * BM + wr * 64 + fr;
#pragma unroll
        for (int bj = 0; bj < 2; ++bj) {
            const int c0 = u.pn * BM + bj * HALF + wc * 32 + 8 * fq;
            int kind = 0;
            if (c0 >= C_MLO && c0 < C_MLG) kind = 1; else if (c0 >= C_LRY && c0 < C_DNQ) kind = 2; else if (c0 >= C_DNZ && c0 < C_DNBA) kind = 3; else if (c0 >= C_GATE) kind = 1;
#define INPROJ_STORE(FN) _Pragma("unroll") for (int ai = 0; ai < 2; ++ai) _Pragma("unroll") for (int m = 0; m < 4; ++m) { float v[8]; \
                _Pragma("unroll") for (int n = 0; n < 2; ++n) _Pragma("unroll") for (int i = 0; i < 4; ++i) { const float x = acc[ai][bj][m][n][i]; v[n * 4 + i] = FN; } \
                *(u32x4*)(O + (size_t)(row0 + ai * HALF + m * 16) * ldc + c0) = pack8(v); }
            if (kind == 0) { INPROJ_STORE(x) } else if (kind == 1) { INPROJ_STORE(sigm(x)) } else if (kind == 2) { INPROJ_STORE(gelu_t(x)) } else { INPROJ_STORE(silu(x)) }
#undef INPROJ_STORE
        }
    }
};
struct EpiBranch {
    static constexpr bool PERM = false;
    const bf16_t* P; float* T; bf16_t* U;
    DEVI void operator()(const f32x4 (&acc)[2][2][4][2], const Unit& u, int wr, int wc, int fr, int fq) const {
        const int row0 = u.pm * BM + wr * 64 + fr, col0 = u.pn * BM + wc * 32 + 4 * fq; const int z = u.z;
#pragma unroll
        for (int ai = 0; ai < 2; ++ai)
#pragma unroll
            for (int m = 0; m < 4; ++m) { const size_t row = (size_t)(row0 + ai * HALF + m * 16);
#pragma unroll
                for (int bj = 0; bj < 2; ++bj)
#pragma unroll
                    for (int n = 0; n < 2; ++n) { const int col = col0 + bj * HALF + n * 16;
                        const u32x2 gr = *(const u32x2*)(P + row * DINP + C_GATE + z * D + col);
                        f32x4 a = acc[ai][bj][m][n];
                        a[0] *= __uint_as_float(gr[0] << 16); a[1] *= __uint_as_float(gr[0] & 0xffff0000u); a[2] *= __uint_as_float(gr[1] << 16); a[3] *= __uint_as_float(gr[1] & 0xffff0000u);
                        float* tp = T + row * D + col;
                        if (z == 0) *(f32x4*)tp = a;
                        else if (z == 1) { f32x4 o = *(f32x4*)tp; *(f32x4*)tp = o + a; }
                        else { f32x4 o = *(f32x4*)tp; o = o + a; u32x2 w; w[0] = pk2(o[0], o[1]); w[1] = pk2(o[2], o[3]); *(u32x2*)(U + row * D + col) = w; }
                    } }
    }
};
}

DEVI int tok_row(bool gdn, int dir, int b, int c, int t) {
    if (c < 4) { int p = c * 64 + t; if (dir) p = 255 - p; return MLAT + b * 256 + p; }
    int p = (c - 4) * 64 + t; if (dir) p = 4095 - p;
    const int s = gdn ? ((p & 63) * 64 + (p >> 6)) : p;
    return b * 4096 + s;
}
DEVI int pos_row(bool gdn, int b, bool isctx, int p) {
    if (isctx) { if (p < 0 || p >= 256) return -1; return MLAT + b * 256 + p; }
    if (p < 0 || p >= 4096) return -1;
    const int s = gdn ? ((p & 63) * 64 + (p >> 6)) : p;
    return b * 4096 + s;
}
DEVI int dir_chunk(int dir, int j) { return dir ? (j < 4 ? 3 - j : 71 - j) : j; }

DEVI int gu_rowmap(int s) {
    const int n = s >= DFF ? 1 : 0, a = s - n * DFF, pn = a >> 7, r = a & 127, wc = r >> 5, fq = (r >> 3) & 3, bj = (r >> 2) & 1, i = r & 3;
    return 256 * pn + 128 * bj + 32 * wc + 16 * n + 4 * fq + i;
}
DEVI void cvt_tile(const float* src, int ldsrc, int Nvalid, int k0, int n0, bf16_t* dst, int lddst, int mode, float* buf, int lane) {
#pragma unroll 4
    for (int it = 0; it < 16; ++it) {
        const int row = it * 4 + (lane >> 4), c4 = (lane & 15) * 4;
        f32x4 v = (f32x4){0.f, 0.f, 0.f, 0.f};
        if (n0 + c4 < Nvalid) v = *(const f32x4*)(src + (size_t)(k0 + row) * ldsrc + n0 + c4);
        float* bp = buf + row * 65 + c4; bp[0] = v[0]; bp[1] = v[1]; bp[2] = v[2]; bp[3] = v[3];
    }
    asm volatile("s_waitcnt lgkmcnt(0)" ::: "memory"); __builtin_amdgcn_wave_barrier();
#pragma unroll 2
    for (int it = 0; it < 8; ++it) {
        const int nc = it * 8 + (lane >> 3), kk = (lane & 7) * 8;
        float f[8];
#pragma unroll
        for (int e = 0; e < 8; ++e) f[e] = buf[(kk + e) * 65 + nc];
        const int drow = mode == 1 ? gu_rowmap(n0 + nc) : (n0 + nc);
        *(u32x4*)(dst + (size_t)drow * lddst + k0 + kk) = pack8(f);
    }
    asm volatile("s_waitcnt lgkmcnt(0)" ::: "memory"); __builtin_amdgcn_wave_barrier();
}
DEVI void convert_phase(const PW& pw0, int l, unsigned char* shm_in, int gwave, int nwaves, int wid, int lane) {
    const PW p{opq64(pw0.ws)};
    unsigned char* shm = opq(shm_in);
    float* buf = (float*)shm + wid * (64 * 65);
    unsigned char* ws = p.ws;
    for (int t = gwave; t < 6880; t += nwaves) {
        int r = t;
        if (r < 2816) { const int f = r / 1408; r -= f * 1408; const int kt = r / 88, ntl = r % 88;
            cvt_tile(pin(7) + ((size_t)(l * 2 + f)) * D * 2 * DFF, 2 * DFF, 2 * DFF, kt * 64, ntl * 64, (bf16_t*)(ws + WS_WGU + f * SZ_WGU), D, 1, buf, lane); continue; }
        r -= 2816;
        if (r < 1408) { const int f = r / 704; r -= f * 704; const int kt = r / 16, ntl = r % 16;
            cvt_tile(pin(8) + ((size_t)(l * 2 + f)) * DFF * D, D, D, kt * 64, ntl * 64, (bf16_t*)(ws + WS_WDN + f * SZ_WDN), DFF, 0, buf, lane); continue; }
        r -= 1408;
        if (r < 1984) { const int kt = r / 124, ntl = r % 124;
            cvt_tile(pin(9) + (size_t)l * D * C_END, C_END, C_END, kt * 64, ntl * 64, (bf16_t*)(ws + WS_WIN), D, 0, buf, lane); continue; }
        r -= 1984;
        if (r < 384) { const int n = r / 128; r -= n * 128; const int kt = r / 16, ntl = r % 16;
            cvt_tile(pin(23) + ((size_t)(l * 3 + n)) * 512 * D, D, D, kt * 64, ntl * 64, (bf16_t*)(ws + WS_WBR) + (size_t)n * D * 512, 512, 0, buf, lane); continue; }
        r -= 384;
        if (r < 256) { const int kt = r / 16, ntl = r % 16;
            cvt_tile(pin(24) + (size_t)l * D * D, D, D, kt * 64, ntl * 64, (bf16_t*)(ws + WS_WOUT), D, 0, buf, lane); continue; }
        r -= 256;
        { const int gate = r >> 4, dn = r & 15;
            cvt_tile(pin(gate ? 16 : 14) + ((size_t)l * 16 + dn) * 4096, 64, 64, 0, 0, (bf16_t*)(ws + WS_WLRU) + (size_t)(gate * 16 + dn) * 4096, 64, 0, buf, lane); }
    }
}

DEVI void mod_phase(const PW& pw0, unsigned char* shm_in, int wv) {
    const PW p{opq64(pw0.ws)};
    unsigned char* shm = opq(shm_in);
    float* sC = (float*)shm;
    float* red = sC + 5 * 1024;
    const int tid = MYTID;
    __syncthreads();
    for (int i = tid; i < 5 * 1024; i += 512) { const int v = i >> 10, k = i & 1023; const float x = v < 4 ? pin(1)[v * 1024 + k] : pin(3)[k]; sC[i] = silu(x); }
    __syncthreads();
    float* MOD = (float*)(p.ws + WS_MOD);
    const int cgp = tid & 15, is = tid >> 4;
    for (int task = blockIdx.x; task < DEPTH * 144; task += gridDim.x) {
        const int l = task / 144, col0 = (task % 144) * 64;
        float acc[5][4];
#pragma unroll
        for (int v = 0; v < 5; ++v)
#pragma unroll
            for (int e = 0; e < 4; ++e) acc[v][e] = 0.f;
        const float* wp = pin(4) + ((size_t)l * 1024 + is * 32) * 9216 + col0 + cgp * 4;
#pragma unroll 8
        for (int r = 0; r < 32; ++r) {
            const f32x4 w = *(const f32x4*)(wp + (size_t)r * 9216);
#pragma unroll
            for (int v = 0; v < 5; ++v) { const float s = sC[v * 1024 + is * 32 + r];
#pragma unroll
                for (int e = 0; e < 4; ++e) acc[v][e] += s * w[e]; }
        }
#pragma unroll
        for (int v = 0; v < 5; ++v)
#pragma unroll
            for (int e = 0; e < 4; ++e) red[tid * 20 + v * 4 + e] = acc[v][e];
        __syncthreads();
        if (tid < 320) { const int v = tid >> 6, c = tid & 63; float s = 0.f;
            for (int k = 0; k < 32; ++k) s += red[(k * 16 + (c >> 2)) * 20 + v * 4 + (c & 3)];
            MOD[((size_t)(l * 5 + v)) * 9216 + col0 + c] = s + pin(5)[(size_t)l * 9216 + col0 + c]; }
        __syncthreads();
    }
}

DEVI void rowwise_phase(const PW& pw0, int mode, int nrows, int l, int kgate, float coef, int gpost_i, int ln, int gpre_i, int kshift, int nzc, int gwave, int nwaves, int lane, int dry = 0) {
    const PW p{opq64(pw0.ws)};
    float* X = (float*)(p.ws + WS_X); float* Xw = dry ? (float*)(p.ws + WS_GN) : X; const float* Y0 = (const float*)(p.ws + WS_Y); const float* YC = (const float*)(p.ws + WS_GB); bf16_t* H = dry ? (bf16_t*)(p.ws + WS_GU) : (bf16_t*)(p.ws + WS_H);
    const float* MOD = (const float*)(p.ws + WS_MOD);
    for (int row = gwave; row < nrows; row += nwaves) {
        const int v = row < MLAT ? (row >> 12) : 4;
        f32x4 x[4];
        if (mode == 0) {
            const float* src = row < MLAT ? pin(0) + (size_t)row * D : pin(2) + (size_t)(row - MLAT) * D;
#pragma unroll
            for (int i = 0; i < 4; ++i) x[i] = *(const f32x4*)(src + lane * 4 + 256 * i);
        } else {
            f32x4 y[4]; float ss = 0.f;
            const float* Y = YC + (size_t)(row - MLAT) * D; const bf16_t* Yl = (const bf16_t*)Y0 + (size_t)row * D;
            if (row >= MLAT) {
#pragma unroll
                for (int ih = 0; ih < 2; ++ih) {
                    f32x4 t[11][2];
#pragma unroll
                    for (int z = 0; z < 11; ++z)
#pragma unroll
                        for (int i2 = 0; i2 < 2; ++i2) t[z][i2] = z < nzc ? *(const f32x4*)(Y + (size_t)z * 1024 * D + lane * 4 + 256 * (ih * 2 + i2)) : (f32x4){0.f, 0.f, 0.f, 0.f};
#pragma unroll
                    for (int i2 = 0; i2 < 2; ++i2) { f32x4 a = t[0][i2];
#pragma unroll
                        for (int z = 1; z < 11; ++z) a = a + t[z][i2];
                        y[ih * 2 + i2] = a; }
                }
            }
#pragma unroll
            for (int i = 0; i < 4; ++i) { if (row < MLAT) { const u32x2 r2 = *(const u32x2*)(Yl + lane * 4 + 256 * i); y[i] = (f32x4){__uint_as_float(r2[0] << 16), __uint_as_float(r2[0] & 0xffff0000u), __uint_as_float(r2[1] << 16), __uint_as_float(r2[1] & 0xffff0000u)}; } x[i] = *(const f32x4*)(X + (size_t)row * D + lane * 4 + 256 * i); }
#pragma unroll
            for (int i = 0; i < 4; ++i) ss += y[i][0] * y[i][0] + y[i][1] * y[i][1] + y[i][2] * y[i][2] + y[i][3] * y[i][3];
            ss = wsum(ss); const float rs = rsqrtf(ss * (1.f / D) + EPS) * coef;
            const float* gp = pin(6) + ((size_t)l * 6 + gpost_i) * D; const float* gt = MOD + ((size_t)(l * 5 + v) * 9 + kgate) * D;
#pragma unroll
            for (int i = 0; i < 4; ++i) { const f32x4 g = *(const f32x4*)(gp + lane * 4 + 256 * i), m = *(const f32x4*)(gt + lane * 4 + 256 * i);
                x[i] = x[i] + m * (y[i] * rs * g); }
        }
        if (mode == 2) {
#pragma unroll
            for (int i = 0; i < 4; ++i) *(f32x4*)((float*)pin(25) + (size_t)row * D + lane * 4 + 256 * i) = x[i];
            continue;
        }
#pragma unroll
        for (int i = 0; i < 4; ++i) *(f32x4*)(Xw + (size_t)row * D + lane * 4 + 256 * i) = x[i];
        float ss = 0.f;
#pragma unroll
        for (int i = 0; i < 4; ++i) ss += x[i][0] * x[i][0] + x[i][1] * x[i][1] + x[i][2] * x[i][2] + x[i][3] * x[i][3];
        ss = wsum(ss); const float rs = rsqrtf(ss * (1.f / D) + EPS);
        const float* gp = pin(6) + ((size_t)ln * 6 + gpre_i) * D; const float* sh = MOD + ((size_t)(ln * 5 + v) * 9 + kshift) * D; const float* sc = sh + D;
#pragma unroll
        for (int i = 0; i < 4; ++i) { const f32x4 g = *(const f32x4*)(gp + lane * 4 + 256 * i), a = *(const f32x4*)(sh + lane * 4 + 256 * i), s = *(const f32x4*)(sc + lane * 4 + 256 * i);
            const f32x4 h = x[i] * rs * g * (s + 1.f) + a; u32x2 w; w[0] = pk2(h[0], h[1]); w[1] = pk2(h[2], h[3]);
            *(u32x2*)(H + (size_t)row * D + lane * 4 + 256 * i) = w; }
    }
}

DEVI void gdn_load(const bf16_t* P, const float* convw, int b, int c, int h, int dir, int want, bf16_t* sQ, bf16_t* sK, bf16_t* sKT, bf16_t* sVT, int tid) {
    const bool isctx = c < 4;
#pragma unroll
    for (int r = 0; r < 6; ++r) {
        const int task = tid + 512 * r, seg = r >> 1, rem = task & 1023, t = rem >> 4, cgp = rem & 15;
        if (seg == 0 && !(want & 1)) continue;
        if (seg == 1 && !(want & 6)) continue;
        if (seg == 2 && !(want & 8)) continue;
        int p = (isctx ? c : c - 4) * 64 + t; if (dir) p = (isctx ? 255 : 4095) - p;
        const int ch = seg * 512 + h * 128 + cgp * 8;
        float a[8];
#pragma unroll
        for (int e = 0; e < 8; ++e) a[e] = 0.f;
#pragma unroll
        for (int j = 0; j < 4; ++j) {
            const int row = pos_row(true, b, isctx, p + j - 2);
            if (row >= 0) {
                const u32x4 raw = *(const u32x4*)(P + (size_t)row * DINP + C_DNQ + ch); float x[8]; unpack8(raw, x);
                const f32x4 w0 = *(const f32x4*)(convw + j * 1536 + ch), w1 = *(const f32x4*)(convw + j * 1536 + ch + 4);
                a[0] += w0[0] * x[0]; a[1] += w0[1] * x[1]; a[2] += w0[2] * x[2]; a[3] += w0[3] * x[3];
                a[4] += w1[0] * x[4]; a[5] += w1[1] * x[5]; a[6] += w1[2] * x[6]; a[7] += w1[3] * x[7];
            }
        }
        float ss = 0.f;
#pragma unroll
        for (int e = 0; e < 8; ++e) { a[e] = silu(a[e]); ss += a[e] * a[e]; }
        if (seg < 2) {
            ss += __shfl_xor(ss, 1, 64); ss += __shfl_xor(ss, 2, 64); ss += __shfl_xor(ss, 4, 64); ss += __shfl_xor(ss, 8, 64);
            float inv = rsqrtf(ss + EPS); if (seg == 0) inv *= 0.08838834764831845f;
#pragma unroll
            for (int e = 0; e < 8; ++e) a[e] *= inv;
        }
        if (seg == 0) *(u32x4*)(sQ + t * 136 + cgp * 8) = pack8(a);
        else if (seg == 1) {
            if (want & 2) *(u32x4*)(sK + t * 136 + cgp * 8) = pack8(a);
            if (want & 4) {
#pragma unroll
                for (int e = 0; e < 8; ++e) sKT[tix(cgp * 8 + e, t)] = (bf16_t)f2bf(a[e]); }
        } else {
#pragma unroll
            for (int e = 0; e < 8; ++e) sVT[tix(cgp * 8 + e, t)] = (bf16_t)f2bf(a[e]);
        }
    }
}
DEVI void gdn_gates(const PW& p, const bf16_t* P, int l, int b, int c, int h, int dir, float* sc, int lane) {
    const int row = tok_row(true, dir, b, c, lane);
    const float bb = bf2f(P[(size_t)row * DINP + C_DNBA + dir * 4 + h]), aa = bf2f(P[(size_t)row * DINP + C_DNBA + 8 + dir * 4 + h]);
    const float beta = sigm(bb);
    const float g = -__expf(pin(20)[l * 8 + dir * 4 + h]) * softplus(aa + pin(21)[l * 8 + dir * 4 + h]);
    float G = g;
#pragma unroll
    for (int o = 1; o < 64; o <<= 1) { const float t = __shfl_up(G, o, 64); if (lane >= o) G += t; }
    const float GT = __shfl(G, 63, 64);
    sc[lane] = G; sc[64 + lane] = beta; sc[128 + lane] = __expf(G); sc[192 + lane] = __expf(GT - G); if (lane == 0) sc[256] = __expf(GT);
}

DEVI void gdn_prep_item(const PW& pw0, int l, int item, unsigned char* shm_in, int wv) {
    const PW p{opq64(pw0.ws)};
    unsigned char* shm = opq(shm_in);
    const int tid = MYTID, wid = __builtin_amdgcn_readfirstlane(tid >> 6), lane = tid & 63, fr = lane & 15, fq = lane >> 4;
    const int c = item % NCH, h = (item / NCH) & 3, b = (item / (NCH * 4)) & 3, dir = item / (NCH * 16);
    const bf16_t* P = (const bf16_t*)(p.ws + WS_P);
    bf16_t* sK = (bf16_t*)shm;
    bf16_t* sKT = (bf16_t*)(shm + 17408);
    bf16_t* sVT = (bf16_t*)(shm + 35840);
    float* sTm = (float*)(shm + 54272);
    bf16_t* sT1 = (bf16_t*)(shm + 71680);
    bf16_t* sT2 = (bf16_t*)(shm + 80896);
    bf16_t* sWT = (bf16_t*)(shm + 90112);
    bf16_t* sUT = (bf16_t*)(shm + 108544);
    float* sc = (float*)(shm + 126976);
    if (wid == 0) gdn_gates(p, P, l, b, c, h, dir, sc, lane);
    gdn_load(P, pin(19) + (size_t)l * 4 * 1536, b, c, h, dir, 2 | 4 | 8, nullptr, sK, sKT, sVT, tid);
    lbar();
#pragma unroll
    for (int ti = 0; ti < 2; ++ti) {
        const int tile = wid * 2 + ti, mt = tile >> 2, nt = tile & 3;
        f32x4 acc = (f32x4){0.f, 0.f, 0.f, 0.f};
#pragma unroll
        for (int kk = 0; kk < 4; ++kk) acc = MFMA16(ldfrag(sK, 136, mt * 16, kk * 32, lane), ldfrag(sK, 136, nt * 16, kk * 32, lane), acc);
        const int s = nt * 16 + fr;
#pragma unroll
        for (int j = 0; j < 4; ++j) { const int t = mt * 16 + fq * 4 + j; sTm[t * 68 + s] = s < t ? sc[64 + t] * acc[j] * __expf(sc[t] - sc[s]) : 0.f; }
    }
    lbar();
    float* tmpY = (float*)sWT;
    if (wid < 4) {
        const int o = wid * 16, c = lane & 15;
        int lz; asm volatile("v_mov_b32 %0, 0" : "=v"(lz));
        const float* tm = sTm + lz;
        float x[16];
#pragma unroll
        for (int t = 0; t < 16; ++t) {
            float v = -sTm[(o + t) * 68 + o + c];
#pragma unroll
            for (int s4 = 0; s4 < (t + 3) / 4; ++s4) {
                const f32x4 a = *(const f32x4*)(tm + (o + t) * 68 + o + s4 * 4);
#pragma unroll
                for (int e = 0; e < 4; ++e) if (s4 * 4 + e < t) v -= a[e] * x[s4 * 4 + e];
            }
            x[t] = v;
        }
        asm volatile("s_waitcnt lgkmcnt(0)" ::: "memory");
        if (lane < 16) {
#pragma unroll
            for (int t = 0; t < 16; ++t) sTm[(o + t) * 68 + o + c] = x[t] + (t == c ? 1.f : 0.f);
        }
    }
    lbar();
    {
        const int blk = tid >> 8, r = (tid >> 4) & 15, c = tid & 15, ib = (blk ? 3 : 1) * 16, jb = ib - 16;
        float y = 0.f;
#pragma unroll
        for (int s2 = 0; s2 < 16; ++s2) y += sTm[(ib + r) * 68 + jb + s2] * sTm[(jb + s2) * 68 + jb + c];
        tmpY[blk * 272 + r * 17 + c] = y;
        lbar();
        float z = 0.f;
#pragma unroll
        for (int s2 = 0; s2 < 16; ++s2) z += sTm[(ib + r) * 68 + ib + s2] * tmpY[blk * 272 + s2 * 17 + c];
        lbar();
        sTm[(ib + r) * 68 + jb + c] = -z;
    }
    lbar();
    {
        float y[2];
#pragma unroll
        for (int u = 0; u < 2; ++u) { const int o = tid + 512 * u, r = o >> 5, c = o & 31; float a = 0.f;
#pragma unroll 8
            for (int s2 = 0; s2 < 32; ++s2) a += sTm[(32 + r) * 68 + s2] * sTm[s2 * 68 + c];
            y[u] = a; }
#pragma unroll
        for (int u = 0; u < 2; ++u) { const int o = tid + 512 * u, r = o >> 5, c = o & 31; tmpY[r * 33 + c] = y[u]; }
        lbar();
#pragma unroll
        for (int u = 0; u < 2; ++u) { const int o = tid + 512 * u, r = o >> 5, c = o & 31; float a = 0.f;
#pragma unroll 8
            for (int s2 = 0; s2 < 32; ++s2) a += sTm[(32 + r) * 68 + 32 + s2] * tmpY[s2 * 33 + c];
            y[u] = a; }
#pragma unroll
        for (int u = 0; u < 2; ++u) { const int o = tid + 512 * u, r = o >> 5, c = o & 31; sTm[(32 + r) * 68 + c] = -y[u]; }
    }
    lbar();
#pragma unroll
    for (int u = 0; u < 8; ++u) {
        const int o = tid + 512 * u, t = o >> 6, s2 = o & 63; const float xv = sTm[t * 68 + s2], bt = sc[64 + s2];
        sT1[t * 72 + s2] = (bf16_t)f2bf(xv * bt * sc[128 + s2]); sT2[t * 72 + s2] = (bf16_t)f2bf(xv * bt);
    }
    lbar();
    bf16_t* GW = (bf16_t*)(p.ws + WS_H) + (size_t)item * 64 * 128;
    bf16_t* GU = (bf16_t*)(p.ws + WS_GU) + (size_t)item * 64 * 128;
    {
        const int tid2 = opaque(tid), lane = tid2 & 63, fr = lane & 15, fq = lane >> 4;
        const int mt = wid;
#pragma unroll
        for (int nt = 0; nt < 4; ++nt) {
            f32x4 aw = (f32x4){0.f, 0.f, 0.f, 0.f}, au = aw;
#pragma unroll
            for (int kk = 0; kk < 2; ++kk) { aw = MFMA16(ldfragT(sKT, mt * 16, kk * 32, lane), ldfrag(sT1, 72, nt * 16, kk * 32, lane), aw);
                au = MFMA16(ldfragT(sVT, mt * 16, kk * 32, lane), ldfrag(sT2, 72, nt * 16, kk * 32, lane), au); }
            const int t = nt * 16 + fr, r0 = mt * 16 + fq * 4; const float dec = sc[192 + t];
            u32x2 w; w[0] = pk2(aw[0], aw[1]); w[1] = pk2(aw[2], aw[3]); *(u32x2*)(GW + t * 128 + r0) = w;
            w[0] = pk2(au[0], au[1]); w[1] = pk2(au[2], au[3]); *(u32x2*)(GU + t * 128 + r0) = w;
#pragma unroll
            for (int j = 0; j < 4; ++j) { sWT[tix(r0 + j, t)] = (bf16_t)f2bf(aw[j] * dec); sUT[tix(r0 + j, t)] = (bf16_t)f2bf(au[j] * dec); }
        }
    }
    lbar();
    bf16_t* GB = (bf16_t*)(p.ws + WS_GB) + (size_t)item * 128 * 128;
    bf16_t* GN = (bf16_t*)(p.ws + WS_GN) + (size_t)item * 128 * 128;
    {
        const int tid2 = opaque(tid), lane = tid2 & 63, fr = lane & 15, fq = lane >> 4;
        const int mt = wid;
#pragma unroll
        for (int nt = 0; nt < 8; ++nt) {
            f32x4 ab = (f32x4){0.f, 0.f, 0.f, 0.f}, an = ab;
#pragma unroll
            for (int kk = 0; kk < 2; ++kk) { ab = MFMA16(ldfragT(sWT, mt * 16, kk * 32, lane), ldfragT(sKT, nt * 16, kk * 32, lane), ab);
                an = MFMA16(ldfragT(sKT, mt * 16, kk * 32, lane), ldfragT(sUT, nt * 16, kk * 32, lane), an); }
            const int cc = nt * 16 + fr, r0 = mt * 16 + fq * 4;
            u32x2 w; w[0] = pk2(-ab[0], -ab[1]); w[1] = pk2(-ab[2], -ab[3]); *(u32x2*)(GB + cc * 128 + r0) = w;
            w[0] = pk2(an[0], an[1]); w[1] = pk2(an[2], an[3]); *(u32x2*)(GN + cc * 128 + r0) = w;
        }
    }
    if (tid == 0) ((float*)(p.ws + WS_SM + SM_GDEC))[item] = sc[256];
    lbar();
}

DEVI void gdn_seq_unit(const PW& pw0, int unit, unsigned char* shm_in, int wv) {
    const PW p{opq64(pw0.ws)};
    unsigned char* shm = opq(shm_in);
    const int tid = MYTID, wid = __builtin_amdgcn_readfirstlane(tid >> 6), lane = tid & 63, fr = lane & 15, fq = lane >> 4;
    const int chain = unit >> 3, es = unit & 7;
    bf16_t* sS = (bf16_t*)shm;
    const bf16_t* GB = (const bf16_t*)(p.ws + WS_GB) + (size_t)chain * NCH * 16384;
    bf16_t* GN = (bf16_t*)(p.ws + WS_GN) + (size_t)chain * NCH * 16384;
    const float* GDEC = (const float*)(p.ws + WS_SM + SM_GDEC) + chain * NCH;
    f32x4 acc = (f32x4){0.f, 0.f, 0.f, 0.f};
    constexpr int PF = 4;
    bf16x8 an[PF][4]; u32x2 nn[PF]; float dn[PF];
    const size_t aoff = (size_t)(wid * 16 + fr) * 128 + fq * 8, noff = (size_t)(es * 16 + fr) * 128 + wid * 16 + fq * 4;
#pragma unroll
    for (int u = 0; u < PF; ++u) {
#pragma unroll
        for (int kk = 0; kk < 4; ++kk) an[u][kk] = *(const bf16x8*)(GB + (size_t)u * 16384 + aoff + kk * 32);
        nn[u] = *(const u32x2*)(GN + (size_t)u * 16384 + noff); dn[u] = GDEC[u];
    }
#pragma unroll 1
    for (int c0 = 0; c0 < NCH; c0 += PF) {
#pragma unroll
        for (int u = 0; u < PF; ++u) {
            const int c = c0 + u;
            bf16x8 a[4]; const u32x2 ncur = nn[u]; const float dcur = dn[u];
#pragma unroll
            for (int kk = 0; kk < 4; ++kk) a[kk] = an[u][kk];
            u32x2 sw; sw[0] = pk2(acc[0], acc[1]); sw[1] = pk2(acc[2], acc[3]);
            bf16_t* sb = sS + (c & 1) * (16 * 136);
            *(u32x2*)(sb + fr * 136 + wid * 16 + fq * 4) = sw;
            *(u32x2*)(GN + (size_t)c * 16384 + noff) = sw;
            if (c + PF < NCH) {
#pragma unroll
                for (int kk = 0; kk < 4; ++kk) an[u][kk] = *(const bf16x8*)(GB + (size_t)(c + PF) * 16384 + aoff + kk * 32);
                nn[u] = *(const u32x2*)(GN + (size_t)(c + PF) * 16384 + noff); dn[u] = GDEC[c + PF];
            }
            lbar();
            acc[0] = dcur * acc[0] + __uint_as_float(ncur[0] << 16); acc[1] = dcur * acc[1] + __uint_as_float(ncur[0] & 0xffff0000u);
            acc[2] = dcur * acc[2] + __uint_as_float(ncur[1] << 16); acc[3] = dcur * acc[3] + __uint_as_float(ncur[1] & 0xffff0000u);
#pragma unroll
            for (int kk = 0; kk < 4; ++kk) acc = MFMA16(a[kk], ldfrag(sb, 136, 0, kk * 32, lane), acc);
        }
    }
    lbar();
}

DEVI void gdn_out_item(const PW& pw0, int l, int item, unsigned char* shm_in, int wv) {
    const PW p{opq64(pw0.ws)};
    unsigned char* shm = opq(shm_in);
    const int tid = MYTID, wid = __builtin_amdgcn_readfirstlane(tid >> 6), lane = tid & 63, fr = lane & 15, fq = lane >> 4;
    const int j = item % NCH, h = (item / NCH) & 3, b = item / (NCH * 4);
    bf16_t* P = (bf16_t*)(p.ws + WS_P);
    bf16_t* sQ = (bf16_t*)shm;
    bf16_t* sK = (bf16_t*)(shm + 17408);
    bf16_t* sST = (bf16_t*)(shm + 34816);
    bf16_t* sW = (bf16_t*)(shm + 69632);
    bf16_t* sVN = (bf16_t*)(shm + 87040);
    bf16_t* sA2 = (bf16_t*)(shm + 105472);
    float* sO = (float*)(shm + 114688);
    float* sc = (float*)(shm + 148480);
#pragma unroll 1
    for (int dir = 0; dir < 2; ++dir) {
        const int c = dir_chunk(dir, j);
        const int it2 = ((dir * 4 + b) * 4 + h) * NCH + c;
        if (wid == 0) gdn_gates(p, P, l, b, c, h, dir, sc, lane);
        gdn_load(P, pin(19) + (size_t)l * 4 * 1536, b, c, h, dir, 1 | 2, sQ, sK, nullptr, nullptr, tid);
        const bf16_t* GS = (const bf16_t*)(p.ws + WS_GN) + (size_t)it2 * 16384;
        const bf16_t* GW = (const bf16_t*)(p.ws + WS_H) + (size_t)it2 * 8192;
        const bf16_t* GU = (const bf16_t*)(p.ws + WS_GU) + (size_t)it2 * 8192;
#pragma unroll
        for (int r = 0; r < 4; ++r) { const int idx = tid + 512 * r, row = idx >> 4, cg8 = (idx & 15) * 8; *(u32x4*)(sST + row * 136 + cg8) = *(const u32x4*)(GS + row * 128 + cg8); }
#pragma unroll
        for (int r = 0; r < 2; ++r) { const int idx = tid + 512 * r, row = idx >> 4, cg8 = (idx & 15) * 8; *(u32x4*)(sW + row * 136 + cg8) = *(const u32x4*)(GW + row * 128 + cg8); }
        lbar();
        {
            const int mt = wid;
#pragma unroll
            for (int nt = 0; nt < 4; ++nt) {
                f32x4 a = (f32x4){0.f, 0.f, 0.f, 0.f};
#pragma unroll
                for (int kk = 0; kk < 4; ++kk) a = MFMA16(ldfrag(sST, 136, mt * 16, kk * 32, lane), ldfrag(sW, 136, nt * 16, kk * 32, lane), a);
                const int t = nt * 16 + fr, e0 = mt * 16 + fq * 4;
                const u32x2 ur = *(const u32x2*)(GU + t * 128 + e0);
                sVN[(e0 + 0) * 72 + t] = (bf16_t)f2bf(__uint_as_float(ur[0] << 16) - a[0]); sVN[(e0 + 1) * 72 + t] = (bf16_t)f2bf(__uint_as_float(ur[0] & 0xffff0000u) - a[1]);
                sVN[(e0 + 2) * 72 + t] = (bf16_t)f2bf(__uint_as_float(ur[1] << 16) - a[2]); sVN[(e0 + 3) * 72 + t] = (bf16_t)f2bf(__uint_as_float(ur[1] & 0xffff0000u) - a[3]);
            }
#pragma unroll
            for (int ti = 0; ti < 2; ++ti) {
                const int tile = wid * 2 + ti, m2 = tile >> 2, n2 = tile & 3;
                f32x4 a = (f32x4){0.f, 0.f, 0.f, 0.f};
#pragma unroll
                for (int kk = 0; kk < 4; ++kk) a = MFMA16(ldfrag(sQ, 136, m2 * 16, kk * 32, lane), ldfrag(sK, 136, n2 * 16, kk * 32, lane), a);
                const int s = n2 * 16 + fr;
#pragma unroll
                for (int jj = 0; jj < 4; ++jj) { const int t = m2 * 16 + fq * 4 + jj; sA2[t * 72 + s] = (bf16_t)f2bf(s <= t ? a[jj] * __expf(sc[t] - sc[s]) : 0.f); }
            }
        }
        lbar();
        {
            const int nt = wid;
#pragma unroll
            for (int mt = 0; mt < 4; ++mt) {
                f32x4 a = (f32x4){0.f, 0.f, 0.f, 0.f};
#pragma unroll
                for (int kk = 0; kk < 4; ++kk) a = MFMA16(ldfrag(sQ, 136, mt * 16, kk * 32, lane), ldfrag(sST, 136, nt * 16, kk * 32, lane), a);
#pragma unroll
                for (int jj = 0; jj < 4; ++jj) a[jj] *= sc[128 + mt * 16 + fq * 4 + jj];
#pragma unroll
                for (int kk = 0; kk < 2; ++kk) a = MFMA16(ldfrag(sA2, 72, mt * 16, kk * 32, lane), ldfrag(sVN, 72, nt * 16, kk * 32, lane), a);
                const int e = nt * 16 + fr;
#pragma unroll
                for (int jj = 0; jj < 4; ++jj) { const int t = mt * 16 + fq * 4 + jj; const int i = dir ? 63 - t : t; if (dir) sO[i * 132 + e] += a[jj]; else sO[i * 132 + e] = a[jj]; }
            }
        }
        lbar();
    }
    {
        const int i = tid >> 3, e0 = (tid & 7) * 16;
        float v[16], ss = 0.f;
#pragma unroll
        for (int e = 0; e < 16; ++e) { v[e] = sO[i * 132 + e0 + e]; ss += v[e] * v[e]; }
        ss += __shfl_xor(ss, 1, 64); ss += __shfl_xor(ss, 2, 64); ss += __shfl_xor(ss, 4, 64);
        const float rs = rsqrtf(ss * (1.f / 128.f) + EPS);
        const int row = tok_row(true, 0, b, j, i);
        bf16_t* zp = P + (size_t)row * DINP + C_DNZ + h * 128 + e0;
        const float* g = pin(22) + l * 128 + e0;
#pragma unroll
        for (int half = 0; half < 2; ++half) {
            float z[8]; unpack8(*(const u32x4*)(zp + half * 8), z); float o[8];
#pragma unroll
            for (int e = 0; e < 8; ++e) o[e] = v[half * 8 + e] * rs * g[half * 8 + e] * z[e];
            *(u32x4*)(zp + half * 8) = pack8(o);
        }
    }
    lbar();
}

DEVI float ml_gates(const PW& p, const bf16_t* P, int l, int b, int c, int h, int dir, float* sc, int lane) {
    const int row = tok_row(false, dir, b, c, lane);
    const float ig = bf2f(P[(size_t)row * DINP + C_MLG + dir * 4 + h]) + pin(10)[l * 16 + dir * 4 + h];
    const float fg = bf2f(P[(size_t)row * DINP + C_MLG + (2 + dir) * 4 + h]) + pin(10)[l * 16 + (2 + dir) * 4 + h];
    float bb = logsig(fg);
#pragma unroll
    for (int o = 1; o < 64; o <<= 1) { const float t = __shfl_up(bb, o, 64); if (lane >= o) bb += t; }
    sc[lane] = bb; sc[64 + lane] = ig;
    return __shfl(bb, 63, 64);
}
DEVI void ml_prep_item(const PW& pw0, int l, int item, unsigned char* shm_in, int wv) {
    const PW p{opq64(pw0.ws)};
    unsigned char* shm = opq(shm_in);
    const int tid = MYTID, wid = __builtin_amdgcn_readfirstlane(tid >> 6), lane = tid & 63, fr = lane & 15, fq = lane >> 4;
    const int c = item % NCH, h = (item / NCH) & 3, b = (item / (NCH * 4)) & 3, dir = item / (NCH * 16);
    const bf16_t* P = (const bf16_t*)(p.ws + WS_P);
    bf16_t* sKT = (bf16_t*)shm;
    bf16_t* sVT = (bf16_t*)(shm + 9216);
    float* sc = (float*)(shm + 27648);
    if (wid == 0) {
        const float bT = ml_gates(p, P, l, b, c, h, dir, sc, lane);
        const float lw = bT - sc[lane] + sc[64 + lane];
        const float Mc = wmax(lw);
        sc[128 + lane] = __expf(lw - Mc);
        if (lane == 0) { float* msc = (float*)(p.ws + WS_SM + SM_MSC) + item * 2; msc[0] = bT; msc[1] = Mc; }
    }
    lbar();
    {
        const int t = tid >> 3, cg8 = (tid & 7) * 8; const int row = tok_row(false, dir, b, c, t);
        float x[8]; unpack8(*(const u32x4*)(P + (size_t)row * DINP + C_MLK + h * 64 + cg8), x);
#pragma unroll
        for (int e = 0; e < 8; ++e) sKT[tix(cg8 + e, t)] = (bf16_t)f2bf(x[e]);
    }
#pragma unroll
    for (int r = 0; r < 2; ++r) {
        const int idx = tid + 512 * r, t = idx >> 4, cg8 = (idx & 15) * 8; const int row = tok_row(false, dir, b, c, t);
        float x[8]; unpack8(*(const u32x4*)(P + (size_t)row * DINP + C_MLV + h * 128 + cg8), x); const float w = sc[128 + t];
#pragma unroll
        for (int e = 0; e < 8; ++e) sVT[tix(cg8 + e, t)] = (bf16_t)f2bf(x[e] * w);
    }
    lbar();
    float* KV = (float*)(p.ws + WS_Y) + (size_t)item * 8192;
    {
        const int nt = wid;
#pragma unroll
        for (int mt = 0; mt < 4; ++mt) {
            f32x4 a = (f32x4){0.f, 0.f, 0.f, 0.f};
#pragma unroll
            for (int kk = 0; kk < 2; ++kk) a = MFMA16(ldfragT(sKT, mt * 16, kk * 32, lane), ldfragT(sVT, nt * 16, kk * 32, lane), a);
            *(f32x4*)(KV + (nt * 16 + fr) * 64 + mt * 16 + fq * 4) = a;
        }
    }
    if (tid < 64) { float s = 0.f;
        for (int t = 0; t < 64; ++t) s += sc[128 + t] * bf2f(sKT[tix(tid, t)]);
        ((float*)(p.ws + WS_SM + SM_MN))[item * 64 + tid] = s; }
    lbar();
}
DEVI void ml_seq(const PW& pw0, int gtid, int nthreads) {
    const PW p{opq64(pw0.ws)};
    const float* MSC = (const float*)(p.ws + WS_SM + SM_MSC);
    float* MM = (float*)(p.ws + WS_SM + SM_MM);
    for (int g = gtid; g < 32 * 4096 + 32 * 32; g += nthreads) {
        const bool isn = g >= 32 * 4096; const int gg = isn ? g - 32 * 4096 : g;
        const int chain = isn ? gg >> 5 : gg >> 12, e2 = isn ? gg & 31 : gg & 4095;
        float* base = isn ? (float*)(p.ws + WS_SM + SM_MN) + (size_t)chain * NCH * 64 + e2 * 2 : (float*)(p.ws + WS_Y) + (size_t)chain * NCH * 8192 + e2 * 2;
        const int stride = isn ? 64 : 8192;
        float m = 0.f; f32x2 C = (f32x2){0.f, 0.f};
        for (int c0 = 0; c0 < NCH; c0 += 17) {
            f32x2 kv[17]; f32x2 sc[17];
#pragma unroll
            for (int u = 0; u < 17; ++u) { kv[u] = *(const f32x2*)(base + (size_t)(c0 + u) * stride); sc[u] = *(const f32x2*)(MSC + (chain * NCH + c0 + u) * 2); }
#pragma unroll
            for (int u = 0; u < 17; ++u) {
                *(f32x2*)(base + (size_t)(c0 + u) * stride) = C;
                if (!isn && e2 == 0) MM[chain * NCH + c0 + u] = m;
                const float mn = fmaxf(sc[u][0] + m, sc[u][1]);
                const float a = __expf(sc[u][0] + m - mn), s = __expf(sc[u][1] - mn);
                C = C * a + kv[u] * s; m = mn;
            }
        }
    }
}
DEVI void ml_out_item(const PW& pw0, int l, int item, unsigned char* shm_in, int wv) {
    const PW p{opq64(pw0.ws)};
    unsigned char* shm = opq(shm_in);
    const int tid = MYTID, wid = __builtin_amdgcn_readfirstlane(tid >> 6), lane = tid & 63, fr = lane & 15, fq = lane >> 4;
    const int j = item % NCH, h = (item / NCH) & 3, b = item / (NCH * 4);
    bf16_t* P = (bf16_t*)(p.ws + WS_P);
    bf16_t* sQ = (bf16_t*)shm;
    bf16_t* sK = (bf16_t*)(shm + 9216);
    bf16_t* sVT = (bf16_t*)(shm + 18432);
    bf16_t* sCT = (bf16_t*)(shm + 36864);
    bf16_t* sS = (bf16_t*)(shm + 55296);
    float* sO = (float*)(shm + 64512);
    float* sc = (float*)(shm + 98304);
#pragma unroll 1
    for (int dir = 0; dir < 2; ++dir) {
        const int c = dir_chunk(dir, j);
        const int it2 = ((dir * 4 + b) * 4 + h) * NCH + c;
        if (wid == 0) {
            ml_gates(p, P, l, b, c, h, dir, sc, lane);
            const float m = ((const float*)(p.ws + WS_SM + SM_MM))[it2];
            const float bb = sc[lane];
            float pm = sc[64 + lane] - bb;
#pragma unroll
            for (int o = 1; o < 64; o <<= 1) { const float t = __shfl_up(pm, o, 64); if (lane >= o) pm = fmaxf(pm, t); }
            const float mt = bb + fmaxf(m, pm);
            sc[128 + lane] = mt; sc[192 + lane] = __expf(bb + m - mt);
            sc[320 + lane] = ((const float*)(p.ws + WS_SM + SM_MN))[it2 * 64 + lane];
        }
        {
            const int t = tid >> 3, cg8 = (tid & 7) * 8; const int row = tok_row(false, dir, b, c, t);
            float x[8]; unpack8(*(const u32x4*)(P + (size_t)row * DINP + C_MLQ + h * 64 + cg8), x);
#pragma unroll
            for (int e = 0; e < 8; ++e) x[e] *= 0.125f;
            *(u32x4*)(sQ + t * 72 + cg8) = pack8(x);
            *(u32x4*)(sK + t * 72 + cg8) = *(const u32x4*)(P + (size_t)row * DINP + C_MLK + h * 64 + cg8);
        }
#pragma unroll
        for (int r = 0; r < 2; ++r) {
            const int idx = tid + 512 * r, t = idx >> 4, cg8 = (idx & 15) * 8; const int row = tok_row(false, dir, b, c, t);
            float x[8]; unpack8(*(const u32x4*)(P + (size_t)row * DINP + C_MLV + h * 128 + cg8), x);
#pragma unroll
            for (int e = 0; e < 8; ++e) sVT[tix(cg8 + e, t)] = (bf16_t)f2bf(x[e]);
        }
        {
            const float* CT = (const float*)(p.ws + WS_Y) + (size_t)it2 * 8192;
#pragma unroll
            for (int r = 0; r < 4; ++r) { const int idx = tid + 512 * r, e = idx >> 4, d4 = (idx & 15) * 4; const f32x4 v = *(const f32x4*)(CT + e * 64 + d4);
                u32x2 w; w[0] = pk2(v[0], v[1]); w[1] = pk2(v[2], v[3]); *(u32x2*)(sCT + e * 72 + d4) = w; }
        }
        lbar();
#pragma unroll
        for (int ti = 0; ti < 2; ++ti) {
            const int tile = wid * 2 + ti, m2 = tile >> 2, n2 = tile & 3;
            f32x4 a = (f32x4){0.f, 0.f, 0.f, 0.f};
#pragma unroll
            for (int kk = 0; kk < 2; ++kk) a = MFMA16(ldfrag(sQ, 72, m2 * 16, kk * 32, lane), ldfrag(sK, 72, n2 * 16, kk * 32, lane), a);
            const int s = n2 * 16 + fr;
#pragma unroll
            for (int jj = 0; jj < 4; ++jj) { const int t = m2 * 16 + fq * 4 + jj;
                sS[t * 72 + s] = (bf16_t)f2bf(s <= t ? a[jj] * __expf(sc[t] - sc[s] + sc[64 + s] - sc[128 + t]) : 0.f); }
        }
        lbar();
        if (tid < 64) {
            float ds = 0.f, qn = 0.f;
            for (int s = 0; s < 64; ++s) { ds += bf2f(sS[tid * 72 + s]); qn += bf2f(sQ[tid * 72 + s]) * sc[320 + s]; }
            const float den = ds + sc[192 + tid] * qn;
            sc[256 + tid] = 1.f / fmaxf(fabsf(den), __expf(-sc[128 + tid]));
        }
        lbar();
        {
            const int nt = wid;
#pragma unroll
            for (int mt = 0; mt < 4; ++mt) {
                f32x4 a = (f32x4){0.f, 0.f, 0.f, 0.f};
#pragma unroll
                for (int kk = 0; kk < 2; ++kk) a = MFMA16(ldfrag(sQ, 72, mt * 16, kk * 32, lane), ldfrag(sCT, 72, nt * 16, kk * 32, lane), a);
#pragma unroll
                for (int jj = 0; jj < 4; ++jj) a[jj] *= sc[192 + mt * 16 + fq * 4 + jj];
#pragma unroll
                for (int kk = 0; kk < 2; ++kk) a = MFMA16(ldfrag(sS, 72, mt * 16, kk * 32, lane), ldfragT(sVT, nt * 16, kk * 32, lane), a);
                const int e = nt * 16 + fr;
#pragma unroll
                for (int jj = 0; jj < 4; ++jj) { const int t = mt * 16 + fq * 4 + jj; const int i = dir ? 63 - t : t; const float hv = a[jj] * sc[256 + t];
                    if (dir) sO[i * 132 + e] += hv; else sO[i * 132 + e] = hv; }
            }
        }
        lbar();
    }
    {
        const int i = tid >> 3, e0 = (tid & 7) * 16;
        float v[16], ss = 0.f;
#pragma unroll
        for (int e = 0; e < 16; ++e) { v[e] = sO[i * 132 + e0 + e]; ss += v[e] * v[e]; }
        ss += __shfl_xor(ss, 1, 64); ss += __shfl_xor(ss, 2, 64); ss += __shfl_xor(ss, 4, 64);
        const float rs = rsqrtf(ss * (1.f / 128.f) + EPS);
        const int row = tok_row(false, 0, b, j, i);
        bf16_t* op = P + (size_t)row * DINP + C_MLO + h * 128 + e0;
        const float* g = pin(11) + l * 512 + h * 128 + e0;
#pragma unroll
        for (int half = 0; half < 2; ++half) {
            float z[8]; unpack8(*(const u32x4*)(op + half * 8), z); float o[8];
#pragma unroll
            for (int e = 0; e < 8; ++e) o[e] = v[half * 8 + e] * rs * g[half * 8 + e] * z[e];
            *(u32x4*)(op + half * 8) = pack8(o);
        }
    }
    lbar();
}

DEVI void lru_item(const PW& pw0, int l, int item, int mode, unsigned char* shm_in, int wv) {
    const PW p{opq64(pw0.ws)};
    unsigned char* shm = opq(shm_in);
    const int tid = MYTID, wid = __builtin_amdgcn_readfirstlane(tid >> 6), lane = tid & 63, fr = lane & 15, fq = lane >> 4;
    const int n4 = item & 3, j = (item >> 2) % NCH, b = (item >> 2) / NCH; const bool isctx = j < 4;
    bf16_t* P = (bf16_t*)(p.ws + WS_P);
    bf16_t* sX = (bf16_t*)shm;
    const int p0 = (isctx ? j : j - 4) * 64;
    const float* cw = pin(12) + (size_t)l * 4 * 512; const float* cb = pin(13) + (size_t)l * 512;
    {
        const int ch = lane * 8, i0 = wid * 8;
        f32x4 w[4][2];
#pragma unroll
        for (int jj = 0; jj < 4; ++jj) { w[jj][0] = *(const f32x4*)(cw + jj * 512 + ch); w[jj][1] = *(const f32x4*)(cw + jj * 512 + ch + 4); }
        const f32x4 b0 = *(const f32x4*)(cb + ch), b1 = *(const f32x4*)(cb + ch + 4);
        u32x4 raw[11];
#pragma unroll
        for (int r = 0; r < 11; ++r) { const int row = pos_row(false, b, isctx, p0 + i0 + r - 2);
            raw[r] = (u32x4){0u, 0u, 0u, 0u}; if (row >= 0) raw[r] = *(const u32x4*)(P + (size_t)row * DINP + C_LRX + ch); }
#pragma unroll
        for (int i = 0; i < 8; ++i) {
            float a[8] = {b0[0], b0[1], b0[2], b0[3], b1[0], b1[1], b1[2], b1[3]};
#pragma unroll
            for (int jj = 0; jj < 4; ++jj) { float x[8]; unpack8(raw[i + jj], x);
#pragma unroll
                for (int e = 0; e < 4; ++e) { a[e] += w[jj][0][e] * x[e]; a[4 + e] += w[jj][1][e] * x[4 + e]; } }
            *(u32x4*)(sX + (i0 + i) * 520 + ch) = pack8(a);
        }
    }
    lbar();
    const int blk = wid;
    const bf16_t* WL = (const bf16_t*)(p.ws + WS_WLRU);
    float* LAGG = (float*)(p.ws + WS_SM + SM_LAGG);
    {
        const int ch = blk * 64 + n4 * 16 + fr;
        float hsum[4][4];
#pragma unroll
        for (int mt = 0; mt < 4; ++mt)
#pragma unroll
            for (int jj = 0; jj < 4; ++jj) hsum[mt][jj] = 0.f;
#pragma unroll
        for (int dir = 0; dir < 2; ++dir) {
            const bf16_t* wa = WL + (size_t)(0 * 16 + dir * 8 + blk) * 4096 + (n4 * 16 + fr) * 64 + fq * 8;
            const bf16_t* wx = WL + (size_t)(1 * 16 + dir * 8 + blk) * 4096 + (n4 * 16 + fr) * 64 + fq * 8;
            bf16x8 ba[2], bx[2];
#pragma unroll
            for (int kk = 0; kk < 2; ++kk) { ba[kk] = *(const bf16x8*)(wa + kk * 32); bx[kk] = *(const bf16x8*)(wx + kk * 32); }
            const float bias_a = pin(15)[(size_t)l * 1024 + dir * 512 + ch], bias_x = pin(17)[(size_t)l * 1024 + dir * 512 + ch];
            const float cl = -8.f * softplus(-pin(18)[(size_t)l * 1024 + dir * 512 + ch]);
            float av[4][4], bv[4][4];
#pragma unroll
            for (int mt = 0; mt < 4; ++mt) {
                f32x4 aa = (f32x4){0.f, 0.f, 0.f, 0.f}, ax = aa;
#pragma unroll
                for (int kk = 0; kk < 2; ++kk) { const bf16x8 af = ldfrag(sX, 520, mt * 16, blk * 64 + kk * 32, lane); aa = MFMA16(af, ba[kk], aa); ax = MFMA16(af, bx[kk], ax); }
#pragma unroll
                for (int jj = 0; jj < 4; ++jj) {
                    const int t = mt * 16 + fq * 4 + jj;
                    const float rr = sigm(aa[jj] + bias_a), ii = sigm(ax[jj] + bias_x), la = cl * rr;
                    const float ea = __expf(la);
                    av[mt][jj] = ea;
                    bv[mt][jj] = __builtin_amdgcn_sqrtf(fmaxf(1.f - ea * ea, 0.f)) * ii * bf2f(sX[t * 520 + ch]);
                }
            }
            const int c = dir_chunk(dir, j);
            const size_t aidx = (((size_t)dir * 4 + b) * NCH + c) * 512 + ch;
            float hin = mode ? LAGG[aidx * 2] : 0.f;
            float Pc = 1.f, Hc = 0.f;
#pragma unroll
            for (int mi = 0; mi < 4; ++mi) {
                const int mt = dir ? 3 - mi : mi;
                float Pl = 1.f, Hl = 0.f;
#pragma unroll
                for (int ji = 0; ji < 4; ++ji) { const int jj = dir ? 3 - ji : ji; Pl = av[mt][jj] * Pl; Hl = av[mt][jj] * Hl + bv[mt][jj]; }
                float Pq[4], Hq[4];
#pragma unroll
                for (int q = 0; q < 4; ++q) { Pq[q] = __shfl(Pl, fr + 16 * q, 64); Hq[q] = __shfl(Hl, fr + 16 * q, 64); }
                if (mode == 0) {
#pragma unroll
                    for (int qi = 0; qi < 4; ++qi) { const int q = dir ? 3 - qi : qi; Hc = Pq[q] * Hc + Hq[q]; Pc = Pq[q] * Pc; }
                } else {
                    float hh = hin;
                    float hme = hin;
#pragma unroll
                    for (int qi = 0; qi < 4; ++qi) { const int q = dir ? 3 - qi : qi; if (q == fq) hme = hh; hh = Pq[q] * hh + Hq[q]; }
                    hin = hh;
#pragma unroll
                    for (int ji = 0; ji < 4; ++ji) { const int jj = dir ? 3 - ji : ji; hme = av[mt][jj] * hme + bv[mt][jj]; hsum[mt][jj] += hme; }
                }
            }
            if (mode == 0 && fq == 0) { LAGG[aidx * 2] = Pc; LAGG[aidx * 2 + 1] = Hc; }
        }
        if (mode == 1) {
#pragma unroll
            for (int mt = 0; mt < 4; ++mt)
#pragma unroll
                for (int jj = 0; jj < 4; ++jj) { const int i = mt * 16 + fq * 4 + jj; const int row = pos_row(false, b, isctx, p0 + i);
                    bf16_t* yp = P + (size_t)row * DINP + C_LRY + ch; *yp = (bf16_t)f2bf(hsum[mt][jj] * bf2f(*yp)); }
        }
    }
    lbar();
}
DEVI void lru_seq(const PW& pw0, int gtid, int nthreads) {
    const PW p{opq64(pw0.ws)};
    float* LAGG = (float*)(p.ws + WS_SM + SM_LAGG);
    for (int g = gtid; g < 4096; g += nthreads) {
        const int ch = g & 511, db = g >> 9;
        float h = 0.f;
        for (int c0 = 0; c0 < NCH; c0 += 17) {
            f32x2 v[17];
#pragma unroll
            for (int u = 0; u < 17; ++u) v[u] = *(const f32x2*)(LAGG + (((size_t)db * NCH + c0 + u) * 512 + ch) * 2);
#pragma unroll
            for (int u = 0; u < 17; ++u) { LAGG[(((size_t)db * NCH + c0 + u) * 512 + ch) * 2] = h; h = v[u][0] * h + v[u][1]; }
        }
    }
}

#define XB_TMO      128
#define XB_XCNT(j)  (256  + 64 * (j))
#define XB_XSUB(j)  (1280 + 64 * (j))
#define XB_XGEN(j)  (2304 + 64 * (j))
#define XB_TOP      3328
#define XB_TOPGEN   3392
#define XCD_BAR_WORDS 3456
#define XB_SPIN_CAP (1u << 22)
DEVI unsigned xb_ld(unsigned* p)              { return __hip_atomic_load(p, __ATOMIC_RELAXED, __HIP_MEMORY_SCOPE_AGENT); }
DEVI unsigned xb_add(unsigned* p, unsigned v) { return __hip_atomic_fetch_add(p, v, __ATOMIC_RELAXED, __HIP_MEMORY_SCOPE_AGENT); }
DEVI unsigned xb_xcc_id() { return (unsigned)__builtin_amdgcn_s_getreg((3 << 11) | 20) & 0xFu; }
#define XB_SPIN(cond, bar) do { unsigned _sp = 0; while (cond) { __builtin_amdgcn_s_sleep(1); \
    if ((++_sp & 255u) == 0u) { if (xb_ld(&(bar)[XB_TMO])) break; if (_sp > XB_SPIN_CAP) { atomicAdd(&(bar)[XB_TMO], 1u); break; } } } } while (0)
DEVI void xcd_barrier_complete(unsigned* bar, unsigned x, unsigned G, unsigned& nloc, unsigned& nx) {
    unsigned sum, cnt, mine, sp = 0u;
    for (;;) {
        sum = 0u; cnt = 0u; mine = 0u;
#pragma unroll
        for (unsigned j = 0; j < 16; ++j) { const unsigned c = xb_ld(&bar[XB_XCNT(j)]); sum += c; cnt += (c > 0u) ? 1u : 0u; mine = (j == x) ? c : mine; }
        if (sum == G) break;
        __builtin_amdgcn_s_sleep(1);
        if ((++sp & 255u) == 0u) { if (xb_ld(&bar[XB_TMO])) break; if (sp > XB_SPIN_CAP) { atomicAdd(&bar[XB_TMO], 1u); break; } }
    }
    nloc = mine > 0u ? mine : 1u; nx = cnt > 0u ? cnt : 1u;
}
DEVI void gsync(unsigned* bar, volatile LAS unsigned* st, int G, int wv) {
    asm volatile("s_waitcnt vmcnt(0)" ::: "memory");
    __syncthreads();
    const int ln = (int)__builtin_amdgcn_mbcnt_hi(~0u, __builtin_amdgcn_mbcnt_lo(~0u, 0u));
    if (wv == 0 && ln == 0) {
        __builtin_amdgcn_s_waitcnt(0);
        const unsigned x = xb_xcc_id();
        unsigned nloc = st[0], nx = st[1];
        if (nloc == 0u) { xcd_barrier_complete(bar, x, (unsigned)G, nloc, nx); st[0] = nloc; st[1] = nx; }
        const unsigned old = xb_add(&bar[XB_XSUB(x)], 1u);
        const unsigned gen = old / nloc;
        if (old + 1u == (gen + 1u) * nloc) {
            __builtin_amdgcn_fence(__ATOMIC_RELEASE, "agent");
            asm volatile("s_waitcnt vmcnt(0)" ::: "memory");
            const unsigned og = xb_add(&bar[XB_TOP], 1u);
            const unsigned tg = og / nx;
            if (og + 1u == (tg + 1u) * nx) xb_add(&bar[XB_TOPGEN], 1u);
            else XB_SPIN(xb_ld(&bar[XB_TOPGEN]) == tg, bar);
            __builtin_amdgcn_fence(__ATOMIC_ACQUIRE, "agent");
            xb_add(&bar[XB_XGEN(x)], 1u);
            asm volatile("s_waitcnt vmcnt(0)" ::: "memory");
        } else {
            XB_SPIN(xb_ld(&bar[XB_XGEN(x)]) == gen, bar);
            __builtin_amdgcn_fence(__ATOMIC_ACQUIRE, "agent");
            asm volatile("s_waitcnt vmcnt(0)" ::: "memory");
        }
    }
    __syncthreads();
}

__global__ void __launch_bounds__(512) mega(Params p) {
    extern __shared__ __attribute__((aligned(16))) unsigned char shm[];
    cg::grid_group grid = cg::this_grid();
    const int wv = __builtin_amdgcn_readfirstlane(threadIdx.x >> 6);
    const int G = gridDim.x, nwaves = G * 8, nthreads = G * 512;
#define TIDS const int tid = MYTID, wid = tid >> 6, lane = tid & 63, gwave = blockIdx.x * 8 + wid, gtid = blockIdx.x * 512 + tid; (void)gtid; (void)gwave; (void)lane;
    LAS unsigned char* lds = (LAS unsigned char*)shm;
#define WSQ unsigned char* ws = opq64(pw.ws); bf16_t* Hb = (bf16_t*)(ws + WS_H); bf16_t* Pb = (bf16_t*)(ws + WS_P); float* Yb = (float*)(ws + WS_Y); (void)Hb; (void)Pb; (void)Yb;

    const PW pw{p.ws};
    unsigned* bar = (unsigned*)p.ws;
    volatile LAS unsigned* xst = (volatile LAS unsigned*)((LAS unsigned char*)shm + (LDS_BYTES - 16));
    if (threadIdx.x == 0) { xst[0] = 0u; xst[1] = 0u; (void)xb_add(&bar[XB_XCNT(xb_xcc_id())], 1u); }
    __syncthreads();
    for (int rep = 0; rep < REP_CVT; ++rep) {
    mod_phase(pw, shm, wv);
    { TIDS convert_phase(pw, 0, shm, gwave, nwaves, wid, lane); }
    }
    grid.sync();
    { TIDS rowwise_phase(pw, 0, MTOT, 0, 0, 0.f, 0, 0, 0, 0, 0, gwave, nwaves, lane); }
    gsync(bar, xst, G, wv);

#pragma unroll 1
    for (int l = 0; l < DEPTH; ++l) {
        const bool last = l == DEPTH - 1;
#pragma unroll 1
        for (int f = 0; f < 2; ++f) {
            if (f == 1) {
                { WSQ pg8::Gemm g{Hb, (const bf16_t*)(ws + WS_WIN), 68, 31, D, D, 1, 0, 0, 0, 0, D, 0}; pg8::Order S; S.init(68, 31, 1, G, blockIdx.x);
                  pg8::EpiInProj E{Pb, DINP}; for (int rep = 0; rep < REP_GEMM; ++rep) pg8::gemm_phase(lds, g, S, E, wv); }
                gsync(bar, xst, G, wv);
#pragma unroll 1
                for (int rep2 = 0; rep2 < REP_PREPSEQ; ++rep2) {
#pragma unroll 1
                for (int rep = 0; rep < REP_PREP; ++rep)
                {
                    for (int it = blockIdx.x; it < 2176; it += G) gdn_prep_item(pw, l, it, shm, wv);
                    for (int it = (blockIdx.x + G / 2) % G; it < 2176; it += G) ml_prep_item(pw, l, it, shm, wv);
                    for (int it = (blockIdx.x + G / 4) % G; it < 1088; it += G) lru_item(pw, l, it, 0, shm, wv);
                }
                gsync(bar, xst, G, wv);
                for (int u = blockIdx.x; u < 256; u += G) gdn_seq_unit(pw, u, shm, wv);
                { TIDS ml_seq(pw, gtid, nthreads); }
                { TIDS lru_seq(pw, gtid, nthreads); }
                gsync(bar, xst, G, wv);
                }
                for (int it = blockIdx.x; it < 1088; it += G) { if (last && (it % NCH) < 4) continue; gdn_out_item(pw, l, it, shm, wv); }
                for (int it = (blockIdx.x + G / 4) % G; it < 1088; it += G) { if (last && (it % NCH) < 4) continue; ml_out_item(pw, l, it, shm, wv); }
                for (int it = (blockIdx.x + G / 2) % G; it < 1088; it += G) { if (last && ((it >> 2) % NCH) < 4) continue; lru_item(pw, l, it, 1, shm, wv); }
                gsync(bar, xst, G, wv);
                const int nM = last ? 64 : 68;
                { WSQ pg8::Gemm g{Pb, (const bf16_t*)(ws + WS_WBR), nM, 4, 512, DINP, 3, C_MLO, C_LRY, C_DNZ, D * 512, 512, 0}; pg8::Order S; S.init(nM, 4, 3, G, blockIdx.x);
                  pg8::EpiBranch E{Pb, Yb, Hb}; for (int rep = 0; rep < REP_GEMM; ++rep) pg8::gemm_phase(lds, g, S, E, wv); }
                gsync(bar, xst, G, wv);
                { WSQ pg8::Gemm g{Hb, (const bf16_t*)(ws + WS_WOUT), 64, 4, D, D, 1, 0, 0, 0, 0, D, 0}; pg8::Order S; S.init(64, 4, 1, G, blockIdx.x);
                  pg8::EpiBf16Y E{(bf16_t*)Yb, D}; for (int rep = 0; rep < REP_GEMM; ++rep) pg8::gemm_phase(lds, g, S, E, wv); }
                if (!last) { WSQ pg8::Gemm g{Hb, (const bf16_t*)(ws + WS_WOUT), 4, 4, 256, D, 4, 0, 0, 0, 256, D, 256}; pg8::Order S; S.init(4, 4, 4, G, blockIdx.x, 64, 1);
                  pg8::EpiF32 E{(float*)(ws + WS_GB), D, MLAT, (size_t)1024 * D}; pg8::gemm_phase(lds, g, S, E, wv); }
                gsync(bar, xst, G, wv);
                { TIDS if (DRY_ROW) { rowwise_phase(pw, 1, nM * 256, l, 5, 1.f, 3, l, 4, 6, 4, gwave, nwaves, lane, 1); } rowwise_phase(pw, 1, nM * 256, l, 5, 1.f, 3, l, 4, 6, 4, gwave, nwaves, lane); }
                gsync(bar, xst, G, wv);
            }
            const int nM = (last && f == 1) ? 64 : 68;
            { WSQ pg8::Gemm g{Hb, (const bf16_t*)(ws + WS_WGU + f * SZ_WGU), nM, 22, D, D, 1, 0, 0, 0, 0, D, 0}; pg8::Order S; S.init(nM, 22, 1, G, blockIdx.x);
              pg8::EpiSwiGLU E{Pb, DFF}; for (int rep = 0; rep < REP_GU; ++rep) pg8::gemm_phase(lds, g, S, E, wv); }
            gsync(bar, xst, G, wv);
            { WSQ pg8::Gemm g{Pb, (const bf16_t*)(ws + WS_WDN + f * SZ_WDN), 64, 4, DFF, DFF, 1, 0, 0, 0, 0, DFF, 0}; pg8::Order S; S.init(64, 4, 1, G, blockIdx.x);
              pg8::EpiBf16Y E{(bf16_t*)Yb, D}; for (int rep = 0; rep < REP_DN; ++rep) pg8::gemm_phase(lds, g, S, E, wv); }
            if (nM == 68) { WSQ pg8::Gemm g{Pb, (const bf16_t*)(ws + WS_WDN + f * SZ_WDN), 4, 4, 256, DFF, 11, 0, 0, 0, 256, DFF, 256}; pg8::Order S; S.init(4, 4, 11, G, blockIdx.x, 64, 1);
              pg8::EpiF32 E{(float*)(ws + WS_GB), D, MLAT, (size_t)1024 * D}; for (int rep = 0; rep < REP_DNC; ++rep) pg8::gemm_phase(lds, g, S, E, wv); }
            gsync(bar, xst, G, wv);
            if (f == 0) { TIDS if (DRY_ROW) { rowwise_phase(pw, 1, nM * 256, l, 2, 0.5f, 1, l, 2, 3, 11, gwave, nwaves, lane, 1); } rowwise_phase(pw, 1, nM * 256, l, 2, 0.5f, 1, l, 2, 3, 11, gwave, nwaves, lane); }
            else if (!last) { { TIDS if (DRY_ROW) { rowwise_phase(pw, 1, nM * 256, l, 8, 0.5f, 5, l + 1, 0, 0, 11, gwave, nwaves, lane, 1); } rowwise_phase(pw, 1, nM * 256, l, 8, 0.5f, 5, l + 1, 0, 0, 11, gwave, nwaves, lane); } for (int rep = 0; rep < REP_CVT; ++rep) { TIDS convert_phase(pw, l + 1, shm, gwave, nwaves, wid, lane); } }
            else { TIDS rowwise_phase(pw, 2, MLAT, l, 8, 0.5f, 5, 0, 0, 0, 0, gwave, nwaves, lane); }
            gsync(bar, xst, G, wv);
        }
    }
}

extern "C" void kernel_launch(void* const* d_in, const int* in_sizes, int n_in, void* d_out, int out_size, void* d_ws, size_t ws_size, hipStream_t stream) {
    static int grid = 0;
    if (grid == 0) {
        if (n_in != 25 || ws_size < WS_END) { fprintf(stderr, "kernel_launch: unexpected n_in %d or ws_size %zu (need %zu)\n", n_in, ws_size, (size_t)WS_END); grid = -1; return; }
        int dev = 0, cus = 0, per_cu = 0;
        hipGetDevice(&dev); hipDeviceGetAttribute(&cus, hipDeviceAttributeMultiprocessorCount, dev);
        if (hipFuncSetAttribute((const void*)mega, hipFuncAttributeMaxDynamicSharedMemorySize, LDS_BYTES) != hipSuccess) { fprintf(stderr, "kernel_launch: hipFuncSetAttribute failed\n"); grid = -1; return; }
        if (hipOccupancyMaxActiveBlocksPerMultiprocessor(&per_cu, (const void*)mega, 512, LDS_BYTES) != hipSuccess || per_cu < 1) { fprintf(stderr, "kernel_launch: occupancy query failed (%d)\n", per_cu); per_cu = 1; }
        (void)hipGetLastError();
        grid = cus * per_cu;
    }
    if (grid < 0) return;
    if (hipMemsetAsync(d_ws, 0, 16384, stream) != hipSuccess) { fprintf(stderr, "kernel_launch: memset failed\n"); return; }
    Params p{};
    for (int i = 0; i < 25; ++i) p.in[i] = (const float*)d_in[i];
    p.out = (float*)d_out; p.ws = (unsigned char*)d_ws;
    void* args[] = {&p};
    hipError_t e = hipLaunchCooperativeKernel((const void*)mega, dim3(grid), dim3(512), args, LDS_BYTES, stream);
    if (e != hipSuccess) fprintf(stderr, "cooperative launch failed: %s (grid %d)\n", hipGetErrorString(e), grid);
}
```

```cpp
#include <hip/hip_runtime.h>
#include <hip/hip_cooperative_groups.h>
#include <cstdio>
namespace cg = cooperative_groups;

#define LAS __attribute__((address_space(3)))
#define DEVI __device__ __forceinline__
typedef unsigned short bf16_t;
typedef short bf16x8 __attribute__((ext_vector_type(8)));
typedef float f32x4 __attribute__((ext_vector_type(4)));
typedef float f32x2 __attribute__((ext_vector_type(2)));
typedef unsigned u32x4 __attribute__((ext_vector_type(4)));
typedef unsigned u32x2 __attribute__((ext_vector_type(2)));

constexpr int D = 1024, NBATCH = 4, SEQ = 4096, CTXL = 256, DEPTH = 4, DFF = 2816, DINP = 7936;
constexpr int MLAT = NBATCH * SEQ, MTOT = MLAT + NBATCH * CTXL;
constexpr int NCH = 68;
constexpr int C_MLQ = 0, C_MLK = 256, C_MLV = 512, C_MLO = 1024, C_MLG = 1536, C_LRX = 1552, C_LRY = 2064,
              C_DNQ = 2576, C_DNZ = 4112, C_DNBA = 4624, C_GATE = 4640, C_END = 7712;
constexpr float EPS = 1e-6f;

constexpr size_t SZ_WGU = (size_t)2 * DFF * D * 2, SZ_WDN = (size_t)D * DFF * 2;
constexpr size_t WS_MOD = 16384;
constexpr size_t WS_WGU = 1u << 20;
constexpr size_t WS_WDN = WS_WGU + 2 * SZ_WGU;
constexpr size_t WS_WIN = WS_WDN + 2 * SZ_WDN;
constexpr size_t WS_WBR = WS_WIN + (size_t)DINP * D * 2;
constexpr size_t WS_WOUT = WS_WBR + (size_t)3 * D * 512 * 2;
constexpr size_t WS_WLRU = WS_WOUT + (size_t)D * D * 2;
constexpr size_t WS_X = WS_WLRU + (size_t)32 * 64 * 64 * 2;
constexpr size_t WS_H = WS_X + (size_t)MTOT * D * 4;
constexpr size_t WS_Y = WS_H + (size_t)MTOT * D * 2;
constexpr size_t WS_P = WS_Y + (size_t)MTOT * D * 4;
constexpr size_t WS_GU = WS_P + (size_t)MTOT * DINP * 2;
constexpr size_t WS_GB = WS_GU + (size_t)2176 * 64 * 128 * 2;
constexpr size_t WS_GN = WS_GB + (size_t)2176 * 128 * 128 * 2;
constexpr size_t WS_SM = WS_GN + (size_t)2176 * 128 * 128 * 2;
constexpr size_t SM_GDEC = 0, SM_MN = 16384, SM_MSC = SM_MN + 2176 * 64 * 4, SM_MM = SM_MSC + 2176 * 8, SM_LAGG = SM_MM + 2176 * 4 + 1024;
constexpr size_t WS_YC = WS_SM + SM_LAGG + (size_t)2 * 4 * NCH * 512 * 2 * 4 + 4096;
constexpr size_t WS_GATES = WS_YC;
constexpr size_t WS_END = WS_GATES + (size_t)2 * 2176 * 320 * 4 + 4096;
constexpr int LDS_BYTES = 155648;
constexpr int REP_GU = 1, REP_DN = 1, REP_DNC = 1, REP_GEMM = 1, DRY_ROW = 0, REP_PREP = 1, REP_PREPSEQ = 1, REP_CVT = 1, REP_GDNP = 1, REP_MLP = 1, REP_LRU0 = 1;

struct Params { const float* in[25]; float* out; unsigned char* ws; };
struct PW { unsigned char* ws; };

#define CAS __attribute__((address_space(4)))
DEVI const float* pin(int i) { const CAS char* k = (const CAS char*)__builtin_amdgcn_kernarg_segment_ptr(); return *(const float* const volatile CAS*)(k + 8 * i); }
DEVI int opaque(int v) { asm volatile("" : "+v"(v)); return v; }
DEVI unsigned char* opq(unsigned char* p) { unsigned v = (unsigned)(size_t)(LAS unsigned char*)p; asm volatile("" : "+s"(v)); return (unsigned char*)(LAS unsigned char*)(size_t)v; }
DEVI LAS unsigned char* opql(LAS unsigned char* p) { unsigned v = (unsigned)(size_t)p; asm volatile("" : "+s"(v)); return (LAS unsigned char*)(size_t)v; }
DEVI unsigned char* opq64(unsigned char* p) { unsigned long long v = (unsigned long long)p; asm volatile("" : "+s"(v)); return (unsigned char*)v; }
#define MYTID opaque(wv * 64 + (int)__builtin_amdgcn_mbcnt_hi(~0u, __builtin_amdgcn_mbcnt_lo(~0u, 0u)))
DEVI float bf2f(bf16_t v) { return __uint_as_float(((unsigned)v) << 16); }
DEVI unsigned f2bf(float f) { unsigned u = __float_as_uint(f); return (u + 0x7fffu + ((u >> 16) & 1u)) >> 16; }
DEVI unsigned pk2(float lo, float hi) { return f2bf(lo) | (f2bf(hi) << 16); }
DEVI float sigm(float x) { return __builtin_amdgcn_rcpf(1.f + __expf(-x)); }
DEVI float silu(float x) { return x * sigm(x); }
DEVI float softplus(float x) { return x > 20.f ? x : log1pf(__expf(x)); }
DEVI float logsig(float x) { return fminf(x, 0.f) - log1pf(__expf(-fabsf(x))); }
DEVI float gelu_t(float x) { float u = 0.7978845608f * (x + 0.044715f * x * x * x); float e = __expf(2.f * u); return x * (1.f - __builtin_amdgcn_rcpf(e + 1.f)); }
DEVI float wsum(float v) { for (int o = 32; o > 0; o >>= 1) v += __shfl_xor(v, o, 64); return v; }
DEVI float wmax(float v) { for (int o = 32; o > 0; o >>= 1) v = fmaxf(v, __shfl_xor(v, o, 64)); return v; }
DEVI void unpack8(u32x4 r, float* f) {
    f[0] = __uint_as_float(r[0] << 16); f[1] = __uint_as_float(r[0] & 0xffff0000u); f[2] = __uint_as_float(r[1] << 16); f[3] = __uint_as_float(r[1] & 0xffff0000u);
    f[4] = __uint_as_float(r[2] << 16); f[5] = __uint_as_float(r[2] & 0xffff0000u); f[6] = __uint_as_float(r[3] << 16); f[7] = __uint_as_float(r[3] & 0xffff0000u);
}
DEVI u32x4 pack8(const float* f) { u32x4 r; r[0] = pk2(f[0], f[1]); r[1] = pk2(f[2], f[3]); r[2] = pk2(f[4], f[5]); r[3] = pk2(f[6], f[7]); return r; }
DEVI bf16x8 ldfrag(const bf16_t* base, int ld, int row0, int k0, int lane) { return *(const bf16x8*)(base + (row0 + (lane & 15)) * ld + k0 + (lane >> 4) * 8); }
DEVI int tix(int row, int col) { return row * 72 + ((((col >> 3) + (row >> 3)) & 7) << 3) + (col & 7); }
DEVI bf16x8 ldfragT(const bf16_t* base, int row0, int k0, int lane) { const int r = row0 + (lane & 15), lg = (k0 >> 3) + (lane >> 4); return *(const bf16x8*)(base + r * 72 + (((lg + (r >> 3)) & 7) << 3)); }
DEVI void lbar() { asm volatile("s_waitcnt lgkmcnt(0)" ::: "memory"); __builtin_amdgcn_s_barrier(); asm volatile("" ::: "memory"); }
#define MFMA16(a, b, c) __builtin_amdgcn_mfma_f32_16x16x32_bf16(a, b, c, 0, 0, 0)

namespace pg8 {
constexpr int BM = 256, BK = 64, HALF = 128, HTB = HALF * BK * 2, NXCD = 8, WGM = 8;
DEVI int lds_byte(int r, int c) { const int st = (r >> 4) * 2 + (c >> 5), rr = r & 15, cc = c & 31, ob = rr * 64 + cc * 2; return st * 1024 + (ob ^ (((ob >> 9) & 1) << 5)); }
DEVI void stage_rc(int b, int& R, int& C) { const int st = b / 1024, sb = b % 1024, swz = sb ^ (((sb >> 9) & 1) << 5); R = (st >> 1) * 16 + swz / 64; C = (st & 1) * 32 + (swz % 64) / 2; }
DEVI int perm32(int rho) { const int n = rho >> 4, i = rho & 15; return 8 * (i >> 2) + 4 * n + (i & 3); }
struct Unit { int pm, pn, z; };
struct Gemm { const bf16_t* A; const bf16_t* Bt; int nM, nN, K, lda, nz, zA0, zA1, zA2, zB; int ldb, zAstep; };
struct Order {
    int nM, nN, nwg, G, c, nz, pm0, spread;
    DEVI void init(int nM_, int nN_, int nz_, int G_, int c_, int pm0_ = 0, int spread_ = 0) { nM = nM_; nN = nN_; nwg = nM * nN; G = G_; c = c_; nz = nz_; pm0 = pm0_; spread = spread_; }
    DEVI bool next(int i, Unit& u) const {
        int ti = i, z = 0; long L;
        if (spread) { L = (long)i * G + c; if (L >= (long)nwg * nz) return false; z = (int)(L / nwg); L -= (long)z * nwg; }
        else { if (nz == 3) { ti = i / 3; z = i - ti * 3; } L = (long)ti * G + c; if (L >= nwg) return false; }
        int wgid = (int)L; { const int q = nwg / NXCD, r = nwg % NXCD, xcd = wgid % NXCD, off = wgid / NXCD; wgid = (xcd < r ? xcd * (q + 1) : r * (q + 1) + (xcd - r) * q) + off; }
        const int nig = WGM * nN, gid = wgid / nig, fm = gid * WGM, gsz = (nM - fm) < WGM ? (nM - fm) : WGM;
        u.pm = pm0 + fm + ((wgid % nig) % gsz); u.pn = (wgid % nig) / gsz; u.z = z; return true;
    }
};

template <class Epi>
DEVI void gemm_phase(LAS unsigned char* lds_in, const Gemm g, const Order& S, const Epi& E, int wv) {
    LAS unsigned char* lds = opql(lds_in);
    const int tid = MYTID, wid = __builtin_amdgcn_readfirstlane(tid >> 6), lane = tid & 63, wr = wid >> 2, wc = wid & 3, fr = lane & 15, fq = lane >> 4;
    const int K = g.K, nt = K / BK, lda = g.lda, ldb = g.ldb;
    unsigned voffA[2], voffB[2];
#pragma unroll
    for (int i = 0; i < 2; ++i) { int R, C; stage_rc(tid * 16 + i * 8192, R, C); const int Rb = Epi::PERM ? ((R & ~31) + perm32(R & 31)) : R;
        voffA[i] = (unsigned)(R * lda + C) * 2u; voffB[i] = (unsigned)(Rb * ldb + C) * 2u; }
    const size_t kstep = (size_t)(BK * 2);
    const size_t hstepA = (size_t)HALF * lda * 2, hstepB = (size_t)HALF * ldb * 2;
    const unsigned ldsw = (unsigned)wid * 1024u;
    const int aoff = lds_byte(wr * 64 + fr, fq * 8), boff = lds_byte(wc * 32 + fr, fq * 8);
#define PG8_SA(b, h) (((b) * 2 + (h)) * HTB)
#define PG8_SB(b, h) ((4 + (b) * 2 + (h)) * HTB)
#define PG8_STAGE(bufoff, gbase, voff) do { _Pragma("unroll") for (int _i = 0; _i < 2; ++_i) \
        __builtin_amdgcn_global_load_lds((const unsigned*)((const char*)(gbase) + (voff)[_i]), (LAS unsigned*)(lds + (bufoff) + ldsw + _i * 8192), 16, 0, 0); } while (0)
#define PG8_LDA(dst, b, h) do { _Pragma("unroll") for (int m = 0; m < 4; ++m) _Pragma("unroll") for (int k = 0; k < 2; ++k) dst[m][k] = *(const LAS bf16x8*)(lds + PG8_SA(b, h) + aoff + m * 2048 + k * 1024); } while (0)
#define PG8_LDB(dst, b, h) do { _Pragma("unroll") for (int n = 0; n < 2; ++n) _Pragma("unroll") for (int k = 0; k < 2; ++k) dst[n][k] = *(const LAS bf16x8*)(lds + PG8_SB(b, h) + boff + n * 2048 + k * 1024); } while (0)
#define PG8_MMA(ai, bj, At, Bt) do { __builtin_amdgcn_s_setprio(1); _Pragma("unroll") for (int m = 0; m < 4; ++m) _Pragma("unroll") for (int n = 0; n < 2; ++n) _Pragma("unroll") for (int k = 0; k < 2; ++k) \
        acc[ai][bj][m][n] = __builtin_amdgcn_mfma_f32_16x16x32_bf16(Bt[n][k], At[m][k], acc[ai][bj][m][n], 0, 0, 0); __builtin_amdgcn_s_setprio(0); } while (0)
#define PG8_WAIT_V(n) asm volatile("s_waitcnt vmcnt(" #n ")" ::: "memory")
#define PG8_WAIT_L(n) asm volatile("s_waitcnt lgkmcnt(" #n ")" ::: "memory")
#define PG8_BAR __builtin_amdgcn_s_barrier()
#define PG8_SCHED __builtin_amdgcn_sched_barrier(0)
#define PG8_PA(u) ((const char*)g.A + ((size_t)(g.nz == 3 ? ((u).z == 0 ? g.zA0 : ((u).z == 1 ? g.zA1 : g.zA2)) : (u).z * g.zAstep) + (size_t)(u).pm * BM * lda) * 2)
#define PG8_PB(u) ((const char*)g.Bt + ((size_t)(u).z * g.zB + (size_t)(u).pn * BM * ldb) * 2)
    Unit cur, nxt; int ui = 0;
    if (!S.next(0, cur)) return;
    f32x4 acc[2][2][4][2];
#pragma unroll
    for (int a = 0; a < 2; ++a)
#pragma unroll
        for (int b = 0; b < 2; ++b)
#pragma unroll
            for (int m = 0; m < 4; ++m)
#pragma unroll
                for (int n = 0; n < 2; ++n) acc[a][b][m][n] = (f32x4){0.f, 0.f, 0.f, 0.f};
    bf16x8 At[4][2], B0[2][2], B1[2][2];
    const char* cA = PG8_PA(cur); const char* cB = PG8_PB(cur);
    PG8_STAGE(PG8_SB(0, 0), cB, voffB); PG8_STAGE(PG8_SA(0, 0), cA, voffA); PG8_STAGE(PG8_SB(0, 1), cB + hstepB, voffB); PG8_STAGE(PG8_SA(0, 1), cA + hstepA, voffA);
    if (wr == 1) PG8_BAR;
    PG8_WAIT_V(4); PG8_BAR;
    PG8_STAGE(PG8_SB(1, 0), cB + kstep, voffB); PG8_STAGE(PG8_SA(1, 0), cA + kstep, voffA); PG8_STAGE(PG8_SB(1, 1), cB + hstepB + kstep, voffB);
    PG8_WAIT_V(6); PG8_BAR;
    for (;;) {
        const bool has_next = S.next(ui + 1, nxt);
        const char* nA = has_next ? PG8_PA(nxt) : cA; const char* nB = has_next ? PG8_PB(nxt) : cB;
        for (int t = 0; t < nt; t += 2) {
            const bool last = (t == nt - 2);
            const char* a1 = cA + (size_t)(t + 1) * kstep;
            const char* a2 = last ? nA : cA + (size_t)(t + 2) * kstep; const char* b2 = last ? nB : cB + (size_t)(t + 2) * kstep;
            const char* a3 = a2 + kstep; const char* b3 = b2 + kstep;
            PG8_LDB(B0, 0, 0); PG8_SCHED; PG8_LDA(At, 0, 0); PG8_STAGE(PG8_SA(1, 1), a1 + hstepA, voffA);
            PG8_WAIT_L(8); PG8_BAR; PG8_WAIT_L(0); PG8_MMA(0, 0, At, B0); PG8_BAR; PG8_SCHED;
            PG8_LDB(B1, 0, 1); PG8_STAGE(PG8_SB(0, 0), b2, voffB);
            PG8_BAR; PG8_WAIT_L(0); PG8_MMA(0, 1, At, B1); PG8_BAR;
            PG8_LDA(At, 0, 1); PG8_STAGE(PG8_SA(0, 0), a2, voffA);
            PG8_BAR; PG8_WAIT_L(0); PG8_MMA(1, 0, At, B0); PG8_BAR; PG8_SCHED;
            PG8_STAGE(PG8_SB(0, 1), b2 + hstepB, voffB);
            PG8_WAIT_V(6); PG8_BAR; PG8_MMA(1, 1, At, B1); PG8_BAR;
            PG8_LDB(B0, 1, 0); PG8_SCHED; PG8_LDA(At, 1, 0); PG8_STAGE(PG8_SA(0, 1), a2 + hstepA, voffA);
            PG8_WAIT_L(8); PG8_BAR; PG8_WAIT_L(0); PG8_MMA(0, 0, At, B0); PG8_BAR; PG8_SCHED;
            PG8_LDB(B1, 1, 1); PG8_STAGE(PG8_SB(1, 0), b3, voffB);
            PG8_BAR; PG8_WAIT_L(0); PG8_MMA(0, 1, At, B1); PG8_BAR;
            PG8_LDA(At, 1, 1); PG8_STAGE(PG8_SA(1, 0), a3, voffA);
            PG8_BAR; PG8_WAIT_L(0); PG8_MMA(1, 0, At, B0); PG8_BAR; PG8_SCHED;
            PG8_STAGE(PG8_SB(1, 1), b3 + hstepB, voffB);
            PG8_WAIT_V(6); PG8_BAR; PG8_MMA(1, 1, At, B1); PG8_BAR;
        }
        E(acc, cur, wr, wc, fr, fq);
        if (!has_next) break;
#pragma unroll
        for (int a = 0; a < 2; ++a)
#pragma unroll
            for (int b = 0; b < 2; ++b)
#pragma unroll
                for (int m = 0; m < 4; ++m)
#pragma unroll
                    for (int n = 0; n < 2; ++n) acc[a][b][m][n] = (f32x4){0.f, 0.f, 0.f, 0.f};
        cur = nxt; cA = nA; cB = nB; ++ui;
    }
    PG8_WAIT_V(0);
    if (wr == 0) PG8_BAR;
    PG8_BAR;
#undef PG8_SA
#undef PG8_SB
#undef PG8_STAGE
#undef PG8_LDA
#undef PG8_LDB
#undef PG8_MMA
#undef PG8_WAIT_V
#undef PG8_WAIT_L
#undef PG8_BAR
#undef PG8_SCHED
#undef PG8_PA
#undef PG8_PB
}

struct EpiF32 {
    static constexpr bool PERM = false;
    float* C; int ldc; int row_base; size_t zstride;
    DEVI void operator()(const f32x4 (&acc)[2][2][4][2], const Unit& u, int wr, int wc, int fr, int fq) const {
        const int row0 = u.pm * BM + wr * 64 + fr - row_base, col0 = u.pn * BM + wc * 32 + 4 * fq;
#pragma unroll
        for (int ai = 0; ai < 2; ++ai)
#pragma unroll
            for (int m = 0; m < 4; ++m) { float* rowp = C + (size_t)u.z * zstride + (size_t)(row0 + ai * HALF + m * 16) * ldc + col0;
#pragma unroll
                for (int bj = 0; bj < 2; ++bj)
#pragma unroll
                    for (int n = 0; n < 2; ++n) *(f32x4*)(rowp + bj * HALF + n * 16) = acc[ai][bj][m][n]; }
    }
};
struct EpiBf16Y {
    static constexpr bool PERM = true;
    bf16_t* O; int ldc;
    DEVI void operator()(const f32x4 (&acc)[2][2][4][2], const Unit& u, int wr, int wc, int fr, int fq) const {
        const int row0 = u.pm * BM + wr * 64 + fr;
#pragma unroll
        for (int bj = 0; bj < 2; ++bj) { const int c0 = u.pn * BM + bj * HALF + wc * 32 + 8 * fq;
#pragma unroll
            for (int ai = 0; ai < 2; ++ai)
#pragma unroll
                for (int m = 0; m < 4; ++m) { float v[8];
#pragma unroll
                    for (int n = 0; n < 2; ++n)
#pragma unroll
                        for (int i = 0; i < 4; ++i) v[n * 4 + i] = acc[ai][bj][m][n][i];
                    *(u32x4*)(O + (size_t)(row0 + ai * HALF + m * 16) * ldc + c0) = pack8(v); } }
    }
};
struct EpiAtomic {
    static constexpr bool PERM = false;
    float* C; int ldc; int row_base;
    DEVI void operator()(const f32x4 (&acc)[2][2][4][2], const Unit& u, int wr, int wc, int fr, int fq) const {
        const int row0 = u.pm * BM + wr * 64 + fr - row_base, col0 = u.pn * BM + wc * 32 + 4 * fq;
#pragma unroll
        for (int ai = 0; ai < 2; ++ai)
#pragma unroll
            for (int m = 0; m < 4; ++m) { float* rowp = C + (size_t)(row0 + ai * HALF + m * 16) * ldc + col0;
#pragma unroll
                for (int bj = 0; bj < 2; ++bj)
#pragma unroll
                    for (int n = 0; n < 2; ++n)
#pragma unroll
                        for (int e = 0; e < 4; ++e) __hip_atomic_fetch_add(rowp + bj * HALF + n * 16 + e, acc[ai][bj][m][n][e], __ATOMIC_RELAXED, __HIP_MEMORY_SCOPE_AGENT); }
    }
};
struct EpiSwiGLU {
    static constexpr bool PERM = false;
    bf16_t* O; int ldc;
    DEVI void operator()(const f32x4 (&acc)[2][2][4][2], const Unit& u, int wr, int wc, int fr, int fq) const {
        const int row0 = u.pm * BM + wr * 64 + fr, col0 = u.pn * 128 + wc * 32 + 8 * fq;
#pragma unroll
        for (int ai = 0; ai < 2; ++ai)
#pragma unroll
            for (int m = 0; m < 4; ++m) {
                float v[8];
#pragma unroll
                for (int bj = 0; bj < 2; ++bj)
#pragma unroll
                    for (int i = 0; i < 4; ++i) { const float gt = acc[ai][bj][m][0][i], up = acc[ai][bj][m][1][i]; v[bj * 4 + i] = silu(gt) * up; }
                *(u32x4*)(O + (size_t)(row0 + ai * HALF + m * 16) * ldc + col0) = pack8(v);
            }
    }
};
struct EpiInProj {
    static constexpr bool PERM = true;
    bf16_t* O; int ldc;
    DEVI void operator()(const f32x4 (&acc)[2][2][4][2], const Unit& u, int wr, int wc, int fr, int fq) const {
        const int row0 = u.pm * BM + wr * 64 + fr;
#pragma unroll
        for (int bj = 0; bj < 2; ++bj) {
            const int c0 = u.pn * BM + bj * HALF + wc * 32 + 8 * fq;
            int kind = 0;
            if (c0 >= C_MLO && c0 < C_MLG) kind = 1; else if (c0 >= C_LRY && c0 < C_DNQ) kind = 2; else if (c0 >= C_DNZ && c0 < C_DNBA) kind = 3; else if (c0 >= C_GATE) kind = 1;
#define INPROJ_STORE(FN) _Pragma("unroll") for (int ai = 0; ai < 2; ++ai) _Pragma("unroll") for (int m = 0; m < 4; ++m) { float v[8]; \
                _Pragma("unroll") for (int n = 0; n < 2; ++n) _Pragma("unroll") for (int i = 0; i < 4; ++i) { const float x = acc[ai][bj][m][n][i]; v[n * 4 + i] = FN; } \
                *(u32x4*)(O + (size_t)(row0 + ai * HALF + m * 16) * ldc + c0) = pack8(v); }
            if (kind == 0) { INPROJ_STORE(x) } else if (kind == 1) { INPROJ_STORE(sigm(x)) } else if (kind == 2) { INPROJ_STORE(gelu_t(x)) } else { INPROJ_STORE(silu(x)) }
#undef INPROJ_STORE
        }
    }
};
struct EpiBranch {
    static constexpr bool PERM = false;
    const bf16_t* P; float* T; bf16_t* U;
    DEVI void operator()(const f32x4 (&acc)[2][2][4][2], const Unit& u, int wr, int wc, int fr, int fq) const {
        const int row0 = u.pm * BM + wr * 64 + fr, col0 = u.pn * BM + wc * 32 + 4 * fq; const int z = u.z;
#pragma unroll
        for (int ai = 0; ai < 2; ++ai)
#pragma unroll
            for (int m = 0; m < 4; ++m) { const size_t row = (size_t)(row0 + ai * HALF + m * 16);
#pragma unroll
                for (int bj = 0; bj < 2; ++bj)
#pragma unroll
                    for (int n = 0; n < 2; ++n) { const int col = col0 + bj * HALF + n * 16;
                        const u32x2 gr = *(const u32x2*)(P + row * DINP + C_GATE + z * D + col);
                        f32x4 a = acc[ai][bj][m][n];
                        a[0] *= __uint_as_float(gr[0] << 16); a[1] *= __uint_as_float(gr[0] & 0xffff0000u); a[2] *= __uint_as_float(gr[1] << 16); a[3] *= __uint_as_float(gr[1] & 0xffff0000u);
                        float* tp = T + row * D + col;
                        if (z == 0) *(f32x4*)tp = a;
                        else if (z == 1) { f32x4 o = *(f32x4*)tp; *(f32x4*)tp = o + a; }
                        else { f32x4 o = *(f32x4*)tp; o = o + a; u32x2 w; w[0] = pk2(o[0], o[1]); w[1] = pk2(o[2], o[3]); *(u32x2*)(U + row * D + col) = w; }
                    } }
    }
};
}

DEVI int tok_row(bool gdn, int dir, int b, int c, int t) {
    if (c < 4) { int p = c * 64 + t; if (dir) p = 255 - p; return MLAT + b * 256 + p; }
    int p = (c - 4) * 64 + t; if (dir) p = 4095 - p;
    const int s = gdn ? ((p & 63) * 64 + (p >> 6)) : p;
    return b * 4096 + s;
}
DEVI int pos_row(bool gdn, int b, bool isctx, int p) {
    if (isctx) { if (p < 0 || p >= 256) return -1; return MLAT + b * 256 + p; }
    if (p < 0 || p >= 4096) return -1;
    const int s = gdn ? ((p & 63) * 64 + (p >> 6)) : p;
    return b * 4096 + s;
}
DEVI int dir_chunk(int dir, int j) { return dir ? (j < 4 ? 3 - j : 71 - j) : j; }

DEVI int gu_rowmap(int s) {
    const int n = s >= DFF ? 1 : 0, a = s - n * DFF, pn = a >> 7, r = a & 127, wc = r >> 5, fq = (r >> 3) & 3, bj = (r >> 2) & 1, i = r & 3;
    return 256 * pn + 128 * bj + 32 * wc + 16 * n + 4 * fq + i;
}
DEVI void cvt_tile(const float* src, int ldsrc, int Nvalid, int k0, int n0, bf16_t* dst, int lddst, int mode, float* buf, int lane) {
#pragma unroll 4
    for (int it = 0; it < 16; ++it) {
        const int row = it * 4 + (lane >> 4), c4 = (lane & 15) * 4;
        f32x4 v = (f32x4){0.f, 0.f, 0.f, 0.f};
        if (n0 + c4 < Nvalid) v = *(const f32x4*)(src + (size_t)(k0 + row) * ldsrc + n0 + c4);
        float* bp = buf + row * 65 + c4; bp[0] = v[0]; bp[1] = v[1]; bp[2] = v[2]; bp[3] = v[3];
    }
    asm volatile("s_waitcnt lgkmcnt(0)" ::: "memory"); __builtin_amdgcn_wave_barrier();
#pragma unroll 2
    for (int it = 0; it < 8; ++it) {
        const int nc = it * 8 + (lane >> 3), kk = (lane & 7) * 8;
        float f[8];
#pragma unroll
        for (int e = 0; e < 8; ++e) f[e] = buf[(kk + e) * 65 + nc];
        const int drow = mode == 1 ? gu_rowmap(n0 + nc) : (n0 + nc);
        *(u32x4*)(dst + (size_t)drow * lddst + k0 + kk) = pack8(f);
    }
    asm volatile("s_waitcnt lgkmcnt(0)" ::: "memory"); __builtin_amdgcn_wave_barrier();
}
DEVI void convert_phase(const PW& pw0, int l, unsigned char* shm_in, int gwave, int nwaves, int wid, int lane) {
    const PW p{opq64(pw0.ws)};
    unsigned char* shm = opq(shm_in);
    float* buf = (float*)shm + wid * (64 * 65);
    unsigned char* ws = p.ws;
    for (int t = gwave; t < 6880; t += nwaves) {
        int r = t;
        if (r < 2816) { const int f = r / 1408; r -= f * 1408; const int kt = r / 88, ntl = r % 88;
            cvt_tile(pin(7) + ((size_t)(l * 2 + f)) * D * 2 * DFF, 2 * DFF, 2 * DFF, kt * 64, ntl * 64, (bf16_t*)(ws + WS_WGU + f * SZ_WGU), D, 1, buf, lane); continue; }
        r -= 2816;
        if (r < 1408) { const int f = r / 704; r -= f * 704; const int kt = r / 16, ntl = r % 16;
            cvt_tile(pin(8) + ((size_t)(l * 2 + f)) * DFF * D, D, D, kt * 64, ntl * 64, (bf16_t*)(ws + WS_WDN + f * SZ_WDN), DFF, 0, buf, lane); continue; }
        r -= 1408;
        if (r < 1984) { const int kt = r / 124, ntl = r % 124;
            cvt_tile(pin(9) + (size_t)l * D * C_END, C_END, C_END, kt * 64, ntl * 64, (bf16_t*)(ws + WS_WIN), D, 0, buf, lane); continue; }
        r -= 1984;
        if (r < 384) { const int n = r / 128; r -= n * 128; const int kt = r / 16, ntl = r % 16;
            cvt_tile(pin(23) + ((size_t)(l * 3 + n)) * 512 * D, D, D, kt * 64, ntl * 64, (bf16_t*)(ws + WS_WBR) + (size_t)n * D * 512, 512, 0, buf, lane); continue; }
        r -= 384;
        if (r < 256) { const int kt = r / 16, ntl = r % 16;
            cvt_tile(pin(24) + (size_t)l * D * D, D, D, kt * 64, ntl * 64, (bf16_t*)(ws + WS_WOUT), D, 0, buf, lane); continue; }
        r -= 256;
        { const int gate = r >> 4, dn = r & 15;
            cvt_tile(pin(gate ? 16 : 14) + ((size_t)l * 16 + dn) * 4096, 64, 64, 0, 0, (bf16_t*)(ws + WS_WLRU) + (size_t)(gate * 16 + dn) * 4096, 64, 0, buf, lane); }
    }
}

DEVI void mod_phase(const PW& pw0, unsigned char* shm_in, int wv) {
    const PW p{opq64(pw0.ws)};
    unsigned char* shm = opq(shm_in);
    float* sC = (float*)shm;
    float* red = sC + 5 * 1024;
    const int tid = MYTID;
    __syncthreads();
    for (int i = tid; i < 5 * 1024; i += 512) { const int v = i >> 10, k = i & 1023; const float x = v < 4 ? pin(1)[v * 1024 + k] : pin(3)[k]; sC[i] = silu(x); }
    __syncthreads();
    float* MOD = (float*)(p.ws + WS_MOD);
    const int cgp = tid & 15, is = tid >> 4;
    for (int task = blockIdx.x; task < DEPTH * 144; task += gridDim.x) {
        const int l = task / 144, col0 = (task % 144) * 64;
        float acc[5][4];
#pragma unroll
        for (int v = 0; v < 5; ++v)
#pragma unroll
            for (int e = 0; e < 4; ++e) acc[v][e] = 0.f;
        const float* wp = pin(4) + ((size_t)l * 1024 + is * 32) * 9216 + col0 + cgp * 4;
#pragma unroll 8
        for (int r = 0; r < 32; ++r) {
            const f32x4 w = *(const f32x4*)(wp + (size_t)r * 9216);
#pragma unroll
            for (int v = 0; v < 5; ++v) { const float s = sC[v * 1024 + is * 32 + r];
#pragma unroll
                for (int e = 0; e < 4; ++e) acc[v][e] += s * w[e]; }
        }
#pragma unroll
        for (int v = 0; v < 5; ++v)
#pragma unroll
            for (int e = 0; e < 4; ++e) red[tid * 20 + v * 4 + e] = acc[v][e];
        __syncthreads();
        if (tid < 320) { const int v = tid >> 6, c = tid & 63; float s = 0.f;
            for (int k = 0; k < 32; ++k) s += red[(k * 16 + (c >> 2)) * 20 + v * 4 + (c & 3)];
            MOD[((size_t)(l * 5 + v)) * 9216 + col0 + c] = s + pin(5)[(size_t)l * 9216 + col0 + c]; }
        __syncthreads();
    }
}

DEVI void rowwise_phase(const PW& pw0, int mode, int nrows, int l, int kgate, float coef, int gpost_i, int ln, int gpre_i, int kshift, int nzc, int gwave, int nwaves, int lane, int dry = 0) {
    const PW p{opq64(pw0.ws)};
    float* X = (float*)(p.ws + WS_X); float* Xw = dry ? (float*)(p.ws + WS_GN) : X; const float* Y0 = (const float*)(p.ws + WS_Y); const float* YC = (const float*)(p.ws + WS_GB); bf16_t* H = dry ? (bf16_t*)(p.ws + WS_GU) : (bf16_t*)(p.ws + WS_H);
    const float* MOD = (const float*)(p.ws + WS_MOD);
    for (int row = gwave; row < nrows; row += nwaves) {
        const int v = row < MLAT ? (row >> 12) : 4;
        f32x4 x[4];
        if (mode == 0) {
            const float* src = row < MLAT ? pin(0) + (size_t)row * D : pin(2) + (size_t)(row - MLAT) * D;
#pragma unroll
            for (int i = 0; i < 4; ++i) x[i] = *(const f32x4*)(src + lane * 4 + 256 * i);
        } else {
            f32x4 y[4]; float ss = 0.f;
            const float* Y = YC + (size_t)(row - MLAT) * D; const bf16_t* Yl = (const bf16_t*)Y0 + (size_t)row * D;
            if (row >= MLAT) {
#pragma unroll
                for (int ih = 0; ih < 2; ++ih) {
                    f32x4 t[11][2];
#pragma unroll
                    for (int z = 0; z < 11; ++z)
#pragma unroll
                        for (int i2 = 0; i2 < 2; ++i2) t[z][i2] = z < nzc ? *(const f32x4*)(Y + (size_t)z * 1024 * D + lane * 4 + 256 * (ih * 2 + i2)) : (f32x4){0.f, 0.f, 0.f, 0.f};
#pragma unroll
                    for (int i2 = 0; i2 < 2; ++i2) { f32x4 a = t[0][i2];
#pragma unroll
                        for (int z = 1; z < 11; ++z) a = a + t[z][i2];
                        y[ih * 2 + i2] = a; }
                }
            }
#pragma unroll
            for (int i = 0; i < 4; ++i) { if (row < MLAT) { const u32x2 r2 = *(const u32x2*)(Yl + lane * 4 + 256 * i); y[i] = (f32x4){__uint_as_float(r2[0] << 16), __uint_as_float(r2[0] & 0xffff0000u), __uint_as_float(r2[1] << 16), __uint_as_float(r2[1] & 0xffff0000u)}; } x[i] = *(const f32x4*)(X + (size_t)row * D + lane * 4 + 256 * i); }
#pragma unroll
            for (int i = 0; i < 4; ++i) ss += y[i][0] * y[i][0] + y[i][1] * y[i][1] + y[i][2] * y[i][2] + y[i][3] * y[i][3];
            ss = wsum(ss); const float rs = rsqrtf(ss * (1.f / D) + EPS) * coef;
            const float* gp = pin(6) + ((size_t)l * 6 + gpost_i) * D; const float* gt = MOD + ((size_t)(l * 5 + v) * 9 + kgate) * D;
#pragma unroll
            for (int i = 0; i < 4; ++i) { const f32x4 g = *(const f32x4*)(gp + lane * 4 + 256 * i), m = *(const f32x4*)(gt + lane * 4 + 256 * i);
                x[i] = x[i] + m * (y[i] * rs * g); }
        }
        if (mode == 2) {
#pragma unroll
            for (int i = 0; i < 4; ++i) *(f32x4*)((float*)pin(25) + (size_t)row * D + lane * 4 + 256 * i) = x[i];
            continue;
        }
#pragma unroll
        for (int i = 0; i < 4; ++i) *(f32x4*)(Xw + (size_t)row * D + lane * 4 + 256 * i) = x[i];
        float ss = 0.f;
#pragma unroll
        for (int i = 0; i < 4; ++i) ss += x[i][0] * x[i][0] + x[i][1] * x[i][1] + x[i][2] * x[i][2] + x[i][3] * x[i][3];
        ss = wsum(ss); const float rs = rsqrtf(ss * (1.f / D) + EPS);
        const float* gp = pin(6) + ((size_t)ln * 6 + gpre_i) * D; const float* sh = MOD + ((size_t)(ln * 5 + v) * 9 + kshift) * D; const float* sc = sh + D;
#pragma unroll
        for (int i = 0; i < 4; ++i) { const f32x4 g = *(const f32x4*)(gp + lane * 4 + 256 * i), a = *(const f32x4*)(sh + lane * 4 + 256 * i), s = *(const f32x4*)(sc + lane * 4 + 256 * i);
            const f32x4 h = x[i] * rs * g * (s + 1.f) + a; u32x2 w; w[0] = pk2(h[0], h[1]); w[1] = pk2(h[2], h[3]);
            *(u32x2*)(H + (size_t)row * D + lane * 4 + 256 * i) = w; }
    }
}

DEVI void gdn_load(const bf16_t* P, const float* convw, int b, int c, int h, int dir, int want, bf16_t* sQ, bf16_t* sK, bf16_t* sKT, bf16_t* sVT, int tid) {
    const bool isctx = c < 4;
#pragma unroll
    for (int r = 0; r < 6; ++r) {
        const int task = tid + 512 * r, seg = r >> 1, rem = task & 1023, t = rem >> 4, cgp = rem & 15;
        if (seg == 0 && !(want & 1)) continue;
        if (seg == 1 && !(want & 6)) continue;
        if (seg == 2 && !(want & 8)) continue;
        int p = (isctx ? c : c - 4) * 64 + t; if (dir) p = (isctx ? 255 : 4095) - p;
        const int ch = seg * 512 + h * 128 + cgp * 8;
        float a[8];
#pragma unroll
        for (int e = 0; e < 8; ++e) a[e] = 0.f;
#pragma unroll
        for (int j = 0; j < 4; ++j) {
            const int row = pos_row(true, b, isctx, p + j - 2);
            if (row >= 0) {
                const u32x4 raw = *(const u32x4*)(P + (size_t)row * DINP + C_DNQ + ch); float x[8]; unpack8(raw, x);
                const f32x4 w0 = *(const f32x4*)(convw + j * 1536 + ch), w1 = *(const f32x4*)(convw + j * 1536 + ch + 4);
                a[0] += w0[0] * x[0]; a[1] += w0[1] * x[1]; a[2] += w0[2] * x[2]; a[3] += w0[3] * x[3];
                a[4] += w1[0] * x[4]; a[5] += w1[1] * x[5]; a[6] += w1[2] * x[6]; a[7] += w1[3] * x[7];
            }
        }
        float ss = 0.f;
#pragma unroll
        for (int e = 0; e < 8; ++e) { a[e] = silu(a[e]); ss += a[e] * a[e]; }
        if (seg < 2) {
            ss += __shfl_xor(ss, 1, 64); ss += __shfl_xor(ss, 2, 64); ss += __shfl_xor(ss, 4, 64); ss += __shfl_xor(ss, 8, 64);
            float inv = rsqrtf(ss + EPS); if (seg == 0) inv *= 0.08838834764831845f;
#pragma unroll
            for (int e = 0; e < 8; ++e) a[e] *= inv;
        }
        if (seg == 0) *(u32x4*)(sQ + t * 136 + cgp * 8) = pack8(a);
        else if (seg == 1) {
            if (want & 2) *(u32x4*)(sK + t * 136 + cgp * 8) = pack8(a);
            if (want & 4) {
#pragma unroll
                for (int e = 0; e < 8; ++e) sKT[tix(cgp * 8 + e, t)] = (bf16_t)f2bf(a[e]); }
        } else {
#pragma unroll
            for (int e = 0; e < 8; ++e) sVT[tix(cgp * 8 + e, t)] = (bf16_t)f2bf(a[e]);
        }
    }
}
DEVI void gdn_gates(const PW& p, const bf16_t* P, int l, int b, int c, int h, int dir, float* sc, int lane) {
    const int row = tok_row(true, dir, b, c, lane);
    const float bb = bf2f(P[(size_t)row * DINP + C_DNBA + dir * 4 + h]), aa = bf2f(P[(size_t)row * DINP + C_DNBA + 8 + dir * 4 + h]);
    const float beta = sigm(bb);
    const float g = -__expf(pin(20)[l * 8 + dir * 4 + h]) * softplus(aa + pin(21)[l * 8 + dir * 4 + h]);
    float G = g;
#pragma unroll
    for (int o = 1; o < 64; o <<= 1) { const float t = __shfl_up(G, o, 64); if (lane >= o) G += t; }
    const float GT = __shfl(G, 63, 64);
    sc[lane] = G; sc[64 + lane] = beta; sc[128 + lane] = __expf(G); sc[192 + lane] = __expf(GT - G); if (lane == 0) sc[256] = __expf(GT);
}

DEVI void gdn_prep_item(const PW& pw0, int l, int item, unsigned char* shm_in, int wv) {
    const PW p{opq64(pw0.ws)};
    unsigned char* shm = opq(shm_in);
    const int tid = MYTID, wid = __builtin_amdgcn_readfirstlane(tid >> 6), lane = tid & 63, fr = lane & 15, fq = lane >> 4;
    const int c = item % NCH, h = (item / NCH) & 3, b = (item / (NCH * 4)) & 3, dir = item / (NCH * 16);
    const bf16_t* P = (const bf16_t*)(p.ws + WS_P);
    bf16_t* sK = (bf16_t*)shm;
    bf16_t* sKT = (bf16_t*)(shm + 17408);
    bf16_t* sVT = (bf16_t*)(shm + 35840);
    float* sTm = (float*)(shm + 54272);
    bf16_t* sT1 = (bf16_t*)(shm + 71680);
    bf16_t* sT2 = (bf16_t*)(shm + 80896);
    bf16_t* sWT = (bf16_t*)(shm + 90112);
    bf16_t* sUT = (bf16_t*)(shm + 108544);
    float* sc = (float*)(shm + 126976);
    if (tid < 257) sc[tid] = ((const float*)(p.ws + WS_GATES))[(size_t)item * 320 + tid];
    gdn_load(P, pin(19) + (size_t)l * 4 * 1536, b, c, h, dir, 2 | 4 | 8, nullptr, sK, sKT, sVT, tid);
    lbar();
#pragma unroll
    for (int ti = 0; ti < 2; ++ti) {
        const int tile = wid * 2 + ti, mt = tile >> 2, nt = tile & 3;
        f32x4 acc = (f32x4){0.f, 0.f, 0.f, 0.f};
#pragma unroll
        for (int kk = 0; kk < 4; ++kk) acc = MFMA16(ldfrag(sK, 136, mt * 16, kk * 32, lane), ldfrag(sK, 136, nt * 16, kk * 32, lane), acc);
        const int s = nt * 16 + fr;
#pragma unroll
        for (int j = 0; j < 4; ++j) { const int t = mt * 16 + fq * 4 + j; sTm[t * 68 + s] = s < t ? sc[64 + t] * acc[j] * __expf(sc[t] - sc[s]) : 0.f; }
    }
    lbar();
    float* tmpY = (float*)sWT;
    if (wid < 4) {
        const int o = wid * 16, c = lane & 15;
        int lz; asm volatile("v_mov_b32 %0, 0" : "=v"(lz));
        const float* tm = sTm + lz;
        float x[16];
#pragma unroll
        for (int t = 0; t < 16; ++t) {
            float v = -sTm[(o + t) * 68 + o + c];
#pragma unroll
            for (int s4 = 0; s4 < (t + 3) / 4; ++s4) {
                const f32x4 a = *(const f32x4*)(tm + (o + t) * 68 + o + s4 * 4);
#pragma unroll
                for (int e = 0; e < 4; ++e) if (s4 * 4 + e < t) v -= a[e] * x[s4 * 4 + e];
            }
            x[t] = v;
        }
        asm volatile("s_waitcnt lgkmcnt(0)" ::: "memory");
        if (lane < 16) {
#pragma unroll
            for (int t = 0; t < 16; ++t) sTm[(o + t) * 68 + o + c] = x[t] + (t == c ? 1.f : 0.f);
        }
    }
    lbar();
    {
        const int blk = tid >> 8, r = (tid >> 4) & 15, c = tid & 15, ib = (blk ? 3 : 1) * 16, jb = ib - 16;
        float y = 0.f;
#pragma unroll
        for (int s2 = 0; s2 < 16; ++s2) y += sTm[(ib + r) * 68 + jb + s2] * sTm[(jb + s2) * 68 + jb + c];
        tmpY[blk * 272 + r * 17 + c] = y;
        lbar();
        float z = 0.f;
#pragma unroll
        for (int s2 = 0; s2 < 16; ++s2) z += sTm[(ib + r) * 68 + ib + s2] * tmpY[blk * 272 + s2 * 17 + c];
        lbar();
        sTm[(ib + r) * 68 + jb + c] = -z;
    }
    lbar();
    {
        float y[2];
#pragma unroll
        for (int u = 0; u < 2; ++u) { const int o = tid + 512 * u, r = o >> 5, c = o & 31; float a = 0.f;
#pragma unroll 8
            for (int s2 = 0; s2 < 32; ++s2) a += sTm[(32 + r) * 68 + s2] * sTm[s2 * 68 + c];
            y[u] = a; }
#pragma unroll
        for (int u = 0; u < 2; ++u) { const int o = tid + 512 * u, r = o >> 5, c = o & 31; tmpY[r * 33 + c] = y[u]; }
        lbar();
#pragma unroll
        for (int u = 0; u < 2; ++u) { const int o = tid + 512 * u, r = o >> 5, c = o & 31; float a = 0.f;
#pragma unroll 8
            for (int s2 = 0; s2 < 32; ++s2) a += sTm[(32 + r) * 68 + 32 + s2] * tmpY[s2 * 33 + c];
            y[u] = a; }
#pragma unroll
        for (int u = 0; u < 2; ++u) { const int o = tid + 512 * u, r = o >> 5, c = o & 31; sTm[(32 + r) * 68 + c] = -y[u]; }
    }
    lbar();
#pragma unroll
    for (int u = 0; u < 8; ++u) {
        const int o = tid + 512 * u, t = o >> 6, s2 = o & 63; const float xv = sTm[t * 68 + s2], bt = sc[64 + s2];
        sT1[t * 72 + s2] = (bf16_t)f2bf(xv * bt * sc[128 + s2]); sT2[t * 72 + s2] = (bf16_t)f2bf(xv * bt);
    }
    lbar();
    bf16_t* GW = (bf16_t*)(p.ws + WS_H) + (size_t)item * 64 * 128;
    bf16_t* GU = (bf16_t*)(p.ws + WS_GU) + (size_t)item * 64 * 128;
    {
        const int tid2 = opaque(tid), lane = tid2 & 63, fr = lane & 15, fq = lane >> 4;
        const int mt = wid;
#pragma unroll
        for (int nt = 0; nt < 4; ++nt) {
            f32x4 aw = (f32x4){0.f, 0.f, 0.f, 0.f}, au = aw;
#pragma unroll
            for (int kk = 0; kk < 2; ++kk) { aw = MFMA16(ldfragT(sKT, mt * 16, kk * 32, lane), ldfrag(sT1, 72, nt * 16, kk * 32, lane), aw);
                au = MFMA16(ldfragT(sVT, mt * 16, kk * 32, lane), ldfrag(sT2, 72, nt * 16, kk * 32, lane), au); }
            const int t = nt * 16 + fr, r0 = mt * 16 + fq * 4; const float dec = sc[192 + t];
            u32x2 w; w[0] = pk2(aw[0], aw[1]); w[1] = pk2(aw[2], aw[3]); *(u32x2*)(GW + t * 128 + r0) = w;
            w[0] = pk2(au[0], au[1]); w[1] = pk2(au[2], au[3]); *(u32x2*)(GU + t * 128 + r0) = w;
#pragma unroll
            for (int j = 0; j < 4; ++j) { sWT[tix(r0 + j, t)] = (bf16_t)f2bf(aw[j] * dec); sUT[tix(r0 + j, t)] = (bf16_t)f2bf(au[j] * dec); }
        }
    }
    lbar();
    bf16_t* GB = (bf16_t*)(p.ws + WS_GB) + (size_t)item * 128 * 128;
    bf16_t* GN = (bf16_t*)(p.ws + WS_GN) + (size_t)item * 128 * 128;
    {
        const int tid2 = opaque(tid), lane = tid2 & 63, fr = lane & 15, fq = lane >> 4;
        const int mt = wid;
#pragma unroll
        for (int nt = 0; nt < 8; ++nt) {
            f32x4 ab = (f32x4){0.f, 0.f, 0.f, 0.f}, an = ab;
#pragma unroll
            for (int kk = 0; kk < 2; ++kk) { ab = MFMA16(ldfragT(sWT, mt * 16, kk * 32, lane), ldfragT(sKT, nt * 16, kk * 32, lane), ab);
                an = MFMA16(ldfragT(sKT, mt * 16, kk * 32, lane), ldfragT(sUT, nt * 16, kk * 32, lane), an); }
            const int cc = nt * 16 + fr, r0 = mt * 16 + fq * 4;
            u32x2 w; w[0] = pk2(-ab[0], -ab[1]); w[1] = pk2(-ab[2], -ab[3]); *(u32x2*)(GB + cc * 128 + r0) = w;
            w[0] = pk2(an[0], an[1]); w[1] = pk2(an[2], an[3]); *(u32x2*)(GN + cc * 128 + r0) = w;
        }
    }
    if (tid == 0) ((float*)(p.ws + WS_SM + SM_GDEC))[item] = sc[256];
    lbar();
}

DEVI void gdn_seq_unit(const PW& pw0, int unit, unsigned char* shm_in, int wv) {
    const PW p{opq64(pw0.ws)};
    unsigned char* shm = opq(shm_in);
    const int tid = MYTID, wid = __builtin_amdgcn_readfirstlane(tid >> 6), lane = tid & 63, fr = lane & 15, fq = lane >> 4;
    const int chain = unit >> 3, es = unit & 7;
    bf16_t* sS = (bf16_t*)shm;
    const bf16_t* GB = (const bf16_t*)(p.ws + WS_GB) + (size_t)chain * NCH * 16384;
    bf16_t* GN = (bf16_t*)(p.ws + WS_GN) + (size_t)chain * NCH * 16384;
    const float* GDEC = (const float*)(p.ws + WS_SM + SM_GDEC) + chain * NCH;
    f32x4 acc = (f32x4){0.f, 0.f, 0.f, 0.f};
    constexpr int PF = 4;
    bf16x8 an[PF][4]; u32x2 nn[PF]; float dn[PF];
    const size_t aoff = (size_t)(wid * 16 + fr) * 128 + fq * 8, noff = (size_t)(es * 16 + fr) * 128 + wid * 16 + fq * 4;
#pragma unroll
    for (int u = 0; u < PF; ++u) {
#pragma unroll
        for (int kk = 0; kk < 4; ++kk) an[u][kk] = *(const bf16x8*)(GB + (size_t)u * 16384 + aoff + kk * 32);
        nn[u] = *(const u32x2*)(GN + (size_t)u * 16384 + noff); dn[u] = GDEC[u];
    }
#pragma unroll 1
    for (int c0 = 0; c0 < NCH; c0 += PF) {
#pragma unroll
        for (int u = 0; u < PF; ++u) {
            const int c = c0 + u;
            bf16x8 a[4]; const u32x2 ncur = nn[u]; const float dcur = dn[u];
#pragma unroll
            for (int kk = 0; kk < 4; ++kk) a[kk] = an[u][kk];
            u32x2 sw; sw[0] = pk2(acc[0], acc[1]); sw[1] = pk2(acc[2], acc[3]);
            bf16_t* sb = sS + (c & 1) * (16 * 136);
            *(u32x2*)(sb + fr * 136 + wid * 16 + fq * 4) = sw;
            *(u32x2*)(GN + (size_t)c * 16384 + noff) = sw;
            if (c + PF < NCH) {
#pragma unroll
                for (int kk = 0; kk < 4; ++kk) an[u][kk] = *(const bf16x8*)(GB + (size_t)(c + PF) * 16384 + aoff + kk * 32);
                nn[u] = *(const u32x2*)(GN + (size_t)(c + PF) * 16384 + noff); dn[u] = GDEC[c + PF];
            }
            lbar();
            acc[0] = dcur * acc[0] + __uint_as_float(ncur[0] << 16); acc[1] = dcur * acc[1] + __uint_as_float(ncur[0] & 0xffff0000u);
            acc[2] = dcur * acc[2] + __uint_as_float(ncur[1] << 16); acc[3] = dcur * acc[3] + __uint_as_float(ncur[1] & 0xffff0000u);
#pragma unroll
            for (int kk = 0; kk < 4; ++kk) acc = MFMA16(a[kk], ldfrag(sb, 136, 0, kk * 32, lane), acc);
        }
    }
    lbar();
}

DEVI void gdn_out_item(const PW& pw0, int l, int item, unsigned char* shm_in, int wv) {
    const PW p{opq64(pw0.ws)};
    unsigned char* shm = opq(shm_in);
    const int tid = MYTID, wid = __builtin_amdgcn_readfirstlane(tid >> 6), lane = tid & 63, fr = lane & 15, fq = lane >> 4;
    const int j = item % NCH, h = (item / NCH) & 3, b = item / (NCH * 4);
    bf16_t* P = (bf16_t*)(p.ws + WS_P);
    bf16_t* sQ = (bf16_t*)shm;
    bf16_t* sK = (bf16_t*)(shm + 17408);
    bf16_t* sST = (bf16_t*)(shm + 34816);
    bf16_t* sW = (bf16_t*)(shm + 69632);
    bf16_t* sVN = (bf16_t*)(shm + 87040);
    bf16_t* sA2 = (bf16_t*)(shm + 105472);
    float* sO = (float*)(shm + 114688);
    float* sc = (float*)(shm + 148480);
#pragma unroll 1
    for (int dir = 0; dir < 2; ++dir) {
        const int c = dir_chunk(dir, j);
        const int it2 = ((dir * 4 + b) * 4 + h) * NCH + c;
        if (tid < 257) sc[tid] = ((const float*)(p.ws + WS_GATES))[(size_t)it2 * 320 + tid];
        gdn_load(P, pin(19) + (size_t)l * 4 * 1536, b, c, h, dir, 1 | 2, sQ, sK, nullptr, nullptr, tid);
        const bf16_t* GS = (const bf16_t*)(p.ws + WS_GN) + (size_t)it2 * 16384;
        const bf16_t* GW = (const bf16_t*)(p.ws + WS_H) + (size_t)it2 * 8192;
        const bf16_t* GU = (const bf16_t*)(p.ws + WS_GU) + (size_t)it2 * 8192;
#pragma unroll
        for (int r = 0; r < 4; ++r) { const int idx = tid + 512 * r, row = idx >> 4, cg8 = (idx & 15) * 8; *(u32x4*)(sST + row * 136 + cg8) = *(const u32x4*)(GS + row * 128 + cg8); }
#pragma unroll
        for (int r = 0; r < 2; ++r) { const int idx = tid + 512 * r, row = idx >> 4, cg8 = (idx & 15) * 8; *(u32x4*)(sW + row * 136 + cg8) = *(const u32x4*)(GW + row * 128 + cg8); }
        lbar();
        {
            const int mt = wid;
#pragma unroll
            for (int nt = 0; nt < 4; ++nt) {
                f32x4 a = (f32x4){0.f, 0.f, 0.f, 0.f};
#pragma unroll
                for (int kk = 0; kk < 4; ++kk) a = MFMA16(ldfrag(sST, 136, mt * 16, kk * 32, lane), ldfrag(sW, 136, nt * 16, kk * 32, lane), a);
                const int t = nt * 16 + fr, e0 = mt * 16 + fq * 4;
                const u32x2 ur = *(const u32x2*)(GU + t * 128 + e0);
                sVN[(e0 + 0) * 72 + t] = (bf16_t)f2bf(__uint_as_float(ur[0] << 16) - a[0]); sVN[(e0 + 1) * 72 + t] = (bf16_t)f2bf(__uint_as_float(ur[0] & 0xffff0000u) - a[1]);
                sVN[(e0 + 2) * 72 + t] = (bf16_t)f2bf(__uint_as_float(ur[1] << 16) - a[2]); sVN[(e0 + 3) * 72 + t] = (bf16_t)f2bf(__uint_as_float(ur[1] & 0xffff0000u) - a[3]);
            }
#pragma unroll
            for (int ti = 0; ti < 2; ++ti) {
                const int tile = wid * 2 + ti, m2 = tile >> 2, n2 = tile & 3;
                f32x4 a = (f32x4){0.f, 0.f, 0.f, 0.f};
#pragma unroll
                for (int kk = 0; kk < 4; ++kk) a = MFMA16(ldfrag(sQ, 136, m2 * 16, kk * 32, lane), ldfrag(sK, 136, n2 * 16, kk * 32, lane), a);
                const int s = n2 * 16 + fr;
#pragma unroll
                for (int jj = 0; jj < 4; ++jj) { const int t = m2 * 16 + fq * 4 + jj; sA2[t * 72 + s] = (bf16_t)f2bf(s <= t ? a[jj] * __expf(sc[t] - sc[s]) : 0.f); }
            }
        }
        lbar();
        {
            const int nt = wid;
#pragma unroll
            for (int mt = 0; mt < 4; ++mt) {
                f32x4 a = (f32x4){0.f, 0.f, 0.f, 0.f};
#pragma unroll
                for (int kk = 0; kk < 4; ++kk) a = MFMA16(ldfrag(sQ, 136, mt * 16, kk * 32, lane), ldfrag(sST, 136, nt * 16, kk * 32, lane), a);
#pragma unroll
                for (int jj = 0; jj < 4; ++jj) a[jj] *= sc[128 + mt * 16 + fq * 4 + jj];
#pragma unroll
                for (int kk = 0; kk < 2; ++kk) a = MFMA16(ldfrag(sA2, 72, mt * 16, kk * 32, lane), ldfrag(sVN, 72, nt * 16, kk * 32, lane), a);
                const int e = nt * 16 + fr;
#pragma unroll
                for (int jj = 0; jj < 4; ++jj) { const int t = mt * 16 + fq * 4 + jj; const int i = dir ? 63 - t : t; if (dir) sO[i * 132 + e] += a[jj]; else sO[i * 132 + e] = a[jj]; }
            }
        }
        lbar();
    }
    {
        const int i = tid >> 3, e0 = (tid & 7) * 16;
        float v[16], ss = 0.f;
#pragma unroll
        for (int e = 0; e < 16; ++e) { v[e] = sO[i * 132 + e0 + e]; ss += v[e] * v[e]; }
        ss += __shfl_xor(ss, 1, 64); ss += __shfl_xor(ss, 2, 64); ss += __shfl_xor(ss, 4, 64);
        const float rs = rsqrtf(ss * (1.f / 128.f) + EPS);
        const int row = tok_row(true, 0, b, j, i);
        bf16_t* zp = P + (size_t)row * DINP + C_DNZ + h * 128 + e0;
        const float* g = pin(22) + l * 128 + e0;
#pragma unroll
        for (int half = 0; half < 2; ++half) {
            float z[8]; unpack8(*(const u32x4*)(zp + half * 8), z); float o[8];
#pragma unroll
            for (int e = 0; e < 8; ++e) o[e] = v[half * 8 + e] * rs * g[half * 8 + e] * z[e];
            *(u32x4*)(zp + half * 8) = pack8(o);
        }
    }
    lbar();
}

DEVI float ml_gates(const PW& p, const bf16_t* P, int l, int b, int c, int h, int dir, float* sc, int lane) {
    const int row = tok_row(false, dir, b, c, lane);
    const float ig = bf2f(P[(size_t)row * DINP + C_MLG + dir * 4 + h]) + pin(10)[l * 16 + dir * 4 + h];
    const float fg = bf2f(P[(size_t)row * DINP + C_MLG + (2 + dir) * 4 + h]) + pin(10)[l * 16 + (2 + dir) * 4 + h];
    float bb = logsig(fg);
#pragma unroll
    for (int o = 1; o < 64; o <<= 1) { const float t = __shfl_up(bb, o, 64); if (lane >= o) bb += t; }
    sc[lane] = bb; sc[64 + lane] = ig;
    return __shfl(bb, 63, 64);
}
DEVI void ml_prep_item(const PW& pw0, int l, int item, unsigned char* shm_in, int wv) {
    const PW p{opq64(pw0.ws)};
    unsigned char* shm = opq(shm_in);
    const int tid = MYTID, wid = __builtin_amdgcn_readfirstlane(tid >> 6), lane = tid & 63, fr = lane & 15, fq = lane >> 4;
    const int c = item % NCH, h = (item / NCH) & 3, b = (item / (NCH * 4)) & 3, dir = item / (NCH * 16);
    const bf16_t* P = (const bf16_t*)(p.ws + WS_P);
    bf16_t* sKT = (bf16_t*)shm;
    bf16_t* sVT = (bf16_t*)(shm + 9216);
    float* sc = (float*)(shm + 27648);
    const float* gp = (const float*)(p.ws + WS_GATES) + (size_t)(2176 + item) * 320;
    if (tid < 64) sc[128 + tid] = gp[128 + tid];
    {
        const int t = tid >> 3, cg8 = (tid & 7) * 8; const int row = tok_row(false, dir, b, c, t);
        float x[8]; unpack8(*(const u32x4*)(P + (size_t)row * DINP + C_MLK + h * 64 + cg8), x);
#pragma unroll
        for (int e = 0; e < 8; ++e) sKT[tix(cg8 + e, t)] = (bf16_t)f2bf(x[e]);
    }
#pragma unroll
    for (int r = 0; r < 2; ++r) {
        const int idx = tid + 512 * r, t = idx >> 4, cg8 = (idx & 15) * 8; const int row = tok_row(false, dir, b, c, t);
        float x[8]; unpack8(*(const u32x4*)(P + (size_t)row * DINP + C_MLV + h * 128 + cg8), x); const float w = gp[128 + t];
#pragma unroll
        for (int e = 0; e < 8; ++e) sVT[tix(cg8 + e, t)] = (bf16_t)f2bf(x[e] * w);
    }
    lbar();
    float* KV = (float*)(p.ws + WS_Y) + (size_t)item * 8192;
    {
        const int nt = wid;
#pragma unroll
        for (int mt = 0; mt < 4; ++mt) {
            f32x4 a = (f32x4){0.f, 0.f, 0.f, 0.f};
#pragma unroll
            for (int kk = 0; kk < 2; ++kk) a = MFMA16(ldfragT(sKT, mt * 16, kk * 32, lane), ldfragT(sVT, nt * 16, kk * 32, lane), a);
            *(f32x4*)(KV + (nt * 16 + fr) * 64 + mt * 16 + fq * 4) = a;
        }
    }
    if (tid < 64) { float s = 0.f;
        for (int t = 0; t < 64; ++t) s += sc[128 + t] * bf2f(sKT[tix(tid, t)]);
        ((float*)(p.ws + WS_SM + SM_MN))[item * 64 + tid] = s; }
    lbar();
}
DEVI void ml_seq(const PW& pw0, int gtid, int nthreads) {
    const PW p{opq64(pw0.ws)};
    const float* MSC = (const float*)(p.ws + WS_SM + SM_MSC);
    float* MM = (float*)(p.ws + WS_SM + SM_MM);
    for (int g = gtid; g < 32 * 4096 + 32 * 32; g += nthreads) {
        const bool isn = g >= 32 * 4096; const int gg = isn ? g - 32 * 4096 : g;
        const int chain = isn ? gg >> 5 : gg >> 12, e2 = isn ? gg & 31 : gg & 4095;
        float* base = isn ? (float*)(p.ws + WS_SM + SM_MN) + (size_t)chain * NCH * 64 + e2 * 2 : (float*)(p.ws + WS_Y) + (size_t)chain * NCH * 8192 + e2 * 2;
        const int stride = isn ? 64 : 8192;
        float m = 0.f; f32x2 C = (f32x2){0.f, 0.f};
        for (int c0 = 0; c0 < NCH; c0 += 17) {
            f32x2 kv[17]; f32x2 sc[17];
#pragma unroll
            for (int u = 0; u < 17; ++u) { kv[u] = *(const f32x2*)(base + (size_t)(c0 + u) * stride); sc[u] = *(const f32x2*)(MSC + (chain * NCH + c0 + u) * 2); }
#pragma unroll
            for (int u = 0; u < 17; ++u) {
                *(f32x2*)(base + (size_t)(c0 + u) * stride) = C;
                if (!isn && e2 == 0) MM[chain * NCH + c0 + u] = m;
                const float mn = fmaxf(sc[u][0] + m, sc[u][1]);
                const float a = __expf(sc[u][0] + m - mn), s = __expf(sc[u][1] - mn);
                C = C * a + kv[u] * s; m = mn;
            }
        }
    }
}
DEVI void ml_out_item(const PW& pw0, int l, int item, unsigned char* shm_in, int wv) {
    const PW p{opq64(pw0.ws)};
    unsigned char* shm = opq(shm_in);
    const int tid = MYTID, wid = __builtin_amdgcn_readfirstlane(tid >> 6), lane = tid & 63, fr = lane & 15, fq = lane >> 4;
    const int j = item % NCH, h = (item / NCH) & 3, b = item / (NCH * 4);
    bf16_t* P = (bf16_t*)(p.ws + WS_P);
    bf16_t* sQ = (bf16_t*)shm;
    bf16_t* sK = (bf16_t*)(shm + 9216);
    bf16_t* sVT = (bf16_t*)(shm + 18432);
    bf16_t* sCT = (bf16_t*)(shm + 36864);
    bf16_t* sS = (bf16_t*)(shm + 55296);
    float* sO = (float*)(shm + 64512);
    float* sc = (float*)(shm + 98304);
#pragma unroll 1
    for (int dir = 0; dir < 2; ++dir) {
        const int c = dir_chunk(dir, j);
        const int it2 = ((dir * 4 + b) * 4 + h) * NCH + c;
        if (wid == 0) {
            const float* gp = (const float*)(p.ws + WS_GATES) + (size_t)(2176 + it2) * 320;
            const float m = ((const float*)(p.ws + WS_SM + SM_MM))[it2];
            const float bb = gp[lane], pm = gp[192 + lane];
            sc[lane] = bb; sc[64 + lane] = gp[64 + lane];
            const float mt = bb + fmaxf(m, pm);
            sc[128 + lane] = mt; sc[192 + lane] = __expf(bb + m - mt);
            sc[320 + lane] = ((const float*)(p.ws + WS_SM + SM_MN))[it2 * 64 + lane];
        }
        {
            const int t = tid >> 3, cg8 = (tid & 7) * 8; const int row = tok_row(false, dir, b, c, t);
            float x[8]; unpack8(*(const u32x4*)(P + (size_t)row * DINP + C_MLQ + h * 64 + cg8), x);
#pragma unroll
            for (int e = 0; e < 8; ++e) x[e] *= 0.125f;
            *(u32x4*)(sQ + t * 72 + cg8) = pack8(x);
            *(u32x4*)(sK + t * 72 + cg8) = *(const u32x4*)(P + (size_t)row * DINP + C_MLK + h * 64 + cg8);
        }
#pragma unroll
        for (int r = 0; r < 2; ++r) {
            const int idx = tid + 512 * r, t = idx >> 4, cg8 = (idx & 15) * 8; const int row = tok_row(false, dir, b, c, t);
            float x[8]; unpack8(*(const u32x4*)(P + (size_t)row * DINP + C_MLV + h * 128 + cg8), x);
#pragma unroll
            for (int e = 0; e < 8; ++e) sVT[tix(cg8 + e, t)] = (bf16_t)f2bf(x[e]);
        }
        {
            const float* CT = (const float*)(p.ws + WS_Y) + (size_t)it2 * 8192;
#pragma unroll
            for (int r = 0; r < 4; ++r) { const int idx = tid + 512 * r, e = idx >> 4, d4 = (idx & 15) * 4; const f32x4 v = *(const f32x4*)(CT + e * 64 + d4);
                u32x2 w; w[0] = pk2(v[0], v[1]); w[1] = pk2(v[2], v[3]); *(u32x2*)(sCT + e * 72 + d4) = w; }
        }
        lbar();
#pragma unroll
        for (int ti = 0; ti < 2; ++ti) {
            const int tile = wid * 2 + ti, m2 = tile >> 2, n2 = tile & 3;
            f32x4 a = (f32x4){0.f, 0.f, 0.f, 0.f};
#pragma unroll
            for (int kk = 0; kk < 2; ++kk) a = MFMA16(ldfrag(sQ, 72, m2 * 16, kk * 32, lane), ldfrag(sK, 72, n2 * 16, kk * 32, lane), a);
            const int s = n2 * 16 + fr;
#pragma unroll
            for (int jj = 0; jj < 4; ++jj) { const int t = m2 * 16 + fq * 4 + jj;
                sS[t * 72 + s] = (bf16_t)f2bf(s <= t ? a[jj] * __expf(sc[t] - sc[s] + sc[64 + s] - sc[128 + t]) : 0.f); }
        }
        lbar();
        if (tid < 64) {
            float ds = 0.f, qn = 0.f;
            for (int s = 0; s < 64; ++s) { ds += bf2f(sS[tid * 72 + s]); qn += bf2f(sQ[tid * 72 + s]) * sc[320 + s]; }
            const float den = ds + sc[192 + tid] * qn;
            sc[256 + tid] = 1.f / fmaxf(fabsf(den), __expf(-sc[128 + tid]));
        }
        lbar();
        {
            const int nt = wid;
#pragma unroll
            for (int mt = 0; mt < 4; ++mt) {
                f32x4 a = (f32x4){0.f, 0.f, 0.f, 0.f};
#pragma unroll
                for (int kk = 0; kk < 2; ++kk) a = MFMA16(ldfrag(sQ, 72, mt * 16, kk * 32, lane), ldfrag(sCT, 72, nt * 16, kk * 32, lane), a);
#pragma unroll
                for (int jj = 0; jj < 4; ++jj) a[jj] *= sc[192 + mt * 16 + fq * 4 + jj];
#pragma unroll
                for (int kk = 0; kk < 2; ++kk) a = MFMA16(ldfrag(sS, 72, mt * 16, kk * 32, lane), ldfragT(sVT, nt * 16, kk * 32, lane), a);
                const int e = nt * 16 + fr;
#pragma unroll
                for (int jj = 0; jj < 4; ++jj) { const int t = mt * 16 + fq * 4 + jj; const int i = dir ? 63 - t : t; const float hv = a[jj] * sc[256 + t];
                    if (dir) sO[i * 132 + e] += hv; else sO[i * 132 + e] = hv; }
            }
        }
        lbar();
    }
    {
        const int i = tid >> 3, e0 = (tid & 7) * 16;
        float v[16], ss = 0.f;
#pragma unroll
        for (int e = 0; e < 16; ++e) { v[e] = sO[i * 132 + e0 + e]; ss += v[e] * v[e]; }
        ss += __shfl_xor(ss, 1, 64); ss += __shfl_xor(ss, 2, 64); ss += __shfl_xor(ss, 4, 64);
        const float rs = rsqrtf(ss * (1.f / 128.f) + EPS);
        const int row = tok_row(false, 0, b, j, i);
        bf16_t* op = P + (size_t)row * DINP + C_MLO + h * 128 + e0;
        const float* g = pin(11) + l * 512 + h * 128 + e0;
#pragma unroll
        for (int half = 0; half < 2; ++half) {
            float z[8]; unpack8(*(const u32x4*)(op + half * 8), z); float o[8];
#pragma unroll
            for (int e = 0; e < 8; ++e) o[e] = v[half * 8 + e] * rs * g[half * 8 + e] * z[e];
            *(u32x4*)(op + half * 8) = pack8(o);
        }
    }
    lbar();
}

DEVI void lru_item(const PW& pw0, int l, int item, int mode, unsigned char* shm_in, int wv) {
    const PW p{opq64(pw0.ws)};
    unsigned char* shm = opq(shm_in);
    const int tid = MYTID, wid = __builtin_amdgcn_readfirstlane(tid >> 6), lane = tid & 63, fr = lane & 15, fq = lane >> 4;
    const int n4 = item & 3, j = (item >> 2) % NCH, b = (item >> 2) / NCH; const bool isctx = j < 4;
    bf16_t* P = (bf16_t*)(p.ws + WS_P);
    bf16_t* sX = (bf16_t*)shm;
    const int p0 = (isctx ? j : j - 4) * 64;
    const float* cw = pin(12) + (size_t)l * 4 * 512; const float* cb = pin(13) + (size_t)l * 512;
    {
        const int ch = lane * 8, i0 = wid * 8;
        f32x4 w[4][2];
#pragma unroll
        for (int jj = 0; jj < 4; ++jj) { w[jj][0] = *(const f32x4*)(cw + jj * 512 + ch); w[jj][1] = *(const f32x4*)(cw + jj * 512 + ch + 4); }
        const f32x4 b0 = *(const f32x4*)(cb + ch), b1 = *(const f32x4*)(cb + ch + 4);
        u32x4 raw[11];
#pragma unroll
        for (int r = 0; r < 11; ++r) { const int row = pos_row(false, b, isctx, p0 + i0 + r - 2);
            raw[r] = (u32x4){0u, 0u, 0u, 0u}; if (row >= 0) raw[r] = *(const u32x4*)(P + (size_t)row * DINP + C_LRX + ch); }
#pragma unroll
        for (int i = 0; i < 8; ++i) {
            float a[8] = {b0[0], b0[1], b0[2], b0[3], b1[0], b1[1], b1[2], b1[3]};
#pragma unroll
            for (int jj = 0; jj < 4; ++jj) { float x[8]; unpack8(raw[i + jj], x);
#pragma unroll
                for (int e = 0; e < 4; ++e) { a[e] += w[jj][0][e] * x[e]; a[4 + e] += w[jj][1][e] * x[4 + e]; } }
            *(u32x4*)(sX + (i0 + i) * 520 + ch) = pack8(a);
        }
    }
    lbar();
    const int blk = wid;
    const bf16_t* WL = (const bf16_t*)(p.ws + WS_WLRU);
    float* LAGG = (float*)(p.ws + WS_SM + SM_LAGG);
    {
        const int ch = blk * 64 + n4 * 16 + fr;
        float hsum[4][4];
#pragma unroll
        for (int mt = 0; mt < 4; ++mt)
#pragma unroll
            for (int jj = 0; jj < 4; ++jj) hsum[mt][jj] = 0.f;
#pragma unroll
        for (int dir = 0; dir < 2; ++dir) {
            const bf16_t* wa = WL + (size_t)(0 * 16 + dir * 8 + blk) * 4096 + (n4 * 16 + fr) * 64 + fq * 8;
            const bf16_t* wx = WL + (size_t)(1 * 16 + dir * 8 + blk) * 4096 + (n4 * 16 + fr) * 64 + fq * 8;
            bf16x8 ba[2], bx[2];
#pragma unroll
            for (int kk = 0; kk < 2; ++kk) { ba[kk] = *(const bf16x8*)(wa + kk * 32); bx[kk] = *(const bf16x8*)(wx + kk * 32); }
            const float bias_a = pin(15)[(size_t)l * 1024 + dir * 512 + ch], bias_x = pin(17)[(size_t)l * 1024 + dir * 512 + ch];
            const float cl = -8.f * softplus(-pin(18)[(size_t)l * 1024 + dir * 512 + ch]);
            float av[4][4], bv[4][4];
#pragma unroll
            for (int mt = 0; mt < 4; ++mt) {
                f32x4 aa = (f32x4){0.f, 0.f, 0.f, 0.f}, ax = aa;
#pragma unroll
                for (int kk = 0; kk < 2; ++kk) { const bf16x8 af = ldfrag(sX, 520, mt * 16, blk * 64 + kk * 32, lane); aa = MFMA16(af, ba[kk], aa); ax = MFMA16(af, bx[kk], ax); }
#pragma unroll
                for (int jj = 0; jj < 4; ++jj) {
                    const int t = mt * 16 + fq * 4 + jj;
                    const float rr = sigm(aa[jj] + bias_a), ii = sigm(ax[jj] + bias_x), la = cl * rr;
                    const float ea = __expf(la);
                    av[mt][jj] = ea;
                    bv[mt][jj] = __builtin_amdgcn_sqrtf(fmaxf(1.f - ea * ea, 0.f)) * ii * bf2f(sX[t * 520 + ch]);
                }
            }
            const int c = dir_chunk(dir, j);
            const size_t aidx = (((size_t)dir * 4 + b) * NCH + c) * 512 + ch;
            float hin = mode ? LAGG[aidx * 2] : 0.f;
            float Pc = 1.f, Hc = 0.f;
#pragma unroll
            for (int mi = 0; mi < 4; ++mi) {
                const int mt = dir ? 3 - mi : mi;
                float Pl = 1.f, Hl = 0.f;
#pragma unroll
                for (int ji = 0; ji < 4; ++ji) { const int jj = dir ? 3 - ji : ji; Pl = av[mt][jj] * Pl; Hl = av[mt][jj] * Hl + bv[mt][jj]; }
                float Pq[4], Hq[4];
#pragma unroll
                for (int q = 0; q < 4; ++q) { Pq[q] = __shfl(Pl, fr + 16 * q, 64); Hq[q] = __shfl(Hl, fr + 16 * q, 64); }
                if (mode == 0) {
#pragma unroll
                    for (int qi = 0; qi < 4; ++qi) { const int q = dir ? 3 - qi : qi; Hc = Pq[q] * Hc + Hq[q]; Pc = Pq[q] * Pc; }
                } else {
                    float hh = hin;
                    float hme = hin;
#pragma unroll
                    for (int qi = 0; qi < 4; ++qi) { const int q = dir ? 3 - qi : qi; if (q == fq) hme = hh; hh = Pq[q] * hh + Hq[q]; }
                    hin = hh;
#pragma unroll
                    for (int ji = 0; ji < 4; ++ji) { const int jj = dir ? 3 - ji : ji; hme = av[mt][jj] * hme + bv[mt][jj]; hsum[mt][jj] += hme; }
                }
            }
            if (mode == 0 && fq == 0) { LAGG[aidx * 2] = Pc; LAGG[aidx * 2 + 1] = Hc; }
        }
        if (mode == 1) {
#pragma unroll
            for (int mt = 0; mt < 4; ++mt)
#pragma unroll
                for (int jj = 0; jj < 4; ++jj) { const int i = mt * 16 + fq * 4 + jj; const int row = pos_row(false, b, isctx, p0 + i);
                    bf16_t* yp = P + (size_t)row * DINP + C_LRY + ch; *yp = (bf16_t)f2bf(hsum[mt][jj] * bf2f(*yp)); }
        }
    }
    lbar();
}
DEVI void lru_seq(const PW& pw0, int gtid, int nthreads) {
    const PW p{opq64(pw0.ws)};
    float* LAGG = (float*)(p.ws + WS_SM + SM_LAGG);
    for (int g = gtid; g < 4096; g += nthreads) {
        const int ch = g & 511, db = g >> 9;
        float h = 0.f;
        for (int c0 = 0; c0 < NCH; c0 += 17) {
            f32x2 v[17];
#pragma unroll
            for (int u = 0; u < 17; ++u) v[u] = *(const f32x2*)(LAGG + (((size_t)db * NCH + c0 + u) * 512 + ch) * 2);
#pragma unroll
            for (int u = 0; u < 17; ++u) { LAGG[(((size_t)db * NCH + c0 + u) * 512 + ch) * 2] = h; h = v[u][0] * h + v[u][1]; }
        }
    }
}

DEVI void gate_phase(const PW& pw0, int l, int gwave, int nwaves, int lane) {
    const PW p{opq64(pw0.ws)};
    const bf16_t* P = (const bf16_t*)(p.ws + WS_P);
    float* GT = (float*)(p.ws + WS_GATES);
    for (int w = gwave; w < 4352; w += nwaves) {
        const int kind = w >= 2176 ? 1 : 0, item = kind ? w - 2176 : w;
        const int c = item % NCH, h = (item / NCH) & 3, b = (item / (NCH * 4)) & 3, dir = item / (NCH * 16);
        float* gp = GT + (size_t)(kind * 2176 + item) * 320;
        if (kind == 0) gdn_gates(p, P, l, b, c, h, dir, gp, lane);
        else {
            const int row = tok_row(false, dir, b, c, lane);
            const float ig = bf2f(P[(size_t)row * DINP + C_MLG + dir * 4 + h]) + pin(10)[l * 16 + dir * 4 + h];
            const float fg = bf2f(P[(size_t)row * DINP + C_MLG + (2 + dir) * 4 + h]) + pin(10)[l * 16 + (2 + dir) * 4 + h];
            float bb = logsig(fg);
#pragma unroll
            for (int o = 1; o < 64; o <<= 1) { const float t = __shfl_up(bb, o, 64); if (lane >= o) bb += t; }
            const float bT = __shfl(bb, 63, 64);
            const float lw = bT - bb + ig;
            const float Mc = wmax(lw);
            float pm = ig - bb;
#pragma unroll
            for (int o = 1; o < 64; o <<= 1) { const float t = __shfl_up(pm, o, 64); if (lane >= o) pm = fmaxf(pm, t); }
            gp[lane] = bb; gp[64 + lane] = ig; gp[128 + lane] = __expf(lw - Mc); gp[192 + lane] = pm;
            if (lane == 0) { float* msc = (float*)(p.ws + WS_SM + SM_MSC) + item * 2; msc[0] = bT; msc[1] = Mc; }
        }
    }
}

#define XB_TMO      128
#define XB_XCNT(j)  (256  + 64 * (j))
#define XB_XSUB(j)  (1280 + 64 * (j))
#define XB_XGEN(j)  (2304 + 64 * (j))
#define XB_TOP      3328
#define XB_TOPGEN   3392
#define XCD_BAR_WORDS 3456
#define XB_SPIN_CAP (1u << 22)
DEVI unsigned xb_ld(unsigned* p)              { return __hip_atomic_load(p, __ATOMIC_RELAXED, __HIP_MEMORY_SCOPE_AGENT); }
DEVI unsigned xb_add(unsigned* p, unsigned v) { return __hip_atomic_fetch_add(p, v, __ATOMIC_RELAXED, __HIP_MEMORY_SCOPE_AGENT); }
DEVI unsigned xb_xcc_id() { return (unsigned)__builtin_amdgcn_s_getreg((3 << 11) | 20) & 0xFu; }
#define XB_SPIN(cond, bar) do { unsigned _sp = 0; while (cond) { __builtin_amdgcn_s_sleep(1); \
    if ((++_sp & 255u) == 0u) { if (xb_ld(&(bar)[XB_TMO])) break; if (_sp > XB_SPIN_CAP) { atomicAdd(&(bar)[XB_TMO], 1u); break; } } } } while (0)
DEVI void xcd_barrier_complete(unsigned* bar, unsigned x, unsigned G, unsigned& nloc, unsigned& nx) {
    unsigned sum, cnt, mine, sp = 0u;
    for (;;) {
        sum = 0u; cnt = 0u; mine = 0u;
#pragma unroll
        for (unsigned j = 0; j < 16; ++j) { const unsigned c = xb_ld(&bar[XB_XCNT(j)]); sum += c; cnt += (c > 0u) ? 1u : 0u; mine = (j == x) ? c : mine; }
        if (sum == G) break;
        __builtin_amdgcn_s_sleep(1);
        if ((++sp & 255u) == 0u) { if (xb_ld(&bar[XB_TMO])) break; if (sp > XB_SPIN_CAP) { atomicAdd(&bar[XB_TMO], 1u); break; } }
    }
    nloc = mine > 0u ? mine : 1u; nx = cnt > 0u ? cnt : 1u;
}
DEVI void gsync(unsigned* bar, volatile LAS unsigned* st, int G, int wv) {
    asm volatile("s_waitcnt vmcnt(0)" ::: "memory");
    __syncthreads();
    const int ln = (int)__builtin_amdgcn_mbcnt_hi(~0u, __builtin_amdgcn_mbcnt_lo(~0u, 0u));
    if (wv == 0 && ln == 0) {
        __builtin_amdgcn_s_waitcnt(0);
        const unsigned x = xb_xcc_id();
        unsigned nloc = st[0], nx = st[1];
        if (nloc == 0u) { xcd_barrier_complete(bar, x, (unsigned)G, nloc, nx); st[0] = nloc; st[1] = nx; }
        const unsigned old = xb_add(&bar[XB_XSUB(x)], 1u);
        const unsigned gen = old / nloc;
        if (old + 1u == (gen + 1u) * nloc) {
            __builtin_amdgcn_fence(__ATOMIC_RELEASE, "agent");
            asm volatile("s_waitcnt vmcnt(0)" ::: "memory");
            const unsigned og = xb_add(&bar[XB_TOP], 1u);
            const unsigned tg = og / nx;
            if (og + 1u == (tg + 1u) * nx) xb_add(&bar[XB_TOPGEN], 1u);
            else XB_SPIN(xb_ld(&bar[XB_TOPGEN]) == tg, bar);
            __builtin_amdgcn_fence(__ATOMIC_ACQUIRE, "agent");
            xb_add(&bar[XB_XGEN(x)], 1u);
            asm volatile("s_waitcnt vmcnt(0)" ::: "memory");
        } else {
            XB_SPIN(xb_ld(&bar[XB_XGEN(x)]) == gen, bar);
            __builtin_amdgcn_fence(__ATOMIC_ACQUIRE, "agent");
            asm volatile("s_waitcnt vmcnt(0)" ::: "memory");
        }
    }
    __syncthreads();
}

__global__ void __launch_bounds__(512) mega(Params p) {
    extern __shared__ __attribute__((aligned(16))) unsigned char shm[];
    cg::grid_group grid = cg::this_grid();
    const int wv = __builtin_amdgcn_readfirstlane(threadIdx.x >> 6);
    const int G = gridDim.x, nwaves = G * 8, nthreads = G * 512;
#define TIDS const int tid = MYTID, wid = tid >> 6, lane = tid & 63, gwave = blockIdx.x * 8 + wid, gtid = blockIdx.x * 512 + tid; (void)gtid; (void)gwave; (void)lane;
    LAS unsigned char* lds = (LAS unsigned char*)shm;
#define WSQ unsigned char* ws = opq64(pw.ws); bf16_t* Hb = (bf16_t*)(ws + WS_H); bf16_t* Pb = (bf16_t*)(ws + WS_P); float* Yb = (float*)(ws + WS_Y); (void)Hb; (void)Pb; (void)Yb;

    const PW pw{p.ws};
    unsigned* bar = (unsigned*)p.ws;
    volatile LAS unsigned* xst = (volatile LAS unsigned*)((LAS unsigned char*)shm + (LDS_BYTES - 16));
    if (threadIdx.x == 0) { xst[0] = 0u; xst[1] = 0u; (void)xb_add(&bar[XB_XCNT(xb_xcc_id())], 1u); }
    __syncthreads();
    for (int rep = 0; rep < REP_CVT; ++rep) {
    mod_phase(pw, shm, wv);
    { TIDS convert_phase(pw, 0, shm, gwave, nwaves, wid, lane); }
    }
    grid.sync();
    { TIDS rowwise_phase(pw, 0, MTOT, 0, 0, 0.f, 0, 0, 0, 0, 0, gwave, nwaves, lane); }
    gsync(bar, xst, G, wv);

#pragma unroll 1
    for (int l = 0; l < DEPTH; ++l) {
        const bool last = l == DEPTH - 1;
#pragma unroll 1
        for (int f = 0; f < 2; ++f) {
            if (f == 1) {
                { WSQ pg8::Gemm g{Hb, (const bf16_t*)(ws + WS_WIN), 68, 31, D, D, 1, 0, 0, 0, 0, D, 0}; pg8::Order S; S.init(68, 31, 1, G, blockIdx.x);
                  pg8::EpiInProj E{Pb, DINP}; for (int rep = 0; rep < REP_GEMM; ++rep) pg8::gemm_phase(lds, g, S, E, wv); }
                gsync(bar, xst, G, wv);
                { TIDS gate_phase(pw, l, gwave, nwaves, lane); }
                gsync(bar, xst, G, wv);
#pragma unroll 1
                for (int rep2 = 0; rep2 < REP_PREPSEQ; ++rep2) {
#pragma unroll 1
                for (int rep = 0; rep < REP_PREP; ++rep)
                {
                    for (int it = blockIdx.x; it < 2176; it += G) gdn_prep_item(pw, l, it, shm, wv);
                    for (int it = (blockIdx.x + G / 2) % G; it < 2176; it += G) ml_prep_item(pw, l, it, shm, wv);
                    for (int it = (blockIdx.x + G / 4) % G; it < 1088; it += G) lru_item(pw, l, it, 0, shm, wv);
                }
                gsync(bar, xst, G, wv);
                for (int u = blockIdx.x; u < 256; u += G) gdn_seq_unit(pw, u, shm, wv);
                { TIDS ml_seq(pw, gtid, nthreads); }
                { TIDS lru_seq(pw, gtid, nthreads); }
                gsync(bar, xst, G, wv);
                }
                for (int it = blockIdx.x; it < 1088; it += G) { if (last && (it % NCH) < 4) continue; gdn_out_item(pw, l, it, shm, wv); }
                for (int it = (blockIdx.x + G / 4) % G; it < 1088; it += G) { if (last && (it % NCH) < 4) continue; ml_out_item(pw, l, it, shm, wv); }
                for (int it = (blockIdx.x + G / 2) % G; it < 1088; it += G) { if (last && ((it >> 2) % NCH) < 4) continue; lru_item(pw, l, it, 1, shm, wv); }
                gsync(bar, xst, G, wv);
                const int nM = last ? 64 : 68;
                { WSQ pg8::Gemm g{Pb, (const bf16_t*)(ws + WS_WBR), nM, 4, 512, DINP, 3, C_MLO, C_LRY, C_DNZ, D * 512, 512, 0}; pg8::Order S; S.init(nM, 4, 3, G, blockIdx.x);
                  pg8::EpiBranch E{Pb, Yb, Hb}; for (int rep = 0; rep < REP_GEMM; ++rep) pg8::gemm_phase(lds, g, S, E, wv); }
                gsync(bar, xst, G, wv);
                { WSQ pg8::Gemm g{Hb, (const bf16_t*)(ws + WS_WOUT), 64, 4, D, D, 1, 0, 0, 0, 0, D, 0}; pg8::Order S; S.init(64, 4, 1, G, blockIdx.x);
                  pg8::EpiBf16Y E{(bf16_t*)Yb, D}; for (int rep = 0; rep < REP_GEMM; ++rep) pg8::gemm_phase(lds, g, S, E, wv); }
                if (!last) { WSQ pg8::Gemm g{Hb, (const bf16_t*)(ws + WS_WOUT), 4, 4, 256, D, 4, 0, 0, 0, 256, D, 256}; pg8::Order S; S.init(4, 4, 4, G, blockIdx.x, 64, 1);
                  pg8::EpiF32 E{(float*)(ws + WS_GB), D, MLAT, (size_t)1024 * D}; pg8::gemm_phase(lds, g, S, E, wv); }
                gsync(bar, xst, G, wv);
                { TIDS if (DRY_ROW) { rowwise_phase(pw, 1, nM * 256, l, 5, 1.f, 3, l, 4, 6, 4, gwave, nwaves, lane, 1); } rowwise_phase(pw, 1, nM * 256, l, 5, 1.f, 3, l, 4, 6, 4, gwave, nwaves, lane); }
                gsync(bar, xst, G, wv);
            }
            const int nM = (last && f == 1) ? 64 : 68;
            { WSQ pg8::Gemm g{Hb, (const bf16_t*)(ws + WS_WGU + f * SZ_WGU), nM, 22, D, D, 1, 0, 0, 0, 0, D, 0}; pg8::Order S; S.init(nM, 22, 1, G, blockIdx.x);
              pg8::EpiSwiGLU E{Pb, DFF}; for (int rep = 0; rep < REP_GU; ++rep) pg8::gemm_phase(lds, g, S, E, wv); }
            gsync(bar, xst, G, wv);
            { WSQ pg8::Gemm g{Pb, (const bf16_t*)(ws + WS_WDN + f * SZ_WDN), 64, 4, DFF, DFF, 1, 0, 0, 0, 0, DFF, 0}; pg8::Order S; S.init(64, 4, 1, G, blockIdx.x);
              pg8::EpiBf16Y E{(bf16_t*)Yb, D}; for (int rep = 0; rep < REP_DN; ++rep) pg8::gemm_phase(lds, g, S, E, wv); }
            if (nM == 68) { WSQ pg8::Gemm g{Pb, (const bf16_t*)(ws + WS_WDN + f * SZ_WDN), 4, 4, 256, DFF, 11, 0, 0, 0, 256, DFF, 256}; pg8::Order S; S.init(4, 4, 11, G, blockIdx.x, 64, 1);
              pg8::EpiF32 E{(float*)(ws + WS_GB), D, MLAT, (size_t)1024 * D}; for (int rep = 0; rep < REP_DNC; ++rep) pg8::gemm_phase(lds, g, S, E, wv); }
            gsync(bar, xst, G, wv);
            if (f == 0) { TIDS if (DRY_ROW) { rowwise_phase(pw, 1, nM * 256, l, 2, 0.5f, 1, l, 2, 3, 11, gwave, nwaves, lane, 1); } rowwise_phase(pw, 1, nM * 256, l, 2, 0.5f, 1, l, 2, 3, 11, gwave, nwaves, lane); }
            else if (!last) { { TIDS if (DRY_ROW) { rowwise_phase(pw, 1, nM * 256, l, 8, 0.5f, 5, l + 1, 0, 0, 11, gwave, nwaves, lane, 1); } rowwise_phase(pw, 1, nM * 256, l, 8, 0.5f, 5, l + 1, 0, 0, 11, gwave, nwaves, lane); } for (int rep = 0; rep < REP_CVT; ++rep) { TIDS convert_phase(pw, l + 1, shm, gwave, nwaves, wid, lane); } }
            else { TIDS rowwise_phase(pw, 2, MLAT, l, 8, 0.5f, 5, 0, 0, 0, 0, gwave, nwaves, lane); }
            gsync(bar, xst, G, wv);
        }
    }
}

extern "C" void kernel_launch(void* const* d_in, const int* in_sizes, int n_in, void* d_out, int out_size, void* d_ws, size_t ws_size, hipStream_t stream) {
    static int grid = 0;
    if (grid == 0) {
        if (n_in != 25 || ws_size < WS_END) { fprintf(stderr, "kernel_launch: unexpected n_in %d or ws_size %zu (need %zu)\n", n_in, ws_size, (size_t)WS_END); grid = -1; return; }
        int dev = 0, cus = 0, per_cu = 0;
        hipGetDevice(&dev); hipDeviceGetAttribute(&cus, hipDeviceAttributeMultiprocessorCount, dev);
        if (hipFuncSetAttribute((const void*)mega, hipFuncAttributeMaxDynamicSharedMemorySize, LDS_BYTES) != hipSuccess) { fprintf(stderr, "kernel_launch: hipFuncSetAttribute failed\n"); grid = -1; return; }
        if (hipOccupancyMaxActiveBlocksPerMultiprocessor(&per_cu, (const void*)mega, 512, LDS_BYTES) != hipSuccess || per_cu < 1) { fprintf(stderr, "kernel_launch: occupancy query failed (%d)\n", per_cu); per_cu = 1; }
        (void)hipGetLastError();
        grid = cus * per_cu;
    }
    if (grid < 0) return;
    if (hipMemsetAsync(d_ws, 0, 16384, stream) != hipSuccess) { fprintf(stderr, "kernel_launch: memset failed\n"); return; }
    Params p{};
    for (int i = 0; i < 25; ++i) p.in[i] = (const float*)d_in[i];
    p.out = (float*)d_out; p.ws = (unsigned char*)d_ws;
    void* args[] = {&p};
    hipError_t e = hipLaunchCooperativeKernel((const void*)mega, dim3(grid), dim3(512), args, LDS_BYTES, stream);
    if (e != hipSuccess) fprintf(stderr, "cooperative launch failed: %s (grid %d)\n", hipGetErrorString(e), grid);
}
```

```cpp
#include <hip/hip_runtime.h>
#include <hip/hip_cooperative_groups.h>
#include <cstdio>
namespace cg = cooperative_groups;

#define LAS __attribute__((address_space(3)))
#define DEVI __device__ __forceinline__
typedef unsigned short bf16_t;
typedef short bf16x8 __attribute__((ext_vector_type(8)));
typedef float f32x4 __attribute__((ext_vector_type(4)));
typedef float f32x2 __attribute__((ext_vector_type(2)));
typedef unsigned u32x4 __attribute__((ext_vector_type(4)));
typedef unsigned u32x2 __attribute__((ext_vector_type(2)));

constexpr int D = 1024, NBATCH = 4, SEQ = 4096, CTXL = 256, DEPTH = 4, DFF = 2816, DINP = 7936;
constexpr int MLAT = NBATCH * SEQ, MTOT = MLAT + NBATCH * CTXL;
constexpr int NCH = 68;
constexpr int C_MLQ = 0, C_MLK = 256, C_MLV = 512, C_MLO = 1024, C_MLG = 1536, C_LRX = 1552, C_LRY = 2064,
              C_DNQ = 2576, C_DNZ = 4112, C_DNBA = 4624, C_GATE = 4640, C_END = 7712;
constexpr float EPS = 1e-6f;

constexpr size_t SZ_WGU = (size_t)2 * DFF * D * 2, SZ_WDN = (size_t)D * DFF * 2;
constexpr size_t WS_MOD = 16384;
constexpr size_t WS_WGU = 1u << 20;
constexpr size_t WS_WDN = WS_WGU + 2 * SZ_WGU;
constexpr size_t WS_WIN = WS_WDN + 2 * SZ_WDN;
constexpr size_t WS_WBR = WS_WIN + (size_t)DINP * D * 2;
constexpr size_t WS_WOUT = WS_WBR + (size_t)3 * D * 512 * 2;
constexpr size_t WS_WLRU = WS_WOUT + (size_t)D * D * 2;
constexpr size_t WS_X = WS_WLRU + (size_t)32 * 64 * 64 * 2;
constexpr size_t WS_H = WS_X + (size_t)MTOT * D * 4;
constexpr size_t WS_Y = WS_H + (size_t)MTOT * D * 2;
constexpr size_t WS_P = WS_Y + (size_t)MTOT * D * 4;
constexpr size_t WS_GU = WS_P + (size_t)MTOT * DINP * 2;
constexpr size_t WS_GB = WS_GU + (size_t)2176 * 64 * 128 * 2;
constexpr size_t WS_GN = WS_GB + (size_t)2176 * 128 * 128 * 2;
constexpr size_t WS_SM = WS_GN + (size_t)2176 * 128 * 128 * 2;
constexpr size_t SM_GDEC = 0, SM_MN = 16384, SM_MSC = SM_MN + 2176 * 64 * 4, SM_MM = SM_MSC + 2176 * 8, SM_LAGG = SM_MM + 2176 * 4 + 1024;
constexpr size_t WS_YC = WS_SM + SM_LAGG + (size_t)2 * 4 * NCH * 512 * 2 * 4 + 4096;
constexpr size_t WS_GATES = WS_YC;
constexpr size_t WS_END = WS_GATES + (size_t)2 * 2176 * 320 * 4 + 4096;
constexpr int LDS_BYTES = 155648;
constexpr int REP_BR = 1, REP_GU = 1, REP_DN = 1, REP_DNC = 1, REP_GEMM = 1, DRY_ROW = 0, REP_PREP = 1, REP_PREPSEQ = 1, REP_CVT = 1, REP_GDNP = 1, REP_MLP = 1, REP_LRU0 = 1, DRY_GO = 0, DRY_MO = 0, DRY_LO = 0;

struct Params { const float* in[25]; float* out; unsigned char* ws; };
struct PW { unsigned char* ws; };

#define CAS __attribute__((address_space(4)))
DEVI const float* pin(int i) { const CAS char* k = (const CAS char*)__builtin_amdgcn_kernarg_segment_ptr(); return *(const float* const volatile CAS*)(k + 8 * i); }
DEVI int opaque(int v) { asm volatile("" : "+v"(v)); return v; }
DEVI unsigned char* opq(unsigned char* p) { unsigned v = (unsigned)(size_t)(LAS unsigned char*)p; asm volatile("" : "+s"(v)); return (unsigned char*)(LAS unsigned char*)(size_t)v; }
DEVI LAS unsigned char* opql(LAS unsigned char* p) { unsigned v = (unsigned)(size_t)p; asm volatile("" : "+s"(v)); return (LAS unsigned char*)(size_t)v; }
DEVI unsigned char* opq64(unsigned char* p) { unsigned long long v = (unsigned long long)p; asm volatile("" : "+s"(v)); return (unsigned char*)v; }
#define MYTID opaque(wv * 64 + (int)__builtin_amdgcn_mbcnt_hi(~0u, __builtin_amdgcn_mbcnt_lo(~0u, 0u)))
DEVI float bf2f(bf16_t v) { return __uint_as_float(((unsigned)v) << 16); }
DEVI unsigned f2bf(float f) { unsigned u = __float_as_uint(f); return (u + 0x7fffu + ((u >> 16) & 1u)) >> 16; }
DEVI unsigned pk2(float lo, float hi) { return f2bf(lo) | (f2bf(hi) << 16); }
DEVI float sigm(float x) { return __builtin_amdgcn_rcpf(1.f + __expf(-x)); }
DEVI float silu(float x) { return x * sigm(x); }
DEVI float softplus(float x) { return x > 20.f ? x : log1pf(__expf(x)); }
DEVI float logsig(float x) { return fminf(x, 0.f) - log1pf(__expf(-fabsf(x))); }
DEVI float gelu_t(float x) { float u = 0.7978845608f * (x + 0.044715f * x * x * x); float e = __expf(2.f * u); return x * (1.f - __builtin_amdgcn_rcpf(e + 1.f)); }
DEVI float wsum(float v) { for (int o = 32; o > 0; o >>= 1) v += __shfl_xor(v, o, 64); return v; }
DEVI float wmax(float v) { for (int o = 32; o > 0; o >>= 1) v = fmaxf(v, __shfl_xor(v, o, 64)); return v; }
DEVI void unpack8(u32x4 r, float* f) {
    f[0] = __uint_as_float(r[0] << 16); f[1] = __uint_as_float(r[0] & 0xffff0000u); f[2] = __uint_as_float(r[1] << 16); f[3] = __uint_as_float(r[1] & 0xffff0000u);
    f[4] = __uint_as_float(r[2] << 16); f[5] = __uint_as_float(r[2] & 0xffff0000u); f[6] = __uint_as_float(r[3] << 16); f[7] = __uint_as_float(r[3] & 0xffff0000u);
}
DEVI u32x4 pack8(const float* f) { u32x4 r; r[0] = pk2(f[0], f[1]); r[1] = pk2(f[2], f[3]); r[2] = pk2(f[4], f[5]); r[3] = pk2(f[6], f[7]); return r; }
DEVI bf16x8 ldfrag(const bf16_t* base, int ld, int row0, int k0, int lane) { return *(const bf16x8*)(base + (row0 + (lane & 15)) * ld + k0 + (lane >> 4) * 8); }
DEVI int tix(int row, int col) { return row * 72 + ((((col >> 3) + (row >> 3)) & 7) << 3) + (col & 7); }
DEVI bf16x8 ldfragT(const bf16_t* base, int row0, int k0, int lane) { const int r = row0 + (lane & 15), lg = (k0 >> 3) + (lane >> 4); return *(const bf16x8*)(base + r * 72 + (((lg + (r >> 3)) & 7) << 3)); }
DEVI void lbar() { asm volatile("s_waitcnt lgkmcnt(0)" ::: "memory"); __builtin_amdgcn_s_barrier(); asm volatile("" ::: "memory"); }
#define MFMA16(a, b, c) __builtin_amdgcn_mfma_f32_16x16x32_bf16(a, b, c, 0, 0, 0)

namespace pg8 {
constexpr int BM = 256, BK = 64, HALF = 128, HTB = HALF * BK * 2, NXCD = 8, WGM = 8;
DEVI int lds_byte(int r, int c) { const int st = (r >> 4) * 2 + (c >> 5), rr = r & 15, cc = c & 31, ob = rr * 64 + cc * 2; return st * 1024 + (ob ^ (((ob >> 9) & 1) << 5)); }
DEVI void stage_rc(int b, int& R, int& C) { const int st = b / 1024, sb = b % 1024, swz = sb ^ (((sb >> 9) & 1) << 5); R = (st >> 1) * 16 + swz / 64; C = (st & 1) * 32 + (swz % 64) / 2; }
DEVI int perm32(int rho) { const int n = rho >> 4, i = rho & 15; return 8 * (i >> 2) + 4 * n + (i & 3); }
struct Unit { int pm, pn, z; };
struct Gemm { const bf16_t* A; const bf16_t* Bt; int nM, nN, K, lda, nz, zA0, zA1, zA2, zB; int ldb, zAstep; };
struct Order {
    int nM, nN, nwg, G, c, nz, pm0, spread;
    DEVI void init(int nM_, int nN_, int nz_, int G_, int c_, int pm0_ = 0, int spread_ = 0) { nM = nM_; nN = nN_; nwg = nM * nN; G = G_; c = c_; nz = nz_; pm0 = pm0_; spread = spread_; }
    DEVI bool next(int i, Unit& u) const {
        int ti = i, z = 0; long L;
        if (spread) { L = (long)i * G + c; if (L >= (long)nwg * nz) return false; z = (int)(L / nwg); L -= (long)z * nwg; }
        else { if (nz == 3) { ti = i / 3; z = i - ti * 3; } L = (long)ti * G + c; if (L >= nwg) return false; }
        int wgid = (int)L; { const int q = nwg / NXCD, r = nwg % NXCD, xcd = wgid % NXCD, off = wgid / NXCD; wgid = (xcd < r ? xcd * (q + 1) : r * (q + 1) + (xcd - r) * q) + off; }
        const int nig = WGM * nN, gid = wgid / nig, fm = gid * WGM, gsz = (nM - fm) < WGM ? (nM - fm) : WGM;
        u.pm = pm0 + fm + ((wgid % nig) % gsz); u.pn = (wgid % nig) / gsz; u.z = z; return true;
    }
};

template <class Epi>
DEVI void gemm_phase(LAS unsigned char* lds_in, const Gemm g, const Order& S, const Epi& E, int wv) {
    LAS unsigned char* lds = opql(lds_in);
    const int tid = MYTID, wid = __builtin_amdgcn_readfirstlane(tid >> 6), lane = tid & 63, wr = wid >> 2, wc = wid & 3, fr = lane & 15, fq = lane >> 4;
    const int K = g.K, nt = K / BK, lda = g.lda, ldb = g.ldb;
    unsigned voffA[2], voffB[2];
#pragma unroll
    for (int i = 0; i < 2; ++i) { int R, C; stage_rc(tid * 16 + i * 8192, R, C); const int Rb = Epi::PERM ? ((R & ~31) + perm32(R & 31)) : R;
        voffA[i] = (unsigned)(R * lda + C) * 2u; voffB[i] = (unsigned)(Rb * ldb + C) * 2u; }
    const size_t kstep = (size_t)(BK * 2);
    const size_t hstepA = (size_t)HALF * lda * 2, hstepB = (size_t)HALF * ldb * 2;
    const unsigned ldsw = (unsigned)wid * 1024u;
    const int aoff = lds_byte(wr * 64 + fr, fq * 8), boff = lds_byte(wc * 32 + fr, fq * 8);
#define PG8_SA(b, h) (((b) * 2 + (h)) * HTB)
#define PG8_SB(b, h) ((4 + (b) * 2 + (h)) * HTB)
#define PG8_STAGE(bufoff, gbase, voff) do { _Pragma("unroll") for (int _i = 0; _i < 2; ++_i) \
        __builtin_amdgcn_global_load_lds((const unsigned*)((const char*)(gbase) + (voff)[_i]), (LAS unsigned*)(lds + (bufoff) + ldsw + _i * 8192), 16, 0, 0); } while (0)
#define PG8_LDA(dst, b, h) do { _Pragma("unroll") for (int m = 0; m < 4; ++m) _Pragma("unroll") for (int k = 0; k < 2; ++k) dst[m][k] = *(const LAS bf16x8*)(lds + PG8_SA(b, h) + aoff + m * 2048 + k * 1024); } while (0)
#define PG8_LDB(dst, b, h) do { _Pragma("unroll") for (int n = 0; n < 2; ++n) _Pragma("unroll") for (int k = 0; k < 2; ++k) dst[n][k] = *(const LAS bf16x8*)(lds + PG8_SB(b, h) + boff + n * 2048 + k * 1024); } while (0)
#define PG8_MMA(ai, bj, At, Bt) do { __builtin_amdgcn_s_setprio(1); _Pragma("unroll") for (int m = 0; m < 4; ++m) _Pragma("unroll") for (int n = 0; n < 2; ++n) _Pragma("unroll") for (int k = 0; k < 2; ++k) \
        acc[ai][bj][m][n] = __builtin_amdgcn_mfma_f32_16x16x32_bf16(Bt[n][k], At[m][k], acc[ai][bj][m][n], 0, 0, 0); __builtin_amdgcn_s_setprio(0); } while (0)
#define PG8_WAIT_V(n) asm volatile("s_waitcnt vmcnt(" #n ")" ::: "memory")
#define PG8_WAIT_L(n) asm volatile("s_waitcnt lgkmcnt(" #n ")" ::: "memory")
#define PG8_BAR __builtin_amdgcn_s_barrier()
#define PG8_SCHED __builtin_amdgcn_sched_barrier(0)
#define PG8_PA(u) ((const char*)g.A + ((size_t)(g.nz == 3 ? ((u).z == 0 ? g.zA0 : ((u).z == 1 ? g.zA1 : g.zA2)) : (u).z * g.zAstep) + (size_t)(u).pm * BM * lda) * 2)
#define PG8_PB(u) ((const char*)g.Bt + ((size_t)(u).z * g.zB + (size_t)(u).pn * BM * ldb) * 2)
    Unit cur, nxt; int ui = 0;
    if (!S.next(0, cur)) return;
    f32x4 acc[2][2][4][2];
#pragma unroll
    for (int a = 0; a < 2; ++a)
#pragma unroll
        for (int b = 0; b < 2; ++b)
#pragma unroll
            for (int m = 0; m < 4; ++m)
#pragma unroll
                for (int n = 0; n < 2; ++n) acc[a][b][m][n] = (f32x4){0.f, 0.f, 0.f, 0.f};
    bf16x8 At[4][2], B0[2][2], B1[2][2];
    const char* cA = PG8_PA(cur); const char* cB = PG8_PB(cur);
    PG8_STAGE(PG8_SB(0, 0), cB, voffB); PG8_STAGE(PG8_SA(0, 0), cA, voffA); PG8_STAGE(PG8_SB(0, 1), cB + hstepB, voffB); PG8_STAGE(PG8_SA(0, 1), cA + hstepA, voffA);
    if (wr == 1) PG8_BAR;
    PG8_WAIT_V(4); PG8_BAR;
    PG8_STAGE(PG8_SB(1, 0), cB + kstep, voffB); PG8_STAGE(PG8_SA(1, 0), cA + kstep, voffA); PG8_STAGE(PG8_SB(1, 1), cB + hstepB + kstep, voffB);
    PG8_WAIT_V(6); PG8_BAR;
    for (;;) {
        const bool has_next = S.next(ui + 1, nxt);
        const char* nA = has_next ? PG8_PA(nxt) : cA; const char* nB = has_next ? PG8_PB(nxt) : cB;
        for (int t = 0; t < nt; t += 2) {
            const bool last = (t == nt - 2);
            const char* a1 = cA + (size_t)(t + 1) * kstep;
            const char* a2 = last ? nA : cA + (size_t)(t + 2) * kstep; const char* b2 = last ? nB : cB + (size_t)(t + 2) * kstep;
            const char* a3 = a2 + kstep; const char* b3 = b2 + kstep;
            PG8_LDB(B0, 0, 0); PG8_SCHED; PG8_LDA(At, 0, 0); PG8_STAGE(PG8_SA(1, 1), a1 + hstepA, voffA);
            PG8_WAIT_L(8); PG8_BAR; PG8_WAIT_L(0); PG8_MMA(0, 0, At, B0); PG8_BAR; PG8_SCHED;
            PG8_LDB(B1, 0, 1); PG8_STAGE(PG8_SB(0, 0), b2, voffB);
            PG8_BAR; PG8_WAIT_L(0); PG8_MMA(0, 1, At, B1); PG8_BAR;
            PG8_LDA(At, 0, 1); PG8_STAGE(PG8_SA(0, 0), a2, voffA);
            PG8_BAR; PG8_WAIT_L(0); PG8_MMA(1, 0, At, B0); PG8_BAR; PG8_SCHED;
            PG8_STAGE(PG8_SB(0, 1), b2 + hstepB, voffB);
            PG8_WAIT_V(6); PG8_BAR; PG8_MMA(1, 1, At, B1); PG8_BAR;
            PG8_LDB(B0, 1, 0); PG8_SCHED; PG8_LDA(At, 1, 0); PG8_STAGE(PG8_SA(0, 1), a2 + hstepA, voffA);
            PG8_WAIT_L(8); PG8_BAR; PG8_WAIT_L(0); PG8_MMA(0, 0, At, B0); PG8_BAR; PG8_SCHED;
            PG8_LDB(B1, 1, 1); PG8_STAGE(PG8_SB(1, 0), b3, voffB);
            PG8_BAR; PG8_WAIT_L(0); PG8_MMA(0, 1, At, B1); PG8_BAR;
            PG8_LDA(At, 1, 1); PG8_STAGE(PG8_SA(1, 0), a3, voffA);
            PG8_BAR; PG8_WAIT_L(0); PG8_MMA(1, 0, At, B0); PG8_BAR; PG8_SCHED;
            PG8_STAGE(PG8_SB(1, 1), b3 + hstepB, voffB);
            PG8_WAIT_V(6); PG8_BAR; PG8_MMA(1, 1, At, B1); PG8_BAR;
        }
        E(acc, cur, wr, wc, fr, fq);
        if (!has_next) break;
#pragma unroll
        for (int a = 0; a < 2; ++a)
#pragma unroll
            for (int b = 0; b < 2; ++b)
#pragma unroll
                for (int m = 0; m < 4; ++m)
#pragma unroll
                    for (int n = 0; n < 2; ++n) acc[a][b][m][n] = (f32x4){0.f, 0.f, 0.f, 0.f};
        cur = nxt; cA = nA; cB = nB; ++ui;
    }
    PG8_WAIT_V(0);
    if (wr == 0) PG8_BAR;
    PG8_BAR;
#undef PG8_SA
#undef PG8_SB
#undef PG8_STAGE
#undef PG8_LDA
#undef PG8_LDB
#undef PG8_MMA
#undef PG8_WAIT_V
#undef PG8_WAIT_L
#undef PG8_BAR
#undef PG8_SCHED
#undef PG8_PA
#undef PG8_PB
}

struct EpiF32 {
    static constexpr bool PERM = false;
    float* C; int ldc; int row_base; size_t zstride;
    DEVI void operator()(const f32x4 (&acc)[2][2][4][2], const Unit& u, int wr, int wc, int fr, int fq) const {
        const int row0 = u.pm * BM + wr * 64 + fr - row_base, col0 = u.pn * BM + wc * 32 + 4 * fq;
#pragma unroll
        for (int ai = 0; ai < 2; ++ai)
#pragma unroll
            for (int m = 0; m < 4; ++m) { float* rowp = C + (size_t)u.z * zstride + (size_t)(row0 + ai * HALF + m * 16) * ldc + col0;
#pragma unroll
                for (int bj = 0; bj < 2; ++bj)
#pragma unroll
                    for (int n = 0; n < 2; ++n) *(f32x4*)(rowp + bj * HALF + n * 16) = acc[ai][bj][m][n]; }
    }
};
struct EpiBf16Y {
    static constexpr bool PERM = true;
    bf16_t* O; int ldc;
    DEVI void operator()(const f32x4 (&acc)[2][2][4][2], const Unit& u, int wr, int wc, int fr, int fq) const {
        const int row0 = u.pm * BM + wr * 64 + fr;
#pragma unroll
        for (int bj = 0; bj < 2; ++bj) { const int c0 = u.pn * BM + bj * HALF + wc * 32 + 8 * fq;
#pragma unroll
            for (int ai = 0; ai < 2; ++ai)
#pragma unroll
                for (int m = 0; m < 4; ++m) { float v[8];
#pragma unroll
                    for (int n = 0; n < 2; ++n)
#pragma unroll
                        for (int i = 0; i < 4; ++i) v[n * 4 + i] = acc[ai][bj][m][n][i];
                    *(u32x4*)(O + (size_t)(row0 + ai * HALF + m * 16) * ldc + c0) = pack8(v); } }
    }
};
struct EpiAtomic {
    static constexpr bool PERM = false;
    float* C; int ldc; int row_base;
    DEVI void operator()(const f32x4 (&acc)[2][2][4][2], const Unit& u, int wr, int wc, int fr, int fq) const {
        const int row0 = u.pm * BM + wr * 64 + fr - row_base, col0 = u.pn * BM + wc * 32 + 4 * fq;
#pragma unroll
        for (int ai = 0; ai < 2; ++ai)
#pragma unroll
            for (int m = 0; m < 4; ++m) { float* rowp = C + (size_t)(row0 + ai * HALF + m * 16) * ldc + col0;
#pragma unroll
                for (int bj = 0; bj < 2; ++bj)
#pragma unroll
                    for (int n = 0; n < 2; ++n)
#pragma unroll
                        for (int e = 0; e < 4; ++e) __hip_atomic_fetch_add(rowp + bj * HALF + n * 16 + e, acc[ai][bj][m][n][e], __ATOMIC_RELAXED, __HIP_MEMORY_SCOPE_AGENT); }
    }
};
struct EpiSwiGLU {
    static constexpr bool PERM = false;
    bf16_t* O; int ldc;
    DEVI void operator()(const f32x4 (&acc)[2][2][4][2], const Unit& u, int wr, int wc, int fr, int fq) const {
        const int row0 = u.pm * BM + wr * 64 + fr, col0 = u.pn * 128 + wc * 32 + 8 * fq;
#pragma unroll
        for (int ai = 0; ai < 2; ++ai)
#pragma unroll
            for (int m = 0; m < 4; ++m) {
                float v[8];
#pragma unroll
                for (int bj = 0; bj < 2; ++bj)
#pragma unroll
                    for (int i = 0; i < 4; ++i) { const float gt = acc[ai][bj][m][0][i], up = acc[ai][bj][m][1][i]; v[bj * 4 + i] = silu(gt) * up; }
                *(u32x4*)(O + (size_t)(row0 + ai * HALF + m * 16) * ldc + col0) = pack8(v);
            }
    }
};
struct EpiInProj {
    static constexpr bool PERM = true;
    bf16_t* O; int ldc;
    DEVI void operator()(const f32x4 (&acc)[2][2][4][2], const Unit& u, int wr, int wc, int fr, int fq) const {
        const int row0 = u.pm * BM + wr * 64 + fr;
#pragma unroll
        for (int bj = 0; bj < 2; ++bj) {
            const int c0 = u.pn * BM + bj * HALF + wc * 32 + 8 * fq;
            int kind = 0;
            if (c0 >= C_MLO && c0 < C_MLG) kind = 1; else if (c0 >= C_LRY && c0 < C_DNQ) kind = 2; else if (c0 >= C_DNZ && c0 < C_DNBA) kind = 3; else if (c0 >= C_GATE) kind = 1;
#define INPROJ_STORE(FN) _Pragma("unroll") for (int ai = 0; ai < 2; ++ai) _Pragma("unroll") for (int m = 0; m < 4; ++m) { float v[8]; \
                _Pragma("unroll") for (int n = 0; n < 2; ++n) _Pragma("unroll") for (int i = 0; i < 4; ++i) { const float x = acc[ai][bj][m][n][i]; v[n * 4 + i] = FN; } \
                *(u32x4*)(O + (size_t)(row0 + ai * HALF + m * 16) * ldc + c0) = pack8(v); }
            if (kind == 0) { INPROJ_STORE(x) } else if (kind == 1) { INPROJ_STORE(sigm(x)) } else if (kind == 2) { INPROJ_STORE(gelu_t(x)) } else { INPROJ_STORE(silu(x)) }
#undef INPROJ_STORE
        }
    }
};
struct EpiBranch {
    static constexpr bool PERM = false;
    const bf16_t* P; float* T; bf16_t* U;
    DEVI void operator()(const f32x4 (&acc)[2][2][4][2], const Unit& u, int wr, int wc, int fr, int fq) const {
        const int row0 = u.pm * BM + wr * 64 + fr, col0 = u.pn * BM + wc * 32 + 4 * fq; const int z = u.z;
#pragma unroll
        for (int ai = 0; ai < 2; ++ai)
#pragma unroll
            for (int mh = 0; mh < 2; ++mh) {
                u32x2 gr[2][2][2]; f32x4 tv[2][2][2];
#pragma unroll
                for (int mm = 0; mm < 2; ++mm) { const size_t row = (size_t)(row0 + ai * HALF + (mh * 2 + mm) * 16);
#pragma unroll
                    for (int bj = 0; bj < 2; ++bj)
#pragma unroll
                        for (int n = 0; n < 2; ++n) { const int col = col0 + bj * HALF + n * 16;
                            gr[mm][bj][n] = *(const u32x2*)(P + row * DINP + C_GATE + z * D + col);
                            tv[mm][bj][n] = (f32x4){0.f, 0.f, 0.f, 0.f};
                            if (z > 0) tv[mm][bj][n] = *(const f32x4*)(T + row * D + col); } }
#pragma unroll
                for (int mm = 0; mm < 2; ++mm) { const size_t row = (size_t)(row0 + ai * HALF + (mh * 2 + mm) * 16);
#pragma unroll
                    for (int bj = 0; bj < 2; ++bj)
#pragma unroll
                        for (int n = 0; n < 2; ++n) { const int col = col0 + bj * HALF + n * 16;
                            const u32x2 g2 = gr[mm][bj][n]; f32x4 a = acc[ai][bj][mh * 2 + mm][n];
                            a[0] *= __uint_as_float(g2[0] << 16); a[1] *= __uint_as_float(g2[0] & 0xffff0000u); a[2] *= __uint_as_float(g2[1] << 16); a[3] *= __uint_as_float(g2[1] & 0xffff0000u);
                            a = a + tv[mm][bj][n];
                            if (z < 2) *(f32x4*)(T + row * D + col) = a;
                            else { u32x2 w; w[0] = pk2(a[0], a[1]); w[1] = pk2(a[2], a[3]); *(u32x2*)(U + row * D + col) = w; } } }
            }
    }
};
}

DEVI int tok_row(bool gdn, int dir, int b, int c, int t) {
    if (c < 4) { int p = c * 64 + t; if (dir) p = 255 - p; return MLAT + b * 256 + p; }
    int p = (c - 4) * 64 + t; if (dir) p = 4095 - p;
    const int s = gdn ? ((p & 63) * 64 + (p >> 6)) : p;
    return b * 4096 + s;
}
DEVI int pos_row(bool gdn, int b, bool isctx, int p) {
    if (isctx) { if (p < 0 || p >= 256) return -1; return MLAT + b * 256 + p; }
    if (p < 0 || p >= 4096) return -1;
    const int s = gdn ? ((p & 63) * 64 + (p >> 6)) : p;
    return b * 4096 + s;
}
DEVI int dir_chunk(int dir, int j) { return dir ? (j < 4 ? 3 - j : 71 - j) : j; }

DEVI int gu_rowmap(int s) {
    const int n = s >= DFF ? 1 : 0, a = s - n * DFF, pn = a >> 7, r = a & 127, wc = r >> 5, fq = (r >> 3) & 3, bj = (r >> 2) & 1, i = r & 3;
    return 256 * pn + 128 * bj + 32 * wc + 16 * n + 4 * fq + i;
}
DEVI void cvt_tile(const float* src, int ldsrc, int Nvalid, int k0, int n0, bf16_t* dst, int lddst, int mode, float* buf, int lane) {
#pragma unroll 4
    for (int it = 0; it < 16; ++it) {
        const int row = it * 4 + (lane >> 4), c4 = (lane & 15) * 4;
        f32x4 v = (f32x4){0.f, 0.f, 0.f, 0.f};
        if (n0 + c4 < Nvalid) v = *(const f32x4*)(src + (size_t)(k0 + row) * ldsrc + n0 + c4);
        float* bp = buf + row * 65 + c4; bp[0] = v[0]; bp[1] = v[1]; bp[2] = v[2]; bp[3] = v[3];
    }
    asm volatile("s_waitcnt lgkmcnt(0)" ::: "memory"); __builtin_amdgcn_wave_barrier();
#pragma unroll 2
    for (int it = 0; it < 8; ++it) {
        const int nc = it * 8 + (lane >> 3), kk = (lane & 7) * 8;
        float f[8];
#pragma unroll
        for (int e = 0; e < 8; ++e) f[e] = buf[(kk + e) * 65 + nc];
        const int drow = mode == 1 ? gu_rowmap(n0 + nc) : (n0 + nc);
        *(u32x4*)(dst + (size_t)drow * lddst + k0 + kk) = pack8(f);
    }
    asm volatile("s_waitcnt lgkmcnt(0)" ::: "memory"); __builtin_amdgcn_wave_barrier();
}
DEVI void convert_phase(const PW& pw0, int l, unsigned char* shm_in, int gwave, int nwaves, int wid, int lane) {
    const PW p{opq64(pw0.ws)};
    unsigned char* shm = opq(shm_in);
    float* buf = (float*)shm + wid * (64 * 65);
    unsigned char* ws = p.ws;
    for (int t = gwave; t < 6880; t += nwaves) {
        int r = t;
        if (r < 2816) { const int f = r / 1408; r -= f * 1408; const int kt = r / 88, ntl = r % 88;
            cvt_tile(pin(7) + ((size_t)(l * 2 + f)) * D * 2 * DFF, 2 * DFF, 2 * DFF, kt * 64, ntl * 64, (bf16_t*)(ws + WS_WGU + f * SZ_WGU), D, 1, buf, lane); continue; }
        r -= 2816;
        if (r < 1408) { const int f = r / 704; r -= f * 704; const int kt = r / 16, ntl = r % 16;
            cvt_tile(pin(8) + ((size_t)(l * 2 + f)) * DFF * D, D, D, kt * 64, ntl * 64, (bf16_t*)(ws + WS_WDN + f * SZ_WDN), DFF, 0, buf, lane); continue; }
        r -= 1408;
        if (r < 1984) { const int kt = r / 124, ntl = r % 124;
            cvt_tile(pin(9) + (size_t)l * D * C_END, C_END, C_END, kt * 64, ntl * 64, (bf16_t*)(ws + WS_WIN), D, 0, buf, lane); continue; }
        r -= 1984;
        if (r < 384) { const int n = r / 128; r -= n * 128; const int kt = r / 16, ntl = r % 16;
            cvt_tile(pin(23) + ((size_t)(l * 3 + n)) * 512 * D, D, D, kt * 64, ntl * 64, (bf16_t*)(ws + WS_WBR) + (size_t)n * D * 512, 512, 0, buf, lane); continue; }
        r -= 384;
        if (r < 256) { const int kt = r / 16, ntl = r % 16;
            cvt_tile(pin(24) + (size_t)l * D * D, D, D, kt * 64, ntl * 64, (bf16_t*)(ws + WS_WOUT), D, 0, buf, lane); continue; }
        r -= 256;
        { const int gate = r >> 4, dn = r & 15;
            cvt_tile(pin(gate ? 16 : 14) + ((size_t)l * 16 + dn) * 4096, 64, 64, 0, 0, (bf16_t*)(ws + WS_WLRU) + (size_t)(gate * 16 + dn) * 4096, 64, 0, buf, lane); }
    }
}

DEVI void mod_phase(const PW& pw0, unsigned char* shm_in, int wv) {
    const PW p{opq64(pw0.ws)};
    unsigned char* shm = opq(shm_in);
    float* sC = (float*)shm;
    float* red = sC + 5 * 1024;
    const int tid = MYTID;
    __syncthreads();
    for (int i = tid; i < 5 * 1024; i += 512) { const int v = i >> 10, k = i & 1023; const float x = v < 4 ? pin(1)[v * 1024 + k] : pin(3)[k]; sC[i] = silu(x); }
    __syncthreads();
    float* MOD = (float*)(p.ws + WS_MOD);
    const int cgp = tid & 15, is = tid >> 4;
    for (int task = blockIdx.x; task < DEPTH * 144; task += gridDim.x) {
        const int l = task / 144, col0 = (task % 144) * 64;
        float acc[5][4];
#pragma unroll
        for (int v = 0; v < 5; ++v)
#pragma unroll
            for (int e = 0; e < 4; ++e) acc[v][e] = 0.f;
        const float* wp = pin(4) + ((size_t)l * 1024 + is * 32) * 9216 + col0 + cgp * 4;
#pragma unroll 8
        for (int r = 0; r < 32; ++r) {
            const f32x4 w = *(const f32x4*)(wp + (size_t)r * 9216);
#pragma unroll
            for (int v = 0; v < 5; ++v) { const float s = sC[v * 1024 + is * 32 + r];
#pragma unroll
                for (int e = 0; e < 4; ++e) acc[v][e] += s * w[e]; }
        }
#pragma unroll
        for (int v = 0; v < 5; ++v)
#pragma unroll
            for (int e = 0; e < 4; ++e) red[tid * 20 + v * 4 + e] = acc[v][e];
        __syncthreads();
        if (tid < 320) { const int v = tid >> 6, c = tid & 63; float s = 0.f;
            for (int k = 0; k < 32; ++k) s += red[(k * 16 + (c >> 2)) * 20 + v * 4 + (c & 3)];
            MOD[((size_t)(l * 5 + v)) * 9216 + col0 + c] = s + pin(5)[(size_t)l * 9216 + col0 + c]; }
        __syncthreads();
    }
}

DEVI void rowwise_phase(const PW& pw0, int mode, int nrows, int l, int kgate, float coef, int gpost_i, int ln, int gpre_i, int kshift, int nzc, int gwave, int nwaves, int lane, int dry = 0) {
    const PW p{opq64(pw0.ws)};
    float* X = (float*)(p.ws + WS_X); float* Xw = dry ? (float*)(p.ws + WS_GN) : X; const float* Y0 = (const float*)(p.ws + WS_Y); const float* YC = (const float*)(p.ws + WS_GB); bf16_t* H = dry ? (bf16_t*)(p.ws + WS_GU) : (bf16_t*)(p.ws + WS_H);
    const float* MOD = (const float*)(p.ws + WS_MOD);
    const int co = lane * 4;
    u32x2 yq[4]; f32x4 xq[4];
#pragma unroll
    for (int i = 0; i < 4; ++i) { yq[i] = (u32x2){0u, 0u}; xq[i] = (f32x4){0.f, 0.f, 0.f, 0.f}; }
    if (mode != 0 && gwave < nrows && gwave < MLAT) {
#pragma unroll
        for (int i = 0; i < 4; ++i) { yq[i] = *(const u32x2*)((const bf16_t*)Y0 + (size_t)gwave * D + co + 256 * i); xq[i] = *(const f32x4*)(X + (size_t)gwave * D + co + 256 * i); }
    }
    for (int row = gwave; row < nrows; row += nwaves) {
        const int v = row < MLAT ? (row >> 12) : 4;
        f32x4 x[4], y[4];
        f32x4 pg[4], pm[4], qg[4], qa[4], qs[4];
        if (mode == 0) {
            const float* src = row < MLAT ? pin(0) + (size_t)row * D : pin(2) + (size_t)(row - MLAT) * D;
#pragma unroll
            for (int i = 0; i < 4; ++i) x[i] = *(const f32x4*)(src + co + 256 * i);
        {
            const float* gp = pin(6) + ((size_t)l * 6 + gpost_i) * D; const float* gt = MOD + ((size_t)(l * 5 + v) * 9 + kgate) * D;
            const float* gq = pin(6) + ((size_t)ln * 6 + gpre_i) * D; const float* sh = MOD + ((size_t)(ln * 5 + v) * 9 + kshift) * D; const float* sc = sh + D;
#pragma unroll
            for (int i = 0; i < 4; ++i) { pg[i] = *(const f32x4*)(gp + co + 256 * i); pm[i] = *(const f32x4*)(gt + co + 256 * i);
                qg[i] = *(const f32x4*)(gq + co + 256 * i); qa[i] = *(const f32x4*)(sh + co + 256 * i); qs[i] = *(const f32x4*)(sc + co + 256 * i); }
        }
        } else {
            if (row >= MLAT) {
                const float* Y = YC + (size_t)(row - MLAT) * D;
#pragma unroll
                for (int ih = 0; ih < 2; ++ih) {
                    f32x4 t[11][2];
#pragma unroll
                    for (int z = 0; z < 11; ++z)
#pragma unroll
                        for (int i2 = 0; i2 < 2; ++i2) t[z][i2] = z < nzc ? *(const f32x4*)(Y + (size_t)z * 1024 * D + co + 256 * (ih * 2 + i2)) : (f32x4){0.f, 0.f, 0.f, 0.f};
#pragma unroll
                    for (int i2 = 0; i2 < 2; ++i2) { f32x4 a = t[0][i2];
#pragma unroll
                        for (int z = 1; z < 11; ++z) a = a + t[z][i2];
                        y[ih * 2 + i2] = a; }
                }
#pragma unroll
                for (int i = 0; i < 4; ++i) x[i] = *(const f32x4*)(X + (size_t)row * D + co + 256 * i);
            } else {
#pragma unroll
                for (int i = 0; i < 4; ++i) { const u32x2 r2 = yq[i]; x[i] = xq[i];
                    y[i] = (f32x4){__uint_as_float(r2[0] << 16), __uint_as_float(r2[0] & 0xffff0000u), __uint_as_float(r2[1] << 16), __uint_as_float(r2[1] & 0xffff0000u)}; }
            }
        {
            const float* gp = pin(6) + ((size_t)l * 6 + gpost_i) * D; const float* gt = MOD + ((size_t)(l * 5 + v) * 9 + kgate) * D;
            const float* gq = pin(6) + ((size_t)ln * 6 + gpre_i) * D; const float* sh = MOD + ((size_t)(ln * 5 + v) * 9 + kshift) * D; const float* sc = sh + D;
#pragma unroll
            for (int i = 0; i < 4; ++i) { pg[i] = *(const f32x4*)(gp + co + 256 * i); pm[i] = *(const f32x4*)(gt + co + 256 * i);
                qg[i] = *(const f32x4*)(gq + co + 256 * i); qa[i] = *(const f32x4*)(sh + co + 256 * i); qs[i] = *(const f32x4*)(sc + co + 256 * i); }
        }
            const int nxt = row + nwaves;
            if (nxt < nrows && nxt < MLAT) {
#pragma unroll
                for (int i = 0; i < 4; ++i) { yq[i] = *(const u32x2*)((const bf16_t*)Y0 + (size_t)nxt * D + co + 256 * i); xq[i] = *(const f32x4*)(X + (size_t)nxt * D + co + 256 * i); }
            }
            float ss = 0.f;
#pragma unroll
            for (int i = 0; i < 4; ++i) ss += y[i][0] * y[i][0] + y[i][1] * y[i][1] + y[i][2] * y[i][2] + y[i][3] * y[i][3];
            ss = wsum(ss); const float rs = rsqrtf(ss * (1.f / D) + EPS) * coef;
#pragma unroll
            for (int i = 0; i < 4; ++i) x[i] = x[i] + pm[i] * (y[i] * rs * pg[i]);
        }
        if (mode == 2) {
#pragma unroll
            for (int i = 0; i < 4; ++i) *(f32x4*)((float*)pin(25) + (size_t)row * D + co + 256 * i) = x[i];
            continue;
        }
#pragma unroll
        for (int i = 0; i < 4; ++i) *(f32x4*)(Xw + (size_t)row * D + co + 256 * i) = x[i];
        float ss = 0.f;
#pragma unroll
        for (int i = 0; i < 4; ++i) ss += x[i][0] * x[i][0] + x[i][1] * x[i][1] + x[i][2] * x[i][2] + x[i][3] * x[i][3];
        ss = wsum(ss); const float rs = rsqrtf(ss * (1.f / D) + EPS);
#pragma unroll
        for (int i = 0; i < 4; ++i) { const f32x4 h = x[i] * rs * qg[i] * (qs[i] + 1.f) + qa[i]; u32x2 w; w[0] = pk2(h[0], h[1]); w[1] = pk2(h[2], h[3]);
            *(u32x2*)(H + (size_t)row * D + co + 256 * i) = w; }
    }
}

DEVI void gdn_load(const bf16_t* P, const float* convw, int b, int c, int h, int dir, int want, bf16_t* sQ, bf16_t* sK, bf16_t* sKT, bf16_t* sVT, int tid) {
    const bool isctx = c < 4;
#pragma unroll
    for (int r = 0; r < 6; ++r) {
        const int task = tid + 512 * r, seg = r >> 1, rem = task & 1023, t = rem >> 4, cgp = rem & 15;
        if (seg == 0 && !(want & 1)) continue;
        if (seg == 1 && !(want & 6)) continue;
        if (seg == 2 && !(want & 8)) continue;
        int p = (isctx ? c : c - 4) * 64 + t; if (dir) p = (isctx ? 255 : 4095) - p;
        const int ch = seg * 512 + h * 128 + cgp * 8;
        float a[8];
#pragma unroll
        for (int e = 0; e < 8; ++e) a[e] = 0.f;
#pragma unroll
        for (int j = 0; j < 4; ++j) {
            const int row = pos_row(true, b, isctx, p + j - 2);
            if (row >= 0) {
                const u32x4 raw = *(const u32x4*)(P + (size_t)row * DINP + C_DNQ + ch); float x[8]; unpack8(raw, x);
                const f32x4 w0 = *(const f32x4*)(convw + j * 1536 + ch), w1 = *(const f32x4*)(convw + j * 1536 + ch + 4);
                a[0] += w0[0] * x[0]; a[1] += w0[1] * x[1]; a[2] += w0[2] * x[2]; a[3] += w0[3] * x[3];
                a[4] += w1[0] * x[4]; a[5] += w1[1] * x[5]; a[6] += w1[2] * x[6]; a[7] += w1[3] * x[7];
            }
        }
        float ss = 0.f;
#pragma unroll
        for (int e = 0; e < 8; ++e) { a[e] = silu(a[e]); ss += a[e] * a[e]; }
        if (seg < 2) {
            ss += __shfl_xor(ss, 1, 64); ss += __shfl_xor(ss, 2, 64); ss += __shfl_xor(ss, 4, 64); ss += __shfl_xor(ss, 8, 64);
            float inv = rsqrtf(ss + EPS); if (seg == 0) inv *= 0.08838834764831845f;
#pragma unroll
            for (int e = 0; e < 8; ++e) a[e] *= inv;
        }
        if (seg == 0) *(u32x4*)(sQ + t * 136 + cgp * 8) = pack8(a);
        else if (seg == 1) {
            if (want & 2) *(u32x4*)(sK + t * 136 + cgp * 8) = pack8(a);
            if (want & 4) {
#pragma unroll
                for (int e = 0; e < 8; ++e) sKT[tix(cgp * 8 + e, t)] = (bf16_t)f2bf(a[e]); }
        } else {
#pragma unroll
            for (int e = 0; e < 8; ++e) sVT[tix(cgp * 8 + e, t)] = (bf16_t)f2bf(a[e]);
        }
    }
}
DEVI void gdn_gates(const PW& p, const bf16_t* P, int l, int b, int c, int h, int dir, float* sc, int lane) {
    const int row = tok_row(true, dir, b, c, lane);
    const float bb = bf2f(P[(size_t)row * DINP + C_DNBA + dir * 4 + h]), aa = bf2f(P[(size_t)row * DINP + C_DNBA + 8 + dir * 4 + h]);
    const float beta = sigm(bb);
    const float g = -__expf(pin(20)[l * 8 + dir * 4 + h]) * softplus(aa + pin(21)[l * 8 + dir * 4 + h]);
    float G = g;
#pragma unroll
    for (int o = 1; o < 64; o <<= 1) { const float t = __shfl_up(G, o, 64); if (lane >= o) G += t; }
    const float GT = __shfl(G, 63, 64);
    sc[lane] = G; sc[64 + lane] = beta; sc[128 + lane] = __expf(G); sc[192 + lane] = __expf(GT - G); if (lane == 0) sc[256] = __expf(GT);
}

DEVI void gdn_prep_item(const PW& pw0, int l, int item, unsigned char* shm_in, int wv) {
    const PW p{opq64(pw0.ws)};
    unsigned char* shm = opq(shm_in);
    const int tid = MYTID, wid = __builtin_amdgcn_readfirstlane(tid >> 6), lane = tid & 63, fr = lane & 15, fq = lane >> 4;
    const int c = item % NCH, h = (item / NCH) & 3, b = (item / (NCH * 4)) & 3, dir = item / (NCH * 16);
    const bf16_t* P = (const bf16_t*)(p.ws + WS_P);
    bf16_t* sK = (bf16_t*)shm;
    bf16_t* sKT = (bf16_t*)(shm + 17408);
    bf16_t* sVT = (bf16_t*)(shm + 35840);
    float* sTm = (float*)(shm + 54272);
    bf16_t* sT1 = (bf16_t*)(shm + 71680);
    bf16_t* sT2 = (bf16_t*)(shm + 80896);
    bf16_t* sWT = (bf16_t*)(shm + 90112);
    bf16_t* sUT = (bf16_t*)(shm + 108544);
    float* sc = (float*)(shm + 126976);
    if (tid < 257) sc[tid] = ((const float*)(p.ws + WS_GATES))[(size_t)item * 320 + tid];
    gdn_load(P, pin(19) + (size_t)l * 4 * 1536, b, c, h, dir, 2 | 4 | 8, nullptr, sK, sKT, sVT, tid);
    lbar();
#pragma unroll
    for (int ti = 0; ti < 2; ++ti) {
        const int tile = wid * 2 + ti, mt = tile >> 2, nt = tile & 3;
        f32x4 acc = (f32x4){0.f, 0.f, 0.f, 0.f};
#pragma unroll
        for (int kk = 0; kk < 4; ++kk) acc = MFMA16(ldfrag(sK, 136, mt * 16, kk * 32, lane), ldfrag(sK, 136, nt * 16, kk * 32, lane), acc);
        const int s = nt * 16 + fr;
#pragma unroll
        for (int j = 0; j < 4; ++j) { const int t = mt * 16 + fq * 4 + j; sTm[t * 68 + s] = s < t ? sc[64 + t] * acc[j] * __expf(sc[t] - sc[s]) : 0.f; }
    }
    lbar();
    float* tmpY = (float*)sWT;
    if (wid < 4) {
        const int o = wid * 16, c = lane & 15;
        int lz; asm volatile("v_mov_b32 %0, 0" : "=v"(lz));
        const float* tm = sTm + lz;
        float x[16];
#pragma unroll
        for (int t = 0; t < 16; ++t) {
            float v = -sTm[(o + t) * 68 + o + c];
#pragma unroll
            for (int s4 = 0; s4 < (t + 3) / 4; ++s4) {
                const f32x4 a = *(const f32x4*)(tm + (o + t) * 68 + o + s4 * 4);
#pragma unroll
                for (int e = 0; e < 4; ++e) if (s4 * 4 + e < t) v -= a[e] * x[s4 * 4 + e];
            }
            x[t] = v;
        }
        asm volatile("s_waitcnt lgkmcnt(0)" ::: "memory");
        if (lane < 16) {
#pragma unroll
            for (int t = 0; t < 16; ++t) sTm[(o + t) * 68 + o + c] = x[t] + (t == c ? 1.f : 0.f);
        }
    }
    lbar();
    {
        const int blk = tid >> 8, r = (tid >> 4) & 15, c = tid & 15, ib = (blk ? 3 : 1) * 16, jb = ib - 16;
        float y = 0.f;
#pragma unroll
        for (int s2 = 0; s2 < 16; ++s2) y += sTm[(ib + r) * 68 + jb + s2] * sTm[(jb + s2) * 68 + jb + c];
        tmpY[blk * 272 + r * 17 + c] = y;
        lbar();
        float z = 0.f;
#pragma unroll
        for (int s2 = 0; s2 < 16; ++s2) z += sTm[(ib + r) * 68 + ib + s2] * tmpY[blk * 272 + s2 * 17 + c];
        lbar();
        sTm[(ib + r) * 68 + jb + c] = -z;
    }
    lbar();
    {
        float y[2];
#pragma unroll
        for (int u = 0; u < 2; ++u) { const int o = tid + 512 * u, r = o >> 5, c = o & 31; float a = 0.f;
#pragma unroll 8
            for (int s2 = 0; s2 < 32; ++s2) a += sTm[(32 + r) * 68 + s2] * sTm[s2 * 68 + c];
            y[u] = a; }
#pragma unroll
        for (int u = 0; u < 2; ++u) { const int o = tid + 512 * u, r = o >> 5, c = o & 31; tmpY[r * 33 + c] = y[u]; }
        lbar();
#pragma unroll
        for (int u = 0; u < 2; ++u) { const int o = tid + 512 * u, r = o >> 5, c = o & 31; float a = 0.f;
#pragma unroll 8
            for (int s2 = 0; s2 < 32; ++s2) a += sTm[(32 + r) * 68 + 32 + s2] * tmpY[s2 * 33 + c];
            y[u] = a; }
#pragma unroll
        for (int u = 0; u < 2; ++u) { const int o = tid + 512 * u, r = o >> 5, c = o & 31; sTm[(32 + r) * 68 + c] = -y[u]; }
    }
    lbar();
#pragma unroll
    for (int u = 0; u < 8; ++u) {
        const int o = tid + 512 * u, t = o >> 6, s2 = o & 63; const float xv = sTm[t * 68 + s2], bt = sc[64 + s2];
        sT1[t * 72 + s2] = (bf16_t)f2bf(xv * bt * sc[128 + s2]); sT2[t * 72 + s2] = (bf16_t)f2bf(xv * bt);
    }
    lbar();
    bf16_t* GW = (bf16_t*)(p.ws + WS_H) + (size_t)item * 64 * 128;
    bf16_t* GU = (bf16_t*)(p.ws + WS_GU) + (size_t)item * 64 * 128;
    {
        const int tid2 = opaque(tid), lane = tid2 & 63, fr = lane & 15, fq = lane >> 4;
        const int mt = wid;
#pragma unroll
        for (int nt = 0; nt < 4; ++nt) {
            f32x4 aw = (f32x4){0.f, 0.f, 0.f, 0.f}, au = aw;
#pragma unroll
            for (int kk = 0; kk < 2; ++kk) { aw = MFMA16(ldfragT(sKT, mt * 16, kk * 32, lane), ldfrag(sT1, 72, nt * 16, kk * 32, lane), aw);
                au = MFMA16(ldfragT(sVT, mt * 16, kk * 32, lane), ldfrag(sT2, 72, nt * 16, kk * 32, lane), au); }
            const int t = nt * 16 + fr, r0 = mt * 16 + fq * 4; const float dec = sc[192 + t];
            u32x2 w; w[0] = pk2(aw[0], aw[1]); w[1] = pk2(aw[2], aw[3]); *(u32x2*)(GW + t * 128 + r0) = w;
            w[0] = pk2(au[0], au[1]); w[1] = pk2(au[2], au[3]); *(u32x2*)(GU + t * 128 + r0) = w;
#pragma unroll
            for (int j = 0; j < 4; ++j) { sWT[tix(r0 + j, t)] = (bf16_t)f2bf(aw[j] * dec); sUT[tix(r0 + j, t)] = (bf16_t)f2bf(au[j] * dec); }
        }
    }
    lbar();
    bf16_t* GB = (bf16_t*)(p.ws + WS_GB) + (size_t)item * 128 * 128;
    bf16_t* GN = (bf16_t*)(p.ws + WS_GN) + (size_t)item * 128 * 128;
    {
        const int tid2 = opaque(tid), lane = tid2 & 63, fr = lane & 15, fq = lane >> 4;
        const int mt = wid;
#pragma unroll
        for (int nt = 0; nt < 8; ++nt) {
            f32x4 ab = (f32x4){0.f, 0.f, 0.f, 0.f}, an = ab;
#pragma unroll
            for (int kk = 0; kk < 2; ++kk) { ab = MFMA16(ldfragT(sWT, mt * 16, kk * 32, lane), ldfragT(sKT, nt * 16, kk * 32, lane), ab);
                an = MFMA16(ldfragT(sKT, mt * 16, kk * 32, lane), ldfragT(sUT, nt * 16, kk * 32, lane), an); }
            const int cc = nt * 16 + fr, r0 = mt * 16 + fq * 4;
            u32x2 w; w[0] = pk2(-ab[0], -ab[1]); w[1] = pk2(-ab[2], -ab[3]); *(u32x2*)(GB + cc * 128 + r0) = w;
            w[0] = pk2(an[0], an[1]); w[1] = pk2(an[2], an[3]); *(u32x2*)(GN + cc * 128 + r0) = w;
        }
    }
    if (tid == 0) ((float*)(p.ws + WS_SM + SM_GDEC))[item] = sc[256];
    lbar();
}

DEVI void gdn_seq_unit(const PW& pw0, int unit, unsigned char* shm_in, int wv) {
    const PW p{opq64(pw0.ws)};
    unsigned char* shm = opq(shm_in);
    const int tid = MYTID, wid = __builtin_amdgcn_readfirstlane(tid >> 6), lane = tid & 63, fr = lane & 15, fq = lane >> 4;
    const int chain = unit >> 3, es = unit & 7;
    bf16_t* sS = (bf16_t*)shm;
    const bf16_t* GB = (const bf16_t*)(p.ws + WS_GB) + (size_t)chain * NCH * 16384;
    bf16_t* GN = (bf16_t*)(p.ws + WS_GN) + (size_t)chain * NCH * 16384;
    const float* GDEC = (const float*)(p.ws + WS_SM + SM_GDEC) + chain * NCH;
    f32x4 acc = (f32x4){0.f, 0.f, 0.f, 0.f};
    constexpr int PF = 4;
    bf16x8 an[PF][4]; u32x2 nn[PF]; float dn[PF];
    const size_t aoff = (size_t)(wid * 16 + fr) * 128 + fq * 8, noff = (size_t)(es * 16 + fr) * 128 + wid * 16 + fq * 4;
#pragma unroll
    for (int u = 0; u < PF; ++u) {
#pragma unroll
        for (int kk = 0; kk < 4; ++kk) an[u][kk] = *(const bf16x8*)(GB + (size_t)u * 16384 + aoff + kk * 32);
        nn[u] = *(const u32x2*)(GN + (size_t)u * 16384 + noff); dn[u] = GDEC[u];
    }
#pragma unroll 1
    for (int c0 = 0; c0 < NCH; c0 += PF) {
#pragma unroll
        for (int u = 0; u < PF; ++u) {
            const int c = c0 + u;
            bf16x8 a[4]; const u32x2 ncur = nn[u]; const float dcur = dn[u];
#pragma unroll
            for (int kk = 0; kk < 4; ++kk) a[kk] = an[u][kk];
            u32x2 sw; sw[0] = pk2(acc[0], acc[1]); sw[1] = pk2(acc[2], acc[3]);
            bf16_t* sb = sS + (c & 1) * (16 * 136);
            *(u32x2*)(sb + fr * 136 + wid * 16 + fq * 4) = sw;
            *(u32x2*)(GN + (size_t)c * 16384 + noff) = sw;
            if (c + PF < NCH) {
#pragma unroll
                for (int kk = 0; kk < 4; ++kk) an[u][kk] = *(const bf16x8*)(GB + (size_t)(c + PF) * 16384 + aoff + kk * 32);
                nn[u] = *(const u32x2*)(GN + (size_t)(c + PF) * 16384 + noff); dn[u] = GDEC[c + PF];
            }
            lbar();
            acc[0] = dcur * acc[0] + __uint_as_float(ncur[0] << 16); acc[1] = dcur * acc[1] + __uint_as_float(ncur[0] & 0xffff0000u);
            acc[2] = dcur * acc[2] + __uint_as_float(ncur[1] << 16); acc[3] = dcur * acc[3] + __uint_as_float(ncur[1] & 0xffff0000u);
#pragma unroll
            for (int kk = 0; kk < 4; ++kk) acc = MFMA16(a[kk], ldfrag(sb, 136, 0, kk * 32, lane), acc);
        }
    }
    lbar();
}

DEVI void gdn_out_item(const PW& pw0, int l, int item, unsigned char* shm_in, int wv, int dry = 0) {
    const PW p{opq64(pw0.ws)};
    unsigned char* shm = opq(shm_in);
    const int tid = MYTID, wid = __builtin_amdgcn_readfirstlane(tid >> 6), lane = tid & 63, fr = lane & 15, fq = lane >> 4;
    const int j = item % NCH, h = (item / NCH) & 3, b = item / (NCH * 4);
    bf16_t* P = (bf16_t*)(p.ws + WS_P);
    bf16_t* sQ = (bf16_t*)shm;
    bf16_t* sK = (bf16_t*)(shm + 17408);
    bf16_t* sST = (bf16_t*)(shm + 34816);
    bf16_t* sW = (bf16_t*)(shm + 69632);
    bf16_t* sVN = (bf16_t*)(shm + 87040);
    bf16_t* sA2 = (bf16_t*)(shm + 105472);
    float* sO = (float*)(shm + 114688);
    float* sc = (float*)(shm + 148480);
#pragma unroll 1
    for (int dir = 0; dir < 2; ++dir) {
        const int c = dir_chunk(dir, j);
        const int it2 = ((dir * 4 + b) * 4 + h) * NCH + c;
        if (tid < 257) sc[tid] = ((const float*)(p.ws + WS_GATES))[(size_t)it2 * 320 + tid];
        gdn_load(P, pin(19) + (size_t)l * 4 * 1536, b, c, h, dir, 1 | 2, sQ, sK, nullptr, nullptr, tid);
        const bf16_t* GS = (const bf16_t*)(p.ws + WS_GN) + (size_t)it2 * 16384;
        const bf16_t* GW = (const bf16_t*)(p.ws + WS_H) + (size_t)it2 * 8192;
        const bf16_t* GU = (const bf16_t*)(p.ws + WS_GU) + (size_t)it2 * 8192;
#pragma unroll
        for (int r = 0; r < 4; ++r) { const int idx = tid + 512 * r, row = idx >> 4, cg8 = (idx & 15) * 8; *(u32x4*)(sST + row * 136 + cg8) = *(const u32x4*)(GS + row * 128 + cg8); }
#pragma unroll
        for (int r = 0; r < 2; ++r) { const int idx = tid + 512 * r, row = idx >> 4, cg8 = (idx & 15) * 8; *(u32x4*)(sW + row * 136 + cg8) = *(const u32x4*)(GW + row * 128 + cg8); }
        lbar();
        {
            const int mt = wid;
#pragma unroll
            for (int nt = 0; nt < 4; ++nt) {
                f32x4 a = (f32x4){0.f, 0.f, 0.f, 0.f};
#pragma unroll
                for (int kk = 0; kk < 4; ++kk) a = MFMA16(ldfrag(sST, 136, mt * 16, kk * 32, lane), ldfrag(sW, 136, nt * 16, kk * 32, lane), a);
                const int t = nt * 16 + fr, e0 = mt * 16 + fq * 4;
                const u32x2 ur = *(const u32x2*)(GU + t * 128 + e0);
                sVN[(e0 + 0) * 72 + t] = (bf16_t)f2bf(__uint_as_float(ur[0] << 16) - a[0]); sVN[(e0 + 1) * 72 + t] = (bf16_t)f2bf(__uint_as_float(ur[0] & 0xffff0000u) - a[1]);
                sVN[(e0 + 2) * 72 + t] = (bf16_t)f2bf(__uint_as_float(ur[1] << 16) - a[2]); sVN[(e0 + 3) * 72 + t] = (bf16_t)f2bf(__uint_as_float(ur[1] & 0xffff0000u) - a[3]);
            }
#pragma unroll
            for (int ti = 0; ti < 2; ++ti) {
                const int tile = wid * 2 + ti, m2 = tile >> 2, n2 = tile & 3;
                f32x4 a = (f32x4){0.f, 0.f, 0.f, 0.f};
#pragma unroll
                for (int kk = 0; kk < 4; ++kk) a = MFMA16(ldfrag(sQ, 136, m2 * 16, kk * 32, lane), ldfrag(sK, 136, n2 * 16, kk * 32, lane), a);
                const int s = n2 * 16 + fr;
#pragma unroll
                for (int jj = 0; jj < 4; ++jj) { const int t = m2 * 16 + fq * 4 + jj; sA2[t * 72 + s] = (bf16_t)f2bf(s <= t ? a[jj] * __expf(sc[t] - sc[s]) : 0.f); }
            }
        }
        lbar();
        {
            const int nt = wid;
#pragma unroll
            for (int mt = 0; mt < 4; ++mt) {
                f32x4 a = (f32x4){0.f, 0.f, 0.f, 0.f};
#pragma unroll
                for (int kk = 0; kk < 4; ++kk) a = MFMA16(ldfrag(sQ, 136, mt * 16, kk * 32, lane), ldfrag(sST, 136, nt * 16, kk * 32, lane), a);
#pragma unroll
                for (int jj = 0; jj < 4; ++jj) a[jj] *= sc[128 + mt * 16 + fq * 4 + jj];
#pragma unroll
                for (int kk = 0; kk < 2; ++kk) a = MFMA16(ldfrag(sA2, 72, mt * 16, kk * 32, lane), ldfrag(sVN, 72, nt * 16, kk * 32, lane), a);
                const int e = nt * 16 + fr;
#pragma unroll
                for (int jj = 0; jj < 4; ++jj) { const int t = mt * 16 + fq * 4 + jj; const int i = dir ? 63 - t : t; if (dir) sO[i * 132 + e] += a[jj]; else sO[i * 132 + e] = a[jj]; }
            }
        }
        lbar();
    }
    {
        const int i = tid >> 3, e0 = (tid & 7) * 16;
        float v[16], ss = 0.f;
#pragma unroll
        for (int e = 0; e < 16; ++e) { v[e] = sO[i * 132 + e0 + e]; ss += v[e] * v[e]; }
        ss += __shfl_xor(ss, 1, 64); ss += __shfl_xor(ss, 2, 64); ss += __shfl_xor(ss, 4, 64);
        const float rs = rsqrtf(ss * (1.f / 128.f) + EPS);
        const int row = tok_row(true, 0, b, j, i);
        bf16_t* zp = P + (size_t)row * DINP + C_DNZ + h * 128 + e0;
        const float* g = pin(22) + l * 128 + e0;
#pragma unroll
        for (int half = 0; half < 2; ++half) {
            float z[8]; unpack8(*(const u32x4*)(zp + half * 8), z); float o[8];
#pragma unroll
            for (int e = 0; e < 8; ++e) o[e] = v[half * 8 + e] * rs * g[half * 8 + e] * z[e];
            bf16_t* zd = dry ? (bf16_t*)(p.ws + WS_GB) + (size_t)row * 512 + h * 128 + e0 : zp;
            *(u32x4*)(zd + half * 8) = pack8(o);
        }
    }
    lbar();
}

DEVI float ml_gates(const PW& p, const bf16_t* P, int l, int b, int c, int h, int dir, float* sc, int lane) {
    const int row = tok_row(false, dir, b, c, lane);
    const float ig = bf2f(P[(size_t)row * DINP + C_MLG + dir * 4 + h]) + pin(10)[l * 16 + dir * 4 + h];
    const float fg = bf2f(P[(size_t)row * DINP + C_MLG + (2 + dir) * 4 + h]) + pin(10)[l * 16 + (2 + dir) * 4 + h];
    float bb = logsig(fg);
#pragma unroll
    for (int o = 1; o < 64; o <<= 1) { const float t = __shfl_up(bb, o, 64); if (lane >= o) bb += t; }
    sc[lane] = bb; sc[64 + lane] = ig;
    return __shfl(bb, 63, 64);
}
DEVI void ml_prep_item(const PW& pw0, int l, int item, unsigned char* shm_in, int wv) {
    const PW p{opq64(pw0.ws)};
    unsigned char* shm = opq(shm_in);
    const int tid = MYTID, wid = __builtin_amdgcn_readfirstlane(tid >> 6), lane = tid & 63, fr = lane & 15, fq = lane >> 4;
    const int c = item % NCH, h = (item / NCH) & 3, b = (item / (NCH * 4)) & 3, dir = item / (NCH * 16);
    const bf16_t* P = (const bf16_t*)(p.ws + WS_P);
    bf16_t* sKT = (bf16_t*)shm;
    bf16_t* sVT = (bf16_t*)(shm + 9216);
    float* sc = (float*)(shm + 27648);
    const float* gp = (const float*)(p.ws + WS_GATES) + (size_t)(2176 + item) * 320;
    if (tid < 64) sc[128 + tid] = gp[128 + tid];
    {
        const int t = tid >> 3, cg8 = (tid & 7) * 8; const int row = tok_row(false, dir, b, c, t);
        float x[8]; unpack8(*(const u32x4*)(P + (size_t)row * DINP + C_MLK + h * 64 + cg8), x);
#pragma unroll
        for (int e = 0; e < 8; ++e) sKT[tix(cg8 + e, t)] = (bf16_t)f2bf(x[e]);
    }
#pragma unroll
    for (int r = 0; r < 2; ++r) {
        const int idx = tid + 512 * r, t = idx >> 4, cg8 = (idx & 15) * 8; const int row = tok_row(false, dir, b, c, t);
        float x[8]; unpack8(*(const u32x4*)(P + (size_t)row * DINP + C_MLV + h * 128 + cg8), x); const float w = gp[128 + t];
#pragma unroll
        for (int e = 0; e < 8; ++e) sVT[tix(cg8 + e, t)] = (bf16_t)f2bf(x[e] * w);
    }
    lbar();
    float* KV = (float*)(p.ws + WS_Y) + (size_t)item * 8192;
    {
        const int nt = wid;
#pragma unroll
        for (int mt = 0; mt < 4; ++mt) {
            f32x4 a = (f32x4){0.f, 0.f, 0.f, 0.f};
#pragma unroll
            for (int kk = 0; kk < 2; ++kk) a = MFMA16(ldfragT(sKT, mt * 16, kk * 32, lane), ldfragT(sVT, nt * 16, kk * 32, lane), a);
            *(f32x4*)(KV + (nt * 16 + fr) * 64 + mt * 16 + fq * 4) = a;
        }
    }
    if (tid < 64) { float s = 0.f;
        for (int t = 0; t < 64; ++t) s += sc[128 + t] * bf2f(sKT[tix(tid, t)]);
        ((float*)(p.ws + WS_SM + SM_MN))[item * 64 + tid] = s; }
    lbar();
}
DEVI void ml_seq(const PW& pw0, int gtid, int nthreads) {
    const PW p{opq64(pw0.ws)};
    const float* MSC = (const float*)(p.ws + WS_SM + SM_MSC);
    float* MM = (float*)(p.ws + WS_SM + SM_MM);
    for (int g = gtid; g < 32 * 4096 + 32 * 32; g += nthreads) {
        const bool isn = g >= 32 * 4096; const int gg = isn ? g - 32 * 4096 : g;
        const int chain = isn ? gg >> 5 : gg >> 12, e2 = isn ? gg & 31 : gg & 4095;
        float* base = isn ? (float*)(p.ws + WS_SM + SM_MN) + (size_t)chain * NCH * 64 + e2 * 2 : (float*)(p.ws + WS_Y) + (size_t)chain * NCH * 8192 + e2 * 2;
        const int stride = isn ? 64 : 8192;
        float m = 0.f; f32x2 C = (f32x2){0.f, 0.f};
        for (int c0 = 0; c0 < NCH; c0 += 17) {
            f32x2 kv[17]; f32x2 sc[17];
#pragma unroll
            for (int u = 0; u < 17; ++u) { kv[u] = *(const f32x2*)(base + (size_t)(c0 + u) * stride); sc[u] = *(const f32x2*)(MSC + (chain * NCH + c0 + u) * 2); }
#pragma unroll
            for (int u = 0; u < 17; ++u) {
                *(f32x2*)(base + (size_t)(c0 + u) * stride) = C;
                if (!isn && e2 == 0) MM[chain * NCH + c0 + u] = m;
                const float mn = fmaxf(sc[u][0] + m, sc[u][1]);
                const float a = __expf(sc[u][0] + m - mn), s = __expf(sc[u][1] - mn);
                C = C * a + kv[u] * s; m = mn;
            }
        }
    }
}
DEVI void ml_out_item(const PW& pw0, int l, int item, unsigned char* shm_in, int wv, int dry = 0) {
    const PW p{opq64(pw0.ws)};
    unsigned char* shm = opq(shm_in);
    const int tid = MYTID, wid = __builtin_amdgcn_readfirstlane(tid >> 6), lane = tid & 63, fr = lane & 15, fq = lane >> 4;
    const int j = item % NCH, h = (item / NCH) & 3, b = item / (NCH * 4);
    bf16_t* P = (bf16_t*)(p.ws + WS_P);
    bf16_t* sQ = (bf16_t*)shm;
    bf16_t* sK = (bf16_t*)(shm + 9216);
    bf16_t* sVT = (bf16_t*)(shm + 18432);
    bf16_t* sCT = (bf16_t*)(shm + 36864);
    bf16_t* sS = (bf16_t*)(shm + 55296);
    float* sO = (float*)(shm + 64512);
    float* sc = (float*)(shm + 98304);
#pragma unroll 1
    for (int dir = 0; dir < 2; ++dir) {
        const int c = dir_chunk(dir, j);
        const int it2 = ((dir * 4 + b) * 4 + h) * NCH + c;
        if (wid == 0) {
            const float* gp = (const float*)(p.ws + WS_GATES) + (size_t)(2176 + it2) * 320;
            const float m = ((const float*)(p.ws + WS_SM + SM_MM))[it2];
            const float bb = gp[lane], pm = gp[192 + lane];
            sc[lane] = bb; sc[64 + lane] = gp[64 + lane];
            const float mt = bb + fmaxf(m, pm);
            sc[128 + lane] = mt; sc[192 + lane] = __expf(bb + m - mt);
            sc[320 + lane] = ((const float*)(p.ws + WS_SM + SM_MN))[it2 * 64 + lane];
        }
        {
            const int t = tid >> 3, cg8 = (tid & 7) * 8; const int row = tok_row(false, dir, b, c, t);
            float x[8]; unpack8(*(const u32x4*)(P + (size_t)row * DINP + C_MLQ + h * 64 + cg8), x);
#pragma unroll
            for (int e = 0; e < 8; ++e) x[e] *= 0.125f;
            *(u32x4*)(sQ + t * 72 + cg8) = pack8(x);
            *(u32x4*)(sK + t * 72 + cg8) = *(const u32x4*)(P + (size_t)row * DINP + C_MLK + h * 64 + cg8);
        }
#pragma unroll
        for (int r = 0; r < 2; ++r) {
            const int idx = tid + 512 * r, t = idx >> 4, cg8 = (idx & 15) * 8; const int row = tok_row(false, dir, b, c, t);
            float x[8]; unpack8(*(const u32x4*)(P + (size_t)row * DINP + C_MLV + h * 128 + cg8), x);
#pragma unroll
            for (int e = 0; e < 8; ++e) sVT[tix(cg8 + e, t)] = (bf16_t)f2bf(x[e]);
        }
        {
            const float* CT = (const float*)(p.ws + WS_Y) + (size_t)it2 * 8192;
#pragma unroll
            for (int r = 0; r < 4; ++r) { const int idx = tid + 512 * r, e = idx >> 4, d4 = (idx & 15) * 4; const f32x4 v = *(const f32x4*)(CT + e * 64 + d4);
                u32x2 w; w[0] = pk2(v[0], v[1]); w[1] = pk2(v[2], v[3]); *(u32x2*)(sCT + e * 72 + d4) = w; }
        }
        lbar();
#pragma unroll
        for (int ti = 0; ti < 2; ++ti) {
            const int tile = wid * 2 + ti, m2 = tile >> 2, n2 = tile & 3;
            f32x4 a = (f32x4){0.f, 0.f, 0.f, 0.f};
#pragma unroll
            for (int kk = 0; kk < 2; ++kk) a = MFMA16(ldfrag(sQ, 72, m2 * 16, kk * 32, lane), ldfrag(sK, 72, n2 * 16, kk * 32, lane), a);
            const int s = n2 * 16 + fr;
#pragma unroll
            for (int jj = 0; jj < 4; ++jj) { const int t = m2 * 16 + fq * 4 + jj;
                sS[t * 72 + s] = (bf16_t)f2bf(s <= t ? a[jj] * __expf(sc[t] - sc[s] + sc[64 + s] - sc[128 + t]) : 0.f); }
        }
        lbar();
        if (tid < 64) {
            float ds = 0.f, qn = 0.f;
            for (int s = 0; s < 64; ++s) { ds += bf2f(sS[tid * 72 + s]); qn += bf2f(sQ[tid * 72 + s]) * sc[320 + s]; }
            const float den = ds + sc[192 + tid] * qn;
            sc[256 + tid] = 1.f / fmaxf(fabsf(den), __expf(-sc[128 + tid]));
        }
        lbar();
        {
            const int nt = wid;
#pragma unroll
            for (int mt = 0; mt < 4; ++mt) {
                f32x4 a = (f32x4){0.f, 0.f, 0.f, 0.f};
#pragma unroll
                for (int kk = 0; kk < 2; ++kk) a = MFMA16(ldfrag(sQ, 72, mt * 16, kk * 32, lane), ldfrag(sCT, 72, nt * 16, kk * 32, lane), a);
#pragma unroll
                for (int jj = 0; jj < 4; ++jj) a[jj] *= sc[192 + mt * 16 + fq * 4 + jj];
#pragma unroll
                for (int kk = 0; kk < 2; ++kk) a = MFMA16(ldfrag(sS, 72, mt * 16, kk * 32, lane), ldfragT(sVT, nt * 16, kk * 32, lane), a);
                const int e = nt * 16 + fr;
#pragma unroll
                for (int jj = 0; jj < 4; ++jj) { const int t = mt * 16 + fq * 4 + jj; const int i = dir ? 63 - t : t; const float hv = a[jj] * sc[256 + t];
                    if (dir) sO[i * 132 + e] += hv; else sO[i * 132 + e] = hv; }
            }
        }
        lbar();
    }
    {
        const int i = tid >> 3, e0 = (tid & 7) * 16;
        float v[16], ss = 0.f;
#pragma unroll
        for (int e = 0; e < 16; ++e) { v[e] = sO[i * 132 + e0 + e]; ss += v[e] * v[e]; }
        ss += __shfl_xor(ss, 1, 64); ss += __shfl_xor(ss, 2, 64); ss += __shfl_xor(ss, 4, 64);
        const float rs = rsqrtf(ss * (1.f / 128.f) + EPS);
        const int row = tok_row(false, 0, b, j, i);
        bf16_t* op = P + (size_t)row * DINP + C_MLO + h * 128 + e0;
        const float* g = pin(11) + l * 512 + h * 128 + e0;
#pragma unroll
        for (int half = 0; half < 2; ++half) {
            float z[8]; unpack8(*(const u32x4*)(op + half * 8), z); float o[8];
#pragma unroll
            for (int e = 0; e < 8; ++e) o[e] = v[half * 8 + e] * rs * g[half * 8 + e] * z[e];
            bf16_t* od = dry ? (bf16_t*)(p.ws + WS_GB) + (size_t)row * 512 + h * 128 + e0 : op;
            *(u32x4*)(od + half * 8) = pack8(o);
        }
    }
    lbar();
}

DEVI void lru_item(const PW& pw0, int l, int item, int mode, unsigned char* shm_in, int wv, int dry = 0) {
    const PW p{opq64(pw0.ws)};
    unsigned char* shm = opq(shm_in);
    const int tid = MYTID, wid = __builtin_amdgcn_readfirstlane(tid >> 6), lane = tid & 63, fr = lane & 15, fq = lane >> 4;
    const int n4 = item & 3, j = (item >> 2) % NCH, b = (item >> 2) / NCH; const bool isctx = j < 4;
    bf16_t* P = (bf16_t*)(p.ws + WS_P);
    bf16_t* sX = (bf16_t*)shm;
    const int p0 = (isctx ? j : j - 4) * 64;
    const float* cw = pin(12) + (size_t)l * 4 * 512; const float* cb = pin(13) + (size_t)l * 512;
    {
        const int ch = lane * 8, i0 = wid * 8;
        f32x4 w[4][2];
#pragma unroll
        for (int jj = 0; jj < 4; ++jj) { w[jj][0] = *(const f32x4*)(cw + jj * 512 + ch); w[jj][1] = *(const f32x4*)(cw + jj * 512 + ch + 4); }
        const f32x4 b0 = *(const f32x4*)(cb + ch), b1 = *(const f32x4*)(cb + ch + 4);
        u32x4 raw[11];
#pragma unroll
        for (int r = 0; r < 11; ++r) { const int row = pos_row(false, b, isctx, p0 + i0 + r - 2);
            raw[r] = (u32x4){0u, 0u, 0u, 0u}; if (row >= 0) raw[r] = *(const u32x4*)(P + (size_t)row * DINP + C_LRX + ch); }
#pragma unroll
        for (int i = 0; i < 8; ++i) {
            float a[8] = {b0[0], b0[1], b0[2], b0[3], b1[0], b1[1], b1[2], b1[3]};
#pragma unroll
            for (int jj = 0; jj < 4; ++jj) { float x[8]; unpack8(raw[i + jj], x);
#pragma unroll
                for (int e = 0; e < 4; ++e) { a[e] += w[jj][0][e] * x[e]; a[4 + e] += w[jj][1][e] * x[4 + e]; } }
            *(u32x4*)(sX + (i0 + i) * 520 + ch) = pack8(a);
        }
    }
    lbar();
    const int blk = wid;
    const bf16_t* WL = (const bf16_t*)(p.ws + WS_WLRU);
    float* LAGG = (float*)(p.ws + WS_SM + SM_LAGG);
    {
        const int ch = blk * 64 + n4 * 16 + fr;
        float hsum[4][4];
#pragma unroll
        for (int mt = 0; mt < 4; ++mt)
#pragma unroll
            for (int jj = 0; jj < 4; ++jj) hsum[mt][jj] = 0.f;
#pragma unroll
        for (int dir = 0; dir < 2; ++dir) {
            const bf16_t* wa = WL + (size_t)(0 * 16 + dir * 8 + blk) * 4096 + (n4 * 16 + fr) * 64 + fq * 8;
            const bf16_t* wx = WL + (size_t)(1 * 16 + dir * 8 + blk) * 4096 + (n4 * 16 + fr) * 64 + fq * 8;
            bf16x8 ba[2], bx[2];
#pragma unroll
            for (int kk = 0; kk < 2; ++kk) { ba[kk] = *(const bf16x8*)(wa + kk * 32); bx[kk] = *(const bf16x8*)(wx + kk * 32); }
            const float bias_a = pin(15)[(size_t)l * 1024 + dir * 512 + ch], bias_x = pin(17)[(size_t)l * 1024 + dir * 512 + ch];
            const float cl = -8.f * softplus(-pin(18)[(size_t)l * 1024 + dir * 512 + ch]);
            float av[4][4], bv[4][4];
#pragma unroll
            for (int mt = 0; mt < 4; ++mt) {
                f32x4 aa = (f32x4){0.f, 0.f, 0.f, 0.f}, ax = aa;
#pragma unroll
                for (int kk = 0; kk < 2; ++kk) { const bf16x8 af = ldfrag(sX, 520, mt * 16, blk * 64 + kk * 32, lane); aa = MFMA16(af, ba[kk], aa); ax = MFMA16(af, bx[kk], ax); }
#pragma unroll
                for (int jj = 0; jj < 4; ++jj) {
                    const int t = mt * 16 + fq * 4 + jj;
                    const float rr = sigm(aa[jj] + bias_a), ii = sigm(ax[jj] + bias_x), la = cl * rr;
                    const float ea = __expf(la);
                    av[mt][jj] = ea;
                    bv[mt][jj] = __builtin_amdgcn_sqrtf(fmaxf(1.f - ea * ea, 0.f)) * ii * bf2f(sX[t * 520 + ch]);
                }
            }
            const int c = dir_chunk(dir, j);
            const size_t aidx = (((size_t)dir * 4 + b) * NCH + c) * 512 + ch;
            float hin = mode ? LAGG[aidx * 2] : 0.f;
            float Pc = 1.f, Hc = 0.f;
#pragma unroll
            for (int mi = 0; mi < 4; ++mi) {
                const int mt = dir ? 3 - mi : mi;
                float Pl = 1.f, Hl = 0.f;
#pragma unroll
                for (int ji = 0; ji < 4; ++ji) { const int jj = dir ? 3 - ji : ji; Pl = av[mt][jj] * Pl; Hl = av[mt][jj] * Hl + bv[mt][jj]; }
                float Pq[4], Hq[4];
#pragma unroll
                for (int q = 0; q < 4; ++q) { Pq[q] = __shfl(Pl, fr + 16 * q, 64); Hq[q] = __shfl(Hl, fr + 16 * q, 64); }
                if (mode == 0) {
#pragma unroll
                    for (int qi = 0; qi < 4; ++qi) { const int q = dir ? 3 - qi : qi; Hc = Pq[q] * Hc + Hq[q]; Pc = Pq[q] * Pc; }
                } else {
                    float hh = hin;
                    float hme = hin;
#pragma unroll
                    for (int qi = 0; qi < 4; ++qi) { const int q = dir ? 3 - qi : qi; if (q == fq) hme = hh; hh = Pq[q] * hh + Hq[q]; }
                    hin = hh;
#pragma unroll
                    for (int ji = 0; ji < 4; ++ji) { const int jj = dir ? 3 - ji : ji; hme = av[mt][jj] * hme + bv[mt][jj]; hsum[mt][jj] += hme; }
                }
            }
            if (mode == 0 && fq == 0) { LAGG[aidx * 2] = Pc; LAGG[aidx * 2 + 1] = Hc; }
        }
        if (mode == 1) {
#pragma unroll
            for (int mt = 0; mt < 4; ++mt)
#pragma unroll
                for (int jj = 0; jj < 4; ++jj) { const int i = mt * 16 + fq * 4 + jj; const int row = pos_row(false, b, isctx, p0 + i);
                    hsum[mt][jj] *= bf2f(P[(size_t)row * DINP + C_LRY + ch]); }
#pragma unroll
            for (int mt = 0; mt < 4; ++mt)
#pragma unroll
                for (int jj = 0; jj < 4; ++jj) { const int i = mt * 16 + fq * 4 + jj; const int row = pos_row(false, b, isctx, p0 + i);
                    bf16_t* yp = P + (size_t)row * DINP + C_LRY + ch; bf16_t* yd = dry ? (bf16_t*)(p.ws + WS_GB) + (size_t)row * 512 + ch : yp; *yd = (bf16_t)f2bf(hsum[mt][jj]); }
        }
    }
    lbar();
}
DEVI void lru_seq(const PW& pw0, int gtid, int nthreads) {
    const PW p{opq64(pw0.ws)};
    float* LAGG = (float*)(p.ws + WS_SM + SM_LAGG);
    for (int g = gtid; g < 4096; g += nthreads) {
        const int ch = g & 511, db = g >> 9;
        float h = 0.f;
        for (int c0 = 0; c0 < NCH; c0 += 17) {
            f32x2 v[17];
#pragma unroll
            for (int u = 0; u < 17; ++u) v[u] = *(const f32x2*)(LAGG + (((size_t)db * NCH + c0 + u) * 512 + ch) * 2);
#pragma unroll
            for (int u = 0; u < 17; ++u) { LAGG[(((size_t)db * NCH + c0 + u) * 512 + ch) * 2] = h; h = v[u][0] * h + v[u][1]; }
        }
    }
}

DEVI void gate_phase(const PW& pw0, int l, int gwave, int nwaves, int lane) {
    const PW p{opq64(pw0.ws)};
    const bf16_t* P = (const bf16_t*)(p.ws + WS_P);
    float* GT = (float*)(p.ws + WS_GATES);
    for (int w = gwave; w < 4352; w += nwaves) {
        const int kind = w >= 2176 ? 1 : 0, item = kind ? w - 2176 : w;
        const int c = item % NCH, h = (item / NCH) & 3, b = (item / (NCH * 4)) & 3, dir = item / (NCH * 16);
        float* gp = GT + (size_t)(kind * 2176 + item) * 320;
        if (kind == 0) gdn_gates(p, P, l, b, c, h, dir, gp, lane);
        else {
            const int row = tok_row(false, dir, b, c, lane);
            const float ig = bf2f(P[(size_t)row * DINP + C_MLG + dir * 4 + h]) + pin(10)[l * 16 + dir * 4 + h];
            const float fg = bf2f(P[(size_t)row * DINP + C_MLG + (2 + dir) * 4 + h]) + pin(10)[l * 16 + (2 + dir) * 4 + h];
            float bb = logsig(fg);
#pragma unroll
            for (int o = 1; o < 64; o <<= 1) { const float t = __shfl_up(bb, o, 64); if (lane >= o) bb += t; }
            const float bT = __shfl(bb, 63, 64);
            const float lw = bT - bb + ig;
            const float Mc = wmax(lw);
            float pm = ig - bb;
#pragma unroll
            for (int o = 1; o < 64; o <<= 1) { const float t = __shfl_up(pm, o, 64); if (lane >= o) pm = fmaxf(pm, t); }
            gp[lane] = bb; gp[64 + lane] = ig; gp[128 + lane] = __expf(lw - Mc); gp[192 + lane] = pm;
            if (lane == 0) { float* msc = (float*)(p.ws + WS_SM + SM_MSC) + item * 2; msc[0] = bT; msc[1] = Mc; }
        }
    }
}

#define XB_TMO      128
#define XB_XCNT(j)  (256  + 64 * (j))
#define XB_XSUB(j)  (1280 + 64 * (j))
#define XB_XGEN(j)  (2304 + 64 * (j))
#define XB_TOP      3328
#define XB_TOPGEN   3392
#define XCD_BAR_WORDS 3456
#define XB_SPIN_CAP (1u << 22)
DEVI unsigned xb_ld(unsigned* p)              { return __hip_atomic_load(p, __ATOMIC_RELAXED, __HIP_MEMORY_SCOPE_AGENT); }
DEVI unsigned xb_add(unsigned* p, unsigned v) { return __hip_atomic_fetch_add(p, v, __ATOMIC_RELAXED, __HIP_MEMORY_SCOPE_AGENT); }
DEVI unsigned xb_xcc_id() { return (unsigned)__builtin_amdgcn_s_getreg((3 << 11) | 20) & 0xFu; }
#define XB_SPIN(cond, bar) do { unsigned _sp = 0; while (cond) { __builtin_amdgcn_s_sleep(1); \
    if ((++_sp & 255u) == 0u) { if (xb_ld(&(bar)[XB_TMO])) break; if (_sp > XB_SPIN_CAP) { atomicAdd(&(bar)[XB_TMO], 1u); break; } } } } while (0)
DEVI void xcd_barrier_complete(unsigned* bar, unsigned x, unsigned G, unsigned& nloc, unsigned& nx) {
    unsigned sum, cnt, mine, sp = 0u;
    for (;;) {
        sum = 0u; cnt = 0u; mine = 0u;
#pragma unroll
        for (unsigned j = 0; j < 16; ++j) { const unsigned c = xb_ld(&bar[XB_XCNT(j)]); sum += c; cnt += (c > 0u) ? 1u : 0u; mine = (j == x) ? c : mine; }
        if (sum == G) break;
        __builtin_amdgcn_s_sleep(1);
        if ((++sp & 255u) == 0u) { if (xb_ld(&bar[XB_TMO])) break; if (sp > XB_SPIN_CAP) { atomicAdd(&bar[XB_TMO], 1u); break; } }
    }
    nloc = mine > 0u ? mine : 1u; nx = cnt > 0u ? cnt : 1u;
}
DEVI void gsync(unsigned* bar, volatile LAS unsigned* st, int G, int wv) {
    asm volatile("s_waitcnt vmcnt(0)" ::: "memory");
    __syncthreads();
    const int ln = (int)__builtin_amdgcn_mbcnt_hi(~0u, __builtin_amdgcn_mbcnt_lo(~0u, 0u));
    if (wv == 0 && ln == 0) {
        __builtin_amdgcn_s_waitcnt(0);
        const unsigned x = xb_xcc_id();
        unsigned nloc = st[0], nx = st[1];
        if (nloc == 0u) { xcd_barrier_complete(bar, x, (unsigned)G, nloc, nx); st[0] = nloc; st[1] = nx; }
        const unsigned old = xb_add(&bar[XB_XSUB(x)], 1u);
        const unsigned gen = old / nloc;
        if (old + 1u == (gen + 1u) * nloc) {
            __builtin_amdgcn_fence(__ATOMIC_RELEASE, "agent");
            asm volatile("s_waitcnt vmcnt(0)" ::: "memory");
            const unsigned og = xb_add(&bar[XB_TOP], 1u);
            const unsigned tg = og / nx;
            if (og + 1u == (tg + 1u) * nx) xb_add(&bar[XB_TOPGEN], 1u);
            else XB_SPIN(xb_ld(&bar[XB_TOPGEN]) == tg, bar);
            __builtin_amdgcn_fence(__ATOMIC_ACQUIRE, "agent");
            xb_add(&bar[XB_XGEN(x)], 1u);
            asm volatile("s_waitcnt vmcnt(0)" ::: "memory");
        } else {
            XB_SPIN(xb_ld(&bar[XB_XGEN(x)]) == gen, bar);
            __builtin_amdgcn_fence(__ATOMIC_ACQUIRE, "agent");
            asm volatile("s_waitcnt vmcnt(0)" ::: "memory");
        }
    }
    __syncthreads();
}

__global__ void __launch_bounds__(512) mega(Params p) {
    extern __shared__ __attribute__((aligned(16))) unsigned char shm[];
    cg::grid_group grid = cg::this_grid();
    const int wv = __builtin_amdgcn_readfirstlane(threadIdx.x >> 6);
    const int G = gridDim.x, nwaves = G * 8, nthreads = G * 512;
#define TIDS const int tid = MYTID, wid = tid >> 6, lane = tid & 63, gwave = blockIdx.x * 8 + wid, gtid = blockIdx.x * 512 + tid; (void)gtid; (void)gwave; (void)lane;
    LAS unsigned char* lds = (LAS unsigned char*)shm;
#define WSQ unsigned char* ws = opq64(pw.ws); bf16_t* Hb = (bf16_t*)(ws + WS_H); bf16_t* Pb = (bf16_t*)(ws + WS_P); float* Yb = (float*)(ws + WS_Y); (void)Hb; (void)Pb; (void)Yb;

    const PW pw{p.ws};
    unsigned* bar = (unsigned*)p.ws;
    volatile LAS unsigned* xst = (volatile LAS unsigned*)((LAS unsigned char*)shm + (LDS_BYTES - 16));
    if (threadIdx.x == 0) { xst[0] = 0u; xst[1] = 0u; (void)xb_add(&bar[XB_XCNT(xb_xcc_id())], 1u); }
    __syncthreads();
    for (int rep = 0; rep < REP_CVT; ++rep) {
    mod_phase(pw, shm, wv);
    { TIDS convert_phase(pw, 0, shm, gwave, nwaves, wid, lane); }
    }
    grid.sync();
    { TIDS rowwise_phase(pw, 0, MTOT, 0, 0, 0.f, 0, 0, 0, 0, 0, gwave, nwaves, lane); }
    gsync(bar, xst, G, wv);

#pragma unroll 1
    for (int l = 0; l < DEPTH; ++l) {
        const bool last = l == DEPTH - 1;
#pragma unroll 1
        for (int f = 0; f < 2; ++f) {
            if (f == 1) {
                { WSQ pg8::Gemm g{Hb, (const bf16_t*)(ws + WS_WIN), 68, 31, D, D, 1, 0, 0, 0, 0, D, 0}; pg8::Order S; S.init(68, 31, 1, G, blockIdx.x);
                  pg8::EpiInProj E{Pb, DINP}; for (int rep = 0; rep < REP_GEMM; ++rep) pg8::gemm_phase(lds, g, S, E, wv); }
                gsync(bar, xst, G, wv);
                { TIDS gate_phase(pw, l, gwave, nwaves, lane); }
                gsync(bar, xst, G, wv);
#pragma unroll 1
                for (int rep2 = 0; rep2 < REP_PREPSEQ; ++rep2) {
#pragma unroll 1
                for (int rep = 0; rep < REP_PREP; ++rep)
                {
                    for (int it = blockIdx.x; it < 2176; it += G) for (int r3 = 0; r3 < REP_GDNP; ++r3) gdn_prep_item(pw, l, it, shm, wv);
                    for (int it = (blockIdx.x + G / 2) % G; it < 2176; it += G) for (int r3 = 0; r3 < REP_MLP; ++r3) ml_prep_item(pw, l, it, shm, wv);
                    for (int it = (blockIdx.x + G / 4) % G; it < 1088; it += G) for (int r3 = 0; r3 < REP_LRU0; ++r3) lru_item(pw, l, it, 0, shm, wv);
                }
                gsync(bar, xst, G, wv);
                for (int u = blockIdx.x; u < 256; u += G) gdn_seq_unit(pw, u, shm, wv);
                { TIDS ml_seq(pw, gtid, nthreads); }
                { TIDS lru_seq(pw, gtid, nthreads); }
                gsync(bar, xst, G, wv);
                }
                for (int it = blockIdx.x; it < 1088; it += G) { if (last && (it % NCH) < 4) continue; if (DRY_GO) gdn_out_item(pw, l, it, shm, wv, 1); gdn_out_item(pw, l, it, shm, wv); }
                for (int it = (blockIdx.x + G / 4) % G; it < 1088; it += G) { if (last && (it % NCH) < 4) continue; if (DRY_MO) ml_out_item(pw, l, it, shm, wv, 1); ml_out_item(pw, l, it, shm, wv); }
                for (int it = (blockIdx.x + G / 2) % G; it < 1088; it += G) { if (last && ((it >> 2) % NCH) < 4) continue; if (DRY_LO) lru_item(pw, l, it, 1, shm, wv, 1); lru_item(pw, l, it, 1, shm, wv); }
                gsync(bar, xst, G, wv);
                const int nM = last ? 64 : 68;
                { WSQ pg8::Gemm g{Pb, (const bf16_t*)(ws + WS_WBR), nM, 4, 512, DINP, 3, C_MLO, C_LRY, C_DNZ, D * 512, 512, 0}; pg8::Order S; S.init(nM, 4, 3, G, blockIdx.x);
                  pg8::EpiBranch E{Pb, Yb, Hb}; for (int rep = 0; rep < REP_BR; ++rep) pg8::gemm_phase(lds, g, S, E, wv); }
                gsync(bar, xst, G, wv);
                { WSQ pg8::Gemm g{Hb, (const bf16_t*)(ws + WS_WOUT), 64, 4, D, D, 1, 0, 0, 0, 0, D, 0}; pg8::Order S; S.init(64, 4, 1, G, blockIdx.x);
                  pg8::EpiBf16Y E{(bf16_t*)Yb, D}; for (int rep = 0; rep < REP_GEMM; ++rep) pg8::gemm_phase(lds, g, S, E, wv); }
                if (!last) { WSQ pg8::Gemm g{Hb, (const bf16_t*)(ws + WS_WOUT), 4, 4, 256, D, 4, 0, 0, 0, 256, D, 256}; pg8::Order S; S.init(4, 4, 4, G, blockIdx.x, 64, 1);
                  pg8::EpiF32 E{(float*)(ws + WS_GB), D, MLAT, (size_t)1024 * D}; pg8::gemm_phase(lds, g, S, E, wv); }
                gsync(bar, xst, G, wv);
                { TIDS if (DRY_ROW) { rowwise_phase(pw, 1, nM * 256, l, 5, 1.f, 3, l, 4, 6, 4, gwave, nwaves, lane, 1); } rowwise_phase(pw, 1, nM * 256, l, 5, 1.f, 3, l, 4, 6, 4, gwave, nwaves, lane); }
                gsync(bar, xst, G, wv);
            }
            const int nM = (last && f == 1) ? 64 : 68;
            { WSQ pg8::Gemm g{Hb, (const bf16_t*)(ws + WS_WGU + f * SZ_WGU), nM, 22, D, D, 1, 0, 0, 0, 0, D, 0}; pg8::Order S; S.init(nM, 22, 1, G, blockIdx.x);
              pg8::EpiSwiGLU E{Pb, DFF}; for (int rep = 0; rep < REP_GU; ++rep) pg8::gemm_phase(lds, g, S, E, wv); }
            gsync(bar, xst, G, wv);
            { WSQ pg8::Gemm g{Pb, (const bf16_t*)(ws + WS_WDN + f * SZ_WDN), 64, 4, DFF, DFF, 1, 0, 0, 0, 0, DFF, 0}; pg8::Order S; S.init(64, 4, 1, G, blockIdx.x);
              pg8::EpiBf16Y E{(bf16_t*)Yb, D}; for (int rep = 0; rep < REP_DN; ++rep) pg8::gemm_phase(lds, g, S, E, wv); }
            if (nM == 68) { WSQ pg8::Gemm g{Pb, (const bf16_t*)(ws + WS_WDN + f * SZ_WDN), 4, 4, 256, DFF, 11, 0, 0, 0, 256, DFF, 256}; pg8::Order S; S.init(4, 4, 11, G, blockIdx.x, 64, 1);
              pg8::EpiF32 E{(float*)(ws + WS_GB), D, MLAT, (size_t)1024 * D}; for (int rep = 0; rep < REP_DNC; ++rep) pg8::gemm_phase(lds, g, S, E, wv); }
            gsync(bar, xst, G, wv);
            if (f == 0) { TIDS if (DRY_ROW) { rowwise_phase(pw, 1, nM * 256, l, 2, 0.5f, 1, l, 2, 3, 11, gwave, nwaves, lane, 1); } rowwise_phase(pw, 1, nM * 256, l, 2, 0.5f, 1, l, 2, 3, 11, gwave, nwaves, lane); }
            else if (!last) { { TIDS if (DRY_ROW) { rowwise_phase(pw, 1, nM * 256, l, 8, 0.5f, 5, l + 1, 0, 0, 11, gwave, nwaves, lane, 1); } rowwise_phase(pw, 1, nM * 256, l, 8, 0.5f, 5, l + 1, 0, 0, 11, gwave, nwaves, lane); } for (int rep = 0; rep < REP_CVT; ++rep) { TIDS convert_phase(pw, l + 1, shm, gwave, nwaves, wid, lane); } }
            else { TIDS rowwise_phase(pw, 2, MLAT, l, 8, 0.5f, 5, 0, 0, 0, 0, gwave, nwaves, lane); }
            gsync(bar, xst, G, wv);
        }
    }
}

extern "C" void kernel_launch(void* const* d_in, const int* in_sizes, int n_in, void* d_out, int out_size, void* d_ws, size_t ws_size, hipStream_t stream) {
    static int grid = 0;
    if (grid == 0) {
        if (n_in != 25 || ws_size < WS_END) { fprintf(stderr, "kernel_launch: unexpected n_in %d or ws_size %zu (need %zu)\n", n_in, ws_size, (size_t)WS_END); grid = -1; return; }
        int dev = 0, cus = 0, per_cu = 0;
        hipGetDevice(&dev); hipDeviceGetAttribute(&cus, hipDeviceAttributeMultiprocessorCount, dev);
        if (hipFuncSetAttribute((const void*)mega, hipFuncAttributeMaxDynamicSharedMemorySize, LDS_BYTES) != hipSuccess) { fprintf(stderr, "kernel_launch: hipFuncSetAttribute failed\n"); grid = -1; return; }
        if (hipOccupancyMaxActiveBlocksPerMultiprocessor(&per_cu, (const void*)mega, 512, LDS_BYTES) != hipSuccess || per_cu < 1) { fprintf(stderr, "kernel_launch: occupancy query failed (%d)\n", per_cu); per_cu = 1; }
        (void)hipGetLastError();
        grid = cus * per_cu;
    }
    if (grid < 0) return;
    if (hipMemsetAsync(d_ws, 0, 16384, stream) != hipSuccess) { fprintf(stderr, "kernel_launch: memset failed\n"); return; }
    Params p{};
    for (int i = 0; i < 25; ++i) p.in[i] = (const float*)d_in[i];
    p.out = (float*)d_out; p.ws = (unsigned char*)d_ws;
    void* args[] = {&p};
    hipError_t e = hipLaunchCooperativeKernel((const void*)mega, dim3(grid), dim3(512), args, LDS_BYTES, stream);
    if (e != hipSuccess) fprintf(stderr, "cooperative launch failed: %s (grid %d)\n", hipGetErrorString(e), grid);
}
```

```cpp
#include <hip/hip_runtime.h>
#include <hip/hip_cooperative_groups.h>
#include <cstdio>
namespace cg = cooperative_groups;

#define LAS __attribute__((address_space(3)))
#define DEVI __device__ __forceinline__
typedef unsigned short bf16_t;
typedef short bf16x8 __attribute__((ext_vector_type(8)));
typedef float f32x4 __attribute__((ext_vector_type(4)));
typedef float f32x2 __attribute__((ext_vector_type(2)));
typedef unsigned u32x4 __attribute__((ext_vector_type(4)));
typedef unsigned u32x2 __attribute__((ext_vector_type(2)));

constexpr int D = 1024, NBATCH = 4, SEQ = 4096, CTXL = 256, DEPTH = 4, DFF = 2816, DINP = 7936;
constexpr int MLAT = NBATCH * SEQ, MTOT = MLAT + NBATCH * CTXL;
constexpr int NCH = 68;
constexpr int C_MLQ = 0, C_MLK = 256, C_MLV = 512, C_MLO = 1024, C_MLG = 1536, C_LRX = 1552, C_LRY = 2064,
              C_DNQ = 2576, C_DNZ = 4112, C_DNBA = 4624, C_GATE = 4640, C_END = 7712;
constexpr float EPS = 1e-6f;

constexpr size_t SZ_WGU = (size_t)2 * DFF * D * 2, SZ_WDN = (size_t)D * DFF * 2;
constexpr size_t WS_MOD = 16384;
constexpr size_t WS_WGU = 1u << 20;
constexpr size_t WS_WDN = WS_WGU + 2 * SZ_WGU;
constexpr size_t WS_WIN = WS_WDN + 2 * SZ_WDN;
constexpr size_t WS_WBR = WS_WIN + (size_t)DINP * D * 2;
constexpr size_t WS_WOUT = WS_WBR + (size_t)3 * D * 512 * 2;
constexpr size_t WS_WLRU = WS_WOUT + (size_t)D * D * 2;
constexpr size_t WS_X = WS_WLRU + (size_t)32 * 64 * 64 * 2;
constexpr size_t WS_H = WS_X + (size_t)MTOT * D * 4;
constexpr size_t WS_Y = WS_H + (size_t)MTOT * D * 2;
constexpr size_t WS_P = WS_Y + (size_t)MTOT * D * 4;
constexpr size_t WS_GU = WS_P + (size_t)MTOT * DINP * 2;
constexpr size_t WS_GB = WS_GU + (size_t)2176 * 64 * 128 * 2;
constexpr size_t WS_GN = WS_GB + (size_t)2176 * 128 * 128 * 2;
constexpr size_t WS_SM = WS_GN + (size_t)2176 * 128 * 128 * 2;
constexpr size_t SM_GDEC = 0, SM_MN = 16384, SM_MSC = SM_MN + 2176 * 64 * 4, SM_MM = SM_MSC + 2176 * 8, SM_LAGG = SM_MM + 2176 * 4 + 1024;
constexpr size_t WS_YC = WS_SM + SM_LAGG + (size_t)2 * 4 * NCH * 512 * 2 * 4 + 4096;
constexpr size_t WS_GATES = WS_YC;
constexpr size_t WS_END = WS_GATES + (size_t)2 * 2176 * 320 * 4 + 4096;
constexpr int LDS_BYTES = 155648;
constexpr int REP_BR = 1, REP_GU = 1, REP_DN = 1, REP_DNC = 1, REP_GEMM = 1, DRY_ROW = 0, REP_PREP = 1, REP_PREPSEQ = 1, REP_CVT = 1, REP_GDNP = 1, REP_MLP = 1, REP_LRU0 = 1, DRY_GO = 0, DRY_MO = 0, DRY_LO = 0;

struct Params { const float* in[25]; float* out; unsigned char* ws; };
struct PW { unsigned char* ws; };

#define CAS __attribute__((address_space(4)))
DEVI const float* pin(int i) { const CAS char* k = (const CAS char*)__builtin_amdgcn_kernarg_segment_ptr(); return *(const float* const volatile CAS*)(k + 8 * i); }
DEVI int opaque(int v) { asm volatile("" : "+v"(v)); return v; }
DEVI unsigned char* opq(unsigned char* p) { unsigned v = (unsigned)(size_t)(LAS unsigned char*)p; asm volatile("" : "+s"(v)); return (unsigned char*)(LAS unsigned char*)(size_t)v; }
DEVI LAS unsigned char* opql(LAS unsigned char* p) { unsigned v = (unsigned)(size_t)p; asm volatile("" : "+s"(v)); return (LAS unsigned char*)(size_t)v; }
DEVI unsigned char* opq64(unsigned char* p) { unsigned long long v = (unsigned long long)p; asm volatile("" : "+s"(v)); return (unsigned char*)v; }
#define MYTID opaque(wv * 64 + (int)__builtin_amdgcn_mbcnt_hi(~0u, __builtin_amdgcn_mbcnt_lo(~0u, 0u)))
DEVI float bf2f(bf16_t v) { return __uint_as_float(((unsigned)v) << 16); }
DEVI unsigned f2bf(float f) { unsigned u = __float_as_uint(f); return (u + 0x7fffu + ((u >> 16) & 1u)) >> 16; }
DEVI unsigned pk2(float lo, float hi) { return f2bf(lo) | (f2bf(hi) << 16); }
DEVI float sigm(float x) { return __builtin_amdgcn_rcpf(1.f + __expf(-x)); }
DEVI float silu(float x) { return x * sigm(x); }
DEVI float softplus(float x) { return x > 20.f ? x : log1pf(__expf(x)); }
DEVI float logsig(float x) { return fminf(x, 0.f) - log1pf(__expf(-fabsf(x))); }
DEVI float gelu_t(float x) { float u = 0.7978845608f * (x + 0.044715f * x * x * x); float e = __expf(2.f * u); return x * (1.f - __builtin_amdgcn_rcpf(e + 1.f)); }
DEVI float wsum(float v) { for (int o = 32; o > 0; o >>= 1) v += __shfl_xor(v, o, 64); return v; }
DEVI float wmax(float v) { for (int o = 32; o > 0; o >>= 1) v = fmaxf(v, __shfl_xor(v, o, 64)); return v; }
DEVI void unpack8(u32x4 r, float* f) {
    f[0] = __uint_as_float(r[0] << 16); f[1] = __uint_as_float(r[0] & 0xffff0000u); f[2] = __uint_as_float(r[1] << 16); f[3] = __uint_as_float(r[1] & 0xffff0000u);
    f[4] = __uint_as_float(r[2] << 16); f[5] = __uint_as_float(r[2] & 0xffff0000u); f[6] = __uint_as_float(r[3] << 16); f[7] = __uint_as_float(r[3] & 0xffff0000u);
}
DEVI u32x4 pack8(const float* f) { u32x4 r; r[0] = pk2(f[0], f[1]); r[1] = pk2(f[2], f[3]); r[2] = pk2(f[4], f[5]); r[3] = pk2(f[6], f[7]); return r; }
DEVI bf16x8 ldfrag(const bf16_t* base, int ld, int row0, int k0, int lane) { return *(const bf16x8*)(base + (row0 + (lane & 15)) * ld + k0 + (lane >> 4) * 8); }
DEVI int tix(int row, int col) { return row * 72 + ((((col >> 3) + (row >> 3)) & 7) << 3) + (col & 7); }
DEVI bf16x8 ldfragT(const bf16_t* base, int row0, int k0, int lane) { const int r = row0 + (lane & 15), lg = (k0 >> 3) + (lane >> 4); return *(const bf16x8*)(base + r * 72 + (((lg + (r >> 3)) & 7) << 3)); }
DEVI void lbar() { asm volatile("s_waitcnt lgkmcnt(0)" ::: "memory"); __builtin_amdgcn_s_barrier(); asm volatile("" ::: "memory"); }
#define MFMA16(a, b, c) __builtin_amdgcn_mfma_f32_16x16x32_bf16(a, b, c, 0, 0, 0)

namespace pg8 {
constexpr int BM = 256, BK = 64, HALF = 128, HTB = HALF * BK * 2, NXCD = 8, WGM = 8;
DEVI int lds_byte(int r, int c) { const int st = (r >> 4) * 2 + (c >> 5), rr = r & 15, cc = c & 31, ob = rr * 64 + cc * 2; return st * 1024 + (ob ^ (((ob >> 9) & 1) << 5)); }
DEVI void stage_rc(int b, int& R, int& C) { const int st = b / 1024, sb = b % 1024, swz = sb ^ (((sb >> 9) & 1) << 5); R = (st >> 1) * 16 + swz / 64; C = (st & 1) * 32 + (swz % 64) / 2; }
DEVI int perm32(int rho) { const int n = rho >> 4, i = rho & 15; return 8 * (i >> 2) + 4 * n + (i & 3); }
struct Unit { int pm, pn, z; };
struct Gemm { const bf16_t* A; const bf16_t* Bt; int nM, nN, K, lda, nz, zA0, zA1, zA2, zB; int ldb, zAstep; };
struct Order {
    int nM, nN, nwg, G, c, nz, pm0, spread;
    DEVI void init(int nM_, int nN_, int nz_, int G_, int c_, int pm0_ = 0, int spread_ = 0) { nM = nM_; nN = nN_; nwg = nM * nN; G = G_; c = c_; nz = nz_; pm0 = pm0_; spread = spread_; }
    DEVI bool next(int i, Unit& u) const {
        int ti = i, z = 0; long L;
        if (spread) { L = (long)i * G + c; if (L >= (long)nwg * nz) return false; z = (int)(L / nwg); L -= (long)z * nwg; }
        else { if (nz == 3) { ti = i / 3; z = i - ti * 3; } L = (long)ti * G + c; if (L >= nwg) return false; }
        int wgid = (int)L; { const int q = nwg / NXCD, r = nwg % NXCD, xcd = wgid % NXCD, off = wgid / NXCD; wgid = (xcd < r ? xcd * (q + 1) : r * (q + 1) + (xcd - r) * q) + off; }
        const int nig = WGM * nN, gid = wgid / nig, fm = gid * WGM, gsz = (nM - fm) < WGM ? (nM - fm) : WGM;
        u.pm = pm0 + fm + ((wgid % nig) % gsz); u.pn = (wgid % nig) / gsz; u.z = z; return true;
    }
};

template <class Epi>
DEVI void gemm_phase(LAS unsigned char* lds_in, const Gemm g, const Order& S, const Epi& E, int wv) {
    LAS unsigned char* lds = opql(lds_in);
    const int tid = MYTID, wid = __builtin_amdgcn_readfirstlane(tid >> 6), lane = tid & 63, wr = wid >> 2, wc = wid & 3, fr = lane & 15, fq = lane >> 4;
    const int K = g.K, nt = K / BK, lda = g.lda, ldb = g.ldb;
    unsigned voffA[2], voffB[2];
#pragma unroll
    for (int i = 0; i < 2; ++i) { int R, C; stage_rc(tid * 16 + i * 8192, R, C); const int Rb = Epi::PERM ? ((R & ~31) + perm32(R & 31)) : R;
        voffA[i] = (unsigned)(R * lda + C) * 2u; voffB[i] = (unsigned)(Rb * ldb + C) * 2u; }
    const size_t kstep = (size_t)(BK * 2);
    const size_t hstepA = (size_t)HALF * lda * 2, hstepB = (size_t)HALF * ldb * 2;
    const unsigned ldsw = (unsigned)wid * 1024u;
    const int aoff = lds_byte(wr * 64 + fr, fq * 8), boff = lds_byte(wc * 32 + fr, fq * 8);
#define PG8_SA(b, h) (((b) * 2 + (h)) * HTB)
#define PG8_SB(b, h) ((4 + (b) * 2 + (h)) * HTB)
#define PG8_STAGE(bufoff, gbase, voff) do { _Pragma("unroll") for (int _i = 0; _i < 2; ++_i) \
        __builtin_amdgcn_global_load_lds((const unsigned*)((const char*)(gbase) + (voff)[_i]), (LAS unsigned*)(lds + (bufoff) + ldsw + _i * 8192), 16, 0, 0); } while (0)
#define PG8_LDA(dst, b, h) do { _Pragma("unroll") for (int m = 0; m < 4; ++m) _Pragma("unroll") for (int k = 0; k < 2; ++k) dst[m][k] = *(const LAS bf16x8*)(lds + PG8_SA(b, h) + aoff + m * 2048 + k * 1024); } while (0)
#define PG8_LDB(dst, b, h) do { _Pragma("unroll") for (int n = 0; n < 2; ++n) _Pragma("unroll") for (int k = 0; k < 2; ++k) dst[n][k] = *(const LAS bf16x8*)(lds + PG8_SB(b, h) + boff + n * 2048 + k * 1024); } while (0)
#define PG8_MMA(ai, bj, At, Bt) do { __builtin_amdgcn_s_setprio(1); _Pragma("unroll") for (int m = 0; m < 4; ++m) _Pragma("unroll") for (int n = 0; n < 2; ++n) _Pragma("unroll") for (int k = 0; k < 2; ++k) \
        acc[ai][bj][m][n] = __builtin_amdgcn_mfma_f32_16x16x32_bf16(Bt[n][k], At[m][k], acc[ai][bj][m][n], 0, 0, 0); __builtin_amdgcn_s_setprio(0); } while (0)
#define PG8_WAIT_V(n) asm volatile("s_waitcnt vmcnt(" #n ")" ::: "memory")
#define PG8_WAIT_L(n) asm volatile("s_waitcnt lgkmcnt(" #n ")" ::: "memory")
#define PG8_BAR __builtin_amdgcn_s_barrier()
#define PG8_SCHED __builtin_amdgcn_sched_barrier(0)
#define PG8_PA(u) ((const char*)g.A + ((size_t)(g.nz == 3 ? ((u).z == 0 ? g.zA0 : ((u).z == 1 ? g.zA1 : g.zA2)) : (u).z * g.zAstep) + (size_t)(u).pm * BM * lda) * 2)
#define PG8_PB(u) ((const char*)g.Bt + ((size_t)(u).z * g.zB + (size_t)(u).pn * BM * ldb) * 2)
    Unit cur, nxt; int ui = 0;
    if (!S.next(0, cur)) return;
    f32x4 acc[2][2][4][2];
#pragma unroll
    for (int a = 0; a < 2; ++a)
#pragma unroll
        for (int b = 0; b < 2; ++b)
#pragma unroll
            for (int m = 0; m < 4; ++m)
#pragma unroll
                for (int n = 0; n < 2; ++n) acc[a][b][m][n] = (f32x4){0.f, 0.f, 0.f, 0.f};
    bf16x8 At[4][2], B0[2][2], B1[2][2];
    const char* cA = PG8_PA(cur); const char* cB = PG8_PB(cur);
    PG8_STAGE(PG8_SB(0, 0), cB, voffB); PG8_STAGE(PG8_SA(0, 0), cA, voffA); PG8_STAGE(PG8_SB(0, 1), cB + hstepB, voffB); PG8_STAGE(PG8_SA(0, 1), cA + hstepA, voffA);
    if (wr == 1) PG8_BAR;
    PG8_WAIT_V(4); PG8_BAR;
    PG8_STAGE(PG8_SB(1, 0), cB + kstep, voffB); PG8_STAGE(PG8_SA(1, 0), cA + kstep, voffA); PG8_STAGE(PG8_SB(1, 1), cB + hstepB + kstep, voffB);
    PG8_WAIT_V(6); PG8_BAR;
    for (;;) {
        const bool has_next = S.next(ui + 1, nxt);
        const char* nA = has_next ? PG8_PA(nxt) : cA; const char* nB = has_next ? PG8_PB(nxt) : cB;
        for (int t = 0; t < nt; t += 2) {
            const bool last = (t == nt - 2);
            const char* a1 = cA + (size_t)(t + 1) * kstep;
            const char* a2 = last ? nA : cA + (size_t)(t + 2) * kstep; const char* b2 = last ? nB : cB + (size_t)(t + 2) * kstep;
            const char* a3 = a2 + kstep; const char* b3 = b2 + kstep;
            PG8_LDB(B0, 0, 0); PG8_SCHED; PG8_LDA(At, 0, 0); PG8_STAGE(PG8_SA(1, 1), a1 + hstepA, voffA);
            PG8_WAIT_L(8); PG8_BAR; PG8_WAIT_L(0); PG8_MMA(0, 0, At, B0); PG8_BAR; PG8_SCHED;
            PG8_LDB(B1, 0, 1); PG8_STAGE(PG8_SB(0, 0), b2, voffB);
            PG8_BAR; PG8_WAIT_L(0); PG8_MMA(0, 1, At, B1); PG8_BAR;
            PG8_LDA(At, 0, 1); PG8_STAGE(PG8_SA(0, 0), a2, voffA);
            PG8_BAR; PG8_WAIT_L(0); PG8_MMA(1, 0, At, B0); PG8_BAR; PG8_SCHED;
            PG8_STAGE(PG8_SB(0, 1), b2 + hstepB, voffB);
            PG8_WAIT_V(6); PG8_BAR; PG8_MMA(1, 1, At, B1); PG8_BAR;
            PG8_LDB(B0, 1, 0); PG8_SCHED; PG8_LDA(At, 1, 0); PG8_STAGE(PG8_SA(0, 1), a2 + hstepA, voffA);
            PG8_WAIT_L(8); PG8_BAR; PG8_WAIT_L(0); PG8_MMA(0, 0, At, B0); PG8_BAR; PG8_SCHED;
            PG8_LDB(B1, 1, 1); PG8_STAGE(PG8_SB(1, 0), b3, voffB);
            PG8_BAR; PG8_WAIT_L(0); PG8_MMA(0, 1, At, B1); PG8_BAR;
            PG8_LDA(At, 1, 1); PG8_STAGE(PG8_SA(1, 0), a3, voffA);
            PG8_BAR; PG8_WAIT_L(0); PG8_MMA(1, 0, At, B0); PG8_BAR; PG8_SCHED;
            PG8_STAGE(PG8_SB(1, 1), b3 + hstepB, voffB);
            PG8_WAIT_V(6); PG8_BAR; PG8_MMA(1, 1, At, B1); PG8_BAR;
        }
        E(acc, cur, wr, wc, fr, fq);
        if (!has_next) break;
#pragma unroll
        for (int a = 0; a < 2; ++a)
#pragma unroll
            for (int b = 0; b < 2; ++b)
#pragma unroll
                for (int m = 0; m < 4; ++m)
#pragma unroll
                    for (int n = 0; n < 2; ++n) acc[a][b][m][n] = (f32x4){0.f, 0.f, 0.f, 0.f};
        cur = nxt; cA = nA; cB = nB; ++ui;
    }
    PG8_WAIT_V(0);
    if (wr == 0) PG8_BAR;
    PG8_BAR;
#undef PG8_SA
#undef PG8_SB
#undef PG8_STAGE
#undef PG8_LDA
#undef PG8_LDB
#undef PG8_MMA
#undef PG8_WAIT_V
#undef PG8_WAIT_L
#undef PG8_BAR
#undef PG8_SCHED
#undef PG8_PA
#undef PG8_PB
}

struct EpiF32 {
    static constexpr bool PERM = false;
    float* C; int ldc; int row_base; size_t zstride;
    DEVI void operator()(const f32x4 (&acc)[2][2][4][2], const Unit& u, int wr, int wc, int fr, int fq) const {
        const int row0 = u.pm * BM + wr * 64 + fr - row_base, col0 = u.pn * BM + wc * 32 + 4 * fq;
#pragma unroll
        for (int ai = 0; ai < 2; ++ai)
#pragma unroll
            for (int m = 0; m < 4; ++m) { float* rowp = C + (size_t)u.z * zstride + (size_t)(row0 + ai * HALF + m * 16) * ldc + col0;
#pragma unroll
                for (int bj = 0; bj < 2; ++bj)
#pragma unroll
                    for (int n = 0; n < 2; ++n) *(f32x4*)(rowp + bj * HALF + n * 16) = acc[ai][bj][m][n]; }
    }
};
struct EpiBf16Y {
    static constexpr bool PERM = true;
    bf16_t* O; int ldc;
    DEVI void operator()(const f32x4 (&acc)[2][2][4][2], const Unit& u, int wr, int wc, int fr, int fq) const {
        const int row0 = u.pm * BM + wr * 64 + fr;
#pragma unroll
        for (int bj = 0; bj < 2; ++bj) { const int c0 = u.pn * BM + bj * HALF + wc * 32 + 8 * fq;
#pragma unroll
            for (int ai = 0; ai < 2; ++ai)
#pragma unroll
                for (int m = 0; m < 4; ++m) { float v[8];
#pragma unroll
                    for (int n = 0; n < 2; ++n)
#pragma unroll
                        for (int i = 0; i < 4; ++i) v[n * 4 + i] = acc[ai][bj][m][n][i];
                    *(u32x4*)(O + (size_t)(row0 + ai * HALF + m * 16) * ldc + c0) = pack8(v); } }
    }
};
struct EpiAtomic {
    static constexpr bool PERM = false;
    float* C; int ldc; int row_base;
    DEVI void operator()(const f32x4 (&acc)[2][2][4][2], const Unit& u, int wr, int wc, int fr, int fq) const {
        const int row0 = u.pm * BM + wr * 64 + fr - row_base, col0 = u.pn * BM + wc * 32 + 4 * fq;
#pragma unroll
        for (int ai = 0; ai < 2; ++ai)
#pragma unroll
            for (int m = 0; m < 4; ++m) { float* rowp = C + (size_t)(row0 + ai * HALF + m * 16) * ldc + col0;
#pragma unroll
                for (int bj = 0; bj < 2; ++bj)
#pragma unroll
                    for (int n = 0; n < 2; ++n)
#pragma unroll
                        for (int e = 0; e < 4; ++e) __hip_atomic_fetch_add(rowp + bj * HALF + n * 16 + e, acc[ai][bj][m][n][e], __ATOMIC_RELAXED, __HIP_MEMORY_SCOPE_AGENT); }
    }
};
struct EpiSwiGLU {
    static constexpr bool PERM = false;
    bf16_t* O; int ldc;
    DEVI void operator()(const f32x4 (&acc)[2][2][4][2], const Unit& u, int wr, int wc, int fr, int fq) const {
        const int row0 = u.pm * BM + wr * 64 + fr, col0 = u.pn * 128 + wc * 32 + 8 * fq;
#pragma unroll
        for (int ai = 0; ai < 2; ++ai)
#pragma unroll
            for (int m = 0; m < 4; ++m) {
                float v[8];
#pragma unroll
                for (int bj = 0; bj < 2; ++bj)
#pragma unroll
                    for (int i = 0; i < 4; ++i) { const float gt = acc[ai][bj][m][0][i], up = acc[ai][bj][m][1][i]; v[bj * 4 + i] = silu(gt) * up; }
                *(u32x4*)(O + (size_t)(row0 + ai * HALF + m * 16) * ldc + col0) = pack8(v);
            }
    }
};
struct EpiInProj {
    static constexpr bool PERM = true;
    bf16_t* O; int ldc;
    DEVI void operator()(const f32x4 (&acc)[2][2][4][2], const Unit& u, int wr, int wc, int fr, int fq) const {
        const int row0 = u.pm * BM + wr * 64 + fr;
#pragma unroll
        for (int bj = 0; bj < 2; ++bj) {
            const int c0 = u.pn * BM + bj * HALF + wc * 32 + 8 * fq;
            int kind = 0;
            if (c0 >= C_MLO && c0 < C_MLG) kind = 1; else if (c0 >= C_LRY && c0 < C_DNQ) kind = 2; else if (c0 >= C_DNZ && c0 < C_DNBA) kind = 3; else if (c0 >= C_GATE) kind = 1;
#define INPROJ_STORE(FN) _Pragma("unroll") for (int ai = 0; ai < 2; ++ai) _Pragma("unroll") for (int m = 0; m < 4; ++m) { float v[8]; \
                _Pragma("unroll") for (int n = 0; n < 2; ++n) _Pragma("unroll") for (int i = 0; i < 4; ++i) { const float x = acc[ai][bj][m][n][i]; v[n * 4 + i] = FN; } \
                *(u32x4*)(O + (size_t)(row0 + ai * HALF + m * 16) * ldc + c0) = pack8(v); }
            if (kind == 0) { INPROJ_STORE(x) } else if (kind == 1) { INPROJ_STORE(sigm(x)) } else if (kind == 2) { INPROJ_STORE(gelu_t(x)) } else { INPROJ_STORE(silu(x)) }
#undef INPROJ_STORE
        }
    }
};
struct EpiBranch {
    static constexpr bool PERM = false;
    const bf16_t* P; bf16_t* T; bf16_t* U;
    DEVI void operator()(const f32x4 (&acc)[2][2][4][2], const Unit& u, int wr, int wc, int fr, int fq) const {
        const int row0 = u.pm * BM + wr * 64 + fr, col0 = u.pn * BM + wc * 32 + 4 * fq; const int z = u.z;
        bf16_t* dst = z < 2 ? T : U;
#pragma unroll
        for (int ai = 0; ai < 2; ++ai)
#pragma unroll
            for (int mh = 0; mh < 2; ++mh) {
                u32x2 gr[2][2][2], tv[2][2][2];
#pragma unroll
                for (int mm = 0; mm < 2; ++mm) { const size_t row = (size_t)(row0 + ai * HALF + (mh * 2 + mm) * 16);
#pragma unroll
                    for (int bj = 0; bj < 2; ++bj)
#pragma unroll
                        for (int n = 0; n < 2; ++n) { const int col = col0 + bj * HALF + n * 16;
                            gr[mm][bj][n] = *(const u32x2*)(P + row * DINP + C_GATE + z * D + col);
                            tv[mm][bj][n] = (u32x2){0u, 0u};
                            if (z > 0) tv[mm][bj][n] = *(const u32x2*)(T + row * D + col); } }
#pragma unroll
                for (int mm = 0; mm < 2; ++mm) { const size_t row = (size_t)(row0 + ai * HALF + (mh * 2 + mm) * 16);
#pragma unroll
                    for (int bj = 0; bj < 2; ++bj)
#pragma unroll
                        for (int n = 0; n < 2; ++n) { const int col = col0 + bj * HALF + n * 16;
                            const u32x2 g2 = gr[mm][bj][n], t2 = tv[mm][bj][n]; f32x4 a = acc[ai][bj][mh * 2 + mm][n];
                            a[0] = a[0] * __uint_as_float(g2[0] << 16) + __uint_as_float(t2[0] << 16); a[1] = a[1] * __uint_as_float(g2[0] & 0xffff0000u) + __uint_as_float(t2[0] & 0xffff0000u);
                            a[2] = a[2] * __uint_as_float(g2[1] << 16) + __uint_as_float(t2[1] << 16); a[3] = a[3] * __uint_as_float(g2[1] & 0xffff0000u) + __uint_as_float(t2[1] & 0xffff0000u);
                            u32x2 w; w[0] = pk2(a[0], a[1]); w[1] = pk2(a[2], a[3]); *(u32x2*)(dst + row * D + col) = w; } }
            }
    }
};
}

DEVI int tok_row(bool gdn, int dir, int b, int c, int t) {
    if (c < 4) { int p = c * 64 + t; if (dir) p = 255 - p; return MLAT + b * 256 + p; }
    int p = (c - 4) * 64 + t; if (dir) p = 4095 - p;
    const int s = gdn ? ((p & 63) * 64 + (p >> 6)) : p;
    return b * 4096 + s;
}
DEVI int pos_row(bool gdn, int b, bool isctx, int p) {
    if (isctx) { if (p < 0 || p >= 256) return -1; return MLAT + b * 256 + p; }
    if (p < 0 || p >= 4096) return -1;
    const int s = gdn ? ((p & 63) * 64 + (p >> 6)) : p;
    return b * 4096 + s;
}
DEVI int dir_chunk(int dir, int j) { return dir ? (j < 4 ? 3 - j : 71 - j) : j; }

DEVI int gu_rowmap(int s) {
    const int n = s >= DFF ? 1 : 0, a = s - n * DFF, pn = a >> 7, r = a & 127, wc = r >> 5, fq = (r >> 3) & 3, bj = (r >> 2) & 1, i = r & 3;
    return 256 * pn + 128 * bj + 32 * wc + 16 * n + 4 * fq + i;
}
DEVI void cvt_tile(const float* src, int ldsrc, int Nvalid, int k0, int n0, bf16_t* dst, int lddst, int mode, float* buf, int lane) {
    f32x4 vv[16];
#pragma unroll
    for (int it = 0; it < 16; ++it) {
        const int row = it * 4 + (lane >> 4), c4 = (lane & 15) * 4;
        vv[it] = (f32x4){0.f, 0.f, 0.f, 0.f};
        if (n0 + c4 < Nvalid) vv[it] = *(const f32x4*)(src + (size_t)(k0 + row) * ldsrc + n0 + c4);
    }
#pragma unroll
    for (int it = 0; it < 16; ++it) {
        const int row = it * 4 + (lane >> 4), c4 = (lane & 15) * 4;
        float* bp = buf + row * 65 + c4; bp[0] = vv[it][0]; bp[1] = vv[it][1]; bp[2] = vv[it][2]; bp[3] = vv[it][3];
    }
    asm volatile("s_waitcnt lgkmcnt(0)" ::: "memory"); __builtin_amdgcn_wave_barrier();
#pragma unroll 2
    for (int it = 0; it < 8; ++it) {
        const int nc = it * 8 + (lane >> 3), kk = (lane & 7) * 8;
        float f[8];
#pragma unroll
        for (int e = 0; e < 8; ++e) f[e] = buf[(kk + e) * 65 + nc];
        const int drow = mode == 1 ? gu_rowmap(n0 + nc) : (n0 + nc);
        *(u32x4*)(dst + (size_t)drow * lddst + k0 + kk) = pack8(f);
    }
    asm volatile("s_waitcnt lgkmcnt(0)" ::: "memory"); __builtin_amdgcn_wave_barrier();
}
DEVI void convert_phase(const PW& pw0, int l, unsigned char* shm_in, int gwave, int nwaves, int wid, int lane) {
    const PW p{opq64(pw0.ws)};
    unsigned char* shm = opq(shm_in);
    float* buf = (float*)shm + wid * (64 * 65);
    unsigned char* ws = p.ws;
    for (int t = gwave; t < 6880; t += nwaves) {
        int r = t;
        if (r < 2816) { const int f = r / 1408; r -= f * 1408; const int kt = r / 88, ntl = r % 88;
            cvt_tile(pin(7) + ((size_t)(l * 2 + f)) * D * 2 * DFF, 2 * DFF, 2 * DFF, kt * 64, ntl * 64, (bf16_t*)(ws + WS_WGU + f * SZ_WGU), D, 1, buf, lane); continue; }
        r -= 2816;
        if (r < 1408) { const int f = r / 704; r -= f * 704; const int kt = r / 16, ntl = r % 16;
            cvt_tile(pin(8) + ((size_t)(l * 2 + f)) * DFF * D, D, D, kt * 64, ntl * 64, (bf16_t*)(ws + WS_WDN + f * SZ_WDN), DFF, 0, buf, lane); continue; }
        r -= 1408;
        if (r < 1984) { const int kt = r / 124, ntl = r % 124;
            cvt_tile(pin(9) + (size_t)l * D * C_END, C_END, C_END, kt * 64, ntl * 64, (bf16_t*)(ws + WS_WIN), D, 0, buf, lane); continue; }
        r -= 1984;
        if (r < 384) { const int n = r / 128; r -= n * 128; const int kt = r / 16, ntl = r % 16;
            cvt_tile(pin(23) + ((size_t)(l * 3 + n)) * 512 * D, D, D, kt * 64, ntl * 64, (bf16_t*)(ws + WS_WBR) + (size_t)n * D * 512, 512, 0, buf, lane); continue; }
        r -= 384;
        if (r < 256) { const int kt = r / 16, ntl = r % 16;
            cvt_tile(pin(24) + (size_t)l * D * D, D, D, kt * 64, ntl * 64, (bf16_t*)(ws + WS_WOUT), D, 0, buf, lane); continue; }
        r -= 256;
        { const int gate = r >> 4, dn = r & 15;
            cvt_tile(pin(gate ? 16 : 14) + ((size_t)l * 16 + dn) * 4096, 64, 64, 0, 0, (bf16_t*)(ws + WS_WLRU) + (size_t)(gate * 16 + dn) * 4096, 64, 0, buf, lane); }
    }
}

DEVI void mod_phase(const PW& pw0, unsigned char* shm_in, int wv) {
    const PW p{opq64(pw0.ws)};
    unsigned char* shm = opq(shm_in);
    float* sC = (float*)shm;
    float* red = sC + 5 * 1024;
    const int tid = MYTID;
    __syncthreads();
    for (int i = tid; i < 5 * 1024; i += 512) { const int v = i >> 10, k = i & 1023; const float x = v < 4 ? pin(1)[v * 1024 + k] : pin(3)[k]; sC[i] = silu(x); }
    __syncthreads();
    float* MOD = (float*)(p.ws + WS_MOD);
    const int cgp = tid & 15, is = tid >> 4;
    for (int task = blockIdx.x; task < DEPTH * 144; task += gridDim.x) {
        const int l = task / 144, col0 = (task % 144) * 64;
        float acc[5][4];
#pragma unroll
        for (int v = 0; v < 5; ++v)
#pragma unroll
            for (int e = 0; e < 4; ++e) acc[v][e] = 0.f;
        const float* wp = pin(4) + ((size_t)l * 1024 + is * 32) * 9216 + col0 + cgp * 4;
#pragma unroll 16
        for (int r = 0; r < 32; ++r) {
            const f32x4 w = *(const f32x4*)(wp + (size_t)r * 9216);
#pragma unroll
            for (int v = 0; v < 5; ++v) { const float s = sC[v * 1024 + is * 32 + r];
#pragma unroll
                for (int e = 0; e < 4; ++e) acc[v][e] += s * w[e]; }
        }
#pragma unroll
        for (int v = 0; v < 5; ++v)
#pragma unroll
            for (int e = 0; e < 4; ++e) red[tid * 20 + v * 4 + e] = acc[v][e];
        __syncthreads();
        if (tid < 320) { const int v = tid >> 6, c = tid & 63; float s = 0.f;
            for (int k = 0; k < 32; ++k) s += red[(k * 16 + (c >> 2)) * 20 + v * 4 + (c & 3)];
            MOD[((size_t)(l * 5 + v)) * 9216 + col0 + c] = s + pin(5)[(size_t)l * 9216 + col0 + c]; }
        __syncthreads();
    }
}

DEVI void rowwise_phase(const PW& pw0, int mode, int nrows, int l, int kgate, float coef, int gpost_i, int ln, int gpre_i, int kshift, int nzc, int gwave, int nwaves, int lane, int dry = 0) {
    const PW p{opq64(pw0.ws)};
    float* X = (float*)(p.ws + WS_X); float* Xw = dry ? (float*)(p.ws + WS_GN) : X; const float* Y0 = (const float*)(p.ws + WS_Y); const float* YC = (const float*)(p.ws + WS_GB); bf16_t* H = dry ? (bf16_t*)(p.ws + WS_GU) : (bf16_t*)(p.ws + WS_H);
    const float* MOD = (const float*)(p.ws + WS_MOD);
    const int co = lane * 4;
    u32x2 yq[4]; f32x4 xq[4];
#pragma unroll
    for (int i = 0; i < 4; ++i) { yq[i] = (u32x2){0u, 0u}; xq[i] = (f32x4){0.f, 0.f, 0.f, 0.f}; }
    if (mode != 0 && gwave < nrows && gwave < MLAT) {
#pragma unroll
        for (int i = 0; i < 4; ++i) { yq[i] = *(const u32x2*)((const bf16_t*)Y0 + (size_t)gwave * D + co + 256 * i); xq[i] = *(const f32x4*)(X + (size_t)gwave * D + co + 256 * i); }
    }
    for (int row = gwave; row < nrows; row += nwaves) {
        const int v = row < MLAT ? (row >> 12) : 4;
        f32x4 x[4], y[4];
        f32x4 pg[4], pm[4], qg[4], qa[4], qs[4];
        if (mode == 0) {
            const float* src = row < MLAT ? pin(0) + (size_t)row * D : pin(2) + (size_t)(row - MLAT) * D;
#pragma unroll
            for (int i = 0; i < 4; ++i) x[i] = *(const f32x4*)(src + co + 256 * i);
        {
            const float* gp = pin(6) + ((size_t)l * 6 + gpost_i) * D; const float* gt = MOD + ((size_t)(l * 5 + v) * 9 + kgate) * D;
            const float* gq = pin(6) + ((size_t)ln * 6 + gpre_i) * D; const float* sh = MOD + ((size_t)(ln * 5 + v) * 9 + kshift) * D; const float* sc = sh + D;
#pragma unroll
            for (int i = 0; i < 4; ++i) { pg[i] = *(const f32x4*)(gp + co + 256 * i); pm[i] = *(const f32x4*)(gt + co + 256 * i);
                qg[i] = *(const f32x4*)(gq + co + 256 * i); qa[i] = *(const f32x4*)(sh + co + 256 * i); qs[i] = *(const f32x4*)(sc + co + 256 * i); }
        }
        } else {
            if (row >= MLAT) {
                const float* Y = YC + (size_t)(row - MLAT) * D;
#pragma unroll
                for (int ih = 0; ih < 2; ++ih) {
                    f32x4 t[11][2];
#pragma unroll
                    for (int z = 0; z < 11; ++z)
#pragma unroll
                        for (int i2 = 0; i2 < 2; ++i2) t[z][i2] = z < nzc ? *(const f32x4*)(Y + (size_t)z * 1024 * D + co + 256 * (ih * 2 + i2)) : (f32x4){0.f, 0.f, 0.f, 0.f};
#pragma unroll
                    for (int i2 = 0; i2 < 2; ++i2) { f32x4 a = t[0][i2];
#pragma unroll
                        for (int z = 1; z < 11; ++z) a = a + t[z][i2];
                        y[ih * 2 + i2] = a; }
                }
#pragma unroll
                for (int i = 0; i < 4; ++i) x[i] = *(const f32x4*)(X + (size_t)row * D + co + 256 * i);
            } else {
#pragma unroll
                for (int i = 0; i < 4; ++i) { const u32x2 r2 = yq[i]; x[i] = xq[i];
                    y[i] = (f32x4){__uint_as_float(r2[0] << 16), __uint_as_float(r2[0] & 0xffff0000u), __uint_as_float(r2[1] << 16), __uint_as_float(r2[1] & 0xffff0000u)}; }
            }
        {
            const float* gp = pin(6) + ((size_t)l * 6 + gpost_i) * D; const float* gt = MOD + ((size_t)(l * 5 + v) * 9 + kgate) * D;
            const float* gq = pin(6) + ((size_t)ln * 6 + gpre_i) * D; const float* sh = MOD + ((size_t)(ln * 5 + v) * 9 + kshift) * D; const float* sc = sh + D;
#pragma unroll
            for (int i = 0; i < 4; ++i) { pg[i] = *(const f32x4*)(gp + co + 256 * i); pm[i] = *(const f32x4*)(gt + co + 256 * i);
                qg[i] = *(const f32x4*)(gq + co + 256 * i); qa[i] = *(const f32x4*)(sh + co + 256 * i); qs[i] = *(const f32x4*)(sc + co + 256 * i); }
        }
            const int nxt = row + nwaves;
            if (nxt < nrows && nxt < MLAT) {
#pragma unroll
                for (int i = 0; i < 4; ++i) { yq[i] = *(const u32x2*)((const bf16_t*)Y0 + (size_t)nxt * D + co + 256 * i); xq[i] = *(const f32x4*)(X + (size_t)nxt * D + co + 256 * i); }
            }
            float ss = 0.f;
#pragma unroll
            for (int i = 0; i < 4; ++i) ss += y[i][0] * y[i][0] + y[i][1] * y[i][1] + y[i][2] * y[i][2] + y[i][3] * y[i][3];
            ss = wsum(ss); const float rs = rsqrtf(ss * (1.f / D) + EPS) * coef;
#pragma unroll
            for (int i = 0; i < 4; ++i) x[i] = x[i] + pm[i] * (y[i] * rs * pg[i]);
        }
        if (mode == 2) {
#pragma unroll
            for (int i = 0; i < 4; ++i) *(f32x4*)((float*)pin(25) + (size_t)row * D + co + 256 * i) = x[i];
            continue;
        }
#pragma unroll
        for (int i = 0; i < 4; ++i) *(f32x4*)(Xw + (size_t)row * D + co + 256 * i) = x[i];
        float ss = 0.f;
#pragma unroll
        for (int i = 0; i < 4; ++i) ss += x[i][0] * x[i][0] + x[i][1] * x[i][1] + x[i][2] * x[i][2] + x[i][3] * x[i][3];
        ss = wsum(ss); const float rs = rsqrtf(ss * (1.f / D) + EPS);
#pragma unroll
        for (int i = 0; i < 4; ++i) { const f32x4 h = x[i] * rs * qg[i] * (qs[i] + 1.f) + qa[i]; u32x2 w; w[0] = pk2(h[0], h[1]); w[1] = pk2(h[2], h[3]);
            *(u32x2*)(H + (size_t)row * D + co + 256 * i) = w; }
    }
}

DEVI void gdn_load(const bf16_t* P, const float* convw, int b, int c, int h, int dir, int want, bf16_t* sQ, bf16_t* sK, bf16_t* sKT, bf16_t* sVT, int tid) {
    const bool isctx = c < 4;
#pragma unroll
    for (int r = 0; r < 6; ++r) {
        const int task = tid + 512 * r, seg = r >> 1, rem = task & 1023, t = rem >> 4, cgp = rem & 15;
        if (seg == 0 && !(want & 1)) continue;
        if (seg == 1 && !(want & 6)) continue;
        if (seg == 2 && !(want & 8)) continue;
        int p = (isctx ? c : c - 4) * 64 + t; if (dir) p = (isctx ? 255 : 4095) - p;
        const int ch = seg * 512 + h * 128 + cgp * 8;
        float a[8];
#pragma unroll
        for (int e = 0; e < 8; ++e) a[e] = 0.f;
#pragma unroll
        for (int j = 0; j < 4; ++j) {
            const int row = pos_row(true, b, isctx, p + j - 2);
            if (row >= 0) {
                const u32x4 raw = *(const u32x4*)(P + (size_t)row * DINP + C_DNQ + ch); float x[8]; unpack8(raw, x);
                const f32x4 w0 = *(const f32x4*)(convw + j * 1536 + ch), w1 = *(const f32x4*)(convw + j * 1536 + ch + 4);
                a[0] += w0[0] * x[0]; a[1] += w0[1] * x[1]; a[2] += w0[2] * x[2]; a[3] += w0[3] * x[3];
                a[4] += w1[0] * x[4]; a[5] += w1[1] * x[5]; a[6] += w1[2] * x[6]; a[7] += w1[3] * x[7];
            }
        }
        float ss = 0.f;
#pragma unroll
        for (int e = 0; e < 8; ++e) { a[e] = silu(a[e]); ss += a[e] * a[e]; }
        if (seg < 2) {
            ss += __shfl_xor(ss, 1, 64); ss += __shfl_xor(ss, 2, 64); ss += __shfl_xor(ss, 4, 64); ss += __shfl_xor(ss, 8, 64);
            float inv = rsqrtf(ss + EPS); if (seg == 0) inv *= 0.08838834764831845f;
#pragma unroll
            for (int e = 0; e < 8; ++e) a[e] *= inv;
        }
        if (seg == 0) *(u32x4*)(sQ + t * 136 + cgp * 8) = pack8(a);
        else if (seg == 1) {
            if (want & 2) *(u32x4*)(sK + t * 136 + cgp * 8) = pack8(a);
            if (want & 4) {
#pragma unroll
                for (int e = 0; e < 8; ++e) sKT[tix(cgp * 8 + e, t)] = (bf16_t)f2bf(a[e]); }
        } else {
#pragma unroll
            for (int e = 0; e < 8; ++e) sVT[tix(cgp * 8 + e, t)] = (bf16_t)f2bf(a[e]);
        }
    }
}
DEVI void gdn_gates(const PW& p, const bf16_t* P, int l, int b, int c, int h, int dir, float* sc, int lane) {
    const int row = tok_row(true, dir, b, c, lane);
    const float bb = bf2f(P[(size_t)row * DINP + C_DNBA + dir * 4 + h]), aa = bf2f(P[(size_t)row * DINP + C_DNBA + 8 + dir * 4 + h]);
    const float beta = sigm(bb);
    const float g = -__expf(pin(20)[l * 8 + dir * 4 + h]) * softplus(aa + pin(21)[l * 8 + dir * 4 + h]);
    float G = g;
#pragma unroll
    for (int o = 1; o < 64; o <<= 1) { const float t = __shfl_up(G, o, 64); if (lane >= o) G += t; }
    const float GT = __shfl(G, 63, 64);
    sc[lane] = G; sc[64 + lane] = beta; sc[128 + lane] = __expf(G); sc[192 + lane] = __expf(GT - G); if (lane == 0) sc[256] = __expf(GT);
}

DEVI void gdn_prep_item(const PW& pw0, int l, int item, unsigned char* shm_in, int wv) {
    const PW p{opq64(pw0.ws)};
    unsigned char* shm = opq(shm_in);
    const int tid = MYTID, wid = __builtin_amdgcn_readfirstlane(tid >> 6), lane = tid & 63, fr = lane & 15, fq = lane >> 4;
    const int c = item % NCH, h = (item / NCH) & 3, b = (item / (NCH * 4)) & 3, dir = item / (NCH * 16);
    const bf16_t* P = (const bf16_t*)(p.ws + WS_P);
    bf16_t* sK = (bf16_t*)shm;
    bf16_t* sKT = (bf16_t*)(shm + 17408);
    bf16_t* sVT = (bf16_t*)(shm + 35840);
    float* sTm = (float*)(shm + 54272);
    bf16_t* sT1 = (bf16_t*)(shm + 71680);
    bf16_t* sT2 = (bf16_t*)(shm + 80896);
    bf16_t* sWT = (bf16_t*)(shm + 90112);
    bf16_t* sUT = (bf16_t*)(shm + 108544);
    float* sc = (float*)(shm + 126976);
    if (tid < 257) sc[tid] = ((const float*)(p.ws + WS_GATES))[(size_t)item * 320 + tid];
    gdn_load(P, pin(19) + (size_t)l * 4 * 1536, b, c, h, dir, 2 | 4 | 8, nullptr, sK, sKT, sVT, tid);
    lbar();
#pragma unroll
    for (int ti = 0; ti < 2; ++ti) {
        const int tile = wid * 2 + ti, mt = tile >> 2, nt = tile & 3;
        f32x4 acc = (f32x4){0.f, 0.f, 0.f, 0.f};
#pragma unroll
        for (int kk = 0; kk < 4; ++kk) acc = MFMA16(ldfrag(sK, 136, mt * 16, kk * 32, lane), ldfrag(sK, 136, nt * 16, kk * 32, lane), acc);
        const int s = nt * 16 + fr;
#pragma unroll
        for (int j = 0; j < 4; ++j) { const int t = mt * 16 + fq * 4 + j; sTm[t * 68 + s] = s < t ? sc[64 + t] * acc[j] * __expf(sc[t] - sc[s]) : 0.f; }
    }
    lbar();
    float* tmpY = (float*)sWT;
    if (wid < 4) {
        const int o = wid * 16, c = lane & 15;
        int lz; asm volatile("v_mov_b32 %0, 0" : "=v"(lz));
        const float* tm = sTm + lz;
        float x[16];
#pragma unroll
        for (int t = 0; t < 16; ++t) {
            float v = -sTm[(o + t) * 68 + o + c];
#pragma unroll
            for (int s4 = 0; s4 < (t + 3) / 4; ++s4) {
                const f32x4 a = *(const f32x4*)(tm + (o + t) * 68 + o + s4 * 4);
#pragma unroll
                for (int e = 0; e < 4; ++e) if (s4 * 4 + e < t) v -= a[e] * x[s4 * 4 + e];
            }
            x[t] = v;
        }
        asm volatile("s_waitcnt lgkmcnt(0)" ::: "memory");
        if (lane < 16) {
#pragma unroll
            for (int t = 0; t < 16; ++t) sTm[(o + t) * 68 + o + c] = x[t] + (t == c ? 1.f : 0.f);
        }
    }
    lbar();
    {
        const int blk = tid >> 8, r = (tid >> 4) & 15, c = tid & 15, ib = (blk ? 3 : 1) * 16, jb = ib - 16;
        float y = 0.f;
#pragma unroll
        for (int s2 = 0; s2 < 16; ++s2) y += sTm[(ib + r) * 68 + jb + s2] * sTm[(jb + s2) * 68 + jb + c];
        tmpY[blk * 272 + r * 17 + c] = y;
        lbar();
        float z = 0.f;
#pragma unroll
        for (int s2 = 0; s2 < 16; ++s2) z += sTm[(ib + r) * 68 + ib + s2] * tmpY[blk * 272 + s2 * 17 + c];
        lbar();
        sTm[(ib + r) * 68 + jb + c] = -z;
    }
    lbar();
    {
        float y[2];
#pragma unroll
        for (int u = 0; u < 2; ++u) { const int o = tid + 512 * u, r = o >> 5, c = o & 31; float a = 0.f;
#pragma unroll 8
            for (int s2 = 0; s2 < 32; ++s2) a += sTm[(32 + r) * 68 + s2] * sTm[s2 * 68 + c];
            y[u] = a; }
#pragma unroll
        for (int u = 0; u < 2; ++u) { const int o = tid + 512 * u, r = o >> 5, c = o & 31; tmpY[r * 33 + c] = y[u]; }
        lbar();
#pragma unroll
        for (int u = 0; u < 2; ++u) { const int o = tid + 512 * u, r = o >> 5, c = o & 31; float a = 0.f;
#pragma unroll 8
            for (int s2 = 0; s2 < 32; ++s2) a += sTm[(32 + r) * 68 + 32 + s2] * tmpY[s2 * 33 + c];
            y[u] = a; }
#pragma unroll
        for (int u = 0; u < 2; ++u) { const int o = tid + 512 * u, r = o >> 5, c = o & 31; sTm[(32 + r) * 68 + c] = -y[u]; }
    }
    lbar();
#pragma unroll
    for (int u = 0; u < 8; ++u) {
        const int o = tid + 512 * u, t = o >> 6, s2 = o & 63; const float xv = sTm[t * 68 + s2], bt = sc[64 + s2];
        sT1[t * 72 + s2] = (bf16_t)f2bf(xv * bt * sc[128 + s2]); sT2[t * 72 + s2] = (bf16_t)f2bf(xv * bt);
    }
    lbar();
    bf16_t* GW = (bf16_t*)(p.ws + WS_H) + (size_t)item * 64 * 128;
    bf16_t* GU = (bf16_t*)(p.ws + WS_GU) + (size_t)item * 64 * 128;
    {
        const int tid2 = opaque(tid), lane = tid2 & 63, fr = lane & 15, fq = lane >> 4;
        const int mt = wid;
#pragma unroll
        for (int nt = 0; nt < 4; ++nt) {
            f32x4 aw = (f32x4){0.f, 0.f, 0.f, 0.f}, au = aw;
#pragma unroll
            for (int kk = 0; kk < 2; ++kk) { aw = MFMA16(ldfragT(sKT, mt * 16, kk * 32, lane), ldfrag(sT1, 72, nt * 16, kk * 32, lane), aw);
                au = MFMA16(ldfragT(sVT, mt * 16, kk * 32, lane), ldfrag(sT2, 72, nt * 16, kk * 32, lane), au); }
            const int t = nt * 16 + fr, r0 = mt * 16 + fq * 4; const float dec = sc[192 + t];
            u32x2 w; w[0] = pk2(aw[0], aw[1]); w[1] = pk2(aw[2], aw[3]); *(u32x2*)(GW + t * 128 + r0) = w;
            w[0] = pk2(au[0], au[1]); w[1] = pk2(au[2], au[3]); *(u32x2*)(GU + t * 128 + r0) = w;
#pragma unroll
            for (int j = 0; j < 4; ++j) { sWT[tix(r0 + j, t)] = (bf16_t)f2bf(aw[j] * dec); sUT[tix(r0 + j, t)] = (bf16_t)f2bf(au[j] * dec); }
        }
    }
    lbar();
    bf16_t* GB = (bf16_t*)(p.ws + WS_GB) + (size_t)item * 128 * 128;
    bf16_t* GN = (bf16_t*)(p.ws + WS_GN) + (size_t)item * 128 * 128;
    {
        const int tid2 = opaque(tid), lane = tid2 & 63, fr = lane & 15, fq = lane >> 4;
        const int mt = wid;
#pragma unroll
        for (int nt = 0; nt < 8; ++nt) {
            f32x4 ab = (f32x4){0.f, 0.f, 0.f, 0.f}, an = ab;
#pragma unroll
            for (int kk = 0; kk < 2; ++kk) { ab = MFMA16(ldfragT(sWT, mt * 16, kk * 32, lane), ldfragT(sKT, nt * 16, kk * 32, lane), ab);
                an = MFMA16(ldfragT(sKT, mt * 16, kk * 32, lane), ldfragT(sUT, nt * 16, kk * 32, lane), an); }
            const int cc = nt * 16 + fr, r0 = mt * 16 + fq * 4;
            u32x2 w; w[0] = pk2(-ab[0], -ab[1]); w[1] = pk2(-ab[2], -ab[3]); *(u32x2*)(GB + cc * 128 + r0) = w;
            w[0] = pk2(an[0], an[1]); w[1] = pk2(an[2], an[3]); *(u32x2*)(GN + cc * 128 + r0) = w;
        }
    }
    if (tid == 0) ((float*)(p.ws + WS_SM + SM_GDEC))[item] = sc[256];
    lbar();
}

DEVI void gdn_seq_unit(const PW& pw0, int unit, unsigned char* shm_in, int wv) {
    const PW p{opq64(pw0.ws)};
    unsigned char* shm = opq(shm_in);
    const int tid = MYTID, wid = __builtin_amdgcn_readfirstlane(tid >> 6), lane = tid & 63, fr = lane & 15, fq = lane >> 4;
    const int chain = unit >> 3, es = unit & 7;
    bf16_t* sS = (bf16_t*)shm;
    const bf16_t* GB = (const bf16_t*)(p.ws + WS_GB) + (size_t)chain * NCH * 16384;
    bf16_t* GN = (bf16_t*)(p.ws + WS_GN) + (size_t)chain * NCH * 16384;
    const float* GDEC = (const float*)(p.ws + WS_SM + SM_GDEC) + chain * NCH;
    f32x4 acc = (f32x4){0.f, 0.f, 0.f, 0.f};
    constexpr int PF = 4;
    bf16x8 an[PF][4]; u32x2 nn[PF]; float dn[PF];
    const size_t aoff = (size_t)(wid * 16 + fr) * 128 + fq * 8, noff = (size_t)(es * 16 + fr) * 128 + wid * 16 + fq * 4;
#pragma unroll
    for (int u = 0; u < PF; ++u) {
#pragma unroll
        for (int kk = 0; kk < 4; ++kk) an[u][kk] = *(const bf16x8*)(GB + (size_t)u * 16384 + aoff + kk * 32);
        nn[u] = *(const u32x2*)(GN + (size_t)u * 16384 + noff); dn[u] = GDEC[u];
    }
#pragma unroll 1
    for (int c0 = 0; c0 < NCH; c0 += PF) {
#pragma unroll
        for (int u = 0; u < PF; ++u) {
            const int c = c0 + u;
            bf16x8 a[4]; const u32x2 ncur = nn[u]; const float dcur = dn[u];
#pragma unroll
            for (int kk = 0; kk < 4; ++kk) a[kk] = an[u][kk];
            u32x2 sw; sw[0] = pk2(acc[0], acc[1]); sw[1] = pk2(acc[2], acc[3]);
            bf16_t* sb = sS + (c & 1) * (16 * 136);
            *(u32x2*)(sb + fr * 136 + wid * 16 + fq * 4) = sw;
            *(u32x2*)(GN + (size_t)c * 16384 + noff) = sw;
            if (c + PF < NCH) {
#pragma unroll
                for (int kk = 0; kk < 4; ++kk) an[u][kk] = *(const bf16x8*)(GB + (size_t)(c + PF) * 16384 + aoff + kk * 32);
                nn[u] = *(const u32x2*)(GN + (size_t)(c + PF) * 16384 + noff); dn[u] = GDEC[c + PF];
            }
            lbar();
            acc[0] = dcur * acc[0] + __uint_as_float(ncur[0] << 16); acc[1] = dcur * acc[1] + __uint_as_float(ncur[0] & 0xffff0000u);
            acc[2] = dcur * acc[2] + __uint_as_float(ncur[1] << 16); acc[3] = dcur * acc[3] + __uint_as_float(ncur[1] & 0xffff0000u);
#pragma unroll
            for (int kk = 0; kk < 4; ++kk) acc = MFMA16(a[kk], ldfrag(sb, 136, 0, kk * 32, lane), acc);
        }
    }
    lbar();
}

DEVI void gdn_out_item(const PW& pw0, int l, int item, unsigned char* shm_in, int wv, int dry = 0) {
    const PW p{opq64(pw0.ws)};
    unsigned char* shm = opq(shm_in);
    const int tid = MYTID, wid = __builtin_amdgcn_readfirstlane(tid >> 6), lane = tid & 63, fr = lane & 15, fq = lane >> 4;
    const int j = item % NCH, h = (item / NCH) & 3, b = item / (NCH * 4);
    bf16_t* P = (bf16_t*)(p.ws + WS_P);
    bf16_t* sQ = (bf16_t*)shm;
    bf16_t* sK = (bf16_t*)(shm + 17408);
    bf16_t* sST = (bf16_t*)(shm + 34816);
    bf16_t* sW = (bf16_t*)(shm + 69632);
    bf16_t* sVN = (bf16_t*)(shm + 87040);
    bf16_t* sA2 = (bf16_t*)(shm + 105472);
    float* sO = (float*)(shm + 114688);
    float* sc = (float*)(shm + 148480);
#pragma unroll 1
    for (int dir = 0; dir < 2; ++dir) {
        const int c = dir_chunk(dir, j);
        const int it2 = ((dir * 4 + b) * 4 + h) * NCH + c;
        if (tid < 257) sc[tid] = ((const float*)(p.ws + WS_GATES))[(size_t)it2 * 320 + tid];
        gdn_load(P, pin(19) + (size_t)l * 4 * 1536, b, c, h, dir, 1 | 2, sQ, sK, nullptr, nullptr, tid);
        const bf16_t* GS = (const bf16_t*)(p.ws + WS_GN) + (size_t)it2 * 16384;
        const bf16_t* GW = (const bf16_t*)(p.ws + WS_H) + (size_t)it2 * 8192;
        const bf16_t* GU = (const bf16_t*)(p.ws + WS_GU) + (size_t)it2 * 8192;
#pragma unroll
        for (int r = 0; r < 4; ++r) { const int idx = tid + 512 * r, row = idx >> 4, cg8 = (idx & 15) * 8; *(u32x4*)(sST + row * 136 + cg8) = *(const u32x4*)(GS + row * 128 + cg8); }
#pragma unroll
        for (int r = 0; r < 2; ++r) { const int idx = tid + 512 * r, row = idx >> 4, cg8 = (idx & 15) * 8; *(u32x4*)(sW + row * 136 + cg8) = *(const u32x4*)(GW + row * 128 + cg8); }
        u32x2 ur4[4];
#pragma unroll
        for (int nt = 0; nt < 4; ++nt) ur4[nt] = *(const u32x2*)(GU + (nt * 16 + fr) * 128 + wid * 16 + fq * 4);
        lbar();
        {
            const int mt = wid;
#pragma unroll
            for (int nt = 0; nt < 4; ++nt) {
                const u32x2 ur = ur4[nt];
                f32x4 a = (f32x4){0.f, 0.f, 0.f, 0.f};
#pragma unroll
                for (int kk = 0; kk < 4; ++kk) a = MFMA16(ldfrag(sST, 136, mt * 16, kk * 32, lane), ldfrag(sW, 136, nt * 16, kk * 32, lane), a);
                const int t = nt * 16 + fr, e0 = mt * 16 + fq * 4;
                sVN[(e0 + 0) * 72 + t] = (bf16_t)f2bf(__uint_as_float(ur[0] << 16) - a[0]); sVN[(e0 + 1) * 72 + t] = (bf16_t)f2bf(__uint_as_float(ur[0] & 0xffff0000u) - a[1]);
                sVN[(e0 + 2) * 72 + t] = (bf16_t)f2bf(__uint_as_float(ur[1] << 16) - a[2]); sVN[(e0 + 3) * 72 + t] = (bf16_t)f2bf(__uint_as_float(ur[1] & 0xffff0000u) - a[3]);
            }
#pragma unroll
            for (int ti = 0; ti < 2; ++ti) {
                const int tile = wid * 2 + ti, m2 = tile >> 2, n2 = tile & 3;
                f32x4 a = (f32x4){0.f, 0.f, 0.f, 0.f};
#pragma unroll
                for (int kk = 0; kk < 4; ++kk) a = MFMA16(ldfrag(sQ, 136, m2 * 16, kk * 32, lane), ldfrag(sK, 136, n2 * 16, kk * 32, lane), a);
                const int s = n2 * 16 + fr;
#pragma unroll
                for (int jj = 0; jj < 4; ++jj) { const int t = m2 * 16 + fq * 4 + jj; sA2[t * 72 + s] = (bf16_t)f2bf(s <= t ? a[jj] * __expf(sc[t] - sc[s]) : 0.f); }
            }
        }
        lbar();
        {
            const int nt = wid;
#pragma unroll
            for (int mt = 0; mt < 4; ++mt) {
                f32x4 a = (f32x4){0.f, 0.f, 0.f, 0.f};
#pragma unroll
                for (int kk = 0; kk < 4; ++kk) a = MFMA16(ldfrag(sQ, 136, mt * 16, kk * 32, lane), ldfrag(sST, 136, nt * 16, kk * 32, lane), a);
#pragma unroll
                for (int jj = 0; jj < 4; ++jj) a[jj] *= sc[128 + mt * 16 + fq * 4 + jj];
#pragma unroll
                for (int kk = 0; kk < 2; ++kk) a = MFMA16(ldfrag(sA2, 72, mt * 16, kk * 32, lane), ldfrag(sVN, 72, nt * 16, kk * 32, lane), a);
                const int e = nt * 16 + fr;
#pragma unroll
                for (int jj = 0; jj < 4; ++jj) { const int t = mt * 16 + fq * 4 + jj; const int i = dir ? 63 - t : t; if (dir) sO[i * 132 + e] += a[jj]; else sO[i * 132 + e] = a[jj]; }
            }
        }
        lbar();
    }
    {
        const int i = tid >> 3, e0 = (tid & 7) * 16;
        float v[16], ss = 0.f;
#pragma unroll
        for (int e = 0; e < 16; ++e) { v[e] = sO[i * 132 + e0 + e]; ss += v[e] * v[e]; }
        ss += __shfl_xor(ss, 1, 64); ss += __shfl_xor(ss, 2, 64); ss += __shfl_xor(ss, 4, 64);
        const float rs = rsqrtf(ss * (1.f / 128.f) + EPS);
        const int row = tok_row(true, 0, b, j, i);
        bf16_t* zp = P + (size_t)row * DINP + C_DNZ + h * 128 + e0;
        const float* g = pin(22) + l * 128 + e0;
#pragma unroll
        for (int half = 0; half < 2; ++half) {
            float z[8]; unpack8(*(const u32x4*)(zp + half * 8), z); float o[8];
#pragma unroll
            for (int e = 0; e < 8; ++e) o[e] = v[half * 8 + e] * rs * g[half * 8 + e] * z[e];
            bf16_t* zd = dry ? (bf16_t*)(p.ws + WS_GB) + (size_t)row * 512 + h * 128 + e0 : zp;
            *(u32x4*)(zd + half * 8) = pack8(o);
        }
    }
    lbar();
}

DEVI float ml_gates(const PW& p, const bf16_t* P, int l, int b, int c, int h, int dir, float* sc, int lane) {
    const int row = tok_row(false, dir, b, c, lane);
    const float ig = bf2f(P[(size_t)row * DINP + C_MLG + dir * 4 + h]) + pin(10)[l * 16 + dir * 4 + h];
    const float fg = bf2f(P[(size_t)row * DINP + C_MLG + (2 + dir) * 4 + h]) + pin(10)[l * 16 + (2 + dir) * 4 + h];
    float bb = logsig(fg);
#pragma unroll
    for (int o = 1; o < 64; o <<= 1) { const float t = __shfl_up(bb, o, 64); if (lane >= o) bb += t; }
    sc[lane] = bb; sc[64 + lane] = ig;
    return __shfl(bb, 63, 64);
}
DEVI void ml_prep_item(const PW& pw0, int l, int item, unsigned char* shm_in, int wv) {
    const PW p{opq64(pw0.ws)};
    unsigned char* shm = opq(shm_in);
    const int tid = MYTID, wid = __builtin_amdgcn_readfirstlane(tid >> 6), lane = tid & 63, fr = lane & 15, fq = lane >> 4;
    const int c = item % NCH, h = (item / NCH) & 3, b = (item / (NCH * 4)) & 3, dir = item / (NCH * 16);
    const bf16_t* P = (const bf16_t*)(p.ws + WS_P);
    bf16_t* sKT = (bf16_t*)shm;
    bf16_t* sVT = (bf16_t*)(shm + 9216);
    float* sc = (float*)(shm + 27648);
    const float* gp = (const float*)(p.ws + WS_GATES) + (size_t)(2176 + item) * 320;
    if (tid < 64) sc[128 + tid] = gp[128 + tid];
    {
        const int t = tid >> 3, cg8 = (tid & 7) * 8; const int row = tok_row(false, dir, b, c, t);
        float x[8]; unpack8(*(const u32x4*)(P + (size_t)row * DINP + C_MLK + h * 64 + cg8), x);
#pragma unroll
        for (int e = 0; e < 8; ++e) sKT[tix(cg8 + e, t)] = (bf16_t)f2bf(x[e]);
    }
#pragma unroll
    for (int r = 0; r < 2; ++r) {
        const int idx = tid + 512 * r, t = idx >> 4, cg8 = (idx & 15) * 8; const int row = tok_row(false, dir, b, c, t);
        float x[8]; unpack8(*(const u32x4*)(P + (size_t)row * DINP + C_MLV + h * 128 + cg8), x); const float w = gp[128 + t];
#pragma unroll
        for (int e = 0; e < 8; ++e) sVT[tix(cg8 + e, t)] = (bf16_t)f2bf(x[e] * w);
    }
    lbar();
    float* KV = (float*)(p.ws + WS_Y) + (size_t)item * 8192;
    {
        const int nt = wid;
#pragma unroll
        for (int mt = 0; mt < 4; ++mt) {
            f32x4 a = (f32x4){0.f, 0.f, 0.f, 0.f};
#pragma unroll
            for (int kk = 0; kk < 2; ++kk) a = MFMA16(ldfragT(sKT, mt * 16, kk * 32, lane), ldfragT(sVT, nt * 16, kk * 32, lane), a);
            *(f32x4*)(KV + (nt * 16 + fr) * 64 + mt * 16 + fq * 4) = a;
        }
    }
    if (tid < 64) { float s = 0.f;
        for (int t = 0; t < 64; ++t) s += sc[128 + t] * bf2f(sKT[tix(tid, t)]);
        ((float*)(p.ws + WS_SM + SM_MN))[item * 64 + tid] = s; }
    lbar();
}
DEVI void ml_seq(const PW& pw0, int gtid, int nthreads) {
    const PW p{opq64(pw0.ws)};
    const float* MSC = (const float*)(p.ws + WS_SM + SM_MSC);
    float* MM = (float*)(p.ws + WS_SM + SM_MM);
    for (int g = gtid; g < 32 * 4096 + 32 * 32; g += nthreads) {
        const bool isn = g >= 32 * 4096; const int gg = isn ? g - 32 * 4096 : g;
        const int chain = isn ? gg >> 5 : gg >> 12, e2 = isn ? gg & 31 : gg & 4095;
        float* base = isn ? (float*)(p.ws + WS_SM + SM_MN) + (size_t)chain * NCH * 64 + e2 * 2 : (float*)(p.ws + WS_Y) + (size_t)chain * NCH * 8192 + e2 * 2;
        const int stride = isn ? 64 : 8192;
        float m = 0.f; f32x2 C = (f32x2){0.f, 0.f};
        for (int c0 = 0; c0 < NCH; c0 += 17) {
            f32x2 kv[17]; f32x2 sc[17];
#pragma unroll
            for (int u = 0; u < 17; ++u) { kv[u] = *(const f32x2*)(base + (size_t)(c0 + u) * stride); sc[u] = *(const f32x2*)(MSC + (chain * NCH + c0 + u) * 2); }
#pragma unroll
            for (int u = 0; u < 17; ++u) {
                *(f32x2*)(base + (size_t)(c0 + u) * stride) = C;
                if (!isn && e2 == 0) MM[chain * NCH + c0 + u] = m;
                const float mn = fmaxf(sc[u][0] + m, sc[u][1]);
                const float a = __expf(sc[u][0] + m - mn), s = __expf(sc[u][1] - mn);
                C = C * a + kv[u] * s; m = mn;
            }
        }
    }
}
DEVI void ml_out_item(const PW& pw0, int l, int item, unsigned char* shm_in, int wv, int dry = 0) {
    const PW p{opq64(pw0.ws)};
    unsigned char* shm = opq(shm_in);
    const int tid = MYTID, wid = __builtin_amdgcn_readfirstlane(tid >> 6), lane = tid & 63, fr = lane & 15, fq = lane >> 4;
    const int j = item % NCH, h = (item / NCH) & 3, b = item / (NCH * 4);
    bf16_t* P = (bf16_t*)(p.ws + WS_P);
    bf16_t* sQ = (bf16_t*)shm;
    bf16_t* sK = (bf16_t*)(shm + 9216);
    bf16_t* sVT = (bf16_t*)(shm + 18432);
    bf16_t* sCT = (bf16_t*)(shm + 36864);
    bf16_t* sS = (bf16_t*)(shm + 55296);
    float* sO = (float*)(shm + 64512);
    float* sc = (float*)(shm + 98304);
#pragma unroll 1
    for (int dir = 0; dir < 2; ++dir) {
        const int c = dir_chunk(dir, j);
        const int it2 = ((dir * 4 + b) * 4 + h) * NCH + c;
        if (wid == 0) {
            const float* gp = (const float*)(p.ws + WS_GATES) + (size_t)(2176 + it2) * 320;
            const float m = ((const float*)(p.ws + WS_SM + SM_MM))[it2];
            const float bb = gp[lane], pm = gp[192 + lane];
            sc[lane] = bb; sc[64 + lane] = gp[64 + lane];
            const float mt = bb + fmaxf(m, pm);
            sc[128 + lane] = mt; sc[192 + lane] = __expf(bb + m - mt);
            sc[320 + lane] = ((const float*)(p.ws + WS_SM + SM_MN))[it2 * 64 + lane];
        }
        {
            const int t = tid >> 3, cg8 = (tid & 7) * 8; const int row = tok_row(false, dir, b, c, t);
            float x[8]; unpack8(*(const u32x4*)(P + (size_t)row * DINP + C_MLQ + h * 64 + cg8), x);
#pragma unroll
            for (int e = 0; e < 8; ++e) x[e] *= 0.125f;
            *(u32x4*)(sQ + t * 72 + cg8) = pack8(x);
            *(u32x4*)(sK + t * 72 + cg8) = *(const u32x4*)(P + (size_t)row * DINP + C_MLK + h * 64 + cg8);
        }
#pragma unroll
        for (int r = 0; r < 2; ++r) {
            const int idx = tid + 512 * r, t = idx >> 4, cg8 = (idx & 15) * 8; const int row = tok_row(false, dir, b, c, t);
            float x[8]; unpack8(*(const u32x4*)(P + (size_t)row * DINP + C_MLV + h * 128 + cg8), x);
#pragma unroll
            for (int e = 0; e < 8; ++e) sVT[tix(cg8 + e, t)] = (bf16_t)f2bf(x[e]);
        }
        {
            const float* CT = (const float*)(p.ws + WS_Y) + (size_t)it2 * 8192;
#pragma unroll
            for (int r = 0; r < 4; ++r) { const int idx = tid + 512 * r, e = idx >> 4, d4 = (idx & 15) * 4; const f32x4 v = *(const f32x4*)(CT + e * 64 + d4);
                u32x2 w; w[0] = pk2(v[0], v[1]); w[1] = pk2(v[2], v[3]); *(u32x2*)(sCT + e * 72 + d4) = w; }
        }
        lbar();
#pragma unroll
        for (int ti = 0; ti < 2; ++ti) {
            const int tile = wid * 2 + ti, m2 = tile >> 2, n2 = tile & 3;
            f32x4 a = (f32x4){0.f, 0.f, 0.f, 0.f};
#pragma unroll
            for (int kk = 0; kk < 2; ++kk) a = MFMA16(ldfrag(sQ, 72, m2 * 16, kk * 32, lane), ldfrag(sK, 72, n2 * 16, kk * 32, lane), a);
            const int s = n2 * 16 + fr;
#pragma unroll
            for (int jj = 0; jj < 4; ++jj) { const int t = m2 * 16 + fq * 4 + jj;
                sS[t * 72 + s] = (bf16_t)f2bf(s <= t ? a[jj] * __expf(sc[t] - sc[s] + sc[64 + s] - sc[128 + t]) : 0.f); }
        }
        lbar();
        if (tid < 64) {
            float ds = 0.f, qn = 0.f;
            for (int s = 0; s < 64; ++s) { ds += bf2f(sS[tid * 72 + s]); qn += bf2f(sQ[tid * 72 + s]) * sc[320 + s]; }
            const float den = ds + sc[192 + tid] * qn;
            sc[256 + tid] = 1.f / fmaxf(fabsf(den), __expf(-sc[128 + tid]));
        }
        lbar();
        {
            const int nt = wid;
#pragma unroll
            for (int mt = 0; mt < 4; ++mt) {
                f32x4 a = (f32x4){0.f, 0.f, 0.f, 0.f};
#pragma unroll
                for (int kk = 0; kk < 2; ++kk) a = MFMA16(ldfrag(sQ, 72, mt * 16, kk * 32, lane), ldfrag(sCT, 72, nt * 16, kk * 32, lane), a);
#pragma unroll
                for (int jj = 0; jj < 4; ++jj) a[jj] *= sc[192 + mt * 16 + fq * 4 + jj];
#pragma unroll
                for (int kk = 0; kk < 2; ++kk) a = MFMA16(ldfrag(sS, 72, mt * 16, kk * 32, lane), ldfragT(sVT, nt * 16, kk * 32, lane), a);
                const int e = nt * 16 + fr;
#pragma unroll
                for (int jj = 0; jj < 4; ++jj) { const int t = mt * 16 + fq * 4 + jj; const int i = dir ? 63 - t : t; const float hv = a[jj] * sc[256 + t];
                    if (dir) sO[i * 132 + e] += hv; else sO[i * 132 + e] = hv; }
            }
        }
        lbar();
    }
    {
        const int i = tid >> 3, e0 = (tid & 7) * 16;
        float v[16], ss = 0.f;
#pragma unroll
        for (int e = 0; e < 16; ++e) { v[e] = sO[i * 132 + e0 + e]; ss += v[e] * v[e]; }
        ss += __shfl_xor(ss, 1, 64); ss += __shfl_xor(ss, 2, 64); ss += __shfl_xor(ss, 4, 64);
        const float rs = rsqrtf(ss * (1.f / 128.f) + EPS);
        const int row = tok_row(false, 0, b, j, i);
        bf16_t* op = P + (size_t)row * DINP + C_MLO + h * 128 + e0;
        const float* g = pin(11) + l * 512 + h * 128 + e0;
#pragma unroll
        for (int half = 0; half < 2; ++half) {
            float z[8]; unpack8(*(const u32x4*)(op + half * 8), z); float o[8];
#pragma unroll
            for (int e = 0; e < 8; ++e) o[e] = v[half * 8 + e] * rs * g[half * 8 + e] * z[e];
            bf16_t* od = dry ? (bf16_t*)(p.ws + WS_GB) + (size_t)row * 512 + h * 128 + e0 : op;
            *(u32x4*)(od + half * 8) = pack8(o);
        }
    }
    lbar();
}

DEVI void lru_item(const PW& pw0, int l, int item, int mode, unsigned char* shm_in, int wv, int dry = 0) {
    const PW p{opq64(pw0.ws)};
    unsigned char* shm = opq(shm_in);
    const int tid = MYTID, wid = __builtin_amdgcn_readfirstlane(tid >> 6), lane = tid & 63, fr = lane & 15, fq = lane >> 4;
    const int n4 = item & 3, j = (item >> 2) % NCH, b = (item >> 2) / NCH; const bool isctx = j < 4;
    bf16_t* P = (bf16_t*)(p.ws + WS_P);
    bf16_t* sX = (bf16_t*)shm;
    const int p0 = (isctx ? j : j - 4) * 64;
    const float* cw = pin(12) + (size_t)l * 4 * 512; const float* cb = pin(13) + (size_t)l * 512;
    {
        const int ch = lane * 8, i0 = wid * 8;
        f32x4 w[4][2];
#pragma unroll
        for (int jj = 0; jj < 4; ++jj) { w[jj][0] = *(const f32x4*)(cw + jj * 512 + ch); w[jj][1] = *(const f32x4*)(cw + jj * 512 + ch + 4); }
        const f32x4 b0 = *(const f32x4*)(cb + ch), b1 = *(const f32x4*)(cb + ch + 4);
        u32x4 raw[11];
#pragma unroll
        for (int r = 0; r < 11; ++r) { const int row = pos_row(false, b, isctx, p0 + i0 + r - 2);
            raw[r] = (u32x4){0u, 0u, 0u, 0u}; if (row >= 0) raw[r] = *(const u32x4*)(P + (size_t)row * DINP + C_LRX + ch); }
#pragma unroll
        for (int i = 0; i < 8; ++i) {
            float a[8] = {b0[0], b0[1], b0[2], b0[3], b1[0], b1[1], b1[2], b1[3]};
#pragma unroll
            for (int jj = 0; jj < 4; ++jj) { float x[8]; unpack8(raw[i + jj], x);
#pragma unroll
                for (int e = 0; e < 4; ++e) { a[e] += w[jj][0][e] * x[e]; a[4 + e] += w[jj][1][e] * x[4 + e]; } }
            *(u32x4*)(sX + (i0 + i) * 520 + ch) = pack8(a);
        }
    }
    lbar();
    const int blk = wid;
    const bf16_t* WL = (const bf16_t*)(p.ws + WS_WLRU);
    float* LAGG = (float*)(p.ws + WS_SM + SM_LAGG);
    {
        const int ch = blk * 64 + n4 * 16 + fr;
        float hsum[4][4];
#pragma unroll
        for (int mt = 0; mt < 4; ++mt)
#pragma unroll
            for (int jj = 0; jj < 4; ++jj) hsum[mt][jj] = 0.f;
#pragma unroll
        for (int dir = 0; dir < 2; ++dir) {
            const bf16_t* wa = WL + (size_t)(0 * 16 + dir * 8 + blk) * 4096 + (n4 * 16 + fr) * 64 + fq * 8;
            const bf16_t* wx = WL + (size_t)(1 * 16 + dir * 8 + blk) * 4096 + (n4 * 16 + fr) * 64 + fq * 8;
            bf16x8 ba[2], bx[2];
#pragma unroll
            for (int kk = 0; kk < 2; ++kk) { ba[kk] = *(const bf16x8*)(wa + kk * 32); bx[kk] = *(const bf16x8*)(wx + kk * 32); }
            const int c = dir_chunk(dir, j);
            const size_t aidx = (((size_t)dir * 4 + b) * NCH + c) * 512 + ch;
            const float hin0 = mode ? LAGG[aidx * 2] : 0.f;
            const float bias_a = pin(15)[(size_t)l * 1024 + dir * 512 + ch], bias_x = pin(17)[(size_t)l * 1024 + dir * 512 + ch];
            const float cl = -8.f * softplus(-pin(18)[(size_t)l * 1024 + dir * 512 + ch]);
            float av[4][4], bv[4][4];
#pragma unroll
            for (int mt = 0; mt < 4; ++mt) {
                f32x4 aa = (f32x4){0.f, 0.f, 0.f, 0.f}, ax = aa;
#pragma unroll
                for (int kk = 0; kk < 2; ++kk) { const bf16x8 af = ldfrag(sX, 520, mt * 16, blk * 64 + kk * 32, lane); aa = MFMA16(af, ba[kk], aa); ax = MFMA16(af, bx[kk], ax); }
#pragma unroll
                for (int jj = 0; jj < 4; ++jj) {
                    const int t = mt * 16 + fq * 4 + jj;
                    const float rr = sigm(aa[jj] + bias_a), ii = sigm(ax[jj] + bias_x), la = cl * rr;
                    const float ea = __expf(la);
                    av[mt][jj] = ea;
                    bv[mt][jj] = __builtin_amdgcn_sqrtf(fmaxf(1.f - ea * ea, 0.f)) * ii * bf2f(sX[t * 520 + ch]);
                }
            }
            float hin = hin0;
            float Pc = 1.f, Hc = 0.f;
#pragma unroll
            for (int mi = 0; mi < 4; ++mi) {
                const int mt = dir ? 3 - mi : mi;
                float Pl = 1.f, Hl = 0.f;
#pragma unroll
                for (int ji = 0; ji < 4; ++ji) { const int jj = dir ? 3 - ji : ji; Pl = av[mt][jj] * Pl; Hl = av[mt][jj] * Hl + bv[mt][jj]; }
                float Pq[4], Hq[4];
#pragma unroll
                for (int q = 0; q < 4; ++q) { Pq[q] = __shfl(Pl, fr + 16 * q, 64); Hq[q] = __shfl(Hl, fr + 16 * q, 64); }
                if (mode == 0) {
#pragma unroll
                    for (int qi = 0; qi < 4; ++qi) { const int q = dir ? 3 - qi : qi; Hc = Pq[q] * Hc + Hq[q]; Pc = Pq[q] * Pc; }
                } else {
                    float hh = hin;
                    float hme = hin;
#pragma unroll
                    for (int qi = 0; qi < 4; ++qi) { const int q = dir ? 3 - qi : qi; if (q == fq) hme = hh; hh = Pq[q] * hh + Hq[q]; }
                    hin = hh;
#pragma unroll
                    for (int ji = 0; ji < 4; ++ji) { const int jj = dir ? 3 - ji : ji; hme = av[mt][jj] * hme + bv[mt][jj]; hsum[mt][jj] += hme; }
                }
            }
            if (mode == 0 && fq == 0) { LAGG[aidx * 2] = Pc; LAGG[aidx * 2 + 1] = Hc; }
        }
        if (mode == 1) {
#pragma unroll
            for (int mt = 0; mt < 4; ++mt)
#pragma unroll
                for (int jj = 0; jj < 4; ++jj) { const int i = mt * 16 + fq * 4 + jj; const int row = pos_row(false, b, isctx, p0 + i);
                    hsum[mt][jj] *= bf2f(P[(size_t)row * DINP + C_LRY + ch]); }
#pragma unroll
            for (int mt = 0; mt < 4; ++mt)
#pragma unroll
                for (int jj = 0; jj < 4; ++jj) { const int i = mt * 16 + fq * 4 + jj; const int row = pos_row(false, b, isctx, p0 + i);
                    bf16_t* yp = P + (size_t)row * DINP + C_LRY + ch; bf16_t* yd = dry ? (bf16_t*)(p.ws + WS_GB) + (size_t)row * 512 + ch : yp; *yd = (bf16_t)f2bf(hsum[mt][jj]); }
        }
    }
    lbar();
}
DEVI void lru_seq(const PW& pw0, int gtid, int nthreads) {
    const PW p{opq64(pw0.ws)};
    float* LAGG = (float*)(p.ws + WS_SM + SM_LAGG);
    for (int g = gtid; g < 4096; g += nthreads) {
        const int ch = g & 511, db = g >> 9;
        float h = 0.f;
        for (int c0 = 0; c0 < NCH; c0 += 17) {
            f32x2 v[17];
#pragma unroll
            for (int u = 0; u < 17; ++u) v[u] = *(const f32x2*)(LAGG + (((size_t)db * NCH + c0 + u) * 512 + ch) * 2);
#pragma unroll
            for (int u = 0; u < 17; ++u) { LAGG[(((size_t)db * NCH + c0 + u) * 512 + ch) * 2] = h; h = v[u][0] * h + v[u][1]; }
        }
    }
}

DEVI void gate_phase(const PW& pw0, int l, int gwave, int nwaves, int lane) {
    const PW p{opq64(pw0.ws)};
    const bf16_t* P = (const bf16_t*)(p.ws + WS_P);
    float* GT = (float*)(p.ws + WS_GATES);
    for (int w = gwave; w < 4352; w += nwaves) {
        const int kind = w >= 2176 ? 1 : 0, item = kind ? w - 2176 : w;
        const int c = item % NCH, h = (item / NCH) & 3, b = (item / (NCH * 4)) & 3, dir = item / (NCH * 16);
        float* gp = GT + (size_t)(kind * 2176 + item) * 320;
        if (kind == 0) gdn_gates(p, P, l, b, c, h, dir, gp, lane);
        else {
            const int row = tok_row(false, dir, b, c, lane);
            const float ig = bf2f(P[(size_t)row * DINP + C_MLG + dir * 4 + h]) + pin(10)[l * 16 + dir * 4 + h];
            const float fg = bf2f(P[(size_t)row * DINP + C_MLG + (2 + dir) * 4 + h]) + pin(10)[l * 16 + (2 + dir) * 4 + h];
            float bb = logsig(fg);
#pragma unroll
            for (int o = 1; o < 64; o <<= 1) { const float t = __shfl_up(bb, o, 64); if (lane >= o) bb += t; }
            const float bT = __shfl(bb, 63, 64);
            const float lw = bT - bb + ig;
            const float Mc = wmax(lw);
            float pm = ig - bb;
#pragma unroll
            for (int o = 1; o < 64; o <<= 1) { const float t = __shfl_up(pm, o, 64); if (lane >= o) pm = fmaxf(pm, t); }
            gp[lane] = bb; gp[64 + lane] = ig; gp[128 + lane] = __expf(lw - Mc); gp[192 + lane] = pm;
            if (lane == 0) { float* msc = (float*)(p.ws + WS_SM + SM_MSC) + item * 2; msc[0] = bT; msc[1] = Mc; }
        }
    }
}

#define XB_TMO      128
#define XB_XCNT(j)  (256  + 64 * (j))
#define XB_XSUB(j)  (1280 + 64 * (j))
#define XB_XGEN(j)  (2304 + 64 * (j))
#define XB_TOP      3328
#define XB_TOPGEN   3392
#define XCD_BAR_WORDS 3456
#define XB_SPIN_CAP (1u << 22)
DEVI unsigned xb_ld(unsigned* p)              { return __hip_atomic_load(p, __ATOMIC_RELAXED, __HIP_MEMORY_SCOPE_AGENT); }
DEVI unsigned xb_add(unsigned* p, unsigned v) { return __hip_atomic_fetch_add(p, v, __ATOMIC_RELAXED, __HIP_MEMORY_SCOPE_AGENT); }
DEVI unsigned xb_xcc_id() { return (unsigned)__builtin_amdgcn_s_getreg((3 << 11) | 20) & 0xFu; }
#define XB_SPIN(cond, bar) do { unsigned _sp = 0; while (cond) { __builtin_amdgcn_s_sleep(1); \
    if ((++_sp & 255u) == 0u) { if (xb_ld(&(bar)[XB_TMO])) break; if (_sp > XB_SPIN_CAP) { atomicAdd(&(bar)[XB_TMO], 1u); break; } } } } while (0)
DEVI void xcd_barrier_complete(unsigned* bar, unsigned x, unsigned G, unsigned& nloc, unsigned& nx) {
    unsigned sum, cnt, mine, sp = 0u;
    for (;;) {
        sum = 0u; cnt = 0u; mine = 0u;
#pragma unroll
        for (unsigned j = 0; j < 16; ++j) { const unsigned c = xb_ld(&bar[XB_XCNT(j)]); sum += c; cnt += (c > 0u) ? 1u : 0u; mine = (j == x) ? c : mine; }
        if (sum == G) break;
        __builtin_amdgcn_s_sleep(1);
        if ((++sp & 255u) == 0u) { if (xb_ld(&bar[XB_TMO])) break; if (sp > XB_SPIN_CAP) { atomicAdd(&bar[XB_TMO], 1u); break; } }
    }
    nloc = mine > 0u ? mine : 1u; nx = cnt > 0u ? cnt : 1u;
}
DEVI void gsync(unsigned* bar, volatile LAS unsigned* st, int G, int wv) {
    asm volatile("s_waitcnt vmcnt(0)" ::: "memory");
    __syncthreads();
    const int ln = (int)__builtin_amdgcn_mbcnt_hi(~0u, __builtin_amdgcn_mbcnt_lo(~0u, 0u));
    if (wv == 0 && ln == 0) {
        __builtin_amdgcn_s_waitcnt(0);
        const unsigned x = xb_xcc_id();
        unsigned nloc = st[0], nx = st[1];
        if (nloc == 0u) { xcd_barrier_complete(bar, x, (unsigned)G, nloc, nx); st[0] = nloc; st[1] = nx; }
        const unsigned old = xb_add(&bar[XB_XSUB(x)], 1u);
        const unsigned gen = old / nloc;
        if (old + 1u == (gen + 1u) * nloc) {
            __builtin_amdgcn_fence(__ATOMIC_RELEASE, "agent");
            asm volatile("s_waitcnt vmcnt(0)" ::: "memory");
            const unsigned og = xb_add(&bar[XB_TOP], 1u);
            const unsigned tg = og / nx;
            if (og + 1u == (tg + 1u) * nx) xb_add(&bar[XB_TOPGEN], 1u);
            else XB_SPIN(xb_ld(&bar[XB_TOPGEN]) == tg, bar);
            __builtin_amdgcn_fence(__ATOMIC_ACQUIRE, "agent");
            xb_add(&bar[XB_XGEN(x)], 1u);
            asm volatile("s_waitcnt vmcnt(0)" ::: "memory");
        } else {
            XB_SPIN(xb_ld(&bar[XB_XGEN(x)]) == gen, bar);
            __builtin_amdgcn_fence(__ATOMIC_ACQUIRE, "agent");
            asm volatile("s_waitcnt vmcnt(0)" ::: "memory");
        }
    }
    __syncthreads();
}

__global__ void __launch_bounds__(512) mega(Params p) {
    extern __shared__ __attribute__((aligned(16))) unsigned char shm[];
    cg::grid_group grid = cg::this_grid();
    const int wv = __builtin_amdgcn_readfirstlane(threadIdx.x >> 6);
    const int G = gridDim.x, nwaves = G * 8, nthreads = G * 512;
#define TIDS const int tid = MYTID, wid = tid >> 6, lane = tid & 63, gwave = blockIdx.x * 8 + wid, gtid = blockIdx.x * 512 + tid; (void)gtid; (void)gwave; (void)lane;
    LAS unsigned char* lds = (LAS unsigned char*)shm;
#define WSQ unsigned char* ws = opq64(pw.ws); bf16_t* Hb = (bf16_t*)(ws + WS_H); bf16_t* Pb = (bf16_t*)(ws + WS_P); float* Yb = (float*)(ws + WS_Y); (void)Hb; (void)Pb; (void)Yb;

    const PW pw{p.ws};
    unsigned* bar = (unsigned*)p.ws;
    volatile LAS unsigned* xst = (volatile LAS unsigned*)((LAS unsigned char*)shm + (LDS_BYTES - 16));
    if (threadIdx.x == 0) { xst[0] = 0u; xst[1] = 0u; (void)xb_add(&bar[XB_XCNT(xb_xcc_id())], 1u); }
    __syncthreads();
    for (int rep = 0; rep < REP_CVT; ++rep) {
    mod_phase(pw, shm, wv);
    { TIDS convert_phase(pw, 0, shm, gwave, nwaves, wid, lane); }
    }
    grid.sync();
    { TIDS rowwise_phase(pw, 0, MTOT, 0, 0, 0.f, 0, 0, 0, 0, 0, gwave, nwaves, lane); }
    gsync(bar, xst, G, wv);

#pragma unroll 1
    for (int l = 0; l < DEPTH; ++l) {
        const bool last = l == DEPTH - 1;
#pragma unroll 1
        for (int f = 0; f < 2; ++f) {
            if (f == 1) {
                { WSQ pg8::Gemm g{Hb, (const bf16_t*)(ws + WS_WIN), 68, 31, D, D, 1, 0, 0, 0, 0, D, 0}; pg8::Order S; S.init(68, 31, 1, G, blockIdx.x);
                  pg8::EpiInProj E{Pb, DINP}; for (int rep = 0; rep < REP_GEMM; ++rep) pg8::gemm_phase(lds, g, S, E, wv); }
                gsync(bar, xst, G, wv);
                { TIDS gate_phase(pw, l, gwave, nwaves, lane); }
                gsync(bar, xst, G, wv);
#pragma unroll 1
                for (int rep2 = 0; rep2 < REP_PREPSEQ; ++rep2) {
#pragma unroll 1
                for (int rep = 0; rep < REP_PREP; ++rep)
                {
                    for (int it = blockIdx.x; it < 2176; it += G) for (int r3 = 0; r3 < REP_GDNP; ++r3) gdn_prep_item(pw, l, it, shm, wv);
                    for (int it = (blockIdx.x + G / 2) % G; it < 2176; it += G) for (int r3 = 0; r3 < REP_MLP; ++r3) ml_prep_item(pw, l, it, shm, wv);
                    for (int it = (blockIdx.x + G / 4) % G; it < 1088; it += G) for (int r3 = 0; r3 < REP_LRU0; ++r3) lru_item(pw, l, it, 0, shm, wv);
                }
                gsync(bar, xst, G, wv);
                for (int u = blockIdx.x; u < 256; u += G) gdn_seq_unit(pw, u, shm, wv);
                { TIDS ml_seq(pw, gtid, nthreads); }
                { TIDS lru_seq(pw, gtid, nthreads); }
                gsync(bar, xst, G, wv);
                }
                for (int it = blockIdx.x; it < 1088; it += G) { if (last && (it % NCH) < 4) continue; if (DRY_GO) gdn_out_item(pw, l, it, shm, wv, 1); gdn_out_item(pw, l, it, shm, wv); }
                for (int it = (blockIdx.x + G / 4) % G; it < 1088; it += G) { if (last && (it % NCH) < 4) continue; if (DRY_MO) ml_out_item(pw, l, it, shm, wv, 1); ml_out_item(pw, l, it, shm, wv); }
                for (int it = (blockIdx.x + G / 2) % G; it < 1088; it += G) { if (last && ((it >> 2) % NCH) < 4) continue; if (DRY_LO) lru_item(pw, l, it, 1, shm, wv, 1); lru_item(pw, l, it, 1, shm, wv); }
                gsync(bar, xst, G, wv);
                const int nM = last ? 64 : 68;
                { WSQ pg8::Gemm g{Pb, (const bf16_t*)(ws + WS_WBR), nM, 4, 512, DINP, 3, C_MLO, C_LRY, C_DNZ, D * 512, 512, 0}; pg8::Order S; S.init(nM, 4, 3, G, blockIdx.x);
                  pg8::EpiBranch E{Pb, (bf16_t*)Yb, Hb}; for (int rep = 0; rep < REP_BR; ++rep) pg8::gemm_phase(lds, g, S, E, wv); }
                gsync(bar, xst, G, wv);
                { WSQ pg8::Gemm g{Hb, (const bf16_t*)(ws + WS_WOUT), 64, 4, D, D, 1, 0, 0, 0, 0, D, 0}; pg8::Order S; S.init(64, 4, 1, G, blockIdx.x);
                  pg8::EpiBf16Y E{(bf16_t*)Yb, D}; for (int rep = 0; rep < REP_GEMM; ++rep) pg8::gemm_phase(lds, g, S, E, wv); }
                if (!last) { WSQ pg8::Gemm g{Hb, (const bf16_t*)(ws + WS_WOUT), 4, 4, 256, D, 4, 0, 0, 0, 256, D, 256}; pg8::Order S; S.init(4, 4, 4, G, blockIdx.x, 64, 1);
                  pg8::EpiF32 E{(float*)(ws + WS_GB), D, MLAT, (size_t)1024 * D}; pg8::gemm_phase(lds, g, S, E, wv); }
                gsync(bar, xst, G, wv);
                { TIDS if (DRY_ROW) { rowwise_phase(pw, 1, nM * 256, l, 5, 1.f, 3, l, 4, 6, 4, gwave, nwaves, lane, 1); } rowwise_phase(pw, 1, nM * 256, l, 5, 1.f, 3, l, 4, 6, 4, gwave, nwaves, lane); }
                gsync(bar, xst, G, wv);
            }
            const int nM = (last && f == 1) ? 64 : 68;
            { WSQ pg8::Gemm g{Hb, (const bf16_t*)(ws + WS_WGU + f * SZ_WGU), nM, 22, D, D, 1, 0, 0, 0, 0, D, 0}; pg8::Order S; S.init(nM, 22, 1, G, blockIdx.x);
              pg8::EpiSwiGLU E{Pb, DFF}; for (int rep = 0; rep < REP_GU; ++rep) pg8::gemm_phase(lds, g, S, E, wv); }
            gsync(bar, xst, G, wv);
            { WSQ pg8::Gemm g{Pb, (const bf16_t*)(ws + WS_WDN + f * SZ_WDN), 64, 4, DFF, DFF, 1, 0, 0, 0, 0, DFF, 0}; pg8::Order S; S.init(64, 4, 1, G, blockIdx.x);
              pg8::EpiBf16Y E{(bf16_t*)Yb, D}; for (int rep = 0; rep < REP_DN; ++rep) pg8::gemm_phase(lds, g, S, E, wv); }
            if (nM == 68) { WSQ pg8::Gemm g{Pb, (const bf16_t*)(ws + WS_WDN + f * SZ_WDN), 4, 4, 256, DFF, 11, 0, 0, 0, 256, DFF, 256}; pg8::Order S; S.init(4, 4, 11, G, blockIdx.x, 64, 1);
              pg8::EpiF32 E{(float*)(ws + WS_GB), D, MLAT, (size_t)1024 * D}; for (int rep = 0; rep < REP_DNC; ++rep) pg8::gemm_phase(lds, g, S, E, wv); }
            gsync(bar, xst, G, wv);
            if (f == 0) { TIDS if (DRY_ROW) { rowwise_phase(pw, 1, nM * 256, l, 2, 0.5f, 1, l, 2, 3, 11, gwave, nwaves, lane, 1); } rowwise_phase(pw, 1, nM * 256, l, 2, 0.5f, 1, l, 2, 3, 11, gwave, nwaves, lane); }
            else if (!last) { { TIDS if (DRY_ROW) { rowwise_phase(pw, 1, nM * 256, l, 8, 0.5f, 5, l + 1, 0, 0, 11, gwave, nwaves, lane, 1); } rowwise_phase(pw, 1, nM * 256, l, 8, 0.5f, 5, l + 1, 0, 0, 11, gwave, nwaves, lane); } for (int rep = 0; rep < REP_CVT; ++rep) { TIDS convert_phase(pw, l + 1, shm, gwave, nwaves, wid, lane); } }
            else { TIDS rowwise_phase(pw, 2, MLAT, l, 8, 0.5f, 5, 0, 0, 0, 0, gwave, nwaves, lane); }
            gsync(bar, xst, G, wv);
        }
    }
}

extern "C" void kernel_launch(void* const* d_in, const int* in_sizes, int n_in, void* d_out, int out_size, void* d_ws, size_t ws_size, hipStream_t stream) {
    static int grid = 0;
    if (grid == 0) {
        if (n_in != 25 || ws_size < WS_END) { fprintf(stderr, "kernel_launch: unexpected n_in %d or ws_size %zu (need %zu)\n", n_in, ws_size, (size_t)WS_END); grid = -1; return; }
        int dev = 0, cus = 0, per_cu = 0;
        hipGetDevice(&dev); hipDeviceGetAttribute(&cus, hipDeviceAttributeMultiprocessorCount, dev);
        if (hipFuncSetAttribute((const void*)mega, hipFuncAttributeMaxDynamicSharedMemorySize, LDS_BYTES) != hipSuccess) { fprintf(stderr, "kernel_launch: hipFuncSetAttribute failed\n"); grid = -1; return; }
        if (hipOccupancyMaxActiveBlocksPerMultiprocessor(&per_cu, (const void*)mega, 512, LDS_BYTES) != hipSuccess || per_cu < 1) { fprintf(stderr, "kernel_launch: occupancy query failed (%d)\n", per_cu); per_cu = 1; }
        (void)hipGetLastError();
        grid = cus * per_cu;
    }
    if (grid < 0) return;
    if (hipMemsetAsync(d_ws, 0, 16384, stream) != hipSuccess) { fprintf(stderr, "kernel_launch: memset failed\n"); return; }
    Params p{};
    for (int i = 0; i < 25; ++i) p.in[i] = (const float*)d_in[i];
    p.out = (float*)d_out; p.ws = (unsigned char*)d_ws;
    void* args[] = {&p};
    hipError_t e = hipLaunchCooperativeKernel((const void*)mega, dim3(grid), dim3(512), args, LDS_BYTES, stream);
    if (e != hipSuccess) fprintf(stderr, "cooperative launch failed: %s (grid %d)\n", hipGetErrorString(e), grid);
}
```

```cpp
#include <hip/hip_runtime.h>
#include <hip/hip_cooperative_groups.h>
#include <cstdio>
namespace cg = cooperative_groups;

#define LAS __attribute__((address_space(3)))
#define DEVI __device__ __forceinline__
typedef unsigned short bf16_t;
typedef short bf16x8 __attribute__((ext_vector_type(8)));
typedef float f32x4 __attribute__((ext_vector_type(4)));
typedef float f32x2 __attribute__((ext_vector_type(2)));
typedef unsigned u32x4 __attribute__((ext_vector_type(4)));
typedef unsigned u32x2 __attribute__((ext_vector_type(2)));

constexpr int D = 1024, NBATCH = 4, SEQ = 4096, CTXL = 256, DEPTH = 4, DFF = 2816, DINP = 7936;
constexpr int MLAT = NBATCH * SEQ, MTOT = MLAT + NBATCH * CTXL;
constexpr int NCH = 68;
constexpr int C_MLQ = 0, C_MLK = 256, C_MLV = 512, C_MLO = 1024, C_MLG = 1536, C_LRX = 1552, C_LRY = 2064,
              C_DNQ = 2576, C_DNZ = 4112, C_DNBA = 4624, C_GATE = 4640, C_END = 7712;
constexpr float EPS = 1e-6f;

constexpr size_t SZ_WGU = (size_t)2 * DFF * D * 2, SZ_WDN = (size_t)D * DFF * 2;
constexpr size_t WS_MOD = 16384;
constexpr size_t WS_WGU = 1u << 20;
constexpr size_t WS_WDN = WS_WGU + 2 * SZ_WGU;
constexpr size_t WS_WIN = WS_WDN + 2 * SZ_WDN;
constexpr size_t WS_WBR = WS_WIN + (size_t)DINP * D * 2;
constexpr size_t WS_WOUT = WS_WBR + (size_t)3 * D * 512 * 2;
constexpr size_t WS_WLRU = WS_WOUT + (size_t)D * D * 2;
constexpr size_t WS_X = WS_WLRU + (size_t)32 * 64 * 64 * 2;
constexpr size_t WS_H = WS_X + (size_t)MTOT * D * 4;
constexpr size_t WS_Y = WS_H + (size_t)MTOT * D * 2;
constexpr size_t WS_P = WS_Y + (size_t)MTOT * D * 4;
constexpr size_t WS_GU = WS_P + (size_t)MTOT * DINP * 2;
constexpr size_t WS_GB = WS_GU + (size_t)2176 * 64 * 128 * 2;
constexpr size_t WS_GN = WS_GB + (size_t)2176 * 128 * 128 * 2;
constexpr size_t WS_SM = WS_GN + (size_t)2176 * 128 * 128 * 2;
constexpr size_t SM_GDEC = 0, SM_MN = 16384, SM_MSC = SM_MN + 2176 * 64 * 4, SM_MM = SM_MSC + 2176 * 8, SM_LAGG = SM_MM + 2176 * 4 + 1024;
constexpr size_t WS_YC = WS_SM + SM_LAGG + (size_t)2 * 4 * NCH * 512 * 2 * 4 + 4096;
constexpr size_t WS_GATES = WS_YC;
constexpr size_t WS_END = WS_GATES + (size_t)2 * 2176 * 320 * 4 + 4096;
constexpr int LDS_BYTES = 155648;
constexpr int REP_BR = 1, REP_GU = 1, REP_DN = 1, REP_DNC = 1, REP_GEMM = 1, DRY_ROW = 0, REP_PREP = 1, REP_PREPSEQ = 1, REP_CVT = 1, REP_GDNP = 1, REP_MLP = 1, REP_LRU0 = 1, DRY_GO = 0, DRY_MO = 0, DRY_LO = 0;

struct Params { const float* in[25]; float* out; unsigned char* ws; };
struct PW { unsigned char* ws; };

#define CAS __attribute__((address_space(4)))
DEVI const float* pin(int i) { const CAS char* k = (const CAS char*)__builtin_amdgcn_kernarg_segment_ptr(); return *(const float* const volatile CAS*)(k + 8 * i); }
DEVI int opaque(int v) { asm volatile("" : "+v"(v)); return v; }
DEVI unsigned char* opq(unsigned char* p) { unsigned v = (unsigned)(size_t)(LAS unsigned char*)p; asm volatile("" : "+s"(v)); return (unsigned char*)(LAS unsigned char*)(size_t)v; }
DEVI LAS unsigned char* opql(LAS unsigned char* p) { unsigned v = (unsigned)(size_t)p; asm volatile("" : "+s"(v)); return (LAS unsigned char*)(size_t)v; }
DEVI unsigned char* opq64(unsigned char* p) { unsigned long long v = (unsigned long long)p; asm volatile("" : "+s"(v)); return (unsigned char*)v; }
#define MYTID opaque(wv * 64 + (int)__builtin_amdgcn_mbcnt_hi(~0u, __builtin_amdgcn_mbcnt_lo(~0u, 0u)))
DEVI float bf2f(bf16_t v) { return __uint_as_float(((unsigned)v) << 16); }
DEVI unsigned f2bf(float f) { unsigned u = __float_as_uint(f); return (u + 0x7fffu + ((u >> 16) & 1u)) >> 16; }
DEVI unsigned pk2(float lo, float hi) { return f2bf(lo) | (f2bf(hi) << 16); }
DEVI float sigm(float x) { return __builtin_amdgcn_rcpf(1.f + __expf(-x)); }
DEVI float silu(float x) { return x * sigm(x); }
DEVI float softplus(float x) { return x > 20.f ? x : log1pf(__expf(x)); }
DEVI float logsig(float x) { return fminf(x, 0.f) - log1pf(__expf(-fabsf(x))); }
DEVI float gelu_t(float x) { float u = 0.7978845608f * (x + 0.044715f * x * x * x); float e = __expf(2.f * u); return x * (1.f - __builtin_amdgcn_rcpf(e + 1.f)); }
DEVI float wsum(float v) { for (int o = 32; o > 0; o >>= 1) v += __shfl_xor(v, o, 64); return v; }
DEVI float wmax(float v) { for (int o = 32; o > 0; o >>= 1) v = fmaxf(v, __shfl_xor(v, o, 64)); return v; }
DEVI void unpack8(u32x4 r, float* f) {
    f[0] = __uint_as_float(r[0] << 16); f[1] = __uint_as_float(r[0] & 0xffff0000u); f[2] = __uint_as_float(r[1] << 16); f[3] = __uint_as_float(r[1] & 0xffff0000u);
    f[4] = __uint_as_float(r[2] << 16); f[5] = __uint_as_float(r[2] & 0xffff0000u); f[6] = __uint_as_float(r[3] << 16); f[7] = __uint_as_float(r[3] & 0xffff0000u);
}
DEVI u32x4 pack8(const float* f) { u32x4 r; r[0] = pk2(f[0], f[1]); r[1] = pk2(f[2], f[3]); r[2] = pk2(f[4], f[5]); r[3] = pk2(f[6], f[7]); return r; }
DEVI bf16x8 ldfrag(const bf16_t* base, int ld, int row0, int k0, int lane) { return *(const bf16x8*)(base + (row0 + (lane & 15)) * ld + k0 + (lane >> 4) * 8); }
DEVI int tix(int row, int col) { return row * 72 + ((((col >> 3) + (row >> 3)) & 7) << 3) + (col & 7); }
DEVI bf16x8 ldfragT(const bf16_t* base, int row0, int k0, int lane) { const int r = row0 + (lane & 15), lg = (k0 >> 3) + (lane >> 4); return *(const bf16x8*)(base + r * 72 + (((lg + (r >> 3)) & 7) << 3)); }
DEVI void lbar() { asm volatile("s_waitcnt lgkmcnt(0)" ::: "memory"); __builtin_amdgcn_s_barrier(); asm volatile("" ::: "memory"); }
#define MFMA16(a, b, c) __builtin_amdgcn_mfma_f32_16x16x32_bf16(a, b, c, 0, 0, 0)

namespace pg8 {
constexpr int BM = 256, BK = 64, HALF = 128, HTB = HALF * BK * 2, NXCD = 8, WGM = 8;
DEVI int lds_byte(int r, int c) { const int st = (r >> 4) * 2 + (c >> 5), rr = r & 15, cc = c & 31, ob = rr * 64 + cc * 2; return st * 1024 + (ob ^ (((ob >> 9) & 1) << 5)); }
DEVI void stage_rc(int b, int& R, int& C) { const int st = b / 1024, sb = b % 1024, swz = sb ^ (((sb >> 9) & 1) << 5); R = (st >> 1) * 16 + swz / 64; C = (st & 1) * 32 + (swz % 64) / 2; }
DEVI int perm32(int rho) { const int n = rho >> 4, i = rho & 15; return 8 * (i >> 2) + 4 * n + (i & 3); }
struct Unit { int pm, pn, z; };
struct Gemm { const bf16_t* A; const bf16_t* Bt; int nM, nN, K, lda, nz, zA0, zA1, zA2, zB; int ldb, zAstep; };
struct Order {
    int nM, nN, nwg, G, c, nz, pm0, spread;
    DEVI void init(int nM_, int nN_, int nz_, int G_, int c_, int pm0_ = 0, int spread_ = 0) { nM = nM_; nN = nN_; nwg = nM * nN; G = G_; c = c_; nz = nz_; pm0 = pm0_; spread = spread_; }
    DEVI bool next(int i, Unit& u) const {
        int ti = i, z = 0; long L;
        if (spread) { L = (long)i * G + c; if (L >= (long)nwg * nz) return false; z = (int)(L / nwg); L -= (long)z * nwg; }
        else { if (nz == 3) { ti = i / 3; z = i - ti * 3; } L = (long)ti * G + c; if (L >= nwg) return false; }
        int wgid = (int)L; { const int q = nwg / NXCD, r = nwg % NXCD, xcd = wgid % NXCD, off = wgid / NXCD; wgid = (xcd < r ? xcd * (q + 1) : r * (q + 1) + (xcd - r) * q) + off; }
        const int nig = WGM * nN, gid = wgid / nig, fm = gid * WGM, gsz = (nM - fm) < WGM ? (nM - fm) : WGM;
        u.pm = pm0 + fm + ((wgid % nig) % gsz); u.pn = (wgid % nig) / gsz; u.z = z; return true;
    }
};

template <class Epi>
DEVI void gemm_phase(LAS unsigned char* lds_in, const Gemm g, const Order& S, const Epi& E, int wv) {
    LAS unsigned char* lds = opql(lds_in);
    const int tid = MYTID, wid = __builtin_amdgcn_readfirstlane(tid >> 6), lane = tid & 63, wr = wid >> 2, wc = wid & 3, fr = lane & 15, fq = lane >> 4;
    const int K = g.K, nt = K / BK, lda = g.lda, ldb = g.ldb;
    unsigned voffA[2], voffB[2];
#pragma unroll
    for (int i = 0; i < 2; ++i) { int R, C; stage_rc(tid * 16 + i * 8192, R, C); const int Rb = Epi::PERM ? ((R & ~31) + perm32(R & 31)) : R;
        voffA[i] = (unsigned)(R * lda + C) * 2u; voffB[i] = (unsigned)(Rb * ldb + C) * 2u; }
    const size_t kstep = (size_t)(BK * 2);
    const size_t hstepA = (size_t)HALF * lda * 2, hstepB = (size_t)HALF * ldb * 2;
    const unsigned ldsw = (unsigned)wid * 1024u;
    const int aoff = lds_byte(wr * 64 + fr, fq * 8), boff = lds_byte(wc * 32 + fr, fq * 8);
#define PG8_SA(b, h) (((b) * 2 + (h)) * HTB)
#define PG8_SB(b, h) ((4 + (b) * 2 + (h)) * HTB)
#define PG8_STAGE(bufoff, gbase, voff) do { _Pragma("unroll") for (int _i = 0; _i < 2; ++_i) \
        __builtin_amdgcn_global_load_lds((const unsigned*)((const char*)(gbase) + (voff)[_i]), (LAS unsigned*)(lds + (bufoff) + ldsw + _i * 8192), 16, 0, 0); } while (0)
#define PG8_LDA(dst, b, h) do { _Pragma("unroll") for (int m = 0; m < 4; ++m) _Pragma("unroll") for (int k = 0; k < 2; ++k) dst[m][k] = *(const LAS bf16x8*)(lds + PG8_SA(b, h) + aoff + m * 2048 + k * 1024); } while (0)
#define PG8_LDB(dst, b, h) do { _Pragma("unroll") for (int n = 0; n < 2; ++n) _Pragma("unroll") for (int k = 0; k < 2; ++k) dst[n][k] = *(const LAS bf16x8*)(lds + PG8_SB(b, h) + boff + n * 2048 + k * 1024); } while (0)
#define PG8_MMA(ai, bj, At, Bt) do { __builtin_amdgcn_s_setprio(1); _Pragma("unroll") for (int m = 0; m < 4; ++m) _Pragma("unroll") for (int n = 0; n < 2; ++n) _Pragma("unroll") for (int k = 0; k < 2; ++k) \
        acc[ai][bj][m][n] = __builtin_amdgcn_mfma_f32_16x16x32_bf16(Bt[n][k], At[m][k], acc[ai][bj][m][n], 0, 0, 0); __builtin_amdgcn_s_setprio(0); } while (0)
#define PG8_WAIT_V(n) asm volatile("s_waitcnt vmcnt(" #n ")" ::: "memory")
#define PG8_WAIT_L(n) asm volatile("s_waitcnt lgkmcnt(" #n ")" ::: "memory")
#define PG8_BAR __builtin_amdgcn_s_barrier()
#define PG8_SCHED __builtin_amdgcn_sched_barrier(0)
#define PG8_PA(u) ((const char*)g.A + ((size_t)(g.nz == 3 ? ((u).z == 0 ? g.zA0 : ((u).z == 1 ? g.zA1 : g.zA2)) : (u).z * g.zAstep) + (size_t)(u).pm * BM * lda) * 2)
#define PG8_PB(u) ((const char*)g.Bt + ((size_t)(u).z * g.zB + (size_t)(u).pn * BM * ldb) * 2)
    Unit cur, nxt; int ui = 0;
    if (!S.next(0, cur)) return;
    f32x4 acc[2][2][4][2];
#pragma unroll
    for (int a = 0; a < 2; ++a)
#pragma unroll
        for (int b = 0; b < 2; ++b)
#pragma unroll
            for (int m = 0; m < 4; ++m)
#pragma unroll
                for (int n = 0; n < 2; ++n) acc[a][b][m][n] = (f32x4){0.f, 0.f, 0.f, 0.f};
    bf16x8 At[4][2], B0[2][2], B1[2][2];
    const char* cA = PG8_PA(cur); const char* cB = PG8_PB(cur);
    PG8_STAGE(PG8_SB(0, 0), cB, voffB); PG8_STAGE(PG8_SA(0, 0), cA, voffA); PG8_STAGE(PG8_SB(0, 1), cB + hstepB, voffB); PG8_STAGE(PG8_SA(0, 1), cA + hstepA, voffA);
    if (wr == 1) PG8_BAR;
    PG8_WAIT_V(4); PG8_BAR;
    PG8_STAGE(PG8_SB(1, 0), cB + kstep, voffB); PG8_STAGE(PG8_SA(1, 0), cA + kstep, voffA); PG8_STAGE(PG8_SB(1, 1), cB + hstepB + kstep, voffB);
    PG8_WAIT_V(6); PG8_BAR;
    for (;;) {
        const bool has_next = S.next(ui + 1, nxt);
        const char* nA = has_next ? PG8_PA(nxt) : cA; const char* nB = has_next ? PG8_PB(nxt) : cB;
        for (int t = 0; t < nt; t += 2) {
            const bool last = (t == nt - 2);
            const char* a1 = cA + (size_t)(t + 1) * kstep;
            const char* a2 = last ? nA : cA + (size_t)(t + 2) * kstep; const char* b2 = last ? nB : cB + (size_t)(t + 2) * kstep;
            const char* a3 = a2 + kstep; const char* b3 = b2 + kstep;
            PG8_LDB(B0, 0, 0); PG8_SCHED; PG8_LDA(At, 0, 0); PG8_STAGE(PG8_SA(1, 1), a1 + hstepA, voffA);
            PG8_WAIT_L(8); PG8_BAR; PG8_WAIT_L(0); PG8_MMA(0, 0, At, B0); PG8_BAR; PG8_SCHED;
            PG8_LDB(B1, 0, 1); PG8_STAGE(PG8_SB(0, 0), b2, voffB);
            PG8_BAR; PG8_WAIT_L(0); PG8_MMA(0, 1, At, B1); PG8_BAR;
            PG8_LDA(At, 0, 1); PG8_STAGE(PG8_SA(0, 0), a2, voffA);
            PG8_BAR; PG8_WAIT_L(0); PG8_MMA(1, 0, At, B0); PG8_BAR; PG8_SCHED;
            PG8_STAGE(PG8_SB(0, 1), b2 + hstepB, voffB);
            PG8_WAIT_V(6); PG8_BAR; PG8_MMA(1, 1, At, B1); PG8_BAR;
            PG8_LDB(B0, 1, 0); PG8_SCHED; PG8_LDA(At, 1, 0); PG8_STAGE(PG8_SA(0, 1), a2 + hstepA, voffA);
            PG8_WAIT_L(8); PG8_BAR; PG8_WAIT_L(0); PG8_MMA(0, 0, At, B0); PG8_BAR; PG8_SCHED;
            PG8_LDB(B1, 1, 1); PG8_STAGE(PG8_SB(1, 0), b3, voffB);
            PG8_BAR; PG8_WAIT_L(0); PG8_MMA(0, 1, At, B1); PG8_BAR;
            PG8_LDA(At, 1, 1); PG8_STAGE(PG8_SA(1, 0), a3, voffA);
            PG8_BAR; PG8_WAIT_L(0); PG8_MMA(1, 0, At, B0); PG8_BAR; PG8_SCHED;
            PG8_STAGE(PG8_SB(1, 1), b3 + hstepB, voffB);
            PG8_WAIT_V(6); PG8_BAR; PG8_MMA(1, 1, At, B1); PG8_BAR;
        }
        E(acc, cur, wr, wc, fr, fq);
        if (!has_next) break;
#pragma unroll
        for (int a = 0; a < 2; ++a)
#pragma unroll
            for (int b = 0; b < 2; ++b)
#pragma unroll
                for (int m = 0; m < 4; ++m)
#pragma unroll
                    for (int n = 0; n < 2; ++n) acc[a][b][m][n] = (f32x4){0.f, 0.f, 0.f, 0.f};
        cur = nxt; cA = nA; cB = nB; ++ui;
    }
    PG8_WAIT_V(0);
    if (wr == 0) PG8_BAR;
    PG8_BAR;
#undef PG8_SA
#undef PG8_SB
#undef PG8_STAGE
#undef PG8_LDA
#undef PG8_LDB
#undef PG8_MMA
#undef PG8_WAIT_V
#undef PG8_WAIT_L
#undef PG8_BAR
#undef PG8_SCHED
#undef PG8_PA
#undef PG8_PB
}

struct EpiF32 {
    static constexpr bool PERM = false;
    float* C; int ldc; int row_base; size_t zstride;
    DEVI void operator()(const f32x4 (&acc)[2][2][4][2], const Unit& u, int wr, int wc, int fr, int fq) const {
        const int row0 = u.pm * BM + wr * 64 + fr - row_base, col0 = u.pn * BM + wc * 32 + 4 * fq;
#pragma unroll
        for (int ai = 0; ai < 2; ++ai)
#pragma unroll
            for (int m = 0; m < 4; ++m) { float* rowp = C + (size_t)u.z * zstride + (size_t)(row0 + ai * HALF + m * 16) * ldc + col0;
#pragma unroll
                for (int bj = 0; bj < 2; ++bj)
#pragma unroll
                    for (int n = 0; n < 2; ++n) *(f32x4*)(rowp + bj * HALF + n * 16) = acc[ai][bj][m][n]; }
    }
};
struct EpiBf16Y {
    static constexpr bool PERM = true;
    bf16_t* O; int ldc;
    DEVI void operator()(const f32x4 (&acc)[2][2][4][2], const Unit& u, int wr, int wc, int fr, int fq) const {
        const int row0 = u.pm * BM + wr * 64 + fr;
#pragma unroll
        for (int bj = 0; bj < 2; ++bj) { const int c0 = u.pn * BM + bj * HALF + wc * 32 + 8 * fq;
#pragma unroll
            for (int ai = 0; ai < 2; ++ai)
#pragma unroll
                for (int m = 0; m < 4; ++m) { float v[8];
#pragma unroll
                    for (int n = 0; n < 2; ++n)
#pragma unroll
                        for (int i = 0; i < 4; ++i) v[n * 4 + i] = acc[ai][bj][m][n][i];
                    *(u32x4*)(O + (size_t)(row0 + ai * HALF + m * 16) * ldc + c0) = pack8(v); } }
    }
};
struct EpiAtomic {
    static constexpr bool PERM = false;
    float* C; int ldc; int row_base;
    DEVI void operator()(const f32x4 (&acc)[2][2][4][2], const Unit& u, int wr, int wc, int fr, int fq) const {
        const int row0 = u.pm * BM + wr * 64 + fr - row_base, col0 = u.pn * BM + wc * 32 + 4 * fq;
#pragma unroll
        for (int ai = 0; ai < 2; ++ai)
#pragma unroll
            for (int m = 0; m < 4; ++m) { float* rowp = C + (size_t)(row0 + ai * HALF + m * 16) * ldc + col0;
#pragma unroll
                for (int bj = 0; bj < 2; ++bj)
#pragma unroll
                    for (int n = 0; n < 2; ++n)
#pragma unroll
                        for (int e = 0; e < 4; ++e) __hip_atomic_fetch_add(rowp + bj * HALF + n * 16 + e, acc[ai][bj][m][n][e], __ATOMIC_RELAXED, __HIP_MEMORY_SCOPE_AGENT); }
    }
};
struct EpiSwiGLU {
    static constexpr bool PERM = false;
    bf16_t* O; int ldc;
    DEVI void operator()(const f32x4 (&acc)[2][2][4][2], const Unit& u, int wr, int wc, int fr, int fq) const {
        const int row0 = u.pm * BM + wr * 64 + fr, col0 = u.pn * 128 + wc * 32 + 8 * fq;
#pragma unroll
        for (int ai = 0; ai < 2; ++ai)
#pragma unroll
            for (int m = 0; m < 4; ++m) {
                float v[8];
#pragma unroll
                for (int bj = 0; bj < 2; ++bj)
#pragma unroll
                    for (int i = 0; i < 4; ++i) { const float gt = acc[ai][bj][m][0][i], up = acc[ai][bj][m][1][i]; v[bj * 4 + i] = silu(gt) * up; }
                *(u32x4*)(O + (size_t)(row0 + ai * HALF + m * 16) * ldc + col0) = pack8(v);
            }
    }
};
struct EpiInProj {
    static constexpr bool PERM = true;
    bf16_t* O; int ldc;
    DEVI void operator()(const f32x4 (&acc)[2][2][4][2], const Unit& u, int wr, int wc, int fr, int fq) const {
        const int row0 = u.pm * BM + wr * 64 + fr;
#pragma unroll
        for (int bj = 0; bj < 2; ++bj) {
            const int c0 = u.pn * BM + bj * HALF + wc * 32 + 8 * fq;
            int kind = 0;
            if (c0 >= C_MLO && c0 < C_MLG) kind = 1; else if (c0 >= C_LRY && c0 < C_DNQ) kind = 2; else if (c0 >= C_DNZ && c0 < C_DNBA) kind = 3; else if (c0 >= C_GATE) kind = 1;
#define INPROJ_STORE(FN) _Pragma("unroll") for (int ai = 0; ai < 2; ++ai) _Pragma("unroll") for (int m = 0; m < 4; ++m) { float v[8]; \
                _Pragma("unroll") for (int n = 0; n < 2; ++n) _Pragma("unroll") for (int i = 0; i < 4; ++i) { const float x = acc[ai][bj][m][n][i]; v[n * 4 + i] = FN; } \
                *(u32x4*)(O + (size_t)(row0 + ai * HALF + m * 16) * ldc + c0) = pack8(v); }
            if (kind == 0) { INPROJ_STORE(x) } else if (kind == 1) { INPROJ_STORE(sigm(x)) } else if (kind == 2) { INPROJ_STORE(gelu_t(x)) } else { INPROJ_STORE(silu(x)) }
#undef INPROJ_STORE
        }
    }
};
struct EpiBranch {
    static constexpr bool PERM = false;
    const bf16_t* P; bf16_t* T; bf16_t* U;
    DEVI void operator()(const f32x4 (&acc)[2][2][4][2], const Unit& u, int wr, int wc, int fr, int fq) const {
        const int row0 = u.pm * BM + wr * 64 + fr, col0 = u.pn * BM + wc * 32 + 4 * fq; const int z = u.z;
        bf16_t* dst = z < 2 ? T : U;
#pragma unroll
        for (int ai = 0; ai < 2; ++ai)
#pragma unroll
            for (int mh = 0; mh < 2; ++mh) {
                u32x2 gr[2][2][2], tv[2][2][2];
#pragma unroll
                for (int mm = 0; mm < 2; ++mm) { const size_t row = (size_t)(row0 + ai * HALF + (mh * 2 + mm) * 16);
#pragma unroll
                    for (int bj = 0; bj < 2; ++bj)
#pragma unroll
                        for (int n = 0; n < 2; ++n) { const int col = col0 + bj * HALF + n * 16;
                            gr[mm][bj][n] = *(const u32x2*)(P + row * DINP + C_GATE + z * D + col);
                            tv[mm][bj][n] = (u32x2){0u, 0u};
                            if (z > 0) tv[mm][bj][n] = *(const u32x2*)(T + row * D + col); } }
#pragma unroll
                for (int mm = 0; mm < 2; ++mm) { const size_t row = (size_t)(row0 + ai * HALF + (mh * 2 + mm) * 16);
#pragma unroll
                    for (int bj = 0; bj < 2; ++bj)
#pragma unroll
                        for (int n = 0; n < 2; ++n) { const int col = col0 + bj * HALF + n * 16;
                            const u32x2 g2 = gr[mm][bj][n], t2 = tv[mm][bj][n]; f32x4 a = acc[ai][bj][mh * 2 + mm][n];
                            a[0] = a[0] * __uint_as_float(g2[0] << 16) + __uint_as_float(t2[0] << 16); a[1] = a[1] * __uint_as_float(g2[0] & 0xffff0000u) + __uint_as_float(t2[0] & 0xffff0000u);
                            a[2] = a[2] * __uint_as_float(g2[1] << 16) + __uint_as_float(t2[1] << 16); a[3] = a[3] * __uint_as_float(g2[1] & 0xffff0000u) + __uint_as_float(t2[1] & 0xffff0000u);
                            u32x2 w; w[0] = pk2(a[0], a[1]); w[1] = pk2(a[2], a[3]); *(u32x2*)(dst + row * D + col) = w; } }
            }
    }
};
}

DEVI int tok_row(bool gdn, int dir, int b, int c, int t) {
    if (c < 4) { int p = c * 64 + t; if (dir) p = 255 - p; return MLAT + b * 256 + p; }
    int p = (c - 4) * 64 + t; if (dir) p = 4095 - p;
    const int s = gdn ? ((p & 63) * 64 + (p >> 6)) : p;
    return b * 4096 + s;
}
DEVI int pos_row(bool gdn, int b, bool isctx, int p) {
    if (isctx) { if (p < 0 || p >= 256) return -1; return MLAT + b * 256 + p; }
    if (p < 0 || p >= 4096) return -1;
    const int s = gdn ? ((p & 63) * 64 + (p >> 6)) : p;
    return b * 4096 + s;
}
DEVI int dir_chunk(int dir, int j) { return dir ? (j < 4 ? 3 - j : 71 - j) : j; }

DEVI int gu_rowmap(int s) {
    const int n = s >= DFF ? 1 : 0, a = s - n * DFF, pn = a >> 7, r = a & 127, wc = r >> 5, fq = (r >> 3) & 3, bj = (r >> 2) & 1, i = r & 3;
    return 256 * pn + 128 * bj + 32 * wc + 16 * n + 4 * fq + i;
}
DEVI void cvt_tile(const float* src, int ldsrc, int Nvalid, int k0, int n0, bf16_t* dst, int lddst, int mode, float* buf, int lane) {
    f32x4 vv[16];
#pragma unroll
    for (int it = 0; it < 16; ++it) {
        const int row = it * 4 + (lane >> 4), c4 = (lane & 15) * 4;
        vv[it] = (f32x4){0.f, 0.f, 0.f, 0.f};
        if (n0 + c4 < Nvalid) vv[it] = *(const f32x4*)(src + (size_t)(k0 + row) * ldsrc + n0 + c4);
    }
#pragma unroll
    for (int it = 0; it < 16; ++it) {
        const int row = it * 4 + (lane >> 4), c4 = (lane & 15) * 4;
        float* bp = buf + row * 65 + c4; bp[0] = vv[it][0]; bp[1] = vv[it][1]; bp[2] = vv[it][2]; bp[3] = vv[it][3];
    }
    asm volatile("s_waitcnt lgkmcnt(0)" ::: "memory"); __builtin_amdgcn_wave_barrier();
#pragma unroll 2
    for (int it = 0; it < 8; ++it) {
        const int nc = it * 8 + (lane >> 3), kk = (lane & 7) * 8;
        float f[8];
#pragma unroll
        for (int e = 0; e < 8; ++e) f[e] = buf[(kk + e) * 65 + nc];
        const int drow = mode == 1 ? gu_rowmap(n0 + nc) : (n0 + nc);
        *(u32x4*)(dst + (size_t)drow * lddst + k0 + kk) = pack8(f);
    }
    asm volatile("s_waitcnt lgkmcnt(0)" ::: "memory"); __builtin_amdgcn_wave_barrier();
}
DEVI void convert_phase(const PW& pw0, int l, unsigned char* shm_in, int gwave, int nwaves, int wid, int lane) {
    const PW p{opq64(pw0.ws)};
    unsigned char* shm = opq(shm_in);
    float* buf = (float*)shm + wid * (64 * 65);
    unsigned char* ws = p.ws;
    for (int t = gwave; t < 6880; t += nwaves) {
        int r = t;
        if (r < 2816) { const int f = r / 1408; r -= f * 1408; const int kt = r / 88, ntl = r % 88;
            cvt_tile(pin(7) + ((size_t)(l * 2 + f)) * D * 2 * DFF, 2 * DFF, 2 * DFF, kt * 64, ntl * 64, (bf16_t*)(ws + WS_WGU + f * SZ_WGU), D, 1, buf, lane); continue; }
        r -= 2816;
        if (r < 1408) { const int f = r / 704; r -= f * 704; const int kt = r / 16, ntl = r % 16;
            cvt_tile(pin(8) + ((size_t)(l * 2 + f)) * DFF * D, D, D, kt * 64, ntl * 64, (bf16_t*)(ws + WS_WDN + f * SZ_WDN), DFF, 0, buf, lane); continue; }
        r -= 1408;
        if (r < 1984) { const int kt = r / 124, ntl = r % 124;
            cvt_tile(pin(9) + (size_t)l * D * C_END, C_END, C_END, kt * 64, ntl * 64, (bf16_t*)(ws + WS_WIN), D, 0, buf, lane); continue; }
        r -= 1984;
        if (r < 384) { const int n = r / 128; r -= n * 128; const int kt = r / 16, ntl = r % 16;
            cvt_tile(pin(23) + ((size_t)(l * 3 + n)) * 512 * D, D, D, kt * 64, ntl * 64, (bf16_t*)(ws + WS_WBR) + (size_t)n * D * 512, 512, 0, buf, lane); continue; }
        r -= 384;
        if (r < 256) { const int kt = r / 16, ntl = r % 16;
            cvt_tile(pin(24) + (size_t)l * D * D, D, D, kt * 64, ntl * 64, (bf16_t*)(ws + WS_WOUT), D, 0, buf, lane); continue; }
        r -= 256;
        { const int gate = r >> 4, dn = r & 15;
            cvt_tile(pin(gate ? 16 : 14) + ((size_t)l * 16 + dn) * 4096, 64, 64, 0, 0, (bf16_t*)(ws + WS_WLRU) + (size_t)(gate * 16 + dn) * 4096, 64, 0, buf, lane); }
    }
}

DEVI void mod_phase(const PW& pw0, unsigned char* shm_in, int wv) {
    const PW p{opq64(pw0.ws)};
    unsigned char* shm = opq(shm_in);
    float* sC = (float*)shm;
    float* red = sC + 5 * 1024;
    const int tid = MYTID;
    __syncthreads();
    for (int i = tid; i < 5 * 1024; i += 512) { const int v = i >> 10, k = i & 1023; const float x = v < 4 ? pin(1)[v * 1024 + k] : pin(3)[k]; sC[i] = silu(x); }
    __syncthreads();
    float* MOD = (float*)(p.ws + WS_MOD);
    const int cgp = tid & 15, is = tid >> 4;
    for (int task = blockIdx.x; task < DEPTH * 144; task += gridDim.x) {
        const int l = task / 144, col0 = (task % 144) * 64;
        float acc[5][4];
#pragma unroll
        for (int v = 0; v < 5; ++v)
#pragma unroll
            for (int e = 0; e < 4; ++e) acc[v][e] = 0.f;
        const float* wp = pin(4) + ((size_t)l * 1024 + is * 32) * 9216 + col0 + cgp * 4;
#pragma unroll 16
        for (int r = 0; r < 32; ++r) {
            const f32x4 w = *(const f32x4*)(wp + (size_t)r * 9216);
#pragma unroll
            for (int v = 0; v < 5; ++v) { const float s = sC[v * 1024 + is * 32 + r];
#pragma unroll
                for (int e = 0; e < 4; ++e) acc[v][e] += s * w[e]; }
        }
#pragma unroll
        for (int v = 0; v < 5; ++v)
#pragma unroll
            for (int e = 0; e < 4; ++e) red[tid * 20 + v * 4 + e] = acc[v][e];
        __syncthreads();
        if (tid < 320) { const int v = tid >> 6, c = tid & 63; float s = 0.f;
            for (int k = 0; k < 32; ++k) s += red[(k * 16 + (c >> 2)) * 20 + v * 4 + (c & 3)];
            MOD[((size_t)(l * 5 + v)) * 9216 + col0 + c] = s + pin(5)[(size_t)l * 9216 + col0 + c]; }
        __syncthreads();
    }
}

DEVI void rowwise_phase(const PW& pw0, int mode, int nrows, int l, int kgate, float coef, int gpost_i, int ln, int gpre_i, int kshift, int nzc, int gwave, int nwaves, int lane, int dry = 0) {
    const PW p{opq64(pw0.ws)};
    float* X = (float*)(p.ws + WS_X); float* Xw = dry ? (float*)(p.ws + WS_GN) : X; const float* Y0 = (const float*)(p.ws + WS_Y); const float* YC = (const float*)(p.ws + WS_GB); bf16_t* H = dry ? (bf16_t*)(p.ws + WS_GU) : (bf16_t*)(p.ws + WS_H);
    const float* MOD = (const float*)(p.ws + WS_MOD);
    const int co = lane * 4;
    u32x2 yq[4]; f32x4 xq[4];
#pragma unroll
    for (int i = 0; i < 4; ++i) { yq[i] = (u32x2){0u, 0u}; xq[i] = (f32x4){0.f, 0.f, 0.f, 0.f}; }
    if (mode != 0 && gwave < nrows && gwave < MLAT) {
#pragma unroll
        for (int i = 0; i < 4; ++i) { yq[i] = *(const u32x2*)((const bf16_t*)Y0 + (size_t)gwave * D + co + 256 * i); xq[i] = *(const f32x4*)(X + (size_t)gwave * D + co + 256 * i); }
    }
    for (int row = gwave; row < nrows; row += nwaves) {
        const int v = row < MLAT ? (row >> 12) : 4;
        f32x4 x[4], y[4];
        f32x4 pg[4], pm[4], qg[4], qa[4], qs[4];
        if (mode == 0) {
            const float* src = row < MLAT ? pin(0) + (size_t)row * D : pin(2) + (size_t)(row - MLAT) * D;
#pragma unroll
            for (int i = 0; i < 4; ++i) x[i] = *(const f32x4*)(src + co + 256 * i);
        {
            const float* gp = pin(6) + ((size_t)l * 6 + gpost_i) * D; const float* gt = MOD + ((size_t)(l * 5 + v) * 9 + kgate) * D;
            const float* gq = pin(6) + ((size_t)ln * 6 + gpre_i) * D; const float* sh = MOD + ((size_t)(ln * 5 + v) * 9 + kshift) * D; const float* sc = sh + D;
#pragma unroll
            for (int i = 0; i < 4; ++i) { pg[i] = *(const f32x4*)(gp + co + 256 * i); pm[i] = *(const f32x4*)(gt + co + 256 * i);
                qg[i] = *(const f32x4*)(gq + co + 256 * i); qa[i] = *(const f32x4*)(sh + co + 256 * i); qs[i] = *(const f32x4*)(sc + co + 256 * i); }
        }
        } else {
            if (row >= MLAT) {
                const float* Y = YC + (size_t)(row - MLAT) * D;
#pragma unroll
                for (int ih = 0; ih < 2; ++ih) {
                    f32x4 t[11][2];
#pragma unroll
                    for (int z = 0; z < 11; ++z)
#pragma unroll
                        for (int i2 = 0; i2 < 2; ++i2) t[z][i2] = z < nzc ? *(const f32x4*)(Y + (size_t)z * 1024 * D + co + 256 * (ih * 2 + i2)) : (f32x4){0.f, 0.f, 0.f, 0.f};
#pragma unroll
                    for (int i2 = 0; i2 < 2; ++i2) { f32x4 a = t[0][i2];
#pragma unroll
                        for (int z = 1; z < 11; ++z) a = a + t[z][i2];
                        y[ih * 2 + i2] = a; }
                }
#pragma unroll
                for (int i = 0; i < 4; ++i) x[i] = *(const f32x4*)(X + (size_t)row * D + co + 256 * i);
            } else {
#pragma unroll
                for (int i = 0; i < 4; ++i) { const u32x2 r2 = yq[i]; x[i] = xq[i];
                    y[i] = (f32x4){__uint_as_float(r2[0] << 16), __uint_as_float(r2[0] & 0xffff0000u), __uint_as_float(r2[1] << 16), __uint_as_float(r2[1] & 0xffff0000u)}; }
            }
        {
            const float* gp = pin(6) + ((size_t)l * 6 + gpost_i) * D; const float* gt = MOD + ((size_t)(l * 5 + v) * 9 + kgate) * D;
            const float* gq = pin(6) + ((size_t)ln * 6 + gpre_i) * D; const float* sh = MOD + ((size_t)(ln * 5 + v) * 9 + kshift) * D; const float* sc = sh + D;
#pragma unroll
            for (int i = 0; i < 4; ++i) { pg[i] = *(const f32x4*)(gp + co + 256 * i); pm[i] = *(const f32x4*)(gt + co + 256 * i);
                qg[i] = *(const f32x4*)(gq + co + 256 * i); qa[i] = *(const f32x4*)(sh + co + 256 * i); qs[i] = *(const f32x4*)(sc + co + 256 * i); }
        }
            const int nxt = row + nwaves;
            if (nxt < nrows && nxt < MLAT) {
#pragma unroll
                for (int i = 0; i < 4; ++i) { yq[i] = *(const u32x2*)((const bf16_t*)Y0 + (size_t)nxt * D + co + 256 * i); xq[i] = *(const f32x4*)(X + (size_t)nxt * D + co + 256 * i); }
            }
            float ss = 0.f;
#pragma unroll
            for (int i = 0; i < 4; ++i) ss += y[i][0] * y[i][0] + y[i][1] * y[i][1] + y[i][2] * y[i][2] + y[i][3] * y[i][3];
            ss = wsum(ss); const float rs = rsqrtf(ss * (1.f / D) + EPS) * coef;
#pragma unroll
            for (int i = 0; i < 4; ++i) x[i] = x[i] + pm[i] * (y[i] * rs * pg[i]);
        }
        if (mode == 2) {
#pragma unroll
            for (int i = 0; i < 4; ++i) *(f32x4*)((float*)pin(25) + (size_t)row * D + co + 256 * i) = x[i];
            continue;
        }
#pragma unroll
        for (int i = 0; i < 4; ++i) *(f32x4*)(Xw + (size_t)row * D + co + 256 * i) = x[i];
        float ss = 0.f;
#pragma unroll
        for (int i = 0; i < 4; ++i) ss += x[i][0] * x[i][0] + x[i][1] * x[i][1] + x[i][2] * x[i][2] + x[i][3] * x[i][3];
        ss = wsum(ss); const float rs = rsqrtf(ss * (1.f / D) + EPS);
#pragma unroll
        for (int i = 0; i < 4; ++i) { const f32x4 h = x[i] * rs * qg[i] * (qs[i] + 1.f) + qa[i]; u32x2 w; w[0] = pk2(h[0], h[1]); w[1] = pk2(h[2], h[3]);
            *(u32x2*)(H + (size_t)row * D + co + 256 * i) = w; }
    }
}

DEVI void gdn_load(const bf16_t* P, const float* convw, int b, int c, int h, int dir, int want, bf16_t* sQ, bf16_t* sK, bf16_t* sKT, bf16_t* sVT, int tid) {
    const bool isctx = c < 4;
#pragma unroll
    for (int r = 0; r < 6; ++r) {
        const int task = tid + 512 * r, seg = r >> 1, rem = task & 1023, t = rem >> 4, cgp = rem & 15;
        if (seg == 0 && !(want & 1)) continue;
        if (seg == 1 && !(want & 6)) continue;
        if (seg == 2 && !(want & 8)) continue;
        int p = (isctx ? c : c - 4) * 64 + t; if (dir) p = (isctx ? 255 : 4095) - p;
        const int ch = seg * 512 + h * 128 + cgp * 8;
        float a[8];
#pragma unroll
        for (int e = 0; e < 8; ++e) a[e] = 0.f;
#pragma unroll
        for (int j = 0; j < 4; ++j) {
            const int row = pos_row(true, b, isctx, p + j - 2);
            if (row >= 0) {
                const u32x4 raw = *(const u32x4*)(P + (size_t)row * DINP + C_DNQ + ch); float x[8]; unpack8(raw, x);
                const f32x4 w0 = *(const f32x4*)(convw + j * 1536 + ch), w1 = *(const f32x4*)(convw + j * 1536 + ch + 4);
                a[0] += w0[0] * x[0]; a[1] += w0[1] * x[1]; a[2] += w0[2] * x[2]; a[3] += w0[3] * x[3];
                a[4] += w1[0] * x[4]; a[5] += w1[1] * x[5]; a[6] += w1[2] * x[6]; a[7] += w1[3] * x[7];
            }
        }
        float ss = 0.f;
#pragma unroll
        for (int e = 0; e < 8; ++e) { a[e] = silu(a[e]); ss += a[e] * a[e]; }
        if (seg < 2) {
            ss += __shfl_xor(ss, 1, 64); ss += __shfl_xor(ss, 2, 64); ss += __shfl_xor(ss, 4, 64); ss += __shfl_xor(ss, 8, 64);
            float inv = rsqrtf(ss + EPS); if (seg == 0) inv *= 0.08838834764831845f;
#pragma unroll
            for (int e = 0; e < 8; ++e) a[e] *= inv;
        }
        if (seg == 0) *(u32x4*)(sQ + t * 136 + cgp * 8) = pack8(a);
        else if (seg == 1) {
            if (want & 2) *(u32x4*)(sK + t * 136 + cgp * 8) = pack8(a);
            if (want & 4) {
#pragma unroll
                for (int e = 0; e < 8; ++e) sKT[tix(cgp * 8 + e, t)] = (bf16_t)f2bf(a[e]); }
        } else {
#pragma unroll
            for (int e = 0; e < 8; ++e) sVT[tix(cgp * 8 + e, t)] = (bf16_t)f2bf(a[e]);
        }
    }
}
struct GdnRaw { u32x4 r[4][4]; float g; };
DEVI void gdn_ld_issue(const bf16_t* P, const float* gates, int b, int c, int h, int dir, int seg_lo, GdnRaw& R, int tid) {
    const bool isctx = c < 4;
#pragma unroll
    for (int tk = 0; tk < 4; ++tk) {
        const int r = seg_lo * 2 + tk, task = tid + 512 * r, seg = r >> 1, rem = task & 1023, t = rem >> 4, cgp = rem & 15;
        int p = (isctx ? c : c - 4) * 64 + t; if (dir) p = (isctx ? 255 : 4095) - p;
        const int ch = seg * 512 + h * 128 + cgp * 8;
#pragma unroll
        for (int j = 0; j < 4; ++j) { const int row = pos_row(true, b, isctx, p + j - 2); R.r[tk][j] = (u32x4){0u, 0u, 0u, 0u};
            if (row >= 0) R.r[tk][j] = *(const u32x4*)(P + (size_t)row * DINP + C_DNQ + ch); }
    }
    R.g = 0.f; if (tid < 257) R.g = gates[tid];
}
DEVI void gdn_ld_finish(const GdnRaw& R, const float* convw, int h, int seg_lo, int want, bf16_t* sQ, bf16_t* sK, bf16_t* sKT, bf16_t* sVT, float* sc, int tid) {
#pragma unroll
    for (int tk = 0; tk < 4; ++tk) {
        const int r = seg_lo * 2 + tk, task = tid + 512 * r, seg = r >> 1, rem = task & 1023, t = rem >> 4, cgp = rem & 15;
        const int ch = seg * 512 + h * 128 + cgp * 8;
        float a[8];
#pragma unroll
        for (int e = 0; e < 8; ++e) a[e] = 0.f;
#pragma unroll
        for (int j = 0; j < 4; ++j) {
            float x[8]; unpack8(R.r[tk][j], x);
            const f32x4 w0 = *(const f32x4*)(convw + j * 1536 + ch), w1 = *(const f32x4*)(convw + j * 1536 + ch + 4);
            a[0] += w0[0] * x[0]; a[1] += w0[1] * x[1]; a[2] += w0[2] * x[2]; a[3] += w0[3] * x[3];
            a[4] += w1[0] * x[4]; a[5] += w1[1] * x[5]; a[6] += w1[2] * x[6]; a[7] += w1[3] * x[7];
        }
        float ss = 0.f;
#pragma unroll
        for (int e = 0; e < 8; ++e) { a[e] = silu(a[e]); ss += a[e] * a[e]; }
        if (seg < 2) {
            ss += __shfl_xor(ss, 1, 64); ss += __shfl_xor(ss, 2, 64); ss += __shfl_xor(ss, 4, 64); ss += __shfl_xor(ss, 8, 64);
            float inv = rsqrtf(ss + EPS); if (seg == 0) inv *= 0.08838834764831845f;
#pragma unroll
            for (int e = 0; e < 8; ++e) a[e] *= inv;
        }
        if (seg == 0) *(u32x4*)(sQ + t * 136 + cgp * 8) = pack8(a);
        else if (seg == 1) {
            if (want & 2) *(u32x4*)(sK + t * 136 + cgp * 8) = pack8(a);
            if (want & 4) {
#pragma unroll
                for (int e = 0; e < 8; ++e) sKT[tix(cgp * 8 + e, t)] = (bf16_t)f2bf(a[e]); }
        } else {
#pragma unroll
            for (int e = 0; e < 8; ++e) sVT[tix(cgp * 8 + e, t)] = (bf16_t)f2bf(a[e]);
        }
    }
    if (tid < 257) sc[tid] = R.g;
}
DEVI void gdn_gates(const PW& p, const bf16_t* P, int l, int b, int c, int h, int dir, float* sc, int lane) {
    const int row = tok_row(true, dir, b, c, lane);
    const float bb = bf2f(P[(size_t)row * DINP + C_DNBA + dir * 4 + h]), aa = bf2f(P[(size_t)row * DINP + C_DNBA + 8 + dir * 4 + h]);
    const float beta = sigm(bb);
    const float g = -__expf(pin(20)[l * 8 + dir * 4 + h]) * softplus(aa + pin(21)[l * 8 + dir * 4 + h]);
    float G = g;
#pragma unroll
    for (int o = 1; o < 64; o <<= 1) { const float t = __shfl_up(G, o, 64); if (lane >= o) G += t; }
    const float GT = __shfl(G, 63, 64);
    sc[lane] = G; sc[64 + lane] = beta; sc[128 + lane] = __expf(G); sc[192 + lane] = __expf(GT - G); if (lane == 0) sc[256] = __expf(GT);
}

DEVI void gdn_prep_all(const PW& pw0, int l, int first, int G, unsigned char* shm_in, int wv) {
    GdnRaw R;
    if (first < 2176) { const PW p{opq64(pw0.ws)}; const int tid = MYTID; const int c = first % NCH, h = (first / NCH) & 3, b = (first / (NCH * 4)) & 3, dir = first / (NCH * 16);
        gdn_ld_issue((const bf16_t*)(p.ws + WS_P), (const float*)(p.ws + WS_GATES) + (size_t)first * 320, b, c, h, dir, 1, R, tid); }
#pragma unroll 1
    for (int item = first; item < 2176; item += G) {
    const PW p{opq64(pw0.ws)};
    unsigned char* shm = opq(shm_in);
    const int tid = MYTID, wid = __builtin_amdgcn_readfirstlane(tid >> 6), lane = tid & 63, fr = lane & 15, fq = lane >> 4;
    const bf16_t* P = (const bf16_t*)(p.ws + WS_P);
    const float* GATES = (const float*)(p.ws + WS_GATES);
    const int h = (item / NCH) & 3;
    bf16_t* sK = (bf16_t*)shm;
    bf16_t* sKT = (bf16_t*)(shm + 17408);
    bf16_t* sVT = (bf16_t*)(shm + 35840);
    float* sTm = (float*)(shm + 54272);
    bf16_t* sT1 = (bf16_t*)(shm + 71680);
    bf16_t* sT2 = (bf16_t*)(shm + 80896);
    bf16_t* sWT = (bf16_t*)(shm + 90112);
    bf16_t* sUT = (bf16_t*)(shm + 108544);
    float* sc = (float*)(shm + 126976);
    gdn_ld_finish(R, pin(19) + (size_t)l * 4 * 1536, h, 1, 2 | 4 | 8, nullptr, sK, sKT, sVT, sc, tid);
    __builtin_amdgcn_sched_barrier(0);
    { const int nxt = item + G; if (nxt < 2176) { const int c2 = nxt % NCH, h2 = (nxt / NCH) & 3, b2 = (nxt / (NCH * 4)) & 3, dir2 = nxt / (NCH * 16); gdn_ld_issue(P, GATES + (size_t)nxt * 320, b2, c2, h2, dir2, 1, R, opaque(tid)); } }
    __builtin_amdgcn_sched_barrier(0);
    lbar();
#pragma unroll
    for (int ti = 0; ti < 2; ++ti) {
        const int tile = wid * 2 + ti, mt = tile >> 2, nt = tile & 3;
        f32x4 acc = (f32x4){0.f, 0.f, 0.f, 0.f};
#pragma unroll
        for (int kk = 0; kk < 4; ++kk) acc = MFMA16(ldfrag(sK, 136, mt * 16, kk * 32, lane), ldfrag(sK, 136, nt * 16, kk * 32, lane), acc);
        const int s = nt * 16 + fr;
#pragma unroll
        for (int j = 0; j < 4; ++j) { const int t = mt * 16 + fq * 4 + j; sTm[t * 68 + s] = s < t ? sc[64 + t] * acc[j] * __expf(sc[t] - sc[s]) : 0.f; }
    }
    lbar();
    float* tmpY = (float*)sWT;
    if (wid < 4) {
        const int o = wid * 16, c = lane & 15;
        int lz; asm volatile("v_mov_b32 %0, 0" : "=v"(lz));
        const float* tm = sTm + lz;
        float x[16];
#pragma unroll
        for (int t = 0; t < 16; ++t) {
            float v = -sTm[(o + t) * 68 + o + c];
#pragma unroll
            for (int s4 = 0; s4 < (t + 3) / 4; ++s4) {
                const f32x4 a = *(const f32x4*)(tm + (o + t) * 68 + o + s4 * 4);
#pragma unroll
                for (int e = 0; e < 4; ++e) if (s4 * 4 + e < t) v -= a[e] * x[s4 * 4 + e];
            }
            x[t] = v;
        }
        asm volatile("s_waitcnt lgkmcnt(0)" ::: "memory");
        if (lane < 16) {
#pragma unroll
            for (int t = 0; t < 16; ++t) sTm[(o + t) * 68 + o + c] = x[t] + (t == c ? 1.f : 0.f);
        }
    }
    lbar();
    {
        const int blk = tid >> 8, r = (tid >> 4) & 15, c = tid & 15, ib = (blk ? 3 : 1) * 16, jb = ib - 16;
        float y = 0.f;
#pragma unroll
        for (int s2 = 0; s2 < 16; ++s2) y += sTm[(ib + r) * 68 + jb + s2] * sTm[(jb + s2) * 68 + jb + c];
        tmpY[blk * 272 + r * 17 + c] = y;
        lbar();
        float z = 0.f;
#pragma unroll
        for (int s2 = 0; s2 < 16; ++s2) z += sTm[(ib + r) * 68 + ib + s2] * tmpY[blk * 272 + s2 * 17 + c];
        lbar();
        sTm[(ib + r) * 68 + jb + c] = -z;
    }
    lbar();
    {
        float y[2];
#pragma unroll
        for (int u = 0; u < 2; ++u) { const int o = tid + 512 * u, r = o >> 5, c = o & 31; float a = 0.f;
#pragma unroll 8
            for (int s2 = 0; s2 < 32; ++s2) a += sTm[(32 + r) * 68 + s2] * sTm[s2 * 68 + c];
            y[u] = a; }
#pragma unroll
        for (int u = 0; u < 2; ++u) { const int o = tid + 512 * u, r = o >> 5, c = o & 31; tmpY[r * 33 + c] = y[u]; }
        lbar();
#pragma unroll
        for (int u = 0; u < 2; ++u) { const int o = tid + 512 * u, r = o >> 5, c = o & 31; float a = 0.f;
#pragma unroll 8
            for (int s2 = 0; s2 < 32; ++s2) a += sTm[(32 + r) * 68 + 32 + s2] * tmpY[s2 * 33 + c];
            y[u] = a; }
#pragma unroll
        for (int u = 0; u < 2; ++u) { const int o = tid + 512 * u, r = o >> 5, c = o & 31; sTm[(32 + r) * 68 + c] = -y[u]; }
    }
    lbar();
#pragma unroll
    for (int u = 0; u < 8; ++u) {
        const int o = tid + 512 * u, t = o >> 6, s2 = o & 63; const float xv = sTm[t * 68 + s2], bt = sc[64 + s2];
        sT1[t * 72 + s2] = (bf16_t)f2bf(xv * bt * sc[128 + s2]); sT2[t * 72 + s2] = (bf16_t)f2bf(xv * bt);
    }
    lbar();
    bf16_t* GW = (bf16_t*)(p.ws + WS_H) + (size_t)item * 64 * 128;
    bf16_t* GU = (bf16_t*)(p.ws + WS_GU) + (size_t)item * 64 * 128;
    {
        const int tid2 = opaque(tid), lane = tid2 & 63, fr = lane & 15, fq = lane >> 4;
        const int mt = wid;
#pragma unroll
        for (int nt = 0; nt < 4; ++nt) {
            f32x4 aw = (f32x4){0.f, 0.f, 0.f, 0.f}, au = aw;
#pragma unroll
            for (int kk = 0; kk < 2; ++kk) { aw = MFMA16(ldfragT(sKT, mt * 16, kk * 32, lane), ldfrag(sT1, 72, nt * 16, kk * 32, lane), aw);
                au = MFMA16(ldfragT(sVT, mt * 16, kk * 32, lane), ldfrag(sT2, 72, nt * 16, kk * 32, lane), au); }
            const int t = nt * 16 + fr, r0 = mt * 16 + fq * 4; const float dec = sc[192 + t];
            u32x2 w; w[0] = pk2(aw[0], aw[1]); w[1] = pk2(aw[2], aw[3]); *(u32x2*)(GW + t * 128 + r0) = w;
            w[0] = pk2(au[0], au[1]); w[1] = pk2(au[2], au[3]); *(u32x2*)(GU + t * 128 + r0) = w;
#pragma unroll
            for (int j = 0; j < 4; ++j) { sWT[tix(r0 + j, t)] = (bf16_t)f2bf(aw[j] * dec); sUT[tix(r0 + j, t)] = (bf16_t)f2bf(au[j] * dec); }
        }
    }
    lbar();
    bf16_t* GB = (bf16_t*)(p.ws + WS_GB) + (size_t)item * 128 * 128;
    bf16_t* GN = (bf16_t*)(p.ws + WS_GN) + (size_t)item * 128 * 128;
    {
        const int tid2 = opaque(tid), lane = tid2 & 63, fr = lane & 15, fq = lane >> 4;
        const int mt = wid;
#pragma unroll
        for (int nt = 0; nt < 8; ++nt) {
            f32x4 ab = (f32x4){0.f, 0.f, 0.f, 0.f}, an = ab;
#pragma unroll
            for (int kk = 0; kk < 2; ++kk) { ab = MFMA16(ldfragT(sWT, mt * 16, kk * 32, lane), ldfragT(sKT, nt * 16, kk * 32, lane), ab);
                an = MFMA16(ldfragT(sKT, mt * 16, kk * 32, lane), ldfragT(sUT, nt * 16, kk * 32, lane), an); }
            const int cc = nt * 16 + fr, r0 = mt * 16 + fq * 4;
            u32x2 w; w[0] = pk2(-ab[0], -ab[1]); w[1] = pk2(-ab[2], -ab[3]); *(u32x2*)(GB + cc * 128 + r0) = w;
            w[0] = pk2(an[0], an[1]); w[1] = pk2(an[2], an[3]); *(u32x2*)(GN + cc * 128 + r0) = w;
        }
    }
    if (tid == 0) ((float*)(p.ws + WS_SM + SM_GDEC))[item] = sc[256];
    lbar();
    }
}

DEVI void gdn_seq_unit(const PW& pw0, int unit, unsigned char* shm_in, int wv) {
    const PW p{opq64(pw0.ws)};
    unsigned char* shm = opq(shm_in);
    const int tid = MYTID, wid = __builtin_amdgcn_readfirstlane(tid >> 6), lane = tid & 63, fr = lane & 15, fq = lane >> 4;
    const int chain = unit >> 3, es = unit & 7;
    bf16_t* sS = (bf16_t*)shm;
    const bf16_t* GB = (const bf16_t*)(p.ws + WS_GB) + (size_t)chain * NCH * 16384;
    bf16_t* GN = (bf16_t*)(p.ws + WS_GN) + (size_t)chain * NCH * 16384;
    const float* GDEC = (const float*)(p.ws + WS_SM + SM_GDEC) + chain * NCH;
    f32x4 acc = (f32x4){0.f, 0.f, 0.f, 0.f};
    constexpr int PF = 4;
    bf16x8 an[PF][4]; u32x2 nn[PF]; float dn[PF];
    const size_t aoff = (size_t)(wid * 16 + fr) * 128 + fq * 8, noff = (size_t)(es * 16 + fr) * 128 + wid * 16 + fq * 4;
#pragma unroll
    for (int u = 0; u < PF; ++u) {
#pragma unroll
        for (int kk = 0; kk < 4; ++kk) an[u][kk] = *(const bf16x8*)(GB + (size_t)u * 16384 + aoff + kk * 32);
        nn[u] = *(const u32x2*)(GN + (size_t)u * 16384 + noff); dn[u] = GDEC[u];
    }
#pragma unroll 1
    for (int c0 = 0; c0 < NCH; c0 += PF) {
#pragma unroll
        for (int u = 0; u < PF; ++u) {
            const int c = c0 + u;
            bf16x8 a[4]; const u32x2 ncur = nn[u]; const float dcur = dn[u];
#pragma unroll
            for (int kk = 0; kk < 4; ++kk) a[kk] = an[u][kk];
            u32x2 sw; sw[0] = pk2(acc[0], acc[1]); sw[1] = pk2(acc[2], acc[3]);
            bf16_t* sb = sS + (c & 1) * (16 * 136);
            *(u32x2*)(sb + fr * 136 + wid * 16 + fq * 4) = sw;
            *(u32x2*)(GN + (size_t)c * 16384 + noff) = sw;
            if (c + PF < NCH) {
#pragma unroll
                for (int kk = 0; kk < 4; ++kk) an[u][kk] = *(const bf16x8*)(GB + (size_t)(c + PF) * 16384 + aoff + kk * 32);
                nn[u] = *(const u32x2*)(GN + (size_t)(c + PF) * 16384 + noff); dn[u] = GDEC[c + PF];
            }
            lbar();
            acc[0] = dcur * acc[0] + __uint_as_float(ncur[0] << 16); acc[1] = dcur * acc[1] + __uint_as_float(ncur[0] & 0xffff0000u);
            acc[2] = dcur * acc[2] + __uint_as_float(ncur[1] << 16); acc[3] = dcur * acc[3] + __uint_as_float(ncur[1] & 0xffff0000u);
#pragma unroll
            for (int kk = 0; kk < 4; ++kk) acc = MFMA16(a[kk], ldfrag(sb, 136, 0, kk * 32, lane), acc);
        }
    }
    lbar();
}

struct GdnOutRaw { GdnRaw L; u32x4 st[4]; u32x4 w[2]; u32x2 ur[4]; };
DEVI void gdn_out_issue(const PW& p, int item, int dir, GdnOutRaw& R, int tid) {
    const int lane = tid & 63, fr = lane & 15, fq = lane >> 4, wid = tid >> 6;
    const int j = item % NCH, h = (item / NCH) & 3, b = item / (NCH * 4);
    const int c = dir_chunk(dir, j);
    const int it2 = ((dir * 4 + b) * 4 + h) * NCH + c;
    gdn_ld_issue((const bf16_t*)(p.ws + WS_P), (const float*)(p.ws + WS_GATES) + (size_t)it2 * 320, b, c, h, dir, 0, R.L, tid);
    const bf16_t* GS = (const bf16_t*)(p.ws + WS_GN) + (size_t)it2 * 16384;
    const bf16_t* GW = (const bf16_t*)(p.ws + WS_H) + (size_t)it2 * 8192;
    const bf16_t* GU = (const bf16_t*)(p.ws + WS_GU) + (size_t)it2 * 8192;
#pragma unroll
    for (int r = 0; r < 4; ++r) { const int idx = tid + 512 * r, row = idx >> 4, cg8 = (idx & 15) * 8; R.st[r] = *(const u32x4*)(GS + row * 128 + cg8); }
#pragma unroll
    for (int r = 0; r < 2; ++r) { const int idx = tid + 512 * r, row = idx >> 4, cg8 = (idx & 15) * 8; R.w[r] = *(const u32x4*)(GW + row * 128 + cg8); }
#pragma unroll
    for (int nt = 0; nt < 4; ++nt) R.ur[nt] = *(const u32x2*)(GU + (nt * 16 + fr) * 128 + wid * 16 + fq * 4);
}
DEVI void gdn_out_all(const PW& pw0, int l, int first, int G, bool skipctx, unsigned char* shm_in, int wv) {
    const int dry = 0;
    GdnOutRaw R;
    int item = first;
    while (item < 1088 && skipctx && (item % NCH) < 4) item += G;
    if (item < 1088) { const PW p{opq64(pw0.ws)}; gdn_out_issue(p, item, 0, R, MYTID); }
#pragma unroll 1
    while (item < 1088) {
    int nitem = item + G;
    while (nitem < 1088 && skipctx && (nitem % NCH) < 4) nitem += G;
#pragma unroll 1
    for (int dir = 0; dir < 2; ++dir) {
        const PW p{opq64(pw0.ws)};
        unsigned char* shm = opq(shm_in);
        const int tid = MYTID, wid = __builtin_amdgcn_readfirstlane(tid >> 6), lane = tid & 63, fr = lane & 15, fq = lane >> 4;
        const int j = item % NCH, h = (item / NCH) & 3, b = item / (NCH * 4);
        bf16_t* P = (bf16_t*)(p.ws + WS_P);
        bf16_t* sQ = (bf16_t*)shm;
        bf16_t* sK = (bf16_t*)(shm + 17408);
        bf16_t* sST = (bf16_t*)(shm + 34816);
        bf16_t* sW = (bf16_t*)(shm + 69632);
        bf16_t* sVN = (bf16_t*)(shm + 87040);
        bf16_t* sA2 = (bf16_t*)(shm + 105472);
        float* sO = (float*)(shm + 114688);
        float* sc = (float*)(shm + 148480);
        gdn_ld_finish(R.L, pin(19) + (size_t)l * 4 * 1536, h, 0, 1 | 2, sQ, sK, nullptr, nullptr, sc, tid);
#pragma unroll
        for (int r = 0; r < 4; ++r) { const int idx = tid + 512 * r, row = idx >> 4, cg8 = (idx & 15) * 8; *(u32x4*)(sST + row * 136 + cg8) = R.st[r]; }
#pragma unroll
        for (int r = 0; r < 2; ++r) { const int idx = tid + 512 * r, row = idx >> 4, cg8 = (idx & 15) * 8; *(u32x4*)(sW + row * 136 + cg8) = R.w[r]; }
        u32x2 ur4[4];
#pragma unroll
        for (int nt = 0; nt < 4; ++nt) ur4[nt] = R.ur[nt];
        __builtin_amdgcn_sched_barrier(0);
        if (dir == 0) gdn_out_issue(p, item, 1, R, opaque(tid)); else if (nitem < 1088) gdn_out_issue(p, nitem, 0, R, opaque(tid));
        __builtin_amdgcn_sched_barrier(0);
        lbar();
        {
            const int mt = wid;
#pragma unroll
            for (int nt = 0; nt < 4; ++nt) {
                const u32x2 ur = ur4[nt];
                f32x4 a = (f32x4){0.f, 0.f, 0.f, 0.f};
#pragma unroll
                for (int kk = 0; kk < 4; ++kk) a = MFMA16(ldfrag(sST, 136, mt * 16, kk * 32, lane), ldfrag(sW, 136, nt * 16, kk * 32, lane), a);
                const int t = nt * 16 + fr, e0 = mt * 16 + fq * 4;
                sVN[(e0 + 0) * 72 + t] = (bf16_t)f2bf(__uint_as_float(ur[0] << 16) - a[0]); sVN[(e0 + 1) * 72 + t] = (bf16_t)f2bf(__uint_as_float(ur[0] & 0xffff0000u) - a[1]);
                sVN[(e0 + 2) * 72 + t] = (bf16_t)f2bf(__uint_as_float(ur[1] << 16) - a[2]); sVN[(e0 + 3) * 72 + t] = (bf16_t)f2bf(__uint_as_float(ur[1] & 0xffff0000u) - a[3]);
            }
#pragma unroll
            for (int ti = 0; ti < 2; ++ti) {
                const int tile = wid * 2 + ti, m2 = tile >> 2, n2 = tile & 3;
                f32x4 a = (f32x4){0.f, 0.f, 0.f, 0.f};
#pragma unroll
                for (int kk = 0; kk < 4; ++kk) a = MFMA16(ldfrag(sQ, 136, m2 * 16, kk * 32, lane), ldfrag(sK, 136, n2 * 16, kk * 32, lane), a);
                const int s = n2 * 16 + fr;
#pragma unroll
                for (int jj = 0; jj < 4; ++jj) { const int t = m2 * 16 + fq * 4 + jj; sA2[t * 72 + s] = (bf16_t)f2bf(s <= t ? a[jj] * __expf(sc[t] - sc[s]) : 0.f); }
            }
        }
        lbar();
        {
            const int nt = wid;
#pragma unroll
            for (int mt = 0; mt < 4; ++mt) {
                f32x4 a = (f32x4){0.f, 0.f, 0.f, 0.f};
#pragma unroll
                for (int kk = 0; kk < 4; ++kk) a = MFMA16(ldfrag(sQ, 136, mt * 16, kk * 32, lane), ldfrag(sST, 136, nt * 16, kk * 32, lane), a);
#pragma unroll
                for (int jj = 0; jj < 4; ++jj) a[jj] *= sc[128 + mt * 16 + fq * 4 + jj];
#pragma unroll
                for (int kk = 0; kk < 2; ++kk) a = MFMA16(ldfrag(sA2, 72, mt * 16, kk * 32, lane), ldfrag(sVN, 72, nt * 16, kk * 32, lane), a);
                const int e = nt * 16 + fr;
#pragma unroll
                for (int jj = 0; jj < 4; ++jj) { const int t = mt * 16 + fq * 4 + jj; const int i = dir ? 63 - t : t; if (dir) sO[i * 132 + e] += a[jj]; else sO[i * 132 + e] = a[jj]; }
            }
        }
        lbar();
    }
    {
        const PW p{opq64(pw0.ws)};
        unsigned char* shm = opq(shm_in);
        const int tid = MYTID;
        const int j = item % NCH, h = (item / NCH) & 3, b = item / (NCH * 4);
        bf16_t* P = (bf16_t*)(p.ws + WS_P);
        float* sO = (float*)(shm + 114688);
    {
        const int i = tid >> 3, e0 = (tid & 7) * 16;
        float v[16], ss = 0.f;
#pragma unroll
        for (int e = 0; e < 16; ++e) { v[e] = sO[i * 132 + e0 + e]; ss += v[e] * v[e]; }
        ss += __shfl_xor(ss, 1, 64); ss += __shfl_xor(ss, 2, 64); ss += __shfl_xor(ss, 4, 64);
        const float rs = rsqrtf(ss * (1.f / 128.f) + EPS);
        const int row = tok_row(true, 0, b, j, i);
        bf16_t* zp = P + (size_t)row * DINP + C_DNZ + h * 128 + e0;
        const float* g = pin(22) + l * 128 + e0;
#pragma unroll
        for (int half = 0; half < 2; ++half) {
            float z[8]; unpack8(*(const u32x4*)(zp + half * 8), z); float o[8];
#pragma unroll
            for (int e = 0; e < 8; ++e) o[e] = v[half * 8 + e] * rs * g[half * 8 + e] * z[e];
            bf16_t* zd = dry ? (bf16_t*)(p.ws + WS_GB) + (size_t)row * 512 + h * 128 + e0 : zp;
            *(u32x4*)(zd + half * 8) = pack8(o);
        }
    }
    lbar();
    }
    item = nitem;
    }
}

DEVI float ml_gates(const PW& p, const bf16_t* P, int l, int b, int c, int h, int dir, float* sc, int lane) {
    const int row = tok_row(false, dir, b, c, lane);
    const float ig = bf2f(P[(size_t)row * DINP + C_MLG + dir * 4 + h]) + pin(10)[l * 16 + dir * 4 + h];
    const float fg = bf2f(P[(size_t)row * DINP + C_MLG + (2 + dir) * 4 + h]) + pin(10)[l * 16 + (2 + dir) * 4 + h];
    float bb = logsig(fg);
#pragma unroll
    for (int o = 1; o < 64; o <<= 1) { const float t = __shfl_up(bb, o, 64); if (lane >= o) bb += t; }
    sc[lane] = bb; sc[64 + lane] = ig;
    return __shfl(bb, 63, 64);
}
DEVI void ml_prep_item(const PW& pw0, int l, int item, unsigned char* shm_in, int wv) {
    const PW p{opq64(pw0.ws)};
    unsigned char* shm = opq(shm_in);
    const int tid = MYTID, wid = __builtin_amdgcn_readfirstlane(tid >> 6), lane = tid & 63, fr = lane & 15, fq = lane >> 4;
    const int c = item % NCH, h = (item / NCH) & 3, b = (item / (NCH * 4)) & 3, dir = item / (NCH * 16);
    const bf16_t* P = (const bf16_t*)(p.ws + WS_P);
    bf16_t* sKT = (bf16_t*)shm;
    bf16_t* sVT = (bf16_t*)(shm + 9216);
    float* sc = (float*)(shm + 27648);
    const float* gp = (const float*)(p.ws + WS_GATES) + (size_t)(2176 + item) * 320;
    if (tid < 64) sc[128 + tid] = gp[128 + tid];
    {
        const int t = tid >> 3, cg8 = (tid & 7) * 8; const int row = tok_row(false, dir, b, c, t);
        float x[8]; unpack8(*(const u32x4*)(P + (size_t)row * DINP + C_MLK + h * 64 + cg8), x);
#pragma unroll
        for (int e = 0; e < 8; ++e) sKT[tix(cg8 + e, t)] = (bf16_t)f2bf(x[e]);
    }
#pragma unroll
    for (int r = 0; r < 2; ++r) {
        const int idx = tid + 512 * r, t = idx >> 4, cg8 = (idx & 15) * 8; const int row = tok_row(false, dir, b, c, t);
        float x[8]; unpack8(*(const u32x4*)(P + (size_t)row * DINP + C_MLV + h * 128 + cg8), x); const float w = gp[128 + t];
#pragma unroll
        for (int e = 0; e < 8; ++e) sVT[tix(cg8 + e, t)] = (bf16_t)f2bf(x[e] * w);
    }
    lbar();
    float* KV = (float*)(p.ws + WS_Y) + (size_t)item * 8192;
    {
        const int nt = wid;
#pragma unroll
        for (int mt = 0; mt < 4; ++mt) {
            f32x4 a = (f32x4){0.f, 0.f, 0.f, 0.f};
#pragma unroll
            for (int kk = 0; kk < 2; ++kk) a = MFMA16(ldfragT(sKT, mt * 16, kk * 32, lane), ldfragT(sVT, nt * 16, kk * 32, lane), a);
            *(f32x4*)(KV + (nt * 16 + fr) * 64 + mt * 16 + fq * 4) = a;
        }
    }
    if (tid < 64) { float s = 0.f;
        for (int t = 0; t < 64; ++t) s += sc[128 + t] * bf2f(sKT[tix(tid, t)]);
        ((float*)(p.ws + WS_SM + SM_MN))[item * 64 + tid] = s; }
    lbar();
}
DEVI void ml_seq(const PW& pw0, int gtid, int nthreads) {
    const PW p{opq64(pw0.ws)};
    const float* MSC = (const float*)(p.ws + WS_SM + SM_MSC);
    float* MM = (float*)(p.ws + WS_SM + SM_MM);
    for (int g = gtid; g < 32 * 4096 + 32 * 32; g += nthreads) {
        const bool isn = g >= 32 * 4096; const int gg = isn ? g - 32 * 4096 : g;
        const int chain = isn ? gg >> 5 : gg >> 12, e2 = isn ? gg & 31 : gg & 4095;
        float* base = isn ? (float*)(p.ws + WS_SM + SM_MN) + (size_t)chain * NCH * 64 + e2 * 2 : (float*)(p.ws + WS_Y) + (size_t)chain * NCH * 8192 + e2 * 2;
        const int stride = isn ? 64 : 8192;
        float m = 0.f; f32x2 C = (f32x2){0.f, 0.f};
        for (int c0 = 0; c0 < NCH; c0 += 17) {
            f32x2 kv[17]; f32x2 sc[17];
#pragma unroll
            for (int u = 0; u < 17; ++u) { kv[u] = *(const f32x2*)(base + (size_t)(c0 + u) * stride); sc[u] = *(const f32x2*)(MSC + (chain * NCH + c0 + u) * 2); }
#pragma unroll
            for (int u = 0; u < 17; ++u) {
                *(f32x2*)(base + (size_t)(c0 + u) * stride) = C;
                if (!isn && e2 == 0) MM[chain * NCH + c0 + u] = m;
                const float mn = fmaxf(sc[u][0] + m, sc[u][1]);
                const float a = __expf(sc[u][0] + m - mn), s = __expf(sc[u][1] - mn);
                C = C * a + kv[u] * s; m = mn;
            }
        }
    }
}
DEVI void ml_out_item(const PW& pw0, int l, int item, unsigned char* shm_in, int wv, int dry = 0) {
    const PW p{opq64(pw0.ws)};
    unsigned char* shm = opq(shm_in);
    const int tid = MYTID, wid = __builtin_amdgcn_readfirstlane(tid >> 6), lane = tid & 63, fr = lane & 15, fq = lane >> 4;
    const int j = item % NCH, h = (item / NCH) & 3, b = item / (NCH * 4);
    bf16_t* P = (bf16_t*)(p.ws + WS_P);
    bf16_t* sQ = (bf16_t*)shm;
    bf16_t* sK = (bf16_t*)(shm + 9216);
    bf16_t* sVT = (bf16_t*)(shm + 18432);
    bf16_t* sCT = (bf16_t*)(shm + 36864);
    bf16_t* sS = (bf16_t*)(shm + 55296);
    float* sO = (float*)(shm + 64512);
    float* sc = (float*)(shm + 98304);
#pragma unroll 1
    for (int dir = 0; dir < 2; ++dir) {
        const int c = dir_chunk(dir, j);
        const int it2 = ((dir * 4 + b) * 4 + h) * NCH + c;
        if (wid == 0) {
            const float* gp = (const float*)(p.ws + WS_GATES) + (size_t)(2176 + it2) * 320;
            const float m = ((const float*)(p.ws + WS_SM + SM_MM))[it2];
            const float bb = gp[lane], pm = gp[192 + lane];
            sc[lane] = bb; sc[64 + lane] = gp[64 + lane];
            const float mt = bb + fmaxf(m, pm);
            sc[128 + lane] = mt; sc[192 + lane] = __expf(bb + m - mt);
            sc[320 + lane] = ((const float*)(p.ws + WS_SM + SM_MN))[it2 * 64 + lane];
        }
        {
            const int t = tid >> 3, cg8 = (tid & 7) * 8; const int row = tok_row(false, dir, b, c, t);
            float x[8]; unpack8(*(const u32x4*)(P + (size_t)row * DINP + C_MLQ + h * 64 + cg8), x);
#pragma unroll
            for (int e = 0; e < 8; ++e) x[e] *= 0.125f;
            *(u32x4*)(sQ + t * 72 + cg8) = pack8(x);
            *(u32x4*)(sK + t * 72 + cg8) = *(const u32x4*)(P + (size_t)row * DINP + C_MLK + h * 64 + cg8);
        }
#pragma unroll
        for (int r = 0; r < 2; ++r) {
            const int idx = tid + 512 * r, t = idx >> 4, cg8 = (idx & 15) * 8; const int row = tok_row(false, dir, b, c, t);
            float x[8]; unpack8(*(const u32x4*)(P + (size_t)row * DINP + C_MLV + h * 128 + cg8), x);
#pragma unroll
            for (int e = 0; e < 8; ++e) sVT[tix(cg8 + e, t)] = (bf16_t)f2bf(x[e]);
        }
        {
            const float* CT = (const float*)(p.ws + WS_Y) + (size_t)it2 * 8192;
#pragma unroll
            for (int r = 0; r < 4; ++r) { const int idx = tid + 512 * r, e = idx >> 4, d4 = (idx & 15) * 4; const f32x4 v = *(const f32x4*)(CT + e * 64 + d4);
                u32x2 w; w[0] = pk2(v[0], v[1]); w[1] = pk2(v[2], v[3]); *(u32x2*)(sCT + e * 72 + d4) = w; }
        }
        lbar();
#pragma unroll
        for (int ti = 0; ti < 2; ++ti) {
            const int tile = wid * 2 + ti, m2 = tile >> 2, n2 = tile & 3;
            f32x4 a = (f32x4){0.f, 0.f, 0.f, 0.f};
#pragma unroll
            for (int kk = 0; kk < 2; ++kk) a = MFMA16(ldfrag(sQ, 72, m2 * 16, kk * 32, lane), ldfrag(sK, 72, n2 * 16, kk * 32, lane), a);
            const int s = n2 * 16 + fr;
#pragma unroll
            for (int jj = 0; jj < 4; ++jj) { const int t = m2 * 16 + fq * 4 + jj;
                sS[t * 72 + s] = (bf16_t)f2bf(s <= t ? a[jj] * __expf(sc[t] - sc[s] + sc[64 + s] - sc[128 + t]) : 0.f); }
        }
        lbar();
        if (tid < 64) {
            float ds = 0.f, qn = 0.f;
            for (int s = 0; s < 64; ++s) { ds += bf2f(sS[tid * 72 + s]); qn += bf2f(sQ[tid * 72 + s]) * sc[320 + s]; }
            const float den = ds + sc[192 + tid] * qn;
            sc[256 + tid] = 1.f / fmaxf(fabsf(den), __expf(-sc[128 + tid]));
        }
        lbar();
        {
            const int nt = wid;
#pragma unroll
            for (int mt = 0; mt < 4; ++mt) {
                f32x4 a = (f32x4){0.f, 0.f, 0.f, 0.f};
#pragma unroll
                for (int kk = 0; kk < 2; ++kk) a = MFMA16(ldfrag(sQ, 72, mt * 16, kk * 32, lane), ldfrag(sCT, 72, nt * 16, kk * 32, lane), a);
#pragma unroll
                for (int jj = 0; jj < 4; ++jj) a[jj] *= sc[192 + mt * 16 + fq * 4 + jj];
#pragma unroll
                for (int kk = 0; kk < 2; ++kk) a = MFMA16(ldfrag(sS, 72, mt * 16, kk * 32, lane), ldfragT(sVT, nt * 16, kk * 32, lane), a);
                const int e = nt * 16 + fr;
#pragma unroll
                for (int jj = 0; jj < 4; ++jj) { const int t = mt * 16 + fq * 4 + jj; const int i = dir ? 63 - t : t; const float hv = a[jj] * sc[256 + t];
                    if (dir) sO[i * 132 + e] += hv; else sO[i * 132 + e] = hv; }
            }
        }
        lbar();
    }
    {
        const int i = tid >> 3, e0 = (tid & 7) * 16;
        float v[16], ss = 0.f;
#pragma unroll
        for (int e = 0; e < 16; ++e) { v[e] = sO[i * 132 + e0 + e]; ss += v[e] * v[e]; }
        ss += __shfl_xor(ss, 1, 64); ss += __shfl_xor(ss, 2, 64); ss += __shfl_xor(ss, 4, 64);
        const float rs = rsqrtf(ss * (1.f / 128.f) + EPS);
        const int row = tok_row(false, 0, b, j, i);
        bf16_t* op = P + (size_t)row * DINP + C_MLO + h * 128 + e0;
        const float* g = pin(11) + l * 512 + h * 128 + e0;
#pragma unroll
        for (int half = 0; half < 2; ++half) {
            float z[8]; unpack8(*(const u32x4*)(op + half * 8), z); float o[8];
#pragma unroll
            for (int e = 0; e < 8; ++e) o[e] = v[half * 8 + e] * rs * g[half * 8 + e] * z[e];
            bf16_t* od = dry ? (bf16_t*)(p.ws + WS_GB) + (size_t)row * 512 + h * 128 + e0 : op;
            *(u32x4*)(od + half * 8) = pack8(o);
        }
    }
    lbar();
}

DEVI void lru_item(const PW& pw0, int l, int item, int mode, unsigned char* shm_in, int wv, int dry = 0) {
    const PW p{opq64(pw0.ws)};
    unsigned char* shm = opq(shm_in);
    const int tid = MYTID, wid = __builtin_amdgcn_readfirstlane(tid >> 6), lane = tid & 63, fr = lane & 15, fq = lane >> 4;
    const int n4 = item & 3, j = (item >> 2) % NCH, b = (item >> 2) / NCH; const bool isctx = j < 4;
    bf16_t* P = (bf16_t*)(p.ws + WS_P);
    bf16_t* sX = (bf16_t*)shm;
    const int p0 = (isctx ? j : j - 4) * 64;
    const float* cw = pin(12) + (size_t)l * 4 * 512; const float* cb = pin(13) + (size_t)l * 512;
    {
        const int ch = lane * 8, i0 = wid * 8;
        f32x4 w[4][2];
#pragma unroll
        for (int jj = 0; jj < 4; ++jj) { w[jj][0] = *(const f32x4*)(cw + jj * 512 + ch); w[jj][1] = *(const f32x4*)(cw + jj * 512 + ch + 4); }
        const f32x4 b0 = *(const f32x4*)(cb + ch), b1 = *(const f32x4*)(cb + ch + 4);
        u32x4 raw[11];
#pragma unroll
        for (int r = 0; r < 11; ++r) { const int row = pos_row(false, b, isctx, p0 + i0 + r - 2);
            raw[r] = (u32x4){0u, 0u, 0u, 0u}; if (row >= 0) raw[r] = *(const u32x4*)(P + (size_t)row * DINP + C_LRX + ch); }
#pragma unroll
        for (int i = 0; i < 8; ++i) {
            float a[8] = {b0[0], b0[1], b0[2], b0[3], b1[0], b1[1], b1[2], b1[3]};
#pragma unroll
            for (int jj = 0; jj < 4; ++jj) { float x[8]; unpack8(raw[i + jj], x);
#pragma unroll
                for (int e = 0; e < 4; ++e) { a[e] += w[jj][0][e] * x[e]; a[4 + e] += w[jj][1][e] * x[4 + e]; } }
            *(u32x4*)(sX + (i0 + i) * 520 + ch) = pack8(a);
        }
    }
    lbar();
    const int blk = wid;
    const bf16_t* WL = (const bf16_t*)(p.ws + WS_WLRU);
    float* LAGG = (float*)(p.ws + WS_SM + SM_LAGG);
    {
        const int ch = blk * 64 + n4 * 16 + fr;
        float hsum[4][4];
#pragma unroll
        for (int mt = 0; mt < 4; ++mt)
#pragma unroll
            for (int jj = 0; jj < 4; ++jj) hsum[mt][jj] = 0.f;
#pragma unroll
        for (int dir = 0; dir < 2; ++dir) {
            const bf16_t* wa = WL + (size_t)(0 * 16 + dir * 8 + blk) * 4096 + (n4 * 16 + fr) * 64 + fq * 8;
            const bf16_t* wx = WL + (size_t)(1 * 16 + dir * 8 + blk) * 4096 + (n4 * 16 + fr) * 64 + fq * 8;
            bf16x8 ba[2], bx[2];
#pragma unroll
            for (int kk = 0; kk < 2; ++kk) { ba[kk] = *(const bf16x8*)(wa + kk * 32); bx[kk] = *(const bf16x8*)(wx + kk * 32); }
            const int c = dir_chunk(dir, j);
            const size_t aidx = (((size_t)dir * 4 + b) * NCH + c) * 512 + ch;
            const float hin0 = mode ? LAGG[aidx * 2] : 0.f;
            const float bias_a = pin(15)[(size_t)l * 1024 + dir * 512 + ch], bias_x = pin(17)[(size_t)l * 1024 + dir * 512 + ch];
            const float cl = -8.f * softplus(-pin(18)[(size_t)l * 1024 + dir * 512 + ch]);
            float av[4][4], bv[4][4];
#pragma unroll
            for (int mt = 0; mt < 4; ++mt) {
                f32x4 aa = (f32x4){0.f, 0.f, 0.f, 0.f}, ax = aa;
#pragma unroll
                for (int kk = 0; kk < 2; ++kk) { const bf16x8 af = ldfrag(sX, 520, mt * 16, blk * 64 + kk * 32, lane); aa = MFMA16(af, ba[kk], aa); ax = MFMA16(af, bx[kk], ax); }
#pragma unroll
                for (int jj = 0; jj < 4; ++jj) {
                    const int t = mt * 16 + fq * 4 + jj;
                    const float rr = sigm(aa[jj] + bias_a), ii = sigm(ax[jj] + bias_x), la = cl * rr;
                    const float ea = __expf(la);
                    av[mt][jj] = ea;
                    bv[mt][jj] = __builtin_amdgcn_sqrtf(fmaxf(1.f - ea * ea, 0.f)) * ii * bf2f(sX[t * 520 + ch]);
                }
            }
            float hin = hin0;
            float Pc = 1.f, Hc = 0.f;
#pragma unroll
            for (int mi = 0; mi < 4; ++mi) {
                const int mt = dir ? 3 - mi : mi;
                float Pl = 1.f, Hl = 0.f;
#pragma unroll
                for (int ji = 0; ji < 4; ++ji) { const int jj = dir ? 3 - ji : ji; Pl = av[mt][jj] * Pl; Hl = av[mt][jj] * Hl + bv[mt][jj]; }
                float Pq[4], Hq[4];
#pragma unroll
                for (int q = 0; q < 4; ++q) { Pq[q] = __shfl(Pl, fr + 16 * q, 64); Hq[q] = __shfl(Hl, fr + 16 * q, 64); }
                if (mode == 0) {
#pragma unroll
                    for (int qi = 0; qi < 4; ++qi) { const int q = dir ? 3 - qi : qi; Hc = Pq[q] * Hc + Hq[q]; Pc = Pq[q] * Pc; }
                } else {
                    float hh = hin;
                    float hme = hin;
#pragma unroll
                    for (int qi = 0; qi < 4; ++qi) { const int q = dir ? 3 - qi : qi; if (q == fq) hme = hh; hh = Pq[q] * hh + Hq[q]; }
                    hin = hh;
#pragma unroll
                    for (int ji = 0; ji < 4; ++ji) { const int jj = dir ? 3 - ji : ji; hme = av[mt][jj] * hme + bv[mt][jj]; hsum[mt][jj] += hme; }
                }
            }
            if (mode == 0 && fq == 0) { LAGG[aidx * 2] = Pc; LAGG[aidx * 2 + 1] = Hc; }
        }
        if (mode == 1) {
#pragma unroll
            for (int mt = 0; mt < 4; ++mt)
#pragma unroll
                for (int jj = 0; jj < 4; ++jj) { const int i = mt * 16 + fq * 4 + jj; const int row = pos_row(false, b, isctx, p0 + i);
                    hsum[mt][jj] *= bf2f(P[(size_t)row * DINP + C_LRY + ch]); }
#pragma unroll
            for (int mt = 0; mt < 4; ++mt)
#pragma unroll
                for (int jj = 0; jj < 4; ++jj) { const int i = mt * 16 + fq * 4 + jj; const int row = pos_row(false, b, isctx, p0 + i);
                    bf16_t* yp = P + (size_t)row * DINP + C_LRY + ch; bf16_t* yd = dry ? (bf16_t*)(p.ws + WS_GB) + (size_t)row * 512 + ch : yp; *yd = (bf16_t)f2bf(hsum[mt][jj]); }
        }
    }
    lbar();
}
DEVI void lru_seq(const PW& pw0, int gtid, int nthreads) {
    const PW p{opq64(pw0.ws)};
    float* LAGG = (float*)(p.ws + WS_SM + SM_LAGG);
    for (int g = gtid; g < 4096; g += nthreads) {
        const int ch = g & 511, db = g >> 9;
        float h = 0.f;
        for (int c0 = 0; c0 < NCH; c0 += 17) {
            f32x2 v[17];
#pragma unroll
            for (int u = 0; u < 17; ++u) v[u] = *(const f32x2*)(LAGG + (((size_t)db * NCH + c0 + u) * 512 + ch) * 2);
#pragma unroll
            for (int u = 0; u < 17; ++u) { LAGG[(((size_t)db * NCH + c0 + u) * 512 + ch) * 2] = h; h = v[u][0] * h + v[u][1]; }
        }
    }
}

DEVI void gate_phase(const PW& pw0, int l, int gwave, int nwaves, int lane) {
    const PW p{opq64(pw0.ws)};
    const bf16_t* P = (const bf16_t*)(p.ws + WS_P);
    float* GT = (float*)(p.ws + WS_GATES);
    for (int w = gwave; w < 4352; w += nwaves) {
        const int kind = w >= 2176 ? 1 : 0, item = kind ? w - 2176 : w;
        const int c = item % NCH, h = (item / NCH) & 3, b = (item / (NCH * 4)) & 3, dir = item / (NCH * 16);
        float* gp = GT + (size_t)(kind * 2176 + item) * 320;
        if (kind == 0) gdn_gates(p, P, l, b, c, h, dir, gp, lane);
        else {
            const int row = tok_row(false, dir, b, c, lane);
            const float ig = bf2f(P[(size_t)row * DINP + C_MLG + dir * 4 + h]) + pin(10)[l * 16 + dir * 4 + h];
            const float fg = bf2f(P[(size_t)row * DINP + C_MLG + (2 + dir) * 4 + h]) + pin(10)[l * 16 + (2 + dir) * 4 + h];
            float bb = logsig(fg);
#pragma unroll
            for (int o = 1; o < 64; o <<= 1) { const float t = __shfl_up(bb, o, 64); if (lane >= o) bb += t; }
            const float bT = __shfl(bb, 63, 64);
            const float lw = bT - bb + ig;
            const float Mc = wmax(lw);
            float pm = ig - bb;
#pragma unroll
            for (int o = 1; o < 64; o <<= 1) { const float t = __shfl_up(pm, o, 64); if (lane >= o) pm = fmaxf(pm, t); }
            gp[lane] = bb; gp[64 + lane] = ig; gp[128 + lane] = __expf(lw - Mc); gp[192 + lane] = pm;
            if (lane == 0) { float* msc = (float*)(p.ws + WS_SM + SM_MSC) + item * 2; msc[0] = bT; msc[1] = Mc; }
        }
    }
}

#define XB_TMO      128
#define XB_XCNT(j)  (256  + 64 * (j))
#define XB_XSUB(j)  (1280 + 64 * (j))
#define XB_XGEN(j)  (2304 + 64 * (j))
#define XB_TOP      3328
#define XB_TOPGEN   3392
#define XCD_BAR_WORDS 3456
#define XB_SPIN_CAP (1u << 22)
DEVI unsigned xb_ld(unsigned* p)              { return __hip_atomic_load(p, __ATOMIC_RELAXED, __HIP_MEMORY_SCOPE_AGENT); }
DEVI unsigned xb_add(unsigned* p, unsigned v) { return __hip_atomic_fetch_add(p, v, __ATOMIC_RELAXED, __HIP_MEMORY_SCOPE_AGENT); }
DEVI unsigned xb_xcc_id() { return (unsigned)__builtin_amdgcn_s_getreg((3 << 11) | 20) & 0xFu; }
#define XB_SPIN(cond, bar) do { unsigned _sp = 0; while (cond) { __builtin_amdgcn_s_sleep(1); \
    if ((++_sp & 255u) == 0u) { if (xb_ld(&(bar)[XB_TMO])) break; if (_sp > XB_SPIN_CAP) { atomicAdd(&(bar)[XB_TMO], 1u); break; } } } } while (0)
DEVI void xcd_barrier_complete(unsigned* bar, unsigned x, unsigned G, unsigned& nloc, unsigned& nx) {
    unsigned sum, cnt, mine, sp = 0u;
    for (;;) {
        sum = 0u; cnt = 0u; mine = 0u;
#pragma unroll
        for (unsigned j = 0; j < 16; ++j) { const unsigned c = xb_ld(&bar[XB_XCNT(j)]); sum += c; cnt += (c > 0u) ? 1u : 0u; mine = (j == x) ? c : mine; }
        if (sum == G) break;
        __builtin_amdgcn_s_sleep(1);
        if ((++sp & 255u) == 0u) { if (xb_ld(&bar[XB_TMO])) break; if (sp > XB_SPIN_CAP) { atomicAdd(&bar[XB_TMO], 1u); break; } }
    }
    nloc = mine > 0u ? mine : 1u; nx = cnt > 0u ? cnt : 1u;
}
DEVI void gsync(unsigned* bar, volatile LAS unsigned* st, int G, int wv) {
    asm volatile("s_waitcnt vmcnt(0)" ::: "memory");
    __syncthreads();
    const int ln = (int)__builtin_amdgcn_mbcnt_hi(~0u, __builtin_amdgcn_mbcnt_lo(~0u, 0u));
    if (wv == 0 && ln == 0) {
        __builtin_amdgcn_s_waitcnt(0);
        const unsigned x = xb_xcc_id();
        unsigned nloc = st[0], nx = st[1];
        if (nloc == 0u) { xcd_barrier_complete(bar, x, (unsigned)G, nloc, nx); st[0] = nloc; st[1] = nx; }
        const unsigned old = xb_add(&bar[XB_XSUB(x)], 1u);
        const unsigned gen = old / nloc;
        if (old + 1u == (gen + 1u) * nloc) {
            __builtin_amdgcn_fence(__ATOMIC_RELEASE, "agent");
            asm volatile("s_waitcnt vmcnt(0)" ::: "memory");
            const unsigned og = xb_add(&bar[XB_TOP], 1u);
            const unsigned tg = og / nx;
            if (og + 1u == (tg + 1u) * nx) xb_add(&bar[XB_TOPGEN], 1u);
            else XB_SPIN(xb_ld(&bar[XB_TOPGEN]) == tg, bar);
            __builtin_amdgcn_fence(__ATOMIC_ACQUIRE, "agent");
            xb_add(&bar[XB_XGEN(x)], 1u);
            asm volatile("s_waitcnt vmcnt(0)" ::: "memory");
        } else {
            XB_SPIN(xb_ld(&bar[XB_XGEN(x)]) == gen, bar);
            __builtin_amdgcn_fence(__ATOMIC_ACQUIRE, "agent");
            asm volatile("s_waitcnt vmcnt(0)" ::: "memory");
        }
    }
    __syncthreads();
}

__global__ void __launch_bounds__(512) mega(Params p) {
    extern __shared__ __attribute__((aligned(16))) unsigned char shm[];
    cg::grid_group grid = cg::this_grid();
    const int wv = __builtin_amdgcn_readfirstlane(threadIdx.x >> 6);
    const int G = gridDim.x, nwaves = G * 8, nthreads = G * 512;
#define TIDS const int tid = MYTID, wid = tid >> 6, lane = tid & 63, gwave = blockIdx.x * 8 + wid, gtid = blockIdx.x * 512 + tid; (void)gtid; (void)gwave; (void)lane;
    LAS unsigned char* lds = (LAS unsigned char*)shm;
#define WSQ unsigned char* ws = opq64(pw.ws); bf16_t* Hb = (bf16_t*)(ws + WS_H); bf16_t* Pb = (bf16_t*)(ws + WS_P); float* Yb = (float*)(ws + WS_Y); (void)Hb; (void)Pb; (void)Yb;

    const PW pw{p.ws};
    unsigned* bar = (unsigned*)p.ws;
    volatile LAS unsigned* xst = (volatile LAS unsigned*)((LAS unsigned char*)shm + (LDS_BYTES - 16));
    if (threadIdx.x == 0) { xst[0] = 0u; xst[1] = 0u; (void)xb_add(&bar[XB_XCNT(xb_xcc_id())], 1u); }
    __syncthreads();
    for (int rep = 0; rep < REP_CVT; ++rep) {
    mod_phase(pw, shm, wv);
    { TIDS convert_phase(pw, 0, shm, gwave, nwaves, wid, lane); }
    }
    grid.sync();
    { TIDS rowwise_phase(pw, 0, MTOT, 0, 0, 0.f, 0, 0, 0, 0, 0, gwave, nwaves, lane); }
    gsync(bar, xst, G, wv);

#pragma unroll 1
    for (int l = 0; l < DEPTH; ++l) {
        const bool last = l == DEPTH - 1;
#pragma unroll 1
        for (int f = 0; f < 2; ++f) {
            if (f == 1) {
                { WSQ pg8::Gemm g{Hb, (const bf16_t*)(ws + WS_WIN), 68, 31, D, D, 1, 0, 0, 0, 0, D, 0}; pg8::Order S; S.init(68, 31, 1, G, blockIdx.x);
                  pg8::EpiInProj E{Pb, DINP}; for (int rep = 0; rep < REP_GEMM; ++rep) pg8::gemm_phase(lds, g, S, E, wv); }
                gsync(bar, xst, G, wv);
                { TIDS gate_phase(pw, l, gwave, nwaves, lane); }
                gsync(bar, xst, G, wv);
#pragma unroll 1
                for (int rep2 = 0; rep2 < REP_PREPSEQ; ++rep2) {
#pragma unroll 1
                for (int rep = 0; rep < REP_PREP; ++rep)
                {
                    gdn_prep_all(pw, l, blockIdx.x, G, shm, wv);
                    for (int it = (blockIdx.x + G / 2) % G; it < 2176; it += G) for (int r3 = 0; r3 < REP_MLP; ++r3) ml_prep_item(pw, l, it, shm, wv);
                    for (int it = (blockIdx.x + G / 4) % G; it < 1088; it += G) for (int r3 = 0; r3 < REP_LRU0; ++r3) lru_item(pw, l, it, 0, shm, wv);
                }
                gsync(bar, xst, G, wv);
                for (int u = blockIdx.x; u < 256; u += G) gdn_seq_unit(pw, u, shm, wv);
                { TIDS ml_seq(pw, gtid, nthreads); }
                { TIDS lru_seq(pw, gtid, nthreads); }
                gsync(bar, xst, G, wv);
                }
                gdn_out_all(pw, l, blockIdx.x, G, last, shm, wv);
                for (int it = (blockIdx.x + G / 4) % G; it < 1088; it += G) { if (last && (it % NCH) < 4) continue; if (DRY_MO) ml_out_item(pw, l, it, shm, wv, 1); ml_out_item(pw, l, it, shm, wv); }
                for (int it = (blockIdx.x + G / 2) % G; it < 1088; it += G) { if (last && ((it >> 2) % NCH) < 4) continue; if (DRY_LO) lru_item(pw, l, it, 1, shm, wv, 1); lru_item(pw, l, it, 1, shm, wv); }
                gsync(bar, xst, G, wv);
                const int nM = last ? 64 : 68;
                { WSQ pg8::Gemm g{Pb, (const bf16_t*)(ws + WS_WBR), nM, 4, 512, DINP, 3, C_MLO, C_LRY, C_DNZ, D * 512, 512, 0}; pg8::Order S; S.init(nM, 4, 3, G, blockIdx.x);
                  pg8::EpiBranch E{Pb, (bf16_t*)Yb, Hb}; for (int rep = 0; rep < REP_BR; ++rep) pg8::gemm_phase(lds, g, S, E, wv); }
                gsync(bar, xst, G, wv);
                { WSQ pg8::Gemm g{Hb, (const bf16_t*)(ws + WS_WOUT), 64, 4, D, D, 1, 0, 0, 0, 0, D, 0}; pg8::Order S; S.init(64, 4, 1, G, blockIdx.x);
                  pg8::EpiBf16Y E{(bf16_t*)Yb, D}; for (int rep = 0; rep < REP_GEMM; ++rep) pg8::gemm_phase(lds, g, S, E, wv); }
                if (!last) { WSQ pg8::Gemm g{Hb, (const bf16_t*)(ws + WS_WOUT), 4, 4, 256, D, 4, 0, 0, 0, 256, D, 256}; pg8::Order S; S.init(4, 4, 4, G, blockIdx.x, 64, 1);
                  pg8::EpiF32 E{(float*)(ws + WS_GB), D, MLAT, (size_t)1024 * D}; pg8::gemm_phase(lds, g, S, E, wv); }
                gsync(bar, xst, G, wv);
                { TIDS if (DRY_ROW) { rowwise_phase(pw, 1, nM * 256, l, 5, 1.f, 3, l, 4, 6, 4, gwave, nwaves, lane, 1); } rowwise_phase(pw, 1, nM * 256, l, 5, 1.f, 3, l, 4, 6, 4, gwave, nwaves, lane); }
                gsync(bar, xst, G, wv);
            }
            const int nM = (last && f == 1) ? 64 : 68;
            { WSQ pg8::Gemm g{Hb, (const bf16_t*)(ws + WS_WGU + f * SZ_WGU), nM, 22, D, D, 1, 0, 0, 0, 0, D, 0}; pg8::Order S; S.init(nM, 22, 1, G, blockIdx.x);
              pg8::EpiSwiGLU E{Pb, DFF}; for (int rep = 0; rep < REP_GU; ++rep) pg8::gemm_phase(lds, g, S, E, wv); }
            gsync(bar, xst, G, wv);
            { WSQ pg8::Gemm g{Pb, (const bf16_t*)(ws + WS_WDN + f * SZ_WDN), 64, 4, DFF, DFF, 1, 0, 0, 0, 0, DFF, 0}; pg8::Order S; S.init(64, 4, 1, G, blockIdx.x);
              pg8::EpiBf16Y E{(bf16_t*)Yb, D}; for (int rep = 0; rep < REP_DN; ++rep) pg8::gemm_phase(lds, g, S, E, wv); }
            if (nM == 68) { WSQ pg8::Gemm g{Pb, (const bf16_t*)(ws + WS_WDN + f * SZ_WDN), 4, 4, 256, DFF, 11, 0, 0, 0, 256, DFF, 256}; pg8::Order S; S.init(4, 4, 11, G, blockIdx.x, 64, 1);
              pg8::EpiF32 E{(float*)(ws + WS_GB), D, MLAT, (size_t)1024 * D}; for (int rep = 0; rep < REP_DNC; ++rep) pg8::gemm_phase(lds, g, S, E, wv); }
            gsync(bar, xst, G, wv);
            if (f == 0) { TIDS if (DRY_ROW) { rowwise_phase(pw, 1, nM * 256, l, 2, 0.5f, 1, l, 2, 3, 11, gwave, nwaves, lane, 1); } rowwise_phase(pw, 1, nM * 256, l, 2, 0.5f, 1, l, 2, 3, 11, gwave, nwaves, lane); }
            else if (!last) { { TIDS if (DRY_ROW) { rowwise_phase(pw, 1, nM * 256, l, 8, 0.5f, 5, l + 1, 0, 0, 11, gwave, nwaves, lane, 1); } rowwise_phase(pw, 1, nM * 256, l, 8, 0.5f, 5, l + 1, 0, 0, 11, gwave, nwaves, lane); } for (int rep = 0; rep < REP_CVT; ++rep) { TIDS convert_phase(pw, l + 1, shm, gwave, nwaves, wid, lane); } }
            else { TIDS rowwise_phase(pw, 2, MLAT, l, 8, 0.5f, 5, 0, 0, 0, 0, gwave, nwaves, lane); }
            gsync(bar, xst, G, wv);
        }
    }
}

extern "C" void kernel_launch(void* const* d_in, const int* in_sizes, int n_in, void* d_out, int out_size, void* d_ws, size_t ws_size, hipStream_t stream) {
    static int grid = 0;
    if (grid == 0) {
        if (n_in != 25 || ws_size < WS_END) { fprintf(stderr, "kernel_launch: unexpected n_in %d or ws_size %zu (need %zu)\n", n_in, ws_size, (size_t)WS_END); grid = -1; return; }
        int dev = 0, cus = 0, per_cu = 0;
        hipGetDevice(&dev); hipDeviceGetAttribute(&cus, hipDeviceAttributeMultiprocessorCount, dev);
        if (hipFuncSetAttribute((const void*)mega, hipFuncAttributeMaxDynamicSharedMemorySize, LDS_BYTES) != hipSuccess) { fprintf(stderr, "kernel_launch: hipFuncSetAttribute failed\n"); grid = -1; return; }
        if (hipOccupancyMaxActiveBlocksPerMultiprocessor(&per_cu, (const void*)mega, 512, LDS_BYTES) != hipSuccess || per_cu < 1) { fprintf(stderr, "kernel_launch: occupancy query failed (%d)\n", per_cu); per_cu = 1; }
        (void)hipGetLastError();
        grid = cus * per_cu;
    }
    if (grid < 0) return;
    if (hipMemsetAsync(d_ws, 0, 16384, stream) != hipSuccess) { fprintf(stderr, "kernel_launch: memset failed\n"); return; }
    Params p{};
    for (int i = 0; i < 25; ++i) p.in[i] = (const float*)d_in[i];
    p.out = (float*)d_out; p.ws = (unsigned char*)d_ws;
    void* args[] = {&p};
    hipError_t e = hipLaunchCooperativeKernel((const void*)mega, dim3(grid), dim3(512), args, LDS_BYTES, stream);
    if (e != hipSuccess) fprintf(stderr, "cooperative launch failed: %s (grid %d)\n", hipGetErrorString(e), grid);
}
```

```cpp
#include <hip/hip_runtime.h>
#include <hip/hip_cooperative_groups.h>
#include <cstdio>
namespace cg = cooperative_groups;

#define LAS __attribute__((address_space(3)))
#define DEVI __device__ __forceinline__
typedef unsigned short bf16_t;
typedef short bf16x8 __attribute__((ext_vector_type(8)));
typedef float f32x4 __attribute__((ext_vector_type(4)));
typedef float f32x2 __attribute__((ext_vector_type(2)));
typedef unsigned u32x4 __attribute__((ext_vector_type(4)));
typedef unsigned u32x2 __attribute__((ext_vector_type(2)));

constexpr int D = 1024, NBATCH = 4, SEQ = 4096, CTXL = 256, DEPTH = 4, DFF = 2816, DINP = 7936;
constexpr int MLAT = NBATCH * SEQ, MTOT = MLAT + NBATCH * CTXL;
constexpr int NCH = 68;
constexpr int C_MLQ = 0, C_MLK = 256, C_MLV = 512, C_MLO = 1024, C_MLG = 1536, C_LRX = 1552, C_LRY = 2064,
              C_DNQ = 2576, C_DNZ = 4112, C_DNBA = 4624, C_GATE = 4640, C_END = 7712;
constexpr float EPS = 1e-6f;

constexpr size_t SZ_WGU = (size_t)2 * DFF * D * 2, SZ_WDN = (size_t)D * DFF * 2;
constexpr size_t WS_MOD = 16384;
constexpr size_t WS_WGU = 1u << 20;
constexpr size_t WS_WDN = WS_WGU + 2 * SZ_WGU;
constexpr size_t WS_WIN = WS_WDN + 2 * SZ_WDN;
constexpr size_t WS_WBR = WS_WIN + (size_t)DINP * D * 2;
constexpr size_t WS_WOUT = WS_WBR + (size_t)3 * D * 512 * 2;
constexpr size_t WS_WLRU = WS_WOUT + (size_t)D * D * 2;
constexpr size_t WS_X = WS_WLRU + (size_t)32 * 64 * 64 * 2;
constexpr size_t WS_H = WS_X + (size_t)MTOT * D * 4;
constexpr size_t WS_Y = WS_H + (size_t)MTOT * D * 2;
constexpr size_t WS_P = WS_Y + (size_t)MTOT * D * 4;
constexpr size_t WS_GU = WS_P + (size_t)MTOT * DINP * 2;
constexpr size_t WS_GB = WS_GU + (size_t)2176 * 64 * 128 * 2;
constexpr size_t WS_GN = WS_GB + (size_t)2176 * 128 * 128 * 2;
constexpr size_t WS_SM = WS_GN + (size_t)2176 * 128 * 128 * 2;
constexpr size_t SM_GDEC = 0, SM_MN = 16384, SM_MSC = SM_MN + 2176 * 64 * 4, SM_MM = SM_MSC + 2176 * 8, SM_LAGG = SM_MM + 2176 * 4 + 1024;
constexpr size_t WS_YC = WS_SM + SM_LAGG + (size_t)2 * 4 * NCH * 512 * 2 * 4 + 4096;
constexpr size_t WS_GATES = WS_YC;
constexpr size_t WS_END = WS_GATES + (size_t)2 * 2176 * 320 * 4 + 4096;
constexpr int LDS_BYTES = 155648;
constexpr int REP_BR = 1, REP_GU = 1, REP_DN = 1, REP_DNC = 1, REP_GEMM = 1, DRY_ROW = 0, REP_PREP = 1, REP_PREPSEQ = 1, REP_CVT = 1, REP_GDNP = 1, REP_MLP = 1, REP_LRU0 = 1, DRY_GO = 0, DRY_MO = 0, DRY_LO = 0;

struct Params { const float* in[25]; float* out; unsigned char* ws; };
struct PW { unsigned char* ws; };

#define CAS __attribute__((address_space(4)))
DEVI const float* pin(int i) { const CAS char* k = (const CAS char*)__builtin_amdgcn_kernarg_segment_ptr(); return *(const float* const volatile CAS*)(k + 8 * i); }
DEVI int opaque(int v) { asm volatile("" : "+v"(v)); return v; }
DEVI unsigned char* opq(unsigned char* p) { unsigned v = (unsigned)(size_t)(LAS unsigned char*)p; asm volatile("" : "+s"(v)); return (unsigned char*)(LAS unsigned char*)(size_t)v; }
DEVI LAS unsigned char* opql(LAS unsigned char* p) { unsigned v = (unsigned)(size_t)p; asm volatile("" : "+s"(v)); return (LAS unsigned char*)(size_t)v; }
DEVI unsigned char* opq64(unsigned char* p) { unsigned long long v = (unsigned long long)p; asm volatile("" : "+s"(v)); return (unsigned char*)v; }
#define MYTID opaque(wv * 64 + (int)__builtin_amdgcn_mbcnt_hi(~0u, __builtin_amdgcn_mbcnt_lo(~0u, 0u)))
DEVI float bf2f(bf16_t v) { return __uint_as_float(((unsigned)v) << 16); }
DEVI unsigned f2bf(float f) { unsigned u = __float_as_uint(f); return (u + 0x7fffu + ((u >> 16) & 1u)) >> 16; }
DEVI unsigned pk2(float lo, float hi) { return f2bf(lo) | (f2bf(hi) << 16); }
DEVI float sigm(float x) { return __builtin_amdgcn_rcpf(1.f + __expf(-x)); }
DEVI float silu(float x) { return x * sigm(x); }
DEVI float softplus(float x) { return x > 20.f ? x : log1pf(__expf(x)); }
DEVI float logsig(float x) { return fminf(x, 0.f) - log1pf(__expf(-fabsf(x))); }
DEVI float gelu_t(float x) { float u = 0.7978845608f * (x + 0.044715f * x * x * x); float e = __expf(2.f * u); return x * (1.f - __builtin_amdgcn_rcpf(e + 1.f)); }
DEVI float wsum(float v) { for (int o = 32; o > 0; o >>= 1) v += __shfl_xor(v, o, 64); return v; }
DEVI float wmax(float v) { for (int o = 32; o > 0; o >>= 1) v = fmaxf(v, __shfl_xor(v, o, 64)); return v; }
DEVI void unpack8(u32x4 r, float* f) {
    f[0] = __uint_as_float(r[0] << 16); f[1] = __uint_as_float(r[0] & 0xffff0000u); f[2] = __uint_as_float(r[1] << 16); f[3] = __uint_as_float(r[1] & 0xffff0000u);
    f[4] = __uint_as_float(r[2] << 16); f[5] = __uint_as_float(r[2] & 0xffff0000u); f[6] = __uint_as_float(r[3] << 16); f[7] = __uint_as_float(r[3] & 0xffff0000u);
}
DEVI u32x4 pack8(const float* f) { u32x4 r; r[0] = pk2(f[0], f[1]); r[1] = pk2(f[2], f[3]); r[2] = pk2(f[4], f[5]); r[3] = pk2(f[6], f[7]); return r; }
DEVI bf16x8 ldfrag(const bf16_t* base, int ld, int row0, int k0, int lane) { return *(const bf16x8*)(base + (row0 + (lane & 15)) * ld + k0 + (lane >> 4) * 8); }
DEVI int tix(int row, int col) { return row * 72 + ((((col >> 3) + (row >> 3)) & 7) << 3) + (col & 7); }
DEVI bf16x8 ldfragT(const bf16_t* base, int row0, int k0, int lane) { const int r = row0 + (lane & 15), lg = (k0 >> 3) + (lane >> 4); return *(const bf16x8*)(base + r * 72 + (((lg + (r >> 3)) & 7) << 3)); }
DEVI void lbar() { asm volatile("s_waitcnt lgkmcnt(0)" ::: "memory"); __builtin_amdgcn_s_barrier(); asm volatile("" ::: "memory"); }
#define MFMA16(a, b, c) __builtin_amdgcn_mfma_f32_16x16x32_bf16(a, b, c, 0, 0, 0)

namespace pg8 {
constexpr int BM = 256, BK = 64, HALF = 128, HTB = HALF * BK * 2, NXCD = 8, WGM = 8;
DEVI int lds_byte(int r, int c) { const int st = (r >> 4) * 2 + (c >> 5), rr = r & 15, cc = c & 31, ob = rr * 64 + cc * 2; return st * 1024 + (ob ^ (((ob >> 9) & 1) << 5)); }
DEVI void stage_rc(int b, int& R, int& C) { const int st = b / 1024, sb = b % 1024, swz = sb ^ (((sb >> 9) & 1) << 5); R = (st >> 1) * 16 + swz / 64; C = (st & 1) * 32 + (swz % 64) / 2; }
DEVI int perm32(int rho) { const int n = rho >> 4, i = rho & 15; return 8 * (i >> 2) + 4 * n + (i & 3); }
struct Unit { int pm, pn, z; };
struct Gemm { const bf16_t* A; const bf16_t* Bt; int nM, nN, K, lda, nz, zA0, zA1, zA2, zB; int ldb, zAstep; };
struct Order {
    int nM, nN, nwg, G, c, nz, pm0, spread;
    DEVI void init(int nM_, int nN_, int nz_, int G_, int c_, int pm0_ = 0, int spread_ = 0) { nM = nM_; nN = nN_; nwg = nM * nN; G = G_; c = c_; nz = nz_; pm0 = pm0_; spread = spread_; }
    DEVI bool next(int i, Unit& u) const {
        int ti = i, z = 0; long L;
        if (spread) { L = (long)i * G + c; if (L >= (long)nwg * nz) return false; z = (int)(L / nwg); L -= (long)z * nwg; }
        else { if (nz == 3) { ti = i / 3; z = i - ti * 3; } L = (long)ti * G + c; if (L >= nwg) return false; }
        int wgid = (int)L; { const int q = nwg / NXCD, r = nwg % NXCD, xcd = wgid % NXCD, off = wgid / NXCD; wgid = (xcd < r ? xcd * (q + 1) : r * (q + 1) + (xcd - r) * q) + off; }
        const int nig = WGM * nN, gid = wgid / nig, fm = gid * WGM, gsz = (nM - fm) < WGM ? (nM - fm) : WGM;
        u.pm = pm0 + fm + ((wgid % nig) % gsz); u.pn = (wgid % nig) / gsz; u.z = z; return true;
    }
};

template <class Epi>
DEVI void gemm_phase(LAS unsigned char* lds_in, const Gemm g, const Order& S, const Epi& E, int wv) {
    LAS unsigned char* lds = opql(lds_in);
    const int tid = MYTID, wid = __builtin_amdgcn_readfirstlane(tid >> 6), lane = tid & 63, wr = wid >> 2, wc = wid & 3, fr = lane & 15, fq = lane >> 4;
    const int K = g.K, nt = K / BK, lda = g.lda, ldb = g.ldb;
    unsigned voffA[2], voffB[2];
#pragma unroll
    for (int i = 0; i < 2; ++i) { int R, C; stage_rc(tid * 16 + i * 8192, R, C); const int Rb = Epi::PERM ? ((R & ~31) + perm32(R & 31)) : R;
        voffA[i] = (unsigned)(R * lda + C) * 2u; voffB[i] = (unsigned)(Rb * ldb + C) * 2u; }
    const size_t kstep = (size_t)(BK * 2);
    const size_t hstepA = (size_t)HALF * lda * 2, hstepB = (size_t)HALF * ldb * 2;
    const unsigned ldsw = (unsigned)wid * 1024u;
    const int aoff = lds_byte(wr * 64 + fr, fq * 8), boff = lds_byte(wc * 32 + fr, fq * 8);
#define PG8_SA(b, h) (((b) * 2 + (h)) * HTB)
#define PG8_SB(b, h) ((4 + (b) * 2 + (h)) * HTB)
#define PG8_STAGE(bufoff, gbase, voff) do { _Pragma("unroll") for (int _i = 0; _i < 2; ++_i) \
        __builtin_amdgcn_global_load_lds((const unsigned*)((const char*)(gbase) + (voff)[_i]), (LAS unsigned*)(lds + (bufoff) + ldsw + _i * 8192), 16, 0, 0); } while (0)
#define PG8_LDA(dst, b, h) do { _Pragma("unroll") for (int m = 0; m < 4; ++m) _Pragma("unroll") for (int k = 0; k < 2; ++k) dst[m][k] = *(const LAS bf16x8*)(lds + PG8_SA(b, h) + aoff + m * 2048 + k * 1024); } while (0)
#define PG8_LDB(dst, b, h) do { _Pragma("unroll") for (int n = 0; n < 2; ++n) _Pragma("unroll") for (int k = 0; k < 2; ++k) dst[n][k] = *(const LAS bf16x8*)(lds + PG8_SB(b, h) + boff + n * 2048 + k * 1024); } while (0)
#define PG8_MMA(ai, bj, At, Bt) do { __builtin_amdgcn_s_setprio(1); _Pragma("unroll") for (int m = 0; m < 4; ++m) _Pragma("unroll") for (int n = 0; n < 2; ++n) _Pragma("unroll") for (int k = 0; k < 2; ++k) \
        acc[ai][bj][m][n] = __builtin_amdgcn_mfma_f32_16x16x32_bf16(Bt[n][k], At[m][k], acc[ai][bj][m][n], 0, 0, 0); __builtin_amdgcn_s_setprio(0); } while (0)
#define PG8_WAIT_V(n) asm volatile("s_waitcnt vmcnt(" #n ")" ::: "memory")
#define PG8_WAIT_L(n) asm volatile("s_waitcnt lgkmcnt(" #n ")" ::: "memory")
#define PG8_BAR __builtin_amdgcn_s_barrier()
#define PG8_SCHED __builtin_amdgcn_sched_barrier(0)
#define PG8_PA(u) ((const char*)g.A + ((size_t)(g.nz == 3 ? ((u).z == 0 ? g.zA0 : ((u).z == 1 ? g.zA1 : g.zA2)) : (u).z * g.zAstep) + (size_t)(u).pm * BM * lda) * 2)
#define PG8_PB(u) ((const char*)g.Bt + ((size_t)(u).z * g.zB + (size_t)(u).pn * BM * ldb) * 2)
    Unit cur, nxt; int ui = 0;
    if (!S.next(0, cur)) return;
    f32x4 acc[2][2][4][2];
#pragma unroll
    for (int a = 0; a < 2; ++a)
#pragma unroll
        for (int b = 0; b < 2; ++b)
#pragma unroll
            for (int m = 0; m < 4; ++m)
#pragma unroll
                for (int n = 0; n < 2; ++n) acc[a][b][m][n] = (f32x4){0.f, 0.f, 0.f, 0.f};
    bf16x8 At[4][2], B0[2][2], B1[2][2];
    const char* cA = PG8_PA(cur); const char* cB = PG8_PB(cur);
    PG8_STAGE(PG8_SB(0, 0), cB, voffB); PG8_STAGE(PG8_SA(0, 0), cA, voffA); PG8_STAGE(PG8_SB(0, 1), cB + hstepB, voffB); PG8_STAGE(PG8_SA(0, 1), cA + hstepA, voffA);
    if (wr == 1) PG8_BAR;
    PG8_WAIT_V(4); PG8_BAR;
    PG8_STAGE(PG8_SB(1, 0), cB + kstep, voffB); PG8_STAGE(PG8_SA(1, 0), cA + kstep, voffA); PG8_STAGE(PG8_SB(1, 1), cB + hstepB + kstep, voffB);
    PG8_WAIT_V(6); PG8_BAR;
    for (;;) {
        const bool has_next = S.next(ui + 1, nxt);
        const char* nA = has_next ? PG8_PA(nxt) : cA; const char* nB = has_next ? PG8_PB(nxt) : cB;
        for (int t = 0; t < nt; t += 2) {
            const bool last = (t == nt - 2);
            const char* a1 = cA + (size_t)(t + 1) * kstep;
            const char* a2 = last ? nA : cA + (size_t)(t + 2) * kstep; const char* b2 = last ? nB : cB + (size_t)(t + 2) * kstep;
            const char* a3 = a2 + kstep; const char* b3 = b2 + kstep;
            PG8_LDB(B0, 0, 0); PG8_SCHED; PG8_LDA(At, 0, 0); PG8_STAGE(PG8_SA(1, 1), a1 + hstepA, voffA);
            PG8_WAIT_L(8); PG8_BAR; PG8_WAIT_L(0); PG8_MMA(0, 0, At, B0); PG8_BAR; PG8_SCHED;
            PG8_LDB(B1, 0, 1); PG8_STAGE(PG8_SB(0, 0), b2, voffB);
            PG8_BAR; PG8_WAIT_L(0); PG8_MMA(0, 1, At, B1); PG8_BAR;
            PG8_LDA(At, 0, 1); PG8_STAGE(PG8_SA(0, 0), a2, voffA);
            PG8_BAR; PG8_WAIT_L(0); PG8_MMA(1, 0, At, B0); PG8_BAR; PG8_SCHED;
            PG8_STAGE(PG8_SB(0, 1), b2 + hstepB, voffB);
            PG8_WAIT_V(6); PG8_BAR; PG8_MMA(1, 1, At, B1); PG8_BAR;
            PG8_LDB(B0, 1, 0); PG8_SCHED; PG8_LDA(At, 1, 0); PG8_STAGE(PG8_SA(0, 1), a2 + hstepA, voffA);
            PG8_WAIT_L(8); PG8_BAR; PG8_WAIT_L(0); PG8_MMA(0, 0, At, B0); PG8_BAR; PG8_SCHED;
            PG8_LDB(B1, 1, 1); PG8_STAGE(PG8_SB(1, 0), b3, voffB);
            PG8_BAR; PG8_WAIT_L(0); PG8_MMA(0, 1, At, B1); PG8_BAR;
            PG8_LDA(At, 1, 1); PG8_STAGE(PG8_SA(1, 0), a3, voffA);
            PG8_BAR; PG8_WAIT_L(0); PG8_MMA(1, 0, At, B0); PG8_BAR; PG8_SCHED;
            PG8_STAGE(PG8_SB(1, 1), b3 + hstepB, voffB);
            PG8_WAIT_V(6); PG8_BAR; PG8_MMA(1, 1, At, B1); PG8_BAR;
        }
        E(acc, cur, wr, wc, fr, fq);
        if (!has_next) break;
#pragma unroll
        for (int a = 0; a < 2; ++a)
#pragma unroll
            for (int b = 0; b < 2; ++b)
#pragma unroll
                for (int m = 0; m < 4; ++m)
#pragma unroll
                    for (int n = 0; n < 2; ++n) acc[a][b][m][n] = (f32x4){0.f, 0.f, 0.f, 0.f};
        cur = nxt; cA = nA; cB = nB; ++ui;
    }
    PG8_WAIT_V(0);
    if (wr == 0) PG8_BAR;
    PG8_BAR;
#undef PG8_SA
#undef PG8_SB
#undef PG8_STAGE
#undef PG8_LDA
#undef PG8_LDB
#undef PG8_MMA
#undef PG8_WAIT_V
#undef PG8_WAIT_L
#undef PG8_BAR
#undef PG8_SCHED
#undef PG8_PA
#undef PG8_PB
}

struct EpiF32 {
    static constexpr bool PERM = false;
    float* C; int ldc; int row_base; size_t zstride;
    DEVI void operator()(const f32x4 (&acc)[2][2][4][2], const Unit& u, int wr, int wc, int fr, int fq) const {
        const int row0 = u.pm * BM + wr * 64 + fr - row_base, col0 = u.pn * BM + wc * 32 + 4 * fq;
#pragma unroll
        for (int ai = 0; ai < 2; ++ai)
#pragma unroll
            for (int m = 0; m < 4; ++m) { float* rowp = C + (size_t)u.z * zstride + (size_t)(row0 + ai * HALF + m * 16) * ldc + col0;
#pragma unroll
                for (int bj = 0; bj < 2; ++bj)
#pragma unroll
                    for (int n = 0; n < 2; ++n) *(f32x4*)(rowp + bj * HALF + n * 16) = acc[ai][bj][m][n]; }
    }
};
struct EpiBf16Y {
    static constexpr bool PERM = true;
    bf16_t* O; int ldc;
    DEVI void operator()(const f32x4 (&acc)[2][2][4][2], const Unit& u, int wr, int wc, int fr, int fq) const {
        const int row0 = u.pm * BM + wr * 64 + fr;
#pragma unroll
        for (int bj = 0; bj < 2; ++bj) { const int c0 = u.pn * BM + bj * HALF + wc * 32 + 8 * fq;
#pragma unroll
            for (int ai = 0; ai < 2; ++ai)
#pragma unroll
                for (int m = 0; m < 4; ++m) { float v[8];
#pragma unroll
                    for (int n = 0; n < 2; ++n)
#pragma unroll
                        for (int i = 0; i < 4; ++i) v[n * 4 + i] = acc[ai][bj][m][n][i];
                    *(u32x4*)(O + (size_t)(row0 + ai * HALF + m * 16) * ldc + c0) = pack8(v); } }
    }
};
struct EpiAtomic {
    static constexpr bool PERM = false;
    float* C; int ldc; int row_base;
    DEVI void operator()(const f32x4 (&acc)[2][2][4][2], const Unit& u, int wr, int wc, int fr, int fq) const {
        const int row0 = u.pm * BM + wr * 64 + fr - row_base, col0 = u.pn * BM + wc * 32 + 4 * fq;
#pragma unroll
        for (int ai = 0; ai < 2; ++ai)
#pragma unroll
            for (int m = 0; m < 4; ++m) { float* rowp = C + (size_t)(row0 + ai * HALF + m * 16) * ldc + col0;
#pragma unroll
                for (int bj = 0; bj < 2; ++bj)
#pragma unroll
                    for (int n = 0; n < 2; ++n)
#pragma unroll
                        for (int e = 0; e < 4; ++e) __hip_atomic_fetch_add(rowp + bj * HALF + n * 16 + e, acc[ai][bj][m][n][e], __ATOMIC_RELAXED, __HIP_MEMORY_SCOPE_AGENT); }
    }
};
struct EpiSwiGLU {
    static constexpr bool PERM = false;
    bf16_t* O; int ldc;
    DEVI void operator()(const f32x4 (&acc)[2][2][4][2], const Unit& u, int wr, int wc, int fr, int fq) const {
        const int row0 = u.pm * BM + wr * 64 + fr, col0 = u.pn * 128 + wc * 32 + 8 * fq;
#pragma unroll
        for (int ai = 0; ai < 2; ++ai)
#pragma unroll
            for (int m = 0; m < 4; ++m) {
                float v[8];
#pragma unroll
                for (int bj = 0; bj < 2; ++bj)
#pragma unroll
                    for (int i = 0; i < 4; ++i) { const float gt = acc[ai][bj][m][0][i], up = acc[ai][bj][m][1][i]; v[bj * 4 + i] = silu(gt) * up; }
                *(u32x4*)(O + (size_t)(row0 + ai * HALF + m * 16) * ldc + col0) = pack8(v);
            }
    }
};
struct EpiInProj {
    static constexpr bool PERM = true;
    bf16_t* O; int ldc;
    DEVI void operator()(const f32x4 (&acc)[2][2][4][2], const Unit& u, int wr, int wc, int fr, int fq) const {
        const int row0 = u.pm * BM + wr * 64 + fr;
#pragma unroll
        for (int bj = 0; bj < 2; ++bj) {
            const int c0 = u.pn * BM + bj * HALF + wc * 32 + 8 * fq;
            int kind = 0;
            if (c0 >= C_MLO && c0 < C_MLG) kind = 1; else if (c0 >= C_LRY && c0 < C_DNQ) kind = 2; else if (c0 >= C_DNZ && c0 < C_DNBA) kind = 3; else if (c0 >= C_GATE) kind = 1;
#define INPROJ_STORE(FN) _Pragma("unroll") for (int ai = 0; ai < 2; ++ai) _Pragma("unroll") for (int m = 0; m < 4; ++m) { float v[8]; \
                _Pragma("unroll") for (int n = 0; n < 2; ++n) _Pragma("unroll") for (int i = 0; i < 4; ++i) { const float x = acc[ai][bj][m][n][i]; v[n * 4 + i] = FN; } \
                *(u32x4*)(O + (size_t)(row0 + ai * HALF + m * 16) * ldc + c0) = pack8(v); }
            if (kind == 0) { INPROJ_STORE(x) } else if (kind == 1) { INPROJ_STORE(sigm(x)) } else if (kind == 2) { INPROJ_STORE(gelu_t(x)) } else { INPROJ_STORE(silu(x)) }
#undef INPROJ_STORE
        }
    }
};
struct EpiBranch {
    static constexpr bool PERM = false;
    const bf16_t* P; bf16_t* T; bf16_t* U;
    DEVI void operator()(const f32x4 (&acc)[2][2][4][2], const Unit& u, int wr, int wc, int fr, int fq) const {
        const int row0 = u.pm * BM + wr * 64 + fr, col0 = u.pn * BM + wc * 32 + 4 * fq; const int z = u.z;
        bf16_t* dst = z < 2 ? T : U;
#pragma unroll
        for (int ai = 0; ai < 2; ++ai)
#pragma unroll
            for (int mh = 0; mh < 2; ++mh) {
                u32x2 gr[2][2][2], tv[2][2][2];
#pragma unroll
                for (int mm = 0; mm < 2; ++mm) { const size_t row = (size_t)(row0 + ai * HALF + (mh * 2 + mm) * 16);
#pragma unroll
                    for (int bj = 0; bj < 2; ++bj)
#pragma unroll
                        for (int n = 0; n < 2; ++n) { const int col = col0 + bj * HALF + n * 16;
                            gr[mm][bj][n] = *(const u32x2*)(P + row * DINP + C_GATE + z * D + col);
                            tv[mm][bj][n] = (u32x2){0u, 0u};
                            if (z > 0) tv[mm][bj][n] = *(const u32x2*)(T + row * D + col); } }
#pragma unroll
                for (int mm = 0; mm < 2; ++mm) { const size_t row = (size_t)(row0 + ai * HALF + (mh * 2 + mm) * 16);
#pragma unroll
                    for (int bj = 0; bj < 2; ++bj)
#pragma unroll
                        for (int n = 0; n < 2; ++n) { const int col = col0 + bj * HALF + n * 16;
                            const u32x2 g2 = gr[mm][bj][n], t2 = tv[mm][bj][n]; f32x4 a = acc[ai][bj][mh * 2 + mm][n];
                            a[0] = a[0] * __uint_as_float(g2[0] << 16) + __uint_as_float(t2[0] << 16); a[1] = a[1] * __uint_as_float(g2[0] & 0xffff0000u) + __uint_as_float(t2[0] & 0xffff0000u);
                            a[2] = a[2] * __uint_as_float(g2[1] << 16) + __uint_as_float(t2[1] << 16); a[3] = a[3] * __uint_as_float(g2[1] & 0xffff0000u) + __uint_as_float(t2[1] & 0xffff0000u);
                            u32x2 w; w[0] = pk2(a[0], a[1]); w[1] = pk2(a[2], a[3]); *(u32x2*)(dst + row * D + col) = w; } }
            }
    }
};
}

DEVI int tok_row(bool gdn, int dir, int b, int c, int t) {
    if (c < 4) { int p = c * 64 + t; if (dir) p = 255 - p; return MLAT + b * 256 + p; }
    int p = (c - 4) * 64 + t; if (dir) p = 4095 - p;
    const int s = gdn ? ((p & 63) * 64 + (p >> 6)) : p;
    return b * 4096 + s;
}
DEVI int pos_row(bool gdn, int b, bool isctx, int p) {
    if (isctx) { if (p < 0 || p >= 256) return -1; return MLAT + b * 256 + p; }
    if (p < 0 || p >= 4096) return -1;
    const int s = gdn ? ((p & 63) * 64 + (p >> 6)) : p;
    return b * 4096 + s;
}
DEVI int dir_chunk(int dir, int j) { return dir ? (j < 4 ? 3 - j : 71 - j) : j; }

DEVI int gu_rowmap(int s) {
    const int n = s >= DFF ? 1 : 0, a = s - n * DFF, pn = a >> 7, r = a & 127, wc = r >> 5, fq = (r >> 3) & 3, bj = (r >> 2) & 1, i = r & 3;
    return 256 * pn + 128 * bj + 32 * wc + 16 * n + 4 * fq + i;
}
DEVI void cvt_tile(const float* src, int ldsrc, int Nvalid, int k0, int n0, bf16_t* dst, int lddst, int mode, float* buf, int lane) {
    f32x4 vv[16];
#pragma unroll
    for (int it = 0; it < 16; ++it) {
        const int row = it * 4 + (lane >> 4), c4 = (lane & 15) * 4;
        vv[it] = (f32x4){0.f, 0.f, 0.f, 0.f};
        if (n0 + c4 < Nvalid) vv[it] = *(const f32x4*)(src + (size_t)(k0 + row) * ldsrc + n0 + c4);
    }
#pragma unroll
    for (int it = 0; it < 16; ++it) {
        const int row = it * 4 + (lane >> 4), c4 = (lane & 15) * 4;
        float* bp = buf + row * 65 + c4; bp[0] = vv[it][0]; bp[1] = vv[it][1]; bp[2] = vv[it][2]; bp[3] = vv[it][3];
    }
    asm volatile("s_waitcnt lgkmcnt(0)" ::: "memory"); __builtin_amdgcn_wave_barrier();
#pragma unroll 2
    for (int it = 0; it < 8; ++it) {
        const int nc = it * 8 + (lane >> 3), kk = (lane & 7) * 8;
        float f[8];
#pragma unroll
        for (int e = 0; e < 8; ++e) f[e] = buf[(kk + e) * 65 + nc];
        const int drow = mode == 1 ? gu_rowmap(n0 + nc) : (n0 + nc);
        *(u32x4*)(dst + (size_t)drow * lddst + k0 + kk) = pack8(f);
    }
    asm volatile("s_waitcnt lgkmcnt(0)" ::: "memory"); __builtin_amdgcn_wave_barrier();
}
DEVI void convert_phase(const PW& pw0, int l, unsigned char* shm_in, int gwave, int nwaves, int wid, int lane) {
    const PW p{opq64(pw0.ws)};
    unsigned char* shm = opq(shm_in);
    float* buf = (float*)shm + wid * (64 * 65);
    unsigned char* ws = p.ws;
    for (int t = gwave; t < 6880; t += nwaves) {
        int r = t;
        if (r < 2816) { const int f = r / 1408; r -= f * 1408; const int kt = r / 88, ntl = r % 88;
            cvt_tile(pin(7) + ((size_t)(l * 2 + f)) * D * 2 * DFF, 2 * DFF, 2 * DFF, kt * 64, ntl * 64, (bf16_t*)(ws + WS_WGU + f * SZ_WGU), D, 1, buf, lane); continue; }
        r -= 2816;
        if (r < 1408) { const int f = r / 704; r -= f * 704; const int kt = r / 16, ntl = r % 16;
            cvt_tile(pin(8) + ((size_t)(l * 2 + f)) * DFF * D, D, D, kt * 64, ntl * 64, (bf16_t*)(ws + WS_WDN + f * SZ_WDN), DFF, 0, buf, lane); continue; }
        r -= 1408;
        if (r < 1984) { const int kt = r / 124, ntl = r % 124;
            cvt_tile(pin(9) + (size_t)l * D * C_END, C_END, C_END, kt * 64, ntl * 64, (bf16_t*)(ws + WS_WIN), D, 0, buf, lane); continue; }
        r -= 1984;
        if (r < 384) { const int n = r / 128; r -= n * 128; const int kt = r / 16, ntl = r % 16;
            cvt_tile(pin(23) + ((size_t)(l * 3 + n)) * 512 * D, D, D, kt * 64, ntl * 64, (bf16_t*)(ws + WS_WBR) + (size_t)n * D * 512, 512, 0, buf, lane); continue; }
        r -= 384;
        if (r < 256) { const int kt = r / 16, ntl = r % 16;
            cvt_tile(pin(24) + (size_t)l * D * D, D, D, kt * 64, ntl * 64, (bf16_t*)(ws + WS_WOUT), D, 0, buf, lane); continue; }
        r -= 256;
        { const int gate = r >> 4, dn = r & 15;
            cvt_tile(pin(gate ? 16 : 14) + ((size_t)l * 16 + dn) * 4096, 64, 64, 0, 0, (bf16_t*)(ws + WS_WLRU) + (size_t)(gate * 16 + dn) * 4096, 64, 0, buf, lane); }
    }
}

DEVI void mod_phase(const PW& pw0, unsigned char* shm_in, int wv) {
    const PW p{opq64(pw0.ws)};
    unsigned char* shm = opq(shm_in);
    float* sC = (float*)shm;
    float* red = sC + 5 * 1024;
    const int tid = MYTID;
    __syncthreads();
    for (int i = tid; i < 5 * 1024; i += 512) { const int v = i >> 10, k = i & 1023; const float x = v < 4 ? pin(1)[v * 1024 + k] : pin(3)[k]; sC[i] = silu(x); }
    __syncthreads();
    float* MOD = (float*)(p.ws + WS_MOD);
    const int cgp = tid & 15, is = tid >> 4;
    for (int task = blockIdx.x; task < DEPTH * 144; task += gridDim.x) {
        const int l = task / 144, col0 = (task % 144) * 64;
        float acc[5][4];
#pragma unroll
        for (int v = 0; v < 5; ++v)
#pragma unroll
            for (int e = 0; e < 4; ++e) acc[v][e] = 0.f;
        const float* wp = pin(4) + ((size_t)l * 1024 + is * 32) * 9216 + col0 + cgp * 4;
#pragma unroll 16
        for (int r = 0; r < 32; ++r) {
            const f32x4 w = *(const f32x4*)(wp + (size_t)r * 9216);
#pragma unroll
            for (int v = 0; v < 5; ++v) { const float s = sC[v * 1024 + is * 32 + r];
#pragma unroll
                for (int e = 0; e < 4; ++e) acc[v][e] += s * w[e]; }
        }
#pragma unroll
        for (int v = 0; v < 5; ++v)
#pragma unroll
            for (int e = 0; e < 4; ++e) red[tid * 20 + v * 4 + e] = acc[v][e];
        __syncthreads();
        if (tid < 320) { const int v = tid >> 6, c = tid & 63; float s = 0.f;
            for (int k = 0; k < 32; ++k) s += red[(k * 16 + (c >> 2)) * 20 + v * 4 + (c & 3)];
            MOD[((size_t)(l * 5 + v)) * 9216 + col0 + c] = s + pin(5)[(size_t)l * 9216 + col0 + c]; }
        __syncthreads();
    }
}

DEVI void rowwise_phase(const PW& pw0, int mode, int nrows, int l, int kgate, float coef, int gpost_i, int ln, int gpre_i, int kshift, int nzc, int gwave, int nwaves, int lane, int dry = 0) {
    const PW p{opq64(pw0.ws)};
    float* X = (float*)(p.ws + WS_X); float* Xw = dry ? (float*)(p.ws + WS_GN) : X; const float* Y0 = (const float*)(p.ws + WS_Y); const float* YC = (const float*)(p.ws + WS_GB); bf16_t* H = dry ? (bf16_t*)(p.ws + WS_GU) : (bf16_t*)(p.ws + WS_H);
    const float* MOD = (const float*)(p.ws + WS_MOD);
    const int co = lane * 4;
    u32x2 yq[4]; f32x4 xq[4];
#pragma unroll
    for (int i = 0; i < 4; ++i) { yq[i] = (u32x2){0u, 0u}; xq[i] = (f32x4){0.f, 0.f, 0.f, 0.f}; }
    if (mode != 0 && gwave < nrows && gwave < MLAT) {
#pragma unroll
        for (int i = 0; i < 4; ++i) { yq[i] = *(const u32x2*)((const bf16_t*)Y0 + (size_t)gwave * D + co + 256 * i); xq[i] = *(const f32x4*)(X + (size_t)gwave * D + co + 256 * i); }
    }
    for (int row = gwave; row < nrows; row += nwaves) {
        const int v = row < MLAT ? (row >> 12) : 4;
        f32x4 x[4], y[4];
        f32x4 pg[4], pm[4], qg[4], qa[4], qs[4];
        if (mode == 0) {
            const float* src = row < MLAT ? pin(0) + (size_t)row * D : pin(2) + (size_t)(row - MLAT) * D;
#pragma unroll
            for (int i = 0; i < 4; ++i) x[i] = *(const f32x4*)(src + co + 256 * i);
        {
            const float* gp = pin(6) + ((size_t)l * 6 + gpost_i) * D; const float* gt = MOD + ((size_t)(l * 5 + v) * 9 + kgate) * D;
            const float* gq = pin(6) + ((size_t)ln * 6 + gpre_i) * D; const float* sh = MOD + ((size_t)(ln * 5 + v) * 9 + kshift) * D; const float* sc = sh + D;
#pragma unroll
            for (int i = 0; i < 4; ++i) { pg[i] = *(const f32x4*)(gp + co + 256 * i); pm[i] = *(const f32x4*)(gt + co + 256 * i);
                qg[i] = *(const f32x4*)(gq + co + 256 * i); qa[i] = *(const f32x4*)(sh + co + 256 * i); qs[i] = *(const f32x4*)(sc + co + 256 * i); }
        }
        } else {
            if (row >= MLAT) {
                const float* Y = YC + (size_t)(row - MLAT) * D;
#pragma unroll
                for (int ih = 0; ih < 2; ++ih) {
                    f32x4 t[11][2];
#pragma unroll
                    for (int z = 0; z < 11; ++z)
#pragma unroll
                        for (int i2 = 0; i2 < 2; ++i2) t[z][i2] = z < nzc ? *(const f32x4*)(Y + (size_t)z * 1024 * D + co + 256 * (ih * 2 + i2)) : (f32x4){0.f, 0.f, 0.f, 0.f};
#pragma unroll
                    for (int i2 = 0; i2 < 2; ++i2) { f32x4 a = t[0][i2];
#pragma unroll
                        for (int z = 1; z < 11; ++z) a = a + t[z][i2];
                        y[ih * 2 + i2] = a; }
                }
#pragma unroll
                for (int i = 0; i < 4; ++i) x[i] = *(const f32x4*)(X + (size_t)row * D + co + 256 * i);
            } else {
#pragma unroll
                for (int i = 0; i < 4; ++i) { const u32x2 r2 = yq[i]; x[i] = xq[i];
                    y[i] = (f32x4){__uint_as_float(r2[0] << 16), __uint_as_float(r2[0] & 0xffff0000u), __uint_as_float(r2[1] << 16), __uint_as_float(r2[1] & 0xffff0000u)}; }
            }
        {
            const float* gp = pin(6) + ((size_t)l * 6 + gpost_i) * D; const float* gt = MOD + ((size_t)(l * 5 + v) * 9 + kgate) * D;
            const float* gq = pin(6) + ((size_t)ln * 6 + gpre_i) * D; const float* sh = MOD + ((size_t)(ln * 5 + v) * 9 + kshift) * D; const float* sc = sh + D;
#pragma unroll
            for (int i = 0; i < 4; ++i) { pg[i] = *(const f32x4*)(gp + co + 256 * i); pm[i] = *(const f32x4*)(gt + co + 256 * i);
                qg[i] = *(const f32x4*)(gq + co + 256 * i); qa[i] = *(const f32x4*)(sh + co + 256 * i); qs[i] = *(const f32x4*)(sc + co + 256 * i); }
        }
            const int nxt = row + nwaves;
            if (nxt < nrows && nxt < MLAT) {
#pragma unroll
                for (int i = 0; i < 4; ++i) { yq[i] = *(const u32x2*)((const bf16_t*)Y0 + (size_t)nxt * D + co + 256 * i); xq[i] = *(const f32x4*)(X + (size_t)nxt * D + co + 256 * i); }
            }
            float ss = 0.f;
#pragma unroll
            for (int i = 0; i < 4; ++i) ss += y[i][0] * y[i][0] + y[i][1] * y[i][1] + y[i][2] * y[i][2] + y[i][3] * y[i][3];
            ss = wsum(ss); const float rs = rsqrtf(ss * (1.f / D) + EPS) * coef;
#pragma unroll
            for (int i = 0; i < 4; ++i) x[i] = x[i] + pm[i] * (y[i] * rs * pg[i]);
        }
        if (mode == 2) {
#pragma unroll
            for (int i = 0; i < 4; ++i) *(f32x4*)((float*)pin(25) + (size_t)row * D + co + 256 * i) = x[i];
            continue;
        }
#pragma unroll
        for (int i = 0; i < 4; ++i) *(f32x4*)(Xw + (size_t)row * D + co + 256 * i) = x[i];
        float ss = 0.f;
#pragma unroll
        for (int i = 0; i < 4; ++i) ss += x[i][0] * x[i][0] + x[i][1] * x[i][1] + x[i][2] * x[i][2] + x[i][3] * x[i][3];
        ss = wsum(ss); const float rs = rsqrtf(ss * (1.f / D) + EPS);
#pragma unroll
        for (int i = 0; i < 4; ++i) { const f32x4 h = x[i] * rs * qg[i] * (qs[i] + 1.f) + qa[i]; u32x2 w; w[0] = pk2(h[0], h[1]); w[1] = pk2(h[2], h[3]);
            *(u32x2*)(H + (size_t)row * D + co + 256 * i) = w; }
    }
}

DEVI void gdn_load(const bf16_t* P, const float* convw, int b, int c, int h, int dir, int want, bf16_t* sQ, bf16_t* sK, bf16_t* sKT, bf16_t* sVT, int tid) {
    const bool isctx = c < 4;
#pragma unroll
    for (int r = 0; r < 6; ++r) {
        const int task = tid + 512 * r, seg = r >> 1, rem = task & 1023, t = rem >> 4, cgp = rem & 15;
        if (seg == 0 && !(want & 1)) continue;
        if (seg == 1 && !(want & 6)) continue;
        if (seg == 2 && !(want & 8)) continue;
        int p = (isctx ? c : c - 4) * 64 + t; if (dir) p = (isctx ? 255 : 4095) - p;
        const int ch = seg * 512 + h * 128 + cgp * 8;
        float a[8];
#pragma unroll
        for (int e = 0; e < 8; ++e) a[e] = 0.f;
#pragma unroll
        for (int j = 0; j < 4; ++j) {
            const int row = pos_row(true, b, isctx, p + j - 2);
            if (row >= 0) {
                const u32x4 raw = *(const u32x4*)(P + (size_t)row * DINP + C_DNQ + ch); float x[8]; unpack8(raw, x);
                const f32x4 w0 = *(const f32x4*)(convw + j * 1536 + ch), w1 = *(const f32x4*)(convw + j * 1536 + ch + 4);
                a[0] += w0[0] * x[0]; a[1] += w0[1] * x[1]; a[2] += w0[2] * x[2]; a[3] += w0[3] * x[3];
                a[4] += w1[0] * x[4]; a[5] += w1[1] * x[5]; a[6] += w1[2] * x[6]; a[7] += w1[3] * x[7];
            }
        }
        float ss = 0.f;
#pragma unroll
        for (int e = 0; e < 8; ++e) { a[e] = silu(a[e]); ss += a[e] * a[e]; }
        if (seg < 2) {
            ss += __shfl_xor(ss, 1, 64); ss += __shfl_xor(ss, 2, 64); ss += __shfl_xor(ss, 4, 64); ss += __shfl_xor(ss, 8, 64);
            float inv = rsqrtf(ss + EPS); if (seg == 0) inv *= 0.08838834764831845f;
#pragma unroll
            for (int e = 0; e < 8; ++e) a[e] *= inv;
        }
        if (seg == 0) *(u32x4*)(sQ + t * 136 + cgp * 8) = pack8(a);
        else if (seg == 1) {
            if (want & 2) *(u32x4*)(sK + t * 136 + cgp * 8) = pack8(a);
            if (want & 4) {
#pragma unroll
                for (int e = 0; e < 8; ++e) sKT[tix(cgp * 8 + e, t)] = (bf16_t)f2bf(a[e]); }
        } else {
#pragma unroll
            for (int e = 0; e < 8; ++e) sVT[tix(cgp * 8 + e, t)] = (bf16_t)f2bf(a[e]);
        }
    }
}
struct GdnRaw { u32x4 r[4][4]; float g; };
DEVI void gdn_ld_issue(const bf16_t* P, const float* gates, int b, int c, int h, int dir, int seg_lo, GdnRaw& R, int tid) {
    const bool isctx = c < 4;
#pragma unroll
    for (int tk = 0; tk < 4; ++tk) {
        const int r = seg_lo * 2 + tk, task = tid + 512 * r, seg = r >> 1, rem = task & 1023, t = rem >> 4, cgp = rem & 15;
        int p = (isctx ? c : c - 4) * 64 + t; if (dir) p = (isctx ? 255 : 4095) - p;
        const int ch = seg * 512 + h * 128 + cgp * 8;
#pragma unroll
        for (int j = 0; j < 4; ++j) { const int row = pos_row(true, b, isctx, p + j - 2); R.r[tk][j] = (u32x4){0u, 0u, 0u, 0u};
            if (row >= 0) R.r[tk][j] = *(const u32x4*)(P + (size_t)row * DINP + C_DNQ + ch); }
    }
    R.g = 0.f; if (tid < 257) R.g = gates[tid];
}
DEVI void gdn_ld_finish(const GdnRaw& R, const float* convw, int h, int seg_lo, int want, bf16_t* sQ, bf16_t* sK, bf16_t* sKT, bf16_t* sVT, float* sc, int tid) {
#pragma unroll
    for (int tk = 0; tk < 4; ++tk) {
        const int r = seg_lo * 2 + tk, task = tid + 512 * r, seg = r >> 1, rem = task & 1023, t = rem >> 4, cgp = rem & 15;
        const int ch = seg * 512 + h * 128 + cgp * 8;
        float a[8];
#pragma unroll
        for (int e = 0; e < 8; ++e) a[e] = 0.f;
#pragma unroll
        for (int j = 0; j < 4; ++j) {
            float x[8]; unpack8(R.r[tk][j], x);
            const f32x4 w0 = *(const f32x4*)(convw + j * 1536 + ch), w1 = *(const f32x4*)(convw + j * 1536 + ch + 4);
            a[0] += w0[0] * x[0]; a[1] += w0[1] * x[1]; a[2] += w0[2] * x[2]; a[3] += w0[3] * x[3];
            a[4] += w1[0] * x[4]; a[5] += w1[1] * x[5]; a[6] += w1[2] * x[6]; a[7] += w1[3] * x[7];
        }
        float ss = 0.f;
#pragma unroll
        for (int e = 0; e < 8; ++e) { a[e] = silu(a[e]); ss += a[e] * a[e]; }
        if (seg < 2) {
            ss += __shfl_xor(ss, 1, 64); ss += __shfl_xor(ss, 2, 64); ss += __shfl_xor(ss, 4, 64); ss += __shfl_xor(ss, 8, 64);
            float inv = rsqrtf(ss + EPS); if (seg == 0) inv *= 0.08838834764831845f;
#pragma unroll
            for (int e = 0; e < 8; ++e) a[e] *= inv;
        }
        if (seg == 0) *(u32x4*)(sQ + t * 136 + cgp * 8) = pack8(a);
        else if (seg == 1) {
            if (want & 2) *(u32x4*)(sK + t * 136 + cgp * 8) = pack8(a);
            if (want & 4) {
#pragma unroll
                for (int e = 0; e < 8; ++e) sKT[tix(cgp * 8 + e, t)] = (bf16_t)f2bf(a[e]); }
        } else {
#pragma unroll
            for (int e = 0; e < 8; ++e) sVT[tix(cgp * 8 + e, t)] = (bf16_t)f2bf(a[e]);
        }
    }
    if (tid < 257) sc[tid] = R.g;
}
DEVI void gdn_gates(const PW& p, const bf16_t* P, int l, int b, int c, int h, int dir, float* sc, int lane) {
    const int row = tok_row(true, dir, b, c, lane);
    const float bb = bf2f(P[(size_t)row * DINP + C_DNBA + dir * 4 + h]), aa = bf2f(P[(size_t)row * DINP + C_DNBA + 8 + dir * 4 + h]);
    const float beta = sigm(bb);
    const float g = -__expf(pin(20)[l * 8 + dir * 4 + h]) * softplus(aa + pin(21)[l * 8 + dir * 4 + h]);
    float G = g;
#pragma unroll
    for (int o = 1; o < 64; o <<= 1) { const float t = __shfl_up(G, o, 64); if (lane >= o) G += t; }
    const float GT = __shfl(G, 63, 64);
    sc[lane] = G; sc[64 + lane] = beta; sc[128 + lane] = __expf(G); sc[192 + lane] = __expf(GT - G); if (lane == 0) sc[256] = __expf(GT);
}

DEVI void gdn_prep_all(const PW& pw0, int l, int first, int G, unsigned char* shm_in, int wv) {
    GdnRaw R;
    if (first < 2176) { const PW p{opq64(pw0.ws)}; const int tid = MYTID; const int c = first % NCH, h = (first / NCH) & 3, b = (first / (NCH * 4)) & 3, dir = first / (NCH * 16);
        gdn_ld_issue((const bf16_t*)(p.ws + WS_P), (const float*)(p.ws + WS_GATES) + (size_t)first * 320, b, c, h, dir, 1, R, tid); }
#pragma unroll 1
    for (int item = first; item < 2176; item += G) {
    const PW p{opq64(pw0.ws)};
    unsigned char* shm = opq(shm_in);
    const int tid = MYTID, wid = __builtin_amdgcn_readfirstlane(tid >> 6), lane = tid & 63, fr = lane & 15, fq = lane >> 4;
    const bf16_t* P = (const bf16_t*)(p.ws + WS_P);
    const float* GATES = (const float*)(p.ws + WS_GATES);
    const int h = (item / NCH) & 3;
    bf16_t* sK = (bf16_t*)shm;
    bf16_t* sKT = (bf16_t*)(shm + 17408);
    bf16_t* sVT = (bf16_t*)(shm + 35840);
    float* sTm = (float*)(shm + 54272);
    bf16_t* sT1 = (bf16_t*)(shm + 71680);
    bf16_t* sT2 = (bf16_t*)(shm + 80896);
    bf16_t* sWT = (bf16_t*)(shm + 90112);
    bf16_t* sUT = (bf16_t*)(shm + 108544);
    float* sc = (float*)(shm + 126976);
    gdn_ld_finish(R, pin(19) + (size_t)l * 4 * 1536, h, 1, 2 | 4 | 8, nullptr, sK, sKT, sVT, sc, tid);
    __builtin_amdgcn_sched_barrier(0);
    { const int nxt = item + G; if (nxt < 2176) { const int c2 = nxt % NCH, h2 = (nxt / NCH) & 3, b2 = (nxt / (NCH * 4)) & 3, dir2 = nxt / (NCH * 16); gdn_ld_issue(P, GATES + (size_t)nxt * 320, b2, c2, h2, dir2, 1, R, opaque(tid)); } }
    __builtin_amdgcn_sched_barrier(0);
    lbar();
#pragma unroll
    for (int ti = 0; ti < 2; ++ti) {
        const int tile = wid * 2 + ti, mt = tile >> 2, nt = tile & 3;
        f32x4 acc = (f32x4){0.f, 0.f, 0.f, 0.f};
#pragma unroll
        for (int kk = 0; kk < 4; ++kk) acc = MFMA16(ldfrag(sK, 136, mt * 16, kk * 32, lane), ldfrag(sK, 136, nt * 16, kk * 32, lane), acc);
        const int s = nt * 16 + fr;
#pragma unroll
        for (int j = 0; j < 4; ++j) { const int t = mt * 16 + fq * 4 + j; sTm[t * 68 + s] = s < t ? sc[64 + t] * acc[j] * __expf(sc[t] - sc[s]) : 0.f; }
    }
    lbar();
    float* tmpY = (float*)sWT;
    if (wid < 4) {
        const int o = wid * 16, c = lane & 15;
        int lz; asm volatile("v_mov_b32 %0, 0" : "=v"(lz));
        const float* tm = sTm + lz;
        float x[16];
#pragma unroll
        for (int t = 0; t < 16; ++t) {
            float v = -sTm[(o + t) * 68 + o + c];
#pragma unroll
            for (int s4 = 0; s4 < (t + 3) / 4; ++s4) {
                const f32x4 a = *(const f32x4*)(tm + (o + t) * 68 + o + s4 * 4);
#pragma unroll
                for (int e = 0; e < 4; ++e) if (s4 * 4 + e < t) v -= a[e] * x[s4 * 4 + e];
            }
            x[t] = v;
        }
        asm volatile("s_waitcnt lgkmcnt(0)" ::: "memory");
        if (lane < 16) {
#pragma unroll
            for (int t = 0; t < 16; ++t) sTm[(o + t) * 68 + o + c] = x[t] + (t == c ? 1.f : 0.f);
        }
    }
    lbar();
    {
        const int blk = tid >> 8, r = (tid >> 4) & 15, c = tid & 15, ib = (blk ? 3 : 1) * 16, jb = ib - 16;
        float y = 0.f;
#pragma unroll
        for (int s2 = 0; s2 < 16; ++s2) y += sTm[(ib + r) * 68 + jb + s2] * sTm[(jb + s2) * 68 + jb + c];
        tmpY[blk * 272 + r * 17 + c] = y;
        lbar();
        float z = 0.f;
#pragma unroll
        for (int s2 = 0; s2 < 16; ++s2) z += sTm[(ib + r) * 68 + ib + s2] * tmpY[blk * 272 + s2 * 17 + c];
        lbar();
        sTm[(ib + r) * 68 + jb + c] = -z;
    }
    lbar();
    {
        float y[2];
#pragma unroll
        for (int u = 0; u < 2; ++u) { const int o = tid + 512 * u, r = o >> 5, c = o & 31; float a = 0.f;
#pragma unroll 8
            for (int s2 = 0; s2 < 32; ++s2) a += sTm[(32 + r) * 68 + s2] * sTm[s2 * 68 + c];
            y[u] = a; }
#pragma unroll
        for (int u = 0; u < 2; ++u) { const int o = tid + 512 * u, r = o >> 5, c = o & 31; tmpY[r * 33 + c] = y[u]; }
        lbar();
#pragma unroll
        for (int u = 0; u < 2; ++u) { const int o = tid + 512 * u, r = o >> 5, c = o & 31; float a = 0.f;
#pragma unroll 8
            for (int s2 = 0; s2 < 32; ++s2) a += sTm[(32 + r) * 68 + 32 + s2] * tmpY[s2 * 33 + c];
            y[u] = a; }
#pragma unroll
        for (int u = 0; u < 2; ++u) { const int o = tid + 512 * u, r = o >> 5, c = o & 31; sTm[(32 + r) * 68 + c] = -y[u]; }
    }
    lbar();
#pragma unroll
    for (int u = 0; u < 8; ++u) {
        const int o = tid + 512 * u, t = o >> 6, s2 = o & 63; const float xv = sTm[t * 68 + s2], bt = sc[64 + s2];
        sT1[t * 72 + s2] = (bf16_t)f2bf(xv * bt * sc[128 + s2]); sT2[t * 72 + s2] = (bf16_t)f2bf(xv * bt);
    }
    lbar();
    bf16_t* GW = (bf16_t*)(p.ws + WS_H) + (size_t)item * 64 * 128;
    bf16_t* GU = (bf16_t*)(p.ws + WS_GU) + (size_t)item * 64 * 128;
    {
        const int tid2 = opaque(tid), lane = tid2 & 63, fr = lane & 15, fq = lane >> 4;
        const int mt = wid;
#pragma unroll
        for (int nt = 0; nt < 4; ++nt) {
            f32x4 aw = (f32x4){0.f, 0.f, 0.f, 0.f}, au = aw;
#pragma unroll
            for (int kk = 0; kk < 2; ++kk) { aw = MFMA16(ldfragT(sKT, mt * 16, kk * 32, lane), ldfrag(sT1, 72, nt * 16, kk * 32, lane), aw);
                au = MFMA16(ldfragT(sVT, mt * 16, kk * 32, lane), ldfrag(sT2, 72, nt * 16, kk * 32, lane), au); }
            const int t = nt * 16 + fr, r0 = mt * 16 + fq * 4; const float dec = sc[192 + t];
            u32x2 w; w[0] = pk2(aw[0], aw[1]); w[1] = pk2(aw[2], aw[3]); *(u32x2*)(GW + t * 128 + r0) = w;
            w[0] = pk2(au[0], au[1]); w[1] = pk2(au[2], au[3]); *(u32x2*)(GU + t * 128 + r0) = w;
#pragma unroll
            for (int j = 0; j < 4; ++j) { sWT[tix(r0 + j, t)] = (bf16_t)f2bf(aw[j] * dec); sUT[tix(r0 + j, t)] = (bf16_t)f2bf(au[j] * dec); }
        }
    }
    lbar();
    bf16_t* GB = (bf16_t*)(p.ws + WS_GB) + (size_t)item * 128 * 128;
    bf16_t* GN = (bf16_t*)(p.ws + WS_GN) + (size_t)item * 128 * 128;
    {
        const int tid2 = opaque(tid), lane = tid2 & 63, fr = lane & 15, fq = lane >> 4;
        const int mt = wid;
#pragma unroll
        for (int nt = 0; nt < 8; ++nt) {
            f32x4 ab = (f32x4){0.f, 0.f, 0.f, 0.f}, an = ab;
#pragma unroll
            for (int kk = 0; kk < 2; ++kk) { ab = MFMA16(ldfragT(sWT, mt * 16, kk * 32, lane), ldfragT(sKT, nt * 16, kk * 32, lane), ab);
                an = MFMA16(ldfragT(sKT, mt * 16, kk * 32, lane), ldfragT(sUT, nt * 16, kk * 32, lane), an); }
            const int cc = nt * 16 + fr, r0 = mt * 16 + fq * 4;
            u32x2 w; w[0] = pk2(-ab[0], -ab[1]); w[1] = pk2(-ab[2], -ab[3]); *(u32x2*)(GB + cc * 128 + r0) = w;
            w[0] = pk2(an[0], an[1]); w[1] = pk2(an[2], an[3]); *(u32x2*)(GN + cc * 128 + r0) = w;
        }
    }
    if (tid == 0) ((float*)(p.ws + WS_SM + SM_GDEC))[item] = sc[256];
    lbar();
    }
}

DEVI void gdn_seq_unit(const PW& pw0, int unit, unsigned char* shm_in, int wv) {
    const PW p{opq64(pw0.ws)};
    unsigned char* shm = opq(shm_in);
    const int tid = MYTID, wid = __builtin_amdgcn_readfirstlane(tid >> 6), lane = tid & 63, fr = lane & 15, fq = lane >> 4;
    const int chain = unit >> 3, es = unit & 7;
    bf16_t* sS = (bf16_t*)shm;
    const bf16_t* GB = (const bf16_t*)(p.ws + WS_GB) + (size_t)chain * NCH * 16384;
    bf16_t* GN = (bf16_t*)(p.ws + WS_GN) + (size_t)chain * NCH * 16384;
    const float* GDEC = (const float*)(p.ws + WS_SM + SM_GDEC) + chain * NCH;
    f32x4 acc = (f32x4){0.f, 0.f, 0.f, 0.f};
    constexpr int PF = 4;
    bf16x8 an[PF][4]; u32x2 nn[PF]; float dn[PF];
    const size_t aoff = (size_t)(wid * 16 + fr) * 128 + fq * 8, noff = (size_t)(es * 16 + fr) * 128 + wid * 16 + fq * 4;
#pragma unroll
    for (int u = 0; u < PF; ++u) {
#pragma unroll
        for (int kk = 0; kk < 4; ++kk) an[u][kk] = *(const bf16x8*)(GB + (size_t)u * 16384 + aoff + kk * 32);
        nn[u] = *(const u32x2*)(GN + (size_t)u * 16384 + noff); dn[u] = GDEC[u];
    }
#pragma unroll 1
    for (int c0 = 0; c0 < NCH; c0 += PF) {
#pragma unroll
        for (int u = 0; u < PF; ++u) {
            const int c = c0 + u;
            bf16x8 a[4]; const u32x2 ncur = nn[u]; const float dcur = dn[u];
#pragma unroll
            for (int kk = 0; kk < 4; ++kk) a[kk] = an[u][kk];
            u32x2 sw; sw[0] = pk2(acc[0], acc[1]); sw[1] = pk2(acc[2], acc[3]);
            bf16_t* sb = sS + (c & 1) * (16 * 136);
            *(u32x2*)(sb + fr * 136 + wid * 16 + fq * 4) = sw;
            *(u32x2*)(GN + (size_t)c * 16384 + noff) = sw;
            if (c + PF < NCH) {
#pragma unroll
                for (int kk = 0; kk < 4; ++kk) an[u][kk] = *(const bf16x8*)(GB + (size_t)(c + PF) * 16384 + aoff + kk * 32);
                nn[u] = *(const u32x2*)(GN + (size_t)(c + PF) * 16384 + noff); dn[u] = GDEC[c + PF];
            }
            lbar();
            acc[0] = dcur * acc[0] + __uint_as_float(ncur[0] << 16); acc[1] = dcur * acc[1] + __uint_as_float(ncur[0] & 0xffff0000u);
            acc[2] = dcur * acc[2] + __uint_as_float(ncur[1] << 16); acc[3] = dcur * acc[3] + __uint_as_float(ncur[1] & 0xffff0000u);
#pragma unroll
            for (int kk = 0; kk < 4; ++kk) acc = MFMA16(a[kk], ldfrag(sb, 136, 0, kk * 32, lane), acc);
        }
    }
    lbar();
}

struct GdnOutRaw { GdnRaw L; u32x4 st[4]; u32x4 w[2]; u32x2 ur[4]; };
DEVI void gdn_out_issue(const PW& p, int item, int dir, GdnOutRaw& R, int tid) {
    const int lane = tid & 63, fr = lane & 15, fq = lane >> 4, wid = tid >> 6;
    const int j = item % NCH, h = (item / NCH) & 3, b = item / (NCH * 4);
    const int c = dir_chunk(dir, j);
    const int it2 = ((dir * 4 + b) * 4 + h) * NCH + c;
    gdn_ld_issue((const bf16_t*)(p.ws + WS_P), (const float*)(p.ws + WS_GATES) + (size_t)it2 * 320, b, c, h, dir, 0, R.L, tid);
    const bf16_t* GS = (const bf16_t*)(p.ws + WS_GN) + (size_t)it2 * 16384;
    const bf16_t* GW = (const bf16_t*)(p.ws + WS_H) + (size_t)it2 * 8192;
    const bf16_t* GU = (const bf16_t*)(p.ws + WS_GU) + (size_t)it2 * 8192;
#pragma unroll
    for (int r = 0; r < 4; ++r) { const int idx = tid + 512 * r, row = idx >> 4, cg8 = (idx & 15) * 8; R.st[r] = *(const u32x4*)(GS + row * 128 + cg8); }
#pragma unroll
    for (int r = 0; r < 2; ++r) { const int idx = tid + 512 * r, row = idx >> 4, cg8 = (idx & 15) * 8; R.w[r] = *(const u32x4*)(GW + row * 128 + cg8); }
#pragma unroll
    for (int nt = 0; nt < 4; ++nt) R.ur[nt] = *(const u32x2*)(GU + (nt * 16 + fr) * 128 + wid * 16 + fq * 4);
}
DEVI void gdn_out_all(const PW& pw0, int l, int first, int G, bool skipctx, unsigned char* shm_in, int wv) {
    const int dry = 0;
    GdnOutRaw R;
    int item = first;
    while (item < 1088 && skipctx && (item % NCH) < 4) item += G;
    if (item < 1088) { const PW p{opq64(pw0.ws)}; gdn_out_issue(p, item, 0, R, MYTID); }
#pragma unroll 1
    while (item < 1088) {
    int nitem = item + G;
    while (nitem < 1088 && skipctx && (nitem % NCH) < 4) nitem += G;
#pragma unroll 1
    for (int dir = 0; dir < 2; ++dir) {
        const PW p{opq64(pw0.ws)};
        unsigned char* shm = opq(shm_in);
        const int tid = MYTID, wid = __builtin_amdgcn_readfirstlane(tid >> 6), lane = tid & 63, fr = lane & 15, fq = lane >> 4;
        const int j = item % NCH, h = (item / NCH) & 3, b = item / (NCH * 4);
        bf16_t* P = (bf16_t*)(p.ws + WS_P);
        bf16_t* sQ = (bf16_t*)shm;
        bf16_t* sK = (bf16_t*)(shm + 17408);
        bf16_t* sST = (bf16_t*)(shm + 34816);
        bf16_t* sW = (bf16_t*)(shm + 69632);
        bf16_t* sVN = (bf16_t*)(shm + 87040);
        bf16_t* sA2 = (bf16_t*)(shm + 105472);
        float* sO = (float*)(shm + 114688);
        float* sc = (float*)(shm + 148480);
        gdn_ld_finish(R.L, pin(19) + (size_t)l * 4 * 1536, h, 0, 1 | 2, sQ, sK, nullptr, nullptr, sc, tid);
#pragma unroll
        for (int r = 0; r < 4; ++r) { const int idx = tid + 512 * r, row = idx >> 4, cg8 = (idx & 15) * 8; *(u32x4*)(sST + row * 136 + cg8) = R.st[r]; }
#pragma unroll
        for (int r = 0; r < 2; ++r) { const int idx = tid + 512 * r, row = idx >> 4, cg8 = (idx & 15) * 8; *(u32x4*)(sW + row * 136 + cg8) = R.w[r]; }
        u32x2 ur4[4];
#pragma unroll
        for (int nt = 0; nt < 4; ++nt) ur4[nt] = R.ur[nt];
        __builtin_amdgcn_sched_barrier(0);
        if (dir == 0) gdn_out_issue(p, item, 1, R, opaque(tid)); else if (nitem < 1088) gdn_out_issue(p, nitem, 0, R, opaque(tid));
        __builtin_amdgcn_sched_barrier(0);
        lbar();
        {
            const int mt = wid;
#pragma unroll
            for (int nt = 0; nt < 4; ++nt) {
                const u32x2 ur = ur4[nt];
                f32x4 a = (f32x4){0.f, 0.f, 0.f, 0.f};
#pragma unroll
                for (int kk = 0; kk < 4; ++kk) a = MFMA16(ldfrag(sST, 136, mt * 16, kk * 32, lane), ldfrag(sW, 136, nt * 16, kk * 32, lane), a);
                const int t = nt * 16 + fr, e0 = mt * 16 + fq * 4;
                sVN[(e0 + 0) * 72 + t] = (bf16_t)f2bf(__uint_as_float(ur[0] << 16) - a[0]); sVN[(e0 + 1) * 72 + t] = (bf16_t)f2bf(__uint_as_float(ur[0] & 0xffff0000u) - a[1]);
                sVN[(e0 + 2) * 72 + t] = (bf16_t)f2bf(__uint_as_float(ur[1] << 16) - a[2]); sVN[(e0 + 3) * 72 + t] = (bf16_t)f2bf(__uint_as_float(ur[1] & 0xffff0000u) - a[3]);
            }
#pragma unroll
            for (int ti = 0; ti < 2; ++ti) {
                const int tile = wid * 2 + ti, m2 = tile >> 2, n2 = tile & 3;
                f32x4 a = (f32x4){0.f, 0.f, 0.f, 0.f};
#pragma unroll
                for (int kk = 0; kk < 4; ++kk) a = MFMA16(ldfrag(sQ, 136, m2 * 16, kk * 32, lane), ldfrag(sK, 136, n2 * 16, kk * 32, lane), a);
                const int s = n2 * 16 + fr;
#pragma unroll
                for (int jj = 0; jj < 4; ++jj) { const int t = m2 * 16 + fq * 4 + jj; sA2[t * 72 + s] = (bf16_t)f2bf(s <= t ? a[jj] * __expf(sc[t] - sc[s]) : 0.f); }
            }
        }
        lbar();
        {
            const int nt = wid;
#pragma unroll
            for (int mt = 0; mt < 4; ++mt) {
                f32x4 a = (f32x4){0.f, 0.f, 0.f, 0.f};
#pragma unroll
                for (int kk = 0; kk < 4; ++kk) a = MFMA16(ldfrag(sQ, 136, mt * 16, kk * 32, lane), ldfrag(sST, 136, nt * 16, kk * 32, lane), a);
#pragma unroll
                for (int jj = 0; jj < 4; ++jj) a[jj] *= sc[128 + mt * 16 + fq * 4 + jj];
#pragma unroll
                for (int kk = 0; kk < 2; ++kk) a = MFMA16(ldfrag(sA2, 72, mt * 16, kk * 32, lane), ldfrag(sVN, 72, nt * 16, kk * 32, lane), a);
                const int e = nt * 16 + fr;
#pragma unroll
                for (int jj = 0; jj < 4; ++jj) { const int t = mt * 16 + fq * 4 + jj; const int i = dir ? 63 - t : t; if (dir) sO[i * 132 + e] += a[jj]; else sO[i * 132 + e] = a[jj]; }
            }
        }
        lbar();
    }
    {
        const PW p{opq64(pw0.ws)};
        unsigned char* shm = opq(shm_in);
        const int tid = MYTID;
        const int j = item % NCH, h = (item / NCH) & 3, b = item / (NCH * 4);
        bf16_t* P = (bf16_t*)(p.ws + WS_P);
        float* sO = (float*)(shm + 114688);
    {
        const int i = tid >> 3, e0 = (tid & 7) * 16;
        float v[16], ss = 0.f;
#pragma unroll
        for (int e = 0; e < 16; ++e) { v[e] = sO[i * 132 + e0 + e]; ss += v[e] * v[e]; }
        ss += __shfl_xor(ss, 1, 64); ss += __shfl_xor(ss, 2, 64); ss += __shfl_xor(ss, 4, 64);
        const float rs = rsqrtf(ss * (1.f / 128.f) + EPS);
        const int row = tok_row(true, 0, b, j, i);
        bf16_t* zp = P + (size_t)row * DINP + C_DNZ + h * 128 + e0;
        const float* g = pin(22) + l * 128 + e0;
#pragma unroll
        for (int half = 0; half < 2; ++half) {
            float z[8]; unpack8(*(const u32x4*)(zp + half * 8), z); float o[8];
#pragma unroll
            for (int e = 0; e < 8; ++e) o[e] = v[half * 8 + e] * rs * g[half * 8 + e] * z[e];
            bf16_t* zd = dry ? (bf16_t*)(p.ws + WS_GB) + (size_t)row * 512 + h * 128 + e0 : zp;
            *(u32x4*)(zd + half * 8) = pack8(o);
        }
    }
    lbar();
    }
    item = nitem;
    }
}

DEVI float ml_gates(const PW& p, const bf16_t* P, int l, int b, int c, int h, int dir, float* sc, int lane) {
    const int row = tok_row(false, dir, b, c, lane);
    const float ig = bf2f(P[(size_t)row * DINP + C_MLG + dir * 4 + h]) + pin(10)[l * 16 + dir * 4 + h];
    const float fg = bf2f(P[(size_t)row * DINP + C_MLG + (2 + dir) * 4 + h]) + pin(10)[l * 16 + (2 + dir) * 4 + h];
    float bb = logsig(fg);
#pragma unroll
    for (int o = 1; o < 64; o <<= 1) { const float t = __shfl_up(bb, o, 64); if (lane >= o) bb += t; }
    sc[lane] = bb; sc[64 + lane] = ig;
    return __shfl(bb, 63, 64);
}
struct MlPrepRaw { u32x4 k; u32x4 v[2]; float w[2]; float g; };
DEVI void ml_prep_issue(const PW& p, int item, MlPrepRaw& R, int tid) {
    const int c = item % NCH, h = (item / NCH) & 3, b = (item / (NCH * 4)) & 3, dir = item / (NCH * 16);
    const bf16_t* P = (const bf16_t*)(p.ws + WS_P);
    const float* gp = (const float*)(p.ws + WS_GATES) + (size_t)(2176 + item) * 320;
    { const int t = tid >> 3, cg8 = (tid & 7) * 8; const int row = tok_row(false, dir, b, c, t); R.k = *(const u32x4*)(P + (size_t)row * DINP + C_MLK + h * 64 + cg8); }
#pragma unroll
    for (int r = 0; r < 2; ++r) { const int idx = tid + 512 * r, t = idx >> 4, cg8 = (idx & 15) * 8; const int row = tok_row(false, dir, b, c, t);
        R.v[r] = *(const u32x4*)(P + (size_t)row * DINP + C_MLV + h * 128 + cg8); R.w[r] = gp[128 + t]; }
    R.g = gp[128 + (tid & 63)];
}
DEVI void ml_prep_all(const PW& pw0, int l, int first, int G, unsigned char* shm_in, int wv) {
    MlPrepRaw R;
    if (first < 2176) { const PW p{opq64(pw0.ws)}; ml_prep_issue(p, first, R, MYTID); }
#pragma unroll 1
    for (int item = first; item < 2176; item += G) {
    const PW p{opq64(pw0.ws)};
    unsigned char* shm = opq(shm_in);
    const int tid = MYTID, wid = __builtin_amdgcn_readfirstlane(tid >> 6), lane = tid & 63, fr = lane & 15, fq = lane >> 4;
    bf16_t* sKT = (bf16_t*)shm;
    bf16_t* sVT = (bf16_t*)(shm + 9216);
    float* sc = (float*)(shm + 27648);
    if (tid < 64) sc[128 + tid] = R.g;
    {
        const int t = tid >> 3, cg8 = (tid & 7) * 8;
        float x[8]; unpack8(R.k, x);
#pragma unroll
        for (int e = 0; e < 8; ++e) sKT[tix(cg8 + e, t)] = (bf16_t)f2bf(x[e]);
    }
#pragma unroll
    for (int r = 0; r < 2; ++r) {
        const int idx = tid + 512 * r, t = idx >> 4, cg8 = (idx & 15) * 8;
        float x[8]; unpack8(R.v[r], x); const float w = R.w[r];
#pragma unroll
        for (int e = 0; e < 8; ++e) sVT[tix(cg8 + e, t)] = (bf16_t)f2bf(x[e] * w);
    }
    __builtin_amdgcn_sched_barrier(0);
    if (item + G < 2176) ml_prep_issue(p, item + G, R, opaque(tid));
    __builtin_amdgcn_sched_barrier(0);
    lbar();
    float* KV = (float*)(p.ws + WS_Y) + (size_t)item * 8192;
    {
        const int nt = wid;
#pragma unroll
        for (int mt = 0; mt < 4; ++mt) {
            f32x4 a = (f32x4){0.f, 0.f, 0.f, 0.f};
#pragma unroll
            for (int kk = 0; kk < 2; ++kk) a = MFMA16(ldfragT(sKT, mt * 16, kk * 32, lane), ldfragT(sVT, nt * 16, kk * 32, lane), a);
            *(f32x4*)(KV + (nt * 16 + fr) * 64 + mt * 16 + fq * 4) = a;
        }
    }
    {
        const int d = tid >> 3, t0 = (tid & 7) * 8; float s = 0.f;
#pragma unroll
        for (int t = 0; t < 8; ++t) s += sc[128 + t0 + t] * bf2f(sKT[tix(d, t0 + t)]);
        s += __shfl_xor(s, 1, 64); s += __shfl_xor(s, 2, 64); s += __shfl_xor(s, 4, 64);
        if ((tid & 7) == 0) ((float*)(p.ws + WS_SM + SM_MN))[item * 64 + d] = s; }
    lbar();
    }
}
DEVI void ml_seq(const PW& pw0, int gtid, int nthreads) {
    const PW p{opq64(pw0.ws)};
    const float* MSC = (const float*)(p.ws + WS_SM + SM_MSC);
    float* MM = (float*)(p.ws + WS_SM + SM_MM);
    for (int g = gtid; g < 32 * 4096 + 32 * 32; g += nthreads) {
        const bool isn = g >= 32 * 4096; const int gg = isn ? g - 32 * 4096 : g;
        const int chain = isn ? gg >> 5 : gg >> 12, e2 = isn ? gg & 31 : gg & 4095;
        float* base = isn ? (float*)(p.ws + WS_SM + SM_MN) + (size_t)chain * NCH * 64 + e2 * 2 : (float*)(p.ws + WS_Y) + (size_t)chain * NCH * 8192 + e2 * 2;
        const int stride = isn ? 64 : 8192;
        float m = 0.f; f32x2 C = (f32x2){0.f, 0.f};
        for (int c0 = 0; c0 < NCH; c0 += 17) {
            f32x2 kv[17]; f32x2 sc[17];
#pragma unroll
            for (int u = 0; u < 17; ++u) { kv[u] = *(const f32x2*)(base + (size_t)(c0 + u) * stride); sc[u] = *(const f32x2*)(MSC + (chain * NCH + c0 + u) * 2); }
#pragma unroll
            for (int u = 0; u < 17; ++u) {
                *(f32x2*)(base + (size_t)(c0 + u) * stride) = C;
                if (!isn && e2 == 0) MM[chain * NCH + c0 + u] = m;
                const float mn = fmaxf(sc[u][0] + m, sc[u][1]);
                const float a = __expf(sc[u][0] + m - mn), s = __expf(sc[u][1] - mn);
                C = C * a + kv[u] * s; m = mn;
            }
        }
    }
}
struct MlOutRaw { u32x4 q, k, v[2]; f32x4 ct[4]; float gb, gi, gpm, m, n; };
DEVI void ml_out_issue(const PW& p, int item, int dir, MlOutRaw& R, int tid) {
    const int lane = tid & 63;
    const int j = item % NCH, h = (item / NCH) & 3, b = item / (NCH * 4);
    const int c = dir_chunk(dir, j);
    const int it2 = ((dir * 4 + b) * 4 + h) * NCH + c;
    const bf16_t* P = (const bf16_t*)(p.ws + WS_P);
    { const int t = tid >> 3, cg8 = (tid & 7) * 8; const int row = tok_row(false, dir, b, c, t);
      R.q = *(const u32x4*)(P + (size_t)row * DINP + C_MLQ + h * 64 + cg8); R.k = *(const u32x4*)(P + (size_t)row * DINP + C_MLK + h * 64 + cg8); }
#pragma unroll
    for (int r = 0; r < 2; ++r) { const int idx = tid + 512 * r, t = idx >> 4, cg8 = (idx & 15) * 8; const int row = tok_row(false, dir, b, c, t);
        R.v[r] = *(const u32x4*)(P + (size_t)row * DINP + C_MLV + h * 128 + cg8); }
    const float* CT = (const float*)(p.ws + WS_Y) + (size_t)it2 * 8192;
#pragma unroll
    for (int r = 0; r < 4; ++r) { const int idx = tid + 512 * r, e = idx >> 4, d4 = (idx & 15) * 4; R.ct[r] = *(const f32x4*)(CT + e * 64 + d4); }
    const float* gp = (const float*)(p.ws + WS_GATES) + (size_t)(2176 + it2) * 320;
    R.gb = gp[lane]; R.gi = gp[64 + lane]; R.gpm = gp[192 + lane];
    R.m = ((const float*)(p.ws + WS_SM + SM_MM))[it2]; R.n = ((const float*)(p.ws + WS_SM + SM_MN))[it2 * 64 + lane];
}
DEVI void ml_out_all(const PW& pw0, int l, int first, int G, bool skipctx, unsigned char* shm_in, int wv) {
    const int dry = 0;
    MlOutRaw R;
    int item = first;
    while (item < 1088 && skipctx && (item % NCH) < 4) item += G;
    if (item < 1088) { const PW p{opq64(pw0.ws)}; ml_out_issue(p, item, 0, R, MYTID); }
#pragma unroll 1
    while (item < 1088) {
    int nitem = item + G;
    while (nitem < 1088 && skipctx && (nitem % NCH) < 4) nitem += G;
#pragma unroll 1
    for (int dir = 0; dir < 2; ++dir) {
        const PW p{opq64(pw0.ws)};
        unsigned char* shm = opq(shm_in);
        const int tid = MYTID, wid = __builtin_amdgcn_readfirstlane(tid >> 6), lane = tid & 63, fr = lane & 15, fq = lane >> 4;
        bf16_t* sQ = (bf16_t*)shm;
        bf16_t* sK = (bf16_t*)(shm + 9216);
        bf16_t* sVT = (bf16_t*)(shm + 18432);
        bf16_t* sCT = (bf16_t*)(shm + 36864);
        bf16_t* sS = (bf16_t*)(shm + 55296);
        float* sO = (float*)(shm + 64512);
        float* sc = (float*)(shm + 98304);
        if (wid == 0) {
            const float m = R.m, bb = R.gb, pm = R.gpm;
            sc[lane] = bb; sc[64 + lane] = R.gi;
            const float mt = bb + fmaxf(m, pm);
            sc[128 + lane] = mt; sc[192 + lane] = __expf(bb + m - mt);
            sc[320 + lane] = R.n;
        }
        {
            const int t = tid >> 3, cg8 = (tid & 7) * 8;
            float x[8]; unpack8(R.q, x);
#pragma unroll
            for (int e = 0; e < 8; ++e) x[e] *= 0.125f;
            *(u32x4*)(sQ + t * 72 + cg8) = pack8(x);
            *(u32x4*)(sK + t * 72 + cg8) = R.k;
        }
#pragma unroll
        for (int r = 0; r < 2; ++r) {
            const int idx = tid + 512 * r, t = idx >> 4, cg8 = (idx & 15) * 8;
            float x[8]; unpack8(R.v[r], x);
#pragma unroll
            for (int e = 0; e < 8; ++e) sVT[tix(cg8 + e, t)] = (bf16_t)f2bf(x[e]);
        }
#pragma unroll
        for (int r = 0; r < 4; ++r) { const int idx = tid + 512 * r, e = idx >> 4, d4 = (idx & 15) * 4; const f32x4 v = R.ct[r];
            u32x2 w; w[0] = pk2(v[0], v[1]); w[1] = pk2(v[2], v[3]); *(u32x2*)(sCT + e * 72 + d4) = w; }
        __builtin_amdgcn_sched_barrier(0);
        if (dir == 0) ml_out_issue(p, item, 1, R, opaque(tid)); else if (nitem < 1088) ml_out_issue(p, nitem, 0, R, opaque(tid));
        __builtin_amdgcn_sched_barrier(0);
        lbar();
#pragma unroll
        for (int ti = 0; ti < 2; ++ti) {
            const int tile = wid * 2 + ti, m2 = tile >> 2, n2 = tile & 3;
            f32x4 a = (f32x4){0.f, 0.f, 0.f, 0.f};
#pragma unroll
            for (int kk = 0; kk < 2; ++kk) a = MFMA16(ldfrag(sQ, 72, m2 * 16, kk * 32, lane), ldfrag(sK, 72, n2 * 16, kk * 32, lane), a);
            const int s = n2 * 16 + fr;
#pragma unroll
            for (int jj = 0; jj < 4; ++jj) { const int t = m2 * 16 + fq * 4 + jj;
                sS[t * 72 + s] = (bf16_t)f2bf(s <= t ? a[jj] * __expf(sc[t] - sc[s] + sc[64 + s] - sc[128 + t]) : 0.f); }
        }
        lbar();
        {
            const int t = tid >> 3, s0 = (tid & 7) * 8; float ds = 0.f, qn = 0.f;
#pragma unroll
            for (int s2 = 0; s2 < 8; ++s2) { ds += bf2f(sS[t * 72 + s0 + s2]); qn += bf2f(sQ[t * 72 + s0 + s2]) * sc[320 + s0 + s2]; }
            ds += __shfl_xor(ds, 1, 64); ds += __shfl_xor(ds, 2, 64); ds += __shfl_xor(ds, 4, 64);
            qn += __shfl_xor(qn, 1, 64); qn += __shfl_xor(qn, 2, 64); qn += __shfl_xor(qn, 4, 64);
            const float den = ds + sc[192 + t] * qn;
            if ((tid & 7) == 0) sc[256 + t] = 1.f / fmaxf(fabsf(den), __expf(-sc[128 + t]));
        }
        lbar();
        {
            const int nt = wid;
#pragma unroll
            for (int mt = 0; mt < 4; ++mt) {
                f32x4 a = (f32x4){0.f, 0.f, 0.f, 0.f};
#pragma unroll
                for (int kk = 0; kk < 2; ++kk) a = MFMA16(ldfrag(sQ, 72, mt * 16, kk * 32, lane), ldfrag(sCT, 72, nt * 16, kk * 32, lane), a);
#pragma unroll
                for (int jj = 0; jj < 4; ++jj) a[jj] *= sc[192 + mt * 16 + fq * 4 + jj];
#pragma unroll
                for (int kk = 0; kk < 2; ++kk) a = MFMA16(ldfrag(sS, 72, mt * 16, kk * 32, lane), ldfragT(sVT, nt * 16, kk * 32, lane), a);
                const int e = nt * 16 + fr;
#pragma unroll
                for (int jj = 0; jj < 4; ++jj) { const int t = mt * 16 + fq * 4 + jj; const int i = dir ? 63 - t : t; const float hv = a[jj] * sc[256 + t];
                    if (dir) sO[i * 132 + e] += hv; else sO[i * 132 + e] = hv; }
            }
        }
        lbar();
    }
    {
        const PW p{opq64(pw0.ws)};
        unsigned char* shm = opq(shm_in);
        const int tid = MYTID;
        const int j = item % NCH, h = (item / NCH) & 3, b = item / (NCH * 4);
        bf16_t* P = (bf16_t*)(p.ws + WS_P);
        float* sO = (float*)(shm + 64512);
    {
        const int i = tid >> 3, e0 = (tid & 7) * 16;
        float v[16], ss = 0.f;
#pragma unroll
        for (int e = 0; e < 16; ++e) { v[e] = sO[i * 132 + e0 + e]; ss += v[e] * v[e]; }
        ss += __shfl_xor(ss, 1, 64); ss += __shfl_xor(ss, 2, 64); ss += __shfl_xor(ss, 4, 64);
        const float rs = rsqrtf(ss * (1.f / 128.f) + EPS);
        const int row = tok_row(false, 0, b, j, i);
        bf16_t* op = P + (size_t)row * DINP + C_MLO + h * 128 + e0;
        const float* g = pin(11) + l * 512 + h * 128 + e0;
#pragma unroll
        for (int half = 0; half < 2; ++half) {
            float z[8]; unpack8(*(const u32x4*)(op + half * 8), z); float o[8];
#pragma unroll
            for (int e = 0; e < 8; ++e) o[e] = v[half * 8 + e] * rs * g[half * 8 + e] * z[e];
            bf16_t* od = dry ? (bf16_t*)(p.ws + WS_GB) + (size_t)row * 512 + h * 128 + e0 : op;
            *(u32x4*)(od + half * 8) = pack8(o);
        }
    }
    lbar();
    }
    item = nitem;
    }
}

DEVI void lru_item(const PW& pw0, int l, int item, int mode, unsigned char* shm_in, int wv, int dry = 0) {
    const PW p{opq64(pw0.ws)};
    unsigned char* shm = opq(shm_in);
    const int tid = MYTID, wid = __builtin_amdgcn_readfirstlane(tid >> 6), lane = tid & 63, fr = lane & 15, fq = lane >> 4;
    const int n4 = item & 3, j = (item >> 2) % NCH, b = (item >> 2) / NCH; const bool isctx = j < 4;
    bf16_t* P = (bf16_t*)(p.ws + WS_P);
    bf16_t* sX = (bf16_t*)shm;
    const int p0 = (isctx ? j : j - 4) * 64;
    const float* cw = pin(12) + (size_t)l * 4 * 512; const float* cb = pin(13) + (size_t)l * 512;
    {
        const int ch = lane * 8, i0 = wid * 8;
        f32x4 w[4][2];
#pragma unroll
        for (int jj = 0; jj < 4; ++jj) { w[jj][0] = *(const f32x4*)(cw + jj * 512 + ch); w[jj][1] = *(const f32x4*)(cw + jj * 512 + ch + 4); }
        const f32x4 b0 = *(const f32x4*)(cb + ch), b1 = *(const f32x4*)(cb + ch + 4);
        u32x4 raw[11];
#pragma unroll
        for (int r = 0; r < 11; ++r) { const int row = pos_row(false, b, isctx, p0 + i0 + r - 2);
            raw[r] = (u32x4){0u, 0u, 0u, 0u}; if (row >= 0) raw[r] = *(const u32x4*)(P + (size_t)row * DINP + C_LRX + ch); }
#pragma unroll
        for (int i = 0; i < 8; ++i) {
            float a[8] = {b0[0], b0[1], b0[2], b0[3], b1[0], b1[1], b1[2], b1[3]};
#pragma unroll
            for (int jj = 0; jj < 4; ++jj) { float x[8]; unpack8(raw[i + jj], x);
#pragma unroll
                for (int e = 0; e < 4; ++e) { a[e] += w[jj][0][e] * x[e]; a[4 + e] += w[jj][1][e] * x[4 + e]; } }
            *(u32x4*)(sX + (i0 + i) * 520 + ch) = pack8(a);
        }
    }
    lbar();
    const int blk = wid;
    const bf16_t* WL = (const bf16_t*)(p.ws + WS_WLRU);
    float* LAGG = (float*)(p.ws + WS_SM + SM_LAGG);
    {
        const int ch = blk * 64 + n4 * 16 + fr;
        float hsum[4][4];
#pragma unroll
        for (int mt = 0; mt < 4; ++mt)
#pragma unroll
            for (int jj = 0; jj < 4; ++jj) hsum[mt][jj] = 0.f;
#pragma unroll
        for (int dir = 0; dir < 2; ++dir) {
            const bf16_t* wa = WL + (size_t)(0 * 16 + dir * 8 + blk) * 4096 + (n4 * 16 + fr) * 64 + fq * 8;
            const bf16_t* wx = WL + (size_t)(1 * 16 + dir * 8 + blk) * 4096 + (n4 * 16 + fr) * 64 + fq * 8;
            bf16x8 ba[2], bx[2];
#pragma unroll
            for (int kk = 0; kk < 2; ++kk) { ba[kk] = *(const bf16x8*)(wa + kk * 32); bx[kk] = *(const bf16x8*)(wx + kk * 32); }
            const int c = dir_chunk(dir, j);
            const size_t aidx = (((size_t)dir * 4 + b) * NCH + c) * 512 + ch;
            const float hin0 = mode ? LAGG[aidx * 2] : 0.f;
            const float bias_a = pin(15)[(size_t)l * 1024 + dir * 512 + ch], bias_x = pin(17)[(size_t)l * 1024 + dir * 512 + ch];
            const float cl = -8.f * softplus(-pin(18)[(size_t)l * 1024 + dir * 512 + ch]);
            float av[4][4], bv[4][4];
#pragma unroll
            for (int mt = 0; mt < 4; ++mt) {
                f32x4 aa = (f32x4){0.f, 0.f, 0.f, 0.f}, ax = aa;
#pragma unroll
                for (int kk = 0; kk < 2; ++kk) { const bf16x8 af = ldfrag(sX, 520, mt * 16, blk * 64 + kk * 32, lane); aa = MFMA16(af, ba[kk], aa); ax = MFMA16(af, bx[kk], ax); }
#pragma unroll
                for (int jj = 0; jj < 4; ++jj) {
                    const int t = mt * 16 + fq * 4 + jj;
                    const float rr = sigm(aa[jj] + bias_a), ii = sigm(ax[jj] + bias_x), la = cl * rr;
                    const float ea = __expf(la);
                    av[mt][jj] = ea;
                    bv[mt][jj] = __builtin_amdgcn_sqrtf(fmaxf(1.f - ea * ea, 0.f)) * ii * bf2f(sX[t * 520 + ch]);
                }
            }
            float hin = hin0;
            float Pc = 1.f, Hc = 0.f;
#pragma unroll
            for (int mi = 0; mi < 4; ++mi) {
                const int mt = dir ? 3 - mi : mi;
                float Pl = 1.f, Hl = 0.f;
#pragma unroll
                for (int ji = 0; ji < 4; ++ji) { const int jj = dir ? 3 - ji : ji; Pl = av[mt][jj] * Pl; Hl = av[mt][jj] * Hl + bv[mt][jj]; }
                float Pq[4], Hq[4];
#pragma unroll
                for (int q = 0; q < 4; ++q) { Pq[q] = __shfl(Pl, fr + 16 * q, 64); Hq[q] = __shfl(Hl, fr + 16 * q, 64); }
                if (mode == 0) {
#pragma unroll
                    for (int qi = 0; qi < 4; ++qi) { const int q = dir ? 3 - qi : qi; Hc = Pq[q] * Hc + Hq[q]; Pc = Pq[q] * Pc; }
                } else {
                    float hh = hin;
                    float hme = hin;
#pragma unroll
                    for (int qi = 0; qi < 4; ++qi) { const int q = dir ? 3 - qi : qi; if (q == fq) hme = hh; hh = Pq[q] * hh + Hq[q]; }
                    hin = hh;
#pragma unroll
                    for (int ji = 0; ji < 4; ++ji) { const int jj = dir ? 3 - ji : ji; hme = av[mt][jj] * hme + bv[mt][jj]; hsum[mt][jj] += hme; }
                }
            }
            if (mode == 0 && fq == 0) { LAGG[aidx * 2] = Pc; LAGG[aidx * 2 + 1] = Hc; }
        }
        if (mode == 1) {
#pragma unroll
            for (int mt = 0; mt < 4; ++mt)
#pragma unroll
                for (int jj = 0; jj < 4; ++jj) { const int i = mt * 16 + fq * 4 + jj; const int row = pos_row(false, b, isctx, p0 + i);
                    hsum[mt][jj] *= bf2f(P[(size_t)row * DINP + C_LRY + ch]); }
#pragma unroll
            for (int mt = 0; mt < 4; ++mt)
#pragma unroll
                for (int jj = 0; jj < 4; ++jj) { const int i = mt * 16 + fq * 4 + jj; const int row = pos_row(false, b, isctx, p0 + i);
                    bf16_t* yp = P + (size_t)row * DINP + C_LRY + ch; bf16_t* yd = dry ? (bf16_t*)(p.ws + WS_GB) + (size_t)row * 512 + ch : yp; *yd = (bf16_t)f2bf(hsum[mt][jj]); }
        }
    }
    lbar();
}
DEVI void lru_seq(const PW& pw0, int gtid, int nthreads) {
    const PW p{opq64(pw0.ws)};
    float* LAGG = (float*)(p.ws + WS_SM + SM_LAGG);
    for (int g = gtid; g < 4096; g += nthreads) {
        const int ch = g & 511, db = g >> 9;
        float h = 0.f;
        for (int c0 = 0; c0 < NCH; c0 += 17) {
            f32x2 v[17];
#pragma unroll
            for (int u = 0; u < 17; ++u) v[u] = *(const f32x2*)(LAGG + (((size_t)db * NCH + c0 + u) * 512 + ch) * 2);
#pragma unroll
            for (int u = 0; u < 17; ++u) { LAGG[(((size_t)db * NCH + c0 + u) * 512 + ch) * 2] = h; h = v[u][0] * h + v[u][1]; }
        }
    }
}

DEVI void gate_phase(const PW& pw0, int l, int gwave, int nwaves, int lane) {
    const PW p{opq64(pw0.ws)};
    const bf16_t* P = (const bf16_t*)(p.ws + WS_P);
    float* GT = (float*)(p.ws + WS_GATES);
    for (int w = gwave; w < 4352; w += nwaves) {
        const int kind = w >= 2176 ? 1 : 0, item = kind ? w - 2176 : w;
        const int c = item % NCH, h = (item / NCH) & 3, b = (item / (NCH * 4)) & 3, dir = item / (NCH * 16);
        float* gp = GT + (size_t)(kind * 2176 + item) * 320;
        if (kind == 0) gdn_gates(p, P, l, b, c, h, dir, gp, lane);
        else {
            const int row = tok_row(false, dir, b, c, lane);
            const float ig = bf2f(P[(size_t)row * DINP + C_MLG + dir * 4 + h]) + pin(10)[l * 16 + dir * 4 + h];
            const float fg = bf2f(P[(size_t)row * DINP + C_MLG + (2 + dir) * 4 + h]) + pin(10)[l * 16 + (2 + dir) * 4 + h];
            float bb = logsig(fg);
#pragma unroll
            for (int o = 1; o < 64; o <<= 1) { const float t = __shfl_up(bb, o, 64); if (lane >= o) bb += t; }
            const float bT = __shfl(bb, 63, 64);
            const float lw = bT - bb + ig;
            const float Mc = wmax(lw);
            float pm = ig - bb;
#pragma unroll
            for (int o = 1; o < 64; o <<= 1) { const float t = __shfl_up(pm, o, 64); if (lane >= o) pm = fmaxf(pm, t); }
            gp[lane] = bb; gp[64 + lane] = ig; gp[128 + lane] = __expf(lw - Mc); gp[192 + lane] = pm;
            if (lane == 0) { float* msc = (float*)(p.ws + WS_SM + SM_MSC) + item * 2; msc[0] = bT; msc[1] = Mc; }
        }
    }
}

#define XB_TMO      128
#define XB_XCNT(j)  (256  + 64 * (j))
#define XB_XSUB(j)  (1280 + 64 * (j))
#define XB_XGEN(j)  (2304 + 64 * (j))
#define XB_TOP      3328
#define XB_TOPGEN   3392
#define XCD_BAR_WORDS 3456
#define XB_SPIN_CAP (1u << 22)
DEVI unsigned xb_ld(unsigned* p)              { return __hip_atomic_load(p, __ATOMIC_RELAXED, __HIP_MEMORY_SCOPE_AGENT); }
DEVI unsigned xb_add(unsigned* p, unsigned v) { return __hip_atomic_fetch_add(p, v, __ATOMIC_RELAXED, __HIP_MEMORY_SCOPE_AGENT); }
DEVI unsigned xb_xcc_id() { return (unsigned)__builtin_amdgcn_s_getreg((3 << 11) | 20) & 0xFu; }
#define XB_SPIN(cond, bar) do { unsigned _sp = 0; while (cond) { __builtin_amdgcn_s_sleep(1); \
    if ((++_sp & 255u) == 0u) { if (xb_ld(&(bar)[XB_TMO])) break; if (_sp > XB_SPIN_CAP) { atomicAdd(&(bar)[XB_TMO], 1u); break; } } } } while (0)
DEVI void xcd_barrier_complete(unsigned* bar, unsigned x, unsigned G, unsigned& nloc, unsigned& nx) {
    unsigned sum, cnt, mine, sp = 0u;
    for (;;) {
        sum = 0u; cnt = 0u; mine = 0u;
#pragma unroll
        for (unsigned j = 0; j < 16; ++j) { const unsigned c = xb_ld(&bar[XB_XCNT(j)]); sum += c; cnt += (c > 0u) ? 1u : 0u; mine = (j == x) ? c : mine; }
        if (sum == G) break;
        __builtin_amdgcn_s_sleep(1);
        if ((++sp & 255u) == 0u) { if (xb_ld(&bar[XB_TMO])) break; if (sp > XB_SPIN_CAP) { atomicAdd(&bar[XB_TMO], 1u); break; } }
    }
    nloc = mine > 0u ? mine : 1u; nx = cnt > 0u ? cnt : 1u;
}
DEVI void gsync(unsigned* bar, volatile LAS unsigned* st, int G, int wv) {
    asm volatile("s_waitcnt vmcnt(0)" ::: "memory");
    __syncthreads();
    const int ln = (int)__builtin_amdgcn_mbcnt_hi(~0u, __builtin_amdgcn_mbcnt_lo(~0u, 0u));
    if (wv == 0 && ln == 0) {
        __builtin_amdgcn_s_waitcnt(0);
        const unsigned x = xb_xcc_id();
        unsigned nloc = st[0], nx = st[1];
        if (nloc == 0u) { xcd_barrier_complete(bar, x, (unsigned)G, nloc, nx); st[0] = nloc; st[1] = nx; }
        const unsigned old = xb_add(&bar[XB_XSUB(x)], 1u);
        const unsigned gen = old / nloc;
        if (old + 1u == (gen + 1u) * nloc) {
            __builtin_amdgcn_fence(__ATOMIC_RELEASE, "agent");
            asm volatile("s_waitcnt vmcnt(0)" ::: "memory");
            const unsigned og = xb_add(&bar[XB_TOP], 1u);
            const unsigned tg = og / nx;
            if (og + 1u == (tg + 1u) * nx) xb_add(&bar[XB_TOPGEN], 1u);
            else XB_SPIN(xb_ld(&bar[XB_TOPGEN]) == tg, bar);
            __builtin_amdgcn_fence(__ATOMIC_ACQUIRE, "agent");
            xb_add(&bar[XB_XGEN(x)], 1u);
            asm volatile("s_waitcnt vmcnt(0)" ::: "memory");
        } else {
            XB_SPIN(xb_ld(&bar[XB_XGEN(x)]) == gen, bar);
            __builtin_amdgcn_fence(__ATOMIC_ACQUIRE, "agent");
            asm volatile("s_waitcnt vmcnt(0)" ::: "memory");
        }
    }
    __syncthreads();
}

__global__ void __launch_bounds__(512) mega(Params p) {
    extern __shared__ __attribute__((aligned(16))) unsigned char shm[];
    cg::grid_group grid = cg::this_grid();
    const int wv = __builtin_amdgcn_readfirstlane(threadIdx.x >> 6);
    const int G = gridDim.x, nwaves = G * 8, nthreads = G * 512;
#define TIDS const int tid = MYTID, wid = tid >> 6, lane = tid & 63, gwave = blockIdx.x * 8 + wid, gtid = blockIdx.x * 512 + tid; (void)gtid; (void)gwave; (void)lane;
    LAS unsigned char* lds = (LAS unsigned char*)shm;
#define WSQ unsigned char* ws = opq64(pw.ws); bf16_t* Hb = (bf16_t*)(ws + WS_H); bf16_t* Pb = (bf16_t*)(ws + WS_P); float* Yb = (float*)(ws + WS_Y); (void)Hb; (void)Pb; (void)Yb;

    const PW pw{p.ws};
    unsigned* bar = (unsigned*)p.ws;
    volatile LAS unsigned* xst = (volatile LAS unsigned*)((LAS unsigned char*)shm + (LDS_BYTES - 16));
    if (threadIdx.x == 0) { xst[0] = 0u; xst[1] = 0u; (void)xb_add(&bar[XB_XCNT(xb_xcc_id())], 1u); }
    __syncthreads();
    for (int rep = 0; rep < REP_CVT; ++rep) {
    mod_phase(pw, shm, wv);
    { TIDS convert_phase(pw, 0, shm, gwave, nwaves, wid, lane); }
    }
    grid.sync();
    { TIDS rowwise_phase(pw, 0, MTOT, 0, 0, 0.f, 0, 0, 0, 0, 0, gwave, nwaves, lane); }
    gsync(bar, xst, G, wv);

#pragma unroll 1
    for (int l = 0; l < DEPTH; ++l) {
        const bool last = l == DEPTH - 1;
#pragma unroll 1
        for (int f = 0; f < 2; ++f) {
            if (f == 1) {
                { WSQ pg8::Gemm g{Hb, (const bf16_t*)(ws + WS_WIN), 68, 31, D, D, 1, 0, 0, 0, 0, D, 0}; pg8::Order S; S.init(68, 31, 1, G, blockIdx.x);
                  pg8::EpiInProj E{Pb, DINP}; for (int rep = 0; rep < REP_GEMM; ++rep) pg8::gemm_phase(lds, g, S, E, wv); }
                gsync(bar, xst, G, wv);
                { TIDS gate_phase(pw, l, gwave, nwaves, lane); }
                gsync(bar, xst, G, wv);
#pragma unroll 1
                for (int rep2 = 0; rep2 < REP_PREPSEQ; ++rep2) {
#pragma unroll 1
                for (int rep = 0; rep < REP_PREP; ++rep)
                {
                    gdn_prep_all(pw, l, blockIdx.x, G, shm, wv);
                    ml_prep_all(pw, l, (blockIdx.x + G / 2) % G, G, shm, wv);
                    for (int it = (blockIdx.x + G / 4) % G; it < 1088; it += G) for (int r3 = 0; r3 < REP_LRU0; ++r3) lru_item(pw, l, it, 0, shm, wv);
                }
                gsync(bar, xst, G, wv);
                for (int u = blockIdx.x; u < 256; u += G) gdn_seq_unit(pw, u, shm, wv);
                { TIDS ml_seq(pw, gtid, nthreads); }
                { TIDS lru_seq(pw, gtid, nthreads); }
                gsync(bar, xst, G, wv);
                }
                gdn_out_all(pw, l, blockIdx.x, G, last, shm, wv);
                ml_out_all(pw, l, (blockIdx.x + G / 4) % G, G, last, shm, wv);
                for (int it = (blockIdx.x + G / 2) % G; it < 1088; it += G) { if (last && ((it >> 2) % NCH) < 4) continue; if (DRY_LO) lru_item(pw, l, it, 1, shm, wv, 1); lru_item(pw, l, it, 1, shm, wv); }
                gsync(bar, xst, G, wv);
                const int nM = last ? 64 : 68;
                { WSQ pg8::Gemm g{Pb, (const bf16_t*)(ws + WS_WBR), nM, 4, 512, DINP, 3, C_MLO, C_LRY, C_DNZ, D * 512, 512, 0}; pg8::Order S; S.init(nM, 4, 3, G, blockIdx.x);
                  pg8::EpiBranch E{Pb, (bf16_t*)Yb, Hb}; for (int rep = 0; rep < REP_BR; ++rep) pg8::gemm_phase(lds, g, S, E, wv); }
                gsync(bar, xst, G, wv);
                { WSQ pg8::Gemm g{Hb, (const bf16_t*)(ws + WS_WOUT), 64, 4, D, D, 1, 0, 0, 0, 0, D, 0}; pg8::Order S; S.init(64, 4, 1, G, blockIdx.x);
                  pg8::EpiBf16Y E{(bf16_t*)Yb, D}; for (int rep = 0; rep < REP_GEMM; ++rep) pg8::gemm_phase(lds, g, S, E, wv); }
                if (!last) { WSQ pg8::Gemm g{Hb, (const bf16_t*)(ws + WS_WOUT), 4, 4, 256, D, 4, 0, 0, 0, 256, D, 256}; pg8::Order S; S.init(4, 4, 4, G, blockIdx.x, 64, 1);
                  pg8::EpiF32 E{(float*)(ws + WS_GB), D, MLAT, (size_t)1024 * D}; pg8::gemm_phase(lds, g, S, E, wv); }
                gsync(bar, xst, G, wv);
                { TIDS if (DRY_ROW) { rowwise_phase(pw, 1, nM * 256, l, 5, 1.f, 3, l, 4, 6, 4, gwave, nwaves, lane, 1); } rowwise_phase(pw, 1, nM * 256, l, 5, 1.f, 3, l, 4, 6, 4, gwave, nwaves, lane); }
                gsync(bar, xst, G, wv);
            }
            const int nM = (last && f == 1) ? 64 : 68;
            { WSQ pg8::Gemm g{Hb, (const bf16_t*)(ws + WS_WGU + f * SZ_WGU), nM, 22, D, D, 1, 0, 0, 0, 0, D, 0}; pg8::Order S; S.init(nM, 22, 1, G, blockIdx.x);
              pg8::EpiSwiGLU E{Pb, DFF}; for (int rep = 0; rep < REP_GU; ++rep) pg8::gemm_phase(lds, g, S, E, wv); }
            gsync(bar, xst, G, wv);
            { WSQ pg8::Gemm g{Pb, (const bf16_t*)(ws + WS_WDN + f * SZ_WDN), 64, 4, DFF, DFF, 1, 0, 0, 0, 0, DFF, 0}; pg8::Order S; S.init(64, 4, 1, G, blockIdx.x);
              pg8::EpiBf16Y E{(bf16_t*)Yb, D}; for (int rep = 0; rep < REP_DN; ++rep) pg8::gemm_phase(lds, g, S, E, wv); }
            if (nM == 68) { WSQ pg8::Gemm g{Pb, (const bf16_t*)(ws + WS_WDN + f * SZ_WDN), 4, 4, 256, DFF, 11, 0, 0, 0, 256, DFF, 256}; pg8::Order S; S.init(4, 4, 11, G, blockIdx.x, 64, 1);
              pg8::EpiF32 E{(float*)(ws + WS_GB), D, MLAT, (size_t)1024 * D}; for (int rep = 0; rep < REP_DNC; ++rep) pg8::gemm_phase(lds, g, S, E, wv); }
            gsync(bar, xst, G, wv);
            if (f == 0) { TIDS if (DRY_ROW) { rowwise_phase(pw, 1, nM * 256, l, 2, 0.5f, 1, l, 2, 3, 11, gwave, nwaves, lane, 1); } rowwise_phase(pw, 1, nM * 256, l, 2, 0.5f, 1, l, 2, 3, 11, gwave, nwaves, lane); }
            else if (!last) { { TIDS if (DRY_ROW) { rowwise_phase(pw, 1, nM * 256, l, 8, 0.5f, 5, l + 1, 0, 0, 11, gwave, nwaves, lane, 1); } rowwise_phase(pw, 1, nM * 256, l, 8, 0.5f, 5, l + 1, 0, 0, 11, gwave, nwaves, lane); } for (int rep = 0; rep < REP_CVT; ++rep) { TIDS convert_phase(pw, l + 1, shm, gwave, nwaves, wid, lane); } }
            else { TIDS rowwise_phase(pw, 2, MLAT, l, 8, 0.5f, 5, 0, 0, 0, 0, gwave, nwaves, lane); }
            gsync(bar, xst, G, wv);
        }
    }
}

extern "C" void kernel_launch(void* const* d_in, const int* in_sizes, int n_in, void* d_out, int out_size, void* d_ws, size_t ws_size, hipStream_t stream) {
    static int grid = 0;
    if (grid == 0) {
        if (n_in != 25 || ws_size < WS_END) { fprintf(stderr, "kernel_launch: unexpected n_in %d or ws_size %zu (need %zu)\n", n_in, ws_size, (size_t)WS_END); grid = -1; return; }
        int dev = 0, cus = 0, per_cu = 0;
        hipGetDevice(&dev); hipDeviceGetAttribute(&cus, hipDeviceAttributeMultiprocessorCount, dev);
        if (hipFuncSetAttribute((const void*)mega, hipFuncAttributeMaxDynamicSharedMemorySize, LDS_BYTES) != hipSuccess) { fprintf(stderr, "kernel_launch: hipFuncSetAttribute failed\n"); grid = -1; return; }
        if (hipOccupancyMaxActiveBlocksPerMultiprocessor(&per_cu, (const void*)mega, 512, LDS_BYTES) != hipSuccess || per_cu < 1) { fprintf(stderr, "kernel_launch: occupancy query failed (%d)\n", per_cu); per_cu = 1; }
        (void)hipGetLastError();
        grid = cus * per_cu;
    }
    if (grid < 0) return;
    if (hipMemsetAsync(d_ws, 0, 16384, stream) != hipSuccess) { fprintf(stderr, "kernel_launch: memset failed\n"); return; }
    Params p{};
    for (int i = 0; i < 25; ++i) p.in[i] = (const float*)d_in[i];
    p.out = (float*)d_out; p.ws = (unsigned char*)d_ws;
    void* args[] = {&p};
    hipError_t e = hipLaunchCooperativeKernel((const void*)mega, dim3(grid), dim3(512), args, LDS_BYTES, stream);
    if (e != hipSuccess) fprintf(stderr, "cooperative launch failed: %s (grid %d)\n", hipGetErrorString(e), grid);
}
```

```cpp
#include <hip/hip_runtime.h>
#include <hip/hip_cooperative_groups.h>
#include <cstdio>
namespace cg = cooperative_groups;

#define LAS __attribute__((address_space(3)))
#define DEVI __device__ __forceinline__
typedef unsigned short bf16_t;
typedef short bf16x8 __attribute__((ext_vector_type(8)));
typedef float f32x4 __attribute__((ext_vector_type(4)));
typedef float f32x2 __attribute__((ext_vector_type(2)));
typedef unsigned u32x4 __attribute__((ext_vector_type(4)));
typedef unsigned u32x2 __attribute__((ext_vector_type(2)));

constexpr int D = 1024, NBATCH = 4, SEQ = 4096, CTXL = 256, DEPTH = 4, DFF = 2816, DINP = 7936;
constexpr int MLAT = NBATCH * SEQ, MTOT = MLAT + NBATCH * CTXL;
constexpr int NCH = 68;
constexpr int C_MLQ = 0, C_MLK = 256, C_MLV = 512, C_MLO = 1024, C_MLG = 1536, C_LRX = 1552, C_LRY = 2064,
              C_DNQ = 2576, C_DNZ = 4112, C_DNBA = 4624, C_GATE = 4640, C_END = 7712;
constexpr float EPS = 1e-6f;

constexpr size_t SZ_WGU = (size_t)2 * DFF * D * 2, SZ_WDN = (size_t)D * DFF * 2;
constexpr size_t WS_MOD = 16384;
constexpr size_t WS_WGU = 1u << 20;
constexpr size_t WS_WDN = WS_WGU + 2 * SZ_WGU;
constexpr size_t WS_WIN = WS_WDN + 2 * SZ_WDN;
constexpr size_t WS_WBR = WS_WIN + (size_t)DINP * D * 2;
constexpr size_t WS_WOUT = WS_WBR + (size_t)3 * D * 512 * 2;
constexpr size_t WS_WLRU = WS_WOUT + (size_t)D * D * 2;
constexpr size_t WS_X = WS_WLRU + (size_t)32 * 64 * 64 * 2;
constexpr size_t WS_H = WS_X + (size_t)MTOT * D * 4;
constexpr size_t WS_Y = WS_H + (size_t)MTOT * D * 2;
constexpr size_t WS_P = WS_Y + (size_t)MTOT * D * 4;
constexpr size_t WS_GU = WS_P + (size_t)MTOT * DINP * 2;
constexpr size_t WS_GB = WS_GU + (size_t)2176 * 64 * 128 * 2;
constexpr size_t WS_GN = WS_GB + (size_t)2176 * 128 * 128 * 2;
constexpr size_t WS_SM = WS_GN + (size_t)2176 * 128 * 128 * 2;
constexpr size_t SM_GDEC = 0, SM_MN = 16384, SM_MSC = SM_MN + 2176 * 64 * 4, SM_MM = SM_MSC + 2176 * 8, SM_LAGG = SM_MM + 2176 * 4 + 1024;
constexpr size_t WS_YC = WS_SM + SM_LAGG + (size_t)2 * 4 * NCH * 512 * 2 * 4 + 4096;
constexpr size_t WS_GATES = WS_YC;
constexpr size_t WS_END = WS_GATES + (size_t)2 * 2176 * 320 * 4 + 4096;
constexpr int LDS_BYTES = 155648;
constexpr int REP_BR = 1, REP_GU = 1, REP_DN = 1, REP_DNC = 1, REP_GEMM = 1, DRY_ROW = 0, REP_PREP = 1, REP_PREPSEQ = 1, REP_CVT = 1, REP_GDNP = 1, REP_MLP = 1, REP_LRU0 = 1, DRY_GO = 0, DRY_MO = 0, DRY_LO = 0;

struct Params { const float* in[25]; float* out; unsigned char* ws; };
struct PW { unsigned char* ws; };

#define CAS __attribute__((address_space(4)))
DEVI const float* pin(int i) { const CAS char* k = (const CAS char*)__builtin_amdgcn_kernarg_segment_ptr(); return *(const float* const volatile CAS*)(k + 8 * i); }
DEVI int opaque(int v) { asm volatile("" : "+v"(v)); return v; }
DEVI unsigned char* opq(unsigned char* p) { unsigned v = (unsigned)(size_t)(LAS unsigned char*)p; asm volatile("" : "+s"(v)); return (unsigned char*)(LAS unsigned char*)(size_t)v; }
DEVI LAS unsigned char* opql(LAS unsigned char* p) { unsigned v = (unsigned)(size_t)p; asm volatile("" : "+s"(v)); return (LAS unsigned char*)(size_t)v; }
DEVI unsigned char* opq64(unsigned char* p) { unsigned long long v = (unsigned long long)p; asm volatile("" : "+s"(v)); return (unsigned char*)v; }
#define MYTID opaque(wv * 64 + (int)__builtin_amdgcn_mbcnt_hi(~0u, __builtin_amdgcn_mbcnt_lo(~0u, 0u)))
DEVI float bf2f(bf16_t v) { return __uint_as_float(((unsigned)v) << 16); }
DEVI unsigned f2bf(float f) { unsigned u = __float_as_uint(f); return (u + 0x7fffu + ((u >> 16) & 1u)) >> 16; }
DEVI unsigned pk2(float lo, float hi) { return f2bf(lo) | (f2bf(hi) << 16); }
DEVI float sigm(float x) { return __builtin_amdgcn_rcpf(1.f + __expf(-x)); }
DEVI float silu(float x) { return x * sigm(x); }
DEVI float softplus(float x) { return x > 20.f ? x : log1pf(__expf(x)); }
DEVI float logsig(float x) { return fminf(x, 0.f) - log1pf(__expf(-fabsf(x))); }
DEVI float gelu_t(float x) { float u = 0.7978845608f * (x + 0.044715f * x * x * x); float e = __expf(2.f * u); return x * (1.f - __builtin_amdgcn_rcpf(e + 1.f)); }
DEVI float wsum(float v) { for (int o = 32; o > 0; o >>= 1) v += __shfl_xor(v, o, 64); return v; }
DEVI float wmax(float v) { for (int o = 32; o > 0; o >>= 1) v = fmaxf(v, __shfl_xor(v, o, 64)); return v; }
DEVI void unpack8(u32x4 r, float* f) {
    f[0] = __uint_as_float(r[0] << 16); f[1] = __uint_as_float(r[0] & 0xffff0000u); f[2] = __uint_as_float(r[1] << 16); f[3] = __uint_as_float(r[1] & 0xffff0000u);
    f[4] = __uint_as_float(r[2] << 16); f[5] = __uint_as_float(r[2] & 0xffff0000u); f[6] = __uint_as_float(r[3] << 16); f[7] = __uint_as_float(r[3] & 0xffff0000u);
}
DEVI u32x4 pack8(const float* f) { u32x4 r; r[0] = pk2(f[0], f[1]); r[1] = pk2(f[2], f[3]); r[2] = pk2(f[4], f[5]); r[3] = pk2(f[6], f[7]); return r; }
DEVI bf16x8 ldfrag(const bf16_t* base, int ld, int row0, int k0, int lane) { return *(const bf16x8*)(base + (row0 + (lane & 15)) * ld + k0 + (lane >> 4) * 8); }
DEVI int tix(int row, int col) { return row * 72 + ((((col >> 3) + (row >> 3)) & 7) << 3) + (col & 7); }
DEVI bf16x8 ldfragT(const bf16_t* base, int row0, int k0, int lane) { const int r = row0 + (lane & 15), lg = (k0 >> 3) + (lane >> 4); return *(const bf16x8*)(base + r * 72 + (((lg + (r >> 3)) & 7) << 3)); }
DEVI void lbar() { asm volatile("s_waitcnt lgkmcnt(0)" ::: "memory"); __builtin_amdgcn_s_barrier(); asm volatile("" ::: "memory"); }
#define MFMA16(a, b, c) __builtin_amdgcn_mfma_f32_16x16x32_bf16(a, b, c, 0, 0, 0)

namespace pg8 {
constexpr int BM = 256, BK = 64, HALF = 128, HTB = HALF * BK * 2, NXCD = 8, WGM = 8;
DEVI int lds_byte(int r, int c) { const int st = (r >> 4) * 2 + (c >> 5), rr = r & 15, cc = c & 31, ob = rr * 64 + cc * 2; return st * 1024 + (ob ^ (((ob >> 9) & 1) << 5)); }
DEVI void stage_rc(int b, int& R, int& C) { const int st = b / 1024, sb = b % 1024, swz = sb ^ (((sb >> 9) & 1) << 5); R = (st >> 1) * 16 + swz / 64; C = (st & 1) * 32 + (swz % 64) / 2; }
DEVI int perm32(int rho) { const int n = rho >> 4, i = rho & 15; return 8 * (i >> 2) + 4 * n + (i & 3); }
struct Unit { int pm, pn, z; };
struct Gemm { const bf16_t* A; const bf16_t* Bt; int nM, nN, K, lda, nz, zA0, zA1, zA2, zB; int ldb, zAstep; };
struct Order {
    int nM, nN, nwg, G, c, nz, pm0, spread;
    DEVI void init(int nM_, int nN_, int nz_, int G_, int c_, int pm0_ = 0, int spread_ = 0) { nM = nM_; nN = nN_; nwg = nM * nN; G = G_; c = c_; nz = nz_; pm0 = pm0_; spread = spread_; }
    DEVI bool next(int i, Unit& u) const {
        int ti = i, z = 0; long L;
        if (spread) { L = (long)i * G + c; if (L >= (long)nwg * nz) return false; z = (int)(L / nwg); L -= (long)z * nwg; }
        else { if (nz == 3) { ti = i / 3; z = i - ti * 3; } L = (long)ti * G + c; if (L >= nwg) return false; }
        int wgid = (int)L; { const int q = nwg / NXCD, r = nwg % NXCD, xcd = wgid % NXCD, off = wgid / NXCD; wgid = (xcd < r ? xcd * (q + 1) : r * (q + 1) + (xcd - r) * q) + off; }
        const int nig = WGM * nN, gid = wgid / nig, fm = gid * WGM, gsz = (nM - fm) < WGM ? (nM - fm) : WGM;
        u.pm = pm0 + fm + ((wgid % nig) % gsz); u.pn = (wgid % nig) / gsz; u.z = z; return true;
    }
};

template <class Epi>
DEVI void gemm_phase(LAS unsigned char* lds_in, const Gemm g, const Order& S, const Epi& E, int wv) {
    LAS unsigned char* lds = opql(lds_in);
    const int tid = MYTID, wid = __builtin_amdgcn_readfirstlane(tid >> 6), lane = tid & 63, wr = wid >> 2, wc = wid & 3, fr = lane & 15, fq = lane >> 4;
    const int K = g.K, nt = K / BK, lda = g.lda, ldb = g.ldb;
    unsigned voffA[2], voffB[2];
#pragma unroll
    for (int i = 0; i < 2; ++i) { int R, C; stage_rc(tid * 16 + i * 8192, R, C); const int Rb = Epi::PERM ? ((R & ~31) + perm32(R & 31)) : R;
        voffA[i] = (unsigned)(R * lda + C) * 2u; voffB[i] = (unsigned)(Rb * ldb + C) * 2u; }
    const size_t kstep = (size_t)(BK * 2);
    const size_t hstepA = (size_t)HALF * lda * 2, hstepB = (size_t)HALF * ldb * 2;
    const unsigned ldsw = (unsigned)wid * 1024u;
    const int aoff = lds_byte(wr * 64 + fr, fq * 8), boff = lds_byte(wc * 32 + fr, fq * 8);
#define PG8_SA(b, h) (((b) * 2 + (h)) * HTB)
#define PG8_SB(b, h) ((4 + (b) * 2 + (h)) * HTB)
#define PG8_STAGE(bufoff, gbase, voff) do { _Pragma("unroll") for (int _i = 0; _i < 2; ++_i) \
        __builtin_amdgcn_global_load_lds((const unsigned*)((const char*)(gbase) + (voff)[_i]), (LAS unsigned*)(lds + (bufoff) + ldsw + _i * 8192), 16, 0, 0); } while (0)
#define PG8_LDA(dst, b, h) do { _Pragma("unroll") for (int m = 0; m < 4; ++m) _Pragma("unroll") for (int k = 0; k < 2; ++k) dst[m][k] = *(const LAS bf16x8*)(lds + PG8_SA(b, h) + aoff + m * 2048 + k * 1024); } while (0)
#define PG8_LDB(dst, b, h) do { _Pragma("unroll") for (int n = 0; n < 2; ++n) _Pragma("unroll") for (int k = 0; k < 2; ++k) dst[n][k] = *(const LAS bf16x8*)(lds + PG8_SB(b, h) + boff + n * 2048 + k * 1024); } while (0)
#define PG8_MMA(ai, bj, At, Bt) do { __builtin_amdgcn_s_setprio(1); _Pragma("unroll") for (int m = 0; m < 4; ++m) _Pragma("unroll") for (int n = 0; n < 2; ++n) _Pragma("unroll") for (int k = 0; k < 2; ++k) \
        acc[ai][bj][m][n] = __builtin_amdgcn_mfma_f32_16x16x32_bf16(Bt[n][k], At[m][k], acc[ai][bj][m][n], 0, 0, 0); __builtin_amdgcn_s_setprio(0); } while (0)
#define PG8_WAIT_V(n) asm volatile("s_waitcnt vmcnt(" #n ")" ::: "memory")
#define PG8_WAIT_L(n) asm volatile("s_waitcnt lgkmcnt(" #n ")" ::: "memory")
#define PG8_BAR __builtin_amdgcn_s_barrier()
#define PG8_SCHED __builtin_amdgcn_sched_barrier(0)
#define PG8_PA(u) ((const char*)g.A + ((size_t)(g.nz == 3 ? ((u).z == 0 ? g.zA0 : ((u).z == 1 ? g.zA1 : g.zA2)) : (u).z * g.zAstep) + (size_t)(u).pm * BM * lda) * 2)
#define PG8_PB(u) ((const char*)g.Bt + ((size_t)(u).z * g.zB + (size_t)(u).pn * BM * ldb) * 2)
    Unit cur, nxt; int ui = 0;
    if (!S.next(0, cur)) return;
    f32x4 acc[2][2][4][2];
#pragma unroll
    for (int a = 0; a < 2; ++a)
#pragma unroll
        for (int b = 0; b < 2; ++b)
#pragma unroll
            for (int m = 0; m < 4; ++m)
#pragma unroll
                for (int n = 0; n < 2; ++n) acc[a][b][m][n] = (f32x4){0.f, 0.f, 0.f, 0.f};
    bf16x8 At[4][2], B0[2][2], B1[2][2];
    const char* cA = PG8_PA(cur); const char* cB = PG8_PB(cur);
    PG8_STAGE(PG8_SB(0, 0), cB, voffB); PG8_STAGE(PG8_SA(0, 0), cA, voffA); PG8_STAGE(PG8_SB(0, 1), cB + hstepB, voffB); PG8_STAGE(PG8_SA(0, 1), cA + hstepA, voffA);
    if (wr == 1) PG8_BAR;
    PG8_WAIT_V(4); PG8_BAR;
    PG8_STAGE(PG8_SB(1, 0), cB + kstep, voffB); PG8_STAGE(PG8_SA(1, 0), cA + kstep, voffA); PG8_STAGE(PG8_SB(1, 1), cB + hstepB + kstep, voffB);
    PG8_WAIT_V(6); PG8_BAR;
    for (;;) {
        const bool has_next = S.next(ui + 1, nxt);
        const char* nA = has_next ? PG8_PA(nxt) : cA; const char* nB = has_next ? PG8_PB(nxt) : cB;
        for (int t = 0; t < nt; t += 2) {
            const bool last = (t == nt - 2);
            const char* a1 = cA + (size_t)(t + 1) * kstep;
            const char* a2 = last ? nA : cA + (size_t)(t + 2) * kstep; const char* b2 = last ? nB : cB + (size_t)(t + 2) * kstep;
            const char* a3 = a2 + kstep; const char* b3 = b2 + kstep;
            PG8_LDB(B0, 0, 0); PG8_SCHED; PG8_LDA(At, 0, 0); PG8_STAGE(PG8_SA(1, 1), a1 + hstepA, voffA);
            PG8_WAIT_L(8); PG8_BAR; PG8_WAIT_L(0); PG8_MMA(0, 0, At, B0); PG8_BAR; PG8_SCHED;
            PG8_LDB(B1, 0, 1); PG8_STAGE(PG8_SB(0, 0), b2, voffB);
            PG8_BAR; PG8_WAIT_L(0); PG8_MMA(0, 1, At, B1); PG8_BAR;
            PG8_LDA(At, 0, 1); PG8_STAGE(PG8_SA(0, 0), a2, voffA);
            PG8_BAR; PG8_WAIT_L(0); PG8_MMA(1, 0, At, B0); PG8_BAR; PG8_SCHED;
            PG8_STAGE(PG8_SB(0, 1), b2 + hstepB, voffB);
            PG8_WAIT_V(6); PG8_BAR; PG8_MMA(1, 1, At, B1); PG8_BAR;
            PG8_LDB(B0, 1, 0); PG8_SCHED; PG8_LDA(At, 1, 0); PG8_STAGE(PG8_SA(0, 1), a2 + hstepA, voffA);
            PG8_WAIT_L(8); PG8_BAR; PG8_WAIT_L(0); PG8_MMA(0, 0, At, B0); PG8_BAR; PG8_SCHED;
            PG8_LDB(B1, 1, 1); PG8_STAGE(PG8_SB(1, 0), b3, voffB);
            PG8_BAR; PG8_WAIT_L(0); PG8_MMA(0, 1, At, B1); PG8_BAR;
            PG8_LDA(At, 1, 1); PG8_STAGE(PG8_SA(1, 0), a3, voffA);
            PG8_BAR; PG8_WAIT_L(0); PG8_MMA(1, 0, At, B0); PG8_BAR; PG8_SCHED;
            PG8_STAGE(PG8_SB(1, 1), b3 + hstepB, voffB);
            PG8_WAIT_V(6); PG8_BAR; PG8_MMA(1, 1, At, B1); PG8_BAR;
        }
        E(acc, cur, wr, wc, fr, fq);
        if (!has_next) break;
#pragma unroll
        for (int a = 0; a < 2; ++a)
#pragma unroll
            for (int b = 0; b < 2; ++b)
#pragma unroll
                for (int m = 0; m < 4; ++m)
#pragma unroll
                    for (int n = 0; n < 2; ++n) acc[a][b][m][n] = (f32x4){0.f, 0.f, 0.f, 0.f};
        cur = nxt; cA = nA; cB = nB; ++ui;
    }
    PG8_WAIT_V(0);
    if (wr == 0) PG8_BAR;
    PG8_BAR;
#undef PG8_SA
#undef PG8_SB
#undef PG8_STAGE
#undef PG8_LDA
#undef PG8_LDB
#undef PG8_MMA
#undef PG8_WAIT_V
#undef PG8_WAIT_L
#undef PG8_BAR
#undef PG8_SCHED
#undef PG8_PA
#undef PG8_PB
}

struct EpiF32 {
    static constexpr bool PERM = false;
    float* C; int ldc; int row_base; size_t zstride;
    DEVI void operator()(const f32x4 (&acc)[2][2][4][2], const Unit& u, int wr, int wc, int fr, int fq) const {
        const int row0 = u.pm * BM + wr * 64 + fr - row_base, col0 = u.pn * BM + wc * 32 + 4 * fq;
#pragma unroll
        for (int ai = 0; ai < 2; ++ai)
#pragma unroll
            for (int m = 0; m < 4; ++m) { float* rowp = C + (size_t)u.z * zstride + (size_t)(row0 + ai * HALF + m * 16) * ldc + col0;
#pragma unroll
                for (int bj = 0; bj < 2; ++bj)
#pragma unroll
                    for (int n = 0; n < 2; ++n) *(f32x4*)(rowp + bj * HALF + n * 16) = acc[ai][bj][m][n]; }
    }
};
struct EpiBf16Y {
    static constexpr bool PERM = true;
    bf16_t* O; int ldc;
    DEVI void operator()(const f32x4 (&acc)[2][2][4][2], const Unit& u, int wr, int wc, int fr, int fq) const {
        const int row0 = u.pm * BM + wr * 64 + fr;
#pragma unroll
        for (int bj = 0; bj < 2; ++bj) { const int c0 = u.pn * BM + bj * HALF + wc * 32 + 8 * fq;
#pragma unroll
            for (int ai = 0; ai < 2; ++ai)
#pragma unroll
                for (int m = 0; m < 4; ++m) { float v[8];
#pragma unroll
                    for (int n = 0; n < 2; ++n)
#pragma unroll
                        for (int i = 0; i < 4; ++i) v[n * 4 + i] = acc[ai][bj][m][n][i];
                    *(u32x4*)(O + (size_t)(row0 + ai * HALF + m * 16) * ldc + c0) = pack8(v); } }
    }
};
struct EpiAtomic {
    static constexpr bool PERM = false;
    float* C; int ldc; int row_base;
    DEVI void operator()(const f32x4 (&acc)[2][2][4][2], const Unit& u, int wr, int wc, int fr, int fq) const {
        const int row0 = u.pm * BM + wr * 64 + fr - row_base, col0 = u.pn * BM + wc * 32 + 4 * fq;
#pragma unroll
        for (int ai = 0; ai < 2; ++ai)
#pragma unroll
            for (int m = 0; m < 4; ++m) { float* rowp = C + (size_t)(row0 + ai * HALF + m * 16) * ldc + col0;
#pragma unroll
                for (int bj = 0; bj < 2; ++bj)
#pragma unroll
                    for (int n = 0; n < 2; ++n)
#pragma unroll
                        for (int e = 0; e < 4; ++e) __hip_atomic_fetch_add(rowp + bj * HALF + n * 16 + e, acc[ai][bj][m][n][e], __ATOMIC_RELAXED, __HIP_MEMORY_SCOPE_AGENT); }
    }
};
struct EpiSwiGLU {
    static constexpr bool PERM = false;
    bf16_t* O; int ldc;
    DEVI void operator()(const f32x4 (&acc)[2][2][4][2], const Unit& u, int wr, int wc, int fr, int fq) const {
        const int row0 = u.pm * BM + wr * 64 + fr, col0 = u.pn * 128 + wc * 32 + 8 * fq;
#pragma unroll
        for (int ai = 0; ai < 2; ++ai)
#pragma unroll
            for (int m = 0; m < 4; ++m) {
                float v[8];
#pragma unroll
                for (int bj = 0; bj < 2; ++bj)
#pragma unroll
                    for (int i = 0; i < 4; ++i) { const float gt = acc[ai][bj][m][0][i], up = acc[ai][bj][m][1][i]; v[bj * 4 + i] = silu(gt) * up; }
                *(u32x4*)(O + (size_t)(row0 + ai * HALF + m * 16) * ldc + col0) = pack8(v);
            }
    }
};
struct EpiInProj {
    static constexpr bool PERM = true;
    bf16_t* O; int ldc;
    DEVI void operator()(const f32x4 (&acc)[2][2][4][2], const Unit& u, int wr, int wc, int fr, int fq) const {
        const int row0 = u.pm * BM + wr * 64 + fr;
#pragma unroll
        for (int bj = 0; bj < 2; ++bj) {
            const int c0 = u.pn * BM + bj * HALF + wc * 32 + 8 * fq;
            int kind = 0;
            if (c0 >= C_MLO && c0 < C_MLG) kind = 1; else if (c0 >= C_LRY && c0 < C_DNQ) kind = 2; else if (c0 >= C_DNZ && c0 < C_DNBA) kind = 3; else if (c0 >= C_GATE) kind = 1;
#define INPROJ_STORE(FN) _Pragma("unroll") for (int ai = 0; ai < 2; ++ai) _Pragma("unroll") for (int m = 0; m < 4; ++m) { float v[8]; \
                _Pragma("unroll") for (int n = 0; n < 2; ++n) _Pragma("unroll") for (int i = 0; i < 4; ++i) { const float x = acc[ai][bj][m][n][i]; v[n * 4 + i] = FN; } \
                *(u32x4*)(O + (size_t)(row0 + ai * HALF + m * 16) * ldc + c0) = pack8(v); }
            if (kind == 0) { INPROJ_STORE(x) } else if (kind == 1) { INPROJ_STORE(sigm(x)) } else if (kind == 2) { INPROJ_STORE(gelu_t(x)) } else { INPROJ_STORE(silu(x)) }
#undef INPROJ_STORE
        }
    }
};
struct EpiBranch {
    static constexpr bool PERM = false;
    const bf16_t* P; bf16_t* T; bf16_t* U;
    DEVI void operator()(const f32x4 (&acc)[2][2][4][2], const Unit& u, int wr, int wc, int fr, int fq) const {
        const int row0 = u.pm * BM + wr * 64 + fr, col0 = u.pn * BM + wc * 32 + 4 * fq; const int z = u.z;
        bf16_t* dst = z < 2 ? T : U;
#pragma unroll
        for (int ai = 0; ai < 2; ++ai)
#pragma unroll
            for (int mh = 0; mh < 2; ++mh) {
                u32x2 gr[2][2][2], tv[2][2][2];
#pragma unroll
                for (int mm = 0; mm < 2; ++mm) { const size_t row = (size_t)(row0 + ai * HALF + (mh * 2 + mm) * 16);
#pragma unroll
                    for (int bj = 0; bj < 2; ++bj)
#pragma unroll
                        for (int n = 0; n < 2; ++n) { const int col = col0 + bj * HALF + n * 16;
                            gr[mm][bj][n] = *(const u32x2*)(P + row * DINP + C_GATE + z * D + col);
                            tv[mm][bj][n] = (u32x2){0u, 0u};
                            if (z > 0) tv[mm][bj][n] = *(const u32x2*)(T + row * D + col); } }
#pragma unroll
                for (int mm = 0; mm < 2; ++mm) { const size_t row = (size_t)(row0 + ai * HALF + (mh * 2 + mm) * 16);
#pragma unroll
                    for (int bj = 0; bj < 2; ++bj)
#pragma unroll
                        for (int n = 0; n < 2; ++n) { const int col = col0 + bj * HALF + n * 16;
                            const u32x2 g2 = gr[mm][bj][n], t2 = tv[mm][bj][n]; f32x4 a = acc[ai][bj][mh * 2 + mm][n];
                            a[0] = a[0] * __uint_as_float(g2[0] << 16) + __uint_as_float(t2[0] << 16); a[1] = a[1] * __uint_as_float(g2[0] & 0xffff0000u) + __uint_as_float(t2[0] & 0xffff0000u);
                            a[2] = a[2] * __uint_as_float(g2[1] << 16) + __uint_as_float(t2[1] << 16); a[3] = a[3] * __uint_as_float(g2[1] & 0xffff0000u) + __uint_as_float(t2[1] & 0xffff0000u);
                            u32x2 w; w[0] = pk2(a[0], a[1]); w[1] = pk2(a[2], a[3]); *(u32x2*)(dst + row * D + col) = w; } }
            }
    }
};
}

DEVI int tok_row(bool gdn, int dir, int b, int c, int t) {
    if (c < 4) { int p = c * 64 + t; if (dir) p = 255 - p; return MLAT + b * 256 + p; }
    int p = (c - 4) * 64 + t; if (dir) p = 4095 - p;
    const int s = gdn ? ((p & 63) * 64 + (p >> 6)) : p;
    return b * 4096 + s;
}
DEVI int pos_row(bool gdn, int b, bool isctx, int p) {
    if (isctx) { if (p < 0 || p >= 256) return -1; return MLAT + b * 256 + p; }
    if (p < 0 || p >= 4096) return -1;
    const int s = gdn ? ((p & 63) * 64 + (p >> 6)) : p;
    return b * 4096 + s;
}
DEVI int dir_chunk(int dir, int j) { return dir ? (j < 4 ? 3 - j : 71 - j) : j; }

DEVI int gu_rowmap(int s) {
    const int n = s >= DFF ? 1 : 0, a = s - n * DFF, pn = a >> 7, r = a & 127, wc = r >> 5, fq = (r >> 3) & 3, bj = (r >> 2) & 1, i = r & 3;
    return 256 * pn + 128 * bj + 32 * wc + 16 * n + 4 * fq + i;
}
DEVI void cvt_tile(const float* src, int ldsrc, int Nvalid, int k0, int n0, bf16_t* dst, int lddst, int mode, float* buf, int lane) {
    f32x4 vv[16];
#pragma unroll
    for (int it = 0; it < 16; ++it) {
        const int row = it * 4 + (lane >> 4), c4 = (lane & 15) * 4;
        vv[it] = (f32x4){0.f, 0.f, 0.f, 0.f};
        if (n0 + c4 < Nvalid) vv[it] = *(const f32x4*)(src + (size_t)(k0 + row) * ldsrc + n0 + c4);
    }
#pragma unroll
    for (int it = 0; it < 16; ++it) {
        const int row = it * 4 + (lane >> 4), c4 = (lane & 15) * 4;
        float* bp = buf + row * 65 + c4; bp[0] = vv[it][0]; bp[1] = vv[it][1]; bp[2] = vv[it][2]; bp[3] = vv[it][3];
    }
    asm volatile("s_waitcnt lgkmcnt(0)" ::: "memory"); __builtin_amdgcn_wave_barrier();
#pragma unroll 2
    for (int it = 0; it < 8; ++it) {
        const int nc = it * 8 + (lane >> 3), kk = (lane & 7) * 8;
        float f[8];
#pragma unroll
        for (int e = 0; e < 8; ++e) f[e] = buf[(kk + e) * 65 + nc];
        const int drow = mode == 1 ? gu_rowmap(n0 + nc) : (n0 + nc);
        *(u32x4*)(dst + (size_t)drow * lddst + k0 + kk) = pack8(f);
    }
    asm volatile("s_waitcnt lgkmcnt(0)" ::: "memory"); __builtin_amdgcn_wave_barrier();
}
DEVI void convert_phase(const PW& pw0, int l, unsigned char* shm_in, int gwave, int nwaves, int wid, int lane) {
    const PW p{opq64(pw0.ws)};
    unsigned char* shm = opq(shm_in);
    float* buf = (float*)shm + wid * (64 * 65);
    unsigned char* ws = p.ws;
    for (int t = gwave; t < 6880; t += nwaves) {
        int r = t;
        if (r < 2816) { const int f = r / 1408; r -= f * 1408; const int kt = r / 88, ntl = r % 88;
            cvt_tile(pin(7) + ((size_t)(l * 2 + f)) * D * 2 * DFF, 2 * DFF, 2 * DFF, kt * 64, ntl * 64, (bf16_t*)(ws + WS_WGU + f * SZ_WGU), D, 1, buf, lane); continue; }
        r -= 2816;
        if (r < 1408) { const int f = r / 704; r -= f * 704; const int kt = r / 16, ntl = r % 16;
            cvt_tile(pin(8) + ((size_t)(l * 2 + f)) * DFF * D, D, D, kt * 64, ntl * 64, (bf16_t*)(ws + WS_WDN + f * SZ_WDN), DFF, 0, buf, lane); continue; }
        r -= 1408;
        if (r < 1984) { const int kt = r / 124, ntl = r % 124;
            cvt_tile(pin(9) + (size_t)l * D * C_END, C_END, C_END, kt * 64, ntl * 64, (bf16_t*)(ws + WS_WIN), D, 0, buf, lane); continue; }
        r -= 1984;
        if (r < 384) { const int n = r / 128; r -= n * 128; const int kt = r / 16, ntl = r % 16;
            cvt_tile(pin(23) + ((size_t)(l * 3 + n)) * 512 * D, D, D, kt * 64, ntl * 64, (bf16_t*)(ws + WS_WBR) + (size_t)n * D * 512, 512, 0, buf, lane); continue; }
        r -= 384;
        if (r < 256) { const int kt = r / 16, ntl = r % 16;
            cvt_tile(pin(24) + (size_t)l * D * D, D, D, kt * 64, ntl * 64, (bf16_t*)(ws + WS_WOUT), D, 0, buf, lane); continue; }
        r -= 256;
        { const int gate = r >> 4, dn = r & 15;
            cvt_tile(pin(gate ? 16 : 14) + ((size_t)l * 16 + dn) * 4096, 64, 64, 0, 0, (bf16_t*)(ws + WS_WLRU) + (size_t)(gate * 16 + dn) * 4096, 64, 0, buf, lane); }
    }
}

DEVI void mod_phase(const PW& pw0, unsigned char* shm_in, int wv) {
    const PW p{opq64(pw0.ws)};
    unsigned char* shm = opq(shm_in);
    float* sC = (float*)shm;
    float* red = sC + 5 * 1024;
    const int tid = MYTID;
    __syncthreads();
    for (int i = tid; i < 5 * 1024; i += 512) { const int v = i >> 10, k = i & 1023; const float x = v < 4 ? pin(1)[v * 1024 + k] : pin(3)[k]; sC[i] = silu(x); }
    __syncthreads();
    float* MOD = (float*)(p.ws + WS_MOD);
    const int cgp = tid & 15, is = tid >> 4;
    for (int task = blockIdx.x; task < DEPTH * 144; task += gridDim.x) {
        const int l = task / 144, col0 = (task % 144) * 64;
        float acc[5][4];
#pragma unroll
        for (int v = 0; v < 5; ++v)
#pragma unroll
            for (int e = 0; e < 4; ++e) acc[v][e] = 0.f;
        const float* wp = pin(4) + ((size_t)l * 1024 + is * 32) * 9216 + col0 + cgp * 4;
#pragma unroll 16
        for (int r = 0; r < 32; ++r) {
            const f32x4 w = *(const f32x4*)(wp + (size_t)r * 9216);
#pragma unroll
            for (int v = 0; v < 5; ++v) { const float s = sC[v * 1024 + is * 32 + r];
#pragma unroll
                for (int e = 0; e < 4; ++e) acc[v][e] += s * w[e]; }
        }
#pragma unroll
        for (int v = 0; v < 5; ++v)
#pragma unroll
            for (int e = 0; e < 4; ++e) red[tid * 20 + v * 4 + e] = acc[v][e];
        __syncthreads();
        if (tid < 320) { const int v = tid >> 6, c = tid & 63; float s = 0.f;
            for (int k = 0; k < 32; ++k) s += red[(k * 16 + (c >> 2)) * 20 + v * 4 + (c & 3)];
            MOD[((size_t)(l * 5 + v)) * 9216 + col0 + c] = s + pin(5)[(size_t)l * 9216 + col0 + c]; }
        __syncthreads();
    }
}

DEVI void rowwise_phase(const PW& pw0, int mode, int nrows, int l, int kgate, float coef, int gpost_i, int ln, int gpre_i, int kshift, int nzc, int gwave, int nwaves, int lane, int dry = 0) {
    const PW p{opq64(pw0.ws)};
      bf16_t* X = (bf16_t*)(p.ws + WS_X); bf16_t* Xw = dry ? (bf16_t*)(p.ws + WS_GN) : X; const float* Y0 = (const float*)(p.ws + WS_Y); const float* YC = (const float*)(p.ws + WS_GB); bf16_t* H = dry ? (bf16_t*)(p.ws + WS_GU) : (bf16_t*)(p.ws + WS_H);
    const float* MOD = (const float*)(p.ws + WS_MOD);
    const int co = lane * 4;
    u32x2 yq[4]; u32x2 xq[4];
#pragma unroll
    for (int i = 0; i < 4; ++i) { yq[i] = (u32x2){0u, 0u}; xq[i] = (u32x2){0u, 0u}; }
    if (mode != 0 && gwave < nrows && gwave < MLAT) {
#pragma unroll
        for (int i = 0; i < 4; ++i) { yq[i] = *(const u32x2*)((const bf16_t*)Y0 + (size_t)gwave * D + co + 256 * i); xq[i] = *(const u32x2*)(X + (size_t)gwave * D + co + 256 * i); }
    }
    for (int row = gwave; row < nrows; row += nwaves) {
        const int v = row < MLAT ? (row >> 12) : 4;
        f32x4 x[4], y[4];
        f32x4 pg[4], pm[4], qg[4], qa[4], qs[4];
        if (mode == 0) {
            const float* src = row < MLAT ? pin(0) + (size_t)row * D : pin(2) + (size_t)(row - MLAT) * D;
#pragma unroll
            for (int i = 0; i < 4; ++i) x[i] = *(const f32x4*)(src + co + 256 * i);
        {
            const float* gp = pin(6) + ((size_t)l * 6 + gpost_i) * D; const float* gt = MOD + ((size_t)(l * 5 + v) * 9 + kgate) * D;
            const float* gq = pin(6) + ((size_t)ln * 6 + gpre_i) * D; const float* sh = MOD + ((size_t)(ln * 5 + v) * 9 + kshift) * D; const float* sc = sh + D;
#pragma unroll
            for (int i = 0; i < 4; ++i) { pg[i] = *(const f32x4*)(gp + co + 256 * i); pm[i] = *(const f32x4*)(gt + co + 256 * i);
                qg[i] = *(const f32x4*)(gq + co + 256 * i); qa[i] = *(const f32x4*)(sh + co + 256 * i); qs[i] = *(const f32x4*)(sc + co + 256 * i); }
        }
        } else {
            if (row >= MLAT) {
                const float* Y = YC + (size_t)(row - MLAT) * D;
#pragma unroll
                for (int ih = 0; ih < 2; ++ih) {
                    f32x4 t[11][2];
#pragma unroll
                    for (int z = 0; z < 11; ++z)
#pragma unroll
                        for (int i2 = 0; i2 < 2; ++i2) t[z][i2] = z < nzc ? *(const f32x4*)(Y + (size_t)z * 1024 * D + co + 256 * (ih * 2 + i2)) : (f32x4){0.f, 0.f, 0.f, 0.f};
#pragma unroll
                    for (int i2 = 0; i2 < 2; ++i2) { f32x4 a = t[0][i2];
#pragma unroll
                        for (int z = 1; z < 11; ++z) a = a + t[z][i2];
                        y[ih * 2 + i2] = a; }
                }
#pragma unroll
                for (int i = 0; i < 4; ++i) { const u32x2 r3 = *(const u32x2*)(X + (size_t)row * D + co + 256 * i); x[i] = (f32x4){__uint_as_float(r3[0] << 16), __uint_as_float(r3[0] & 0xffff0000u), __uint_as_float(r3[1] << 16), __uint_as_float(r3[1] & 0xffff0000u)}; }
            } else {
#pragma unroll
                for (int i = 0; i < 4; ++i) { const u32x2 r2 = yq[i]; { const u32x2 r3 = xq[i]; x[i] = (f32x4){__uint_as_float(r3[0] << 16), __uint_as_float(r3[0] & 0xffff0000u), __uint_as_float(r3[1] << 16), __uint_as_float(r3[1] & 0xffff0000u)}; }
                    y[i] = (f32x4){__uint_as_float(r2[0] << 16), __uint_as_float(r2[0] & 0xffff0000u), __uint_as_float(r2[1] << 16), __uint_as_float(r2[1] & 0xffff0000u)}; }
            }
        {
            const float* gp = pin(6) + ((size_t)l * 6 + gpost_i) * D; const float* gt = MOD + ((size_t)(l * 5 + v) * 9 + kgate) * D;
            const float* gq = pin(6) + ((size_t)ln * 6 + gpre_i) * D; const float* sh = MOD + ((size_t)(ln * 5 + v) * 9 + kshift) * D; const float* sc = sh + D;
#pragma unroll
            for (int i = 0; i < 4; ++i) { pg[i] = *(const f32x4*)(gp + co + 256 * i); pm[i] = *(const f32x4*)(gt + co + 256 * i);
                qg[i] = *(const f32x4*)(gq + co + 256 * i); qa[i] = *(const f32x4*)(sh + co + 256 * i); qs[i] = *(const f32x4*)(sc + co + 256 * i); }
        }
            const int nxt = row + nwaves;
            if (nxt < nrows && nxt < MLAT) {
#pragma unroll
                for (int i = 0; i < 4; ++i) { yq[i] = *(const u32x2*)((const bf16_t*)Y0 + (size_t)nxt * D + co + 256 * i); xq[i] = *(const u32x2*)(X + (size_t)nxt * D + co + 256 * i); }
            }
            float ss = 0.f;
#pragma unroll
            for (int i = 0; i < 4; ++i) ss += y[i][0] * y[i][0] + y[i][1] * y[i][1] + y[i][2] * y[i][2] + y[i][3] * y[i][3];
            ss = wsum(ss); const float rs = rsqrtf(ss * (1.f / D) + EPS) * coef;
#pragma unroll
            for (int i = 0; i < 4; ++i) x[i] = x[i] + pm[i] * (y[i] * rs * pg[i]);
        }
        if (mode == 2) {
#pragma unroll
            for (int i = 0; i < 4; ++i) *(f32x4*)((float*)pin(25) + (size_t)row * D + co + 256 * i) = x[i];
            continue;
        }
#pragma unroll
        for (int i = 0; i < 4; ++i) { u32x2 w; w[0] = pk2(x[i][0], x[i][1]); w[1] = pk2(x[i][2], x[i][3]); *(u32x2*)(Xw + (size_t)row * D + co + 256 * i) = w; }
        float ss = 0.f;
#pragma unroll
        for (int i = 0; i < 4; ++i) ss += x[i][0] * x[i][0] + x[i][1] * x[i][1] + x[i][2] * x[i][2] + x[i][3] * x[i][3];
        ss = wsum(ss); const float rs = rsqrtf(ss * (1.f / D) + EPS);
#pragma unroll
        for (int i = 0; i < 4; ++i) { const f32x4 h = x[i] * rs * qg[i] * (qs[i] + 1.f) + qa[i]; u32x2 w; w[0] = pk2(h[0], h[1]); w[1] = pk2(h[2], h[3]);
            *(u32x2*)(H + (size_t)row * D + co + 256 * i) = w; }
    }
}

DEVI void gdn_load(const bf16_t* P, const float* convw, int b, int c, int h, int dir, int want, bf16_t* sQ, bf16_t* sK, bf16_t* sKT, bf16_t* sVT, int tid) {
    const bool isctx = c < 4;
#pragma unroll
    for (int r = 0; r < 6; ++r) {
        const int task = tid + 512 * r, seg = r >> 1, rem = task & 1023, t = rem >> 4, cgp = rem & 15;
        if (seg == 0 && !(want & 1)) continue;
        if (seg == 1 && !(want & 6)) continue;
        if (seg == 2 && !(want & 8)) continue;
        int p = (isctx ? c : c - 4) * 64 + t; if (dir) p = (isctx ? 255 : 4095) - p;
        const int ch = seg * 512 + h * 128 + cgp * 8;
        float a[8];
#pragma unroll
        for (int e = 0; e < 8; ++e) a[e] = 0.f;
#pragma unroll
        for (int j = 0; j < 4; ++j) {
            const int row = pos_row(true, b, isctx, p + j - 2);
            if (row >= 0) {
                const u32x4 raw = *(const u32x4*)(P + (size_t)row * DINP + C_DNQ + ch); float x[8]; unpack8(raw, x);
                const f32x4 w0 = *(const f32x4*)(convw + j * 1536 + ch), w1 = *(const f32x4*)(convw + j * 1536 + ch + 4);
                a[0] += w0[0] * x[0]; a[1] += w0[1] * x[1]; a[2] += w0[2] * x[2]; a[3] += w0[3] * x[3];
                a[4] += w1[0] * x[4]; a[5] += w1[1] * x[5]; a[6] += w1[2] * x[6]; a[7] += w1[3] * x[7];
            }
        }
        float ss = 0.f;
#pragma unroll
        for (int e = 0; e < 8; ++e) { a[e] = silu(a[e]); ss += a[e] * a[e]; }
        if (seg < 2) {
            ss += __shfl_xor(ss, 1, 64); ss += __shfl_xor(ss, 2, 64); ss += __shfl_xor(ss, 4, 64); ss += __shfl_xor(ss, 8, 64);
            float inv = rsqrtf(ss + EPS); if (seg == 0) inv *= 0.08838834764831845f;
#pragma unroll
            for (int e = 0; e < 8; ++e) a[e] *= inv;
        }
        if (seg == 0) *(u32x4*)(sQ + t * 136 + cgp * 8) = pack8(a);
        else if (seg == 1) {
            if (want & 2) *(u32x4*)(sK + t * 136 + cgp * 8) = pack8(a);
            if (want & 4) {
#pragma unroll
                for (int e = 0; e < 8; ++e) sKT[tix(cgp * 8 + e, t)] = (bf16_t)f2bf(a[e]); }
        } else {
#pragma unroll
            for (int e = 0; e < 8; ++e) sVT[tix(cgp * 8 + e, t)] = (bf16_t)f2bf(a[e]);
        }
    }
}
struct GdnRaw { u32x4 r[4][4]; float g; };
DEVI void gdn_ld_issue(const bf16_t* P, const float* gates, int b, int c, int h, int dir, int seg_lo, GdnRaw& R, int tid) {
    const bool isctx = c < 4;
#pragma unroll
    for (int tk = 0; tk < 4; ++tk) {
        const int r = seg_lo * 2 + tk, task = tid + 512 * r, seg = r >> 1, rem = task & 1023, t = rem >> 4, cgp = rem & 15;
        int p = (isctx ? c : c - 4) * 64 + t; if (dir) p = (isctx ? 255 : 4095) - p;
        const int ch = seg * 512 + h * 128 + cgp * 8;
#pragma unroll
        for (int j = 0; j < 4; ++j) { const int row = pos_row(true, b, isctx, p + j - 2); R.r[tk][j] = (u32x4){0u, 0u, 0u, 0u};
            if (row >= 0) R.r[tk][j] = *(const u32x4*)(P + (size_t)row * DINP + C_DNQ + ch); }
    }
    R.g = 0.f; if (tid < 257) R.g = gates[tid];
}
DEVI void gdn_ld_finish(const GdnRaw& R, const float* convw, int h, int seg_lo, int want, bf16_t* sQ, bf16_t* sK, bf16_t* sKT, bf16_t* sVT, float* sc, int tid) {
#pragma unroll
    for (int tk = 0; tk < 4; ++tk) {
        const int r = seg_lo * 2 + tk, task = tid + 512 * r, seg = r >> 1, rem = task & 1023, t = rem >> 4, cgp = rem & 15;
        const int ch = seg * 512 + h * 128 + cgp * 8;
        float a[8];
#pragma unroll
        for (int e = 0; e < 8; ++e) a[e] = 0.f;
#pragma unroll
        for (int j = 0; j < 4; ++j) {
            float x[8]; unpack8(R.r[tk][j], x);
            const f32x4 w0 = *(const f32x4*)(convw + j * 1536 + ch), w1 = *(const f32x4*)(convw + j * 1536 + ch + 4);
            a[0] += w0[0] * x[0]; a[1] += w0[1] * x[1]; a[2] += w0[2] * x[2]; a[3] += w0[3] * x[3];
            a[4] += w1[0] * x[4]; a[5] += w1[1] * x[5]; a[6] += w1[2] * x[6]; a[7] += w1[3] * x[7];
        }
        float ss = 0.f;
#pragma unroll
        for (int e = 0; e < 8; ++e) { a[e] = silu(a[e]); ss += a[e] * a[e]; }
        if (seg < 2) {
            ss += __shfl_xor(ss, 1, 64); ss += __shfl_xor(ss, 2, 64); ss += __shfl_xor(ss, 4, 64); ss += __shfl_xor(ss, 8, 64);
            float inv = rsqrtf(ss + EPS); if (seg == 0) inv *= 0.08838834764831845f;
#pragma unroll
            for (int e = 0; e < 8; ++e) a[e] *= inv;
        }
        if (seg == 0) *(u32x4*)(sQ + t * 136 + cgp * 8) = pack8(a);
        else if (seg == 1) {
            if (want & 2) *(u32x4*)(sK + t * 136 + cgp * 8) = pack8(a);
            if (want & 4) {
#pragma unroll
                for (int e = 0; e < 8; ++e) sKT[tix(cgp * 8 + e, t)] = (bf16_t)f2bf(a[e]); }
        } else {
#pragma unroll
            for (int e = 0; e < 8; ++e) sVT[tix(cgp * 8 + e, t)] = (bf16_t)f2bf(a[e]);
        }
    }
    if (tid < 257) sc[tid] = R.g;
}
DEVI void gdn_gates(const PW& p, const bf16_t* P, int l, int b, int c, int h, int dir, float* sc, int lane) {
    const int row = tok_row(true, dir, b, c, lane);
    const float bb = bf2f(P[(size_t)row * DINP + C_DNBA + dir * 4 + h]), aa = bf2f(P[(size_t)row * DINP + C_DNBA + 8 + dir * 4 + h]);
    const float beta = sigm(bb);
    const float g = -__expf(pin(20)[l * 8 + dir * 4 + h]) * softplus(aa + pin(21)[l * 8 + dir * 4 + h]);
    float G = g;
#pragma unroll
    for (int o = 1; o < 64; o <<= 1) { const float t = __shfl_up(G, o, 64); if (lane >= o) G += t; }
    const float GT = __shfl(G, 63, 64);
    sc[lane] = G; sc[64 + lane] = beta; sc[128 + lane] = __expf(G); sc[192 + lane] = __expf(GT - G); if (lane == 0) sc[256] = __expf(GT);
}

DEVI void gdn_prep_all(const PW& pw0, int l, int first, int G, unsigned char* shm_in, int wv) {
    GdnRaw R;
    if (first < 2176) { const PW p{opq64(pw0.ws)}; const int tid = MYTID; const int c = first % NCH, h = (first / NCH) & 3, b = (first / (NCH * 4)) & 3, dir = first / (NCH * 16);
        gdn_ld_issue((const bf16_t*)(p.ws + WS_P), (const float*)(p.ws + WS_GATES) + (size_t)first * 320, b, c, h, dir, 1, R, tid); }
#pragma unroll 1
    for (int item = first; item < 2176; item += G) {
    const PW p{opq64(pw0.ws)};
    unsigned char* shm = opq(shm_in);
    const int tid = MYTID, wid = __builtin_amdgcn_readfirstlane(tid >> 6), lane = tid & 63, fr = lane & 15, fq = lane >> 4;
    const bf16_t* P = (const bf16_t*)(p.ws + WS_P);
    const float* GATES = (const float*)(p.ws + WS_GATES);
    const int h = (item / NCH) & 3;
    bf16_t* sK = (bf16_t*)shm;
    bf16_t* sKT = (bf16_t*)(shm + 17408);
    bf16_t* sVT = (bf16_t*)(shm + 35840);
    float* sTm = (float*)(shm + 54272);
    bf16_t* sT1 = (bf16_t*)(shm + 71680);
    bf16_t* sT2 = (bf16_t*)(shm + 80896);
    bf16_t* sWT = (bf16_t*)(shm + 90112);
    bf16_t* sUT = (bf16_t*)(shm + 108544);
    float* sc = (float*)(shm + 126976);
    gdn_ld_finish(R, pin(19) + (size_t)l * 4 * 1536, h, 1, 2 | 4 | 8, nullptr, sK, sKT, sVT, sc, tid);
    __builtin_amdgcn_sched_barrier(0);
    { const int nxt = item + G; if (nxt < 2176) { const int c2 = nxt % NCH, h2 = (nxt / NCH) & 3, b2 = (nxt / (NCH * 4)) & 3, dir2 = nxt / (NCH * 16); gdn_ld_issue(P, GATES + (size_t)nxt * 320, b2, c2, h2, dir2, 1, R, opaque(tid)); } }
    __builtin_amdgcn_sched_barrier(0);
    lbar();
#pragma unroll
    for (int ti = 0; ti < 2; ++ti) {
        const int tile = wid * 2 + ti, mt = tile >> 2, nt = tile & 3;
        f32x4 acc = (f32x4){0.f, 0.f, 0.f, 0.f};
#pragma unroll
        for (int kk = 0; kk < 4; ++kk) acc = MFMA16(ldfrag(sK, 136, mt * 16, kk * 32, lane), ldfrag(sK, 136, nt * 16, kk * 32, lane), acc);
        const int s = nt * 16 + fr;
#pragma unroll
        for (int j = 0; j < 4; ++j) { const int t = mt * 16 + fq * 4 + j; sTm[t * 68 + s] = s < t ? sc[64 + t] * acc[j] * __expf(sc[t] - sc[s]) : 0.f; }
    }
    lbar();
    float* tmpY = (float*)sWT;
    if (wid < 4) {
        const int o = wid * 16, c = lane & 15;
        int lz; asm volatile("v_mov_b32 %0, 0" : "=v"(lz));
        const float* tm = sTm + lz;
        float x[16];
#pragma unroll
        for (int t = 0; t < 16; ++t) {
            float v = -sTm[(o + t) * 68 + o + c];
#pragma unroll
            for (int s4 = 0; s4 < (t + 3) / 4; ++s4) {
                const f32x4 a = *(const f32x4*)(tm + (o + t) * 68 + o + s4 * 4);
#pragma unroll
                for (int e = 0; e < 4; ++e) if (s4 * 4 + e < t) v -= a[e] * x[s4 * 4 + e];
            }
            x[t] = v;
        }
        asm volatile("s_waitcnt lgkmcnt(0)" ::: "memory");
        if (lane < 16) {
#pragma unroll
            for (int t = 0; t < 16; ++t) sTm[(o + t) * 68 + o + c] = x[t] + (t == c ? 1.f : 0.f);
        }
    }
    lbar();
    {
        const int blk = tid >> 8, r = (tid >> 4) & 15, c = tid & 15, ib = (blk ? 3 : 1) * 16, jb = ib - 16;
        float y = 0.f;
#pragma unroll
        for (int s2 = 0; s2 < 16; ++s2) y += sTm[(ib + r) * 68 + jb + s2] * sTm[(jb + s2) * 68 + jb + c];
        tmpY[blk * 272 + r * 17 + c] = y;
        lbar();
        float z = 0.f;
#pragma unroll
        for (int s2 = 0; s2 < 16; ++s2) z += sTm[(ib + r) * 68 + ib + s2] * tmpY[blk * 272 + s2 * 17 + c];
        lbar();
        sTm[(ib + r) * 68 + jb + c] = -z;
    }
    lbar();
    {
        float y[2];
#pragma unroll
        for (int u = 0; u < 2; ++u) { const int o = tid + 512 * u, r = o >> 5, c = o & 31; float a = 0.f;
#pragma unroll 8
            for (int s2 = 0; s2 < 32; ++s2) a += sTm[(32 + r) * 68 + s2] * sTm[s2 * 68 + c];
            y[u] = a; }
#pragma unroll
        for (int u = 0; u < 2; ++u) { const int o = tid + 512 * u, r = o >> 5, c = o & 31; tmpY[r * 33 + c] = y[u]; }
        lbar();
#pragma unroll
        for (int u = 0; u < 2; ++u) { const int o = tid + 512 * u, r = o >> 5, c = o & 31; float a = 0.f;
#pragma unroll 8
            for (int s2 = 0; s2 < 32; ++s2) a += sTm[(32 + r) * 68 + 32 + s2] * tmpY[s2 * 33 + c];
            y[u] = a; }
#pragma unroll
        for (int u = 0; u < 2; ++u) { const int o = tid + 512 * u, r = o >> 5, c = o & 31; sTm[(32 + r) * 68 + c] = -y[u]; }
    }
    lbar();
#pragma unroll
    for (int u = 0; u < 8; ++u) {
        const int o = tid + 512 * u, t = o >> 6, s2 = o & 63; const float xv = sTm[t * 68 + s2], bt = sc[64 + s2];
        sT1[t * 72 + s2] = (bf16_t)f2bf(xv * bt * sc[128 + s2]); sT2[t * 72 + s2] = (bf16_t)f2bf(xv * bt);
    }
    lbar();
    bf16_t* GW = (bf16_t*)(p.ws + WS_H) + (size_t)item * 64 * 128;
    bf16_t* GU = (bf16_t*)(p.ws + WS_GU) + (size_t)item * 64 * 128;
    {
        const int tid2 = opaque(tid), lane = tid2 & 63, fr = lane & 15, fq = lane >> 4;
        const int mt = wid;
#pragma unroll
        for (int nt = 0; nt < 4; ++nt) {
            f32x4 aw = (f32x4){0.f, 0.f, 0.f, 0.f}, au = aw;
#pragma unroll
            for (int kk = 0; kk < 2; ++kk) { aw = MFMA16(ldfragT(sKT, mt * 16, kk * 32, lane), ldfrag(sT1, 72, nt * 16, kk * 32, lane), aw);
                au = MFMA16(ldfragT(sVT, mt * 16, kk * 32, lane), ldfrag(sT2, 72, nt * 16, kk * 32, lane), au); }
            const int t = nt * 16 + fr, r0 = mt * 16 + fq * 4; const float dec = sc[192 + t];
            u32x2 w; w[0] = pk2(aw[0], aw[1]); w[1] = pk2(aw[2], aw[3]); *(u32x2*)(GW + t * 128 + r0) = w;
            w[0] = pk2(au[0], au[1]); w[1] = pk2(au[2], au[3]); *(u32x2*)(GU + t * 128 + r0) = w;
#pragma unroll
            for (int j = 0; j < 4; ++j) { sWT[tix(r0 + j, t)] = (bf16_t)f2bf(aw[j] * dec); sUT[tix(r0 + j, t)] = (bf16_t)f2bf(au[j] * dec); }
        }
    }
    lbar();
    bf16_t* GB = (bf16_t*)(p.ws + WS_GB) + (size_t)item * 128 * 128;
    bf16_t* GN = (bf16_t*)(p.ws + WS_GN) + (size_t)item * 128 * 128;
    {
        const int tid2 = opaque(tid), lane = tid2 & 63, fr = lane & 15, fq = lane >> 4;
        const int mt = wid;
#pragma unroll
        for (int nt = 0; nt < 8; ++nt) {
            f32x4 ab = (f32x4){0.f, 0.f, 0.f, 0.f}, an = ab;
#pragma unroll
            for (int kk = 0; kk < 2; ++kk) { ab = MFMA16(ldfragT(sWT, mt * 16, kk * 32, lane), ldfragT(sKT, nt * 16, kk * 32, lane), ab);
                an = MFMA16(ldfragT(sKT, mt * 16, kk * 32, lane), ldfragT(sUT, nt * 16, kk * 32, lane), an); }
            const int cc = nt * 16 + fr, r0 = mt * 16 + fq * 4;
            u32x2 w; w[0] = pk2(-ab[0], -ab[1]); w[1] = pk2(-ab[2], -ab[3]); *(u32x2*)(GB + cc * 128 + r0) = w;
            w[0] = pk2(an[0], an[1]); w[1] = pk2(an[2], an[3]); *(u32x2*)(GN + cc * 128 + r0) = w;
        }
    }
    if (tid == 0) ((float*)(p.ws + WS_SM + SM_GDEC))[item] = sc[256];
    lbar();
    }
}

DEVI void gdn_seq_unit(const PW& pw0, int unit, unsigned char* shm_in, int wv) {
    const PW p{opq64(pw0.ws)};
    unsigned char* shm = opq(shm_in);
    const int tid = MYTID, wid = __builtin_amdgcn_readfirstlane(tid >> 6), lane = tid & 63, fr = lane & 15, fq = lane >> 4;
    const int chain = unit >> 3, es = unit & 7;
    bf16_t* sS = (bf16_t*)shm;
    const bf16_t* GB = (const bf16_t*)(p.ws + WS_GB) + (size_t)chain * NCH * 16384;
    bf16_t* GN = (bf16_t*)(p.ws + WS_GN) + (size_t)chain * NCH * 16384;
    const float* GDEC = (const float*)(p.ws + WS_SM + SM_GDEC) + chain * NCH;
    f32x4 acc = (f32x4){0.f, 0.f, 0.f, 0.f};
    constexpr int PF = 4;
    bf16x8 an[PF][4]; u32x2 nn[PF]; float dn[PF];
    const size_t aoff = (size_t)(wid * 16 + fr) * 128 + fq * 8, noff = (size_t)(es * 16 + fr) * 128 + wid * 16 + fq * 4;
#pragma unroll
    for (int u = 0; u < PF; ++u) {
#pragma unroll
        for (int kk = 0; kk < 4; ++kk) an[u][kk] = *(const bf16x8*)(GB + (size_t)u * 16384 + aoff + kk * 32);
        nn[u] = *(const u32x2*)(GN + (size_t)u * 16384 + noff); dn[u] = GDEC[u];
    }
#pragma unroll 1
    for (int c0 = 0; c0 < NCH; c0 += PF) {
#pragma unroll
        for (int u = 0; u < PF; ++u) {
            const int c = c0 + u;
            bf16x8 a[4]; const u32x2 ncur = nn[u]; const float dcur = dn[u];
#pragma unroll
            for (int kk = 0; kk < 4; ++kk) a[kk] = an[u][kk];
            u32x2 sw; sw[0] = pk2(acc[0], acc[1]); sw[1] = pk2(acc[2], acc[3]);
            bf16_t* sb = sS + (c & 1) * (16 * 136);
            *(u32x2*)(sb + fr * 136 + wid * 16 + fq * 4) = sw;
            *(u32x2*)(GN + (size_t)c * 16384 + noff) = sw;
            if (c + PF < NCH) {
#pragma unroll
                for (int kk = 0; kk < 4; ++kk) an[u][kk] = *(const bf16x8*)(GB + (size_t)(c + PF) * 16384 + aoff + kk * 32);
                nn[u] = *(const u32x2*)(GN + (size_t)(c + PF) * 16384 + noff); dn[u] = GDEC[c + PF];
            }
            lbar();
            acc[0] = dcur * acc[0] + __uint_as_float(ncur[0] << 16); acc[1] = dcur * acc[1] + __uint_as_float(ncur[0] & 0xffff0000u);
            acc[2] = dcur * acc[2] + __uint_as_float(ncur[1] << 16); acc[3] = dcur * acc[3] + __uint_as_float(ncur[1] & 0xffff0000u);
#pragma unroll
            for (int kk = 0; kk < 4; ++kk) acc = MFMA16(a[kk], ldfrag(sb, 136, 0, kk * 32, lane), acc);
        }
    }
    lbar();
}

struct GdnOutRaw { GdnRaw L; u32x4 st[4]; u32x4 w[2]; u32x2 ur[4]; };
DEVI void gdn_out_issue(const PW& p, int item, int dir, GdnOutRaw& R, int tid) {
    const int lane = tid & 63, fr = lane & 15, fq = lane >> 4, wid = tid >> 6;
    const int j = item % NCH, h = (item / NCH) & 3, b = item / (NCH * 4);
    const int c = dir_chunk(dir, j);
    const int it2 = ((dir * 4 + b) * 4 + h) * NCH + c;
    gdn_ld_issue((const bf16_t*)(p.ws + WS_P), (const float*)(p.ws + WS_GATES) + (size_t)it2 * 320, b, c, h, dir, 0, R.L, tid);
    const bf16_t* GS = (const bf16_t*)(p.ws + WS_GN) + (size_t)it2 * 16384;
    const bf16_t* GW = (const bf16_t*)(p.ws + WS_H) + (size_t)it2 * 8192;
    const bf16_t* GU = (const bf16_t*)(p.ws + WS_GU) + (size_t)it2 * 8192;
#pragma unroll
    for (int r = 0; r < 4; ++r) { const int idx = tid + 512 * r, row = idx >> 4, cg8 = (idx & 15) * 8; R.st[r] = *(const u32x4*)(GS + row * 128 + cg8); }
#pragma unroll
    for (int r = 0; r < 2; ++r) { const int idx = tid + 512 * r, row = idx >> 4, cg8 = (idx & 15) * 8; R.w[r] = *(const u32x4*)(GW + row * 128 + cg8); }
#pragma unroll
    for (int nt = 0; nt < 4; ++nt) R.ur[nt] = *(const u32x2*)(GU + (nt * 16 + fr) * 128 + wid * 16 + fq * 4);
}
DEVI void gdn_out_all(const PW& pw0, int l, int first, int G, bool skipctx, unsigned char* shm_in, int wv) {
    const int dry = 0;
    GdnOutRaw R;
    int item = first;
    while (item < 1088 && skipctx && (item % NCH) < 4) item += G;
    if (item < 1088) { const PW p{opq64(pw0.ws)}; gdn_out_issue(p, item, 0, R, MYTID); }
#pragma unroll 1
    while (item < 1088) {
    int nitem = item + G;
    while (nitem < 1088 && skipctx && (nitem % NCH) < 4) nitem += G;
#pragma unroll 1
    for (int dir = 0; dir < 2; ++dir) {
        const PW p{opq64(pw0.ws)};
        unsigned char* shm = opq(shm_in);
        const int tid = MYTID, wid = __builtin_amdgcn_readfirstlane(tid >> 6), lane = tid & 63, fr = lane & 15, fq = lane >> 4;
        const int j = item % NCH, h = (item / NCH) & 3, b = item / (NCH * 4);
        bf16_t* P = (bf16_t*)(p.ws + WS_P);
        bf16_t* sQ = (bf16_t*)shm;
        bf16_t* sK = (bf16_t*)(shm + 17408);
        bf16_t* sST = (bf16_t*)(shm + 34816);
        bf16_t* sW = (bf16_t*)(shm + 69632);
        bf16_t* sVN = (bf16_t*)(shm + 87040);
        bf16_t* sA2 = (bf16_t*)(shm + 105472);
        float* sO = (float*)(shm + 114688);
        float* sc = (float*)(shm + 148480);
        gdn_ld_finish(R.L, pin(19) + (size_t)l * 4 * 1536, h, 0, 1 | 2, sQ, sK, nullptr, nullptr, sc, tid);
#pragma unroll
        for (int r = 0; r < 4; ++r) { const int idx = tid + 512 * r, row = idx >> 4, cg8 = (idx & 15) * 8; *(u32x4*)(sST + row * 136 + cg8) = R.st[r]; }
#pragma unroll
        for (int r = 0; r < 2; ++r) { const int idx = tid + 512 * r, row = idx >> 4, cg8 = (idx & 15) * 8; *(u32x4*)(sW + row * 136 + cg8) = R.w[r]; }
        u32x2 ur4[4];
#pragma unroll
        for (int nt = 0; nt < 4; ++nt) ur4[nt] = R.ur[nt];
        __builtin_amdgcn_sched_barrier(0);
        if (dir == 0) gdn_out_issue(p, item, 1, R, opaque(tid)); else if (nitem < 1088) gdn_out_issue(p, nitem, 0, R, opaque(tid));
        __builtin_amdgcn_sched_barrier(0);
        lbar();
        {
            const int mt = wid;
#pragma unroll
            for (int nt = 0; nt < 4; ++nt) {
                const u32x2 ur = ur4[nt];
                f32x4 a = (f32x4){0.f, 0.f, 0.f, 0.f};
#pragma unroll
                for (int kk = 0; kk < 4; ++kk) a = MFMA16(ldfrag(sST, 136, mt * 16, kk * 32, lane), ldfrag(sW, 136, nt * 16, kk * 32, lane), a);
                const int t = nt * 16 + fr, e0 = mt * 16 + fq * 4;
                sVN[(e0 + 0) * 72 + t] = (bf16_t)f2bf(__uint_as_float(ur[0] << 16) - a[0]); sVN[(e0 + 1) * 72 + t] = (bf16_t)f2bf(__uint_as_float(ur[0] & 0xffff0000u) - a[1]);
                sVN[(e0 + 2) * 72 + t] = (bf16_t)f2bf(__uint_as_float(ur[1] << 16) - a[2]); sVN[(e0 + 3) * 72 + t] = (bf16_t)f2bf(__uint_as_float(ur[1] & 0xffff0000u) - a[3]);
            }
#pragma unroll
            for (int ti = 0; ti < 2; ++ti) {
                const int tile = wid * 2 + ti, m2 = tile >> 2, n2 = tile & 3;
                f32x4 a = (f32x4){0.f, 0.f, 0.f, 0.f};
#pragma unroll
                for (int kk = 0; kk < 4; ++kk) a = MFMA16(ldfrag(sQ, 136, m2 * 16, kk * 32, lane), ldfrag(sK, 136, n2 * 16, kk * 32, lane), a);
                const int s = n2 * 16 + fr;
#pragma unroll
                for (int jj = 0; jj < 4; ++jj) { const int t = m2 * 16 + fq * 4 + jj; sA2[t * 72 + s] = (bf16_t)f2bf(s <= t ? a[jj] * __expf(sc[t] - sc[s]) : 0.f); }
            }
        }
        lbar();
        {
            const int nt = wid;
#pragma unroll
            for (int mt = 0; mt < 4; ++mt) {
                f32x4 a = (f32x4){0.f, 0.f, 0.f, 0.f};
#pragma unroll
                for (int kk = 0; kk < 4; ++kk) a = MFMA16(ldfrag(sQ, 136, mt * 16, kk * 32, lane), ldfrag(sST, 136, nt * 16, kk * 32, lane), a);
#pragma unroll
                for (int jj = 0; jj < 4; ++jj) a[jj] *= sc[128 + mt * 16 + fq * 4 + jj];
#pragma unroll
                for (int kk = 0; kk < 2; ++kk) a = MFMA16(ldfrag(sA2, 72, mt * 16, kk * 32, lane), ldfrag(sVN, 72, nt * 16, kk * 32, lane), a);
                const int e = nt * 16 + fr;
#pragma unroll
                for (int jj = 0; jj < 4; ++jj) { const int t = mt * 16 + fq * 4 + jj; const int i = dir ? 63 - t : t; if (dir) sO[i * 132 + e] += a[jj]; else sO[i * 132 + e] = a[jj]; }
            }
        }
        lbar();
    }
    {
        const PW p{opq64(pw0.ws)};
        unsigned char* shm = opq(shm_in);
        const int tid = MYTID;
        const int j = item % NCH, h = (item / NCH) & 3, b = item / (NCH * 4);
        bf16_t* P = (bf16_t*)(p.ws + WS_P);
        float* sO = (float*)(shm + 114688);
    {
        const int i = tid >> 3, e0 = (tid & 7) * 16;
        float v[16], ss = 0.f;
#pragma unroll
        for (int e = 0; e < 16; ++e) { v[e] = sO[i * 132 + e0 + e]; ss += v[e] * v[e]; }
        ss += __shfl_xor(ss, 1, 64); ss += __shfl_xor(ss, 2, 64); ss += __shfl_xor(ss, 4, 64);
        const float rs = rsqrtf(ss * (1.f / 128.f) + EPS);
        const int row = tok_row(true, 0, b, j, i);
        bf16_t* zp = P + (size_t)row * DINP + C_DNZ + h * 128 + e0;
        const float* g = pin(22) + l * 128 + e0;
#pragma unroll
        for (int half = 0; half < 2; ++half) {
            float z[8]; unpack8(*(const u32x4*)(zp + half * 8), z); float o[8];
#pragma unroll
            for (int e = 0; e < 8; ++e) o[e] = v[half * 8 + e] * rs * g[half * 8 + e] * z[e];
            bf16_t* zd = dry ? (bf16_t*)(p.ws + WS_GB) + (size_t)row * 512 + h * 128 + e0 : zp;
            *(u32x4*)(zd + half * 8) = pack8(o);
        }
    }
    lbar();
    }
    item = nitem;
    }
}

DEVI float ml_gates(const PW& p, const bf16_t* P, int l, int b, int c, int h, int dir, float* sc, int lane) {
    const int row = tok_row(false, dir, b, c, lane);
    const float ig = bf2f(P[(size_t)row * DINP + C_MLG + dir * 4 + h]) + pin(10)[l * 16 + dir * 4 + h];
    const float fg = bf2f(P[(size_t)row * DINP + C_MLG + (2 + dir) * 4 + h]) + pin(10)[l * 16 + (2 + dir) * 4 + h];
    float bb = logsig(fg);
#pragma unroll
    for (int o = 1; o < 64; o <<= 1) { const float t = __shfl_up(bb, o, 64); if (lane >= o) bb += t; }
    sc[lane] = bb; sc[64 + lane] = ig;
    return __shfl(bb, 63, 64);
}
struct MlPrepRaw { u32x4 k; u32x4 v[2]; float w[2]; float g; };
DEVI void ml_prep_issue(const PW& p, int item, MlPrepRaw& R, int tid) {
    const int c = item % NCH, h = (item / NCH) & 3, b = (item / (NCH * 4)) & 3, dir = item / (NCH * 16);
    const bf16_t* P = (const bf16_t*)(p.ws + WS_P);
    const float* gp = (const float*)(p.ws + WS_GATES) + (size_t)(2176 + item) * 320;
    { const int t = tid >> 3, cg8 = (tid & 7) * 8; const int row = tok_row(false, dir, b, c, t); R.k = *(const u32x4*)(P + (size_t)row * DINP + C_MLK + h * 64 + cg8); }
#pragma unroll
    for (int r = 0; r < 2; ++r) { const int idx = tid + 512 * r, t = idx >> 4, cg8 = (idx & 15) * 8; const int row = tok_row(false, dir, b, c, t);
        R.v[r] = *(const u32x4*)(P + (size_t)row * DINP + C_MLV + h * 128 + cg8); R.w[r] = gp[128 + t]; }
    R.g = gp[128 + (tid & 63)];
}
DEVI void ml_prep_all(const PW& pw0, int l, int first, int G, unsigned char* shm_in, int wv) {
    MlPrepRaw R;
    if (first < 2176) { const PW p{opq64(pw0.ws)}; ml_prep_issue(p, first, R, MYTID); }
#pragma unroll 1
    for (int item = first; item < 2176; item += G) {
    const PW p{opq64(pw0.ws)};
    unsigned char* shm = opq(shm_in);
    const int tid = MYTID, wid = __builtin_amdgcn_readfirstlane(tid >> 6), lane = tid & 63, fr = lane & 15, fq = lane >> 4;
    bf16_t* sKT = (bf16_t*)shm;
    bf16_t* sVT = (bf16_t*)(shm + 9216);
    float* sc = (float*)(shm + 27648);
    if (tid < 64) sc[128 + tid] = R.g;
    {
        const int t = tid >> 3, cg8 = (tid & 7) * 8;
        float x[8]; unpack8(R.k, x);
#pragma unroll
        for (int e = 0; e < 8; ++e) sKT[tix(cg8 + e, t)] = (bf16_t)f2bf(x[e]);
    }
#pragma unroll
    for (int r = 0; r < 2; ++r) {
        const int idx = tid + 512 * r, t = idx >> 4, cg8 = (idx & 15) * 8;
        float x[8]; unpack8(R.v[r], x); const float w = R.w[r];
#pragma unroll
        for (int e = 0; e < 8; ++e) sVT[tix(cg8 + e, t)] = (bf16_t)f2bf(x[e] * w);
    }
    __builtin_amdgcn_sched_barrier(0);
    if (item + G < 2176) ml_prep_issue(p, item + G, R, opaque(tid));
    __builtin_amdgcn_sched_barrier(0);
    lbar();
    float* KV = (float*)(p.ws + WS_Y) + (size_t)item * 8192;
    {
        const int nt = wid;
#pragma unroll
        for (int mt = 0; mt < 4; ++mt) {
            f32x4 a = (f32x4){0.f, 0.f, 0.f, 0.f};
#pragma unroll
            for (int kk = 0; kk < 2; ++kk) a = MFMA16(ldfragT(sKT, mt * 16, kk * 32, lane), ldfragT(sVT, nt * 16, kk * 32, lane), a);
            *(f32x4*)(KV + (nt * 16 + fr) * 64 + mt * 16 + fq * 4) = a;
        }
    }
    {
        const int d = tid >> 3, t0 = (tid & 7) * 8; float s = 0.f;
#pragma unroll
        for (int t = 0; t < 8; ++t) s += sc[128 + t0 + t] * bf2f(sKT[tix(d, t0 + t)]);
        s += __shfl_xor(s, 1, 64); s += __shfl_xor(s, 2, 64); s += __shfl_xor(s, 4, 64);
        if ((tid & 7) == 0) ((float*)(p.ws + WS_SM + SM_MN))[item * 64 + d] = s; }
    lbar();
    }
}
DEVI void ml_seq(const PW& pw0, int gtid, int nthreads) {
    const PW p{opq64(pw0.ws)};
    const float* MSC = (const float*)(p.ws + WS_SM + SM_MSC);
    float* MM = (float*)(p.ws + WS_SM + SM_MM);
    for (int g = gtid; g < 32 * 4096 + 32 * 32; g += nthreads) {
        const bool isn = g >= 32 * 4096; const int gg = isn ? g - 32 * 4096 : g;
        const int chain = isn ? gg >> 5 : gg >> 12, e2 = isn ? gg & 31 : gg & 4095;
        float* base = isn ? (float*)(p.ws + WS_SM + SM_MN) + (size_t)chain * NCH * 64 + e2 * 2 : (float*)(p.ws + WS_Y) + (size_t)chain * NCH * 8192 + e2 * 2;
        const int stride = isn ? 64 : 8192;
        float m = 0.f; f32x2 C = (f32x2){0.f, 0.f};
        for (int c0 = 0; c0 < NCH; c0 += 17) {
            f32x2 kv[17]; f32x2 sc[17];
#pragma unroll
            for (int u = 0; u < 17; ++u) { kv[u] = *(const f32x2*)(base + (size_t)(c0 + u) * stride); sc[u] = *(const f32x2*)(MSC + (chain * NCH + c0 + u) * 2); }
#pragma unroll
            for (int u = 0; u < 17; ++u) {
                *(f32x2*)(base + (size_t)(c0 + u) * stride) = C;
                if (!isn && e2 == 0) MM[chain * NCH + c0 + u] = m;
                const float mn = fmaxf(sc[u][0] + m, sc[u][1]);
                const float a = __expf(sc[u][0] + m - mn), s = __expf(sc[u][1] - mn);
                C = C * a + kv[u] * s; m = mn;
            }
        }
    }
}
struct MlOutRaw { u32x4 q, k, v[2]; f32x4 ct[4]; float gb, gi, gpm, m, n; };
DEVI void ml_out_issue(const PW& p, int item, int dir, MlOutRaw& R, int tid) {
    const int lane = tid & 63;
    const int j = item % NCH, h = (item / NCH) & 3, b = item / (NCH * 4);
    const int c = dir_chunk(dir, j);
    const int it2 = ((dir * 4 + b) * 4 + h) * NCH + c;
    const bf16_t* P = (const bf16_t*)(p.ws + WS_P);
    { const int t = tid >> 3, cg8 = (tid & 7) * 8; const int row = tok_row(false, dir, b, c, t);
      R.q = *(const u32x4*)(P + (size_t)row * DINP + C_MLQ + h * 64 + cg8); R.k = *(const u32x4*)(P + (size_t)row * DINP + C_MLK + h * 64 + cg8); }
#pragma unroll
    for (int r = 0; r < 2; ++r) { const int idx = tid + 512 * r, t = idx >> 4, cg8 = (idx & 15) * 8; const int row = tok_row(false, dir, b, c, t);
        R.v[r] = *(const u32x4*)(P + (size_t)row * DINP + C_MLV + h * 128 + cg8); }
    const float* CT = (const float*)(p.ws + WS_Y) + (size_t)it2 * 8192;
#pragma unroll
    for (int r = 0; r < 4; ++r) { const int idx = tid + 512 * r, e = idx >> 4, d4 = (idx & 15) * 4; R.ct[r] = *(const f32x4*)(CT + e * 64 + d4); }
    const float* gp = (const float*)(p.ws + WS_GATES) + (size_t)(2176 + it2) * 320;
    R.gb = gp[lane]; R.gi = gp[64 + lane]; R.gpm = gp[192 + lane];
    R.m = ((const float*)(p.ws + WS_SM + SM_MM))[it2]; R.n = ((const float*)(p.ws + WS_SM + SM_MN))[it2 * 64 + lane];
}
DEVI void ml_out_all(const PW& pw0, int l, int first, int G, bool skipctx, unsigned char* shm_in, int wv) {
    const int dry = 0;
    MlOutRaw R;
    int item = first;
    while (item < 1088 && skipctx && (item % NCH) < 4) item += G;
    if (item < 1088) { const PW p{opq64(pw0.ws)}; ml_out_issue(p, item, 0, R, MYTID); }
#pragma unroll 1
    while (item < 1088) {
    int nitem = item + G;
    while (nitem < 1088 && skipctx && (nitem % NCH) < 4) nitem += G;
#pragma unroll 1
    for (int dir = 0; dir < 2; ++dir) {
        const PW p{opq64(pw0.ws)};
        unsigned char* shm = opq(shm_in);
        const int tid = MYTID, wid = __builtin_amdgcn_readfirstlane(tid >> 6), lane = tid & 63, fr = lane & 15, fq = lane >> 4;
        bf16_t* sQ = (bf16_t*)shm;
        bf16_t* sK = (bf16_t*)(shm + 9216);
        bf16_t* sVT = (bf16_t*)(shm + 18432);
        bf16_t* sCT = (bf16_t*)(shm + 36864);
        bf16_t* sS = (bf16_t*)(shm + 55296);
        float* sO = (float*)(shm + 64512);
        float* sc = (float*)(shm + 98304);
        if (wid == 0) {
            const float m = R.m, bb = R.gb, pm = R.gpm;
            sc[lane] = bb; sc[64 + lane] = R.gi;
            const float mt = bb + fmaxf(m, pm);
            sc[128 + lane] = mt; sc[192 + lane] = __expf(bb + m - mt);
            sc[320 + lane] = R.n;
        }
        {
            const int t = tid >> 3, cg8 = (tid & 7) * 8;
            float x[8]; unpack8(R.q, x);
#pragma unroll
            for (int e = 0; e < 8; ++e) x[e] *= 0.125f;
            *(u32x4*)(sQ + t * 72 + cg8) = pack8(x);
            *(u32x4*)(sK + t * 72 + cg8) = R.k;
        }
#pragma unroll
        for (int r = 0; r < 2; ++r) {
            const int idx = tid + 512 * r, t = idx >> 4, cg8 = (idx & 15) * 8;
            float x[8]; unpack8(R.v[r], x);
#pragma unroll
            for (int e = 0; e < 8; ++e) sVT[tix(cg8 + e, t)] = (bf16_t)f2bf(x[e]);
        }
#pragma unroll
        for (int r = 0; r < 4; ++r) { const int idx = tid + 512 * r, e = idx >> 4, d4 = (idx & 15) * 4; const f32x4 v = R.ct[r];
            u32x2 w; w[0] = pk2(v[0], v[1]); w[1] = pk2(v[2], v[3]); *(u32x2*)(sCT + e * 72 + d4) = w; }
        __builtin_amdgcn_sched_barrier(0);
        if (dir == 0) ml_out_issue(p, item, 1, R, opaque(tid)); else if (nitem < 1088) ml_out_issue(p, nitem, 0, R, opaque(tid));
        __builtin_amdgcn_sched_barrier(0);
        lbar();
#pragma unroll
        for (int ti = 0; ti < 2; ++ti) {
            const int tile = wid * 2 + ti, m2 = tile >> 2, n2 = tile & 3;
            f32x4 a = (f32x4){0.f, 0.f, 0.f, 0.f};
#pragma unroll
            for (int kk = 0; kk < 2; ++kk) a = MFMA16(ldfrag(sQ, 72, m2 * 16, kk * 32, lane), ldfrag(sK, 72, n2 * 16, kk * 32, lane), a);
            const int s = n2 * 16 + fr;
#pragma unroll
            for (int jj = 0; jj < 4; ++jj) { const int t = m2 * 16 + fq * 4 + jj;
                sS[t * 72 + s] = (bf16_t)f2bf(s <= t ? a[jj] * __expf(sc[t] - sc[s] + sc[64 + s] - sc[128 + t]) : 0.f); }
        }
        lbar();
        {
            const int t = tid >> 3, s0 = (tid & 7) * 8; float ds = 0.f, qn = 0.f;
#pragma unroll
            for (int s2 = 0; s2 < 8; ++s2) { ds += bf2f(sS[t * 72 + s0 + s2]); qn += bf2f(sQ[t * 72 + s0 + s2]) * sc[320 + s0 + s2]; }
            ds += __shfl_xor(ds, 1, 64); ds += __shfl_xor(ds, 2, 64); ds += __shfl_xor(ds, 4, 64);
            qn += __shfl_xor(qn, 1, 64); qn += __shfl_xor(qn, 2, 64); qn += __shfl_xor(qn, 4, 64);
            const float den = ds + sc[192 + t] * qn;
            if ((tid & 7) == 0) sc[256 + t] = 1.f / fmaxf(fabsf(den), __expf(-sc[128 + t]));
        }
        lbar();
        {
            const int nt = wid;
#pragma unroll
            for (int mt = 0; mt < 4; ++mt) {
                f32x4 a = (f32x4){0.f, 0.f, 0.f, 0.f};
#pragma unroll
                for (int kk = 0; kk < 2; ++kk) a = MFMA16(ldfrag(sQ, 72, mt * 16, kk * 32, lane), ldfrag(sCT, 72, nt * 16, kk * 32, lane), a);
#pragma unroll
                for (int jj = 0; jj < 4; ++jj) a[jj] *= sc[192 + mt * 16 + fq * 4 + jj];
#pragma unroll
                for (int kk = 0; kk < 2; ++kk) a = MFMA16(ldfrag(sS, 72, mt * 16, kk * 32, lane), ldfragT(sVT, nt * 16, kk * 32, lane), a);
                const int e = nt * 16 + fr;
#pragma unroll
                for (int jj = 0; jj < 4; ++jj) { const int t = mt * 16 + fq * 4 + jj; const int i = dir ? 63 - t : t; const float hv = a[jj] * sc[256 + t];
                    if (dir) sO[i * 132 + e] += hv; else sO[i * 132 + e] = hv; }
            }
        }
        lbar();
    }
    {
        const PW p{opq64(pw0.ws)};
        unsigned char* shm = opq(shm_in);
        const int tid = MYTID;
        const int j = item % NCH, h = (item / NCH) & 3, b = item / (NCH * 4);
        bf16_t* P = (bf16_t*)(p.ws + WS_P);
        float* sO = (float*)(shm + 64512);
    {
        const int i = tid >> 3, e0 = (tid & 7) * 16;
        float v[16], ss = 0.f;
#pragma unroll
        for (int e = 0; e < 16; ++e) { v[e] = sO[i * 132 + e0 + e]; ss += v[e] * v[e]; }
        ss += __shfl_xor(ss, 1, 64); ss += __shfl_xor(ss, 2, 64); ss += __shfl_xor(ss, 4, 64);
        const float rs = rsqrtf(ss * (1.f / 128.f) + EPS);
        const int row = tok_row(false, 0, b, j, i);
        bf16_t* op = P + (size_t)row * DINP + C_MLO + h * 128 + e0;
        const float* g = pin(11) + l * 512 + h * 128 + e0;
#pragma unroll
        for (int half = 0; half < 2; ++half) {
            float z[8]; unpack8(*(const u32x4*)(op + half * 8), z); float o[8];
#pragma unroll
            for (int e = 0; e < 8; ++e) o[e] = v[half * 8 + e] * rs * g[half * 8 + e] * z[e];
            bf16_t* od = dry ? (bf16_t*)(p.ws + WS_GB) + (size_t)row * 512 + h * 128 + e0 : op;
            *(u32x4*)(od + half * 8) = pack8(o);
        }
    }
    lbar();
    }
    item = nitem;
    }
}

DEVI void lru_item(const PW& pw0, int l, int item, int mode, unsigned char* shm_in, int wv, int dry = 0) {
    const PW p{opq64(pw0.ws)};
    unsigned char* shm = opq(shm_in);
    const int tid = MYTID, wid = __builtin_amdgcn_readfirstlane(tid >> 6), lane = tid & 63, fr = lane & 15, fq = lane >> 4;
    const int n4 = item & 3, j = (item >> 2) % NCH, b = (item >> 2) / NCH; const bool isctx = j < 4;
    bf16_t* P = (bf16_t*)(p.ws + WS_P);
    bf16_t* sX = (bf16_t*)shm;
    const int p0 = (isctx ? j : j - 4) * 64;
    const float* cw = pin(12) + (size_t)l * 4 * 512; const float* cb = pin(13) + (size_t)l * 512;
    {
        const int ch = lane * 8, i0 = wid * 8;
        f32x4 w[4][2];
#pragma unroll
        for (int jj = 0; jj < 4; ++jj) { w[jj][0] = *(const f32x4*)(cw + jj * 512 + ch); w[jj][1] = *(const f32x4*)(cw + jj * 512 + ch + 4); }
        const f32x4 b0 = *(const f32x4*)(cb + ch), b1 = *(const f32x4*)(cb + ch + 4);
        u32x4 raw[11];
#pragma unroll
        for (int r = 0; r < 11; ++r) { const int row = pos_row(false, b, isctx, p0 + i0 + r - 2);
            raw[r] = (u32x4){0u, 0u, 0u, 0u}; if (row >= 0) raw[r] = *(const u32x4*)(P + (size_t)row * DINP + C_LRX + ch); }
#pragma unroll
        for (int i = 0; i < 8; ++i) {
            float a[8] = {b0[0], b0[1], b0[2], b0[3], b1[0], b1[1], b1[2], b1[3]};
#pragma unroll
            for (int jj = 0; jj < 4; ++jj) { float x[8]; unpack8(raw[i + jj], x);
#pragma unroll
                for (int e = 0; e < 4; ++e) { a[e] += w[jj][0][e] * x[e]; a[4 + e] += w[jj][1][e] * x[4 + e]; } }
            *(u32x4*)(sX + (i0 + i) * 520 + ch) = pack8(a);
        }
    }
    lbar();
    const int blk = wid;
    const bf16_t* WL = (const bf16_t*)(p.ws + WS_WLRU);
    float* LAGG = (float*)(p.ws + WS_SM + SM_LAGG);
    {
        const int ch = blk * 64 + n4 * 16 + fr;
        float hsum[4][4];
#pragma unroll
        for (int mt = 0; mt < 4; ++mt)
#pragma unroll
            for (int jj = 0; jj < 4; ++jj) hsum[mt][jj] = 0.f;
#pragma unroll
        for (int dir = 0; dir < 2; ++dir) {
            const bf16_t* wa = WL + (size_t)(0 * 16 + dir * 8 + blk) * 4096 + (n4 * 16 + fr) * 64 + fq * 8;
            const bf16_t* wx = WL + (size_t)(1 * 16 + dir * 8 + blk) * 4096 + (n4 * 16 + fr) * 64 + fq * 8;
            bf16x8 ba[2], bx[2];
#pragma unroll
            for (int kk = 0; kk < 2; ++kk) { ba[kk] = *(const bf16x8*)(wa + kk * 32); bx[kk] = *(const bf16x8*)(wx + kk * 32); }
            const int c = dir_chunk(dir, j);
            const size_t aidx = (((size_t)dir * 4 + b) * NCH + c) * 512 + ch;
            const float hin0 = mode ? LAGG[aidx * 2] : 0.f;
            const float bias_a = pin(15)[(size_t)l * 1024 + dir * 512 + ch], bias_x = pin(17)[(size_t)l * 1024 + dir * 512 + ch];
            const float cl = -8.f * softplus(-pin(18)[(size_t)l * 1024 + dir * 512 + ch]);
            float av[4][4], bv[4][4];
#pragma unroll
            for (int mt = 0; mt < 4; ++mt) {
                f32x4 aa = (f32x4){0.f, 0.f, 0.f, 0.f}, ax = aa;
#pragma unroll
                for (int kk = 0; kk < 2; ++kk) { const bf16x8 af = ldfrag(sX, 520, mt * 16, blk * 64 + kk * 32, lane); aa = MFMA16(af, ba[kk], aa); ax = MFMA16(af, bx[kk], ax); }
#pragma unroll
                for (int jj = 0; jj < 4; ++jj) {
                    const int t = mt * 16 + fq * 4 + jj;
                    const float rr = sigm(aa[jj] + bias_a), ii = sigm(ax[jj] + bias_x), la = cl * rr;
                    const float ea = __expf(la);
                    av[mt][jj] = ea;
                    bv[mt][jj] = __builtin_amdgcn_sqrtf(fmaxf(1.f - ea * ea, 0.f)) * ii * bf2f(sX[t * 520 + ch]);
                }
            }
            float hin = hin0;
            float Pc = 1.f, Hc = 0.f;
#pragma unroll
            for (int mi = 0; mi < 4; ++mi) {
                const int mt = dir ? 3 - mi : mi;
                float Pl = 1.f, Hl = 0.f;
#pragma unroll
                for (int ji = 0; ji < 4; ++ji) { const int jj = dir ? 3 - ji : ji; Pl = av[mt][jj] * Pl; Hl = av[mt][jj] * Hl + bv[mt][jj]; }
                float Pq[4], Hq[4];
#pragma unroll
                for (int q = 0; q < 4; ++q) { Pq[q] = __shfl(Pl, fr + 16 * q, 64); Hq[q] = __shfl(Hl, fr + 16 * q, 64); }
                if (mode == 0) {
#pragma unroll
                    for (int qi = 0; qi < 4; ++qi) { const int q = dir ? 3 - qi : qi; Hc = Pq[q] * Hc + Hq[q]; Pc = Pq[q] * Pc; }
                } else {
                    float hh = hin;
                    float hme = hin;
#pragma unroll
                    for (int qi = 0; qi < 4; ++qi) { const int q = dir ? 3 - qi : qi; if (q == fq) hme = hh; hh = Pq[q] * hh + Hq[q]; }
                    hin = hh;
#pragma unroll
                    for (int ji = 0; ji < 4; ++ji) { const int jj = dir ? 3 - ji : ji; hme = av[mt][jj] * hme + bv[mt][jj]; hsum[mt][jj] += hme; }
                }
            }
            if (mode == 0 && fq == 0) { LAGG[aidx * 2] = Pc; LAGG[aidx * 2 + 1] = Hc; }
        }
        if (mode == 1) {
#pragma unroll
            for (int mt = 0; mt < 4; ++mt)
#pragma unroll
                for (int jj = 0; jj < 4; ++jj) { const int i = mt * 16 + fq * 4 + jj; const int row = pos_row(false, b, isctx, p0 + i);
                    hsum[mt][jj] *= bf2f(P[(size_t)row * DINP + C_LRY + ch]); }
#pragma unroll
            for (int mt = 0; mt < 4; ++mt)
#pragma unroll
                for (int jj = 0; jj < 4; ++jj) { const int i = mt * 16 + fq * 4 + jj; const int row = pos_row(false, b, isctx, p0 + i);
                    bf16_t* yp = P + (size_t)row * DINP + C_LRY + ch; bf16_t* yd = dry ? (bf16_t*)(p.ws + WS_GB) + (size_t)row * 512 + ch : yp; *yd = (bf16_t)f2bf(hsum[mt][jj]); }
        }
    }
    lbar();
}
DEVI void lru_seq(const PW& pw0, int gtid, int nthreads) {
    const PW p{opq64(pw0.ws)};
    float* LAGG = (float*)(p.ws + WS_SM + SM_LAGG);
    for (int g = gtid; g < 4096; g += nthreads) {
        const int ch = g & 511, db = g >> 9;
        float h = 0.f;
        for (int c0 = 0; c0 < NCH; c0 += 17) {
            f32x2 v[17];
#pragma unroll
            for (int u = 0; u < 17; ++u) v[u] = *(const f32x2*)(LAGG + (((size_t)db * NCH + c0 + u) * 512 + ch) * 2);
#pragma unroll
            for (int u = 0; u < 17; ++u) { LAGG[(((size_t)db * NCH + c0 + u) * 512 + ch) * 2] = h; h = v[u][0] * h + v[u][1]; }
        }
    }
}

DEVI void gate_phase(const PW& pw0, int l, int gwave, int nwaves, int lane) {
    const PW p{opq64(pw0.ws)};
    const bf16_t* P = (const bf16_t*)(p.ws + WS_P);
    float* GT = (float*)(p.ws + WS_GATES);
    for (int w = gwave; w < 4352; w += nwaves) {
        const int kind = w >= 2176 ? 1 : 0, item = kind ? w - 2176 : w;
        const int c = item % NCH, h = (item / NCH) & 3, b = (item / (NCH * 4)) & 3, dir = item / (NCH * 16);
        float* gp = GT + (size_t)(kind * 2176 + item) * 320;
        if (kind == 0) gdn_gates(p, P, l, b, c, h, dir, gp, lane);
        else {
            const int row = tok_row(false, dir, b, c, lane);
            const float ig = bf2f(P[(size_t)row * DINP + C_MLG + dir * 4 + h]) + pin(10)[l * 16 + dir * 4 + h];
            const float fg = bf2f(P[(size_t)row * DINP + C_MLG + (2 + dir) * 4 + h]) + pin(10)[l * 16 + (2 + dir) * 4 + h];
            float bb = logsig(fg);
#pragma unroll
            for (int o = 1; o < 64; o <<= 1) { const float t = __shfl_up(bb, o, 64); if (lane >= o) bb += t; }
            const float bT = __shfl(bb, 63, 64);
            const float lw = bT - bb + ig;
            const float Mc = wmax(lw);
            float pm = ig - bb;
#pragma unroll
            for (int o = 1; o < 64; o <<= 1) { const float t = __shfl_up(pm, o, 64); if (lane >= o) pm = fmaxf(pm, t); }
            gp[lane] = bb; gp[64 + lane] = ig; gp[128 + lane] = __expf(lw - Mc); gp[192 + lane] = pm;
            if (lane == 0) { float* msc = (float*)(p.ws + WS_SM + SM_MSC) + item * 2; msc[0] = bT; msc[1] = Mc; }
        }
    }
}

#define XB_TMO      128
#define XB_XCNT(j)  (256  + 64 * (j))
#define XB_XSUB(j)  (1280 + 64 * (j))
#define XB_XGEN(j)  (2304 + 64 * (j))
#define XB_TOP      3328
#define XB_TOPGEN   3392
#define XCD_BAR_WORDS 3456
#define XB_SPIN_CAP (1u << 22)
DEVI unsigned xb_ld(unsigned* p)              { return __hip_atomic_load(p, __ATOMIC_RELAXED, __HIP_MEMORY_SCOPE_AGENT); }
DEVI unsigned xb_add(unsigned* p, unsigned v) { return __hip_atomic_fetch_add(p, v, __ATOMIC_RELAXED, __HIP_MEMORY_SCOPE_AGENT); }
DEVI unsigned xb_xcc_id() { return (unsigned)__builtin_amdgcn_s_getreg((3 << 11) | 20) & 0xFu; }
#define XB_SPIN(cond, bar) do { unsigned _sp = 0; while (cond) { __builtin_amdgcn_s_sleep(1); \
    if ((++_sp & 255u) == 0u) { if (xb_ld(&(bar)[XB_TMO])) break; if (_sp > XB_SPIN_CAP) { atomicAdd(&(bar)[XB_TMO], 1u); break; } } } } while (0)
DEVI void xcd_barrier_complete(unsigned* bar, unsigned x, unsigned G, unsigned& nloc, unsigned& nx) {
    unsigned sum, cnt, mine, sp = 0u;
    for (;;) {
        sum = 0u; cnt = 0u; mine = 0u;
#pragma unroll
        for (unsigned j = 0; j < 16; ++j) { const unsigned c = xb_ld(&bar[XB_XCNT(j)]); sum += c; cnt += (c > 0u) ? 1u : 0u; mine = (j == x) ? c : mine; }
        if (sum == G) break;
        __builtin_amdgcn_s_sleep(1);
        if ((++sp & 255u) == 0u) { if (xb_ld(&bar[XB_TMO])) break; if (sp > XB_SPIN_CAP) { atomicAdd(&bar[XB_TMO], 1u); break; } }
    }
    nloc = mine > 0u ? mine : 1u; nx = cnt > 0u ? cnt : 1u;
}
DEVI void gsync(unsigned* bar, volatile LAS unsigned* st, int G, int wv) {
    asm volatile("s_waitcnt vmcnt(0)" ::: "memory");
    __syncthreads();
    const int ln = (int)__builtin_amdgcn_mbcnt_hi(~0u, __builtin_amdgcn_mbcnt_lo(~0u, 0u));
    if (wv == 0 && ln == 0) {
        __builtin_amdgcn_s_waitcnt(0);
        const unsigned x = xb_xcc_id();
        unsigned nloc = st[0], nx = st[1];
        if (nloc == 0u) { xcd_barrier_complete(bar, x, (unsigned)G, nloc, nx); st[0] = nloc; st[1] = nx; }
        const unsigned old = xb_add(&bar[XB_XSUB(x)], 1u);
        const unsigned gen = old / nloc;
        if (old + 1u == (gen + 1u) * nloc) {
            __builtin_amdgcn_fence(__ATOMIC_RELEASE, "agent");
            asm volatile("s_waitcnt vmcnt(0)" ::: "memory");
            const unsigned og = xb_add(&bar[XB_TOP], 1u);
            const unsigned tg = og / nx;
            if (og + 1u == (tg + 1u) * nx) xb_add(&bar[XB_TOPGEN], 1u);
            else XB_SPIN(xb_ld(&bar[XB_TOPGEN]) == tg, bar);
            __builtin_amdgcn_fence(__ATOMIC_ACQUIRE, "agent");
            xb_add(&bar[XB_XGEN(x)], 1u);
            asm volatile("s_waitcnt vmcnt(0)" ::: "memory");
        } else {
            XB_SPIN(xb_ld(&bar[XB_XGEN(x)]) == gen, bar);
            __builtin_amdgcn_fence(__ATOMIC_ACQUIRE, "agent");
            asm volatile("s_waitcnt vmcnt(0)" ::: "memory");
        }
    }
    __syncthreads();
}

__global__ void __launch_bounds__(512) mega(Params p) {
    extern __shared__ __attribute__((aligned(16))) unsigned char shm[];
    cg::grid_group grid = cg::this_grid();
    const int wv = __builtin_amdgcn_readfirstlane(threadIdx.x >> 6);
    const int G = gridDim.x, nwaves = G * 8, nthreads = G * 512;
#define TIDS const int tid = MYTID, wid = tid >> 6, lane = tid & 63, gwave = blockIdx.x * 8 + wid, gtid = blockIdx.x * 512 + tid; (void)gtid; (void)gwave; (void)lane;
    LAS unsigned char* lds = (LAS unsigned char*)shm;
#define WSQ unsigned char* ws = opq64(pw.ws); bf16_t* Hb = (bf16_t*)(ws + WS_H); bf16_t* Pb = (bf16_t*)(ws + WS_P); float* Yb = (float*)(ws + WS_Y); (void)Hb; (void)Pb; (void)Yb;

    const PW pw{p.ws};
    unsigned* bar = (unsigned*)p.ws;
    volatile LAS unsigned* xst = (volatile LAS unsigned*)((LAS unsigned char*)shm + (LDS_BYTES - 16));
    if (threadIdx.x == 0) { xst[0] = 0u; xst[1] = 0u; (void)xb_add(&bar[XB_XCNT(xb_xcc_id())], 1u); }
    __syncthreads();
    for (int rep = 0; rep < REP_CVT; ++rep) {
    mod_phase(pw, shm, wv);
    { TIDS convert_phase(pw, 0, shm, gwave, nwaves, wid, lane); }
    }
    grid.sync();
    { TIDS rowwise_phase(pw, 0, MTOT, 0, 0, 0.f, 0, 0, 0, 0, 0, gwave, nwaves, lane); }
    gsync(bar, xst, G, wv);

#pragma unroll 1
    for (int l = 0; l < DEPTH; ++l) {
        const bool last = l == DEPTH - 1;
#pragma unroll 1
        for (int f = 0; f < 2; ++f) {
            if (f == 1) {
                { WSQ pg8::Gemm g{Hb, (const bf16_t*)(ws + WS_WIN), 68, 31, D, D, 1, 0, 0, 0, 0, D, 0}; pg8::Order S; S.init(68, 31, 1, G, blockIdx.x);
                  pg8::EpiInProj E{Pb, DINP}; for (int rep = 0; rep < REP_GEMM; ++rep) pg8::gemm_phase(lds, g, S, E, wv); }
                gsync(bar, xst, G, wv);
                { TIDS gate_phase(pw, l, gwave, nwaves, lane); }
                gsync(bar, xst, G, wv);
#pragma unroll 1
                for (int rep2 = 0; rep2 < REP_PREPSEQ; ++rep2) {
#pragma unroll 1
                for (int rep = 0; rep < REP_PREP; ++rep)
                {
                    gdn_prep_all(pw, l, blockIdx.x, G, shm, wv);
                    ml_prep_all(pw, l, (blockIdx.x + G / 2) % G, G, shm, wv);
                    for (int it = (blockIdx.x + G / 4) % G; it < 1088; it += G) for (int r3 = 0; r3 < REP_LRU0; ++r3) lru_item(pw, l, it, 0, shm, wv);
                }
                gsync(bar, xst, G, wv);
                for (int u = blockIdx.x; u < 256; u += G) gdn_seq_unit(pw, u, shm, wv);
                { TIDS ml_seq(pw, gtid, nthreads); }
                { TIDS lru_seq(pw, gtid, nthreads); }
                gsync(bar, xst, G, wv);
                }
                gdn_out_all(pw, l, blockIdx.x, G, last, shm, wv);
                ml_out_all(pw, l, (blockIdx.x + G / 4) % G, G, last, shm, wv);
                for (int it = (blockIdx.x + G / 2) % G; it < 1088; it += G) { if (last && ((it >> 2) % NCH) < 4) continue; if (DRY_LO) lru_item(pw, l, it, 1, shm, wv, 1); lru_item(pw, l, it, 1, shm, wv); }
                gsync(bar, xst, G, wv);
                const int nM = last ? 64 : 68;
                { WSQ pg8::Gemm g{Pb, (const bf16_t*)(ws + WS_WBR), nM, 4, 512, DINP, 3, C_MLO, C_LRY, C_DNZ, D * 512, 512, 0}; pg8::Order S; S.init(nM, 4, 3, G, blockIdx.x);
                  pg8::EpiBranch E{Pb, (bf16_t*)Yb, Hb}; for (int rep = 0; rep < REP_BR; ++rep) pg8::gemm_phase(lds, g, S, E, wv); }
                gsync(bar, xst, G, wv);
                { WSQ pg8::Gemm g{Hb, (const bf16_t*)(ws + WS_WOUT), 64, 4, D, D, 1, 0, 0, 0, 0, D, 0}; pg8::Order S; S.init(64, 4, 1, G, blockIdx.x);
                  pg8::EpiBf16Y E{(bf16_t*)Yb, D}; for (int rep = 0; rep < REP_GEMM; ++rep) pg8::gemm_phase(lds, g, S, E, wv); }
                if (!last) { WSQ pg8::Gemm g{Hb, (const bf16_t*)(ws + WS_WOUT), 4, 4, 256, D, 4, 0, 0, 0, 256, D, 256}; pg8::Order S; S.init(4, 4, 4, G, blockIdx.x, 64, 1);
                  pg8::EpiF32 E{(float*)(ws + WS_GB), D, MLAT, (size_t)1024 * D}; pg8::gemm_phase(lds, g, S, E, wv); }
                gsync(bar, xst, G, wv);
                { TIDS if (DRY_ROW) { rowwise_phase(pw, 1, nM * 256, l, 5, 1.f, 3, l, 4, 6, 4, gwave, nwaves, lane, 1); } rowwise_phase(pw, 1, nM * 256, l, 5, 1.f, 3, l, 4, 6, 4, gwave, nwaves, lane); }
                gsync(bar, xst, G, wv);
            }
            const int nM = (last && f == 1) ? 64 : 68;
            { WSQ pg8::Gemm g{Hb, (const bf16_t*)(ws + WS_WGU + f * SZ_WGU), nM, 22, D, D, 1, 0, 0, 0, 0, D, 0}; pg8::Order S; S.init(nM, 22, 1, G, blockIdx.x);
              pg8::EpiSwiGLU E{Pb, DFF}; for (int rep = 0; rep < REP_GU; ++rep) pg8::gemm_phase(lds, g, S, E, wv); }
            gsync(bar, xst, G, wv);
            { WSQ pg8::Gemm g{Pb, (const bf16_t*)(ws + WS_WDN + f * SZ_WDN), 64, 4, DFF, DFF, 1, 0, 0, 0, 0, DFF, 0}; pg8::Order S; S.init(64, 4, 1, G, blockIdx.x);
              pg8::EpiBf16Y E{(bf16_t*)Yb, D}; for (int rep = 0; rep < REP_DN; ++rep) pg8::gemm_phase(lds, g, S, E, wv); }
            if (nM == 68) { WSQ pg8::Gemm g{Pb, (const bf16_t*)(ws + WS_WDN + f * SZ_WDN), 4, 4, 256, DFF, 11, 0, 0, 0, 256, DFF, 256}; pg8::Order S; S.init(4, 4, 11, G, blockIdx.x, 64, 1);
              pg8::EpiF32 E{(float*)(ws + WS_GB), D, MLAT, (size_t)1024 * D}; for (int rep = 0; rep < REP_DNC; ++rep) pg8::gemm_phase(lds, g, S, E, wv); }
            gsync(bar, xst, G, wv);
            if (f == 0) { TIDS if (DRY_ROW) { rowwise_phase(pw, 1, nM * 256, l, 2, 0.5f, 1, l, 2, 3, 11, gwave, nwaves, lane, 1); } rowwise_phase(pw, 1, nM * 256, l, 2, 0.5f, 1, l, 2, 3, 11, gwave, nwaves, lane); }
            else if (!last) { { TIDS if (DRY_ROW) { rowwise_phase(pw, 1, nM * 256, l, 8, 0.5f, 5, l + 1, 0, 0, 11, gwave, nwaves, lane, 1); } rowwise_phase(pw, 1, nM * 256, l, 8, 0.5f, 5, l + 1, 0, 0, 11, gwave, nwaves, lane); } for (int rep = 0; rep < REP_CVT; ++rep) { TIDS convert_phase(pw, l + 1, shm, gwave, nwaves, wid, lane); } }
            else { TIDS rowwise_phase(pw, 2, MLAT, l, 8, 0.5f, 5, 0, 0, 0, 0, gwave, nwaves, lane); }
            gsync(bar, xst, G, wv);
        }
    }
}

extern "C" void kernel_launch(void* const* d_in, const int* in_sizes, int n_in, void* d_out, int out_size, void* d_ws, size_t ws_size, hipStream_t stream) {
    static int grid = 0;
    if (grid == 0) {
        if (n_in != 25 || ws_size < WS_END) { fprintf(stderr, "kernel_launch: unexpected n_in %d or ws_size %zu (need %zu)\n", n_in, ws_size, (size_t)WS_END); grid = -1; return; }
        int dev = 0, cus = 0, per_cu = 0;
        hipGetDevice(&dev); hipDeviceGetAttribute(&cus, hipDeviceAttributeMultiprocessorCount, dev);
        if (hipFuncSetAttribute((const void*)mega, hipFuncAttributeMaxDynamicSharedMemorySize, LDS_BYTES) != hipSuccess) { fprintf(stderr, "kernel_launch: hipFuncSetAttribute failed\n"); grid = -1; return; }
        if (hipOccupancyMaxActiveBlocksPerMultiprocessor(&per_cu, (const void*)mega, 512, LDS_BYTES) != hipSuccess || per_cu < 1) { fprintf(stderr, "kernel_launch: occupancy query failed (%d)\n", per_cu); per_cu = 1; }
        (void)hipGetLastError();
        grid = cus * per_cu;
    }
    if (grid < 0) return;
    if (hipMemsetAsync(d_ws, 0, 16384, stream) != hipSuccess) { fprintf(stderr, "kernel_launch: memset failed\n"); return; }
    Params p{};
    for (int i = 0; i < 25; ++i) p.in[i] = (const float*)d_in[i];
    p.out = (float*)d_out; p.ws = (unsigned char*)d_ws;
    void* args[] = {&p};
    hipError_t e = hipLaunchCooperativeKernel((const void*)mega, dim3(grid), dim3(512), args, LDS_BYTES, stream);
    if (e != hipSuccess) fprintf(stderr, "cooperative launch failed: %s (grid %d)\n", hipGetErrorString(e), grid);
}
```

```cpp
#include <hip/hip_runtime.h>
#include <hip/hip_cooperative_groups.h>
#include <cstdio>
namespace cg = cooperative_groups;

#define LAS __attribute__((address_space(3)))
#define DEVI __device__ __forceinline__
typedef unsigned short bf16_t;
typedef short bf16x8 __attribute__((ext_vector_type(8)));
typedef float f32x4 __attribute__((ext_vector_type(4)));
typedef float f32x2 __attribute__((ext_vector_type(2)));
typedef unsigned u32x4 __attribute__((ext_vector_type(4)));
typedef unsigned u32x2 __attribute__((ext_vector_type(2)));

constexpr int D = 1024, NBATCH = 4, SEQ = 4096, CTXL = 256, DEPTH = 4, DFF = 2816, DINP = 7936;
constexpr int MLAT = NBATCH * SEQ, MTOT = MLAT + NBATCH * CTXL;
constexpr int NCH = 68;
constexpr int C_MLQ = 0, C_MLK = 256, C_MLV = 512, C_MLO = 1024, C_MLG = 1536, C_LRX = 1552, C_LRY = 2064,
              C_DNQ = 2576, C_DNZ = 4112, C_DNBA = 4624, C_GATE = 4640, C_END = 7712;
constexpr float EPS = 1e-6f;

constexpr size_t SZ_WGU = (size_t)2 * DFF * D * 2, SZ_WDN = (size_t)D * DFF * 2;
constexpr size_t WS_MOD = 16384;
constexpr size_t WS_WGU = 1u << 20;
constexpr size_t WS_WDN = WS_WGU + 2 * SZ_WGU;
constexpr size_t WS_WIN = WS_WDN + 2 * SZ_WDN;
constexpr size_t WS_WBR = WS_WIN + (size_t)DINP * D * 2;
constexpr size_t WS_WOUT = WS_WBR + (size_t)3 * D * 512 * 2;
constexpr size_t WS_WLRU = WS_WOUT + (size_t)D * D * 2;
constexpr size_t WS_X = WS_WLRU + (size_t)32 * 64 * 64 * 2;
constexpr size_t WS_H = WS_X + (size_t)MTOT * D * 4;
constexpr size_t WS_Y = WS_H + (size_t)MTOT * D * 2;
constexpr size_t WS_P = WS_Y + (size_t)MTOT * D * 4;
constexpr size_t WS_GU = WS_P + (size_t)MTOT * DINP * 2;
constexpr size_t WS_GB = WS_GU + (size_t)2176 * 64 * 128 * 2;
constexpr size_t WS_GN = WS_GB + (size_t)2176 * 128 * 128 * 2;
constexpr size_t WS_SM = WS_GN + (size_t)2176 * 128 * 128 * 2;
constexpr size_t SM_GDEC = 0, SM_MN = 16384, SM_MSC = SM_MN + 2176 * 64 * 4, SM_MM = SM_MSC + 2176 * 8, SM_LAGG = SM_MM + 2176 * 4 + 1024;
constexpr size_t WS_YC = WS_SM + SM_LAGG + (size_t)2 * 4 * NCH * 512 * 2 * 4 + 4096;
constexpr size_t WS_GATES = WS_YC;
constexpr size_t WS_END = WS_GATES + (size_t)2 * 2176 * 320 * 4 + 4096;
constexpr int LDS_BYTES = 155648;
constexpr int REP_BR = 1, REP_GU = 1, REP_DN = 1, REP_DNC = 1, REP_GEMM = 1, DRY_ROW = 0, REP_PREP = 1, REP_PREPSEQ = 1, REP_CVT = 1, REP_GDNP = 1, REP_MLP = 1, REP_LRU0 = 1, DRY_GO = 0, DRY_MO = 0, DRY_LO = 0;

struct Params { const float* in[25]; float* out; unsigned char* ws; };
struct PW { unsigned char* ws; };

#define CAS __attribute__((address_space(4)))
DEVI const float* pin(int i) { const CAS char* k = (const CAS char*)__builtin_amdgcn_kernarg_segment_ptr(); return *(const float* const volatile CAS*)(k + 8 * i); }
DEVI int opaque(int v) { asm volatile("" : "+v"(v)); return v; }
DEVI unsigned char* opq(unsigned char* p) { unsigned v = (unsigned)(size_t)(LAS unsigned char*)p; asm volatile("" : "+s"(v)); return (unsigned char*)(LAS unsigned char*)(size_t)v; }
DEVI LAS unsigned char* opql(LAS unsigned char* p) { unsigned v = (unsigned)(size_t)p; asm volatile("" : "+s"(v)); return (LAS unsigned char*)(size_t)v; }
DEVI unsigned char* opq64(unsigned char* p) { unsigned long long v = (unsigned long long)p; asm volatile("" : "+s"(v)); return (unsigned char*)v; }
#define MYTID opaque(wv * 64 + (int)__builtin_amdgcn_mbcnt_hi(~0u, __builtin_amdgcn_mbcnt_lo(~0u, 0u)))
DEVI float bf2f(bf16_t v) { return __uint_as_float(((unsigned)v) << 16); }
DEVI unsigned f2bf(float f) { unsigned u = __float_as_uint(f); return (u + 0x7fffu + ((u >> 16) & 1u)) >> 16; }
DEVI unsigned pk2(float lo, float hi) { return f2bf(lo) | (f2bf(hi) << 16); }
DEVI float sigm(float x) { return __builtin_amdgcn_rcpf(1.f + __expf(-x)); }
DEVI float silu(float x) { return x * sigm(x); }
DEVI float softplus(float x) { return x > 20.f ? x : log1pf(__expf(x)); }
DEVI float logsig(float x) { return fminf(x, 0.f) - log1pf(__expf(-fabsf(x))); }
DEVI float gelu_t(float x) { float u = 0.7978845608f * (x + 0.044715f * x * x * x); float e = __expf(2.f * u); return x * (1.f - __builtin_amdgcn_rcpf(e + 1.f)); }
DEVI float wsum(float v) { for (int o = 32; o > 0; o >>= 1) v += __shfl_xor(v, o, 64); return v; }
DEVI float wmax(float v) { for (int o = 32; o > 0; o >>= 1) v = fmaxf(v, __shfl_xor(v, o, 64)); return v; }
DEVI void unpack8(u32x4 r, float* f) {
    f[0] = __uint_as_float(r[0] << 16); f[1] = __uint_as_float(r[0] & 0xffff0000u); f[2] = __uint_as_float(r[1] << 16); f[3] = __uint_as_float(r[1] & 0xffff0000u);
    f[4] = __uint_as_float(r[2] << 16); f[5] = __uint_as_float(r[2] & 0xffff0000u); f[6] = __uint_as_float(r[3] << 16); f[7] = __uint_as_float(r[3] & 0xffff0000u);
}
DEVI u32x4 pack8(const float* f) { u32x4 r; r[0] = pk2(f[0], f[1]); r[1] = pk2(f[2], f[3]); r[2] = pk2(f[4], f[5]); r[3] = pk2(f[6], f[7]); return r; }
DEVI bf16x8 ldfrag(const bf16_t* base, int ld, int row0, int k0, int lane) { return *(const bf16x8*)(base + (row0 + (lane & 15)) * ld + k0 + (lane >> 4) * 8); }
DEVI int tix(int row, int col) { return row * 72 + ((((col >> 3) + (row >> 3)) & 7) << 3) + (col & 7); }
DEVI bf16x8 ldfragT(const bf16_t* base, int row0, int k0, int lane) { const int r = row0 + (lane & 15), lg = (k0 >> 3) + (lane >> 4); return *(const bf16x8*)(base + r * 72 + (((lg + (r >> 3)) & 7) << 3)); }
DEVI void lbar() { asm volatile("s_waitcnt lgkmcnt(0)" ::: "memory"); __builtin_amdgcn_s_barrier(); asm volatile("" ::: "memory"); }
#define MFMA16(a, b, c) __builtin_amdgcn_mfma_f32_16x16x32_bf16(a, b, c, 0, 0, 0)

namespace pg8 {
constexpr int BM = 256, BK = 64, HALF = 128, HTB = HALF * BK * 2, NXCD = 8, WGM = 8;
DEVI int lds_byte(int r, int c) { const int st = (r >> 4) * 2 + (c >> 5), rr = r & 15, cc = c & 31, ob = rr * 64 + cc * 2; return st * 1024 + (ob ^ (((ob >> 9) & 1) << 5)); }
DEVI void stage_rc(int b, int& R, int& C) { const int st = b / 1024, sb = b % 1024, swz = sb ^ (((sb >> 9) & 1) << 5); R = (st >> 1) * 16 + swz / 64; C = (st & 1) * 32 + (swz % 64) / 2; }
DEVI int perm32(int rho) { const int n = rho >> 4, i = rho & 15; return 8 * (i >> 2) + 4 * n + (i & 3); }
struct Unit { int pm, pn, z; };
struct Gemm { const bf16_t* A; const bf16_t* Bt; int nM, nN, K, lda, nz, zA0, zA1, zA2, zB; int ldb, zAstep; };
struct Order {
    int nM, nN, nwg, G, c, nz, pm0, spread;
    DEVI void init(int nM_, int nN_, int nz_, int G_, int c_, int pm0_ = 0, int spread_ = 0) { nM = nM_; nN = nN_; nwg = nM * nN; G = G_; c = c_; nz = nz_; pm0 = pm0_; spread = spread_; }
    DEVI bool next(int i, Unit& u) const {
        int ti = i, z = 0; long L;
        if (spread) { L = (long)i * G + c; if (L >= (long)nwg * nz) return false; z = (int)(L / nwg); L -= (long)z * nwg; }
        else { if (nz == 3) { ti = i / 3; z = i - ti * 3; } L = (long)ti * G + c; if (L >= nwg) return false; }
        int wgid = (int)L; { const int q = nwg / NXCD, r = nwg % NXCD, xcd = wgid % NXCD, off = wgid / NXCD; wgid = (xcd < r ? xcd * (q + 1) : r * (q + 1) + (xcd - r) * q) + off; }
        const int nig = WGM * nN, gid = wgid / nig, fm = gid * WGM, gsz = (nM - fm) < WGM ? (nM - fm) : WGM;
        u.pm = pm0 + fm + ((wgid % nig) % gsz); u.pn = (wgid % nig) / gsz; u.z = z; return true;
    }
};

template <class Epi>
DEVI void gemm_phase(LAS unsigned char* lds_in, const Gemm g, const Order& S, const Epi& E, int wv) {
    LAS unsigned char* lds = opql(lds_in);
    const int tid = MYTID, wid = __builtin_amdgcn_readfirstlane(tid >> 6), lane = tid & 63, wr = wid >> 2, wc = wid & 3, fr = lane & 15, fq = lane >> 4;
    const int K = g.K, nt = K / BK, lda = g.lda, ldb = g.ldb;
    unsigned voffA[2], voffB[2];
#pragma unroll
    for (int i = 0; i < 2; ++i) { int R, C; stage_rc(tid * 16 + i * 8192, R, C); const int Rb = Epi::PERM ? ((R & ~31) + perm32(R & 31)) : R;
        voffA[i] = (unsigned)(R * lda + C) * 2u; voffB[i] = (unsigned)(Rb * ldb + C) * 2u; }
    const size_t kstep = (size_t)(BK * 2);
    const size_t hstepA = (size_t)HALF * lda * 2, hstepB = (size_t)HALF * ldb * 2;
    const unsigned ldsw = (unsigned)wid * 1024u;
    const int aoff = lds_byte(wr * 64 + fr, fq * 8), boff = lds_byte(wc * 32 + fr, fq * 8);
#define PG8_SA(b, h) (((b) * 2 + (h)) * HTB)
#define PG8_SB(b, h) ((4 + (b) * 2 + (h)) * HTB)
#define PG8_STAGE(bufoff, gbase, voff) do { _Pragma("unroll") for (int _i = 0; _i < 2; ++_i) \
        __builtin_amdgcn_global_load_lds((const unsigned*)((const char*)(gbase) + (voff)[_i]), (LAS unsigned*)(lds + (bufoff) + ldsw + _i * 8192), 16, 0, 0); } while (0)
#define PG8_LDA(dst, b, h) do { _Pragma("unroll") for (int m = 0; m < 4; ++m) _Pragma("unroll") for (int k = 0; k < 2; ++k) dst[m][k] = *(const LAS bf16x8*)(lds + PG8_SA(b, h) + aoff + m * 2048 + k * 1024); } while (0)
#define PG8_LDB(dst, b, h) do { _Pragma("unroll") for (int n = 0; n < 2; ++n) _Pragma("unroll") for (int k = 0; k < 2; ++k) dst[n][k] = *(const LAS bf16x8*)(lds + PG8_SB(b, h) + boff + n * 2048 + k * 1024); } while (0)
#define PG8_MMA(ai, bj, At, Bt) do { __builtin_amdgcn_s_setprio(1); _Pragma("unroll") for (int m = 0; m < 4; ++m) _Pragma("unroll") for (int n = 0; n < 2; ++n) _Pragma("unroll") for (int k = 0; k < 2; ++k) \
        acc[ai][bj][m][n] = __builtin_amdgcn_mfma_f32_16x16x32_bf16(Bt[n][k], At[m][k], acc[ai][bj][m][n], 0, 0, 0); __builtin_amdgcn_s_setprio(0); } while (0)
#define PG8_WAIT_V(n) asm volatile("s_waitcnt vmcnt(" #n ")" ::: "memory")
#define PG8_WAIT_L(n) asm volatile("s_waitcnt lgkmcnt(" #n ")" ::: "memory")
#define PG8_BAR __builtin_amdgcn_s_barrier()
#define PG8_SCHED __builtin_amdgcn_sched_barrier(0)
#define PG8_PA(u) ((const char*)g.A + ((size_t)(g.nz == 3 ? ((u).z == 0 ? g.zA0 : ((u).z == 1 ? g.zA1 : g.zA2)) : (u).z * g.zAstep) + (size_t)(u).pm * BM * lda) * 2)
#define PG8_PB(u) ((const char*)g.Bt + ((size_t)(u).z * g.zB + (size_t)(u).pn * BM * ldb) * 2)
    Unit cur, nxt; int ui = 0;
    if (!S.next(0, cur)) return;
    f32x4 acc[2][2][4][2];
#pragma unroll
    for (int a = 0; a < 2; ++a)
#pragma unroll
        for (int b = 0; b < 2; ++b)
#pragma unroll
            for (int m = 0; m < 4; ++m)
#pragma unroll
                for (int n = 0; n < 2; ++n) acc[a][b][m][n] = (f32x4){0.f, 0.f, 0.f, 0.f};
    bf16x8 At[4][2], B0[2][2], B1[2][2];
    const char* cA = PG8_PA(cur); const char* cB = PG8_PB(cur);
    PG8_STAGE(PG8_SB(0, 0), cB, voffB); PG8_STAGE(PG8_SA(0, 0), cA, voffA); PG8_STAGE(PG8_SB(0, 1), cB + hstepB, voffB); PG8_STAGE(PG8_SA(0, 1), cA + hstepA, voffA);
    if (wr == 1) PG8_BAR;
    PG8_WAIT_V(4); PG8_BAR;
    PG8_STAGE(PG8_SB(1, 0), cB + kstep, voffB); PG8_STAGE(PG8_SA(1, 0), cA + kstep, voffA); PG8_STAGE(PG8_SB(1, 1), cB + hstepB + kstep, voffB);
    PG8_WAIT_V(6); PG8_BAR;
    for (;;) {
        const bool has_next = S.next(ui + 1, nxt);
        const char* nA = has_next ? PG8_PA(nxt) : cA; const char* nB = has_next ? PG8_PB(nxt) : cB;
        for (int t = 0; t < nt; t += 2) {
            const bool last = (t == nt - 2);
            const char* a1 = cA + (size_t)(t + 1) * kstep;
            const char* a2 = last ? nA : cA + (size_t)(t + 2) * kstep; const char* b2 = last ? nB : cB + (size_t)(t + 2) * kstep;
            const char* a3 = a2 + kstep; const char* b3 = b2 + kstep;
            PG8_LDB(B0, 0, 0); PG8_SCHED; PG8_LDA(At, 0, 0); PG8_STAGE(PG8_SA(1, 1), a1 + hstepA, voffA);
            PG8_WAIT_L(8); PG8_BAR; PG8_WAIT_L(0); PG8_MMA(0, 0, At, B0); PG8_BAR; PG8_SCHED;
            PG8_LDB(B1, 0, 1); PG8_STAGE(PG8_SB(0, 0), b2, voffB);
            PG8_BAR; PG8_WAIT_L(0); PG8_MMA(0, 1, At, B1); PG8_BAR;
            PG8_LDA(At, 0, 1); PG8_STAGE(PG8_SA(0, 0), a2, voffA);
            PG8_BAR; PG8_WAIT_L(0); PG8_MMA(1, 0, At, B0); PG8_BAR; PG8_SCHED;
            PG8_STAGE(PG8_SB(0, 1), b2 + hstepB, voffB);
            PG8_WAIT_V(6); PG8_BAR; PG8_MMA(1, 1, At, B1); PG8_BAR;
            PG8_LDB(B0, 1, 0); PG8_SCHED; PG8_LDA(At, 1, 0); PG8_STAGE(PG8_SA(0, 1), a2 + hstepA, voffA);
            PG8_WAIT_L(8); PG8_BAR; PG8_WAIT_L(0); PG8_MMA(0, 0, At, B0); PG8_BAR; PG8_SCHED;
            PG8_LDB(B1, 1, 1); PG8_STAGE(PG8_SB(1, 0), b3, voffB);
            PG8_BAR; PG8_WAIT_L(0); PG8_MMA(0, 1, At, B1); PG8_BAR;
            PG8_LDA(At, 1, 1); PG8_STAGE(PG8_SA(1, 0), a3, voffA);
            PG8_BAR; PG8_WAIT_L(0); PG8_MMA(1, 0, At, B0); PG8_BAR; PG8_SCHED;
            PG8_STAGE(PG8_SB(1, 1), b3 + hstepB, voffB);
            PG8_WAIT_V(6); PG8_BAR; PG8_MMA(1, 1, At, B1); PG8_BAR;
        }
        E(acc, cur, wr, wc, fr, fq);
        if (!has_next) break;
#pragma unroll
        for (int a = 0; a < 2; ++a)
#pragma unroll
            for (int b = 0; b < 2; ++b)
#pragma unroll
                for (int m = 0; m < 4; ++m)
#pragma unroll
                    for (int n = 0; n < 2; ++n) acc[a][b][m][n] = (f32x4){0.f, 0.f, 0.f, 0.f};
        cur = nxt; cA = nA; cB = nB; ++ui;
    }
    PG8_WAIT_V(0);
    if (wr == 0) PG8_BAR;
    PG8_BAR;
#undef PG8_SA
#undef PG8_SB
#undef PG8_STAGE
#undef PG8_LDA
#undef PG8_LDB
#undef PG8_MMA
#undef PG8_WAIT_V
#undef PG8_WAIT_L
#undef PG8_BAR
#undef PG8_SCHED
#undef PG8_PA
#undef PG8_PB
}

struct EpiF32 {
    static constexpr bool PERM = false;
    float* C; int ldc; int row_base; size_t zstride;
    DEVI void operator()(const f32x4 (&acc)[2][2][4][2], const Unit& u, int wr, int wc, int fr, int fq) const {
        const int row0 = u.pm * BM + wr * 64 + fr - row_base, col0 = u.pn * BM + wc * 32 + 4 * fq;
#pragma unroll
        for (int ai = 0; ai < 2; ++ai)
#pragma unroll
            for (int m = 0; m < 4; ++m) { float* rowp = C + (size_t)u.z * zstride + (size_t)(row0 + ai * HALF + m * 16) * ldc + col0;
#pragma unroll
                for (int bj = 0; bj < 2; ++bj)
#pragma unroll
                    for (int n = 0; n < 2; ++n) *(f32x4*)(rowp + bj * HALF + n * 16) = acc[ai][bj][m][n]; }
    }
};
struct EpiBf16Y {
    static constexpr bool PERM = true;
    bf16_t* O; int ldc;
    DEVI void operator()(const f32x4 (&acc)[2][2][4][2], const Unit& u, int wr, int wc, int fr, int fq) const {
        const int row0 = u.pm * BM + wr * 64 + fr;
#pragma unroll
        for (int bj = 0; bj < 2; ++bj) { const int c0 = u.pn * BM + bj * HALF + wc * 32 + 8 * fq;
#pragma unroll
            for (int ai = 0; ai < 2; ++ai)
#pragma unroll
                for (int m = 0; m < 4; ++m) { float v[8];
#pragma unroll
                    for (int n = 0; n < 2; ++n)
#pragma unroll
                        for (int i = 0; i < 4; ++i) v[n * 4 + i] = acc[ai][bj][m][n][i];
                    *(u32x4*)(O + (size_t)(row0 + ai * HALF + m * 16) * ldc + c0) = pack8(v); } }
    }
};
struct EpiAtomic {
    static constexpr bool PERM = false;
    float* C; int ldc; int row_base;
    DEVI void operator()(const f32x4 (&acc)[2][2][4][2], const Unit& u, int wr, int wc, int fr, int fq) const {
        const int row0 = u.pm * BM + wr * 64 + fr - row_base, col0 = u.pn * BM + wc * 32 + 4 * fq;
#pragma unroll
        for (int ai = 0; ai < 2; ++ai)
#pragma unroll
            for (int m = 0; m < 4; ++m) { float* rowp = C + (size_t)(row0 + ai * HALF + m * 16) * ldc + col0;
#pragma unroll
                for (int bj = 0; bj < 2; ++bj)
#pragma unroll
                    for (int n = 0; n < 2; ++n)
#pragma unroll
                        for (int e = 0; e < 4; ++e) __hip_atomic_fetch_add(rowp + bj * HALF + n * 16 + e, acc[ai][bj][m][n][e], __ATOMIC_RELAXED, __HIP_MEMORY_SCOPE_AGENT); }
    }
};
struct EpiSwiGLU {
    static constexpr bool PERM = false;
    bf16_t* O; int ldc;
    DEVI void operator()(const f32x4 (&acc)[2][2][4][2], const Unit& u, int wr, int wc, int fr, int fq) const {
        const int row0 = u.pm * BM + wr * 64 + fr, col0 = u.pn * 128 + wc * 32 + 8 * fq;
#pragma unroll
        for (int ai = 0; ai < 2; ++ai)
#pragma unroll
            for (int m = 0; m < 4; ++m) {
                float v[8];
#pragma unroll
                for (int bj = 0; bj < 2; ++bj)
#pragma unroll
                    for (int i = 0; i < 4; ++i) { const float gt = acc[ai][bj][m][0][i], up = acc[ai][bj][m][1][i]; v[bj * 4 + i] = silu(gt) * up; }
                *(u32x4*)(O + (size_t)(row0 + ai * HALF + m * 16) * ldc + col0) = pack8(v);
            }
    }
};
struct EpiInProj {
    static constexpr bool PERM = true;
    bf16_t* O; int ldc;
    DEVI void operator()(const f32x4 (&acc)[2][2][4][2], const Unit& u, int wr, int wc, int fr, int fq) const {
        const int row0 = u.pm * BM + wr * 64 + fr;
#pragma unroll
        for (int bj = 0; bj < 2; ++bj) {
            const int c0 = u.pn * BM + bj * HALF + wc * 32 + 8 * fq;
            int kind = 0;
            if (c0 >= C_MLO && c0 < C_MLG) kind = 1; else if (c0 >= C_LRY && c0 < C_DNQ) kind = 2; else if (c0 >= C_DNZ && c0 < C_DNBA) kind = 3; else if (c0 >= C_GATE) kind = 1;
#define INPROJ_STORE(FN) _Pragma("unroll") for (int ai = 0; ai < 2; ++ai) _Pragma("unroll") for (int m = 0; m < 4; ++m) { float v[8]; \
                _Pragma("unroll") for (int n = 0; n < 2; ++n) _Pragma("unroll") for (int i = 0; i < 4; ++i) { const float x = acc[ai][bj][m][n][i]; v[n * 4 + i] = FN; } \
                *(u32x4*)(O + (size_t)(row0 + ai * HALF + m * 16) * ldc + c0) = pack8(v); }
            if (kind == 0) { INPROJ_STORE(x) } else if (kind == 1) { INPROJ_STORE(sigm(x)) } else if (kind == 2) { INPROJ_STORE(gelu_t(x)) } else { INPROJ_STORE(silu(x)) }
#undef INPROJ_STORE
        }
    }
};
struct EpiBranch {
    static constexpr bool PERM = false;
    const bf16_t* P; bf16_t* T; bf16_t* U;
    DEVI void operator()(const f32x4 (&acc)[2][2][4][2], const Unit& u, int wr, int wc, int fr, int fq) const {
        const int row0 = u.pm * BM + wr * 64 + fr, col0 = u.pn * BM + wc * 32 + 4 * fq; const int z = u.z;
        bf16_t* dst = z < 2 ? T : U;
#pragma unroll
        for (int ai = 0; ai < 2; ++ai)
#pragma unroll
            for (int mh = 0; mh < 2; ++mh) {
                u32x2 gr[2][2][2], tv[2][2][2];
#pragma unroll
                for (int mm = 0; mm < 2; ++mm) { const size_t row = (size_t)(row0 + ai * HALF + (mh * 2 + mm) * 16);
#pragma unroll
                    for (int bj = 0; bj < 2; ++bj)
#pragma unroll
                        for (int n = 0; n < 2; ++n) { const int col = col0 + bj * HALF + n * 16;
                            gr[mm][bj][n] = *(const u32x2*)(P + row * DINP + C_GATE + z * D + col);
                            tv[mm][bj][n] = (u32x2){0u, 0u};
                            if (z > 0) tv[mm][bj][n] = *(const u32x2*)(T + row * D + col); } }
#pragma unroll
                for (int mm = 0; mm < 2; ++mm) { const size_t row = (size_t)(row0 + ai * HALF + (mh * 2 + mm) * 16);
#pragma unroll
                    for (int bj = 0; bj < 2; ++bj)
#pragma unroll
                        for (int n = 0; n < 2; ++n) { const int col = col0 + bj * HALF + n * 16;
                            const u32x2 g2 = gr[mm][bj][n], t2 = tv[mm][bj][n]; f32x4 a = acc[ai][bj][mh * 2 + mm][n];
                            a[0] = a[0] * __uint_as_float(g2[0] << 16) + __uint_as_float(t2[0] << 16); a[1] = a[1] * __uint_as_float(g2[0] & 0xffff0000u) + __uint_as_float(t2[0] & 0xffff0000u);
                            a[2] = a[2] * __uint_as_float(g2[1] << 16) + __uint_as_float(t2[1] << 16); a[3] = a[3] * __uint_as_float(g2[1] & 0xffff0000u) + __uint_as_float(t2[1] & 0xffff0000u);
                            u32x2 w; w[0] = pk2(a[0], a[1]); w[1] = pk2(a[2], a[3]); *(u32x2*)(dst + row * D + col) = w; } }
            }
    }
};
struct EpiBranchPart {
    static constexpr bool PERM = false;
    const bf16_t* P; float* PART;
    DEVI void operator()(const f32x4 (&acc)[2][2][4][2], const Unit& u, int wr, int wc, int fr, int fq) const {
        const int row0 = u.pm * BM + wr * 64 + fr, col0 = u.pn * BM + wc * 32 + 4 * fq; const int z = u.z;
#pragma unroll
        for (int ai = 0; ai < 2; ++ai)
#pragma unroll
            for (int mh = 0; mh < 2; ++mh) {
                u32x2 gr[2][2][2];
#pragma unroll
                for (int mm = 0; mm < 2; ++mm) { const size_t row = (size_t)(row0 + ai * HALF + (mh * 2 + mm) * 16);
#pragma unroll
                    for (int bj = 0; bj < 2; ++bj)
#pragma unroll
                        for (int n = 0; n < 2; ++n) gr[mm][bj][n] = *(const u32x2*)(P + row * DINP + C_GATE + z * D + col0 + bj * HALF + n * 16); }
#pragma unroll
                for (int mm = 0; mm < 2; ++mm) { const size_t row = (size_t)(row0 + ai * HALF + (mh * 2 + mm) * 16);
#pragma unroll
                    for (int bj = 0; bj < 2; ++bj)
#pragma unroll
                        for (int n = 0; n < 2; ++n) { const int col = col0 + bj * HALF + n * 16;
                            const u32x2 g2 = gr[mm][bj][n]; f32x4 a = acc[ai][bj][mh * 2 + mm][n];
                            a[0] *= __uint_as_float(g2[0] << 16); a[1] *= __uint_as_float(g2[0] & 0xffff0000u); a[2] *= __uint_as_float(g2[1] << 16); a[3] *= __uint_as_float(g2[1] & 0xffff0000u);
                            *(f32x4*)(PART + ((size_t)z * 1024 + (row - MLAT)) * D + col) = a; } }
            }
    }
};
}

DEVI int tok_row(bool gdn, int dir, int b, int c, int t) {
    if (c < 4) { int p = c * 64 + t; if (dir) p = 255 - p; return MLAT + b * 256 + p; }
    int p = (c - 4) * 64 + t; if (dir) p = 4095 - p;
    const int s = gdn ? ((p & 63) * 64 + (p >> 6)) : p;
    return b * 4096 + s;
}
DEVI int pos_row(bool gdn, int b, bool isctx, int p) {
    if (isctx) { if (p < 0 || p >= 256) return -1; return MLAT + b * 256 + p; }
    if (p < 0 || p >= 4096) return -1;
    const int s = gdn ? ((p & 63) * 64 + (p >> 6)) : p;
    return b * 4096 + s;
}
DEVI int dir_chunk(int dir, int j) { return dir ? (j < 4 ? 3 - j : 71 - j) : j; }

DEVI int gu_rowmap(int s) {
    const int n = s >= DFF ? 1 : 0, a = s - n * DFF, pn = a >> 7, r = a & 127, wc = r >> 5, fq = (r >> 3) & 3, bj = (r >> 2) & 1, i = r & 3;
    return 256 * pn + 128 * bj + 32 * wc + 16 * n + 4 * fq + i;
}
DEVI void cvt_tile(const float* src, int ldsrc, int Nvalid, int k0, int n0, bf16_t* dst, int lddst, int mode, float* buf, int lane) {
    f32x4 vv[16];
#pragma unroll
    for (int it = 0; it < 16; ++it) {
        const int row = it * 4 + (lane >> 4), c4 = (lane & 15) * 4;
        vv[it] = (f32x4){0.f, 0.f, 0.f, 0.f};
        if (n0 + c4 < Nvalid) vv[it] = *(const f32x4*)(src + (size_t)(k0 + row) * ldsrc + n0 + c4);
    }
#pragma unroll
    for (int it = 0; it < 16; ++it) {
        const int row = it * 4 + (lane >> 4), c4 = (lane & 15) * 4;
        float* bp = buf + row * 65 + c4; bp[0] = vv[it][0]; bp[1] = vv[it][1]; bp[2] = vv[it][2]; bp[3] = vv[it][3];
    }
    asm volatile("s_waitcnt lgkmcnt(0)" ::: "memory"); __builtin_amdgcn_wave_barrier();
#pragma unroll 2
    for (int it = 0; it < 8; ++it) {
        const int nc = it * 8 + (lane >> 3), kk = (lane & 7) * 8;
        float f[8];
#pragma unroll
        for (int e = 0; e < 8; ++e) f[e] = buf[(kk + e) * 65 + nc];
        const int drow = mode == 1 ? gu_rowmap(n0 + nc) : (n0 + nc);
        *(u32x4*)(dst + (size_t)drow * lddst + k0 + kk) = pack8(f);
    }
    asm volatile("s_waitcnt lgkmcnt(0)" ::: "memory"); __builtin_amdgcn_wave_barrier();
}
DEVI void convert_phase(const PW& pw0, int l, unsigned char* shm_in, int gwave, int nwaves, int wid, int lane) {
    const PW p{opq64(pw0.ws)};
    unsigned char* shm = opq(shm_in);
    float* buf = (float*)shm + wid * (64 * 65);
    unsigned char* ws = p.ws;
    for (int t = gwave; t < 6880; t += nwaves) {
        int r = t;
        if (r < 2816) { const int f = r / 1408; r -= f * 1408; const int kt = r / 88, ntl = r % 88;
            cvt_tile(pin(7) + ((size_t)(l * 2 + f)) * D * 2 * DFF, 2 * DFF, 2 * DFF, kt * 64, ntl * 64, (bf16_t*)(ws + WS_WGU + f * SZ_WGU), D, 1, buf, lane); continue; }
        r -= 2816;
        if (r < 1408) { const int f = r / 704; r -= f * 704; const int kt = r / 16, ntl = r % 16;
            cvt_tile(pin(8) + ((size_t)(l * 2 + f)) * DFF * D, D, D, kt * 64, ntl * 64, (bf16_t*)(ws + WS_WDN + f * SZ_WDN), DFF, 0, buf, lane); continue; }
        r -= 1408;
        if (r < 1984) { const int kt = r / 124, ntl = r % 124;
            cvt_tile(pin(9) + (size_t)l * D * C_END, C_END, C_END, kt * 64, ntl * 64, (bf16_t*)(ws + WS_WIN), D, 0, buf, lane); continue; }
        r -= 1984;
        if (r < 384) { const int n = r / 128; r -= n * 128; const int kt = r / 16, ntl = r % 16;
            cvt_tile(pin(23) + ((size_t)(l * 3 + n)) * 512 * D, D, D, kt * 64, ntl * 64, (bf16_t*)(ws + WS_WBR) + (size_t)n * D * 512, 512, 0, buf, lane); continue; }
        r -= 384;
        if (r < 256) { const int kt = r / 16, ntl = r % 16;
            cvt_tile(pin(24) + (size_t)l * D * D, D, D, kt * 64, ntl * 64, (bf16_t*)(ws + WS_WOUT), D, 0, buf, lane); continue; }
        r -= 256;
        { const int gate = r >> 4, dn = r & 15;
            cvt_tile(pin(gate ? 16 : 14) + ((size_t)l * 16 + dn) * 4096, 64, 64, 0, 0, (bf16_t*)(ws + WS_WLRU) + (size_t)(gate * 16 + dn) * 4096, 64, 0, buf, lane); }
    }
}

DEVI void mod_phase(const PW& pw0, unsigned char* shm_in, int wv) {
    const PW p{opq64(pw0.ws)};
    unsigned char* shm = opq(shm_in);
    float* sC = (float*)shm;
    float* red = sC + 5 * 1024;
    const int tid = MYTID;
    __syncthreads();
    for (int i = tid; i < 5 * 1024; i += 512) { const int v = i >> 10, k = i & 1023; const float x = v < 4 ? pin(1)[v * 1024 + k] : pin(3)[k]; sC[i] = silu(x); }
    __syncthreads();
    float* MOD = (float*)(p.ws + WS_MOD);
    const int cgp = tid & 15, is = tid >> 4;
    for (int task = blockIdx.x; task < DEPTH * 144; task += gridDim.x) {
        const int l = task / 144, col0 = (task % 144) * 64;
        float acc[5][4];
#pragma unroll
        for (int v = 0; v < 5; ++v)
#pragma unroll
            for (int e = 0; e < 4; ++e) acc[v][e] = 0.f;
        const float* wp = pin(4) + ((size_t)l * 1024 + is * 32) * 9216 + col0 + cgp * 4;
#pragma unroll 16
        for (int r = 0; r < 32; ++r) {
            const f32x4 w = *(const f32x4*)(wp + (size_t)r * 9216);
#pragma unroll
            for (int v = 0; v < 5; ++v) { const float s = sC[v * 1024 + is * 32 + r];
#pragma unroll
                for (int e = 0; e < 4; ++e) acc[v][e] += s * w[e]; }
        }
#pragma unroll
        for (int v = 0; v < 5; ++v)
#pragma unroll
            for (int e = 0; e < 4; ++e) red[tid * 20 + v * 4 + e] = acc[v][e];
        __syncthreads();
        if (tid < 320) { const int v = tid >> 6, c = tid & 63; float s = 0.f;
            for (int k = 0; k < 32; ++k) s += red[(k * 16 + (c >> 2)) * 20 + v * 4 + (c & 3)];
            MOD[((size_t)(l * 5 + v)) * 9216 + col0 + c] = s + pin(5)[(size_t)l * 9216 + col0 + c]; }
        __syncthreads();
    }
}

DEVI void rowwise_phase(const PW& pw0, int mode, int nrows, int l, int kgate, float coef, int gpost_i, int ln, int gpre_i, int kshift, int nzc, int gwave, int nwaves, int lane, int dry = 0) {
    const PW p{opq64(pw0.ws)};
      bf16_t* X = (bf16_t*)(p.ws + WS_X); bf16_t* Xw = dry ? (bf16_t*)(p.ws + WS_GN) : X; const float* Y0 = (const float*)(p.ws + WS_Y); const float* YC = (const float*)(p.ws + WS_GB); bf16_t* H = dry ? (bf16_t*)(p.ws + WS_GU) : (bf16_t*)(p.ws + WS_H);
    const float* MOD = (const float*)(p.ws + WS_MOD);
    const int co = lane * 4;
    u32x2 yq[4]; u32x2 xq[4];
#pragma unroll
    for (int i = 0; i < 4; ++i) { yq[i] = (u32x2){0u, 0u}; xq[i] = (u32x2){0u, 0u}; }
    if (mode != 0 && gwave < nrows && gwave < MLAT) {
#pragma unroll
        for (int i = 0; i < 4; ++i) { yq[i] = *(const u32x2*)((const bf16_t*)Y0 + (size_t)gwave * D + co + 256 * i); xq[i] = *(const u32x2*)(X + (size_t)gwave * D + co + 256 * i); }
    }
    for (int row = gwave; row < nrows; row += nwaves) {
        const int v = row < MLAT ? (row >> 12) : 4;
        f32x4 x[4], y[4];
        f32x4 pg[4], pm[4], qg[4], qa[4], qs[4];
        if (mode == 0) {
            const float* src = row < MLAT ? pin(0) + (size_t)row * D : pin(2) + (size_t)(row - MLAT) * D;
#pragma unroll
            for (int i = 0; i < 4; ++i) x[i] = *(const f32x4*)(src + co + 256 * i);
        {
            const float* gp = pin(6) + ((size_t)l * 6 + gpost_i) * D; const float* gt = MOD + ((size_t)(l * 5 + v) * 9 + kgate) * D;
            const float* gq = pin(6) + ((size_t)ln * 6 + gpre_i) * D; const float* sh = MOD + ((size_t)(ln * 5 + v) * 9 + kshift) * D; const float* sc = sh + D;
#pragma unroll
            for (int i = 0; i < 4; ++i) { pg[i] = *(const f32x4*)(gp + co + 256 * i); pm[i] = *(const f32x4*)(gt + co + 256 * i);
                qg[i] = *(const f32x4*)(gq + co + 256 * i); qa[i] = *(const f32x4*)(sh + co + 256 * i); qs[i] = *(const f32x4*)(sc + co + 256 * i); }
        }
        } else {
            if (row >= MLAT) {
                const float* Y = YC + (size_t)(row - MLAT) * D;
#pragma unroll
                for (int ih = 0; ih < 2; ++ih) {
                    f32x4 t[11][2];
#pragma unroll
                    for (int z = 0; z < 11; ++z)
#pragma unroll
                        for (int i2 = 0; i2 < 2; ++i2) t[z][i2] = z < nzc ? *(const f32x4*)(Y + (size_t)z * 1024 * D + co + 256 * (ih * 2 + i2)) : (f32x4){0.f, 0.f, 0.f, 0.f};
#pragma unroll
                    for (int i2 = 0; i2 < 2; ++i2) { f32x4 a = t[0][i2];
#pragma unroll
                        for (int z = 1; z < 11; ++z) a = a + t[z][i2];
                        y[ih * 2 + i2] = a; }
                }
#pragma unroll
                for (int i = 0; i < 4; ++i) { const u32x2 r3 = *(const u32x2*)(X + (size_t)row * D + co + 256 * i); x[i] = (f32x4){__uint_as_float(r3[0] << 16), __uint_as_float(r3[0] & 0xffff0000u), __uint_as_float(r3[1] << 16), __uint_as_float(r3[1] & 0xffff0000u)}; }
            } else {
#pragma unroll
                for (int i = 0; i < 4; ++i) { const u32x2 r2 = yq[i]; { const u32x2 r3 = xq[i]; x[i] = (f32x4){__uint_as_float(r3[0] << 16), __uint_as_float(r3[0] & 0xffff0000u), __uint_as_float(r3[1] << 16), __uint_as_float(r3[1] & 0xffff0000u)}; }
                    y[i] = (f32x4){__uint_as_float(r2[0] << 16), __uint_as_float(r2[0] & 0xffff0000u), __uint_as_float(r2[1] << 16), __uint_as_float(r2[1] & 0xffff0000u)}; }
            }
        {
            const float* gp = pin(6) + ((size_t)l * 6 + gpost_i) * D; const float* gt = MOD + ((size_t)(l * 5 + v) * 9 + kgate) * D;
            const float* gq = pin(6) + ((size_t)ln * 6 + gpre_i) * D; const float* sh = MOD + ((size_t)(ln * 5 + v) * 9 + kshift) * D; const float* sc = sh + D;
#pragma unroll
            for (int i = 0; i < 4; ++i) { pg[i] = *(const f32x4*)(gp + co + 256 * i); pm[i] = *(const f32x4*)(gt + co + 256 * i);
                qg[i] = *(const f32x4*)(gq + co + 256 * i); qa[i] = *(const f32x4*)(sh + co + 256 * i); qs[i] = *(const f32x4*)(sc + co + 256 * i); }
        }
            const int nxt = row + nwaves;
            if (nxt < nrows && nxt < MLAT) {
#pragma unroll
                for (int i = 0; i < 4; ++i) { yq[i] = *(const u32x2*)((const bf16_t*)Y0 + (size_t)nxt * D + co + 256 * i); xq[i] = *(const u32x2*)(X + (size_t)nxt * D + co + 256 * i); }
            }
            float ss = 0.f;
#pragma unroll
            for (int i = 0; i < 4; ++i) ss += y[i][0] * y[i][0] + y[i][1] * y[i][1] + y[i][2] * y[i][2] + y[i][3] * y[i][3];
            ss = wsum(ss); const float rs = rsqrtf(ss * (1.f / D) + EPS) * coef;
#pragma unroll
            for (int i = 0; i < 4; ++i) x[i] = x[i] + pm[i] * (y[i] * rs * pg[i]);
        }
        if (mode == 2) {
#pragma unroll
            for (int i = 0; i < 4; ++i) *(f32x4*)((float*)pin(25) + (size_t)row * D + co + 256 * i) = x[i];
            continue;
        }
#pragma unroll
        for (int i = 0; i < 4; ++i) { u32x2 w; w[0] = pk2(x[i][0], x[i][1]); w[1] = pk2(x[i][2], x[i][3]); *(u32x2*)(Xw + (size_t)row * D + co + 256 * i) = w; }
        float ss = 0.f;
#pragma unroll
        for (int i = 0; i < 4; ++i) ss += x[i][0] * x[i][0] + x[i][1] * x[i][1] + x[i][2] * x[i][2] + x[i][3] * x[i][3];
        ss = wsum(ss); const float rs = rsqrtf(ss * (1.f / D) + EPS);
#pragma unroll
        for (int i = 0; i < 4; ++i) { const f32x4 h = x[i] * rs * qg[i] * (qs[i] + 1.f) + qa[i]; u32x2 w; w[0] = pk2(h[0], h[1]); w[1] = pk2(h[2], h[3]);
            *(u32x2*)(H + (size_t)row * D + co + 256 * i) = w; }
    }
}

DEVI void gdn_load(const bf16_t* P, const float* convw, int b, int c, int h, int dir, int want, bf16_t* sQ, bf16_t* sK, bf16_t* sKT, bf16_t* sVT, int tid) {
    const bool isctx = c < 4;
#pragma unroll
    for (int r = 0; r < 6; ++r) {
        const int task = tid + 512 * r, seg = r >> 1, rem = task & 1023, t = rem >> 4, cgp = rem & 15;
        if (seg == 0 && !(want & 1)) continue;
        if (seg == 1 && !(want & 6)) continue;
        if (seg == 2 && !(want & 8)) continue;
        int p = (isctx ? c : c - 4) * 64 + t; if (dir) p = (isctx ? 255 : 4095) - p;
        const int ch = seg * 512 + h * 128 + cgp * 8;
        float a[8];
#pragma unroll
        for (int e = 0; e < 8; ++e) a[e] = 0.f;
#pragma unroll
        for (int j = 0; j < 4; ++j) {
            const int row = pos_row(true, b, isctx, p + j - 2);
            if (row >= 0) {
                const u32x4 raw = *(const u32x4*)(P + (size_t)row * DINP + C_DNQ + ch); float x[8]; unpack8(raw, x);
                const f32x4 w0 = *(const f32x4*)(convw + j * 1536 + ch), w1 = *(const f32x4*)(convw + j * 1536 + ch + 4);
                a[0] += w0[0] * x[0]; a[1] += w0[1] * x[1]; a[2] += w0[2] * x[2]; a[3] += w0[3] * x[3];
                a[4] += w1[0] * x[4]; a[5] += w1[1] * x[5]; a[6] += w1[2] * x[6]; a[7] += w1[3] * x[7];
            }
        }
        float ss = 0.f;
#pragma unroll
        for (int e = 0; e < 8; ++e) { a[e] = silu(a[e]); ss += a[e] * a[e]; }
        if (seg < 2) {
            ss += __shfl_xor(ss, 1, 64); ss += __shfl_xor(ss, 2, 64); ss += __shfl_xor(ss, 4, 64); ss += __shfl_xor(ss, 8, 64);
            float inv = rsqrtf(ss + EPS); if (seg == 0) inv *= 0.08838834764831845f;
#pragma unroll
            for (int e = 0; e < 8; ++e) a[e] *= inv;
        }
        if (seg == 0) *(u32x4*)(sQ + t * 136 + cgp * 8) = pack8(a);
        else if (seg == 1) {
            if (want & 2) *(u32x4*)(sK + t * 136 + cgp * 8) = pack8(a);
            if (want & 4) {
#pragma unroll
                for (int e = 0; e < 8; ++e) sKT[tix(cgp * 8 + e, t)] = (bf16_t)f2bf(a[e]); }
        } else {
#pragma unroll
            for (int e = 0; e < 8; ++e) sVT[tix(cgp * 8 + e, t)] = (bf16_t)f2bf(a[e]);
        }
    }
}
struct GdnRaw { u32x4 r[4][4]; float g; };
DEVI void gdn_ld_issue(const bf16_t* P, const float* gates, int b, int c, int h, int dir, int seg_lo, GdnRaw& R, int tid) {
    const bool isctx = c < 4;
#pragma unroll
    for (int tk = 0; tk < 4; ++tk) {
        const int r = seg_lo * 2 + tk, task = tid + 512 * r, seg = r >> 1, rem = task & 1023, t = rem >> 4, cgp = rem & 15;
        int p = (isctx ? c : c - 4) * 64 + t; if (dir) p = (isctx ? 255 : 4095) - p;
        const int ch = seg * 512 + h * 128 + cgp * 8;
#pragma unroll
        for (int j = 0; j < 4; ++j) { const int row = pos_row(true, b, isctx, p + j - 2); R.r[tk][j] = (u32x4){0u, 0u, 0u, 0u};
            if (row >= 0) R.r[tk][j] = *(const u32x4*)(P + (size_t)row * DINP + C_DNQ + ch); }
    }
    R.g = 0.f; if (tid < 257) R.g = gates[tid];
}
DEVI void gdn_ld_finish(const GdnRaw& R, const float* convw, int h, int seg_lo, int want, bf16_t* sQ, bf16_t* sK, bf16_t* sKT, bf16_t* sVT, float* sc, int tid) {
#pragma unroll
    for (int tk = 0; tk < 4; ++tk) {
        const int r = seg_lo * 2 + tk, task = tid + 512 * r, seg = r >> 1, rem = task & 1023, t = rem >> 4, cgp = rem & 15;
        const int ch = seg * 512 + h * 128 + cgp * 8;
        float a[8];
#pragma unroll
        for (int e = 0; e < 8; ++e) a[e] = 0.f;
#pragma unroll
        for (int j = 0; j < 4; ++j) {
            float x[8]; unpack8(R.r[tk][j], x);
            const f32x4 w0 = *(const f32x4*)(convw + j * 1536 + ch), w1 = *(const f32x4*)(convw + j * 1536 + ch + 4);
            a[0] += w0[0] * x[0]; a[1] += w0[1] * x[1]; a[2] += w0[2] * x[2]; a[3] += w0[3] * x[3];
            a[4] += w1[0] * x[4]; a[5] += w1[1] * x[5]; a[6] += w1[2] * x[6]; a[7] += w1[3] * x[7];
        }
        float ss = 0.f;
#pragma unroll
        for (int e = 0; e < 8; ++e) { a[e] = silu(a[e]); ss += a[e] * a[e]; }
        if (seg < 2) {
            ss += __shfl_xor(ss, 1, 64); ss += __shfl_xor(ss, 2, 64); ss += __shfl_xor(ss, 4, 64); ss += __shfl_xor(ss, 8, 64);
            float inv = rsqrtf(ss + EPS); if (seg == 0) inv *= 0.08838834764831845f;
#pragma unroll
            for (int e = 0; e < 8; ++e) a[e] *= inv;
        }
        if (seg == 0) *(u32x4*)(sQ + t * 136 + cgp * 8) = pack8(a);
        else if (seg == 1) {
            if (want & 2) *(u32x4*)(sK + t * 136 + cgp * 8) = pack8(a);
            if (want & 4) {
#pragma unroll
                for (int e = 0; e < 8; ++e) sKT[tix(cgp * 8 + e, t)] = (bf16_t)f2bf(a[e]); }
        } else {
#pragma unroll
            for (int e = 0; e < 8; ++e) sVT[tix(cgp * 8 + e, t)] = (bf16_t)f2bf(a[e]);
        }
    }
    if (tid < 257) sc[tid] = R.g;
}
DEVI void gdn_gates(const PW& p, const bf16_t* P, int l, int b, int c, int h, int dir, float* sc, int lane) {
    const int row = tok_row(true, dir, b, c, lane);
    const float bb = bf2f(P[(size_t)row * DINP + C_DNBA + dir * 4 + h]), aa = bf2f(P[(size_t)row * DINP + C_DNBA + 8 + dir * 4 + h]);
    const float beta = sigm(bb);
    const float g = -__expf(pin(20)[l * 8 + dir * 4 + h]) * softplus(aa + pin(21)[l * 8 + dir * 4 + h]);
    float G = g;
#pragma unroll
    for (int o = 1; o < 64; o <<= 1) { const float t = __shfl_up(G, o, 64); if (lane >= o) G += t; }
    const float GT = __shfl(G, 63, 64);
    sc[lane] = G; sc[64 + lane] = beta; sc[128 + lane] = __expf(G); sc[192 + lane] = __expf(GT - G); if (lane == 0) sc[256] = __expf(GT);
}

DEVI void gdn_prep_all(const PW& pw0, int l, int first, int G, unsigned char* shm_in, int wv) {
    GdnRaw R;
    if (first < 2176) { const PW p{opq64(pw0.ws)}; const int tid = MYTID; const int c = first % NCH, h = (first / NCH) & 3, b = (first / (NCH * 4)) & 3, dir = first / (NCH * 16);
        gdn_ld_issue((const bf16_t*)(p.ws + WS_P), (const float*)(p.ws + WS_GATES) + (size_t)first * 320, b, c, h, dir, 1, R, tid); }
#pragma unroll 1
    for (int item = first; item < 2176; item += G) {
    const PW p{opq64(pw0.ws)};
    unsigned char* shm = opq(shm_in);
    const int tid = MYTID, wid = __builtin_amdgcn_readfirstlane(tid >> 6), lane = tid & 63, fr = lane & 15, fq = lane >> 4;
    const bf16_t* P = (const bf16_t*)(p.ws + WS_P);
    const float* GATES = (const float*)(p.ws + WS_GATES);
    const int h = (item / NCH) & 3;
    bf16_t* sK = (bf16_t*)shm;
    bf16_t* sKT = (bf16_t*)(shm + 17408);
    bf16_t* sVT = (bf16_t*)(shm + 35840);
    float* sTm = (float*)(shm + 54272);
    bf16_t* sT1 = (bf16_t*)(shm + 71680);
    bf16_t* sT2 = (bf16_t*)(shm + 80896);
    bf16_t* sWT = (bf16_t*)(shm + 90112);
    bf16_t* sUT = (bf16_t*)(shm + 108544);
    float* sc = (float*)(shm + 126976);
    gdn_ld_finish(R, pin(19) + (size_t)l * 4 * 1536, h, 1, 2 | 4 | 8, nullptr, sK, sKT, sVT, sc, tid);
    __builtin_amdgcn_sched_barrier(0);
    { const int nxt = item + G; if (nxt < 2176) { const int c2 = nxt % NCH, h2 = (nxt / NCH) & 3, b2 = (nxt / (NCH * 4)) & 3, dir2 = nxt / (NCH * 16); gdn_ld_issue(P, GATES + (size_t)nxt * 320, b2, c2, h2, dir2, 1, R, opaque(tid)); } }
    __builtin_amdgcn_sched_barrier(0);
    lbar();
#pragma unroll
    for (int ti = 0; ti < 2; ++ti) {
        const int tile = wid * 2 + ti, mt = tile >> 2, nt = tile & 3;
        f32x4 acc = (f32x4){0.f, 0.f, 0.f, 0.f};
#pragma unroll
        for (int kk = 0; kk < 4; ++kk) acc = MFMA16(ldfrag(sK, 136, mt * 16, kk * 32, lane), ldfrag(sK, 136, nt * 16, kk * 32, lane), acc);
        const int s = nt * 16 + fr;
#pragma unroll
        for (int j = 0; j < 4; ++j) { const int t = mt * 16 + fq * 4 + j; sTm[t * 68 + s] = s < t ? sc[64 + t] * acc[j] * __expf(sc[t] - sc[s]) : 0.f; }
    }
    lbar();
    float* tmpY = (float*)sWT;
    if (wid < 4) {
        const int o = wid * 16, c = lane & 15;
        int lz; asm volatile("v_mov_b32 %0, 0" : "=v"(lz));
        const float* tm = sTm + lz;
        float x[16];
#pragma unroll
        for (int t = 0; t < 16; ++t) {
            float v = -sTm[(o + t) * 68 + o + c];
#pragma unroll
            for (int s4 = 0; s4 < (t + 3) / 4; ++s4) {
                const f32x4 a = *(const f32x4*)(tm + (o + t) * 68 + o + s4 * 4);
#pragma unroll
                for (int e = 0; e < 4; ++e) if (s4 * 4 + e < t) v -= a[e] * x[s4 * 4 + e];
            }
            x[t] = v;
        }
        asm volatile("s_waitcnt lgkmcnt(0)" ::: "memory");
        if (lane < 16) {
#pragma unroll
            for (int t = 0; t < 16; ++t) sTm[(o + t) * 68 + o + c] = x[t] + (t == c ? 1.f : 0.f);
        }
    }
    lbar();
    {
        const int blk = tid >> 8, r = (tid >> 4) & 15, c = tid & 15, ib = (blk ? 3 : 1) * 16, jb = ib - 16;
        float y = 0.f;
#pragma unroll
        for (int s2 = 0; s2 < 16; ++s2) y += sTm[(ib + r) * 68 + jb + s2] * sTm[(jb + s2) * 68 + jb + c];
        tmpY[blk * 272 + r * 17 + c] = y;
        lbar();
        float z = 0.f;
#pragma unroll
        for (int s2 = 0; s2 < 16; ++s2) z += sTm[(ib + r) * 68 + ib + s2] * tmpY[blk * 272 + s2 * 17 + c];
        lbar();
        sTm[(ib + r) * 68 + jb + c] = -z;
    }
    lbar();
    {
        float y[2];
#pragma unroll
        for (int u = 0; u < 2; ++u) { const int o = tid + 512 * u, r = o >> 5, c = o & 31; float a = 0.f;
#pragma unroll 8
            for (int s2 = 0; s2 < 32; ++s2) a += sTm[(32 + r) * 68 + s2] * sTm[s2 * 68 + c];
            y[u] = a; }
#pragma unroll
        for (int u = 0; u < 2; ++u) { const int o = tid + 512 * u, r = o >> 5, c = o & 31; tmpY[r * 33 + c] = y[u]; }
        lbar();
#pragma unroll
        for (int u = 0; u < 2; ++u) { const int o = tid + 512 * u, r = o >> 5, c = o & 31; float a = 0.f;
#pragma unroll 8
            for (int s2 = 0; s2 < 32; ++s2) a += sTm[(32 + r) * 68 + 32 + s2] * tmpY[s2 * 33 + c];
            y[u] = a; }
#pragma unroll
        for (int u = 0; u < 2; ++u) { const int o = tid + 512 * u, r = o >> 5, c = o & 31; sTm[(32 + r) * 68 + c] = -y[u]; }
    }
    lbar();
#pragma unroll
    for (int u = 0; u < 8; ++u) {
        const int o = tid + 512 * u, t = o >> 6, s2 = o & 63; const float xv = sTm[t * 68 + s2], bt = sc[64 + s2];
        sT1[t * 72 + s2] = (bf16_t)f2bf(xv * bt * sc[128 + s2]); sT2[t * 72 + s2] = (bf16_t)f2bf(xv * bt);
    }
    lbar();
    bf16_t* GW = (bf16_t*)(p.ws + WS_H) + (size_t)item * 64 * 128;
    bf16_t* GU = (bf16_t*)(p.ws + WS_GU) + (size_t)item * 64 * 128;
    {
        const int tid2 = opaque(tid), lane = tid2 & 63, fr = lane & 15, fq = lane >> 4;
        const int mt = wid;
#pragma unroll
        for (int nt = 0; nt < 4; ++nt) {
            f32x4 aw = (f32x4){0.f, 0.f, 0.f, 0.f}, au = aw;
#pragma unroll
            for (int kk = 0; kk < 2; ++kk) { aw = MFMA16(ldfragT(sKT, mt * 16, kk * 32, lane), ldfrag(sT1, 72, nt * 16, kk * 32, lane), aw);
                au = MFMA16(ldfragT(sVT, mt * 16, kk * 32, lane), ldfrag(sT2, 72, nt * 16, kk * 32, lane), au); }
            const int t = nt * 16 + fr, r0 = mt * 16 + fq * 4; const float dec = sc[192 + t];
            u32x2 w; w[0] = pk2(aw[0], aw[1]); w[1] = pk2(aw[2], aw[3]); *(u32x2*)(GW + t * 128 + r0) = w;
            w[0] = pk2(au[0], au[1]); w[1] = pk2(au[2], au[3]); *(u32x2*)(GU + t * 128 + r0) = w;
#pragma unroll
            for (int j = 0; j < 4; ++j) { sWT[tix(r0 + j, t)] = (bf16_t)f2bf(aw[j] * dec); sUT[tix(r0 + j, t)] = (bf16_t)f2bf(au[j] * dec); }
        }
    }
    lbar();
    bf16_t* GB = (bf16_t*)(p.ws + WS_GB) + (size_t)item * 128 * 128;
    bf16_t* GN = (bf16_t*)(p.ws + WS_GN) + (size_t)item * 128 * 128;
    {
        const int tid2 = opaque(tid), lane = tid2 & 63, fr = lane & 15, fq = lane >> 4;
        const int mt = wid;
#pragma unroll
        for (int nt = 0; nt < 8; ++nt) {
            f32x4 ab = (f32x4){0.f, 0.f, 0.f, 0.f}, an = ab;
#pragma unroll
            for (int kk = 0; kk < 2; ++kk) { ab = MFMA16(ldfragT(sWT, mt * 16, kk * 32, lane), ldfragT(sKT, nt * 16, kk * 32, lane), ab);
                an = MFMA16(ldfragT(sKT, mt * 16, kk * 32, lane), ldfragT(sUT, nt * 16, kk * 32, lane), an); }
            const int cc = nt * 16 + fr, r0 = mt * 16 + fq * 4;
            u32x2 w; w[0] = pk2(-ab[0], -ab[1]); w[1] = pk2(-ab[2], -ab[3]); *(u32x2*)(GB + cc * 128 + r0) = w;
            w[0] = pk2(an[0], an[1]); w[1] = pk2(an[2], an[3]); *(u32x2*)(GN + cc * 128 + r0) = w;
        }
    }
    if (tid == 0) ((float*)(p.ws + WS_SM + SM_GDEC))[item] = sc[256];
    lbar();
    }
}

DEVI void gdn_seq_unit(const PW& pw0, int unit, unsigned char* shm_in, int wv) {
    const PW p{opq64(pw0.ws)};
    unsigned char* shm = opq(shm_in);
    const int tid = MYTID, wid = __builtin_amdgcn_readfirstlane(tid >> 6), lane = tid & 63, fr = lane & 15, fq = lane >> 4;
    const int chain = unit >> 3, es = unit & 7;
    bf16_t* sS = (bf16_t*)shm;
    const bf16_t* GB = (const bf16_t*)(p.ws + WS_GB) + (size_t)chain * NCH * 16384;
    bf16_t* GN = (bf16_t*)(p.ws + WS_GN) + (size_t)chain * NCH * 16384;
    const float* GDEC = (const float*)(p.ws + WS_SM + SM_GDEC) + chain * NCH;
    f32x4 acc = (f32x4){0.f, 0.f, 0.f, 0.f};
    constexpr int PF = 4;
    bf16x8 an[PF][4]; u32x2 nn[PF]; float dn[PF];
    const size_t aoff = (size_t)(wid * 16 + fr) * 128 + fq * 8, noff = (size_t)(es * 16 + fr) * 128 + wid * 16 + fq * 4;
#pragma unroll
    for (int u = 0; u < PF; ++u) {
#pragma unroll
        for (int kk = 0; kk < 4; ++kk) an[u][kk] = *(const bf16x8*)(GB + (size_t)u * 16384 + aoff + kk * 32);
        nn[u] = *(const u32x2*)(GN + (size_t)u * 16384 + noff); dn[u] = GDEC[u];
    }
#pragma unroll 1
    for (int c0 = 0; c0 < NCH; c0 += PF) {
#pragma unroll
        for (int u = 0; u < PF; ++u) {
            const int c = c0 + u;
            bf16x8 a[4]; const u32x2 ncur = nn[u]; const float dcur = dn[u];
#pragma unroll
            for (int kk = 0; kk < 4; ++kk) a[kk] = an[u][kk];
            u32x2 sw; sw[0] = pk2(acc[0], acc[1]); sw[1] = pk2(acc[2], acc[3]);
            bf16_t* sb = sS + (c & 1) * (16 * 136);
            *(u32x2*)(sb + fr * 136 + wid * 16 + fq * 4) = sw;
            *(u32x2*)(GN + (size_t)c * 16384 + noff) = sw;
            if (c + PF < NCH) {
#pragma unroll
                for (int kk = 0; kk < 4; ++kk) an[u][kk] = *(const bf16x8*)(GB + (size_t)(c + PF) * 16384 + aoff + kk * 32);
                nn[u] = *(const u32x2*)(GN + (size_t)(c + PF) * 16384 + noff); dn[u] = GDEC[c + PF];
            }
            lbar();
            acc[0] = dcur * acc[0] + __uint_as_float(ncur[0] << 16); acc[1] = dcur * acc[1] + __uint_as_float(ncur[0] & 0xffff0000u);
            acc[2] = dcur * acc[2] + __uint_as_float(ncur[1] << 16); acc[3] = dcur * acc[3] + __uint_as_float(ncur[1] & 0xffff0000u);
#pragma unroll
            for (int kk = 0; kk < 4; ++kk) acc = MFMA16(a[kk], ldfrag(sb, 136, 0, kk * 32, lane), acc);
        }
    }
    lbar();
}

struct GdnOutRaw { GdnRaw L; u32x4 st[4]; u32x4 w[2]; u32x2 ur[4]; };
DEVI void gdn_out_issue(const PW& p, int item, int dir, GdnOutRaw& R, int tid) {
    const int lane = tid & 63, fr = lane & 15, fq = lane >> 4, wid = tid >> 6;
    const int j = item % NCH, h = (item / NCH) & 3, b = item / (NCH * 4);
    const int c = dir_chunk(dir, j);
    const int it2 = ((dir * 4 + b) * 4 + h) * NCH + c;
    gdn_ld_issue((const bf16_t*)(p.ws + WS_P), (const float*)(p.ws + WS_GATES) + (size_t)it2 * 320, b, c, h, dir, 0, R.L, tid);
    const bf16_t* GS = (const bf16_t*)(p.ws + WS_GN) + (size_t)it2 * 16384;
    const bf16_t* GW = (const bf16_t*)(p.ws + WS_H) + (size_t)it2 * 8192;
    const bf16_t* GU = (const bf16_t*)(p.ws + WS_GU) + (size_t)it2 * 8192;
#pragma unroll
    for (int r = 0; r < 4; ++r) { const int idx = tid + 512 * r, row = idx >> 4, cg8 = (idx & 15) * 8; R.st[r] = *(const u32x4*)(GS + row * 128 + cg8); }
#pragma unroll
    for (int r = 0; r < 2; ++r) { const int idx = tid + 512 * r, row = idx >> 4, cg8 = (idx & 15) * 8; R.w[r] = *(const u32x4*)(GW + row * 128 + cg8); }
#pragma unroll
    for (int nt = 0; nt < 4; ++nt) R.ur[nt] = *(const u32x2*)(GU + (nt * 16 + fr) * 128 + wid * 16 + fq * 4);
}
DEVI void gdn_out_all(const PW& pw0, int l, int first, int G, bool skipctx, unsigned char* shm_in, int wv) {
    const int dry = 0;
    GdnOutRaw R;
    int item = first;
    while (item < 1088 && skipctx && (item % NCH) < 4) item += G;
    if (item < 1088) { const PW p{opq64(pw0.ws)}; gdn_out_issue(p, item, 0, R, MYTID); }
#pragma unroll 1
    while (item < 1088) {
    int nitem = item + G;
    while (nitem < 1088 && skipctx && (nitem % NCH) < 4) nitem += G;
#pragma unroll 1
    for (int dir = 0; dir < 2; ++dir) {
        const PW p{opq64(pw0.ws)};
        unsigned char* shm = opq(shm_in);
        const int tid = MYTID, wid = __builtin_amdgcn_readfirstlane(tid >> 6), lane = tid & 63, fr = lane & 15, fq = lane >> 4;
        const int j = item % NCH, h = (item / NCH) & 3, b = item / (NCH * 4);
        bf16_t* P = (bf16_t*)(p.ws + WS_P);
        bf16_t* sQ = (bf16_t*)shm;
        bf16_t* sK = (bf16_t*)(shm + 17408);
        bf16_t* sST = (bf16_t*)(shm + 34816);
        bf16_t* sW = (bf16_t*)(shm + 69632);
        bf16_t* sVN = (bf16_t*)(shm + 87040);
        bf16_t* sA2 = (bf16_t*)(shm + 105472);
        float* sO = (float*)(shm + 114688);
        float* sc = (float*)(shm + 148480);
        gdn_ld_finish(R.L, pin(19) + (size_t)l * 4 * 1536, h, 0, 1 | 2, sQ, sK, nullptr, nullptr, sc, tid);
#pragma unroll
        for (int r = 0; r < 4; ++r) { const int idx = tid + 512 * r, row = idx >> 4, cg8 = (idx & 15) * 8; *(u32x4*)(sST + row * 136 + cg8) = R.st[r]; }
#pragma unroll
        for (int r = 0; r < 2; ++r) { const int idx = tid + 512 * r, row = idx >> 4, cg8 = (idx & 15) * 8; *(u32x4*)(sW + row * 136 + cg8) = R.w[r]; }
        u32x2 ur4[4];
#pragma unroll
        for (int nt = 0; nt < 4; ++nt) ur4[nt] = R.ur[nt];
        __builtin_amdgcn_sched_barrier(0);
        if (dir == 0) gdn_out_issue(p, item, 1, R, opaque(tid)); else if (nitem < 1088) gdn_out_issue(p, nitem, 0, R, opaque(tid));
        __builtin_amdgcn_sched_barrier(0);
        lbar();
        {
            const int mt = wid;
#pragma unroll
            for (int nt = 0; nt < 4; ++nt) {
                const u32x2 ur = ur4[nt];
                f32x4 a = (f32x4){0.f, 0.f, 0.f, 0.f};
#pragma unroll
                for (int kk = 0; kk < 4; ++kk) a = MFMA16(ldfrag(sST, 136, mt * 16, kk * 32, lane), ldfrag(sW, 136, nt * 16, kk * 32, lane), a);
                const int t = nt * 16 + fr, e0 = mt * 16 + fq * 4;
                sVN[(e0 + 0) * 72 + t] = (bf16_t)f2bf(__uint_as_float(ur[0] << 16) - a[0]); sVN[(e0 + 1) * 72 + t] = (bf16_t)f2bf(__uint_as_float(ur[0] & 0xffff0000u) - a[1]);
                sVN[(e0 + 2) * 72 + t] = (bf16_t)f2bf(__uint_as_float(ur[1] << 16) - a[2]); sVN[(e0 + 3) * 72 + t] = (bf16_t)f2bf(__uint_as_float(ur[1] & 0xffff0000u) - a[3]);
            }
#pragma unroll
            for (int ti = 0; ti < 2; ++ti) {
                const int tile = wid * 2 + ti, m2 = tile >> 2, n2 = tile & 3;
                f32x4 a = (f32x4){0.f, 0.f, 0.f, 0.f};
#pragma unroll
                for (int kk = 0; kk < 4; ++kk) a = MFMA16(ldfrag(sQ, 136, m2 * 16, kk * 32, lane), ldfrag(sK, 136, n2 * 16, kk * 32, lane), a);
                const int s = n2 * 16 + fr;
#pragma unroll
                for (int jj = 0; jj < 4; ++jj) { const int t = m2 * 16 + fq * 4 + jj; sA2[t * 72 + s] = (bf16_t)f2bf(s <= t ? a[jj] * __expf(sc[t] - sc[s]) : 0.f); }
            }
        }
        lbar();
        {
            const int nt = wid;
#pragma unroll
            for (int mt = 0; mt < 4; ++mt) {
                f32x4 a = (f32x4){0.f, 0.f, 0.f, 0.f};
#pragma unroll
                for (int kk = 0; kk < 4; ++kk) a = MFMA16(ldfrag(sQ, 136, mt * 16, kk * 32, lane), ldfrag(sST, 136, nt * 16, kk * 32, lane), a);
#pragma unroll
                for (int jj = 0; jj < 4; ++jj) a[jj] *= sc[128 + mt * 16 + fq * 4 + jj];
#pragma unroll
                for (int kk = 0; kk < 2; ++kk) a = MFMA16(ldfrag(sA2, 72, mt * 16, kk * 32, lane), ldfrag(sVN, 72, nt * 16, kk * 32, lane), a);
                const int e = nt * 16 + fr;
#pragma unroll
                for (int jj = 0; jj < 4; ++jj) { const int t = mt * 16 + fq * 4 + jj; const int i = dir ? 63 - t : t; if (dir) sO[i * 132 + e] += a[jj]; else sO[i * 132 + e] = a[jj]; }
            }
        }
        lbar();
    }
    {
        const PW p{opq64(pw0.ws)};
        unsigned char* shm = opq(shm_in);
        const int tid = MYTID;
        const int j = item % NCH, h = (item / NCH) & 3, b = item / (NCH * 4);
        bf16_t* P = (bf16_t*)(p.ws + WS_P);
        float* sO = (float*)(shm + 114688);
    {
        const int i = tid >> 3, e0 = (tid & 7) * 16;
        float v[16], ss = 0.f;
#pragma unroll
        for (int e = 0; e < 16; ++e) { v[e] = sO[i * 132 + e0 + e]; ss += v[e] * v[e]; }
        ss += __shfl_xor(ss, 1, 64); ss += __shfl_xor(ss, 2, 64); ss += __shfl_xor(ss, 4, 64);
        const float rs = rsqrtf(ss * (1.f / 128.f) + EPS);
        const int row = tok_row(true, 0, b, j, i);
        bf16_t* zp = P + (size_t)row * DINP + C_DNZ + h * 128 + e0;
        const float* g = pin(22) + l * 128 + e0;
#pragma unroll
        for (int half = 0; half < 2; ++half) {
            float z[8]; unpack8(*(const u32x4*)(zp + half * 8), z); float o[8];
#pragma unroll
            for (int e = 0; e < 8; ++e) o[e] = v[half * 8 + e] * rs * g[half * 8 + e] * z[e];
            bf16_t* zd = dry ? (bf16_t*)(p.ws + WS_GB) + (size_t)row * 512 + h * 128 + e0 : zp;
            *(u32x4*)(zd + half * 8) = pack8(o);
        }
    }
    lbar();
    }
    item = nitem;
    }
}

DEVI float ml_gates(const PW& p, const bf16_t* P, int l, int b, int c, int h, int dir, float* sc, int lane) {
    const int row = tok_row(false, dir, b, c, lane);
    const float ig = bf2f(P[(size_t)row * DINP + C_MLG + dir * 4 + h]) + pin(10)[l * 16 + dir * 4 + h];
    const float fg = bf2f(P[(size_t)row * DINP + C_MLG + (2 + dir) * 4 + h]) + pin(10)[l * 16 + (2 + dir) * 4 + h];
    float bb = logsig(fg);
#pragma unroll
    for (int o = 1; o < 64; o <<= 1) { const float t = __shfl_up(bb, o, 64); if (lane >= o) bb += t; }
    sc[lane] = bb; sc[64 + lane] = ig;
    return __shfl(bb, 63, 64);
}
struct MlPrepRaw { u32x4 k; u32x4 v[2]; float w[2]; float g; };
DEVI void ml_prep_issue(const PW& p, int item, MlPrepRaw& R, int tid) {
    const int c = item % NCH, h = (item / NCH) & 3, b = (item / (NCH * 4)) & 3, dir = item / (NCH * 16);
    const bf16_t* P = (const bf16_t*)(p.ws + WS_P);
    const float* gp = (const float*)(p.ws + WS_GATES) + (size_t)(2176 + item) * 320;
    { const int t = tid >> 3, cg8 = (tid & 7) * 8; const int row = tok_row(false, dir, b, c, t); R.k = *(const u32x4*)(P + (size_t)row * DINP + C_MLK + h * 64 + cg8); }
#pragma unroll
    for (int r = 0; r < 2; ++r) { const int idx = tid + 512 * r, t = idx >> 4, cg8 = (idx & 15) * 8; const int row = tok_row(false, dir, b, c, t);
        R.v[r] = *(const u32x4*)(P + (size_t)row * DINP + C_MLV + h * 128 + cg8); R.w[r] = gp[128 + t]; }
    R.g = gp[128 + (tid & 63)];
}
DEVI void ml_prep_all(const PW& pw0, int l, int first, int G, unsigned char* shm_in, int wv) {
    MlPrepRaw R;
    if (first < 2176) { const PW p{opq64(pw0.ws)}; ml_prep_issue(p, first, R, MYTID); }
#pragma unroll 1
    for (int item = first; item < 2176; item += G) {
    const PW p{opq64(pw0.ws)};
    unsigned char* shm = opq(shm_in);
    const int tid = MYTID, wid = __builtin_amdgcn_readfirstlane(tid >> 6), lane = tid & 63, fr = lane & 15, fq = lane >> 4;
    bf16_t* sKT = (bf16_t*)shm;
    bf16_t* sVT = (bf16_t*)(shm + 9216);
    float* sc = (float*)(shm + 27648);
    if (tid < 64) sc[128 + tid] = R.g;
    {
        const int t = tid >> 3, cg8 = (tid & 7) * 8;
        float x[8]; unpack8(R.k, x);
#pragma unroll
        for (int e = 0; e < 8; ++e) sKT[tix(cg8 + e, t)] = (bf16_t)f2bf(x[e]);
    }
#pragma unroll
    for (int r = 0; r < 2; ++r) {
        const int idx = tid + 512 * r, t = idx >> 4, cg8 = (idx & 15) * 8;
        float x[8]; unpack8(R.v[r], x); const float w = R.w[r];
#pragma unroll
        for (int e = 0; e < 8; ++e) sVT[tix(cg8 + e, t)] = (bf16_t)f2bf(x[e] * w);
    }
    __builtin_amdgcn_sched_barrier(0);
    if (item + G < 2176) ml_prep_issue(p, item + G, R, opaque(tid));
    __builtin_amdgcn_sched_barrier(0);
    lbar();
    float* KV = (float*)(p.ws + WS_Y) + (size_t)item * 8192;
    {
        const int nt = wid;
#pragma unroll
        for (int mt = 0; mt < 4; ++mt) {
            f32x4 a = (f32x4){0.f, 0.f, 0.f, 0.f};
#pragma unroll
            for (int kk = 0; kk < 2; ++kk) a = MFMA16(ldfragT(sKT, mt * 16, kk * 32, lane), ldfragT(sVT, nt * 16, kk * 32, lane), a);
            *(f32x4*)(KV + (nt * 16 + fr) * 64 + mt * 16 + fq * 4) = a;
        }
    }
    {
        const int d = tid >> 3, t0 = (tid & 7) * 8; float s = 0.f;
#pragma unroll
        for (int t = 0; t < 8; ++t) s += sc[128 + t0 + t] * bf2f(sKT[tix(d, t0 + t)]);
        s += __shfl_xor(s, 1, 64); s += __shfl_xor(s, 2, 64); s += __shfl_xor(s, 4, 64);
        if ((tid & 7) == 0) ((float*)(p.ws + WS_SM + SM_MN))[item * 64 + d] = s; }
    lbar();
    }
}
DEVI void ml_seq(const PW& pw0, int gtid, int nthreads) {
    const PW p{opq64(pw0.ws)};
    const float* MSC = (const float*)(p.ws + WS_SM + SM_MSC);
    float* MM = (float*)(p.ws + WS_SM + SM_MM);
    for (int g = gtid; g < 32 * 4096 + 32 * 32; g += nthreads) {
        const bool isn = g >= 32 * 4096; const int gg = isn ? g - 32 * 4096 : g;
        const int chain = isn ? gg >> 5 : gg >> 12, e2 = isn ? gg & 31 : gg & 4095;
        float* base = isn ? (float*)(p.ws + WS_SM + SM_MN) + (size_t)chain * NCH * 64 + e2 * 2 : (float*)(p.ws + WS_Y) + (size_t)chain * NCH * 8192 + e2 * 2;
        const int stride = isn ? 64 : 8192;
        float m = 0.f; f32x2 C = (f32x2){0.f, 0.f};
        for (int c0 = 0; c0 < NCH; c0 += 17) {
            f32x2 kv[17]; f32x2 sc[17];
#pragma unroll
            for (int u = 0; u < 17; ++u) { kv[u] = *(const f32x2*)(base + (size_t)(c0 + u) * stride); sc[u] = *(const f32x2*)(MSC + (chain * NCH + c0 + u) * 2); }
#pragma unroll
            for (int u = 0; u < 17; ++u) {
                *(f32x2*)(base + (size_t)(c0 + u) * stride) = C;
                if (!isn && e2 == 0) MM[chain * NCH + c0 + u] = m;
                const float mn = fmaxf(sc[u][0] + m, sc[u][1]);
                const float a = __expf(sc[u][0] + m - mn), s = __expf(sc[u][1] - mn);
                C = C * a + kv[u] * s; m = mn;
            }
        }
    }
}
struct MlOutRaw { u32x4 q, k, v[2]; f32x4 ct[4]; float gb, gi, gpm, m, n; };
DEVI void ml_out_issue(const PW& p, int item, int dir, MlOutRaw& R, int tid) {
    const int lane = tid & 63;
    const int j = item % NCH, h = (item / NCH) & 3, b = item / (NCH * 4);
    const int c = dir_chunk(dir, j);
    const int it2 = ((dir * 4 + b) * 4 + h) * NCH + c;
    const bf16_t* P = (const bf16_t*)(p.ws + WS_P);
    { const int t = tid >> 3, cg8 = (tid & 7) * 8; const int row = tok_row(false, dir, b, c, t);
      R.q = *(const u32x4*)(P + (size_t)row * DINP + C_MLQ + h * 64 + cg8); R.k = *(const u32x4*)(P + (size_t)row * DINP + C_MLK + h * 64 + cg8); }
#pragma unroll
    for (int r = 0; r < 2; ++r) { const int idx = tid + 512 * r, t = idx >> 4, cg8 = (idx & 15) * 8; const int row = tok_row(false, dir, b, c, t);
        R.v[r] = *(const u32x4*)(P + (size_t)row * DINP + C_MLV + h * 128 + cg8); }
    const float* CT = (const float*)(p.ws + WS_Y) + (size_t)it2 * 8192;
#pragma unroll
    for (int r = 0; r < 4; ++r) { const int idx = tid + 512 * r, e = idx >> 4, d4 = (idx & 15) * 4; R.ct[r] = *(const f32x4*)(CT + e * 64 + d4); }
    const float* gp = (const float*)(p.ws + WS_GATES) + (size_t)(2176 + it2) * 320;
    R.gb = gp[lane]; R.gi = gp[64 + lane]; R.gpm = gp[192 + lane];
    R.m = ((const float*)(p.ws + WS_SM + SM_MM))[it2]; R.n = ((const float*)(p.ws + WS_SM + SM_MN))[it2 * 64 + lane];
}
DEVI void ml_out_all(const PW& pw0, int l, int first, int G, bool skipctx, unsigned char* shm_in, int wv) {
    const int dry = 0;
    MlOutRaw R;
    int item = first;
    while (item < 1088 && skipctx && (item % NCH) < 4) item += G;
    if (item < 1088) { const PW p{opq64(pw0.ws)}; ml_out_issue(p, item, 0, R, MYTID); }
#pragma unroll 1
    while (item < 1088) {
    int nitem = item + G;
    while (nitem < 1088 && skipctx && (nitem % NCH) < 4) nitem += G;
#pragma unroll 1
    for (int dir = 0; dir < 2; ++dir) {
        const PW p{opq64(pw0.ws)};
        unsigned char* shm = opq(shm_in);
        const int tid = MYTID, wid = __builtin_amdgcn_readfirstlane(tid >> 6), lane = tid & 63, fr = lane & 15, fq = lane >> 4;
        bf16_t* sQ = (bf16_t*)shm;
        bf16_t* sK = (bf16_t*)(shm + 9216);
        bf16_t* sVT = (bf16_t*)(shm + 18432);
        bf16_t* sCT = (bf16_t*)(shm + 36864);
        bf16_t* sS = (bf16_t*)(shm + 55296);
        float* sO = (float*)(shm + 64512);
        float* sc = (float*)(shm + 98304);
        if (wid == 0) {
            const float m = R.m, bb = R.gb, pm = R.gpm;
            sc[lane] = bb; sc[64 + lane] = R.gi;
            const float mt = bb + fmaxf(m, pm);
            sc[128 + lane] = mt; sc[192 + lane] = __expf(bb + m - mt);
            sc[320 + lane] = R.n;
        }
        {
            const int t = tid >> 3, cg8 = (tid & 7) * 8;
            float x[8]; unpack8(R.q, x);
#pragma unroll
            for (int e = 0; e < 8; ++e) x[e] *= 0.125f;
            *(u32x4*)(sQ + t * 72 + cg8) = pack8(x);
            *(u32x4*)(sK + t * 72 + cg8) = R.k;
        }
#pragma unroll
        for (int r = 0; r < 2; ++r) {
            const int idx = tid + 512 * r, t = idx >> 4, cg8 = (idx & 15) * 8;
            float x[8]; unpack8(R.v[r], x);
#pragma unroll
            for (int e = 0; e < 8; ++e) sVT[tix(cg8 + e, t)] = (bf16_t)f2bf(x[e]);
        }
#pragma unroll
        for (int r = 0; r < 4; ++r) { const int idx = tid + 512 * r, e = idx >> 4, d4 = (idx & 15) * 4; const f32x4 v = R.ct[r];
            u32x2 w; w[0] = pk2(v[0], v[1]); w[1] = pk2(v[2], v[3]); *(u32x2*)(sCT + e * 72 + d4) = w; }
        __builtin_amdgcn_sched_barrier(0);
        if (dir == 0) ml_out_issue(p, item, 1, R, opaque(tid)); else if (nitem < 1088) ml_out_issue(p, nitem, 0, R, opaque(tid));
        __builtin_amdgcn_sched_barrier(0);
        lbar();
#pragma unroll
        for (int ti = 0; ti < 2; ++ti) {
            const int tile = wid * 2 + ti, m2 = tile >> 2, n2 = tile & 3;
            f32x4 a = (f32x4){0.f, 0.f, 0.f, 0.f};
#pragma unroll
            for (int kk = 0; kk < 2; ++kk) a = MFMA16(ldfrag(sQ, 72, m2 * 16, kk * 32, lane), ldfrag(sK, 72, n2 * 16, kk * 32, lane), a);
            const int s = n2 * 16 + fr;
#pragma unroll
            for (int jj = 0; jj < 4; ++jj) { const int t = m2 * 16 + fq * 4 + jj;
                sS[t * 72 + s] = (bf16_t)f2bf(s <= t ? a[jj] * __expf(sc[t] - sc[s] + sc[64 + s] - sc[128 + t]) : 0.f); }
        }
        lbar();
        {
            const int t = tid >> 3, s0 = (tid & 7) * 8; float ds = 0.f, qn = 0.f;
#pragma unroll
            for (int s2 = 0; s2 < 8; ++s2) { ds += bf2f(sS[t * 72 + s0 + s2]); qn += bf2f(sQ[t * 72 + s0 + s2]) * sc[320 + s0 + s2]; }
            ds += __shfl_xor(ds, 1, 64); ds += __shfl_xor(ds, 2, 64); ds += __shfl_xor(ds, 4, 64);
            qn += __shfl_xor(qn, 1, 64); qn += __shfl_xor(qn, 2, 64); qn += __shfl_xor(qn, 4, 64);
            const float den = ds + sc[192 + t] * qn;
            if ((tid & 7) == 0) sc[256 + t] = 1.f / fmaxf(fabsf(den), __expf(-sc[128 + t]));
        }
        lbar();
        {
            const int nt = wid;
#pragma unroll
            for (int mt = 0; mt < 4; ++mt) {
                f32x4 a = (f32x4){0.f, 0.f, 0.f, 0.f};
#pragma unroll
                for (int kk = 0; kk < 2; ++kk) a = MFMA16(ldfrag(sQ, 72, mt * 16, kk * 32, lane), ldfrag(sCT, 72, nt * 16, kk * 32, lane), a);
#pragma unroll
                for (int jj = 0; jj < 4; ++jj) a[jj] *= sc[192 + mt * 16 + fq * 4 + jj];
#pragma unroll
                for (int kk = 0; kk < 2; ++kk) a = MFMA16(ldfrag(sS, 72, mt * 16, kk * 32, lane), ldfragT(sVT, nt * 16, kk * 32, lane), a);
                const int e = nt * 16 + fr;
#pragma unroll
                for (int jj = 0; jj < 4; ++jj) { const int t = mt * 16 + fq * 4 + jj; const int i = dir ? 63 - t : t; const float hv = a[jj] * sc[256 + t];
                    if (dir) sO[i * 132 + e] += hv; else sO[i * 132 + e] = hv; }
            }
        }
        lbar();
    }
    {
        const PW p{opq64(pw0.ws)};
        unsigned char* shm = opq(shm_in);
        const int tid = MYTID;
        const int j = item % NCH, h = (item / NCH) & 3, b = item / (NCH * 4);
        bf16_t* P = (bf16_t*)(p.ws + WS_P);
        float* sO = (float*)(shm + 64512);
    {
        const int i = tid >> 3, e0 = (tid & 7) * 16;
        float v[16], ss = 0.f;
#pragma unroll
        for (int e = 0; e < 16; ++e) { v[e] = sO[i * 132 + e0 + e]; ss += v[e] * v[e]; }
        ss += __shfl_xor(ss, 1, 64); ss += __shfl_xor(ss, 2, 64); ss += __shfl_xor(ss, 4, 64);
        const float rs = rsqrtf(ss * (1.f / 128.f) + EPS);
        const int row = tok_row(false, 0, b, j, i);
        bf16_t* op = P + (size_t)row * DINP + C_MLO + h * 128 + e0;
        const float* g = pin(11) + l * 512 + h * 128 + e0;
#pragma unroll
        for (int half = 0; half < 2; ++half) {
            float z[8]; unpack8(*(const u32x4*)(op + half * 8), z); float o[8];
#pragma unroll
            for (int e = 0; e < 8; ++e) o[e] = v[half * 8 + e] * rs * g[half * 8 + e] * z[e];
            bf16_t* od = dry ? (bf16_t*)(p.ws + WS_GB) + (size_t)row * 512 + h * 128 + e0 : op;
            *(u32x4*)(od + half * 8) = pack8(o);
        }
    }
    lbar();
    }
    item = nitem;
    }
}

DEVI void lru_item(const PW& pw0, int l, int item, int mode, unsigned char* shm_in, int wv, int dry = 0) {
    const PW p{opq64(pw0.ws)};
    unsigned char* shm = opq(shm_in);
    const int tid = MYTID, wid = __builtin_amdgcn_readfirstlane(tid >> 6), lane = tid & 63, fr = lane & 15, fq = lane >> 4;
    const int n4 = item & 3, j = (item >> 2) % NCH, b = (item >> 2) / NCH; const bool isctx = j < 4;
    bf16_t* P = (bf16_t*)(p.ws + WS_P);
    bf16_t* sX = (bf16_t*)shm;
    const int p0 = (isctx ? j : j - 4) * 64;
    const float* cw = pin(12) + (size_t)l * 4 * 512; const float* cb = pin(13) + (size_t)l * 512;
    {
        const int ch = lane * 8, i0 = wid * 8;
        f32x4 w[4][2];
#pragma unroll
        for (int jj = 0; jj < 4; ++jj) { w[jj][0] = *(const f32x4*)(cw + jj * 512 + ch); w[jj][1] = *(const f32x4*)(cw + jj * 512 + ch + 4); }
        const f32x4 b0 = *(const f32x4*)(cb + ch), b1 = *(const f32x4*)(cb + ch + 4);
        u32x4 raw[11];
#pragma unroll
        for (int r = 0; r < 11; ++r) { const int row = pos_row(false, b, isctx, p0 + i0 + r - 2);
            raw[r] = (u32x4){0u, 0u, 0u, 0u}; if (row >= 0) raw[r] = *(const u32x4*)(P + (size_t)row * DINP + C_LRX + ch); }
#pragma unroll
        for (int i = 0; i < 8; ++i) {
            float a[8] = {b0[0], b0[1], b0[2], b0[3], b1[0], b1[1], b1[2], b1[3]};
#pragma unroll
            for (int jj = 0; jj < 4; ++jj) { float x[8]; unpack8(raw[i + jj], x);
#pragma unroll
                for (int e = 0; e < 4; ++e) { a[e] += w[jj][0][e] * x[e]; a[4 + e] += w[jj][1][e] * x[4 + e]; } }
            *(u32x4*)(sX + (i0 + i) * 520 + ch) = pack8(a);
        }
    }
    lbar();
    const int blk = wid;
    const bf16_t* WL = (const bf16_t*)(p.ws + WS_WLRU);
    float* LAGG = (float*)(p.ws + WS_SM + SM_LAGG);
    {
        const int ch = blk * 64 + n4 * 16 + fr;
        float hsum[4][4];
#pragma unroll
        for (int mt = 0; mt < 4; ++mt)
#pragma unroll
            for (int jj = 0; jj < 4; ++jj) hsum[mt][jj] = 0.f;
#pragma unroll
        for (int dir = 0; dir < 2; ++dir) {
            const bf16_t* wa = WL + (size_t)(0 * 16 + dir * 8 + blk) * 4096 + (n4 * 16 + fr) * 64 + fq * 8;
            const bf16_t* wx = WL + (size_t)(1 * 16 + dir * 8 + blk) * 4096 + (n4 * 16 + fr) * 64 + fq * 8;
            bf16x8 ba[2], bx[2];
#pragma unroll
            for (int kk = 0; kk < 2; ++kk) { ba[kk] = *(const bf16x8*)(wa + kk * 32); bx[kk] = *(const bf16x8*)(wx + kk * 32); }
            const int c = dir_chunk(dir, j);
            const size_t aidx = (((size_t)dir * 4 + b) * NCH + c) * 512 + ch;
            const float hin0 = mode ? LAGG[aidx * 2] : 0.f;
            const float bias_a = pin(15)[(size_t)l * 1024 + dir * 512 + ch], bias_x = pin(17)[(size_t)l * 1024 + dir * 512 + ch];
            const float cl = -8.f * softplus(-pin(18)[(size_t)l * 1024 + dir * 512 + ch]);
            float av[4][4], bv[4][4];
#pragma unroll
            for (int mt = 0; mt < 4; ++mt) {
                f32x4 aa = (f32x4){0.f, 0.f, 0.f, 0.f}, ax = aa;
#pragma unroll
                for (int kk = 0; kk < 2; ++kk) { const bf16x8 af = ldfrag(sX, 520, mt * 16, blk * 64 + kk * 32, lane); aa = MFMA16(af, ba[kk], aa); ax = MFMA16(af, bx[kk], ax); }
#pragma unroll
                for (int jj = 0; jj < 4; ++jj) {
                    const int t = mt * 16 + fq * 4 + jj;
                    const float rr = sigm(aa[jj] + bias_a), ii = sigm(ax[jj] + bias_x), la = cl * rr;
                    const float ea = __expf(la);
                    av[mt][jj] = ea;
                    bv[mt][jj] = __builtin_amdgcn_sqrtf(fmaxf(1.f - ea * ea, 0.f)) * ii * bf2f(sX[t * 520 + ch]);
                }
            }
            float hin = hin0;
            float Pc = 1.f, Hc = 0.f;
#pragma unroll
            for (int mi = 0; mi < 4; ++mi) {
                const int mt = dir ? 3 - mi : mi;
                float Pl = 1.f, Hl = 0.f;
#pragma unroll
                for (int ji = 0; ji < 4; ++ji) { const int jj = dir ? 3 - ji : ji; Pl = av[mt][jj] * Pl; Hl = av[mt][jj] * Hl + bv[mt][jj]; }
                float Pq[4], Hq[4];
#pragma unroll
                for (int q = 0; q < 4; ++q) { Pq[q] = __shfl(Pl, fr + 16 * q, 64); Hq[q] = __shfl(Hl, fr + 16 * q, 64); }
                if (mode == 0) {
#pragma unroll
                    for (int qi = 0; qi < 4; ++qi) { const int q = dir ? 3 - qi : qi; Hc = Pq[q] * Hc + Hq[q]; Pc = Pq[q] * Pc; }
                } else {
                    float hh = hin;
                    float hme = hin;
#pragma unroll
                    for (int qi = 0; qi < 4; ++qi) { const int q = dir ? 3 - qi : qi; if (q == fq) hme = hh; hh = Pq[q] * hh + Hq[q]; }
                    hin = hh;
#pragma unroll
                    for (int ji = 0; ji < 4; ++ji) { const int jj = dir ? 3 - ji : ji; hme = av[mt][jj] * hme + bv[mt][jj]; hsum[mt][jj] += hme; }
                }
            }
            if (mode == 0 && fq == 0) { LAGG[aidx * 2] = Pc; LAGG[aidx * 2 + 1] = Hc; }
        }
        if (mode == 1) {
#pragma unroll
            for (int mt = 0; mt < 4; ++mt)
#pragma unroll
                for (int jj = 0; jj < 4; ++jj) { const int i = mt * 16 + fq * 4 + jj; const int row = pos_row(false, b, isctx, p0 + i);
                    hsum[mt][jj] *= bf2f(P[(size_t)row * DINP + C_LRY + ch]); }
#pragma unroll
            for (int mt = 0; mt < 4; ++mt)
#pragma unroll
                for (int jj = 0; jj < 4; ++jj) { const int i = mt * 16 + fq * 4 + jj; const int row = pos_row(false, b, isctx, p0 + i);
                    bf16_t* yp = P + (size_t)row * DINP + C_LRY + ch; bf16_t* yd = dry ? (bf16_t*)(p.ws + WS_GB) + (size_t)row * 512 + ch : yp; *yd = (bf16_t)f2bf(hsum[mt][jj]); }
        }
    }
    lbar();
}
DEVI void lru_seq(const PW& pw0, int gtid, int nthreads) {
    const PW p{opq64(pw0.ws)};
    float* LAGG = (float*)(p.ws + WS_SM + SM_LAGG);
    for (int g = gtid; g < 4096; g += nthreads) {
        const int ch = g & 511, db = g >> 9;
        float h = 0.f;
        for (int c0 = 0; c0 < NCH; c0 += 17) {
            f32x2 v[17];
#pragma unroll
            for (int u = 0; u < 17; ++u) v[u] = *(const f32x2*)(LAGG + (((size_t)db * NCH + c0 + u) * 512 + ch) * 2);
#pragma unroll
            for (int u = 0; u < 17; ++u) { LAGG[(((size_t)db * NCH + c0 + u) * 512 + ch) * 2] = h; h = v[u][0] * h + v[u][1]; }
        }
    }
}

DEVI void gate_phase(const PW& pw0, int l, int gwave, int nwaves, int lane) {
    const PW p{opq64(pw0.ws)};
    const bf16_t* P = (const bf16_t*)(p.ws + WS_P);
    float* GT = (float*)(p.ws + WS_GATES);
    for (int w = gwave; w < 4352; w += nwaves) {
        const int kind = w >= 2176 ? 1 : 0, item = kind ? w - 2176 : w;
        const int c = item % NCH, h = (item / NCH) & 3, b = (item / (NCH * 4)) & 3, dir = item / (NCH * 16);
        float* gp = GT + (size_t)(kind * 2176 + item) * 320;
        if (kind == 0) gdn_gates(p, P, l, b, c, h, dir, gp, lane);
        else {
            const int row = tok_row(false, dir, b, c, lane);
            const float ig = bf2f(P[(size_t)row * DINP + C_MLG + dir * 4 + h]) + pin(10)[l * 16 + dir * 4 + h];
            const float fg = bf2f(P[(size_t)row * DINP + C_MLG + (2 + dir) * 4 + h]) + pin(10)[l * 16 + (2 + dir) * 4 + h];
            float bb = logsig(fg);
#pragma unroll
            for (int o = 1; o < 64; o <<= 1) { const float t = __shfl_up(bb, o, 64); if (lane >= o) bb += t; }
            const float bT = __shfl(bb, 63, 64);
            const float lw = bT - bb + ig;
            const float Mc = wmax(lw);
            float pm = ig - bb;
#pragma unroll
            for (int o = 1; o < 64; o <<= 1) { const float t = __shfl_up(pm, o, 64); if (lane >= o) pm = fmaxf(pm, t); }
            gp[lane] = bb; gp[64 + lane] = ig; gp[128 + lane] = __expf(lw - Mc); gp[192 + lane] = pm;
            if (lane == 0) { float* msc = (float*)(p.ws + WS_SM + SM_MSC) + item * 2; msc[0] = bT; msc[1] = Mc; }
        }
    }
}

#define XB_TMO      128
#define XB_XCNT(j)  (256  + 64 * (j))
#define XB_XSUB(j)  (1280 + 64 * (j))
#define XB_XGEN(j)  (2304 + 64 * (j))
#define XB_TOP      3328
#define XB_TOPGEN   3392
#define XCD_BAR_WORDS 3456
#define XB_SPIN_CAP (1u << 22)
DEVI unsigned xb_ld(unsigned* p)              { return __hip_atomic_load(p, __ATOMIC_RELAXED, __HIP_MEMORY_SCOPE_AGENT); }
DEVI unsigned xb_add(unsigned* p, unsigned v) { return __hip_atomic_fetch_add(p, v, __ATOMIC_RELAXED, __HIP_MEMORY_SCOPE_AGENT); }
DEVI unsigned xb_xcc_id() { return (unsigned)__builtin_amdgcn_s_getreg((3 << 11) | 20) & 0xFu; }
#define XB_SPIN(cond, bar) do { unsigned _sp = 0; while (cond) { __builtin_amdgcn_s_sleep(1); \
    if ((++_sp & 255u) == 0u) { if (xb_ld(&(bar)[XB_TMO])) break; if (_sp > XB_SPIN_CAP) { atomicAdd(&(bar)[XB_TMO], 1u); break; } } } } while (0)
DEVI void xcd_barrier_complete(unsigned* bar, unsigned x, unsigned G, unsigned& nloc, unsigned& nx) {
    unsigned sum, cnt, mine, sp = 0u;
    for (;;) {
        sum = 0u; cnt = 0u; mine = 0u;
#pragma unroll
        for (unsigned j = 0; j < 16; ++j) { const unsigned c = xb_ld(&bar[XB_XCNT(j)]); sum += c; cnt += (c > 0u) ? 1u : 0u; mine = (j == x) ? c : mine; }
        if (sum == G) break;
        __builtin_amdgcn_s_sleep(1);
        if ((++sp & 255u) == 0u) { if (xb_ld(&bar[XB_TMO])) break; if (sp > XB_SPIN_CAP) { atomicAdd(&bar[XB_TMO], 1u); break; } }
    }
    nloc = mine > 0u ? mine : 1u; nx = cnt > 0u ? cnt : 1u;
}
DEVI void gsync(unsigned* bar, volatile LAS unsigned* st, int G, int wv) {
    asm volatile("s_waitcnt vmcnt(0)" ::: "memory");
    __syncthreads();
    const int ln = (int)__builtin_amdgcn_mbcnt_hi(~0u, __builtin_amdgcn_mbcnt_lo(~0u, 0u));
    if (wv == 0 && ln == 0) {
        __builtin_amdgcn_s_waitcnt(0);
        const unsigned x = xb_xcc_id();
        unsigned nloc = st[0], nx = st[1];
        if (nloc == 0u) { xcd_barrier_complete(bar, x, (unsigned)G, nloc, nx); st[0] = nloc; st[1] = nx; }
        const unsigned old = xb_add(&bar[XB_XSUB(x)], 1u);
        const unsigned gen = old / nloc;
        if (old + 1u == (gen + 1u) * nloc) {
            __builtin_amdgcn_fence(__ATOMIC_RELEASE, "agent");
            asm volatile("s_waitcnt vmcnt(0)" ::: "memory");
            const unsigned og = xb_add(&bar[XB_TOP], 1u);
            const unsigned tg = og / nx;
            if (og + 1u == (tg + 1u) * nx) xb_add(&bar[XB_TOPGEN], 1u);
            else XB_SPIN(xb_ld(&bar[XB_TOPGEN]) == tg, bar);
            __builtin_amdgcn_fence(__ATOMIC_ACQUIRE, "agent");
            xb_add(&bar[XB_XGEN(x)], 1u);
            asm volatile("s_waitcnt vmcnt(0)" ::: "memory");
        } else {
            XB_SPIN(xb_ld(&bar[XB_XGEN(x)]) == gen, bar);
            __builtin_amdgcn_fence(__ATOMIC_ACQUIRE, "agent");
            asm volatile("s_waitcnt vmcnt(0)" ::: "memory");
        }
    }
    __syncthreads();
}

__global__ void __launch_bounds__(512) mega(Params p) {
    extern __shared__ __attribute__((aligned(16))) unsigned char shm[];
    cg::grid_group grid = cg::this_grid();
    const int wv = __builtin_amdgcn_readfirstlane(threadIdx.x >> 6);
    const int G = gridDim.x, nwaves = G * 8, nthreads = G * 512;
#define TIDS const int tid = MYTID, wid = tid >> 6, lane = tid & 63, gwave = blockIdx.x * 8 + wid, gtid = blockIdx.x * 512 + tid; (void)gtid; (void)gwave; (void)lane;
    LAS unsigned char* lds = (LAS unsigned char*)shm;
#define WSQ unsigned char* ws = opq64(pw.ws); bf16_t* Hb = (bf16_t*)(ws + WS_H); bf16_t* Pb = (bf16_t*)(ws + WS_P); float* Yb = (float*)(ws + WS_Y); (void)Hb; (void)Pb; (void)Yb;

    const PW pw{p.ws};
    unsigned* bar = (unsigned*)p.ws;
    volatile LAS unsigned* xst = (volatile LAS unsigned*)((LAS unsigned char*)shm + (LDS_BYTES - 16));
    if (threadIdx.x == 0) { xst[0] = 0u; xst[1] = 0u; (void)xb_add(&bar[XB_XCNT(xb_xcc_id())], 1u); }
    __syncthreads();
    for (int rep = 0; rep < REP_CVT; ++rep) {
    mod_phase(pw, shm, wv);
    { TIDS convert_phase(pw, 0, shm, gwave, nwaves, wid, lane); }
    }
    grid.sync();
    { TIDS rowwise_phase(pw, 0, MTOT, 0, 0, 0.f, 0, 0, 0, 0, 0, gwave, nwaves, lane); }
    gsync(bar, xst, G, wv);

#pragma unroll 1
    for (int l = 0; l < DEPTH; ++l) {
        const bool last = l == DEPTH - 1;
#pragma unroll 1
        for (int f = 0; f < 2; ++f) {
            if (f == 1) {
                { WSQ pg8::Gemm g{Hb, (const bf16_t*)(ws + WS_WIN), 68, 31, D, D, 1, 0, 0, 0, 0, D, 0}; pg8::Order S; S.init(68, 31, 1, G, blockIdx.x);
                  pg8::EpiInProj E{Pb, DINP}; for (int rep = 0; rep < REP_GEMM; ++rep) pg8::gemm_phase(lds, g, S, E, wv); }
                gsync(bar, xst, G, wv);
                { TIDS gate_phase(pw, l, gwave, nwaves, lane); }
                gsync(bar, xst, G, wv);
#pragma unroll 1
                for (int rep2 = 0; rep2 < REP_PREPSEQ; ++rep2) {
#pragma unroll 1
                for (int rep = 0; rep < REP_PREP; ++rep)
                {
                    gdn_prep_all(pw, l, blockIdx.x, G, shm, wv);
                    ml_prep_all(pw, l, (blockIdx.x + G / 2) % G, G, shm, wv);
                    for (int it = (blockIdx.x + G / 4) % G; it < 1088; it += G) for (int r3 = 0; r3 < REP_LRU0; ++r3) lru_item(pw, l, it, 0, shm, wv);
                }
                gsync(bar, xst, G, wv);
                for (int u = blockIdx.x; u < 256; u += G) gdn_seq_unit(pw, u, shm, wv);
                { TIDS ml_seq(pw, gtid, nthreads); }
                { TIDS lru_seq(pw, gtid, nthreads); }
                gsync(bar, xst, G, wv);
                }
                gdn_out_all(pw, l, blockIdx.x, G, last, shm, wv);
                ml_out_all(pw, l, (blockIdx.x + G / 4) % G, G, last, shm, wv);
                for (int it = (blockIdx.x + G / 2) % G; it < 1088; it += G) { if (last && ((it >> 2) % NCH) < 4) continue; if (DRY_LO) lru_item(pw, l, it, 1, shm, wv, 1); lru_item(pw, l, it, 1, shm, wv); }
                gsync(bar, xst, G, wv);
                const int nM = last ? 64 : 68;
                { WSQ pg8::Gemm g{Pb, (const bf16_t*)(ws + WS_WBR), 64, 4, 512, DINP, 3, C_MLO, C_LRY, C_DNZ, D * 512, 512, 0}; pg8::Order S; S.init(64, 4, 3, G, blockIdx.x);
                  pg8::EpiBranch E{Pb, (bf16_t*)Yb, Hb}; for (int rep = 0; rep < REP_BR; ++rep) pg8::gemm_phase(lds, g, S, E, wv); }
                if (!last) { WSQ pg8::Gemm g{Pb, (const bf16_t*)(ws + WS_WBR), 4, 4, 512, DINP, 3, C_MLO, C_LRY, C_DNZ, D * 512, 512, 0}; pg8::Order S; S.init(4, 4, 3, G, G - 1 - blockIdx.x, 64, 1);
                  pg8::EpiBranchPart E{Pb, (float*)(ws + WS_GB + ((size_t)32 << 20))}; pg8::gemm_phase(lds, g, S, E, wv); }
                gsync(bar, xst, G, wv);
                { WSQ pg8::Gemm g{Hb, (const bf16_t*)(ws + WS_WOUT), 64, 4, D, D, 1, 0, 0, 0, 0, D, 0}; pg8::Order S; S.init(64, 4, 1, G, blockIdx.x);
                  pg8::EpiBf16Y E{(bf16_t*)Yb, D}; for (int rep = 0; rep < REP_GEMM; ++rep) pg8::gemm_phase(lds, g, S, E, wv); }
                if (!last) { WSQ pg8::Gemm g{Hb, (const bf16_t*)(ws + WS_WOUT), 4, 4, 256, D, 4, 0, 0, 0, 256, D, 256}; pg8::Order S; S.init(4, 4, 4, G, blockIdx.x, 64, 1);
                  pg8::Unit u0;
                  if (S.next(0, u0)) {
                      TIDS const float* PART = (const float*)(ws + WS_GB + ((size_t)32 << 20));
                      const int r = tid >> 1, hc = (tid & 1) * 128;
                      const size_t off = (size_t)((u0.pm - 64) * 256 + r) * D + u0.z * 256 + hc;
                      bf16_t* up = Hb + (size_t)(u0.pm * 256 + r) * D + u0.z * 256 + hc;
#pragma unroll 1
                      for (int cb = 0; cb < 128; cb += 32) {
                          f32x4 t[3][8];
#pragma unroll
                          for (int zz = 0; zz < 3; ++zz)
#pragma unroll
                              for (int q4 = 0; q4 < 8; ++q4) t[zz][q4] = *(const f32x4*)(PART + (size_t)zz * 1024 * D + off + cb + q4 * 4);
#pragma unroll
                          for (int q4 = 0; q4 < 8; q4 += 2) { const f32x4 a = t[0][q4] + t[1][q4] + t[2][q4], b2 = t[0][q4 + 1] + t[1][q4 + 1] + t[2][q4 + 1];
                              u32x4 w; w[0] = pk2(a[0], a[1]); w[1] = pk2(a[2], a[3]); w[2] = pk2(b2[0], b2[1]); w[3] = pk2(b2[2], b2[3]); *(u32x4*)(up + cb + q4 * 4) = w; }
                      }
                  }
                  asm volatile("s_waitcnt vmcnt(0)" ::: "memory"); __syncthreads();
                  pg8::EpiF32 E{(float*)(ws + WS_GB), D, MLAT, (size_t)1024 * D}; pg8::gemm_phase(lds, g, S, E, wv); }
                gsync(bar, xst, G, wv);
                { TIDS if (DRY_ROW) { rowwise_phase(pw, 1, nM * 256, l, 5, 1.f, 3, l, 4, 6, 4, gwave, nwaves, lane, 1); } rowwise_phase(pw, 1, nM * 256, l, 5, 1.f, 3, l, 4, 6, 4, gwave, nwaves, lane); }
                gsync(bar, xst, G, wv);
            }
            const int nM = (last && f == 1) ? 64 : 68;
            { WSQ pg8::Gemm g{Hb, (const bf16_t*)(ws + WS_WGU + f * SZ_WGU), nM, 22, D, D, 1, 0, 0, 0, 0, D, 0}; pg8::Order S; S.init(nM, 22, 1, G, blockIdx.x);
              pg8::EpiSwiGLU E{Pb, DFF}; for (int rep = 0; rep < REP_GU; ++rep) pg8::gemm_phase(lds, g, S, E, wv); }
            gsync(bar, xst, G, wv);
            { WSQ pg8::Gemm g{Pb, (const bf16_t*)(ws + WS_WDN + f * SZ_WDN), 64, 4, DFF, DFF, 1, 0, 0, 0, 0, DFF, 0}; pg8::Order S; S.init(64, 4, 1, G, blockIdx.x);
              pg8::EpiBf16Y E{(bf16_t*)Yb, D}; for (int rep = 0; rep < REP_DN; ++rep) pg8::gemm_phase(lds, g, S, E, wv); }
            if (nM == 68) { WSQ pg8::Gemm g{Pb, (const bf16_t*)(ws + WS_WDN + f * SZ_WDN), 4, 4, 256, DFF, 11, 0, 0, 0, 256, DFF, 256}; pg8::Order S; S.init(4, 4, 11, G, blockIdx.x, 64, 1);
              pg8::EpiF32 E{(float*)(ws + WS_GB), D, MLAT, (size_t)1024 * D}; for (int rep = 0; rep < REP_DNC; ++rep) pg8::gemm_phase(lds, g, S, E, wv); }
            gsync(bar, xst, G, wv);
            if (f == 0) { TIDS if (DRY_ROW) { rowwise_phase(pw, 1, nM * 256, l, 2, 0.5f, 1, l, 2, 3, 11, gwave, nwaves, lane, 1); } rowwise_phase(pw, 1, nM * 256, l, 2, 0.5f, 1, l, 2, 3, 11, gwave, nwaves, lane); }
            else if (!last) { { TIDS if (DRY_ROW) { rowwise_phase(pw, 1, nM * 256, l, 8, 0.5f, 5, l + 1, 0, 0, 11, gwave, nwaves, lane, 1); } rowwise_phase(pw, 1, nM * 256, l, 8, 0.5f, 5, l + 1, 0, 0, 11, gwave, nwaves, lane); } for (int rep = 0; rep < REP_CVT; ++rep) { TIDS convert_phase(pw, l + 1, shm, gwave, nwaves, wid, lane); } }
            else { TIDS rowwise_phase(pw, 2, MLAT, l, 8, 0.5f, 5, 0, 0, 0, 0, gwave, nwaves, lane); }
            gsync(bar, xst, G, wv);
        }
    }
}

extern "C" void kernel_launch(void* const* d_in, const int* in_sizes, int n_in, void* d_out, int out_size, void* d_ws, size_t ws_size, hipStream_t stream) {
    static int grid = 0;
    if (grid == 0) {
        if (n_in != 25 || ws_size < WS_END) { fprintf(stderr, "kernel_launch: unexpected n_in %d or ws_size %zu (need %zu)\n", n_in, ws_size, (size_t)WS_END); grid = -1; return; }
        int dev = 0, cus = 0, per_cu = 0;
        hipGetDevice(&dev); hipDeviceGetAttribute(&cus, hipDeviceAttributeMultiprocessorCount, dev);
        if (hipFuncSetAttribute((const void*)mega, hipFuncAttributeMaxDynamicSharedMemorySize, LDS_BYTES) != hipSuccess) { fprintf(stderr, "kernel_launch: hipFuncSetAttribute failed\n"); grid = -1; return; }
        if (hipOccupancyMaxActiveBlocksPerMultiprocessor(&per_cu, (const void*)mega, 512, LDS_BYTES) != hipSuccess || per_cu < 1) { fprintf(stderr, "kernel_launch: occupancy query failed (%d)\n", per_cu); per_cu = 1; }
        (void)hipGetLastError();
        grid = cus * per_cu;
    }
    if (grid < 0) return;
    if (hipMemsetAsync(d_ws, 0, 16384, stream) != hipSuccess) { fprintf(stderr, "kernel_launch: memset failed\n"); return; }
    Params p{};
    for (int i = 0; i < 25; ++i) p.in[i] = (const float*)d_in[i];
    p.out = (float*)d_out; p.ws = (unsigned char*)d_ws;
    void* args[] = {&p};
    hipError_t e = hipLaunchCooperativeKernel((const void*)mega, dim3(grid), dim3(512), args, LDS_BYTES, stream);
    if (e != hipSuccess) fprintf(stderr, "cooperative launch failed: %s (grid %d)\n", hipGetErrorString(e), grid);
}
```

```cpp
#include <hip/hip_runtime.h>
#include <hip/hip_cooperative_groups.h>
#include <cstdio>
namespace cg = cooperative_groups;

#define LAS __attribute__((address_space(3)))
#define DEVI __device__ __forceinline__
typedef unsigned short bf16_t;
typedef short bf16x8 __attribute__((ext_vector_type(8)));
typedef float f32x4 __attribute__((ext_vector_type(4)));
typedef float f32x2 __attribute__((ext_vector_type(2)));
typedef unsigned u32x4 __attribute__((ext_vector_type(4)));
typedef unsigned u32x2 __attribute__((ext_vector_type(2)));

constexpr int D = 1024, NBATCH = 4, SEQ = 4096, CTXL = 256, DEPTH = 4, DFF = 2816, DINP = 7936;
constexpr int MLAT = NBATCH * SEQ, MTOT = MLAT + NBATCH * CTXL;
constexpr int NCH = 68;
constexpr int C_MLQ = 0, C_MLK = 256, C_MLV = 512, C_MLO = 1024, C_MLG = 1536, C_LRX = 1552, C_LRY = 2064,
              C_DNQ = 2576, C_DNZ = 4112, C_DNBA = 4624, C_GATE = 4640, C_END = 7712;
constexpr float EPS = 1e-6f;

constexpr size_t SZ_WGU = (size_t)2 * DFF * D * 2, SZ_WDN = (size_t)D * DFF * 2;
constexpr size_t WS_MOD = 16384;
constexpr size_t WS_WGU = 1u << 20;
constexpr size_t WS_WDN = WS_WGU + 2 * SZ_WGU;
constexpr size_t WS_WIN = WS_WDN + 2 * SZ_WDN;
constexpr size_t WS_WBR = WS_WIN + (size_t)DINP * D * 2;
constexpr size_t WS_WOUT = WS_WBR + (size_t)3 * D * 512 * 2;
constexpr size_t WS_WLRU = WS_WOUT + (size_t)D * D * 2;
constexpr size_t WS_X = WS_WLRU + (size_t)32 * 64 * 64 * 2;
constexpr size_t WS_H = WS_X + (size_t)MTOT * D * 4;
constexpr size_t WS_Y = WS_H + (size_t)MTOT * D * 2;
constexpr size_t WS_P = WS_Y + (size_t)MTOT * D * 4;
constexpr size_t WS_GU = WS_P + (size_t)MTOT * DINP * 2;
constexpr size_t WS_GB = WS_GU + (size_t)2176 * 64 * 128 * 2;
constexpr size_t WS_GN = WS_GB + (size_t)2176 * 128 * 128 * 2;
constexpr size_t WS_SM = WS_GN + (size_t)2176 * 128 * 128 * 2;
constexpr size_t SM_GDEC = 0, SM_MN = 16384, SM_MSC = SM_MN + 2176 * 64 * 4, SM_MM = SM_MSC + 2176 * 8, SM_LAGG = SM_MM + 2176 * 4 + 1024;
constexpr size_t WS_YC = WS_SM + SM_LAGG + (size_t)2 * 4 * NCH * 512 * 2 * 4 + 4096;
constexpr size_t WS_GATES = WS_YC;
constexpr size_t WS_END = WS_GATES + (size_t)2 * 2176 * 320 * 4 + 4096;
constexpr int LDS_BYTES = 155648;
constexpr int REP_BR = 1, REP_GU = 1, REP_DN = 1, REP_DNC = 1, REP_GEMM = 1, DRY_ROW = 0, REP_PREP = 1, REP_PREPSEQ = 1, REP_CVT = 1, REP_GDNP = 1, REP_MLP = 1, REP_LRU0 = 1, DRY_GO = 0, DRY_MO = 0, DRY_LO = 0;

struct Params { const float* in[25]; float* out; unsigned char* ws; };
struct PW { unsigned char* ws; };

#define CAS __attribute__((address_space(4)))
DEVI const float* pin(int i) { const CAS char* k = (const CAS char*)__builtin_amdgcn_kernarg_segment_ptr(); return *(const float* const volatile CAS*)(k + 8 * i); }
DEVI int opaque(int v) { asm volatile("" : "+v"(v)); return v; }
DEVI unsigned char* opq(unsigned char* p) { unsigned v = (unsigned)(size_t)(LAS unsigned char*)p; asm volatile("" : "+s"(v)); return (unsigned char*)(LAS unsigned char*)(size_t)v; }
DEVI LAS unsigned char* opql(LAS unsigned char* p) { unsigned v = (unsigned)(size_t)p; asm volatile("" : "+s"(v)); return (LAS unsigned char*)(size_t)v; }
DEVI unsigned char* opq64(unsigned char* p) { unsigned long long v = (unsigned long long)p; asm volatile("" : "+s"(v)); return (unsigned char*)v; }
#define MYTID opaque(wv * 64 + (int)__builtin_amdgcn_mbcnt_hi(~0u, __builtin_amdgcn_mbcnt_lo(~0u, 0u)))
DEVI float bf2f(bf16_t v) { return __uint_as_float(((unsigned)v) << 16); }
DEVI unsigned f2bf(float f) { unsigned u = __float_as_uint(f); return (u + 0x7fffu + ((u >> 16) & 1u)) >> 16; }
DEVI unsigned pk2(float lo, float hi) { return f2bf(lo) | (f2bf(hi) << 16); }
DEVI float sigm(float x) { return __builtin_amdgcn_rcpf(1.f + __expf(-x)); }
DEVI float silu(float x) { return x * sigm(x); }
DEVI float softplus(float x) { return x > 20.f ? x : log1pf(__expf(x)); }
DEVI float logsig(float x) { return fminf(x, 0.f) - log1pf(__expf(-fabsf(x))); }
DEVI float gelu_t(float x) { float u = 0.7978845608f * (x + 0.044715f * x * x * x); float e = __expf(2.f * u); return x * (1.f - __builtin_amdgcn_rcpf(e + 1.f)); }
DEVI float wsum(float v) { for (int o = 32; o > 0; o >>= 1) v += __shfl_xor(v, o, 64); return v; }
DEVI float wmax(float v) { for (int o = 32; o > 0; o >>= 1) v = fmaxf(v, __shfl_xor(v, o, 64)); return v; }
DEVI void unpack8(u32x4 r, float* f) {
    f[0] = __uint_as_float(r[0] << 16); f[1] = __uint_as_float(r[0] & 0xffff0000u); f[2] = __uint_as_float(r[1] << 16); f[3] = __uint_as_float(r[1] & 0xffff0000u);
    f[4] = __uint_as_float(r[2] << 16); f[5] = __uint_as_float(r[2] & 0xffff0000u); f[6] = __uint_as_float(r[3] << 16); f[7] = __uint_as_float(r[3] & 0xffff0000u);
}
DEVI u32x4 pack8(const float* f) { u32x4 r; r[0] = pk2(f[0], f[1]); r[1] = pk2(f[2], f[3]); r[2] = pk2(f[4], f[5]); r[3] = pk2(f[6], f[7]); return r; }
DEVI bf16x8 ldfrag(const bf16_t* base, int ld, int row0, int k0, int lane) { return *(const bf16x8*)(base + (row0 + (lane & 15)) * ld + k0 + (lane >> 4) * 8); }
DEVI int tix(int row, int col) { return row * 72 + ((((col >> 3) + (row >> 3)) & 7) << 3) + (col & 7); }
DEVI bf16x8 ldfragT(const bf16_t* base, int row0, int k0, int lane) { const int r = row0 + (lane & 15), lg = (k0 >> 3) + (lane >> 4); return *(const bf16x8*)(base + r * 72 + (((lg + (r >> 3)) & 7) << 3)); }
DEVI void lbar() { asm volatile("s_waitcnt lgkmcnt(0)" ::: "memory"); __builtin_amdgcn_s_barrier(); asm volatile("" ::: "memory"); }
#define MFMA16(a, b, c) __builtin_amdgcn_mfma_f32_16x16x32_bf16(a, b, c, 0, 0, 0)

namespace pg8 {
constexpr int BM = 256, BK = 64, HALF = 128, HTB = HALF * BK * 2, NXCD = 8, WGM = 8;
DEVI int lds_byte(int r, int c) { const int st = (r >> 4) * 2 + (c >> 5), rr = r & 15, cc = c & 31, ob = rr * 64 + cc * 2; return st * 1024 + (ob ^ (((ob >> 9) & 1) << 5)); }
DEVI void stage_rc(int b, int& R, int& C) { const int st = b / 1024, sb = b % 1024, swz = sb ^ (((sb >> 9) & 1) << 5); R = (st >> 1) * 16 + swz / 64; C = (st & 1) * 32 + (swz % 64) / 2; }
DEVI int perm32(int rho) { const int n = rho >> 4, i = rho & 15; return 8 * (i >> 2) + 4 * n + (i & 3); }
struct Unit { int pm, pn, z; };
struct Gemm { const bf16_t* A; const bf16_t* Bt; int nM, nN, K, lda, nz, zA0, zA1, zA2, zB; int ldb, zAstep; };
struct Order {
    int nM, nN, nwg, G, c, nz, pm0, spread;
    DEVI void init(int nM_, int nN_, int nz_, int G_, int c_, int pm0_ = 0, int spread_ = 0) { nM = nM_; nN = nN_; nwg = nM * nN; G = G_; c = c_; nz = nz_; pm0 = pm0_; spread = spread_; }
    DEVI bool next(int i, Unit& u) const {
        int ti = i, z = 0; long L;
        if (spread) { L = (long)i * G + c; if (L >= (long)nwg * nz) return false; z = (int)(L / nwg); L -= (long)z * nwg; }
        else { if (nz == 3) { ti = i / 3; z = i - ti * 3; } L = (long)ti * G + c; if (L >= nwg) return false; }
        int wgid = (int)L; { const int q = nwg / NXCD, r = nwg % NXCD, xcd = wgid % NXCD, off = wgid / NXCD; wgid = (xcd < r ? xcd * (q + 1) : r * (q + 1) + (xcd - r) * q) + off; }
        const int nig = WGM * nN, gid = wgid / nig, fm = gid * WGM, gsz = (nM - fm) < WGM ? (nM - fm) : WGM;
        u.pm = pm0 + fm + ((wgid % nig) % gsz); u.pn = (wgid % nig) / gsz; u.z = z; return true;
    }
};

template <class Epi>
DEVI void gemm_phase(LAS unsigned char* lds_in, const Gemm g, const Order& S, const Epi& E, int wv) {
    LAS unsigned char* lds = opql(lds_in);
    const int tid = MYTID, wid = __builtin_amdgcn_readfirstlane(tid >> 6), lane = tid & 63, wr = wid >> 2, wc = wid & 3, fr = lane & 15, fq = lane >> 4;
    const int K = g.K, nt = K / BK, lda = g.lda, ldb = g.ldb;
    unsigned voffA[2], voffB[2];
#pragma unroll
    for (int i = 0; i < 2; ++i) { int R, C; stage_rc(tid * 16 + i * 8192, R, C); const int Rb = Epi::PERM ? ((R & ~31) + perm32(R & 31)) : R;
        voffA[i] = (unsigned)(R * lda + C) * 2u; voffB[i] = (unsigned)(Rb * ldb + C) * 2u; }
    const size_t kstep = (size_t)(BK * 2);
    const size_t hstepA = (size_t)HALF * lda * 2, hstepB = (size_t)HALF * ldb * 2;
    const unsigned ldsw = (unsigned)wid * 1024u;
    const int aoff = lds_byte(wr * 64 + fr, fq * 8), boff = lds_byte(wc * 32 + fr, fq * 8);
#define PG8_SA(b, h) (((b) * 2 + (h)) * HTB)
#define PG8_SB(b, h) ((4 + (b) * 2 + (h)) * HTB)
#define PG8_STAGE(bufoff, gbase, voff) do { _Pragma("unroll") for (int _i = 0; _i < 2; ++_i) \
        __builtin_amdgcn_global_load_lds((const unsigned*)((const char*)(gbase) + (voff)[_i]), (LAS unsigned*)(lds + (bufoff) + ldsw + _i * 8192), 16, 0, 0); } while (0)
#define PG8_LDA(dst, b, h) do { _Pragma("unroll") for (int m = 0; m < 4; ++m) _Pragma("unroll") for (int k = 0; k < 2; ++k) dst[m][k] = *(const LAS bf16x8*)(lds + PG8_SA(b, h) + aoff + m * 2048 + k * 1024); } while (0)
#define PG8_LDB(dst, b, h) do { _Pragma("unroll") for (int n = 0; n < 2; ++n) _Pragma("unroll") for (int k = 0; k < 2; ++k) dst[n][k] = *(const LAS bf16x8*)(lds + PG8_SB(b, h) + boff + n * 2048 + k * 1024); } while (0)
#define PG8_MMA(ai, bj, At, Bt) do { __builtin_amdgcn_s_setprio(1); _Pragma("unroll") for (int m = 0; m < 4; ++m) _Pragma("unroll") for (int n = 0; n < 2; ++n) _Pragma("unroll") for (int k = 0; k < 2; ++k) \
        acc[ai][bj][m][n] = __builtin_amdgcn_mfma_f32_16x16x32_bf16(Bt[n][k], At[m][k], acc[ai][bj][m][n], 0, 0, 0); __builtin_amdgcn_s_setprio(0); } while (0)
#define PG8_WAIT_V(n) asm volatile("s_waitcnt vmcnt(" #n ")" ::: "memory")
#define PG8_WAIT_L(n) asm volatile("s_waitcnt lgkmcnt(" #n ")" ::: "memory")
#define PG8_BAR __builtin_amdgcn_s_barrier()
#define PG8_SCHED __builtin_amdgcn_sched_barrier(0)
#define PG8_PA(u) ((const char*)g.A + ((size_t)(g.nz == 3 ? ((u).z == 0 ? g.zA0 : ((u).z == 1 ? g.zA1 : g.zA2)) : (u).z * g.zAstep) + (size_t)(u).pm * BM * lda) * 2)
#define PG8_PB(u) ((const char*)g.Bt + ((size_t)(u).z * g.zB + (size_t)(u).pn * BM * ldb) * 2)
    Unit cur, nxt; int ui = 0;
    if (!S.next(0, cur)) return;
    f32x4 acc[2][2][4][2];
#pragma unroll
    for (int a = 0; a < 2; ++a)
#pragma unroll
        for (int b = 0; b < 2; ++b)
#pragma unroll
            for (int m = 0; m < 4; ++m)
#pragma unroll
                for (int n = 0; n < 2; ++n) acc[a][b][m][n] = (f32x4){0.f, 0.f, 0.f, 0.f};
    bf16x8 At[4][2], B0[2][2], B1[2][2];
    const char* cA = PG8_PA(cur); const char* cB = PG8_PB(cur);
    PG8_STAGE(PG8_SB(0, 0), cB, voffB); PG8_STAGE(PG8_SA(0, 0), cA, voffA); PG8_STAGE(PG8_SB(0, 1), cB + hstepB, voffB); PG8_STAGE(PG8_SA(0, 1), cA + hstepA, voffA);
    if (wr == 1) PG8_BAR;
    PG8_WAIT_V(4); PG8_BAR;
    PG8_STAGE(PG8_SB(1, 0), cB + kstep, voffB); PG8_STAGE(PG8_SA(1, 0), cA + kstep, voffA); PG8_STAGE(PG8_SB(1, 1), cB + hstepB + kstep, voffB);
    PG8_WAIT_V(6); PG8_BAR;
    for (;;) {
        const bool has_next = S.next(ui + 1, nxt);
        const char* nA = has_next ? PG8_PA(nxt) : cA; const char* nB = has_next ? PG8_PB(nxt) : cB;
        for (int t = 0; t < nt; t += 2) {
            const bool last = (t == nt - 2);
            const char* a1 = cA + (size_t)(t + 1) * kstep;
            const char* a2 = last ? nA : cA + (size_t)(t + 2) * kstep; const char* b2 = last ? nB : cB + (size_t)(t + 2) * kstep;
            const char* a3 = a2 + kstep; const char* b3 = b2 + kstep;
            PG8_LDB(B0, 0, 0); PG8_SCHED; PG8_LDA(At, 0, 0); PG8_STAGE(PG8_SA(1, 1), a1 + hstepA, voffA);
            PG8_WAIT_L(8); PG8_BAR; PG8_WAIT_L(0); PG8_MMA(0, 0, At, B0); PG8_BAR; PG8_SCHED;
            PG8_LDB(B1, 0, 1); PG8_STAGE(PG8_SB(0, 0), b2, voffB);
            PG8_BAR; PG8_WAIT_L(0); PG8_MMA(0, 1, At, B1); PG8_BAR;
            PG8_LDA(At, 0, 1); PG8_STAGE(PG8_SA(0, 0), a2, voffA);
            PG8_BAR; PG8_WAIT_L(0); PG8_MMA(1, 0, At, B0); PG8_BAR; PG8_SCHED;
            PG8_STAGE(PG8_SB(0, 1), b2 + hstepB, voffB);
            PG8_WAIT_V(6); PG8_BAR; PG8_MMA(1, 1, At, B1); PG8_BAR;
            PG8_LDB(B0, 1, 0); PG8_SCHED; PG8_LDA(At, 1, 0); PG8_STAGE(PG8_SA(0, 1), a2 + hstepA, voffA);
            PG8_WAIT_L(8); PG8_BAR; PG8_WAIT_L(0); PG8_MMA(0, 0, At, B0); PG8_BAR; PG8_SCHED;
            PG8_LDB(B1, 1, 1); PG8_STAGE(PG8_SB(1, 0), b3, voffB);
            PG8_BAR; PG8_WAIT_L(0); PG8_MMA(0, 1, At, B1); PG8_BAR;
            PG8_LDA(At, 1, 1); PG8_STAGE(PG8_SA(1, 0), a3, voffA);
            PG8_BAR; PG8_WAIT_L(0); PG8_MMA(1, 0, At, B0); PG8_BAR; PG8_SCHED;
            PG8_STAGE(PG8_SB(1, 1), b3 + hstepB, voffB);
            PG8_WAIT_V(6); PG8_BAR; PG8_MMA(1, 1, At, B1); PG8_BAR;
        }
        E(acc, cur, wr, wc, fr, fq);
        if (!has_next) break;
#pragma unroll
        for (int a = 0; a < 2; ++a)
#pragma unroll
            for (int b = 0; b < 2; ++b)
#pragma unroll
                for (int m = 0; m < 4; ++m)
#pragma unroll
                    for (int n = 0; n < 2; ++n) acc[a][b][m][n] = (f32x4){0.f, 0.f, 0.f, 0.f};
        cur = nxt; cA = nA; cB = nB; ++ui;
    }
    PG8_WAIT_V(0);
    if (wr == 0) PG8_BAR;
    PG8_BAR;
#undef PG8_SA
#undef PG8_SB
#undef PG8_STAGE
#undef PG8_LDA
#undef PG8_LDB
#undef PG8_MMA
#undef PG8_WAIT_V
#undef PG8_WAIT_L
#undef PG8_BAR
#undef PG8_SCHED
#undef PG8_PA
#undef PG8_PB
}

struct EpiF32 {
    static constexpr bool PERM = false;
    float* C; int ldc; int row_base; size_t zstride;
    DEVI void operator()(const f32x4 (&acc)[2][2][4][2], const Unit& u, int wr, int wc, int fr, int fq) const {
        const int row0 = u.pm * BM + wr * 64 + fr - row_base, col0 = u.pn * BM + wc * 32 + 4 * fq;
#pragma unroll
        for (int ai = 0; ai < 2; ++ai)
#pragma unroll
            for (int m = 0; m < 4; ++m) { float* rowp = C + (size_t)u.z * zstride + (size_t)(row0 + ai * HALF + m * 16) * ldc + col0;
#pragma unroll
                for (int bj = 0; bj < 2; ++bj)
#pragma unroll
                    for (int n = 0; n < 2; ++n) *(f32x4*)(rowp + bj * HALF + n * 16) = acc[ai][bj][m][n]; }
    }
};
struct EpiBf16Y {
    static constexpr bool PERM = true;
    bf16_t* O; int ldc;
    DEVI void operator()(const f32x4 (&acc)[2][2][4][2], const Unit& u, int wr, int wc, int fr, int fq) const {
        const int row0 = u.pm * BM + wr * 64 + fr;
#pragma unroll
        for (int bj = 0; bj < 2; ++bj) { const int c0 = u.pn * BM + bj * HALF + wc * 32 + 8 * fq;
#pragma unroll
            for (int ai = 0; ai < 2; ++ai)
#pragma unroll
                for (int m = 0; m < 4; ++m) { float v[8];
#pragma unroll
                    for (int n = 0; n < 2; ++n)
#pragma unroll
                        for (int i = 0; i < 4; ++i) v[n * 4 + i] = acc[ai][bj][m][n][i];
                    *(u32x4*)(O + (size_t)(row0 + ai * HALF + m * 16) * ldc + c0) = pack8(v); } }
    }
};
struct EpiAtomic {
    static constexpr bool PERM = false;
    float* C; int ldc; int row_base;
    DEVI void operator()(const f32x4 (&acc)[2][2][4][2], const Unit& u, int wr, int wc, int fr, int fq) const {
        const int row0 = u.pm * BM + wr * 64 + fr - row_base, col0 = u.pn * BM + wc * 32 + 4 * fq;
#pragma unroll
        for (int ai = 0; ai < 2; ++ai)
#pragma unroll
            for (int m = 0; m < 4; ++m) { float* rowp = C + (size_t)(row0 + ai * HALF + m * 16) * ldc + col0;
#pragma unroll
                for (int bj = 0; bj < 2; ++bj)
#pragma unroll
                    for (int n = 0; n < 2; ++n)
#pragma unroll
                        for (int e = 0; e < 4; ++e) __hip_atomic_fetch_add(rowp + bj * HALF + n * 16 + e, acc[ai][bj][m][n][e], __ATOMIC_RELAXED, __HIP_MEMORY_SCOPE_AGENT); }
    }
};
struct EpiSwiGLU {
    static constexpr bool PERM = false;
    bf16_t* O; int ldc;
    DEVI void operator()(const f32x4 (&acc)[2][2][4][2], const Unit& u, int wr, int wc, int fr, int fq) const {
        const int row0 = u.pm * BM + wr * 64 + fr, col0 = u.pn * 128 + wc * 32 + 8 * fq;
#pragma unroll
        for (int ai = 0; ai < 2; ++ai)
#pragma unroll
            for (int m = 0; m < 4; ++m) {
                float v[8];
#pragma unroll
                for (int bj = 0; bj < 2; ++bj)
#pragma unroll
                    for (int i = 0; i < 4; ++i) { const float gt = acc[ai][bj][m][0][i], up = acc[ai][bj][m][1][i]; v[bj * 4 + i] = silu(gt) * up; }
                *(u32x4*)(O + (size_t)(row0 + ai * HALF + m * 16) * ldc + col0) = pack8(v);
            }
    }
};
struct EpiInProj {
    static constexpr bool PERM = true;
    bf16_t* O; int ldc;
    DEVI void operator()(const f32x4 (&acc)[2][2][4][2], const Unit& u, int wr, int wc, int fr, int fq) const {
        const int row0 = u.pm * BM + wr * 64 + fr;
#pragma unroll
        for (int bj = 0; bj < 2; ++bj) {
            const int c0 = u.pn * BM + bj * HALF + wc * 32 + 8 * fq;
            int kind = 0;
            if (c0 >= C_MLO && c0 < C_MLG) kind = 1; else if (c0 >= C_LRY && c0 < C_DNQ) kind = 2; else if (c0 >= C_DNZ && c0 < C_DNBA) kind = 3; else if (c0 >= C_GATE) kind = 1;
#define INPROJ_STORE(FN) _Pragma("unroll") for (int ai = 0; ai < 2; ++ai) _Pragma("unroll") for (int m = 0; m < 4; ++m) { float v[8]; \
                _Pragma("unroll") for (int n = 0; n < 2; ++n) _Pragma("unroll") for (int i = 0; i < 4; ++i) { const float x = acc[ai][bj][m][n][i]; v[n * 4 + i] = FN; } \
                *(u32x4*)(O + (size_t)(row0 + ai * HALF + m * 16) * ldc + c0) = pack8(v); }
            if (kind == 0) { INPROJ_STORE(x) } else if (kind == 1) { INPROJ_STORE(sigm(x)) } else if (kind == 2) { INPROJ_STORE(gelu_t(x)) } else { INPROJ_STORE(silu(x)) }
#undef INPROJ_STORE
        }
    }
};
struct EpiBranch {
    static constexpr bool PERM = false;
    const bf16_t* P; bf16_t* T; bf16_t* U;
    DEVI void operator()(const f32x4 (&acc)[2][2][4][2], const Unit& u, int wr, int wc, int fr, int fq) const {
        const int row0 = u.pm * BM + wr * 64 + fr, col0 = u.pn * BM + wc * 32 + 4 * fq; const int z = u.z;
        bf16_t* dst = z < 2 ? T : U;
#pragma unroll
        for (int ai = 0; ai < 2; ++ai)
#pragma unroll
            for (int mh = 0; mh < 2; ++mh) {
                u32x2 gr[2][2][2], tv[2][2][2];
#pragma unroll
                for (int mm = 0; mm < 2; ++mm) { const size_t row = (size_t)(row0 + ai * HALF + (mh * 2 + mm) * 16);
#pragma unroll
                    for (int bj = 0; bj < 2; ++bj)
#pragma unroll
                        for (int n = 0; n < 2; ++n) { const int col = col0 + bj * HALF + n * 16;
                            gr[mm][bj][n] = *(const u32x2*)(P + row * DINP + C_GATE + z * D + col);
                            tv[mm][bj][n] = (u32x2){0u, 0u};
                            if (z > 0) tv[mm][bj][n] = *(const u32x2*)(T + row * D + col); } }
#pragma unroll
                for (int mm = 0; mm < 2; ++mm) { const size_t row = (size_t)(row0 + ai * HALF + (mh * 2 + mm) * 16);
#pragma unroll
                    for (int bj = 0; bj < 2; ++bj)
#pragma unroll
                        for (int n = 0; n < 2; ++n) { const int col = col0 + bj * HALF + n * 16;
                            const u32x2 g2 = gr[mm][bj][n], t2 = tv[mm][bj][n]; f32x4 a = acc[ai][bj][mh * 2 + mm][n];
                            a[0] = a[0] * __uint_as_float(g2[0] << 16) + __uint_as_float(t2[0] << 16); a[1] = a[1] * __uint_as_float(g2[0] & 0xffff0000u) + __uint_as_float(t2[0] & 0xffff0000u);
                            a[2] = a[2] * __uint_as_float(g2[1] << 16) + __uint_as_float(t2[1] << 16); a[3] = a[3] * __uint_as_float(g2[1] & 0xffff0000u) + __uint_as_float(t2[1] & 0xffff0000u);
                            u32x2 w; w[0] = pk2(a[0], a[1]); w[1] = pk2(a[2], a[3]); *(u32x2*)(dst + row * D + col) = w; } }
            }
    }
};
struct EpiBranchPart {
    static constexpr bool PERM = false;
    const bf16_t* P; float* PART;
    DEVI void operator()(const f32x4 (&acc)[2][2][4][2], const Unit& u, int wr, int wc, int fr, int fq) const {
        const int row0 = u.pm * BM + wr * 64 + fr, col0 = u.pn * BM + wc * 32 + 4 * fq; const int z = u.z;
#pragma unroll
        for (int ai = 0; ai < 2; ++ai)
#pragma unroll
            for (int mh = 0; mh < 2; ++mh) {
                u32x2 gr[2][2][2];
#pragma unroll
                for (int mm = 0; mm < 2; ++mm) { const size_t row = (size_t)(row0 + ai * HALF + (mh * 2 + mm) * 16);
#pragma unroll
                    for (int bj = 0; bj < 2; ++bj)
#pragma unroll
                        for (int n = 0; n < 2; ++n) gr[mm][bj][n] = *(const u32x2*)(P + row * DINP + C_GATE + z * D + col0 + bj * HALF + n * 16); }
#pragma unroll
                for (int mm = 0; mm < 2; ++mm) { const size_t row = (size_t)(row0 + ai * HALF + (mh * 2 + mm) * 16);
#pragma unroll
                    for (int bj = 0; bj < 2; ++bj)
#pragma unroll
                        for (int n = 0; n < 2; ++n) { const int col = col0 + bj * HALF + n * 16;
                            const u32x2 g2 = gr[mm][bj][n]; f32x4 a = acc[ai][bj][mh * 2 + mm][n];
                            a[0] *= __uint_as_float(g2[0] << 16); a[1] *= __uint_as_float(g2[0] & 0xffff0000u); a[2] *= __uint_as_float(g2[1] << 16); a[3] *= __uint_as_float(g2[1] & 0xffff0000u);
                            *(f32x4*)(PART + ((size_t)z * 1024 + (row - MLAT)) * D + col) = a; } }
            }
    }
};
}

DEVI int tok_row(bool gdn, int dir, int b, int c, int t) {
    if (c < 4) { int p = c * 64 + t; if (dir) p = 255 - p; return MLAT + b * 256 + p; }
    int p = (c - 4) * 64 + t; if (dir) p = 4095 - p;
    const int s = gdn ? ((p & 63) * 64 + (p >> 6)) : p;
    return b * 4096 + s;
}
DEVI int pos_row(bool gdn, int b, bool isctx, int p) {
    if (isctx) { if (p < 0 || p >= 256) return -1; return MLAT + b * 256 + p; }
    if (p < 0 || p >= 4096) return -1;
    const int s = gdn ? ((p & 63) * 64 + (p >> 6)) : p;
    return b * 4096 + s;
}
DEVI int dir_chunk(int dir, int j) { return dir ? (j < 4 ? 3 - j : 71 - j) : j; }

DEVI int gu_rowmap(int s) {
    const int n = s >= DFF ? 1 : 0, a = s - n * DFF, pn = a >> 7, r = a & 127, wc = r >> 5, fq = (r >> 3) & 3, bj = (r >> 2) & 1, i = r & 3;
    return 256 * pn + 128 * bj + 32 * wc + 16 * n + 4 * fq + i;
}
DEVI void cvt_tile(const float* src, int ldsrc, int Nvalid, int k0, int n0, bf16_t* dst, int lddst, int mode, float* buf, int lane) {
    f32x4 vv[16];
#pragma unroll
    for (int it = 0; it < 16; ++it) {
        const int row = it * 4 + (lane >> 4), c4 = (lane & 15) * 4;
        vv[it] = (f32x4){0.f, 0.f, 0.f, 0.f};
        if (n0 + c4 < Nvalid) vv[it] = *(const f32x4*)(src + (size_t)(k0 + row) * ldsrc + n0 + c4);
    }
#pragma unroll
    for (int it = 0; it < 16; ++it) {
        const int row = it * 4 + (lane >> 4), c4 = (lane & 15) * 4;
        float* bp = buf + row * 65 + c4; bp[0] = vv[it][0]; bp[1] = vv[it][1]; bp[2] = vv[it][2]; bp[3] = vv[it][3];
    }
    asm volatile("s_waitcnt lgkmcnt(0)" ::: "memory"); __builtin_amdgcn_wave_barrier();
#pragma unroll 2
    for (int it = 0; it < 8; ++it) {
        const int nc = it * 8 + (lane >> 3), kk = (lane & 7) * 8;
        float f[8];
#pragma unroll
        for (int e = 0; e < 8; ++e) f[e] = buf[(kk + e) * 65 + nc];
        const int drow = mode == 1 ? gu_rowmap(n0 + nc) : (n0 + nc);
        *(u32x4*)(dst + (size_t)drow * lddst + k0 + kk) = pack8(f);
    }
    asm volatile("s_waitcnt lgkmcnt(0)" ::: "memory"); __builtin_amdgcn_wave_barrier();
}
DEVI void convert_phase(const PW& pw0, int l, unsigned char* shm_in, int gwave, int nwaves, int wid, int lane) {
    const PW p{opq64(pw0.ws)};
    unsigned char* shm = opq(shm_in);
    float* buf = (float*)shm + wid * (64 * 65);
    unsigned char* ws = p.ws;
    for (int t = gwave; t < 6880; t += nwaves) {
        int r = t;
        if (r < 2816) { const int f = r / 1408; r -= f * 1408; const int kt = r / 88, ntl = r % 88;
            cvt_tile(pin(7) + ((size_t)(l * 2 + f)) * D * 2 * DFF, 2 * DFF, 2 * DFF, kt * 64, ntl * 64, (bf16_t*)(ws + WS_WGU + f * SZ_WGU), D, 1, buf, lane); continue; }
        r -= 2816;
        if (r < 1408) { const int f = r / 704; r -= f * 704; const int kt = r / 16, ntl = r % 16;
            cvt_tile(pin(8) + ((size_t)(l * 2 + f)) * DFF * D, D, D, kt * 64, ntl * 64, (bf16_t*)(ws + WS_WDN + f * SZ_WDN), DFF, 0, buf, lane); continue; }
        r -= 1408;
        if (r < 1984) { const int kt = r / 124, ntl = r % 124;
            cvt_tile(pin(9) + (size_t)l * D * C_END, C_END, C_END, kt * 64, ntl * 64, (bf16_t*)(ws + WS_WIN), D, 0, buf, lane); continue; }
        r -= 1984;
        if (r < 384) { const int n = r / 128; r -= n * 128; const int kt = r / 16, ntl = r % 16;
            cvt_tile(pin(23) + ((size_t)(l * 3 + n)) * 512 * D, D, D, kt * 64, ntl * 64, (bf16_t*)(ws + WS_WBR) + (size_t)n * D * 512, 512, 0, buf, lane); continue; }
        r -= 384;
        if (r < 256) { const int kt = r / 16, ntl = r % 16;
            cvt_tile(pin(24) + (size_t)l * D * D, D, D, kt * 64, ntl * 64, (bf16_t*)(ws + WS_WOUT), D, 0, buf, lane); continue; }
        r -= 256;
        { const int gate = r >> 4, dn = r & 15;
            cvt_tile(pin(gate ? 16 : 14) + ((size_t)l * 16 + dn) * 4096, 64, 64, 0, 0, (bf16_t*)(ws + WS_WLRU) + (size_t)(gate * 16 + dn) * 4096, 64, 0, buf, lane); }
    }
}

DEVI void mod_phase(const PW& pw0, unsigned char* shm_in, int wv) {
    const PW p{opq64(pw0.ws)};
    unsigned char* shm = opq(shm_in);
    float* sC = (float*)shm;
    float* red = sC + 5 * 1024;
    const int tid = MYTID;
    __syncthreads();
    for (int i = tid; i < 5 * 1024; i += 512) { const int v = i >> 10, k = i & 1023; const float x = v < 4 ? pin(1)[v * 1024 + k] : pin(3)[k]; sC[i] = silu(x); }
    __syncthreads();
    float* MOD = (float*)(p.ws + WS_MOD);
    const int cgp = tid & 15, is = tid >> 4;
    for (int task = blockIdx.x; task < DEPTH * 144; task += gridDim.x) {
        const int l = task / 144, col0 = (task % 144) * 64;
        float acc[5][4];
#pragma unroll
        for (int v = 0; v < 5; ++v)
#pragma unroll
            for (int e = 0; e < 4; ++e) acc[v][e] = 0.f;
        const float* wp = pin(4) + ((size_t)l * 1024 + is * 32) * 9216 + col0 + cgp * 4;
#pragma unroll 16
        for (int r = 0; r < 32; ++r) {
            const f32x4 w = *(const f32x4*)(wp + (size_t)r * 9216);
#pragma unroll
            for (int v = 0; v < 5; ++v) { const float s = sC[v * 1024 + is * 32 + r];
#pragma unroll
                for (int e = 0; e < 4; ++e) acc[v][e] += s * w[e]; }
        }
#pragma unroll
        for (int v = 0; v < 5; ++v)
#pragma unroll
            for (int e = 0; e < 4; ++e) red[tid * 20 + v * 4 + e] = acc[v][e];
        __syncthreads();
        if (tid < 320) { const int v = tid >> 6, c = tid & 63; float s = 0.f;
            for (int k = 0; k < 32; ++k) s += red[(k * 16 + (c >> 2)) * 20 + v * 4 + (c & 3)];
            MOD[((size_t)(l * 5 + v)) * 9216 + col0 + c] = s + pin(5)[(size_t)l * 9216 + col0 + c]; }
        __syncthreads();
    }
}

DEVI void rowwise_phase(const PW& pw0, int mode, int nrows, int l, int kgate, float coef, int gpost_i, int ln, int gpre_i, int kshift, int nzc, int gwave, int nwaves, int lane, int dry = 0) {
    const PW p{opq64(pw0.ws)};
      bf16_t* X = (bf16_t*)(p.ws + WS_X); bf16_t* Xw = dry ? (bf16_t*)(p.ws + WS_GN) : X; const float* Y0 = (const float*)(p.ws + WS_Y); const float* YC = (const float*)(p.ws + WS_GB); bf16_t* H = dry ? (bf16_t*)(p.ws + WS_GU) : (bf16_t*)(p.ws + WS_H);
    const float* MOD = (const float*)(p.ws + WS_MOD);
    const int co = lane * 4;
    u32x2 yq[4]; u32x2 xq[4];
#pragma unroll
    for (int i = 0; i < 4; ++i) { yq[i] = (u32x2){0u, 0u}; xq[i] = (u32x2){0u, 0u}; }
    if (mode != 0 && gwave < nrows && gwave < MLAT) {
#pragma unroll
        for (int i = 0; i < 4; ++i) { yq[i] = *(const u32x2*)((const bf16_t*)Y0 + (size_t)gwave * D + co + 256 * i); xq[i] = *(const u32x2*)(X + (size_t)gwave * D + co + 256 * i); }
    }
    for (int row = gwave; row < nrows; row += nwaves) {
        const int v = row < MLAT ? (row >> 12) : 4;
        f32x4 x[4], y[4];
        f32x4 pg[4], pm[4], qg[4], qa[4], qs[4];
        if (mode == 0) {
            const float* src = row < MLAT ? pin(0) + (size_t)row * D : pin(2) + (size_t)(row - MLAT) * D;
#pragma unroll
            for (int i = 0; i < 4; ++i) x[i] = *(const f32x4*)(src + co + 256 * i);
        {
            const float* gp = pin(6) + ((size_t)l * 6 + gpost_i) * D; const float* gt = MOD + ((size_t)(l * 5 + v) * 9 + kgate) * D;
            const float* gq = pin(6) + ((size_t)ln * 6 + gpre_i) * D; const float* sh = MOD + ((size_t)(ln * 5 + v) * 9 + kshift) * D; const float* sc = sh + D;
#pragma unroll
            for (int i = 0; i < 4; ++i) { pg[i] = *(const f32x4*)(gp + co + 256 * i); pm[i] = *(const f32x4*)(gt + co + 256 * i);
                qg[i] = *(const f32x4*)(gq + co + 256 * i); qa[i] = *(const f32x4*)(sh + co + 256 * i); qs[i] = *(const f32x4*)(sc + co + 256 * i); }
        }
        } else {
            if (row >= MLAT) {
                const float* Y = YC + (size_t)(row - MLAT) * D;
#pragma unroll
                for (int ih = 0; ih < 2; ++ih) {
                    f32x4 t[11][2];
#pragma unroll
                    for (int z = 0; z < 11; ++z)
#pragma unroll
                        for (int i2 = 0; i2 < 2; ++i2) t[z][i2] = z < nzc ? *(const f32x4*)(Y + (size_t)z * 1024 * D + co + 256 * (ih * 2 + i2)) : (f32x4){0.f, 0.f, 0.f, 0.f};
#pragma unroll
                    for (int i2 = 0; i2 < 2; ++i2) { f32x4 a = t[0][i2];
#pragma unroll
                        for (int z = 1; z < 11; ++z) a = a + t[z][i2];
                        y[ih * 2 + i2] = a; }
                }
#pragma unroll
                for (int i = 0; i < 4; ++i) { const u32x2 r3 = *(const u32x2*)(X + (size_t)row * D + co + 256 * i); x[i] = (f32x4){__uint_as_float(r3[0] << 16), __uint_as_float(r3[0] & 0xffff0000u), __uint_as_float(r3[1] << 16), __uint_as_float(r3[1] & 0xffff0000u)}; }
            } else {
#pragma unroll
                for (int i = 0; i < 4; ++i) { const u32x2 r2 = yq[i]; { const u32x2 r3 = xq[i]; x[i] = (f32x4){__uint_as_float(r3[0] << 16), __uint_as_float(r3[0] & 0xffff0000u), __uint_as_float(r3[1] << 16), __uint_as_float(r3[1] & 0xffff0000u)}; }
                    y[i] = (f32x4){__uint_as_float(r2[0] << 16), __uint_as_float(r2[0] & 0xffff0000u), __uint_as_float(r2[1] << 16), __uint_as_float(r2[1] & 0xffff0000u)}; }
            }
        {
            const float* gp = pin(6) + ((size_t)l * 6 + gpost_i) * D; const float* gt = MOD + ((size_t)(l * 5 + v) * 9 + kgate) * D;
            const float* gq = pin(6) + ((size_t)ln * 6 + gpre_i) * D; const float* sh = MOD + ((size_t)(ln * 5 + v) * 9 + kshift) * D; const float* sc = sh + D;
#pragma unroll
            for (int i = 0; i < 4; ++i) { pg[i] = *(const f32x4*)(gp + co + 256 * i); pm[i] = *(const f32x4*)(gt + co + 256 * i);
                qg[i] = *(const f32x4*)(gq + co + 256 * i); qa[i] = *(const f32x4*)(sh + co + 256 * i); qs[i] = *(const f32x4*)(sc + co + 256 * i); }
        }
            const int nxt = row + nwaves;
            if (nxt < nrows && nxt < MLAT) {
#pragma unroll
                for (int i = 0; i < 4; ++i) { yq[i] = *(const u32x2*)((const bf16_t*)Y0 + (size_t)nxt * D + co + 256 * i); xq[i] = *(const u32x2*)(X + (size_t)nxt * D + co + 256 * i); }
            }
            float ss = 0.f;
#pragma unroll
            for (int i = 0; i < 4; ++i) ss += y[i][0] * y[i][0] + y[i][1] * y[i][1] + y[i][2] * y[i][2] + y[i][3] * y[i][3];
            ss = wsum(ss); const float rs = rsqrtf(ss * (1.f / D) + EPS) * coef;
#pragma unroll
            for (int i = 0; i < 4; ++i) x[i] = x[i] + pm[i] * (y[i] * rs * pg[i]);
        }
        if (mode == 2) {
#pragma unroll
            for (int i = 0; i < 4; ++i) *(f32x4*)((float*)pin(25) + (size_t)row * D + co + 256 * i) = x[i];
            continue;
        }
#pragma unroll
        for (int i = 0; i < 4; ++i) { u32x2 w; w[0] = pk2(x[i][0], x[i][1]); w[1] = pk2(x[i][2], x[i][3]); *(u32x2*)(Xw + (size_t)row * D + co + 256 * i) = w; }
        float ss = 0.f;
#pragma unroll
        for (int i = 0; i < 4; ++i) ss += x[i][0] * x[i][0] + x[i][1] * x[i][1] + x[i][2] * x[i][2] + x[i][3] * x[i][3];
        ss = wsum(ss); const float rs = rsqrtf(ss * (1.f / D) + EPS);
#pragma unroll
        for (int i = 0; i < 4; ++i) { const f32x4 h = x[i] * rs * qg[i] * (qs[i] + 1.f) + qa[i]; u32x2 w; w[0] = pk2(h[0], h[1]); w[1] = pk2(h[2], h[3]);
            *(u32x2*)(H + (size_t)row * D + co + 256 * i) = w; }
    }
}

DEVI void gdn_load(const bf16_t* P, const float* convw, int b, int c, int h, int dir, int want, bf16_t* sQ, bf16_t* sK, bf16_t* sKT, bf16_t* sVT, int tid) {
    const bool isctx = c < 4;
#pragma unroll
    for (int r = 0; r < 6; ++r) {
        const int task = tid + 512 * r, seg = r >> 1, rem = task & 1023, t = rem >> 4, cgp = rem & 15;
        if (seg == 0 && !(want & 1)) continue;
        if (seg == 1 && !(want & 6)) continue;
        if (seg == 2 && !(want & 8)) continue;
        int p = (isctx ? c : c - 4) * 64 + t; if (dir) p = (isctx ? 255 : 4095) - p;
        const int ch = seg * 512 + h * 128 + cgp * 8;
        float a[8];
#pragma unroll
        for (int e = 0; e < 8; ++e) a[e] = 0.f;
#pragma unroll
        for (int j = 0; j < 4; ++j) {
            const int row = pos_row(true, b, isctx, p + j - 2);
            if (row >= 0) {
                const u32x4 raw = *(const u32x4*)(P + (size_t)row * DINP + C_DNQ + ch); float x[8]; unpack8(raw, x);
                const f32x4 w0 = *(const f32x4*)(convw + j * 1536 + ch), w1 = *(const f32x4*)(convw + j * 1536 + ch + 4);
                a[0] += w0[0] * x[0]; a[1] += w0[1] * x[1]; a[2] += w0[2] * x[2]; a[3] += w0[3] * x[3];
                a[4] += w1[0] * x[4]; a[5] += w1[1] * x[5]; a[6] += w1[2] * x[6]; a[7] += w1[3] * x[7];
            }
        }
        float ss = 0.f;
#pragma unroll
        for (int e = 0; e < 8; ++e) { a[e] = silu(a[e]); ss += a[e] * a[e]; }
        if (seg < 2) {
            ss += __shfl_xor(ss, 1, 64); ss += __shfl_xor(ss, 2, 64); ss += __shfl_xor(ss, 4, 64); ss += __shfl_xor(ss, 8, 64);
            float inv = rsqrtf(ss + EPS); if (seg == 0) inv *= 0.08838834764831845f;
#pragma unroll
            for (int e = 0; e < 8; ++e) a[e] *= inv;
        }
        if (seg == 0) *(u32x4*)(sQ + t * 136 + cgp * 8) = pack8(a);
        else if (seg == 1) {
            if (want & 2) *(u32x4*)(sK + t * 136 + cgp * 8) = pack8(a);
            if (want & 4) {
#pragma unroll
                for (int e = 0; e < 8; ++e) sKT[tix(cgp * 8 + e, t)] = (bf16_t)f2bf(a[e]); }
        } else {
#pragma unroll
            for (int e = 0; e < 8; ++e) sVT[tix(cgp * 8 + e, t)] = (bf16_t)f2bf(a[e]);
        }
    }
}
struct GdnRaw { u32x4 r[4][4]; float g; };
DEVI void gdn_ld_issue(const bf16_t* P, const float* gates, int b, int c, int h, int dir, int seg_lo, GdnRaw& R, int tid) {
    const bool isctx = c < 4;
#pragma unroll
    for (int tk = 0; tk < 4; ++tk) {
        const int r = seg_lo * 2 + tk, task = tid + 512 * r, seg = r >> 1, rem = task & 1023, t = rem >> 4, cgp = rem & 15;
        int p = (isctx ? c : c - 4) * 64 + t; if (dir) p = (isctx ? 255 : 4095) - p;
        const int ch = seg * 512 + h * 128 + cgp * 8;
#pragma unroll
        for (int j = 0; j < 4; ++j) { const int row = pos_row(true, b, isctx, p + j - 2); R.r[tk][j] = (u32x4){0u, 0u, 0u, 0u};
            if (row >= 0) R.r[tk][j] = *(const u32x4*)(P + (size_t)row * DINP + C_DNQ + ch); }
    }
    R.g = 0.f; if (tid < 257) R.g = gates[tid];
}
DEVI void gdn_ld_finish(const GdnRaw& R, const float* convw, int h, int seg_lo, int want, bf16_t* sQ, bf16_t* sK, bf16_t* sKT, bf16_t* sVT, float* sc, int tid) {
#pragma unroll
    for (int tk = 0; tk < 4; ++tk) {
        const int r = seg_lo * 2 + tk, task = tid + 512 * r, seg = r >> 1, rem = task & 1023, t = rem >> 4, cgp = rem & 15;
        const int ch = seg * 512 + h * 128 + cgp * 8;
        float a[8];
#pragma unroll
        for (int e = 0; e < 8; ++e) a[e] = 0.f;
#pragma unroll
        for (int j = 0; j < 4; ++j) {
            float x[8]; unpack8(R.r[tk][j], x);
            const f32x4 w0 = *(const f32x4*)(convw + j * 1536 + ch), w1 = *(const f32x4*)(convw + j * 1536 + ch + 4);
            a[0] += w0[0] * x[0]; a[1] += w0[1] * x[1]; a[2] += w0[2] * x[2]; a[3] += w0[3] * x[3];
            a[4] += w1[0] * x[4]; a[5] += w1[1] * x[5]; a[6] += w1[2] * x[6]; a[7] += w1[3] * x[7];
        }
        float ss = 0.f;
#pragma unroll
        for (int e = 0; e < 8; ++e) { a[e] = silu(a[e]); ss += a[e] * a[e]; }
        if (seg < 2) {
            ss += __shfl_xor(ss, 1, 64); ss += __shfl_xor(ss, 2, 64); ss += __shfl_xor(ss, 4, 64); ss += __shfl_xor(ss, 8, 64);
            float inv = rsqrtf(ss + EPS); if (seg == 0) inv *= 0.08838834764831845f;
#pragma unroll
            for (int e = 0; e < 8; ++e) a[e] *= inv;
        }
        if (seg == 0) *(u32x4*)(sQ + t * 136 + cgp * 8) = pack8(a);
        else if (seg == 1) {
            if (want & 2) *(u32x4*)(sK + t * 136 + cgp * 8) = pack8(a);
            if (want & 4) {
#pragma unroll
                for (int e = 0; e < 8; ++e) sKT[tix(cgp * 8 + e, t)] = (bf16_t)f2bf(a[e]); }
        } else {
#pragma unroll
            for (int e = 0; e < 8; ++e) sVT[tix(cgp * 8 + e, t)] = (bf16_t)f2bf(a[e]);
        }
    }
    if (tid < 257) sc[tid] = R.g;
}
DEVI void gdn_gates(const PW& p, const bf16_t* P, int l, int b, int c, int h, int dir, float* sc, int lane) {
    const int row = tok_row(true, dir, b, c, lane);
    const float bb = bf2f(P[(size_t)row * DINP + C_DNBA + dir * 4 + h]), aa = bf2f(P[(size_t)row * DINP + C_DNBA + 8 + dir * 4 + h]);
    const float beta = sigm(bb);
    const float g = -__expf(pin(20)[l * 8 + dir * 4 + h]) * softplus(aa + pin(21)[l * 8 + dir * 4 + h]);
    float G = g;
#pragma unroll
    for (int o = 1; o < 64; o <<= 1) { const float t = __shfl_up(G, o, 64); if (lane >= o) G += t; }
    const float GT = __shfl(G, 63, 64);
    sc[lane] = G; sc[64 + lane] = beta; sc[128 + lane] = __expf(G); sc[192 + lane] = __expf(GT - G); if (lane == 0) sc[256] = __expf(GT);
}

DEVI void gdn_prep_all(const PW& pw0, int l, int first, int G, unsigned char* shm_in, int wv) {
    GdnRaw R;
    if (first < 2176) { const PW p{opq64(pw0.ws)}; const int tid = MYTID; const int c = first % NCH, h = (first / NCH) & 3, b = (first / (NCH * 4)) & 3, dir = first / (NCH * 16);
        gdn_ld_issue((const bf16_t*)(p.ws + WS_P), (const float*)(p.ws + WS_GATES) + (size_t)first * 320, b, c, h, dir, 1, R, tid); }
#pragma unroll 1
    for (int item = first; item < 2176; item += G) {
    const PW p{opq64(pw0.ws)};
    unsigned char* shm = opq(shm_in);
    const int tid = MYTID, wid = __builtin_amdgcn_readfirstlane(tid >> 6), lane = tid & 63, fr = lane & 15, fq = lane >> 4;
    const bf16_t* P = (const bf16_t*)(p.ws + WS_P);
    const float* GATES = (const float*)(p.ws + WS_GATES);
    const int h = (item / NCH) & 3;
    bf16_t* sK = (bf16_t*)shm;
    bf16_t* sKT = (bf16_t*)(shm + 17408);
    bf16_t* sVT = (bf16_t*)(shm + 35840);
    float* sTm = (float*)(shm + 54272);
    bf16_t* sT1 = (bf16_t*)(shm + 71680);
    bf16_t* sT2 = (bf16_t*)(shm + 80896);
    bf16_t* sWT = (bf16_t*)(shm + 90112);
    bf16_t* sUT = (bf16_t*)(shm + 108544);
    float* sc = (float*)(shm + 126976);
    gdn_ld_finish(R, pin(19) + (size_t)l * 4 * 1536, h, 1, 2 | 4 | 8, nullptr, sK, sKT, sVT, sc, tid);
    __builtin_amdgcn_sched_barrier(0);
    { const int nxt = item + G; if (nxt < 2176) { const int c2 = nxt % NCH, h2 = (nxt / NCH) & 3, b2 = (nxt / (NCH * 4)) & 3, dir2 = nxt / (NCH * 16); gdn_ld_issue(P, GATES + (size_t)nxt * 320, b2, c2, h2, dir2, 1, R, opaque(tid)); } }
    __builtin_amdgcn_sched_barrier(0);
    lbar();
#pragma unroll
    for (int ti = 0; ti < 2; ++ti) {
        const int tile = wid * 2 + ti, mt = tile >> 2, nt = tile & 3;
        f32x4 acc = (f32x4){0.f, 0.f, 0.f, 0.f};
#pragma unroll
        for (int kk = 0; kk < 4; ++kk) acc = MFMA16(ldfrag(sK, 136, mt * 16, kk * 32, lane), ldfrag(sK, 136, nt * 16, kk * 32, lane), acc);
        const int s = nt * 16 + fr;
#pragma unroll
        for (int j = 0; j < 4; ++j) { const int t = mt * 16 + fq * 4 + j; sTm[t * 68 + s] = s < t ? sc[64 + t] * acc[j] * __expf(sc[t] - sc[s]) : 0.f; }
    }
    lbar();
    float* tmpY = (float*)sWT;
    if (wid < 4) {
        const int o = wid * 16, c = lane & 15;
        int lz; asm volatile("v_mov_b32 %0, 0" : "=v"(lz));
        const float* tm = sTm + lz;
        float x[16];
#pragma unroll
        for (int t = 0; t < 16; ++t) {
            float v = -sTm[(o + t) * 68 + o + c];
#pragma unroll
            for (int s4 = 0; s4 < (t + 3) / 4; ++s4) {
                const f32x4 a = *(const f32x4*)(tm + (o + t) * 68 + o + s4 * 4);
#pragma unroll
                for (int e = 0; e < 4; ++e) if (s4 * 4 + e < t) v -= a[e] * x[s4 * 4 + e];
            }
            x[t] = v;
        }
        asm volatile("s_waitcnt lgkmcnt(0)" ::: "memory");
        if (lane < 16) {
#pragma unroll
            for (int t = 0; t < 16; ++t) sTm[(o + t) * 68 + o + c] = x[t] + (t == c ? 1.f : 0.f);
        }
    }
    lbar();
    {
        const int blk = tid >> 8, r = (tid >> 4) & 15, c = tid & 15, ib = (blk ? 3 : 1) * 16, jb = ib - 16;
        float y = 0.f;
#pragma unroll
        for (int s2 = 0; s2 < 16; ++s2) y += sTm[(ib + r) * 68 + jb + s2] * sTm[(jb + s2) * 68 + jb + c];
        tmpY[blk * 272 + r * 17 + c] = y;
        lbar();
        float z = 0.f;
#pragma unroll
        for (int s2 = 0; s2 < 16; ++s2) z += sTm[(ib + r) * 68 + ib + s2] * tmpY[blk * 272 + s2 * 17 + c];
        lbar();
        sTm[(ib + r) * 68 + jb + c] = -z;
    }
    lbar();
    {
        float y[2];
#pragma unroll
        for (int u = 0; u < 2; ++u) { const int o = tid + 512 * u, r = o >> 5, c = o & 31; float a = 0.f;
#pragma unroll 8
            for (int s2 = 0; s2 < 32; ++s2) a += sTm[(32 + r) * 68 + s2] * sTm[s2 * 68 + c];
            y[u] = a; }
#pragma unroll
        for (int u = 0; u < 2; ++u) { const int o = tid + 512 * u, r = o >> 5, c = o & 31; tmpY[r * 33 + c] = y[u]; }
        lbar();
#pragma unroll
        for (int u = 0; u < 2; ++u) { const int o = tid + 512 * u, r = o >> 5, c = o & 31; float a = 0.f;
#pragma unroll 8
            for (int s2 = 0; s2 < 32; ++s2) a += sTm[(32 + r) * 68 + 32 + s2] * tmpY[s2 * 33 + c];
            y[u] = a; }
#pragma unroll
        for (int u = 0; u < 2; ++u) { const int o = tid + 512 * u, r = o >> 5, c = o & 31; sTm[(32 + r) * 68 + c] = -y[u]; }
    }
    lbar();
#pragma unroll
    for (int u = 0; u < 8; ++u) {
        const int o = tid + 512 * u, t = o >> 6, s2 = o & 63; const float xv = sTm[t * 68 + s2], bt = sc[64 + s2];
        sT1[t * 72 + s2] = (bf16_t)f2bf(xv * bt * sc[128 + s2]); sT2[t * 72 + s2] = (bf16_t)f2bf(xv * bt);
    }
    lbar();
    bf16_t* GW = (bf16_t*)(p.ws + WS_H) + (size_t)item * 64 * 128;
    bf16_t* GU = (bf16_t*)(p.ws + WS_GU) + (size_t)item * 64 * 128;
    {
        const int tid2 = opaque(tid), lane = tid2 & 63, fr = lane & 15, fq = lane >> 4;
        const int mt = wid;
#pragma unroll
        for (int nt = 0; nt < 4; ++nt) {
            f32x4 aw = (f32x4){0.f, 0.f, 0.f, 0.f}, au = aw;
#pragma unroll
            for (int kk = 0; kk < 2; ++kk) { aw = MFMA16(ldfragT(sKT, mt * 16, kk * 32, lane), ldfrag(sT1, 72, nt * 16, kk * 32, lane), aw);
                au = MFMA16(ldfragT(sVT, mt * 16, kk * 32, lane), ldfrag(sT2, 72, nt * 16, kk * 32, lane), au); }
            const int t = nt * 16 + fr, r0 = mt * 16 + fq * 4; const float dec = sc[192 + t];
            u32x2 w; w[0] = pk2(aw[0], aw[1]); w[1] = pk2(aw[2], aw[3]); *(u32x2*)(GW + t * 128 + r0) = w;
            w[0] = pk2(au[0], au[1]); w[1] = pk2(au[2], au[3]); *(u32x2*)(GU + t * 128 + r0) = w;
#pragma unroll
            for (int j = 0; j < 4; ++j) { sWT[tix(r0 + j, t)] = (bf16_t)f2bf(aw[j] * dec); sUT[tix(r0 + j, t)] = (bf16_t)f2bf(au[j] * dec); }
        }
    }
    lbar();
    bf16_t* GB = (bf16_t*)(p.ws + WS_GB) + (size_t)item * 128 * 128;
    bf16_t* GN = (bf16_t*)(p.ws + WS_GN) + (size_t)item * 128 * 128;
    {
        const int tid2 = opaque(tid), lane = tid2 & 63, fr = lane & 15, fq = lane >> 4;
        const int mt = wid;
#pragma unroll
        for (int nt = 0; nt < 8; ++nt) {
            f32x4 ab = (f32x4){0.f, 0.f, 0.f, 0.f}, an = ab;
#pragma unroll
            for (int kk = 0; kk < 2; ++kk) { ab = MFMA16(ldfragT(sWT, mt * 16, kk * 32, lane), ldfragT(sKT, nt * 16, kk * 32, lane), ab);
                an = MFMA16(ldfragT(sKT, mt * 16, kk * 32, lane), ldfragT(sUT, nt * 16, kk * 32, lane), an); }
            const int cc = nt * 16 + fr, r0 = mt * 16 + fq * 4;
            u32x2 w; w[0] = pk2(-ab[0], -ab[1]); w[1] = pk2(-ab[2], -ab[3]); *(u32x2*)(GB + cc * 128 + r0) = w;
            w[0] = pk2(an[0], an[1]); w[1] = pk2(an[2], an[3]); *(u32x2*)(GN + cc * 128 + r0) = w;
        }
    }
    if (tid == 0) ((float*)(p.ws + WS_SM + SM_GDEC))[item] = sc[256];
    lbar();
    }
}

DEVI void gdn_seq_unit(const PW& pw0, int unit, unsigned char* shm_in, int wv) {
    const PW p{opq64(pw0.ws)};
    unsigned char* shm = opq(shm_in);
    const int tid = MYTID, wid = __builtin_amdgcn_readfirstlane(tid >> 6), lane = tid & 63, fr = lane & 15, fq = lane >> 4;
    const int chain = unit >> 3, es = unit & 7;
    bf16_t* sS = (bf16_t*)shm;
    const bf16_t* GB = (const bf16_t*)(p.ws + WS_GB) + (size_t)chain * NCH * 16384;
    bf16_t* GN = (bf16_t*)(p.ws + WS_GN) + (size_t)chain * NCH * 16384;
    const float* GDEC = (const float*)(p.ws + WS_SM + SM_GDEC) + chain * NCH;
    f32x4 acc = (f32x4){0.f, 0.f, 0.f, 0.f};
    constexpr int PF = 4;
    bf16x8 an[PF][4]; u32x2 nn[PF]; float dn[PF];
    const size_t aoff = (size_t)(wid * 16 + fr) * 128 + fq * 8, noff = (size_t)(es * 16 + fr) * 128 + wid * 16 + fq * 4;
#pragma unroll
    for (int u = 0; u < PF; ++u) {
#pragma unroll
        for (int kk = 0; kk < 4; ++kk) an[u][kk] = *(const bf16x8*)(GB + (size_t)u * 16384 + aoff + kk * 32);
        nn[u] = *(const u32x2*)(GN + (size_t)u * 16384 + noff); dn[u] = GDEC[u];
    }
#pragma unroll 1
    for (int c0 = 0; c0 < NCH; c0 += PF) {
#pragma unroll
        for (int u = 0; u < PF; ++u) {
            const int c = c0 + u;
            bf16x8 a[4]; const u32x2 ncur = nn[u]; const float dcur = dn[u];
#pragma unroll
            for (int kk = 0; kk < 4; ++kk) a[kk] = an[u][kk];
            u32x2 sw; sw[0] = pk2(acc[0], acc[1]); sw[1] = pk2(acc[2], acc[3]);
            bf16_t* sb = sS + (c & 1) * (16 * 136);
            *(u32x2*)(sb + fr * 136 + wid * 16 + fq * 4) = sw;
            *(u32x2*)(GN + (size_t)c * 16384 + noff) = sw;
            if (c + PF < NCH) {
#pragma unroll
                for (int kk = 0; kk < 4; ++kk) an[u][kk] = *(const bf16x8*)(GB + (size_t)(c + PF) * 16384 + aoff + kk * 32);
                nn[u] = *(const u32x2*)(GN + (size_t)(c + PF) * 16384 + noff); dn[u] = GDEC[c + PF];
            }
            lbar();
            acc[0] = dcur * acc[0] + __uint_as_float(ncur[0] << 16); acc[1] = dcur * acc[1] + __uint_as_float(ncur[0] & 0xffff0000u);
            acc[2] = dcur * acc[2] + __uint_as_float(ncur[1] << 16); acc[3] = dcur * acc[3] + __uint_as_float(ncur[1] & 0xffff0000u);
#pragma unroll
            for (int kk = 0; kk < 4; ++kk) acc = MFMA16(a[kk], ldfrag(sb, 136, 0, kk * 32, lane), acc);
        }
    }
    lbar();
}

struct GdnOutRaw { GdnRaw L; u32x4 st[4]; u32x4 w[2]; u32x2 ur[4]; };
DEVI void gdn_out_issue(const PW& p, int item, int dir, GdnOutRaw& R, int tid) {
    const int lane = tid & 63, fr = lane & 15, fq = lane >> 4, wid = tid >> 6;
    const int j = item % NCH, h = (item / NCH) & 3, b = item / (NCH * 4);
    const int c = dir_chunk(dir, j);
    const int it2 = ((dir * 4 + b) * 4 + h) * NCH + c;
    gdn_ld_issue((const bf16_t*)(p.ws + WS_P), (const float*)(p.ws + WS_GATES) + (size_t)it2 * 320, b, c, h, dir, 0, R.L, tid);
    const bf16_t* GS = (const bf16_t*)(p.ws + WS_GN) + (size_t)it2 * 16384;
    const bf16_t* GW = (const bf16_t*)(p.ws + WS_H) + (size_t)it2 * 8192;
    const bf16_t* GU = (const bf16_t*)(p.ws + WS_GU) + (size_t)it2 * 8192;
#pragma unroll
    for (int r = 0; r < 4; ++r) { const int idx = tid + 512 * r, row = idx >> 4, cg8 = (idx & 15) * 8; R.st[r] = *(const u32x4*)(GS + row * 128 + cg8); }
#pragma unroll
    for (int r = 0; r < 2; ++r) { const int idx = tid + 512 * r, row = idx >> 4, cg8 = (idx & 15) * 8; R.w[r] = *(const u32x4*)(GW + row * 128 + cg8); }
#pragma unroll
    for (int nt = 0; nt < 4; ++nt) R.ur[nt] = *(const u32x2*)(GU + (nt * 16 + fr) * 128 + wid * 16 + fq * 4);
}
DEVI void gdn_out_all(const PW& pw0, int l, int first, int G, bool skipctx, unsigned char* shm_in, int wv) {
    const int dry = 0;
    GdnOutRaw R;
    int item = first;
    while (item < 1088 && skipctx && (item % NCH) < 4) item += G;
    if (item < 1088) { const PW p{opq64(pw0.ws)}; gdn_out_issue(p, item, 0, R, MYTID); }
#pragma unroll 1
    while (item < 1088) {
    int nitem = item + G;
    while (nitem < 1088 && skipctx && (nitem % NCH) < 4) nitem += G;
#pragma unroll 1
    for (int dir = 0; dir < 2; ++dir) {
        const PW p{opq64(pw0.ws)};
        unsigned char* shm = opq(shm_in);
        const int tid = MYTID, wid = __builtin_amdgcn_readfirstlane(tid >> 6), lane = tid & 63, fr = lane & 15, fq = lane >> 4;
        const int j = item % NCH, h = (item / NCH) & 3, b = item / (NCH * 4);
        bf16_t* P = (bf16_t*)(p.ws + WS_P);
        bf16_t* sQ = (bf16_t*)shm;
        bf16_t* sK = (bf16_t*)(shm + 17408);
        bf16_t* sST = (bf16_t*)(shm + 34816);
        bf16_t* sW = (bf16_t*)(shm + 69632);
        bf16_t* sVN = (bf16_t*)(shm + 87040);
        bf16_t* sA2 = (bf16_t*)(shm + 105472);
        float* sO = (float*)(shm + 114688);
        float* sc = (float*)(shm + 148480);
        gdn_ld_finish(R.L, pin(19) + (size_t)l * 4 * 1536, h, 0, 1 | 2, sQ, sK, nullptr, nullptr, sc, tid);
#pragma unroll
        for (int r = 0; r < 4; ++r) { const int idx = tid + 512 * r, row = idx >> 4, cg8 = (idx & 15) * 8; *(u32x4*)(sST + row * 136 + cg8) = R.st[r]; }
#pragma unroll
        for (int r = 0; r < 2; ++r) { const int idx = tid + 512 * r, row = idx >> 4, cg8 = (idx & 15) * 8; *(u32x4*)(sW + row * 136 + cg8) = R.w[r]; }
        u32x2 ur4[4];
#pragma unroll
        for (int nt = 0; nt < 4; ++nt) ur4[nt] = R.ur[nt];
        __builtin_amdgcn_sched_barrier(0);
        if (dir == 0) gdn_out_issue(p, item, 1, R, opaque(tid)); else if (nitem < 1088) gdn_out_issue(p, nitem, 0, R, opaque(tid));
        __builtin_amdgcn_sched_barrier(0);
        lbar();
        {
            const int mt = wid;
#pragma unroll
            for (int nt = 0; nt < 4; ++nt) {
                const u32x2 ur = ur4[nt];
                f32x4 a = (f32x4){0.f, 0.f, 0.f, 0.f};
#pragma unroll
                for (int kk = 0; kk < 4; ++kk) a = MFMA16(ldfrag(sST, 136, mt * 16, kk * 32, lane), ldfrag(sW, 136, nt * 16, kk * 32, lane), a);
                const int t = nt * 16 + fr, e0 = mt * 16 + fq * 4;
                sVN[(e0 + 0) * 72 + t] = (bf16_t)f2bf(__uint_as_float(ur[0] << 16) - a[0]); sVN[(e0 + 1) * 72 + t] = (bf16_t)f2bf(__uint_as_float(ur[0] & 0xffff0000u) - a[1]);
                sVN[(e0 + 2) * 72 + t] = (bf16_t)f2bf(__uint_as_float(ur[1] << 16) - a[2]); sVN[(e0 + 3) * 72 + t] = (bf16_t)f2bf(__uint_as_float(ur[1] & 0xffff0000u) - a[3]);
            }
#pragma unroll
            for (int ti = 0; ti < 2; ++ti) {
                const int tile = wid * 2 + ti, m2 = tile >> 2, n2 = tile & 3;
                f32x4 a = (f32x4){0.f, 0.f, 0.f, 0.f};
#pragma unroll
                for (int kk = 0; kk < 4; ++kk) a = MFMA16(ldfrag(sQ, 136, m2 * 16, kk * 32, lane), ldfrag(sK, 136, n2 * 16, kk * 32, lane), a);
                const int s = n2 * 16 + fr;
#pragma unroll
                for (int jj = 0; jj < 4; ++jj) { const int t = m2 * 16 + fq * 4 + jj; sA2[t * 72 + s] = (bf16_t)f2bf(s <= t ? a[jj] * __expf(sc[t] - sc[s]) : 0.f); }
            }
        }
        lbar();
        {
            const int nt = wid;
#pragma unroll
            for (int mt = 0; mt < 4; ++mt) {
                f32x4 a = (f32x4){0.f, 0.f, 0.f, 0.f};
#pragma unroll
                for (int kk = 0; kk < 4; ++kk) a = MFMA16(ldfrag(sQ, 136, mt * 16, kk * 32, lane), ldfrag(sST, 136, nt * 16, kk * 32, lane), a);
#pragma unroll
                for (int jj = 0; jj < 4; ++jj) a[jj] *= sc[128 + mt * 16 + fq * 4 + jj];
#pragma unroll
                for (int kk = 0; kk < 2; ++kk) a = MFMA16(ldfrag(sA2, 72, mt * 16, kk * 32, lane), ldfrag(sVN, 72, nt * 16, kk * 32, lane), a);
                const int e = nt * 16 + fr;
#pragma unroll
                for (int jj = 0; jj < 4; ++jj) { const int t = mt * 16 + fq * 4 + jj; const int i = dir ? 63 - t : t; if (dir) sO[i * 132 + e] += a[jj]; else sO[i * 132 + e] = a[jj]; }
            }
        }
        lbar();
    }
    {
        const PW p{opq64(pw0.ws)};
        unsigned char* shm = opq(shm_in);
        const int tid = MYTID;
        const int j = item % NCH, h = (item / NCH) & 3, b = item / (NCH * 4);
        bf16_t* P = (bf16_t*)(p.ws + WS_P);
        float* sO = (float*)(shm + 114688);
    {
        const int i = tid >> 3, e0 = (tid & 7) * 16;
        float v[16], ss = 0.f;
#pragma unroll
        for (int e = 0; e < 16; ++e) { v[e] = sO[i * 132 + e0 + e]; ss += v[e] * v[e]; }
        ss += __shfl_xor(ss, 1, 64); ss += __shfl_xor(ss, 2, 64); ss += __shfl_xor(ss, 4, 64);
        const float rs = rsqrtf(ss * (1.f / 128.f) + EPS);
        const int row = tok_row(true, 0, b, j, i);
        bf16_t* zp = P + (size_t)row * DINP + C_DNZ + h * 128 + e0;
        const float* g = pin(22) + l * 128 + e0;
#pragma unroll
        for (int half = 0; half < 2; ++half) {
            float z[8]; unpack8(*(const u32x4*)(zp + half * 8), z); float o[8];
#pragma unroll
            for (int e = 0; e < 8; ++e) o[e] = v[half * 8 + e] * rs * g[half * 8 + e] * z[e];
            bf16_t* zd = dry ? (bf16_t*)(p.ws + WS_GB) + (size_t)row * 512 + h * 128 + e0 : zp;
            *(u32x4*)(zd + half * 8) = pack8(o);
        }
    }
    lbar();
    }
    item = nitem;
    }
}

DEVI float ml_gates(const PW& p, const bf16_t* P, int l, int b, int c, int h, int dir, float* sc, int lane) {
    const int row = tok_row(false, dir, b, c, lane);
    const float ig = bf2f(P[(size_t)row * DINP + C_MLG + dir * 4 + h]) + pin(10)[l * 16 + dir * 4 + h];
    const float fg = bf2f(P[(size_t)row * DINP + C_MLG + (2 + dir) * 4 + h]) + pin(10)[l * 16 + (2 + dir) * 4 + h];
    float bb = logsig(fg);
#pragma unroll
    for (int o = 1; o < 64; o <<= 1) { const float t = __shfl_up(bb, o, 64); if (lane >= o) bb += t; }
    sc[lane] = bb; sc[64 + lane] = ig;
    return __shfl(bb, 63, 64);
}
struct MlPrepRaw { u32x4 k; u32x4 v[2]; float w[2]; float g; };
DEVI void ml_prep_issue(const PW& p, int item, MlPrepRaw& R, int tid) {
    const int c = item % NCH, h = (item / NCH) & 3, b = (item / (NCH * 4)) & 3, dir = item / (NCH * 16);
    const bf16_t* P = (const bf16_t*)(p.ws + WS_P);
    const float* gp = (const float*)(p.ws + WS_GATES) + (size_t)(2176 + item) * 320;
    { const int t = tid >> 3, cg8 = (tid & 7) * 8; const int row = tok_row(false, dir, b, c, t); R.k = *(const u32x4*)(P + (size_t)row * DINP + C_MLK + h * 64 + cg8); }
#pragma unroll
    for (int r = 0; r < 2; ++r) { const int idx = tid + 512 * r, t = idx >> 4, cg8 = (idx & 15) * 8; const int row = tok_row(false, dir, b, c, t);
        R.v[r] = *(const u32x4*)(P + (size_t)row * DINP + C_MLV + h * 128 + cg8); R.w[r] = gp[128 + t]; }
    R.g = gp[128 + (tid & 63)];
}
DEVI void ml_prep_all(const PW& pw0, int l, int first, int G, unsigned char* shm_in, int wv) {
    MlPrepRaw R;
    if (first < 2176) { const PW p{opq64(pw0.ws)}; ml_prep_issue(p, first, R, MYTID); }
#pragma unroll 1
    for (int item = first; item < 2176; item += G) {
    const PW p{opq64(pw0.ws)};
    unsigned char* shm = opq(shm_in);
    const int tid = MYTID, wid = __builtin_amdgcn_readfirstlane(tid >> 6), lane = tid & 63, fr = lane & 15, fq = lane >> 4;
    bf16_t* sKT = (bf16_t*)shm;
    bf16_t* sVT = (bf16_t*)(shm + 9216);
    float* sc = (float*)(shm + 27648);
    if (tid < 64) sc[128 + tid] = R.g;
    {
        const int t = tid >> 3, cg8 = (tid & 7) * 8;
        float x[8]; unpack8(R.k, x);
#pragma unroll
        for (int e = 0; e < 8; ++e) sKT[tix(cg8 + e, t)] = (bf16_t)f2bf(x[e]);
    }
#pragma unroll
    for (int r = 0; r < 2; ++r) {
        const int idx = tid + 512 * r, t = idx >> 4, cg8 = (idx & 15) * 8;
        float x[8]; unpack8(R.v[r], x); const float w = R.w[r];
#pragma unroll
        for (int e = 0; e < 8; ++e) sVT[tix(cg8 + e, t)] = (bf16_t)f2bf(x[e] * w);
    }
    __builtin_amdgcn_sched_barrier(0);
    if (item + G < 2176) ml_prep_issue(p, item + G, R, opaque(tid));
    __builtin_amdgcn_sched_barrier(0);
    lbar();
    float* KV = (float*)(p.ws + WS_Y) + (size_t)item * 8192;
    {
        const int nt = wid;
#pragma unroll
        for (int mt = 0; mt < 4; ++mt) {
            f32x4 a = (f32x4){0.f, 0.f, 0.f, 0.f};
#pragma unroll
            for (int kk = 0; kk < 2; ++kk) a = MFMA16(ldfragT(sKT, mt * 16, kk * 32, lane), ldfragT(sVT, nt * 16, kk * 32, lane), a);
            *(f32x4*)(KV + (nt * 16 + fr) * 64 + mt * 16 + fq * 4) = a;
        }
    }
    {
        const int d = tid >> 3, t0 = (tid & 7) * 8; float s = 0.f;
#pragma unroll
        for (int t = 0; t < 8; ++t) s += sc[128 + t0 + t] * bf2f(sKT[tix(d, t0 + t)]);
        s += __shfl_xor(s, 1, 64); s += __shfl_xor(s, 2, 64); s += __shfl_xor(s, 4, 64);
        if ((tid & 7) == 0) ((float*)(p.ws + WS_SM + SM_MN))[item * 64 + d] = s; }
    lbar();
    }
}
DEVI void ml_seq(const PW& pw0, int gtid, int nthreads) {
    const PW p{opq64(pw0.ws)};
    const float* MSC = (const float*)(p.ws + WS_SM + SM_MSC);
    float* MM = (float*)(p.ws + WS_SM + SM_MM);
    for (int g = gtid; g < 32 * 4096 + 32 * 32; g += nthreads) {
        const bool isn = g >= 32 * 4096; const int gg = isn ? g - 32 * 4096 : g;
        const int chain = isn ? gg >> 5 : gg >> 12, e2 = isn ? gg & 31 : gg & 4095;
        float* base = isn ? (float*)(p.ws + WS_SM + SM_MN) + (size_t)chain * NCH * 64 + e2 * 2 : (float*)(p.ws + WS_Y) + (size_t)chain * NCH * 8192 + e2 * 2;
        const int stride = isn ? 64 : 8192;
        float m = 0.f; f32x2 C = (f32x2){0.f, 0.f};
        for (int c0 = 0; c0 < NCH; c0 += 17) {
            f32x2 kv[17]; f32x2 sc[17];
#pragma unroll
            for (int u = 0; u < 17; ++u) { kv[u] = *(const f32x2*)(base + (size_t)(c0 + u) * stride); sc[u] = *(const f32x2*)(MSC + (chain * NCH + c0 + u) * 2); }
#pragma unroll
            for (int u = 0; u < 17; ++u) {
                *(f32x2*)(base + (size_t)(c0 + u) * stride) = C;
                if (!isn && e2 == 0) MM[chain * NCH + c0 + u] = m;
                const float mn = fmaxf(sc[u][0] + m, sc[u][1]);
                const float a = __expf(sc[u][0] + m - mn), s = __expf(sc[u][1] - mn);
                C = C * a + kv[u] * s; m = mn;
            }
        }
    }
}
struct MlOutRaw { u32x4 q, k, v[2]; f32x4 ct[4]; float gb, gi, gpm, m, n; };
DEVI void ml_out_issue(const PW& p, int item, int dir, MlOutRaw& R, int tid) {
    const int lane = tid & 63;
    const int j = item % NCH, h = (item / NCH) & 3, b = item / (NCH * 4);
    const int c = dir_chunk(dir, j);
    const int it2 = ((dir * 4 + b) * 4 + h) * NCH + c;
    const bf16_t* P = (const bf16_t*)(p.ws + WS_P);
    { const int t = tid >> 3, cg8 = (tid & 7) * 8; const int row = tok_row(false, dir, b, c, t);
      R.q = *(const u32x4*)(P + (size_t)row * DINP + C_MLQ + h * 64 + cg8); R.k = *(const u32x4*)(P + (size_t)row * DINP + C_MLK + h * 64 + cg8); }
#pragma unroll
    for (int r = 0; r < 2; ++r) { const int idx = tid + 512 * r, t = idx >> 4, cg8 = (idx & 15) * 8; const int row = tok_row(false, dir, b, c, t);
        R.v[r] = *(const u32x4*)(P + (size_t)row * DINP + C_MLV + h * 128 + cg8); }
    const float* CT = (const float*)(p.ws + WS_Y) + (size_t)it2 * 8192;
#pragma unroll
    for (int r = 0; r < 4; ++r) { const int idx = tid + 512 * r, e = idx >> 4, d4 = (idx & 15) * 4; R.ct[r] = *(const f32x4*)(CT + e * 64 + d4); }
    const float* gp = (const float*)(p.ws + WS_GATES) + (size_t)(2176 + it2) * 320;
    R.gb = gp[lane]; R.gi = gp[64 + lane]; R.gpm = gp[192 + lane];
    R.m = ((const float*)(p.ws + WS_SM + SM_MM))[it2]; R.n = ((const float*)(p.ws + WS_SM + SM_MN))[it2 * 64 + lane];
}
DEVI void ml_out_all(const PW& pw0, int l, int first, int G, bool skipctx, unsigned char* shm_in, int wv) {
    const int dry = 0;
    MlOutRaw R;
    int item = first;
    while (item < 1088 && skipctx && (item % NCH) < 4) item += G;
    if (item < 1088) { const PW p{opq64(pw0.ws)}; ml_out_issue(p, item, 0, R, MYTID); }
#pragma unroll 1
    while (item < 1088) {
    int nitem = item + G;
    while (nitem < 1088 && skipctx && (nitem % NCH) < 4) nitem += G;
#pragma unroll 1
    for (int dir = 0; dir < 2; ++dir) {
        const PW p{opq64(pw0.ws)};
        unsigned char* shm = opq(shm_in);
        const int tid = MYTID, wid = __builtin_amdgcn_readfirstlane(tid >> 6), lane = tid & 63, fr = lane & 15, fq = lane >> 4;
        bf16_t* sQ = (bf16_t*)shm;
        bf16_t* sK = (bf16_t*)(shm + 9216);
        bf16_t* sVT = (bf16_t*)(shm + 18432);
        bf16_t* sCT = (bf16_t*)(shm + 36864);
        bf16_t* sS = (bf16_t*)(shm + 55296);
        float* sO = (float*)(shm + 64512);
        float* sc = (float*)(shm + 98304);
        if (wid == 0) {
            const float m = R.m, bb = R.gb, pm = R.gpm;
            sc[lane] = bb; sc[64 + lane] = R.gi;
            const float mt = bb + fmaxf(m, pm);
            sc[128 + lane] = mt; sc[192 + lane] = __expf(bb + m - mt);
            sc[320 + lane] = R.n;
        }
        {
            const int t = tid >> 3, cg8 = (tid & 7) * 8;
            float x[8]; unpack8(R.q, x);
#pragma unroll
            for (int e = 0; e < 8; ++e) x[e] *= 0.125f;
            *(u32x4*)(sQ + t * 72 + cg8) = pack8(x);
            *(u32x4*)(sK + t * 72 + cg8) = R.k;
        }
#pragma unroll
        for (int r = 0; r < 2; ++r) {
            const int idx = tid + 512 * r, t = idx >> 4, cg8 = (idx & 15) * 8;
            float x[8]; unpack8(R.v[r], x);
#pragma unroll
            for (int e = 0; e < 8; ++e) sVT[tix(cg8 + e, t)] = (bf16_t)f2bf(x[e]);
        }
#pragma unroll
        for (int r = 0; r < 4; ++r) { const int idx = tid + 512 * r, e = idx >> 4, d4 = (idx & 15) * 4; const f32x4 v = R.ct[r];
            u32x2 w; w[0] = pk2(v[0], v[1]); w[1] = pk2(v[2], v[3]); *(u32x2*)(sCT + e * 72 + d4) = w; }
        __builtin_amdgcn_sched_barrier(0);
        if (dir == 0) ml_out_issue(p, item, 1, R, opaque(tid)); else if (nitem < 1088) ml_out_issue(p, nitem, 0, R, opaque(tid));
        __builtin_amdgcn_sched_barrier(0);
        lbar();
#pragma unroll
        for (int ti = 0; ti < 2; ++ti) {
            const int tile = wid * 2 + ti, m2 = tile >> 2, n2 = tile & 3;
            f32x4 a = (f32x4){0.f, 0.f, 0.f, 0.f};
#pragma unroll
            for (int kk = 0; kk < 2; ++kk) a = MFMA16(ldfrag(sQ, 72, m2 * 16, kk * 32, lane), ldfrag(sK, 72, n2 * 16, kk * 32, lane), a);
            const int s = n2 * 16 + fr;
#pragma unroll
            for (int jj = 0; jj < 4; ++jj) { const int t = m2 * 16 + fq * 4 + jj;
                sS[t * 72 + s] = (bf16_t)f2bf(s <= t ? a[jj] * __expf(sc[t] - sc[s] + sc[64 + s] - sc[128 + t]) : 0.f); }
        }
        lbar();
        {
            const int t = tid >> 3, s0 = (tid & 7) * 8; float ds = 0.f, qn = 0.f;
#pragma unroll
            for (int s2 = 0; s2 < 8; ++s2) { ds += bf2f(sS[t * 72 + s0 + s2]); qn += bf2f(sQ[t * 72 + s0 + s2]) * sc[320 + s0 + s2]; }
            ds += __shfl_xor(ds, 1, 64); ds += __shfl_xor(ds, 2, 64); ds += __shfl_xor(ds, 4, 64);
            qn += __shfl_xor(qn, 1, 64); qn += __shfl_xor(qn, 2, 64); qn += __shfl_xor(qn, 4, 64);
            const float den = ds + sc[192 + t] * qn;
            if ((tid & 7) == 0) sc[256 + t] = 1.f / fmaxf(fabsf(den), __expf(-sc[128 + t]));
        }
        lbar();
        {
            const int nt = wid;
#pragma unroll
            for (int mt = 0; mt < 4; ++mt) {
                f32x4 a = (f32x4){0.f, 0.f, 0.f, 0.f};
#pragma unroll
                for (int kk = 0; kk < 2; ++kk) a = MFMA16(ldfrag(sQ, 72, mt * 16, kk * 32, lane), ldfrag(sCT, 72, nt * 16, kk * 32, lane), a);
#pragma unroll
                for (int jj = 0; jj < 4; ++jj) a[jj] *= sc[192 + mt * 16 + fq * 4 + jj];
#pragma unroll
                for (int kk = 0; kk < 2; ++kk) a = MFMA16(ldfrag(sS, 72, mt * 16, kk * 32, lane), ldfragT(sVT, nt * 16, kk * 32, lane), a);
                const int e = nt * 16 + fr;
#pragma unroll
                for (int jj = 0; jj < 4; ++jj) { const int t = mt * 16 + fq * 4 + jj; const int i = dir ? 63 - t : t; const float hv = a[jj] * sc[256 + t];
                    if (dir) sO[i * 132 + e] += hv; else sO[i * 132 + e] = hv; }
            }
        }
        lbar();
    }
    {
        const PW p{opq64(pw0.ws)};
        unsigned char* shm = opq(shm_in);
        const int tid = MYTID;
        const int j = item % NCH, h = (item / NCH) & 3, b = item / (NCH * 4);
        bf16_t* P = (bf16_t*)(p.ws + WS_P);
        float* sO = (float*)(shm + 64512);
    {
        const int i = tid >> 3, e0 = (tid & 7) * 16;
        float v[16], ss = 0.f;
#pragma unroll
        for (int e = 0; e < 16; ++e) { v[e] = sO[i * 132 + e0 + e]; ss += v[e] * v[e]; }
        ss += __shfl_xor(ss, 1, 64); ss += __shfl_xor(ss, 2, 64); ss += __shfl_xor(ss, 4, 64);
        const float rs = rsqrtf(ss * (1.f / 128.f) + EPS);
        const int row = tok_row(false, 0, b, j, i);
        bf16_t* op = P + (size_t)row * DINP + C_MLO + h * 128 + e0;
        const float* g = pin(11) + l * 512 + h * 128 + e0;
#pragma unroll
        for (int half = 0; half < 2; ++half) {
            float z[8]; unpack8(*(const u32x4*)(op + half * 8), z); float o[8];
#pragma unroll
            for (int e = 0; e < 8; ++e) o[e] = v[half * 8 + e] * rs * g[half * 8 + e] * z[e];
            bf16_t* od = dry ? (bf16_t*)(p.ws + WS_GB) + (size_t)row * 512 + h * 128 + e0 : op;
            *(u32x4*)(od + half * 8) = pack8(o);
        }
    }
    lbar();
    }
    item = nitem;
    }
}

DEVI void lru_item(const PW& pw0, int l, int item, int mode, unsigned char* shm_in, int wv, int dry = 0) {
    const PW p{opq64(pw0.ws)};
    unsigned char* shm = opq(shm_in);
    const int tid = MYTID, wid = __builtin_amdgcn_readfirstlane(tid >> 6), lane = tid & 63, fr = lane & 15, fq = lane >> 4;
    const int half = item & 1, j = (item >> 1) % NCH, b = (item >> 1) / NCH; const bool isctx = j < 4;
    bf16_t* P = (bf16_t*)(p.ws + WS_P);
    bf16_t* sX = (bf16_t*)shm;
    const int p0 = (isctx ? j : j - 4) * 64;
    const float* cw = pin(12) + (size_t)l * 4 * 512; const float* cb = pin(13) + (size_t)l * 512;
    {
        const int ch = lane * 8, i0 = wid * 8;
        f32x4 w[4][2];
#pragma unroll
        for (int jj = 0; jj < 4; ++jj) { w[jj][0] = *(const f32x4*)(cw + jj * 512 + ch); w[jj][1] = *(const f32x4*)(cw + jj * 512 + ch + 4); }
        const f32x4 b0 = *(const f32x4*)(cb + ch), b1 = *(const f32x4*)(cb + ch + 4);
        u32x4 raw[11];
#pragma unroll
        for (int r = 0; r < 11; ++r) { const int row = pos_row(false, b, isctx, p0 + i0 + r - 2);
            raw[r] = (u32x4){0u, 0u, 0u, 0u}; if (row >= 0) raw[r] = *(const u32x4*)(P + (size_t)row * DINP + C_LRX + ch); }
#pragma unroll
        for (int i = 0; i < 8; ++i) {
            float a[8] = {b0[0], b0[1], b0[2], b0[3], b1[0], b1[1], b1[2], b1[3]};
#pragma unroll
            for (int jj = 0; jj < 4; ++jj) { float x[8]; unpack8(raw[i + jj], x);
#pragma unroll
                for (int e = 0; e < 4; ++e) { a[e] += w[jj][0][e] * x[e]; a[4 + e] += w[jj][1][e] * x[4 + e]; } }
            *(u32x4*)(sX + (i0 + i) * 520 + ch) = pack8(a);
        }
    }
    lbar();
    const int blk = wid;
    const bf16_t* WL = (const bf16_t*)(p.ws + WS_WLRU);
    float* LAGG = (float*)(p.ws + WS_SM + SM_LAGG);
#pragma unroll 1
    for (int nn = 0; nn < 2; ++nn) {
        const int n4 = half * 2 + nn;
        const int ch = blk * 64 + n4 * 16 + fr;
        float hsum[4][4];
#pragma unroll
        for (int mt = 0; mt < 4; ++mt)
#pragma unroll
            for (int jj = 0; jj < 4; ++jj) hsum[mt][jj] = 0.f;
#pragma unroll
        for (int dir = 0; dir < 2; ++dir) {
            const bf16_t* wa = WL + (size_t)(0 * 16 + dir * 8 + blk) * 4096 + (n4 * 16 + fr) * 64 + fq * 8;
            const bf16_t* wx = WL + (size_t)(1 * 16 + dir * 8 + blk) * 4096 + (n4 * 16 + fr) * 64 + fq * 8;
            bf16x8 ba[2], bx[2];
#pragma unroll
            for (int kk = 0; kk < 2; ++kk) { ba[kk] = *(const bf16x8*)(wa + kk * 32); bx[kk] = *(const bf16x8*)(wx + kk * 32); }
            const int c = dir_chunk(dir, j);
            const size_t aidx = (((size_t)dir * 4 + b) * NCH + c) * 512 + ch;
            const float hin0 = mode ? LAGG[aidx * 2] : 0.f;
            const float bias_a = pin(15)[(size_t)l * 1024 + dir * 512 + ch], bias_x = pin(17)[(size_t)l * 1024 + dir * 512 + ch];
            const float cl = -8.f * softplus(-pin(18)[(size_t)l * 1024 + dir * 512 + ch]);
            float av[4][4], bv[4][4];
#pragma unroll
            for (int mt = 0; mt < 4; ++mt) {
                f32x4 aa = (f32x4){0.f, 0.f, 0.f, 0.f}, ax = aa;
#pragma unroll
                for (int kk = 0; kk < 2; ++kk) { const bf16x8 af = ldfrag(sX, 520, mt * 16, blk * 64 + kk * 32, lane); aa = MFMA16(af, ba[kk], aa); ax = MFMA16(af, bx[kk], ax); }
#pragma unroll
                for (int jj = 0; jj < 4; ++jj) {
                    const int t = mt * 16 + fq * 4 + jj;
                    const float rr = sigm(aa[jj] + bias_a), ii = sigm(ax[jj] + bias_x), la = cl * rr;
                    const float ea = __expf(la);
                    av[mt][jj] = ea;
                    bv[mt][jj] = __builtin_amdgcn_sqrtf(fmaxf(1.f - ea * ea, 0.f)) * ii * bf2f(sX[t * 520 + ch]);
                }
            }
            float hin = hin0;
            float Pc = 1.f, Hc = 0.f;
#pragma unroll
            for (int mi = 0; mi < 4; ++mi) {
                const int mt = dir ? 3 - mi : mi;
                float Pl = 1.f, Hl = 0.f;
#pragma unroll
                for (int ji = 0; ji < 4; ++ji) { const int jj = dir ? 3 - ji : ji; Pl = av[mt][jj] * Pl; Hl = av[mt][jj] * Hl + bv[mt][jj]; }
                float Pq[4], Hq[4];
#pragma unroll
                for (int q = 0; q < 4; ++q) { Pq[q] = __shfl(Pl, fr + 16 * q, 64); Hq[q] = __shfl(Hl, fr + 16 * q, 64); }
                if (mode == 0) {
#pragma unroll
                    for (int qi = 0; qi < 4; ++qi) { const int q = dir ? 3 - qi : qi; Hc = Pq[q] * Hc + Hq[q]; Pc = Pq[q] * Pc; }
                } else {
                    float hh = hin;
                    float hme = hin;
#pragma unroll
                    for (int qi = 0; qi < 4; ++qi) { const int q = dir ? 3 - qi : qi; if (q == fq) hme = hh; hh = Pq[q] * hh + Hq[q]; }
                    hin = hh;
#pragma unroll
                    for (int ji = 0; ji < 4; ++ji) { const int jj = dir ? 3 - ji : ji; hme = av[mt][jj] * hme + bv[mt][jj]; hsum[mt][jj] += hme; }
                }
            }
            if (mode == 0 && fq == 0) { LAGG[aidx * 2] = Pc; LAGG[aidx * 2 + 1] = Hc; }
        }
        if (mode == 1) {
#pragma unroll
            for (int mt = 0; mt < 4; ++mt)
#pragma unroll
                for (int jj = 0; jj < 4; ++jj) { const int i = mt * 16 + fq * 4 + jj; const int row = pos_row(false, b, isctx, p0 + i);
                    hsum[mt][jj] *= bf2f(P[(size_t)row * DINP + C_LRY + ch]); }
#pragma unroll
            for (int mt = 0; mt < 4; ++mt)
#pragma unroll
                for (int jj = 0; jj < 4; ++jj) { const int i = mt * 16 + fq * 4 + jj; const int row = pos_row(false, b, isctx, p0 + i);
                    bf16_t* yp = P + (size_t)row * DINP + C_LRY + ch; bf16_t* yd = dry ? (bf16_t*)(p.ws + WS_GB) + (size_t)row * 512 + ch : yp; *yd = (bf16_t)f2bf(hsum[mt][jj]); }
        }
    }
    lbar();
}
DEVI void lru_seq(const PW& pw0, int gtid, int nthreads) {
    const PW p{opq64(pw0.ws)};
    float* LAGG = (float*)(p.ws + WS_SM + SM_LAGG);
    for (int g = gtid; g < 4096; g += nthreads) {
        const int ch = g & 511, db = g >> 9;
        float h = 0.f;
        for (int c0 = 0; c0 < NCH; c0 += 17) {
            f32x2 v[17];
#pragma unroll
            for (int u = 0; u < 17; ++u) v[u] = *(const f32x2*)(LAGG + (((size_t)db * NCH + c0 + u) * 512 + ch) * 2);
#pragma unroll
            for (int u = 0; u < 17; ++u) { LAGG[(((size_t)db * NCH + c0 + u) * 512 + ch) * 2] = h; h = v[u][0] * h + v[u][1]; }
        }
    }
}

DEVI void gate_phase(const PW& pw0, int l, int gwave, int nwaves, int lane) {
    const PW p{opq64(pw0.ws)};
    const bf16_t* P = (const bf16_t*)(p.ws + WS_P);
    float* GT = (float*)(p.ws + WS_GATES);
    for (int w = gwave; w < 4352; w += nwaves) {
        const int kind = w >= 2176 ? 1 : 0, item = kind ? w - 2176 : w;
        const int c = item % NCH, h = (item / NCH) & 3, b = (item / (NCH * 4)) & 3, dir = item / (NCH * 16);
        float* gp = GT + (size_t)(kind * 2176 + item) * 320;
        if (kind == 0) gdn_gates(p, P, l, b, c, h, dir, gp, lane);
        else {
            const int row = tok_row(false, dir, b, c, lane);
            const float ig = bf2f(P[(size_t)row * DINP + C_MLG + dir * 4 + h]) + pin(10)[l * 16 + dir * 4 + h];
            const float fg = bf2f(P[(size_t)row * DINP + C_MLG + (2 + dir) * 4 + h]) + pin(10)[l * 16 + (2 + dir) * 4 + h];
            float bb = logsig(fg);
#pragma unroll
            for (int o = 1; o < 64; o <<= 1) { const float t = __shfl_up(bb, o, 64); if (lane >= o) bb += t; }
            const float bT = __shfl(bb, 63, 64);
            const float lw = bT - bb + ig;
            const float Mc = wmax(lw);
            float pm = ig - bb;
#pragma unroll
            for (int o = 1; o < 64; o <<= 1) { const float t = __shfl_up(pm, o, 64); if (lane >= o) pm = fmaxf(pm, t); }
            gp[lane] = bb; gp[64 + lane] = ig; gp[128 + lane] = __expf(lw - Mc); gp[192 + lane] = pm;
            if (lane == 0) { float* msc = (float*)(p.ws + WS_SM + SM_MSC) + item * 2; msc[0] = bT; msc[1] = Mc; }
        }
    }
}

#define XB_TMO      128
#define XB_XCNT(j)  (256  + 64 * (j))
#define XB_XSUB(j)  (1280 + 64 * (j))
#define XB_XGEN(j)  (2304 + 64 * (j))
#define XB_TOP      3328
#define XB_TOPGEN   3392
#define XCD_BAR_WORDS 3456
#define XB_SPIN_CAP (1u << 22)
DEVI unsigned xb_ld(unsigned* p)              { return __hip_atomic_load(p, __ATOMIC_RELAXED, __HIP_MEMORY_SCOPE_AGENT); }
DEVI unsigned xb_add(unsigned* p, unsigned v) { return __hip_atomic_fetch_add(p, v, __ATOMIC_RELAXED, __HIP_MEMORY_SCOPE_AGENT); }
DEVI unsigned xb_xcc_id() { return (unsigned)__builtin_amdgcn_s_getreg((3 << 11) | 20) & 0xFu; }
#define XB_SPIN(cond, bar) do { unsigned _sp = 0; while (cond) { __builtin_amdgcn_s_sleep(1); \
    if ((++_sp & 255u) == 0u) { if (xb_ld(&(bar)[XB_TMO])) break; if (_sp > XB_SPIN_CAP) { atomicAdd(&(bar)[XB_TMO], 1u); break; } } } } while (0)
DEVI void xcd_barrier_complete(unsigned* bar, unsigned x, unsigned G, unsigned& nloc, unsigned& nx) {
    unsigned sum, cnt, mine, sp = 0u;
    for (;;) {
        sum = 0u; cnt = 0u; mine = 0u;
#pragma unroll
        for (unsigned j = 0; j < 16; ++j) { const unsigned c = xb_ld(&bar[XB_XCNT(j)]); sum += c; cnt += (c > 0u) ? 1u : 0u; mine = (j == x) ? c : mine; }
        if (sum == G) break;
        __builtin_amdgcn_s_sleep(1);
        if ((++sp & 255u) == 0u) { if (xb_ld(&bar[XB_TMO])) break; if (sp > XB_SPIN_CAP) { atomicAdd(&bar[XB_TMO], 1u); break; } }
    }
    nloc = mine > 0u ? mine : 1u; nx = cnt > 0u ? cnt : 1u;
}
DEVI void gsync(unsigned* bar, volatile LAS unsigned* st, int G, int wv) {
    asm volatile("s_waitcnt vmcnt(0)" ::: "memory");
    __syncthreads();
    const int ln = (int)__builtin_amdgcn_mbcnt_hi(~0u, __builtin_amdgcn_mbcnt_lo(~0u, 0u));
    if (wv == 0 && ln == 0) {
        __builtin_amdgcn_s_waitcnt(0);
        const unsigned x = xb_xcc_id();
        unsigned nloc = st[0], nx = st[1];
        if (nloc == 0u) { xcd_barrier_complete(bar, x, (unsigned)G, nloc, nx); st[0] = nloc; st[1] = nx; }
        const unsigned old = xb_add(&bar[XB_XSUB(x)], 1u);
        const unsigned gen = old / nloc;
        if (old + 1u == (gen + 1u) * nloc) {
            __builtin_amdgcn_fence(__ATOMIC_RELEASE, "agent");
            asm volatile("s_waitcnt vmcnt(0)" ::: "memory");
            const unsigned og = xb_add(&bar[XB_TOP], 1u);
            const unsigned tg = og / nx;
            if (og + 1u == (tg + 1u) * nx) xb_add(&bar[XB_TOPGEN], 1u);
            else XB_SPIN(xb_ld(&bar[XB_TOPGEN]) == tg, bar);
            __builtin_amdgcn_fence(__ATOMIC_ACQUIRE, "agent");
            xb_add(&bar[XB_XGEN(x)], 1u);
            asm volatile("s_waitcnt vmcnt(0)" ::: "memory");
        } else {
            XB_SPIN(xb_ld(&bar[XB_XGEN(x)]) == gen, bar);
            __builtin_amdgcn_fence(__ATOMIC_ACQUIRE, "agent");
            asm volatile("s_waitcnt vmcnt(0)" ::: "memory");
        }
    }
    __syncthreads();
}

__global__ void __launch_bounds__(512) mega(Params p) {
    extern __shared__ __attribute__((aligned(16))) unsigned char shm[];
    cg::grid_group grid = cg::this_grid();
    const int wv = __builtin_amdgcn_readfirstlane(threadIdx.x >> 6);
    const int G = gridDim.x, nwaves = G * 8, nthreads = G * 512;
#define TIDS const int tid = MYTID, wid = tid >> 6, lane = tid & 63, gwave = blockIdx.x * 8 + wid, gtid = blockIdx.x * 512 + tid; (void)gtid; (void)gwave; (void)lane;
    LAS unsigned char* lds = (LAS unsigned char*)shm;
#define WSQ unsigned char* ws = opq64(pw.ws); bf16_t* Hb = (bf16_t*)(ws + WS_H); bf16_t* Pb = (bf16_t*)(ws + WS_P); float* Yb = (float*)(ws + WS_Y); (void)Hb; (void)Pb; (void)Yb;

    const PW pw{p.ws};
    unsigned* bar = (unsigned*)p.ws;
    volatile LAS unsigned* xst = (volatile LAS unsigned*)((LAS unsigned char*)shm + (LDS_BYTES - 16));
    if (threadIdx.x == 0) { xst[0] = 0u; xst[1] = 0u; (void)xb_add(&bar[XB_XCNT(xb_xcc_id())], 1u); }
    __syncthreads();
    for (int rep = 0; rep < REP_CVT; ++rep) {
    mod_phase(pw, shm, wv);
    { TIDS convert_phase(pw, 0, shm, gwave, nwaves, wid, lane); }
    }
    grid.sync();
    { TIDS rowwise_phase(pw, 0, MTOT, 0, 0, 0.f, 0, 0, 0, 0, 0, gwave, nwaves, lane); }
    gsync(bar, xst, G, wv);

#pragma unroll 1
    for (int l = 0; l < DEPTH; ++l) {
        const bool last = l == DEPTH - 1;
#pragma unroll 1
        for (int f = 0; f < 2; ++f) {
            if (f == 1) {
                { WSQ pg8::Gemm g{Hb, (const bf16_t*)(ws + WS_WIN), 68, 31, D, D, 1, 0, 0, 0, 0, D, 0}; pg8::Order S; S.init(68, 31, 1, G, blockIdx.x);
                  pg8::EpiInProj E{Pb, DINP}; for (int rep = 0; rep < REP_GEMM; ++rep) pg8::gemm_phase(lds, g, S, E, wv); }
                gsync(bar, xst, G, wv);
                { TIDS gate_phase(pw, l, gwave, nwaves, lane); }
                gsync(bar, xst, G, wv);
#pragma unroll 1
                for (int rep2 = 0; rep2 < REP_PREPSEQ; ++rep2) {
#pragma unroll 1
                for (int rep = 0; rep < REP_PREP; ++rep)
                {
                    gdn_prep_all(pw, l, blockIdx.x, G, shm, wv);
                    ml_prep_all(pw, l, (blockIdx.x + G / 2) % G, G, shm, wv);
                    for (int it = (blockIdx.x + G / 4) % G; it < 544; it += G) for (int r3 = 0; r3 < REP_LRU0; ++r3) lru_item(pw, l, it, 0, shm, wv);
                }
                gsync(bar, xst, G, wv);
                for (int u = blockIdx.x; u < 256; u += G) gdn_seq_unit(pw, u, shm, wv);
                { TIDS ml_seq(pw, gtid, nthreads); }
                { TIDS lru_seq(pw, gtid, nthreads); }
                gsync(bar, xst, G, wv);
                }
                gdn_out_all(pw, l, blockIdx.x, G, last, shm, wv);
                ml_out_all(pw, l, (blockIdx.x + G / 4) % G, G, last, shm, wv);
                for (int it = (blockIdx.x + G / 2) % G; it < 544; it += G) { if (last && ((it >> 1) % NCH) < 4) continue; if (DRY_LO) lru_item(pw, l, it, 1, shm, wv, 1); lru_item(pw, l, it, 1, shm, wv); }
                gsync(bar, xst, G, wv);
                const int nM = last ? 64 : 68;
                { WSQ pg8::Gemm g{Pb, (const bf16_t*)(ws + WS_WBR), 64, 4, 512, DINP, 3, C_MLO, C_LRY, C_DNZ, D * 512, 512, 0}; pg8::Order S; S.init(64, 4, 3, G, blockIdx.x);
                  pg8::EpiBranch E{Pb, (bf16_t*)Yb, Hb}; for (int rep = 0; rep < REP_BR; ++rep) pg8::gemm_phase(lds, g, S, E, wv); }
                if (!last) { WSQ pg8::Gemm g{Pb, (const bf16_t*)(ws + WS_WBR), 4, 4, 512, DINP, 3, C_MLO, C_LRY, C_DNZ, D * 512, 512, 0}; pg8::Order S; S.init(4, 4, 3, G, G - 1 - blockIdx.x, 64, 1);
                  pg8::EpiBranchPart E{Pb, (float*)(ws + WS_GB + ((size_t)32 << 20))}; pg8::gemm_phase(lds, g, S, E, wv); }
                gsync(bar, xst, G, wv);
                { WSQ pg8::Gemm g{Hb, (const bf16_t*)(ws + WS_WOUT), 64, 4, D, D, 1, 0, 0, 0, 0, D, 0}; pg8::Order S; S.init(64, 4, 1, G, blockIdx.x);
                  pg8::EpiBf16Y E{(bf16_t*)Yb, D}; for (int rep = 0; rep < REP_GEMM; ++rep) pg8::gemm_phase(lds, g, S, E, wv); }
                if (!last) { WSQ pg8::Gemm g{Hb, (const bf16_t*)(ws + WS_WOUT), 4, 4, 256, D, 4, 0, 0, 0, 256, D, 256}; pg8::Order S; S.init(4, 4, 4, G, blockIdx.x, 64, 1);
                  pg8::Unit u0;
                  if (S.next(0, u0)) {
                      TIDS const float* PART = (const float*)(ws + WS_GB + ((size_t)32 << 20));
                      const int r = tid >> 1, hc = (tid & 1) * 128;
                      const size_t off = (size_t)((u0.pm - 64) * 256 + r) * D + u0.z * 256 + hc;
                      bf16_t* up = Hb + (size_t)(u0.pm * 256 + r) * D + u0.z * 256 + hc;
#pragma unroll 1
                      for (int cb = 0; cb < 128; cb += 32) {
                          f32x4 t[3][8];
#pragma unroll
                          for (int zz = 0; zz < 3; ++zz)
#pragma unroll
                              for (int q4 = 0; q4 < 8; ++q4) t[zz][q4] = *(const f32x4*)(PART + (size_t)zz * 1024 * D + off + cb + q4 * 4);
#pragma unroll
                          for (int q4 = 0; q4 < 8; q4 += 2) { const f32x4 a = t[0][q4] + t[1][q4] + t[2][q4], b2 = t[0][q4 + 1] + t[1][q4 + 1] + t[2][q4 + 1];
                              u32x4 w; w[0] = pk2(a[0], a[1]); w[1] = pk2(a[2], a[3]); w[2] = pk2(b2[0], b2[1]); w[3] = pk2(b2[2], b2[3]); *(u32x4*)(up + cb + q4 * 4) = w; }
                      }
                  }
                  asm volatile("s_waitcnt vmcnt(0)" ::: "memory"); __syncthreads();
                  pg8::EpiF32 E{(float*)(ws + WS_GB), D, MLAT, (size_t)1024 * D}; pg8::gemm_phase(lds, g, S, E, wv); }
                gsync(bar, xst, G, wv);
                { TIDS if (DRY_ROW) { rowwise_phase(pw, 1, nM * 256, l, 5, 1.f, 3, l, 4, 6, 4, gwave, nwaves, lane, 1); } rowwise_phase(pw, 1, nM * 256, l, 5, 1.f, 3, l, 4, 6, 4, gwave, nwaves, lane); }
                gsync(bar, xst, G, wv);
            }
            const int nM = (last && f == 1) ? 64 : 68;
            { WSQ pg8::Gemm g{Hb, (const bf16_t*)(ws + WS_WGU + f * SZ_WGU), nM, 22, D, D, 1, 0, 0, 0, 0, D, 0}; pg8::Order S; S.init(nM, 22, 1, G, blockIdx.x);
              pg8::EpiSwiGLU E{Pb, DFF}; for (int rep = 0; rep < REP_GU; ++rep) pg8::gemm_phase(lds, g, S, E, wv); }
            gsync(bar, xst, G, wv);
            { WSQ pg8::Gemm g{Pb, (const bf16_t*)(ws + WS_WDN + f * SZ_WDN), 64, 4, DFF, DFF, 1, 0, 0, 0, 0, DFF, 0}; pg8::Order S; S.init(64, 4, 1, G, blockIdx.x);
              pg8::EpiBf16Y E{(bf16_t*)Yb, D}; for (int rep = 0; rep < REP_DN; ++rep) pg8::gemm_phase(lds, g, S, E, wv); }
            if (nM == 68) { WSQ pg8::Gemm g{Pb, (const bf16_t*)(ws + WS_WDN + f * SZ_WDN), 4, 4, 256, DFF, 11, 0, 0, 0, 256, DFF, 256}; pg8::Order S; S.init(4, 4, 11, G, blockIdx.x, 64, 1);
              pg8::EpiF32 E{(float*)(ws + WS_GB), D, MLAT, (size_t)1024 * D}; for (int rep = 0; rep < REP_DNC; ++rep) pg8::gemm_phase(lds, g, S, E, wv); }
            gsync(bar, xst, G, wv);
            if (f == 0) { TIDS if (DRY_ROW) { rowwise_phase(pw, 1, nM * 256, l, 2, 0.5f, 1, l, 2, 3, 11, gwave, nwaves, lane, 1); } rowwise_phase(pw, 1, nM * 256, l, 2, 0.5f, 1, l, 2, 3, 11, gwave, nwaves, lane); }
            else if (!last) { { TIDS if (DRY_ROW) { rowwise_phase(pw, 1, nM * 256, l, 8, 0.5f, 5, l + 1, 0, 0, 11, gwave, nwaves, lane, 1); } rowwise_phase(pw, 1, nM * 256, l, 8, 0.5f, 5, l + 1, 0, 0, 11, gwave, nwaves, lane); } for (int rep = 0; rep < REP_CVT; ++rep) { TIDS convert_phase(pw, l + 1, shm, gwave, nwaves, wid, lane); } }
            else { TIDS rowwise_phase(pw, 2, MLAT, l, 8, 0.5f, 5, 0, 0, 0, 0, gwave, nwaves, lane); }
            gsync(bar, xst, G, wv);
        }
    }
}

extern "C" void kernel_launch(void* const* d_in, const int* in_sizes, int n_in, void* d_out, int out_size, void* d_ws, size_t ws_size, hipStream_t stream) {
    static int grid = 0;
    if (grid == 0) {
        if (n_in != 25 || ws_size < WS_END) { fprintf(stderr, "kernel_launch: unexpected n_in %d or ws_size %zu (need %zu)\n", n_in, ws_size, (size_t)WS_END); grid = -1; return; }
        int dev = 0, cus = 0, per_cu = 0;
        hipGetDevice(&dev); hipDeviceGetAttribute(&cus, hipDeviceAttributeMultiprocessorCount, dev);
        if (hipFuncSetAttribute((const void*)mega, hipFuncAttributeMaxDynamicSharedMemorySize, LDS_BYTES) != hipSuccess) { fprintf(stderr, "kernel_launch: hipFuncSetAttribute failed\n"); grid = -1; return; }
        if (hipOccupancyMaxActiveBlocksPerMultiprocessor(&per_cu, (const void*)mega, 512, LDS_BYTES) != hipSuccess || per_cu < 1) { fprintf(stderr, "kernel_launch: occupancy query failed (%d)\n", per_cu); per_cu = 1; }
        (void)hipGetLastError();
        grid = cus * per_cu;
    }
    if (grid < 0) return;
    if (hipMemsetAsync(d_ws, 0, 16384, stream) != hipSuccess) { fprintf(stderr, "kernel_launch: memset failed\n"); return; }
    Params p{};
    for (int i = 0; i < 25; ++i) p.in[i] = (const float*)d_in[i];
    p.out = (float*)d_out; p.ws = (unsigned char*)d_ws;
    void* args[] = {&p};
    hipError_t e = hipLaunchCooperativeKernel((const void*)mega, dim3(grid), dim3(512), args, LDS_BYTES, stream);
    if (e != hipSuccess) fprintf(stderr, "cooperative launch failed: %s (grid %d)\n", hipGetErrorString(e), grid);
}
```

```cpp
#include <hip/hip_runtime.h>
#include <hip/hip_cooperative_groups.h>
#include <cstdio>
namespace cg = cooperative_groups;

#define LAS __attribute__((address_space(3)))
#define DEVI __device__ __forceinline__
typedef unsigned short bf16_t;
typedef short bf16x8 __attribute__((ext_vector_type(8)));
typedef float f32x4 __attribute__((ext_vector_type(4)));
typedef float f32x2 __attribute__((ext_vector_type(2)));
typedef unsigned u32x4 __attribute__((ext_vector_type(4)));
typedef unsigned u32x2 __attribute__((ext_vector_type(2)));

constexpr int D = 1024, NBATCH = 4, SEQ = 4096, CTXL = 256, DEPTH = 4, DFF = 2816, DINP = 7936;
constexpr int MLAT = NBATCH * SEQ, MTOT = MLAT + NBATCH * CTXL;
constexpr int NCH = 68;
constexpr int C_MLQ = 0, C_MLK = 256, C_MLV = 512, C_MLO = 1024, C_MLG = 1536, C_LRX = 1552, C_LRY = 2064,
              C_DNQ = 2576, C_DNZ = 4112, C_DNBA = 4624, C_GATE = 4640, C_END = 7712;
constexpr float EPS = 1e-6f;

constexpr size_t SZ_WGU = (size_t)2 * DFF * D * 2, SZ_WDN = (size_t)D * DFF * 2;
constexpr size_t WS_MOD = 16384;
constexpr size_t WS_WGU = 1u << 20;
constexpr size_t WS_WDN = WS_WGU + 2 * SZ_WGU;
constexpr size_t WS_WIN = WS_WDN + 2 * SZ_WDN;
constexpr size_t WS_WBR = WS_WIN + (size_t)DINP * D * 2;
constexpr size_t WS_WOUT = WS_WBR + (size_t)3 * D * 512 * 2;
constexpr size_t WS_WLRU = WS_WOUT + (size_t)D * D * 2;
constexpr size_t WS_X = WS_WLRU + (size_t)32 * 64 * 64 * 2;
constexpr size_t WS_H = WS_X + (size_t)MTOT * D * 4;
constexpr size_t WS_Y = WS_H + (size_t)MTOT * D * 2;
constexpr size_t WS_P = WS_Y + (size_t)MTOT * D * 4;
constexpr size_t WS_GU = WS_P + (size_t)MTOT * DINP * 2;
constexpr size_t WS_GB = WS_GU + (size_t)2176 * 64 * 128 * 2;
constexpr size_t WS_GN = WS_GB + (size_t)2176 * 128 * 128 * 2;
constexpr size_t WS_SM = WS_GN + (size_t)2176 * 128 * 128 * 2;
constexpr size_t SM_GDEC = 0, SM_MN = 16384, SM_MSC = SM_MN + 2176 * 64 * 4, SM_MM = SM_MSC + 2176 * 8, SM_LAGG = SM_MM + 2176 * 4 + 1024;
constexpr size_t WS_YC = WS_SM + SM_LAGG + (size_t)2 * 4 * NCH * 512 * 2 * 4 + 4096;
constexpr size_t WS_GATES = WS_YC;
constexpr size_t WS_END = WS_GATES + (size_t)2 * 2176 * 320 * 4 + 4096;
constexpr int LDS_BYTES = 155648;
constexpr int REP_BR = 1, REP_GU = 1, REP_DN = 1, REP_DNC = 1, REP_GEMM = 1, DRY_ROW = 0, REP_PREP = 1, REP_PREPSEQ = 1, REP_CVT = 1, REP_GDNP = 1, REP_MLP = 1, REP_LRU0 = 1, DRY_GO = 0, DRY_MO = 0, DRY_LO = 0;

struct Params { const float* in[25]; float* out; unsigned char* ws; };
struct PW { unsigned char* ws; };

#define CAS __attribute__((address_space(4)))
DEVI const float* pin(int i) { const CAS char* k = (const CAS char*)__builtin_amdgcn_kernarg_segment_ptr(); return *(const float* const volatile CAS*)(k + 8 * i); }
DEVI int opaque(int v) { asm volatile("" : "+v"(v)); return v; }
DEVI unsigned char* opq(unsigned char* p) { unsigned v = (unsigned)(size_t)(LAS unsigned char*)p; asm volatile("" : "+s"(v)); return (unsigned char*)(LAS unsigned char*)(size_t)v; }
DEVI LAS unsigned char* opql(LAS unsigned char* p) { unsigned v = (unsigned)(size_t)p; asm volatile("" : "+s"(v)); return (LAS unsigned char*)(size_t)v; }
DEVI unsigned char* opq64(unsigned char* p) { unsigned long long v = (unsigned long long)p; asm volatile("" : "+s"(v)); return (unsigned char*)v; }
#define MYTID opaque(wv * 64 + (int)__builtin_amdgcn_mbcnt_hi(~0u, __builtin_amdgcn_mbcnt_lo(~0u, 0u)))
DEVI float bf2f(bf16_t v) { return __uint_as_float(((unsigned)v) << 16); }
DEVI unsigned f2bf(float f) { unsigned u = __float_as_uint(f); return (u + 0x7fffu + ((u >> 16) & 1u)) >> 16; }
DEVI unsigned pk2(float lo, float hi) { return f2bf(lo) | (f2bf(hi) << 16); }
DEVI float sigm(float x) { return __builtin_amdgcn_rcpf(1.f + __expf(-x)); }
DEVI float silu(float x) { return x * sigm(x); }
DEVI float softplus(float x) { return x > 20.f ? x : log1pf(__expf(x)); }
DEVI float logsig(float x) { return fminf(x, 0.f) - log1pf(__expf(-fabsf(x))); }
DEVI float gelu_t(float x) { float u = 0.7978845608f * (x + 0.044715f * x * x * x); float e = __expf(2.f * u); return x * (1.f - __builtin_amdgcn_rcpf(e + 1.f)); }
DEVI float wsum(float v) { for (int o = 32; o > 0; o >>= 1) v += __shfl_xor(v, o, 64); return v; }
DEVI float wmax(float v) { for (int o = 32; o > 0; o >>= 1) v = fmaxf(v, __shfl_xor(v, o, 64)); return v; }
DEVI void unpack8(u32x4 r, float* f) {
    f[0] = __uint_as_float(r[0] << 16); f[1] = __uint_as_float(r[0] & 0xffff0000u); f[2] = __uint_as_float(r[1] << 16); f[3] = __uint_as_float(r[1] & 0xffff0000u);
    f[4] = __uint_as_float(r[2] << 16); f[5] = __uint_as_float(r[2] & 0xffff0000u); f[6] = __uint_as_float(r[3] << 16); f[7] = __uint_as_float(r[3] & 0xffff0000u);
}
DEVI u32x4 pack8(const float* f) { u32x4 r; r[0] = pk2(f[0], f[1]); r[1] = pk2(f[2], f[3]); r[2] = pk2(f[4], f[5]); r[3] = pk2(f[6], f[7]); return r; }
DEVI bf16x8 ldfrag(const bf16_t* base, int ld, int row0, int k0, int lane) { return *(const bf16x8*)(base + (row0 + (lane & 15)) * ld + k0 + (lane >> 4) * 8); }
DEVI int tix(int row, int col) { return row * 72 + ((((col >> 3) + (row >> 3)) & 7) << 3) + (col & 7); }
DEVI bf16x8 ldfragT(const bf16_t* base, int row0, int k0, int lane) { const int r = row0 + (lane & 15), lg = (k0 >> 3) + (lane >> 4); return *(const bf16x8*)(base + r * 72 + (((lg + (r >> 3)) & 7) << 3)); }
DEVI void lbar() { asm volatile("s_waitcnt lgkmcnt(0)" ::: "memory"); __builtin_amdgcn_s_barrier(); asm volatile("" ::: "memory"); }
#define MFMA16(a, b, c) __builtin_amdgcn_mfma_f32_16x16x32_bf16(a, b, c, 0, 0, 0)

namespace pg8 {
constexpr int BM = 256, BK = 64, HALF = 128, HTB = HALF * BK * 2, NXCD = 8, WGM = 8;
DEVI int lds_byte(int r, int c) { const int st = (r >> 4) * 2 + (c >> 5), rr = r & 15, cc = c & 31, ob = rr * 64 + cc * 2; return st * 1024 + (ob ^ (((ob >> 9) & 1) << 5)); }
DEVI void stage_rc(int b, int& R, int& C) { const int st = b / 1024, sb = b % 1024, swz = sb ^ (((sb >> 9) & 1) << 5); R = (st >> 1) * 16 + swz / 64; C = (st & 1) * 32 + (swz % 64) / 2; }
DEVI int perm32(int rho) { const int n = rho >> 4, i = rho & 15; return 8 * (i >> 2) + 4 * n + (i & 3); }
struct Unit { int pm, pn, z; };
struct Gemm { const bf16_t* A; const bf16_t* Bt; int nM, nN, K, lda, nz, zA0, zA1, zA2, zB; int ldb, zAstep; };
struct Order {
    int nM, nN, nwg, G, c, nz, pm0, spread;
    DEVI void init(int nM_, int nN_, int nz_, int G_, int c_, int pm0_ = 0, int spread_ = 0) { nM = nM_; nN = nN_; nwg = nM * nN; G = G_; c = c_; nz = nz_; pm0 = pm0_; spread = spread_; }
    DEVI bool next(int i, Unit& u) const {
        int ti = i, z = 0; long L;
        if (spread) { L = (long)i * G + c; if (L >= (long)nwg * nz) return false; z = (int)(L / nwg); L -= (long)z * nwg; }
        else { if (nz == 3) { ti = i / 3; z = i - ti * 3; } L = (long)ti * G + c; if (L >= nwg) return false; }
        int wgid = (int)L; { const int q = nwg / NXCD, r = nwg % NXCD, xcd = wgid % NXCD, off = wgid / NXCD; wgid = (xcd < r ? xcd * (q + 1) : r * (q + 1) + (xcd - r) * q) + off; }
        const int nig = WGM * nN, gid = wgid / nig, fm = gid * WGM, gsz = (nM - fm) < WGM ? (nM - fm) : WGM;
        u.pm = pm0 + fm + ((wgid % nig) % gsz); u.pn = (wgid % nig) / gsz; u.z = z; return true;
    }
};

template <class Epi>
DEVI void gemm_phase(LAS unsigned char* lds_in, const Gemm g, const Order& S, const Epi& E, int wv) {
    LAS unsigned char* lds = opql(lds_in);
    const int tid = MYTID, wid = __builtin_amdgcn_readfirstlane(tid >> 6), lane = tid & 63, wr = wid >> 2, wc = wid & 3, fr = lane & 15, fq = lane >> 4;
    const int K = g.K, nt = K / BK, lda = g.lda, ldb = g.ldb;
    unsigned voffA[2], voffB[2];
#pragma unroll
    for (int i = 0; i < 2; ++i) { int R, C; stage_rc(tid * 16 + i * 8192, R, C); const int Rb = Epi::PERM ? ((R & ~31) + perm32(R & 31)) : R;
        voffA[i] = (unsigned)(R * lda + C) * 2u; voffB[i] = (unsigned)(Rb * ldb + C) * 2u; }
    const size_t kstep = (size_t)(BK * 2);
    const size_t hstepA = (size_t)HALF * lda * 2, hstepB = (size_t)HALF * ldb * 2;
    const unsigned ldsw = (unsigned)wid * 1024u;
    const int aoff = lds_byte(wr * 64 + fr, fq * 8), boff = lds_byte(wc * 32 + fr, fq * 8);
#define PG8_SA(b, h) (((b) * 2 + (h)) * HTB)
#define PG8_SB(b, h) ((4 + (b) * 2 + (h)) * HTB)
#define PG8_STAGE(bufoff, gbase, voff) do { _Pragma("unroll") for (int _i = 0; _i < 2; ++_i) \
        __builtin_amdgcn_global_load_lds((const unsigned*)((const char*)(gbase) + (voff)[_i]), (LAS unsigned*)(lds + (bufoff) + ldsw + _i * 8192), 16, 0, 0); } while (0)
#define PG8_LDA(dst, b, h) do { _Pragma("unroll") for (int m = 0; m < 4; ++m) _Pragma("unroll") for (int k = 0; k < 2; ++k) dst[m][k] = *(const LAS bf16x8*)(lds + PG8_SA(b, h) + aoff + m * 2048 + k * 1024); } while (0)
#define PG8_LDB(dst, b, h) do { _Pragma("unroll") for (int n = 0; n < 2; ++n) _Pragma("unroll") for (int k = 0; k < 2; ++k) dst[n][k] = *(const LAS bf16x8*)(lds + PG8_SB(b, h) + boff + n * 2048 + k * 1024); } while (0)
#define PG8_MMA(ai, bj, At, Bt) do { __builtin_amdgcn_s_setprio(1); _Pragma("unroll") for (int m = 0; m < 4; ++m) _Pragma("unroll") for (int n = 0; n < 2; ++n) _Pragma("unroll") for (int k = 0; k < 2; ++k) \
        acc[ai][bj][m][n] = __builtin_amdgcn_mfma_f32_16x16x32_bf16(Bt[n][k], At[m][k], acc[ai][bj][m][n], 0, 0, 0); __builtin_amdgcn_s_setprio(0); } while (0)
#define PG8_WAIT_V(n) asm volatile("s_waitcnt vmcnt(" #n ")" ::: "memory")
#define PG8_WAIT_L(n) asm volatile("s_waitcnt lgkmcnt(" #n ")" ::: "memory")
#define PG8_BAR __builtin_amdgcn_s_barrier()
#define PG8_SCHED __builtin_amdgcn_sched_barrier(0)
#define PG8_PA(u) ((const char*)g.A + ((size_t)(g.nz == 3 ? ((u).z == 0 ? g.zA0 : ((u).z == 1 ? g.zA1 : g.zA2)) : (u).z * g.zAstep) + (size_t)(u).pm * BM * lda) * 2)
#define PG8_PB(u) ((const char*)g.Bt + ((size_t)(u).z * g.zB + (size_t)(u).pn * BM * ldb) * 2)
    Unit cur, nxt; int ui = 0;
    if (!S.next(0, cur)) return;
    f32x4 acc[2][2][4][2];
#pragma unroll
    for (int a = 0; a < 2; ++a)
#pragma unroll
        for (int b = 0; b < 2; ++b)
#pragma unroll
            for (int m = 0; m < 4; ++m)
#pragma unroll
                for (int n = 0; n < 2; ++n) acc[a][b][m][n] = (f32x4){0.f, 0.f, 0.f, 0.f};
    bf16x8 At[4][2], B0[2][2], B1[2][2];
    const char* cA = PG8_PA(cur); const char* cB = PG8_PB(cur);
    PG8_STAGE(PG8_SB(0, 0), cB, voffB); PG8_STAGE(PG8_SA(0, 0), cA, voffA); PG8_STAGE(PG8_SB(0, 1), cB + hstepB, voffB); PG8_STAGE(PG8_SA(0, 1), cA + hstepA, voffA);
    if (wr == 1) PG8_BAR;
    PG8_WAIT_V(4); PG8_BAR;
    PG8_STAGE(PG8_SB(1, 0), cB + kstep, voffB); PG8_STAGE(PG8_SA(1, 0), cA + kstep, voffA); PG8_STAGE(PG8_SB(1, 1), cB + hstepB + kstep, voffB);
    PG8_WAIT_V(6); PG8_BAR;
    for (;;) {
        const bool has_next = S.next(ui + 1, nxt);
        const char* nA = has_next ? PG8_PA(nxt) : cA; const char* nB = has_next ? PG8_PB(nxt) : cB;
        for (int t = 0; t < nt; t += 2) {
            const bool last = (t == nt - 2);
            const char* a1 = cA + (size_t)(t + 1) * kstep;
            const char* a2 = last ? nA : cA + (size_t)(t + 2) * kstep; const char* b2 = last ? nB : cB + (size_t)(t + 2) * kstep;
            const char* a3 = a2 + kstep; const char* b3 = b2 + kstep;
            PG8_LDB(B0, 0, 0); PG8_SCHED; PG8_LDA(At, 0, 0); PG8_STAGE(PG8_SA(1, 1), a1 + hstepA, voffA);
            PG8_WAIT_L(8); PG8_BAR; PG8_WAIT_L(0); PG8_MMA(0, 0, At, B0); PG8_BAR; PG8_SCHED;
            PG8_LDB(B1, 0, 1); PG8_STAGE(PG8_SB(0, 0), b2, voffB);
            PG8_BAR; PG8_WAIT_L(0); PG8_MMA(0, 1, At, B1); PG8_BAR;
            PG8_LDA(At, 0, 1); PG8_STAGE(PG8_SA(0, 0), a2, voffA);
            PG8_BAR; PG8_WAIT_L(0); PG8_MMA(1, 0, At, B0); PG8_BAR; PG8_SCHED;
            PG8_STAGE(PG8_SB(0, 1), b2 + hstepB, voffB);
            PG8_WAIT_V(6); PG8_BAR; PG8_MMA(1, 1, At, B1); PG8_BAR;
            PG8_LDB(B0, 1, 0); PG8_SCHED; PG8_LDA(At, 1, 0); PG8_STAGE(PG8_SA(0, 1), a2 + hstepA, voffA);
            PG8_WAIT_L(8); PG8_BAR; PG8_WAIT_L(0); PG8_MMA(0, 0, At, B0); PG8_BAR; PG8_SCHED;
            PG8_LDB(B1, 1, 1); PG8_STAGE(PG8_SB(1, 0), b3, voffB);
            PG8_BAR; PG8_WAIT_L(0); PG8_MMA(0, 1, At, B1); PG8_BAR;
            PG8_LDA(At, 1, 1); PG8_STAGE(PG8_SA(1, 0), a3, voffA);
            PG8_BAR; PG8_WAIT_L(0); PG8_MMA(1, 0, At, B0); PG8_BAR; PG8_SCHED;
            PG8_STAGE(PG8_SB(1, 1), b3 + hstepB, voffB);
            PG8_WAIT_V(6); PG8_BAR; PG8_MMA(1, 1, At, B1); PG8_BAR;
        }
        E(acc, cur, wr, wc, fr, fq);
        if (!has_next) break;
#pragma unroll
        for (int a = 0; a < 2; ++a)
#pragma unroll
            for (int b = 0; b < 2; ++b)
#pragma unroll
                for (int m = 0; m < 4; ++m)
#pragma unroll
                    for (int n = 0; n < 2; ++n) acc[a][b][m][n] = (f32x4){0.f, 0.f, 0.f, 0.f};
        cur = nxt; cA = nA; cB = nB; ++ui;
    }
    PG8_WAIT_V(0);
    if (wr == 0) PG8_BAR;
    PG8_BAR;
#undef PG8_SA
#undef PG8_SB
#undef PG8_STAGE
#undef PG8_LDA
#undef PG8_LDB
#undef PG8_MMA
#undef PG8_WAIT_V
#undef PG8_WAIT_L
#undef PG8_BAR
#undef PG8_SCHED
#undef PG8_PA
#undef PG8_PB
}

struct EpiF32 {
    static constexpr bool PERM = false;
    float* C; int ldc; int row_base; size_t zstride;
    DEVI void operator()(const f32x4 (&acc)[2][2][4][2], const Unit& u, int wr, int wc, int fr, int fq) const {
        const int row0 = u.pm * BM + wr * 64 + fr - row_base, col0 = u.pn * BM + wc * 32 + 4 * fq;
#pragma unroll
        for (int ai = 0; ai < 2; ++ai)
#pragma unroll
            for (int m = 0; m < 4; ++m) { float* rowp = C + (size_t)u.z * zstride + (size_t)(row0 + ai * HALF + m * 16) * ldc + col0;
#pragma unroll
                for (int bj = 0; bj < 2; ++bj)
#pragma unroll
                    for (int n = 0; n < 2; ++n) *(f32x4*)(rowp + bj * HALF + n * 16) = acc[ai][bj][m][n]; }
    }
};
struct EpiBf16Y {
    static constexpr bool PERM = true;
    bf16_t* O; int ldc;
    DEVI void operator()(const f32x4 (&acc)[2][2][4][2], const Unit& u, int wr, int wc, int fr, int fq) const {
        const int row0 = u.pm * BM + wr * 64 + fr;
#pragma unroll
        for (int bj = 0; bj < 2; ++bj) { const int c0 = u.pn * BM + bj * HALF + wc * 32 + 8 * fq;
#pragma unroll
            for (int ai = 0; ai < 2; ++ai)
#pragma unroll
                for (int m = 0; m < 4; ++m) { float v[8];
#pragma unroll
                    for (int n = 0; n < 2; ++n)
#pragma unroll
                        for (int i = 0; i < 4; ++i) v[n * 4 + i] = acc[ai][bj][m][n][i];
                    *(u32x4*)(O + (size_t)(row0 + ai * HALF + m * 16) * ldc + c0) = pack8(v); } }
    }
};
struct EpiAtomic {
    static constexpr bool PERM = false;
    float* C; int ldc; int row_base;
    DEVI void operator()(const f32x4 (&acc)[2][2][4][2], const Unit& u, int wr, int wc, int fr, int fq) const {
        const int row0 = u.pm * BM + wr * 64 + fr - row_base, col0 = u.pn * BM + wc * 32 + 4 * fq;
#pragma unroll
        for (int ai = 0; ai < 2; ++ai)
#pragma unroll
            for (int m = 0; m < 4; ++m) { float* rowp = C + (size_t)(row0 + ai * HALF + m * 16) * ldc + col0;
#pragma unroll
                for (int bj = 0; bj < 2; ++bj)
#pragma unroll
                    for (int n = 0; n < 2; ++n)
#pragma unroll
                        for (int e = 0; e < 4; ++e) __hip_atomic_fetch_add(rowp + bj * HALF + n * 16 + e, acc[ai][bj][m][n][e], __ATOMIC_RELAXED, __HIP_MEMORY_SCOPE_AGENT); }
    }
};
struct EpiSwiGLU {
    static constexpr bool PERM = false;
    bf16_t* O; int ldc;
    DEVI void operator()(const f32x4 (&acc)[2][2][4][2], const Unit& u, int wr, int wc, int fr, int fq) const {
        const int row0 = u.pm * BM + wr * 64 + fr, col0 = u.pn * 128 + wc * 32 + 8 * fq;
#pragma unroll
        for (int ai = 0; ai < 2; ++ai)
#pragma unroll
            for (int m = 0; m < 4; ++m) {
                float v[8];
#pragma unroll
                for (int bj = 0; bj < 2; ++bj)
#pragma unroll
                    for (int i = 0; i < 4; ++i) { const float gt = acc[ai][bj][m][0][i], up = acc[ai][bj][m][1][i]; v[bj * 4 + i] = silu(gt) * up; }
                *(u32x4*)(O + (size_t)(row0 + ai * HALF + m * 16) * ldc + col0) = pack8(v);
            }
    }
};
struct EpiInProj {
    static constexpr bool PERM = true;
    bf16_t* O; int ldc;
    DEVI void operator()(const f32x4 (&acc)[2][2][4][2], const Unit& u, int wr, int wc, int fr, int fq) const {
        const int row0 = u.pm * BM + wr * 64 + fr;
#pragma unroll
        for (int bj = 0; bj < 2; ++bj) {
            const int c0 = u.pn * BM + bj * HALF + wc * 32 + 8 * fq;
            int kind = 0;
            if (c0 >= C_MLO && c0 < C_MLG) kind = 1; else if (c0 >= C_LRY && c0 < C_DNQ) kind = 2; else if (c0 >= C_DNZ && c0 < C_DNBA) kind = 3; else if (c0 >= C_GATE) kind = 1;
#define INPROJ_STORE(FN) _Pragma("unroll") for (int ai = 0; ai < 2; ++ai) _Pragma("unroll") for (int m = 0; m < 4; ++m) { float v[8]; \
                _Pragma("unroll") for (int n = 0; n < 2; ++n) _Pragma("unroll") for (int i = 0; i < 4; ++i) { const float x = acc[ai][bj][m][n][i]; v[n * 4 + i] = FN; } \
                *(u32x4*)(O + (size_t)(row0 + ai * HALF + m * 16) * ldc + c0) = pack8(v); }
            if (kind == 0) { INPROJ_STORE(x) } else if (kind == 1) { INPROJ_STORE(sigm(x)) } else if (kind == 2) { INPROJ_STORE(gelu_t(x)) } else { INPROJ_STORE(silu(x)) }
#undef INPROJ_STORE
        }
    }
};
struct EpiBranch {
    static constexpr bool PERM = false;
    const bf16_t* P; bf16_t* T; bf16_t* U;
    DEVI void operator()(const f32x4 (&acc)[2][2][4][2], const Unit& u, int wr, int wc, int fr, int fq) const {
        const int row0 = u.pm * BM + wr * 64 + fr, col0 = u.pn * BM + wc * 32 + 4 * fq; const int z = u.z;
        bf16_t* dst = z < 2 ? T : U;
#pragma unroll
        for (int ai = 0; ai < 2; ++ai)
#pragma unroll
            for (int mh = 0; mh < 2; ++mh) {
                u32x2 gr[2][2][2], tv[2][2][2];
#pragma unroll
                for (int mm = 0; mm < 2; ++mm) { const size_t row = (size_t)(row0 + ai * HALF + (mh * 2 + mm) * 16);
#pragma unroll
                    for (int bj = 0; bj < 2; ++bj)
#pragma unroll
                        for (int n = 0; n < 2; ++n) { const int col = col0 + bj * HALF + n * 16;
                            gr[mm][bj][n] = *(const u32x2*)(P + row * DINP + C_GATE + z * D + col);
                            tv[mm][bj][n] = (u32x2){0u, 0u};
                            if (z > 0) tv[mm][bj][n] = *(const u32x2*)(T + row * D + col); } }
#pragma unroll
                for (int mm = 0; mm < 2; ++mm) { const size_t row = (size_t)(row0 + ai * HALF + (mh * 2 + mm) * 16);
#pragma unroll
                    for (int bj = 0; bj < 2; ++bj)
#pragma unroll
                        for (int n = 0; n < 2; ++n) { const int col = col0 + bj * HALF + n * 16;
                            const u32x2 g2 = gr[mm][bj][n], t2 = tv[mm][bj][n]; f32x4 a = acc[ai][bj][mh * 2 + mm][n];
                            a[0] = a[0] * __uint_as_float(g2[0] << 16) + __uint_as_float(t2[0] << 16); a[1] = a[1] * __uint_as_float(g2[0] & 0xffff0000u) + __uint_as_float(t2[0] & 0xffff0000u);
                            a[2] = a[2] * __uint_as_float(g2[1] << 16) + __uint_as_float(t2[1] << 16); a[3] = a[3] * __uint_as_float(g2[1] & 0xffff0000u) + __uint_as_float(t2[1] & 0xffff0000u);
                            u32x2 w; w[0] = pk2(a[0], a[1]); w[1] = pk2(a[2], a[3]); *(u32x2*)(dst + row * D + col) = w; } }
            }
    }
};
struct EpiBranchPart {
    static constexpr bool PERM = false;
    const bf16_t* P; float* PART;
    DEVI void operator()(const f32x4 (&acc)[2][2][4][2], const Unit& u, int wr, int wc, int fr, int fq) const {
        const int row0 = u.pm * BM + wr * 64 + fr, col0 = u.pn * BM + wc * 32 + 4 * fq; const int z = u.z;
#pragma unroll
        for (int ai = 0; ai < 2; ++ai)
#pragma unroll
            for (int mh = 0; mh < 2; ++mh) {
                u32x2 gr[2][2][2];
#pragma unroll
                for (int mm = 0; mm < 2; ++mm) { const size_t row = (size_t)(row0 + ai * HALF + (mh * 2 + mm) * 16);
#pragma unroll
                    for (int bj = 0; bj < 2; ++bj)
#pragma unroll
                        for (int n = 0; n < 2; ++n) gr[mm][bj][n] = *(const u32x2*)(P + row * DINP + C_GATE + z * D + col0 + bj * HALF + n * 16); }
#pragma unroll
                for (int mm = 0; mm < 2; ++mm) { const size_t row = (size_t)(row0 + ai * HALF + (mh * 2 + mm) * 16);
#pragma unroll
                    for (int bj = 0; bj < 2; ++bj)
#pragma unroll
                        for (int n = 0; n < 2; ++n) { const int col = col0 + bj * HALF + n * 16;
                            const u32x2 g2 = gr[mm][bj][n]; f32x4 a = acc[ai][bj][mh * 2 + mm][n];
                            a[0] *= __uint_as_float(g2[0] << 16); a[1] *= __uint_as_float(g2[0] & 0xffff0000u); a[2] *= __uint_as_float(g2[1] << 16); a[3] *= __uint_as_float(g2[1] & 0xffff0000u);
                            *(f32x4*)(PART + ((size_t)z * 1024 + (row - MLAT)) * D + col) = a; } }
            }
    }
};
}

DEVI int tok_row(bool gdn, int dir, int b, int c, int t) {
    if (c < 4) { int p = c * 64 + t; if (dir) p = 255 - p; return MLAT + b * 256 + p; }
    int p = (c - 4) * 64 + t; if (dir) p = 4095 - p;
    const int s = gdn ? ((p & 63) * 64 + (p >> 6)) : p;
    return b * 4096 + s;
}
DEVI int pos_row(bool gdn, int b, bool isctx, int p) {
    if (isctx) { if (p < 0 || p >= 256) return -1; return MLAT + b * 256 + p; }
    if (p < 0 || p >= 4096) return -1;
    const int s = gdn ? ((p & 63) * 64 + (p >> 6)) : p;
    return b * 4096 + s;
}
DEVI int dir_chunk(int dir, int j) { return dir ? (j < 4 ? 3 - j : 71 - j) : j; }

DEVI int gu_rowmap(int s) {
    const int n = s >= DFF ? 1 : 0, a = s - n * DFF, pn = a >> 7, r = a & 127, wc = r >> 5, fq = (r >> 3) & 3, bj = (r >> 2) & 1, i = r & 3;
    return 256 * pn + 128 * bj + 32 * wc + 16 * n + 4 * fq + i;
}
DEVI void cvt_tile(const float* src, int ldsrc, int Nvalid, int k0, int n0, bf16_t* dst, int lddst, int mode, float* buf, int lane) {
    f32x4 vv[16];
#pragma unroll
    for (int it = 0; it < 16; ++it) {
        const int row = it * 4 + (lane >> 4), c4 = (lane & 15) * 4;
        vv[it] = (f32x4){0.f, 0.f, 0.f, 0.f};
        if (n0 + c4 < Nvalid) vv[it] = *(const f32x4*)(src + (size_t)(k0 + row) * ldsrc + n0 + c4);
    }
#pragma unroll
    for (int it = 0; it < 16; ++it) {
        const int row = it * 4 + (lane >> 4), c4 = (lane & 15) * 4;
        float* bp = buf + row * 65 + c4; bp[0] = vv[it][0]; bp[1] = vv[it][1]; bp[2] = vv[it][2]; bp[3] = vv[it][3];
    }
    asm volatile("s_waitcnt lgkmcnt(0)" ::: "memory"); __builtin_amdgcn_wave_barrier();
#pragma unroll 2
    for (int it = 0; it < 8; ++it) {
        const int nc = it * 8 + (lane >> 3), kk = (lane & 7) * 8;
        float f[8];
#pragma unroll
        for (int e = 0; e < 8; ++e) f[e] = buf[(kk + e) * 65 + nc];
        const int drow = mode == 1 ? gu_rowmap(n0 + nc) : (n0 + nc);
        *(u32x4*)(dst + (size_t)drow * lddst + k0 + kk) = pack8(f);
    }
    asm volatile("s_waitcnt lgkmcnt(0)" ::: "memory"); __builtin_amdgcn_wave_barrier();
}
DEVI void convert_phase(const PW& pw0, int l, unsigned char* shm_in, int gwave, int nwaves, int wid, int lane) {
    const PW p{opq64(pw0.ws)};
    unsigned char* shm = opq(shm_in);
    float* buf = (float*)shm + wid * (64 * 65);
    unsigned char* ws = p.ws;
    for (int t = gwave; t < 6880; t += nwaves) {
        int r = t;
        if (r < 2816) { const int f = r / 1408; r -= f * 1408; const int kt = r / 88, ntl = r % 88;
            cvt_tile(pin(7) + ((size_t)(l * 2 + f)) * D * 2 * DFF, 2 * DFF, 2 * DFF, kt * 64, ntl * 64, (bf16_t*)(ws + WS_WGU + f * SZ_WGU), D, 1, buf, lane); continue; }
        r -= 2816;
        if (r < 1408) { const int f = r / 704; r -= f * 704; const int kt = r / 16, ntl = r % 16;
            cvt_tile(pin(8) + ((size_t)(l * 2 + f)) * DFF * D, D, D, kt * 64, ntl * 64, (bf16_t*)(ws + WS_WDN + f * SZ_WDN), DFF, 0, buf, lane); continue; }
        r -= 1408;
        if (r < 1984) { const int kt = r / 124, ntl = r % 124;
            cvt_tile(pin(9) + (size_t)l * D * C_END, C_END, C_END, kt * 64, ntl * 64, (bf16_t*)(ws + WS_WIN), D, 0, buf, lane); continue; }
        r -= 1984;
        if (r < 384) { const int n = r / 128; r -= n * 128; const int kt = r / 16, ntl = r % 16;
            cvt_tile(pin(23) + ((size_t)(l * 3 + n)) * 512 * D, D, D, kt * 64, ntl * 64, (bf16_t*)(ws + WS_WBR) + (size_t)n * D * 512, 512, 0, buf, lane); continue; }
        r -= 384;
        if (r < 256) { const int kt = r / 16, ntl = r % 16;
            cvt_tile(pin(24) + (size_t)l * D * D, D, D, kt * 64, ntl * 64, (bf16_t*)(ws + WS_WOUT), D, 0, buf, lane); continue; }
        r -= 256;
        { const int gate = r >> 4, dn = r & 15;
            cvt_tile(pin(gate ? 16 : 14) + ((size_t)l * 16 + dn) * 4096, 64, 64, 0, 0, (bf16_t*)(ws + WS_WLRU) + (size_t)(gate * 16 + dn) * 4096, 64, 0, buf, lane); }
    }
}

DEVI void mod_phase(const PW& pw0, unsigned char* shm_in, int wv) {
    const PW p{opq64(pw0.ws)};
    unsigned char* shm = opq(shm_in);
    float* sC = (float*)shm;
    float* red = sC + 5 * 1024;
    const int tid = MYTID;
    __syncthreads();
    for (int i = tid; i < 5 * 1024; i += 512) { const int v = i >> 10, k = i & 1023; const float x = v < 4 ? pin(1)[v * 1024 + k] : pin(3)[k]; sC[i] = silu(x); }
    __syncthreads();
    float* MOD = (float*)(p.ws + WS_MOD);
    const int cgp = tid & 15, is = tid >> 4;
    for (int task = blockIdx.x; task < DEPTH * 144; task += gridDim.x) {
        const int l = task / 144, col0 = (task % 144) * 64;
        float acc[5][4];
#pragma unroll
        for (int v = 0; v < 5; ++v)
#pragma unroll
            for (int e = 0; e < 4; ++e) acc[v][e] = 0.f;
        const float* wp = pin(4) + ((size_t)l * 1024 + is * 32) * 9216 + col0 + cgp * 4;
#pragma unroll 16
        for (int r = 0; r < 32; ++r) {
            const f32x4 w = *(const f32x4*)(wp + (size_t)r * 9216);
#pragma unroll
            for (int v = 0; v < 5; ++v) { const float s = sC[v * 1024 + is * 32 + r];
#pragma unroll
                for (int e = 0; e < 4; ++e) acc[v][e] += s * w[e]; }
        }
#pragma unroll
        for (int v = 0; v < 5; ++v)
#pragma unroll
            for (int e = 0; e < 4; ++e) red[tid * 20 + v * 4 + e] = acc[v][e];
        __syncthreads();
        if (tid < 320) { const int v = tid >> 6, c = tid & 63; float s = 0.f;
            for (int k = 0; k < 32; ++k) s += red[(k * 16 + (c >> 2)) * 20 + v * 4 + (c & 3)];
            MOD[((size_t)(l * 5 + v)) * 9216 + col0 + c] = s + pin(5)[(size_t)l * 9216 + col0 + c]; }
        __syncthreads();
    }
}

DEVI void rowwise_phase(const PW& pw0, int mode, int nrows, int l, int kgate, float coef, int gpost_i, int ln, int gpre_i, int kshift, int nzc, int gwave, int nwaves, int lane, int dry = 0) {
    const PW p{opq64(pw0.ws)};
      bf16_t* X = (bf16_t*)(p.ws + WS_X); bf16_t* Xw = dry ? (bf16_t*)(p.ws + WS_GN) : X; const float* Y0 = (const float*)(p.ws + WS_Y); const float* YC = (const float*)(p.ws + WS_GB); bf16_t* H = dry ? (bf16_t*)(p.ws + WS_GU) : (bf16_t*)(p.ws + WS_H);
    const float* MOD = (const float*)(p.ws + WS_MOD);
    const int co = lane * 4;
    u32x2 yq[4]; u32x2 xq[4];
#pragma unroll
    for (int i = 0; i < 4; ++i) { yq[i] = (u32x2){0u, 0u}; xq[i] = (u32x2){0u, 0u}; }
    if (mode != 0 && gwave < nrows && gwave < MLAT) {
#pragma unroll
        for (int i = 0; i < 4; ++i) { yq[i] = *(const u32x2*)((const bf16_t*)Y0 + (size_t)gwave * D + co + 256 * i); xq[i] = *(const u32x2*)(X + (size_t)gwave * D + co + 256 * i); }
    }
    for (int row = gwave; row < nrows; row += nwaves) {
        const int v = row < MLAT ? (row >> 12) : 4;
        f32x4 x[4], y[4];
        f32x4 pg[4], pm[4], qg[4], qa[4], qs[4];
        if (mode == 0) {
            const float* src = row < MLAT ? pin(0) + (size_t)row * D : pin(2) + (size_t)(row - MLAT) * D;
#pragma unroll
            for (int i = 0; i < 4; ++i) x[i] = *(const f32x4*)(src + co + 256 * i);
        {
            const float* gp = pin(6) + ((size_t)l * 6 + gpost_i) * D; const float* gt = MOD + ((size_t)(l * 5 + v) * 9 + kgate) * D;
            const float* gq = pin(6) + ((size_t)ln * 6 + gpre_i) * D; const float* sh = MOD + ((size_t)(ln * 5 + v) * 9 + kshift) * D; const float* sc = sh + D;
#pragma unroll
            for (int i = 0; i < 4; ++i) { pg[i] = *(const f32x4*)(gp + co + 256 * i); pm[i] = *(const f32x4*)(gt + co + 256 * i);
                qg[i] = *(const f32x4*)(gq + co + 256 * i); qa[i] = *(const f32x4*)(sh + co + 256 * i); qs[i] = *(const f32x4*)(sc + co + 256 * i); }
        }
        } else {
            if (row >= MLAT) {
                const float* Y = YC + (size_t)(row - MLAT) * D;
#pragma unroll
                for (int ih = 0; ih < 2; ++ih) {
                    f32x4 t[11][2];
#pragma unroll
                    for (int z = 0; z < 11; ++z)
#pragma unroll
                        for (int i2 = 0; i2 < 2; ++i2) t[z][i2] = z < nzc ? *(const f32x4*)(Y + (size_t)z * 1024 * D + co + 256 * (ih * 2 + i2)) : (f32x4){0.f, 0.f, 0.f, 0.f};
#pragma unroll
                    for (int i2 = 0; i2 < 2; ++i2) { f32x4 a = t[0][i2];
#pragma unroll
                        for (int z = 1; z < 11; ++z) a = a + t[z][i2];
                        y[ih * 2 + i2] = a; }
                }
#pragma unroll
                for (int i = 0; i < 4; ++i) { const u32x2 r3 = *(const u32x2*)(X + (size_t)row * D + co + 256 * i); x[i] = (f32x4){__uint_as_float(r3[0] << 16), __uint_as_float(r3[0] & 0xffff0000u), __uint_as_float(r3[1] << 16), __uint_as_float(r3[1] & 0xffff0000u)}; }
            } else {
#pragma unroll
                for (int i = 0; i < 4; ++i) { const u32x2 r2 = yq[i]; { const u32x2 r3 = xq[i]; x[i] = (f32x4){__uint_as_float(r3[0] << 16), __uint_as_float(r3[0] & 0xffff0000u), __uint_as_float(r3[1] << 16), __uint_as_float(r3[1] & 0xffff0000u)}; }
                    y[i] = (f32x4){__uint_as_float(r2[0] << 16), __uint_as_float(r2[0] & 0xffff0000u), __uint_as_float(r2[1] << 16), __uint_as_float(r2[1] & 0xffff0000u)}; }
            }
        {
            const float* gp = pin(6) + ((size_t)l * 6 + gpost_i) * D; const float* gt = MOD + ((size_t)(l * 5 + v) * 9 + kgate) * D;
            const float* gq = pin(6) + ((size_t)ln * 6 + gpre_i) * D; const float* sh = MOD + ((size_t)(ln * 5 + v) * 9 + kshift) * D; const float* sc = sh + D;
#pragma unroll
            for (int i = 0; i < 4; ++i) { pg[i] = *(const f32x4*)(gp + co + 256 * i); pm[i] = *(const f32x4*)(gt + co + 256 * i);
                qg[i] = *(const f32x4*)(gq + co + 256 * i); qa[i] = *(const f32x4*)(sh + co + 256 * i); qs[i] = *(const f32x4*)(sc + co + 256 * i); }
        }
            const int nxt = row + nwaves;
            if (nxt < nrows && nxt < MLAT) {
#pragma unroll
                for (int i = 0; i < 4; ++i) { yq[i] = *(const u32x2*)((const bf16_t*)Y0 + (size_t)nxt * D + co + 256 * i); xq[i] = *(const u32x2*)(X + (size_t)nxt * D + co + 256 * i); }
            }
            float ss = 0.f;
#pragma unroll
            for (int i = 0; i < 4; ++i) ss += y[i][0] * y[i][0] + y[i][1] * y[i][1] + y[i][2] * y[i][2] + y[i][3] * y[i][3];
            ss = wsum(ss); const float rs = rsqrtf(ss * (1.f / D) + EPS) * coef;
#pragma unroll
            for (int i = 0; i < 4; ++i) x[i] = x[i] + pm[i] * (y[i] * rs * pg[i]);
        }
        if (mode == 2) {
#pragma unroll
            for (int i = 0; i < 4; ++i) *(f32x4*)((float*)pin(25) + (size_t)row * D + co + 256 * i) = x[i];
            continue;
        }
#pragma unroll
        for (int i = 0; i < 4; ++i) { u32x2 w; w[0] = pk2(x[i][0], x[i][1]); w[1] = pk2(x[i][2], x[i][3]); *(u32x2*)(Xw + (size_t)row * D + co + 256 * i) = w; }
        float ss = 0.f;
#pragma unroll
        for (int i = 0; i < 4; ++i) ss += x[i][0] * x[i][0] + x[i][1] * x[i][1] + x[i][2] * x[i][2] + x[i][3] * x[i][3];
        ss = wsum(ss); const float rs = rsqrtf(ss * (1.f / D) + EPS);
#pragma unroll
        for (int i = 0; i < 4; ++i) { const f32x4 h = x[i] * rs * qg[i] * (qs[i] + 1.f) + qa[i]; u32x2 w; w[0] = pk2(h[0], h[1]); w[1] = pk2(h[2], h[3]);
            *(u32x2*)(H + (size_t)row * D + co + 256 * i) = w; }
    }
}

DEVI void gdn_load(const bf16_t* P, const float* convw, int b, int c, int h, int dir, int want, bf16_t* sQ, bf16_t* sK, bf16_t* sKT, bf16_t* sVT, int tid) {
    const bool isctx = c < 4;
#pragma unroll
    for (int r = 0; r < 6; ++r) {
        const int task = tid + 512 * r, seg = r >> 1, rem = task & 1023, t = rem >> 4, cgp = rem & 15;
        if (seg == 0 && !(want & 1)) continue;
        if (seg == 1 && !(want & 6)) continue;
        if (seg == 2 && !(want & 8)) continue;
        int p = (isctx ? c : c - 4) * 64 + t; if (dir) p = (isctx ? 255 : 4095) - p;
        const int ch = seg * 512 + h * 128 + cgp * 8;
        float a[8];
#pragma unroll
        for (int e = 0; e < 8; ++e) a[e] = 0.f;
#pragma unroll
        for (int j = 0; j < 4; ++j) {
            const int row = pos_row(true, b, isctx, p + j - 2);
            if (row >= 0) {
                const u32x4 raw = *(const u32x4*)(P + (size_t)row * DINP + C_DNQ + ch); float x[8]; unpack8(raw, x);
                const f32x4 w0 = *(const f32x4*)(convw + j * 1536 + ch), w1 = *(const f32x4*)(convw + j * 1536 + ch + 4);
                a[0] += w0[0] * x[0]; a[1] += w0[1] * x[1]; a[2] += w0[2] * x[2]; a[3] += w0[3] * x[3];
                a[4] += w1[0] * x[4]; a[5] += w1[1] * x[5]; a[6] += w1[2] * x[6]; a[7] += w1[3] * x[7];
            }
        }
        float ss = 0.f;
#pragma unroll
        for (int e = 0; e < 8; ++e) { a[e] = silu(a[e]); ss += a[e] * a[e]; }
        if (seg < 2) {
            ss += __shfl_xor(ss, 1, 64); ss += __shfl_xor(ss, 2, 64); ss += __shfl_xor(ss, 4, 64); ss += __shfl_xor(ss, 8, 64);
            float inv = rsqrtf(ss + EPS); if (seg == 0) inv *= 0.08838834764831845f;
#pragma unroll
            for (int e = 0; e < 8; ++e) a[e] *= inv;
        }
        if (seg == 0) *(u32x4*)(sQ + t * 136 + cgp * 8) = pack8(a);
        else if (seg == 1) {
            if (want & 2) *(u32x4*)(sK + t * 136 + cgp * 8) = pack8(a);
            if (want & 4) {
#pragma unroll
                for (int e = 0; e < 8; ++e) sKT[tix(cgp * 8 + e, t)] = (bf16_t)f2bf(a[e]); }
        } else {
#pragma unroll
            for (int e = 0; e < 8; ++e) sVT[tix(cgp * 8 + e, t)] = (bf16_t)f2bf(a[e]);
        }
    }
}
struct GdnRaw { u32x4 r[4][4]; float g; };
DEVI void gdn_ld_issue(const bf16_t* P, const float* gates, int b, int c, int h, int dir, int seg_lo, GdnRaw& R, int tid) {
    const bool isctx = c < 4;
#pragma unroll
    for (int tk = 0; tk < 4; ++tk) {
        const int r = seg_lo * 2 + tk, task = tid + 512 * r, seg = r >> 1, rem = task & 1023, t = rem >> 4, cgp = rem & 15;
        int p = (isctx ? c : c - 4) * 64 + t; if (dir) p = (isctx ? 255 : 4095) - p;
        const int ch = seg * 512 + h * 128 + cgp * 8;
#pragma unroll
        for (int j = 0; j < 4; ++j) { const int row = pos_row(true, b, isctx, p + j - 2); R.r[tk][j] = (u32x4){0u, 0u, 0u, 0u};
            if (row >= 0) R.r[tk][j] = *(const u32x4*)(P + (size_t)row * DINP + C_DNQ + ch); }
    }
    R.g = 0.f; if (tid < 257) R.g = gates[tid];
}
DEVI void gdn_ld_finish(const GdnRaw& R, const float* convw, int h, int seg_lo, int want, bf16_t* sQ, bf16_t* sK, bf16_t* sKT, bf16_t* sVT, float* sc, int tid) {
#pragma unroll
    for (int tk = 0; tk < 4; ++tk) {
        const int r = seg_lo * 2 + tk, task = tid + 512 * r, seg = r >> 1, rem = task & 1023, t = rem >> 4, cgp = rem & 15;
        const int ch = seg * 512 + h * 128 + cgp * 8;
        float a[8];
#pragma unroll
        for (int e = 0; e < 8; ++e) a[e] = 0.f;
#pragma unroll
        for (int j = 0; j < 4; ++j) {
            float x[8]; unpack8(R.r[tk][j], x);
            const f32x4 w0 = *(const f32x4*)(convw + j * 1536 + ch), w1 = *(const f32x4*)(convw + j * 1536 + ch + 4);
            a[0] += w0[0] * x[0]; a[1] += w0[1] * x[1]; a[2] += w0[2] * x[2]; a[3] += w0[3] * x[3];
            a[4] += w1[0] * x[4]; a[5] += w1[1] * x[5]; a[6] += w1[2] * x[6]; a[7] += w1[3] * x[7];
        }
        float ss = 0.f;
#pragma unroll
        for (int e = 0; e < 8; ++e) { a[e] = silu(a[e]); ss += a[e] * a[e]; }
        if (seg < 2) {
            ss += __shfl_xor(ss, 1, 64); ss += __shfl_xor(ss, 2, 64); ss += __shfl_xor(ss, 4, 64); ss += __shfl_xor(ss, 8, 64);
            float inv = rsqrtf(ss + EPS); if (seg == 0) inv *= 0.08838834764831845f;
#pragma unroll
            for (int e = 0; e < 8; ++e) a[e] *= inv;
        }
        if (seg == 0) *(u32x4*)(sQ + t * 136 + cgp * 8) = pack8(a);
        else if (seg == 1) {
            if (want & 2) *(u32x4*)(sK + t * 136 + cgp * 8) = pack8(a);
            if (want & 4) {
#pragma unroll
                for (int e = 0; e < 8; ++e) sKT[tix(cgp * 8 + e, t)] = (bf16_t)f2bf(a[e]); }
        } else {
#pragma unroll
            for (int e = 0; e < 8; ++e) sVT[tix(cgp * 8 + e, t)] = (bf16_t)f2bf(a[e]);
        }
    }
    if (tid < 257) sc[tid] = R.g;
}
DEVI void gdn_gates(const PW& p, const bf16_t* P, int l, int b, int c, int h, int dir, float* sc, int lane) {
    const int row = tok_row(true, dir, b, c, lane);
    const float bb = bf2f(P[(size_t)row * DINP + C_DNBA + dir * 4 + h]), aa = bf2f(P[(size_t)row * DINP + C_DNBA + 8 + dir * 4 + h]);
    const float beta = sigm(bb);
    const float g = -__expf(pin(20)[l * 8 + dir * 4 + h]) * softplus(aa + pin(21)[l * 8 + dir * 4 + h]);
    float G = g;
#pragma unroll
    for (int o = 1; o < 64; o <<= 1) { const float t = __shfl_up(G, o, 64); if (lane >= o) G += t; }
    const float GT = __shfl(G, 63, 64);
    sc[lane] = G; sc[64 + lane] = beta; sc[128 + lane] = __expf(G); sc[192 + lane] = __expf(GT - G); if (lane == 0) sc[256] = __expf(GT);
}

DEVI void gdn_prep_all(const PW& pw0, int l, int first, int G, unsigned char* shm_in, int wv) {
    GdnRaw R;
    if (first < 2176) { const PW p{opq64(pw0.ws)}; const int tid = MYTID; const int c = first % NCH, h = (first / NCH) & 3, b = (first / (NCH * 4)) & 3, dir = first / (NCH * 16);
        gdn_ld_issue((const bf16_t*)(p.ws + WS_P), (const float*)(p.ws + WS_GATES) + (size_t)first * 320, b, c, h, dir, 1, R, tid); }
#pragma unroll 1
    for (int item = first; item < 2176; item += G) {
    const PW p{opq64(pw0.ws)};
    unsigned char* shm = opq(shm_in);
    const int tid = MYTID, wid = __builtin_amdgcn_readfirstlane(tid >> 6), lane = tid & 63, fr = lane & 15, fq = lane >> 4;
    const bf16_t* P = (const bf16_t*)(p.ws + WS_P);
    const float* GATES = (const float*)(p.ws + WS_GATES);
    const int h = (item / NCH) & 3;
    bf16_t* sK = (bf16_t*)shm;
    bf16_t* sKT = (bf16_t*)(shm + 17408);
    bf16_t* sVT = (bf16_t*)(shm + 35840);
    float* sTm = (float*)(shm + 54272);
    bf16_t* sT1 = (bf16_t*)(shm + 71680);
    bf16_t* sT2 = (bf16_t*)(shm + 80896);
    bf16_t* sWT = (bf16_t*)(shm + 90112);
    bf16_t* sUT = (bf16_t*)(shm + 108544);
    float* sc = (float*)(shm + 126976);
    gdn_ld_finish(R, pin(19) + (size_t)l * 4 * 1536, h, 1, 2 | 4 | 8, nullptr, sK, sKT, sVT, sc, tid);
    __builtin_amdgcn_sched_barrier(0);
    { const int nxt = item + G; if (nxt < 2176) { const int c2 = nxt % NCH, h2 = (nxt / NCH) & 3, b2 = (nxt / (NCH * 4)) & 3, dir2 = nxt / (NCH * 16); gdn_ld_issue(P, GATES + (size_t)nxt * 320, b2, c2, h2, dir2, 1, R, opaque(tid)); } }
    __builtin_amdgcn_sched_barrier(0);
    lbar();
#pragma unroll
    for (int ti = 0; ti < 2; ++ti) {
        const int tile = wid * 2 + ti, mt = tile >> 2, nt = tile & 3;
        f32x4 acc = (f32x4){0.f, 0.f, 0.f, 0.f};
#pragma unroll
        for (int kk = 0; kk < 4; ++kk) acc = MFMA16(ldfrag(sK, 136, mt * 16, kk * 32, lane), ldfrag(sK, 136, nt * 16, kk * 32, lane), acc);
        const int s = nt * 16 + fr;
#pragma unroll
        for (int j = 0; j < 4; ++j) { const int t = mt * 16 + fq * 4 + j; sTm[t * 68 + s] = s < t ? sc[64 + t] * acc[j] * __expf(sc[t] - sc[s]) : 0.f; }
    }
    lbar();
    float* tmpY = (float*)sWT;
    if (wid < 4) {
        const int o = wid * 16, c = lane & 15;
        int lz; asm volatile("v_mov_b32 %0, 0" : "=v"(lz));
        const float* tm = sTm + lz;
        float x[16];
#pragma unroll
        for (int t = 0; t < 16; ++t) {
            float v = -sTm[(o + t) * 68 + o + c];
#pragma unroll
            for (int s4 = 0; s4 < (t + 3) / 4; ++s4) {
                const f32x4 a = *(const f32x4*)(tm + (o + t) * 68 + o + s4 * 4);
#pragma unroll
                for (int e = 0; e < 4; ++e) if (s4 * 4 + e < t) v -= a[e] * x[s4 * 4 + e];
            }
            x[t] = v;
        }
        asm volatile("s_waitcnt lgkmcnt(0)" ::: "memory");
        if (lane < 16) {
#pragma unroll
            for (int t = 0; t < 16; ++t) sTm[(o + t) * 68 + o + c] = x[t] + (t == c ? 1.f : 0.f);
        }
    }
    lbar();
    {
        const int blk = tid >> 8, r = (tid >> 4) & 15, c = tid & 15, ib = (blk ? 3 : 1) * 16, jb = ib - 16;
        float y = 0.f;
#pragma unroll
        for (int s2 = 0; s2 < 16; ++s2) y += sTm[(ib + r) * 68 + jb + s2] * sTm[(jb + s2) * 68 + jb + c];
        tmpY[blk * 272 + r * 17 + c] = y;
        lbar();
        float z = 0.f;
#pragma unroll
        for (int s2 = 0; s2 < 16; ++s2) z += sTm[(ib + r) * 68 + ib + s2] * tmpY[blk * 272 + s2 * 17 + c];
        sTm[(ib + r) * 68 + jb + c] = -z;
    }
    lbar();
    {
        float y[2];
#pragma unroll
        for (int u = 0; u < 2; ++u) { const int o = tid + 512 * u, r = o >> 5, c = o & 31; float a = 0.f;
#pragma unroll 8
            for (int s2 = 0; s2 < 32; ++s2) a += sTm[(32 + r) * 68 + s2] * sTm[s2 * 68 + c];
            y[u] = a; }
#pragma unroll
        for (int u = 0; u < 2; ++u) { const int o = tid + 512 * u, r = o >> 5, c = o & 31; tmpY[r * 33 + c] = y[u]; }
        lbar();
#pragma unroll
        for (int u = 0; u < 2; ++u) { const int o = tid + 512 * u, r = o >> 5, c = o & 31; float a = 0.f;
#pragma unroll 8
            for (int s2 = 0; s2 < 32; ++s2) a += sTm[(32 + r) * 68 + 32 + s2] * tmpY[s2 * 33 + c];
            y[u] = a; }
#pragma unroll
        for (int u = 0; u < 2; ++u) { const int o = tid + 512 * u, r = o >> 5, c = o & 31; sTm[(32 + r) * 68 + c] = -y[u]; }
    }
    lbar();
#pragma unroll
    for (int u = 0; u < 8; ++u) {
        const int o = tid + 512 * u, t = o >> 6, s2 = o & 63; const float xv = sTm[t * 68 + s2], bt = sc[64 + s2];
        sT1[t * 72 + s2] = (bf16_t)f2bf(xv * bt * sc[128 + s2]); sT2[t * 72 + s2] = (bf16_t)f2bf(xv * bt);
    }
    lbar();
    bf16_t* GW = (bf16_t*)(p.ws + WS_H) + (size_t)item * 64 * 128;
    bf16_t* GU = (bf16_t*)(p.ws + WS_GU) + (size_t)item * 64 * 128;
    {
        const int tid2 = opaque(tid), lane = tid2 & 63, fr = lane & 15, fq = lane >> 4;
        const int mt = wid;
#pragma unroll
        for (int nt = 0; nt < 4; ++nt) {
            f32x4 aw = (f32x4){0.f, 0.f, 0.f, 0.f}, au = aw;
#pragma unroll
            for (int kk = 0; kk < 2; ++kk) { aw = MFMA16(ldfragT(sKT, mt * 16, kk * 32, lane), ldfrag(sT1, 72, nt * 16, kk * 32, lane), aw);
                au = MFMA16(ldfragT(sVT, mt * 16, kk * 32, lane), ldfrag(sT2, 72, nt * 16, kk * 32, lane), au); }
            const int t = nt * 16 + fr, r0 = mt * 16 + fq * 4; const float dec = sc[192 + t];
            u32x2 w; w[0] = pk2(aw[0], aw[1]); w[1] = pk2(aw[2], aw[3]); *(u32x2*)(GW + t * 128 + r0) = w;
            w[0] = pk2(au[0], au[1]); w[1] = pk2(au[2], au[3]); *(u32x2*)(GU + t * 128 + r0) = w;
#pragma unroll
            for (int j = 0; j < 4; ++j) { sWT[tix(r0 + j, t)] = (bf16_t)f2bf(aw[j] * dec); sUT[tix(r0 + j, t)] = (bf16_t)f2bf(au[j] * dec); }
        }
    }
    lbar();
    bf16_t* GB = (bf16_t*)(p.ws + WS_GB) + (size_t)item * 128 * 128;
    bf16_t* GN = (bf16_t*)(p.ws + WS_GN) + (size_t)item * 128 * 128;
    {
        const int tid2 = opaque(tid), lane = tid2 & 63, fr = lane & 15, fq = lane >> 4;
        const int mt = wid;
#pragma unroll
        for (int nt = 0; nt < 8; ++nt) {
            f32x4 ab = (f32x4){0.f, 0.f, 0.f, 0.f}, an = ab;
#pragma unroll
            for (int kk = 0; kk < 2; ++kk) { ab = MFMA16(ldfragT(sWT, mt * 16, kk * 32, lane), ldfragT(sKT, nt * 16, kk * 32, lane), ab);
                an = MFMA16(ldfragT(sKT, mt * 16, kk * 32, lane), ldfragT(sUT, nt * 16, kk * 32, lane), an); }
            const int cc = nt * 16 + fr, r0 = mt * 16 + fq * 4;
            u32x2 w; w[0] = pk2(-ab[0], -ab[1]); w[1] = pk2(-ab[2], -ab[3]); *(u32x2*)(GB + cc * 128 + r0) = w;
            w[0] = pk2(an[0], an[1]); w[1] = pk2(an[2], an[3]); *(u32x2*)(GN + cc * 128 + r0) = w;
        }
    }
    if (tid == 0) ((float*)(p.ws + WS_SM + SM_GDEC))[item] = sc[256];
    lbar();
    }
}

DEVI void gdn_seq_unit(const PW& pw0, int unit, unsigned char* shm_in, int wv) {
    const PW p{opq64(pw0.ws)};
    unsigned char* shm = opq(shm_in);
    const int tid = MYTID, wid = __builtin_amdgcn_readfirstlane(tid >> 6), lane = tid & 63, fr = lane & 15, fq = lane >> 4;
    const int chain = unit >> 3, es = unit & 7;
    bf16_t* sS = (bf16_t*)shm;
    const bf16_t* GB = (const bf16_t*)(p.ws + WS_GB) + (size_t)chain * NCH * 16384;
    bf16_t* GN = (bf16_t*)(p.ws + WS_GN) + (size_t)chain * NCH * 16384;
    const float* GDEC = (const float*)(p.ws + WS_SM + SM_GDEC) + chain * NCH;
    f32x4 acc = (f32x4){0.f, 0.f, 0.f, 0.f};
    constexpr int PF = 4;
    bf16x8 an[PF][4]; u32x2 nn[PF]; float dn[PF];
    const size_t aoff = (size_t)(wid * 16 + fr) * 128 + fq * 8, noff = (size_t)(es * 16 + fr) * 128 + wid * 16 + fq * 4;
#pragma unroll
    for (int u = 0; u < PF; ++u) {
#pragma unroll
        for (int kk = 0; kk < 4; ++kk) an[u][kk] = *(const bf16x8*)(GB + (size_t)u * 16384 + aoff + kk * 32);
        nn[u] = *(const u32x2*)(GN + (size_t)u * 16384 + noff); dn[u] = GDEC[u];
    }
#pragma unroll 1
    for (int c0 = 0; c0 < NCH; c0 += PF) {
#pragma unroll
        for (int u = 0; u < PF; ++u) {
            const int c = c0 + u;
            bf16x8 a[4]; const u32x2 ncur = nn[u]; const float dcur = dn[u];
#pragma unroll
            for (int kk = 0; kk < 4; ++kk) a[kk] = an[u][kk];
            u32x2 sw; sw[0] = pk2(acc[0], acc[1]); sw[1] = pk2(acc[2], acc[3]);
            bf16_t* sb = sS + (c & 1) * (16 * 136);
            *(u32x2*)(sb + fr * 136 + wid * 16 + fq * 4) = sw;
            *(u32x2*)(GN + (size_t)c * 16384 + noff) = sw;
            if (c + PF < NCH) {
#pragma unroll
                for (int kk = 0; kk < 4; ++kk) an[u][kk] = *(const bf16x8*)(GB + (size_t)(c + PF) * 16384 + aoff + kk * 32);
                nn[u] = *(const u32x2*)(GN + (size_t)(c + PF) * 16384 + noff); dn[u] = GDEC[c + PF];
            }
            lbar();
            acc[0] = dcur * acc[0] + __uint_as_float(ncur[0] << 16); acc[1] = dcur * acc[1] + __uint_as_float(ncur[0] & 0xffff0000u);
            acc[2] = dcur * acc[2] + __uint_as_float(ncur[1] << 16); acc[3] = dcur * acc[3] + __uint_as_float(ncur[1] & 0xffff0000u);
#pragma unroll
            for (int kk = 0; kk < 4; ++kk) acc = MFMA16(a[kk], ldfrag(sb, 136, 0, kk * 32, lane), acc);
        }
    }
    lbar();
}

struct GdnOutRaw { GdnRaw L; u32x4 st[4]; u32x4 w[2]; u32x2 ur[4]; };
DEVI void gdn_out_issue(const PW& p, int item, int dir, GdnOutRaw& R, int tid) {
    const int lane = tid & 63, fr = lane & 15, fq = lane >> 4, wid = tid >> 6;
    const int j = item % NCH, h = (item / NCH) & 3, b = item / (NCH * 4);
    const int c = dir_chunk(dir, j);
    const int it2 = ((dir * 4 + b) * 4 + h) * NCH + c;
    gdn_ld_issue((const bf16_t*)(p.ws + WS_P), (const float*)(p.ws + WS_GATES) + (size_t)it2 * 320, b, c, h, dir, 0, R.L, tid);
    const bf16_t* GS = (const bf16_t*)(p.ws + WS_GN) + (size_t)it2 * 16384;
    const bf16_t* GW = (const bf16_t*)(p.ws + WS_H) + (size_t)it2 * 8192;
    const bf16_t* GU = (const bf16_t*)(p.ws + WS_GU) + (size_t)it2 * 8192;
#pragma unroll
    for (int r = 0; r < 4; ++r) { const int idx = tid + 512 * r, row = idx >> 4, cg8 = (idx & 15) * 8; R.st[r] = *(const u32x4*)(GS + row * 128 + cg8); }
#pragma unroll
    for (int r = 0; r < 2; ++r) { const int idx = tid + 512 * r, row = idx >> 4, cg8 = (idx & 15) * 8; R.w[r] = *(const u32x4*)(GW + row * 128 + cg8); }
#pragma unroll
    for (int nt = 0; nt < 4; ++nt) R.ur[nt] = *(const u32x2*)(GU + (nt * 16 + fr) * 128 + wid * 16 + fq * 4);
}
DEVI void gdn_out_all(const PW& pw0, int l, int first, int G, bool skipctx, unsigned char* shm_in, int wv) {
    const int dry = 0;
    GdnOutRaw R;
    int item = first;
    while (item < 1088 && skipctx && (item % NCH) < 4) item += G;
    if (item < 1088) { const PW p{opq64(pw0.ws)}; gdn_out_issue(p, item, 0, R, MYTID); }
#pragma unroll 1
    while (item < 1088) {
    int nitem = item + G;
    while (nitem < 1088 && skipctx && (nitem % NCH) < 4) nitem += G;
#pragma unroll 1
    for (int dir = 0; dir < 2; ++dir) {
        const PW p{opq64(pw0.ws)};
        unsigned char* shm = opq(shm_in);
        const int tid = MYTID, wid = __builtin_amdgcn_readfirstlane(tid >> 6), lane = tid & 63, fr = lane & 15, fq = lane >> 4;
        const int j = item % NCH, h = (item / NCH) & 3, b = item / (NCH * 4);
        bf16_t* P = (bf16_t*)(p.ws + WS_P);
        bf16_t* sQ = (bf16_t*)shm;
        bf16_t* sK = (bf16_t*)(shm + 17408);
        bf16_t* sST = (bf16_t*)(shm + 34816);
        bf16_t* sW = (bf16_t*)(shm + 69632);
        bf16_t* sVN = (bf16_t*)(shm + 87040);
        bf16_t* sA2 = (bf16_t*)(shm + 105472);
        float* sO = (float*)(shm + 114688);
        float* sc = (float*)(shm + 148480);
        gdn_ld_finish(R.L, pin(19) + (size_t)l * 4 * 1536, h, 0, 1 | 2, sQ, sK, nullptr, nullptr, sc, tid);
#pragma unroll
        for (int r = 0; r < 4; ++r) { const int idx = tid + 512 * r, row = idx >> 4, cg8 = (idx & 15) * 8; *(u32x4*)(sST + row * 136 + cg8) = R.st[r]; }
#pragma unroll
        for (int r = 0; r < 2; ++r) { const int idx = tid + 512 * r, row = idx >> 4, cg8 = (idx & 15) * 8; *(u32x4*)(sW + row * 136 + cg8) = R.w[r]; }
        u32x2 ur4[4];
#pragma unroll
        for (int nt = 0; nt < 4; ++nt) ur4[nt] = R.ur[nt];
        __builtin_amdgcn_sched_barrier(0);
        if (dir == 0) gdn_out_issue(p, item, 1, R, opaque(tid)); else if (nitem < 1088) gdn_out_issue(p, nitem, 0, R, opaque(tid));
        __builtin_amdgcn_sched_barrier(0);
        lbar();
        {
            const int mt = wid;
#pragma unroll
            for (int nt = 0; nt < 4; ++nt) {
                const u32x2 ur = ur4[nt];
                f32x4 a = (f32x4){0.f, 0.f, 0.f, 0.f};
#pragma unroll
                for (int kk = 0; kk < 4; ++kk) a = MFMA16(ldfrag(sST, 136, mt * 16, kk * 32, lane), ldfrag(sW, 136, nt * 16, kk * 32, lane), a);
                const int t = nt * 16 + fr, e0 = mt * 16 + fq * 4;
                sVN[(e0 + 0) * 72 + t] = (bf16_t)f2bf(__uint_as_float(ur[0] << 16) - a[0]); sVN[(e0 + 1) * 72 + t] = (bf16_t)f2bf(__uint_as_float(ur[0] & 0xffff0000u) - a[1]);
                sVN[(e0 + 2) * 72 + t] = (bf16_t)f2bf(__uint_as_float(ur[1] << 16) - a[2]); sVN[(e0 + 3) * 72 + t] = (bf16_t)f2bf(__uint_as_float(ur[1] & 0xffff0000u) - a[3]);
            }
#pragma unroll
            for (int ti = 0; ti < 2; ++ti) {
                const int tile = wid * 2 + ti, m2 = tile >> 2, n2 = tile & 3;
                f32x4 a = (f32x4){0.f, 0.f, 0.f, 0.f};
#pragma unroll
                for (int kk = 0; kk < 4; ++kk) a = MFMA16(ldfrag(sQ, 136, m2 * 16, kk * 32, lane), ldfrag(sK, 136, n2 * 16, kk * 32, lane), a);
                const int s = n2 * 16 + fr;
#pragma unroll
                for (int jj = 0; jj < 4; ++jj) { const int t = m2 * 16 + fq * 4 + jj; sA2[t * 72 + s] = (bf16_t)f2bf(s <= t ? a[jj] * __expf(sc[t] - sc[s]) : 0.f); }
            }
        }
        lbar();
        {
            const int nt = wid;
#pragma unroll
            for (int mt = 0; mt < 4; ++mt) {
                f32x4 a = (f32x4){0.f, 0.f, 0.f, 0.f};
#pragma unroll
                for (int kk = 0; kk < 4; ++kk) a = MFMA16(ldfrag(sQ, 136, mt * 16, kk * 32, lane), ldfrag(sST, 136, nt * 16, kk * 32, lane), a);
#pragma unroll
                for (int jj = 0; jj < 4; ++jj) a[jj] *= sc[128 + mt * 16 + fq * 4 + jj];
#pragma unroll
                for (int kk = 0; kk < 2; ++kk) a = MFMA16(ldfrag(sA2, 72, mt * 16, kk * 32, lane), ldfrag(sVN, 72, nt * 16, kk * 32, lane), a);
                const int e = nt * 16 + fr;
#pragma unroll
                for (int jj = 0; jj < 4; ++jj) { const int t = mt * 16 + fq * 4 + jj; const int i = dir ? 63 - t : t; if (dir) sO[i * 132 + e] += a[jj]; else sO[i * 132 + e] = a[jj]; }
            }
        }
        lbar();
    }
    {
        const PW p{opq64(pw0.ws)};
        unsigned char* shm = opq(shm_in);
        const int tid = MYTID;
        const int j = item % NCH, h = (item / NCH) & 3, b = item / (NCH * 4);
        bf16_t* P = (bf16_t*)(p.ws + WS_P);
        float* sO = (float*)(shm + 114688);
    {
        const int i = tid >> 3, e0 = (tid & 7) * 16;
        float v[16], ss = 0.f;
#pragma unroll
        for (int e = 0; e < 16; ++e) { v[e] = sO[i * 132 + e0 + e]; ss += v[e] * v[e]; }
        ss += __shfl_xor(ss, 1, 64); ss += __shfl_xor(ss, 2, 64); ss += __shfl_xor(ss, 4, 64);
        const float rs = rsqrtf(ss * (1.f / 128.f) + EPS);
        const int row = tok_row(true, 0, b, j, i);
        bf16_t* zp = P + (size_t)row * DINP + C_DNZ + h * 128 + e0;
        const float* g = pin(22) + l * 128 + e0;
#pragma unroll
        for (int half = 0; half < 2; ++half) {
            float z[8]; unpack8(*(const u32x4*)(zp + half * 8), z); float o[8];
#pragma unroll
            for (int e = 0; e < 8; ++e) o[e] = v[half * 8 + e] * rs * g[half * 8 + e] * z[e];
            bf16_t* zd = dry ? (bf16_t*)(p.ws + WS_GB) + (size_t)row * 512 + h * 128 + e0 : zp;
            *(u32x4*)(zd + half * 8) = pack8(o);
        }
    }
    lbar();
    }
    item = nitem;
    }
}

DEVI float ml_gates(const PW& p, const bf16_t* P, int l, int b, int c, int h, int dir, float* sc, int lane) {
    const int row = tok_row(false, dir, b, c, lane);
    const float ig = bf2f(P[(size_t)row * DINP + C_MLG + dir * 4 + h]) + pin(10)[l * 16 + dir * 4 + h];
    const float fg = bf2f(P[(size_t)row * DINP + C_MLG + (2 + dir) * 4 + h]) + pin(10)[l * 16 + (2 + dir) * 4 + h];
    float bb = logsig(fg);
#pragma unroll
    for (int o = 1; o < 64; o <<= 1) { const float t = __shfl_up(bb, o, 64); if (lane >= o) bb += t; }
    sc[lane] = bb; sc[64 + lane] = ig;
    return __shfl(bb, 63, 64);
}
struct MlPrepRaw { u32x4 k; u32x4 v[2]; float w[2]; float g; };
DEVI void ml_prep_issue(const PW& p, int item, MlPrepRaw& R, int tid) {
    const int c = item % NCH, h = (item / NCH) & 3, b = (item / (NCH * 4)) & 3, dir = item / (NCH * 16);
    const bf16_t* P = (const bf16_t*)(p.ws + WS_P);
    const float* gp = (const float*)(p.ws + WS_GATES) + (size_t)(2176 + item) * 320;
    { const int t = tid >> 3, cg8 = (tid & 7) * 8; const int row = tok_row(false, dir, b, c, t); R.k = *(const u32x4*)(P + (size_t)row * DINP + C_MLK + h * 64 + cg8); }
#pragma unroll
    for (int r = 0; r < 2; ++r) { const int idx = tid + 512 * r, t = idx >> 4, cg8 = (idx & 15) * 8; const int row = tok_row(false, dir, b, c, t);
        R.v[r] = *(const u32x4*)(P + (size_t)row * DINP + C_MLV + h * 128 + cg8); R.w[r] = gp[128 + t]; }
    R.g = gp[128 + (tid & 63)];
}
DEVI void ml_prep_all(const PW& pw0, int l, int first, int G, unsigned char* shm_in, int wv) {
    MlPrepRaw R;
    if (first < 2176) { const PW p{opq64(pw0.ws)}; ml_prep_issue(p, first, R, MYTID); }
#pragma unroll 1
    for (int item = first; item < 2176; item += G) {
    const PW p{opq64(pw0.ws)};
    unsigned char* shm = opq(shm_in);
    const int tid = MYTID, wid = __builtin_amdgcn_readfirstlane(tid >> 6), lane = tid & 63, fr = lane & 15, fq = lane >> 4;
    bf16_t* sKT = (bf16_t*)shm;
    bf16_t* sVT = (bf16_t*)(shm + 9216);
    float* sc = (float*)(shm + 27648);
    if (tid < 64) sc[128 + tid] = R.g;
    {
        const int t = tid >> 3, cg8 = (tid & 7) * 8;
        float x[8]; unpack8(R.k, x);
#pragma unroll
        for (int e = 0; e < 8; ++e) sKT[tix(cg8 + e, t)] = (bf16_t)f2bf(x[e]);
    }
#pragma unroll
    for (int r = 0; r < 2; ++r) {
        const int idx = tid + 512 * r, t = idx >> 4, cg8 = (idx & 15) * 8;
        float x[8]; unpack8(R.v[r], x); const float w = R.w[r];
#pragma unroll
        for (int e = 0; e < 8; ++e) sVT[tix(cg8 + e, t)] = (bf16_t)f2bf(x[e] * w);
    }
    __builtin_amdgcn_sched_barrier(0);
    if (item + G < 2176) ml_prep_issue(p, item + G, R, opaque(tid));
    __builtin_amdgcn_sched_barrier(0);
    lbar();
    float* KV = (float*)(p.ws + WS_Y) + (size_t)item * 8192;
    {
        const int nt = wid;
#pragma unroll
        for (int mt = 0; mt < 4; ++mt) {
            f32x4 a = (f32x4){0.f, 0.f, 0.f, 0.f};
#pragma unroll
            for (int kk = 0; kk < 2; ++kk) a = MFMA16(ldfragT(sKT, mt * 16, kk * 32, lane), ldfragT(sVT, nt * 16, kk * 32, lane), a);
            *(f32x4*)(KV + (nt * 16 + fr) * 64 + mt * 16 + fq * 4) = a;
        }
    }
    {
        const int d = tid >> 3, t0 = (tid & 7) * 8; float s = 0.f;
#pragma unroll
        for (int t = 0; t < 8; ++t) s += sc[128 + t0 + t] * bf2f(sKT[tix(d, t0 + t)]);
        s += __shfl_xor(s, 1, 64); s += __shfl_xor(s, 2, 64); s += __shfl_xor(s, 4, 64);
        if ((tid & 7) == 0) ((float*)(p.ws + WS_SM + SM_MN))[item * 64 + d] = s; }
    lbar();
    }
}
DEVI void ml_seq(const PW& pw0, int gtid, int nthreads) {
    const PW p{opq64(pw0.ws)};
    const float* MSC = (const float*)(p.ws + WS_SM + SM_MSC);
    float* MM = (float*)(p.ws + WS_SM + SM_MM);
    for (int g = gtid; g < 32 * 4096 + 32 * 32; g += nthreads) {
        const bool isn = g >= 32 * 4096; const int gg = isn ? g - 32 * 4096 : g;
        const int chain = isn ? gg >> 5 : gg >> 12, e2 = isn ? gg & 31 : gg & 4095;
        float* base = isn ? (float*)(p.ws + WS_SM + SM_MN) + (size_t)chain * NCH * 64 + e2 * 2 : (float*)(p.ws + WS_Y) + (size_t)chain * NCH * 8192 + e2 * 2;
        const int stride = isn ? 64 : 8192;
        float m = 0.f; f32x2 C = (f32x2){0.f, 0.f};
        for (int c0 = 0; c0 < NCH; c0 += 17) {
            f32x2 kv[17]; f32x2 sc[17];
#pragma unroll
            for (int u = 0; u < 17; ++u) { kv[u] = *(const f32x2*)(base + (size_t)(c0 + u) * stride); sc[u] = *(const f32x2*)(MSC + (chain * NCH + c0 + u) * 2); }
#pragma unroll
            for (int u = 0; u < 17; ++u) {
                *(f32x2*)(base + (size_t)(c0 + u) * stride) = C;
                if (!isn && e2 == 0) MM[chain * NCH + c0 + u] = m;
                const float mn = fmaxf(sc[u][0] + m, sc[u][1]);
                const float a = __expf(sc[u][0] + m - mn), s = __expf(sc[u][1] - mn);
                C = C * a + kv[u] * s; m = mn;
            }
        }
    }
}
struct MlOutRaw { u32x4 q, k, v[2]; f32x4 ct[4]; float gb, gi, gpm, m, n; };
DEVI void ml_out_issue(const PW& p, int item, int dir, MlOutRaw& R, int tid) {
    const int lane = tid & 63;
    const int j = item % NCH, h = (item / NCH) & 3, b = item / (NCH * 4);
    const int c = dir_chunk(dir, j);
    const int it2 = ((dir * 4 + b) * 4 + h) * NCH + c;
    const bf16_t* P = (const bf16_t*)(p.ws + WS_P);
    { const int t = tid >> 3, cg8 = (tid & 7) * 8; const int row = tok_row(false, dir, b, c, t);
      R.q = *(const u32x4*)(P + (size_t)row * DINP + C_MLQ + h * 64 + cg8); R.k = *(const u32x4*)(P + (size_t)row * DINP + C_MLK + h * 64 + cg8); }
#pragma unroll
    for (int r = 0; r < 2; ++r) { const int idx = tid + 512 * r, t = idx >> 4, cg8 = (idx & 15) * 8; const int row = tok_row(false, dir, b, c, t);
        R.v[r] = *(const u32x4*)(P + (size_t)row * DINP + C_MLV + h * 128 + cg8); }
    const float* CT = (const float*)(p.ws + WS_Y) + (size_t)it2 * 8192;
#pragma unroll
    for (int r = 0; r < 4; ++r) { const int idx = tid + 512 * r, e = idx >> 4, d4 = (idx & 15) * 4; R.ct[r] = *(const f32x4*)(CT + e * 64 + d4); }
    const float* gp = (const float*)(p.ws + WS_GATES) + (size_t)(2176 + it2) * 320;
    R.gb = gp[lane]; R.gi = gp[64 + lane]; R.gpm = gp[192 + lane];
    R.m = ((const float*)(p.ws + WS_SM + SM_MM))[it2]; R.n = ((const float*)(p.ws + WS_SM + SM_MN))[it2 * 64 + lane];
}
DEVI void ml_out_all(const PW& pw0, int l, int first, int G, bool skipctx, unsigned char* shm_in, int wv) {
    const int dry = 0;
    MlOutRaw R;
    int item = first;
    while (item < 1088 && skipctx && (item % NCH) < 4) item += G;
    if (item < 1088) { const PW p{opq64(pw0.ws)}; ml_out_issue(p, item, 0, R, MYTID); }
#pragma unroll 1
    while (item < 1088) {
    int nitem = item + G;
    while (nitem < 1088 && skipctx && (nitem % NCH) < 4) nitem += G;
#pragma unroll 1
    for (int dir = 0; dir < 2; ++dir) {
        const PW p{opq64(pw0.ws)};
        unsigned char* shm = opq(shm_in);
        const int tid = MYTID, wid = __builtin_amdgcn_readfirstlane(tid >> 6), lane = tid & 63, fr = lane & 15, fq = lane >> 4;
        bf16_t* sQ = (bf16_t*)shm;
        bf16_t* sK = (bf16_t*)(shm + 9216);
        bf16_t* sVT = (bf16_t*)(shm + 18432);
        bf16_t* sCT = (bf16_t*)(shm + 36864);
        bf16_t* sS = (bf16_t*)(shm + 55296);
        float* sO = (float*)(shm + 64512);
        float* sc = (float*)(shm + 98304);
        if (wid == 0) {
            const float m = R.m, bb = R.gb, pm = R.gpm;
            sc[lane] = bb; sc[64 + lane] = R.gi;
            const float mt = bb + fmaxf(m, pm);
            sc[128 + lane] = mt; sc[192 + lane] = __expf(bb + m - mt);
            sc[320 + lane] = R.n;
        }
        {
            const int t = tid >> 3, cg8 = (tid & 7) * 8;
            float x[8]; unpack8(R.q, x);
#pragma unroll
            for (int e = 0; e < 8; ++e) x[e] *= 0.125f;
            *(u32x4*)(sQ + t * 72 + cg8) = pack8(x);
            *(u32x4*)(sK + t * 72 + cg8) = R.k;
        }
#pragma unroll
        for (int r = 0; r < 2; ++r) {
            const int idx = tid + 512 * r, t = idx >> 4, cg8 = (idx & 15) * 8;
            float x[8]; unpack8(R.v[r], x);
#pragma unroll
            for (int e = 0; e < 8; ++e) sVT[tix(cg8 + e, t)] = (bf16_t)f2bf(x[e]);
        }
#pragma unroll
        for (int r = 0; r < 4; ++r) { const int idx = tid + 512 * r, e = idx >> 4, d4 = (idx & 15) * 4; const f32x4 v = R.ct[r];
            u32x2 w; w[0] = pk2(v[0], v[1]); w[1] = pk2(v[2], v[3]); *(u32x2*)(sCT + e * 72 + d4) = w; }
        __builtin_amdgcn_sched_barrier(0);
        if (dir == 0) ml_out_issue(p, item, 1, R, opaque(tid)); else if (nitem < 1088) ml_out_issue(p, nitem, 0, R, opaque(tid));
        __builtin_amdgcn_sched_barrier(0);
        lbar();
#pragma unroll
        for (int ti = 0; ti < 2; ++ti) {
            const int tile = wid * 2 + ti, m2 = tile >> 2, n2 = tile & 3;
            f32x4 a = (f32x4){0.f, 0.f, 0.f, 0.f};
#pragma unroll
            for (int kk = 0; kk < 2; ++kk) a = MFMA16(ldfrag(sQ, 72, m2 * 16, kk * 32, lane), ldfrag(sK, 72, n2 * 16, kk * 32, lane), a);
            const int s = n2 * 16 + fr;
#pragma unroll
            for (int jj = 0; jj < 4; ++jj) { const int t = m2 * 16 + fq * 4 + jj;
                sS[t * 72 + s] = (bf16_t)f2bf(s <= t ? a[jj] * __expf(sc[t] - sc[s] + sc[64 + s] - sc[128 + t]) : 0.f); }
        }
        lbar();
        {
            const int t = tid >> 3, s0 = (tid & 7) * 8; float ds = 0.f, qn = 0.f;
#pragma unroll
            for (int s2 = 0; s2 < 8; ++s2) { ds += bf2f(sS[t * 72 + s0 + s2]); qn += bf2f(sQ[t * 72 + s0 + s2]) * sc[320 + s0 + s2]; }
            ds += __shfl_xor(ds, 1, 64); ds += __shfl_xor(ds, 2, 64); ds += __shfl_xor(ds, 4, 64);
            qn += __shfl_xor(qn, 1, 64); qn += __shfl_xor(qn, 2, 64); qn += __shfl_xor(qn, 4, 64);
            const float den = ds + sc[192 + t] * qn;
            if ((tid & 7) == 0) sc[256 + t] = 1.f / fmaxf(fabsf(den), __expf(-sc[128 + t]));
        }
        lbar();
        {
            const int nt = wid;
#pragma unroll
            for (int mt = 0; mt < 4; ++mt) {
                f32x4 a = (f32x4){0.f, 0.f, 0.f, 0.f};
#pragma unroll
                for (int kk = 0; kk < 2; ++kk) a = MFMA16(ldfrag(sQ, 72, mt * 16, kk * 32, lane), ldfrag(sCT, 72, nt * 16, kk * 32, lane), a);
#pragma unroll
                for (int jj = 0; jj < 4; ++jj) a[jj] *= sc[192 + mt * 16 + fq * 4 + jj];
#pragma unroll
                for (int kk = 0; kk < 2; ++kk) a = MFMA16(ldfrag(sS, 72, mt * 16, kk * 32, lane), ldfragT(sVT, nt * 16, kk * 32, lane), a);
                const int e = nt * 16 + fr;
#pragma unroll
                for (int jj = 0; jj < 4; ++jj) { const int t = mt * 16 + fq * 4 + jj; const int i = dir ? 63 - t : t; const float hv = a[jj] * sc[256 + t];
                    if (dir) sO[i * 132 + e] += hv; else sO[i * 132 + e] = hv; }
            }
        }
        lbar();
    }
    {
        const PW p{opq64(pw0.ws)};
        unsigned char* shm = opq(shm_in);
        const int tid = MYTID;
        const int j = item % NCH, h = (item / NCH) & 3, b = item / (NCH * 4);
        bf16_t* P = (bf16_t*)(p.ws + WS_P);
        float* sO = (float*)(shm + 64512);
    {
        const int i = tid >> 3, e0 = (tid & 7) * 16;
        float v[16], ss = 0.f;
#pragma unroll
        for (int e = 0; e < 16; ++e) { v[e] = sO[i * 132 + e0 + e]; ss += v[e] * v[e]; }
        ss += __shfl_xor(ss, 1, 64); ss += __shfl_xor(ss, 2, 64); ss += __shfl_xor(ss, 4, 64);
        const float rs = rsqrtf(ss * (1.f / 128.f) + EPS);
        const int row = tok_row(false, 0, b, j, i);
        bf16_t* op = P + (size_t)row * DINP + C_MLO + h * 128 + e0;
        const float* g = pin(11) + l * 512 + h * 128 + e0;
#pragma unroll
        for (int half = 0; half < 2; ++half) {
            float z[8]; unpack8(*(const u32x4*)(op + half * 8), z); float o[8];
#pragma unroll
            for (int e = 0; e < 8; ++e) o[e] = v[half * 8 + e] * rs * g[half * 8 + e] * z[e];
            bf16_t* od = dry ? (bf16_t*)(p.ws + WS_GB) + (size_t)row * 512 + h * 128 + e0 : op;
            *(u32x4*)(od + half * 8) = pack8(o);
        }
    }
    lbar();
    }
    item = nitem;
    }
}

DEVI void lru_item(const PW& pw0, int l, int item, int mode, unsigned char* shm_in, int wv, int dry = 0) {
    const PW p{opq64(pw0.ws)};
    unsigned char* shm = opq(shm_in);
    const int tid = MYTID, wid = __builtin_amdgcn_readfirstlane(tid >> 6), lane = tid & 63, fr = lane & 15, fq = lane >> 4;
    const int half = item & 1, j = (item >> 1) % NCH, b = (item >> 1) / NCH; const bool isctx = j < 4;
    bf16_t* P = (bf16_t*)(p.ws + WS_P);
    bf16_t* sX = (bf16_t*)shm;
    const int p0 = (isctx ? j : j - 4) * 64;
    const float* cw = pin(12) + (size_t)l * 4 * 512; const float* cb = pin(13) + (size_t)l * 512;
    {
        const int ch = lane * 8, i0 = wid * 8;
        f32x4 w[4][2];
#pragma unroll
        for (int jj = 0; jj < 4; ++jj) { w[jj][0] = *(const f32x4*)(cw + jj * 512 + ch); w[jj][1] = *(const f32x4*)(cw + jj * 512 + ch + 4); }
        const f32x4 b0 = *(const f32x4*)(cb + ch), b1 = *(const f32x4*)(cb + ch + 4);
        u32x4 raw[11];
#pragma unroll
        for (int r = 0; r < 11; ++r) { const int row = pos_row(false, b, isctx, p0 + i0 + r - 2);
            raw[r] = (u32x4){0u, 0u, 0u, 0u}; if (row >= 0) raw[r] = *(const u32x4*)(P + (size_t)row * DINP + C_LRX + ch); }
#pragma unroll
        for (int i = 0; i < 8; ++i) {
            float a[8] = {b0[0], b0[1], b0[2], b0[3], b1[0], b1[1], b1[2], b1[3]};
#pragma unroll
            for (int jj = 0; jj < 4; ++jj) { float x[8]; unpack8(raw[i + jj], x);
#pragma unroll
                for (int e = 0; e < 4; ++e) { a[e] += w[jj][0][e] * x[e]; a[4 + e] += w[jj][1][e] * x[4 + e]; } }
            *(u32x4*)(sX + (i0 + i) * 520 + ch) = pack8(a);
        }
    }
    lbar();
    const int blk = wid;
    const bf16_t* WL = (const bf16_t*)(p.ws + WS_WLRU);
    float* LAGG = (float*)(p.ws + WS_SM + SM_LAGG);
#pragma unroll 1
    for (int nn = 0; nn < 2; ++nn) {
        const int n4 = half * 2 + nn;
        const int ch = blk * 64 + n4 * 16 + fr;
        float hsum[4][4];
#pragma unroll
        for (int mt = 0; mt < 4; ++mt)
#pragma unroll
            for (int jj = 0; jj < 4; ++jj) hsum[mt][jj] = 0.f;
#pragma unroll
        for (int dir = 0; dir < 2; ++dir) {
            const bf16_t* wa = WL + (size_t)(0 * 16 + dir * 8 + blk) * 4096 + (n4 * 16 + fr) * 64 + fq * 8;
            const bf16_t* wx = WL + (size_t)(1 * 16 + dir * 8 + blk) * 4096 + (n4 * 16 + fr) * 64 + fq * 8;
            bf16x8 ba[2], bx[2];
#pragma unroll
            for (int kk = 0; kk < 2; ++kk) { ba[kk] = *(const bf16x8*)(wa + kk * 32); bx[kk] = *(const bf16x8*)(wx + kk * 32); }
            const int c = dir_chunk(dir, j);
            const size_t aidx = (((size_t)dir * 4 + b) * NCH + c) * 512 + ch;
            const float hin0 = mode ? LAGG[aidx * 2] : 0.f;
            const float bias_a = pin(15)[(size_t)l * 1024 + dir * 512 + ch], bias_x = pin(17)[(size_t)l * 1024 + dir * 512 + ch];
            const float cl = -8.f * softplus(-pin(18)[(size_t)l * 1024 + dir * 512 + ch]);
            float av[4][4], bv[4][4];
#pragma unroll
            for (int mt = 0; mt < 4; ++mt) {
                f32x4 aa = (f32x4){0.f, 0.f, 0.f, 0.f}, ax = aa;
#pragma unroll
                for (int kk = 0; kk < 2; ++kk) { const bf16x8 af = ldfrag(sX, 520, mt * 16, blk * 64 + kk * 32, lane); aa = MFMA16(af, ba[kk], aa); ax = MFMA16(af, bx[kk], ax); }
#pragma unroll
                for (int jj = 0; jj < 4; ++jj) {
                    const int t = mt * 16 + fq * 4 + jj;
                    const float rr = sigm(aa[jj] + bias_a), ii = sigm(ax[jj] + bias_x), la = cl * rr;
                    const float ea = __expf(la);
                    av[mt][jj] = ea;
                    bv[mt][jj] = __builtin_amdgcn_sqrtf(fmaxf(1.f - ea * ea, 0.f)) * ii * bf2f(sX[t * 520 + ch]);
                }
            }
            float hin = hin0;
            float Pc = 1.f, Hc = 0.f;
#pragma unroll
            for (int mi = 0; mi < 4; ++mi) {
                const int mt = dir ? 3 - mi : mi;
                float Pl = 1.f, Hl = 0.f;
#pragma unroll
                for (int ji = 0; ji < 4; ++ji) { const int jj = dir ? 3 - ji : ji; Pl = av[mt][jj] * Pl; Hl = av[mt][jj] * Hl + bv[mt][jj]; }
                float Pq[4], Hq[4];
#pragma unroll
                for (int q = 0; q < 4; ++q) { Pq[q] = __shfl(Pl, fr + 16 * q, 64); Hq[q] = __shfl(Hl, fr + 16 * q, 64); }
                if (mode == 0) {
#pragma unroll
                    for (int qi = 0; qi < 4; ++qi) { const int q = dir ? 3 - qi : qi; Hc = Pq[q] * Hc + Hq[q]; Pc = Pq[q] * Pc; }
                } else {
                    float hh = hin;
                    float hme = hin;
#pragma unroll
                    for (int qi = 0; qi < 4; ++qi) { const int q = dir ? 3 - qi : qi; if (q == fq) hme = hh; hh = Pq[q] * hh + Hq[q]; }
                    hin = hh;
#pragma unroll
                    for (int ji = 0; ji < 4; ++ji) { const int jj = dir ? 3 - ji : ji; hme = av[mt][jj] * hme + bv[mt][jj]; hsum[mt][jj] += hme; }
                }
            }
            if (mode == 0 && fq == 0) { LAGG[aidx * 2] = Pc; LAGG[aidx * 2 + 1] = Hc; }
        }
        if (mode == 1) {
#pragma unroll
            for (int mt = 0; mt < 4; ++mt)
#pragma unroll
                for (int jj = 0; jj < 4; ++jj) { const int i = mt * 16 + fq * 4 + jj; const int row = pos_row(false, b, isctx, p0 + i);
                    hsum[mt][jj] *= bf2f(P[(size_t)row * DINP + C_LRY + ch]); }
#pragma unroll
            for (int mt = 0; mt < 4; ++mt)
#pragma unroll
                for (int jj = 0; jj < 4; ++jj) { const int i = mt * 16 + fq * 4 + jj; const int row = pos_row(false, b, isctx, p0 + i);
                    bf16_t* yp = P + (size_t)row * DINP + C_LRY + ch; bf16_t* yd = dry ? (bf16_t*)(p.ws + WS_GB) + (size_t)row * 512 + ch : yp; *yd = (bf16_t)f2bf(hsum[mt][jj]); }
        }
    }
    lbar();
}
DEVI void lru_seq(const PW& pw0, int gtid, int nthreads) {
    const PW p{opq64(pw0.ws)};
    float* LAGG = (float*)(p.ws + WS_SM + SM_LAGG);
    for (int g = gtid; g < 4096; g += nthreads) {
        const int ch = g & 511, db = g >> 9;
        float h = 0.f;
        for (int c0 = 0; c0 < NCH; c0 += 17) {
            f32x2 v[17];
#pragma unroll
            for (int u = 0; u < 17; ++u) v[u] = *(const f32x2*)(LAGG + (((size_t)db * NCH + c0 + u) * 512 + ch) * 2);
#pragma unroll
            for (int u = 0; u < 17; ++u) { LAGG[(((size_t)db * NCH + c0 + u) * 512 + ch) * 2] = h; h = v[u][0] * h + v[u][1]; }
        }
    }
}

DEVI void gate_phase(const PW& pw0, int l, int gwave, int nwaves, int lane) {
    const PW p{opq64(pw0.ws)};
    const bf16_t* P = (const bf16_t*)(p.ws + WS_P);
    float* GT = (float*)(p.ws + WS_GATES);
    for (int w = gwave; w < 4352; w += nwaves) {
        const int kind = w >= 2176 ? 1 : 0, item = kind ? w - 2176 : w;
        const int c = item % NCH, h = (item / NCH) & 3, b = (item / (NCH * 4)) & 3, dir = item / (NCH * 16);
        float* gp = GT + (size_t)(kind * 2176 + item) * 320;
        if (kind == 0) gdn_gates(p, P, l, b, c, h, dir, gp, lane);
        else {
            const int row = tok_row(false, dir, b, c, lane);
            const float ig = bf2f(P[(size_t)row * DINP + C_MLG + dir * 4 + h]) + pin(10)[l * 16 + dir * 4 + h];
            const float fg = bf2f(P[(size_t)row * DINP + C_MLG + (2 + dir) * 4 + h]) + pin(10)[l * 16 + (2 + dir) * 4 + h];
            float bb = logsig(fg);
#pragma unroll
            for (int o = 1; o < 64; o <<= 1) { const float t = __shfl_up(bb, o, 64); if (lane >= o) bb += t; }
            const float bT = __shfl(bb, 63, 64);
            const float lw = bT - bb + ig;
            const float Mc = wmax(lw);
            float pm = ig - bb;
#pragma unroll
            for (int o = 1; o < 64; o <<= 1) { const float t = __shfl_up(pm, o, 64); if (lane >= o) pm = fmaxf(pm, t); }
            gp[lane] = bb; gp[64 + lane] = ig; gp[128 + lane] = __expf(lw - Mc); gp[192 + lane] = pm;
            if (lane == 0) { float* msc = (float*)(p.ws + WS_SM + SM_MSC) + item * 2; msc[0] = bT; msc[1] = Mc; }
        }
    }
}

#define XB_TMO      128
#define XB_XCNT(j)  (256  + 64 * (j))
#define XB_XSUB(j)  (1280 + 64 * (j))
#define XB_XGEN(j)  (2304 + 64 * (j))
#define XB_TOP      3328
#define XB_TOPGEN   3392
#define XCD_BAR_WORDS 3456
#define XB_SPIN_CAP (1u << 22)
DEVI unsigned xb_ld(unsigned* p)              { return __hip_atomic_load(p, __ATOMIC_RELAXED, __HIP_MEMORY_SCOPE_AGENT); }
DEVI unsigned xb_add(unsigned* p, unsigned v) { return __hip_atomic_fetch_add(p, v, __ATOMIC_RELAXED, __HIP_MEMORY_SCOPE_AGENT); }
DEVI unsigned xb_xcc_id() { return (unsigned)__builtin_amdgcn_s_getreg((3 << 11) | 20) & 0xFu; }
#define XB_SPIN(cond, bar) do { unsigned _sp = 0; while (cond) { __builtin_amdgcn_s_sleep(1); \
    if ((++_sp & 255u) == 0u) { if (xb_ld(&(bar)[XB_TMO])) break; if (_sp > XB_SPIN_CAP) { atomicAdd(&(bar)[XB_TMO], 1u); break; } } } } while (0)
DEVI void xcd_barrier_complete(unsigned* bar, unsigned x, unsigned G, unsigned& nloc, unsigned& nx) {
    unsigned sum, cnt, mine, sp = 0u;
    for (;;) {
        sum = 0u; cnt = 0u; mine = 0u;
#pragma unroll
        for (unsigned j = 0; j < 16; ++j) { const unsigned c = xb_ld(&bar[XB_XCNT(j)]); sum += c; cnt += (c > 0u) ? 1u : 0u; mine = (j == x) ? c : mine; }
        if (sum == G) break;
        __builtin_amdgcn_s_sleep(1);
        if ((++sp & 255u) == 0u) { if (xb_ld(&bar[XB_TMO])) break; if (sp > XB_SPIN_CAP) { atomicAdd(&bar[XB_TMO], 1u); break; } }
    }
    nloc = mine > 0u ? mine : 1u; nx = cnt > 0u ? cnt : 1u;
}
DEVI void gsync(unsigned* bar, volatile LAS unsigned* st, int G, int wv) {
    asm volatile("s_waitcnt vmcnt(0)" ::: "memory");
    __syncthreads();
    const int ln = (int)__builtin_amdgcn_mbcnt_hi(~0u, __builtin_amdgcn_mbcnt_lo(~0u, 0u));
    if (wv == 0 && ln == 0) {
        __builtin_amdgcn_s_waitcnt(0);
        const unsigned x = xb_xcc_id();
        unsigned nloc = st[0], nx = st[1];
        if (nloc == 0u) { xcd_barrier_complete(bar, x, (unsigned)G, nloc, nx); st[0] = nloc; st[1] = nx; }
        const unsigned old = xb_add(&bar[XB_XSUB(x)], 1u);
        const unsigned gen = old / nloc;
        if (old + 1u == (gen + 1u) * nloc) {
            __builtin_amdgcn_fence(__ATOMIC_RELEASE, "agent");
            asm volatile("s_waitcnt vmcnt(0)" ::: "memory");
            const unsigned og = xb_add(&bar[XB_TOP], 1u);
            const unsigned tg = og / nx;
            if (og + 1u == (tg + 1u) * nx) xb_add(&bar[XB_TOPGEN], 1u);
            else XB_SPIN(xb_ld(&bar[XB_TOPGEN]) == tg, bar);
            __builtin_amdgcn_fence(__ATOMIC_ACQUIRE, "agent");
            xb_add(&bar[XB_XGEN(x)], 1u);
            asm volatile("s_waitcnt vmcnt(0)" ::: "memory");
        } else {
            XB_SPIN(xb_ld(&bar[XB_XGEN(x)]) == gen, bar);
            __builtin_amdgcn_fence(__ATOMIC_ACQUIRE, "agent");
            asm volatile("s_waitcnt vmcnt(0)" ::: "memory");
        }
    }
    __syncthreads();
}

__global__ void __launch_bounds__(512) mega(Params p) {
    extern __shared__ __attribute__((aligned(16))) unsigned char shm[];
    cg::grid_group grid = cg::this_grid();
    const int wv = __builtin_amdgcn_readfirstlane(threadIdx.x >> 6);
    const int G = gridDim.x, nwaves = G * 8, nthreads = G * 512;
#define TIDS const int tid = MYTID, wid = tid >> 6, lane = tid & 63, gwave = blockIdx.x * 8 + wid, gtid = blockIdx.x * 512 + tid; (void)gtid; (void)gwave; (void)lane;
    LAS unsigned char* lds = (LAS unsigned char*)shm;
#define WSQ unsigned char* ws = opq64(pw.ws); bf16_t* Hb = (bf16_t*)(ws + WS_H); bf16_t* Pb = (bf16_t*)(ws + WS_P); float* Yb = (float*)(ws + WS_Y); (void)Hb; (void)Pb; (void)Yb;

    const PW pw{p.ws};
    unsigned* bar = (unsigned*)p.ws;
    volatile LAS unsigned* xst = (volatile LAS unsigned*)((LAS unsigned char*)shm + (LDS_BYTES - 16));
    if (threadIdx.x == 0) { xst[0] = 0u; xst[1] = 0u; (void)xb_add(&bar[XB_XCNT(xb_xcc_id())], 1u); }
    __syncthreads();
    for (int rep = 0; rep < REP_CVT; ++rep) {
    mod_phase(pw, shm, wv);
    { TIDS convert_phase(pw, 0, shm, gwave, nwaves, wid, lane); }
    }
    grid.sync();
    { TIDS rowwise_phase(pw, 0, MTOT, 0, 0, 0.f, 0, 0, 0, 0, 0, gwave, nwaves, lane); }
    gsync(bar, xst, G, wv);

#pragma unroll 1
    for (int l = 0; l < DEPTH; ++l) {
        const bool last = l == DEPTH - 1;
#pragma unroll 1
        for (int f = 0; f < 2; ++f) {
            if (f == 1) {
                { WSQ pg8::Gemm g{Hb, (const bf16_t*)(ws + WS_WIN), 68, 31, D, D, 1, 0, 0, 0, 0, D, 0}; pg8::Order S; S.init(68, 31, 1, G, blockIdx.x);
                  pg8::EpiInProj E{Pb, DINP}; for (int rep = 0; rep < REP_GEMM; ++rep) pg8::gemm_phase(lds, g, S, E, wv); }
                gsync(bar, xst, G, wv);
                { TIDS gate_phase(pw, l, gwave, nwaves, lane); }
                gsync(bar, xst, G, wv);
#pragma unroll 1
                for (int rep2 = 0; rep2 < REP_PREPSEQ; ++rep2) {
#pragma unroll 1
                for (int rep = 0; rep < REP_PREP; ++rep)
                {
                    gdn_prep_all(pw, l, blockIdx.x, G, shm, wv);
                    ml_prep_all(pw, l, (blockIdx.x + G / 2) % G, G, shm, wv);
                    for (int it = (blockIdx.x + G / 4) % G; it < 544; it += G) for (int r3 = 0; r3 < REP_LRU0; ++r3) lru_item(pw, l, it, 0, shm, wv);
                }
                gsync(bar, xst, G, wv);
                for (int u = blockIdx.x; u < 256; u += G) gdn_seq_unit(pw, u, shm, wv);
                { TIDS ml_seq(pw, gtid, nthreads); }
                { TIDS lru_seq(pw, gtid, nthreads); }
                gsync(bar, xst, G, wv);
                }
                gdn_out_all(pw, l, blockIdx.x, G, last, shm, wv);
                ml_out_all(pw, l, (blockIdx.x + G / 4) % G, G, last, shm, wv);
                for (int it = (blockIdx.x + G / 2) % G; it < 544; it += G) { if (last && ((it >> 1) % NCH) < 4) continue; if (DRY_LO) lru_item(pw, l, it, 1, shm, wv, 1); lru_item(pw, l, it, 1, shm, wv); }
                gsync(bar, xst, G, wv);
                const int nM = last ? 64 : 68;
                { WSQ pg8::Gemm g{Pb, (const bf16_t*)(ws + WS_WBR), 64, 4, 512, DINP, 3, C_MLO, C_LRY, C_DNZ, D * 512, 512, 0}; pg8::Order S; S.init(64, 4, 3, G, blockIdx.x);
                  pg8::EpiBranch E{Pb, (bf16_t*)Yb, Hb}; for (int rep = 0; rep < REP_BR; ++rep) pg8::gemm_phase(lds, g, S, E, wv); }
                if (!last) { WSQ pg8::Gemm g{Pb, (const bf16_t*)(ws + WS_WBR), 4, 4, 512, DINP, 3, C_MLO, C_LRY, C_DNZ, D * 512, 512, 0}; pg8::Order S; S.init(4, 4, 3, G, G - 1 - blockIdx.x, 64, 1);
                  pg8::EpiBranchPart E{Pb, (float*)(ws + WS_GB + ((size_t)32 << 20))}; pg8::gemm_phase(lds, g, S, E, wv); }
                gsync(bar, xst, G, wv);
                { WSQ pg8::Gemm g{Hb, (const bf16_t*)(ws + WS_WOUT), 64, 4, D, D, 1, 0, 0, 0, 0, D, 0}; pg8::Order S; S.init(64, 4, 1, G, blockIdx.x);
                  pg8::EpiBf16Y E{(bf16_t*)Yb, D}; for (int rep = 0; rep < REP_GEMM; ++rep) pg8::gemm_phase(lds, g, S, E, wv); }
                if (!last) { WSQ pg8::Gemm g{Hb, (const bf16_t*)(ws + WS_WOUT), 4, 4, 256, D, 4, 0, 0, 0, 256, D, 256}; pg8::Order S; S.init(4, 4, 4, G, blockIdx.x, 64, 1);
                  pg8::Unit u0;
                  if (S.next(0, u0)) {
                      TIDS const float* PART = (const float*)(ws + WS_GB + ((size_t)32 << 20));
                      const int r = tid >> 1, hc = (tid & 1) * 128;
                      const size_t off = (size_t)((u0.pm - 64) * 256 + r) * D + u0.z * 256 + hc;
                      bf16_t* up = Hb + (size_t)(u0.pm * 256 + r) * D + u0.z * 256 + hc;
#pragma unroll 1
                      for (int cb = 0; cb < 128; cb += 32) {
                          f32x4 t[3][8];
#pragma unroll
                          for (int zz = 0; zz < 3; ++zz)
#pragma unroll
                              for (int q4 = 0; q4 < 8; ++q4) t[zz][q4] = *(const f32x4*)(PART + (size_t)zz * 1024 * D + off + cb + q4 * 4);
#pragma unroll
                          for (int q4 = 0; q4 < 8; q4 += 2) { const f32x4 a = t[0][q4] + t[1][q4] + t[2][q4], b2 = t[0][q4 + 1] + t[1][q4 + 1] + t[2][q4 + 1];
                              u32x4 w; w[0] = pk2(a[0], a[1]); w[1] = pk2(a[2], a[3]); w[2] = pk2(b2[0], b2[1]); w[3] = pk2(b2[2], b2[3]); *(u32x4*)(up + cb + q4 * 4) = w; }
                      }
                  }
                  asm volatile("s_waitcnt vmcnt(0)" ::: "memory"); __syncthreads();
                  pg8::EpiF32 E{(float*)(ws + WS_GB), D, MLAT, (size_t)1024 * D}; pg8::gemm_phase(lds, g, S, E, wv); }
                gsync(bar, xst, G, wv);
                { TIDS if (DRY_ROW) { rowwise_phase(pw, 1, nM * 256, l, 5, 1.f, 3, l, 4, 6, 4, gwave, nwaves, lane, 1); } rowwise_phase(pw, 1, nM * 256, l, 5, 1.f, 3, l, 4, 6, 4, gwave, nwaves, lane); }
                gsync(bar, xst, G, wv);
            }
            const int nM = (last && f == 1) ? 64 : 68;
            { WSQ pg8::Gemm g{Hb, (const bf16_t*)(ws + WS_WGU + f * SZ_WGU), nM, 22, D, D, 1, 0, 0, 0, 0, D, 0}; pg8::Order S; S.init(nM, 22, 1, G, blockIdx.x);
              pg8::EpiSwiGLU E{Pb, DFF}; for (int rep = 0; rep < REP_GU; ++rep) pg8::gemm_phase(lds, g, S, E, wv); }
            gsync(bar, xst, G, wv);
            { WSQ pg8::Gemm g{Pb, (const bf16_t*)(ws + WS_WDN + f * SZ_WDN), 64, 4, DFF, DFF, 1, 0, 0, 0, 0, DFF, 0}; pg8::Order S; S.init(64, 4, 1, G, blockIdx.x);
              pg8::EpiBf16Y E{(bf16_t*)Yb, D}; for (int rep = 0; rep < REP_DN; ++rep) pg8::gemm_phase(lds, g, S, E, wv); }
            if (nM == 68) { WSQ pg8::Gemm g{Pb, (const bf16_t*)(ws + WS_WDN + f * SZ_WDN), 4, 4, 256, DFF, 11, 0, 0, 0, 256, DFF, 256}; pg8::Order S; S.init(4, 4, 11, G, blockIdx.x, 64, 1);
              pg8::EpiF32 E{(float*)(ws + WS_GB), D, MLAT, (size_t)1024 * D}; for (int rep = 0; rep < REP_DNC; ++rep) pg8::gemm_phase(lds, g, S, E, wv); }
            gsync(bar, xst, G, wv);
            if (f == 0) { TIDS if (DRY_ROW) { rowwise_phase(pw, 1, nM * 256, l, 2, 0.5f, 1, l, 2, 3, 11, gwave, nwaves, lane, 1); } rowwise_phase(pw, 1, nM * 256, l, 2, 0.5f, 1, l, 2, 3, 11, gwave, nwaves, lane); }
            else if (!last) { { TIDS if (DRY_ROW) { rowwise_phase(pw, 1, nM * 256, l, 8, 0.5f, 5, l + 1, 0, 0, 11, gwave, nwaves, lane, 1); } rowwise_phase(pw, 1, nM * 256, l, 8, 0.5f, 5, l + 1, 0, 0, 11, gwave, nwaves, lane); } for (int rep = 0; rep < REP_CVT; ++rep) { TIDS convert_phase(pw, l + 1, shm, gwave, nwaves, wid, lane); } }
            else { TIDS rowwise_phase(pw, 2, MLAT, l, 8, 0.5f, 5, 0, 0, 0, 0, gwave, nwaves, lane); }
            gsync(bar, xst, G, wv);
        }
    }
}

extern "C" void kernel_launch(void* const* d_in, const int* in_sizes, int n_in, void* d_out, int out_size, void* d_ws, size_t ws_size, hipStream_t stream) {
    static int grid = 0;
    if (grid == 0) {
        if (n_in != 25 || ws_size < WS_END) { fprintf(stderr, "kernel_launch: unexpected n_in %d or ws_size %zu (need %zu)\n", n_in, ws_size, (size_t)WS_END); grid = -1; return; }
        int dev = 0, cus = 0, per_cu = 0;
        hipGetDevice(&dev); hipDeviceGetAttribute(&cus, hipDeviceAttributeMultiprocessorCount, dev);
        if (hipFuncSetAttribute((const void*)mega, hipFuncAttributeMaxDynamicSharedMemorySize, LDS_BYTES) != hipSuccess) { fprintf(stderr, "kernel_launch: hipFuncSetAttribute failed\n"); grid = -1; return; }
        if (hipOccupancyMaxActiveBlocksPerMultiprocessor(&per_cu, (const void*)mega, 512, LDS_BYTES) != hipSuccess || per_cu < 1) { fprintf(stderr, "kernel_launch: occupancy query failed (%d)\n", per_cu); per_cu = 1; }
        (void)hipGetLastError();
        grid = cus * per_cu;
    }
    if (grid < 0) return;
    if (hipMemsetAsync(d_ws, 0, 16384, stream) != hipSuccess) { fprintf(stderr, "kernel_launch: memset failed\n"); return; }
    Params p{};
    for (int i = 0; i < 25; ++i) p.in[i] = (const float*)d_in[i];
    p.out = (float*)d_out; p.ws = (unsigned char*)d_ws;
    void* args[] = {&p};
    hipError_t e = hipLaunchCooperativeKernel((const void*)mega, dim3(grid), dim3(512), args, LDS_BYTES, stream);
    if (e != hipSuccess) fprintf(stderr, "cooperative launch failed: %s (grid %d)\n", hipGetErrorString(e), grid);
}
```

```cpp
#include <hip/hip_runtime.h>
#include <hip/hip_cooperative_groups.h>
#include <cstdio>
namespace cg = cooperative_groups;

#define LAS __attribute__((address_space(3)))
#define DEVI __device__ __forceinline__
typedef unsigned short bf16_t;
typedef short bf16x8 __attribute__((ext_vector_type(8)));
typedef float f32x4 __attribute__((ext_vector_type(4)));
typedef float f32x2 __attribute__((ext_vector_type(2)));
typedef unsigned u32x4 __attribute__((ext_vector_type(4)));
typedef unsigned u32x2 __attribute__((ext_vector_type(2)));

constexpr int D = 1024, NBATCH = 4, SEQ = 4096, CTXL = 256, DEPTH = 4, DFF = 2816, DINP = 7936;
constexpr int MLAT = NBATCH * SEQ, MTOT = MLAT + NBATCH * CTXL;
constexpr int NCH = 68;
constexpr int C_MLQ = 0, C_MLK = 256, C_MLV = 512, C_MLO = 1024, C_MLG = 1536, C_LRX = 1552, C_LRY = 2064,
              C_DNQ = 2576, C_DNZ = 4112, C_DNBA = 4624, C_GATE = 4640, C_END = 7712;
constexpr float EPS = 1e-6f;

constexpr size_t SZ_WGU = (size_t)2 * DFF * D * 2, SZ_WDN = (size_t)D * DFF * 2;
constexpr size_t WS_MOD = 16384;
constexpr size_t WS_WGU = 1u << 20;
constexpr size_t WS_WDN = WS_WGU + 2 * SZ_WGU;
constexpr size_t WS_WIN = WS_WDN + 2 * SZ_WDN;
constexpr size_t WS_WBR = WS_WIN + (size_t)DINP * D * 2;
constexpr size_t WS_WOUT = WS_WBR + (size_t)3 * D * 512 * 2;
constexpr size_t WS_WLRU = WS_WOUT + (size_t)D * D * 2;
constexpr size_t WS_X = WS_WLRU + (size_t)32 * 64 * 64 * 2;
constexpr size_t WS_H = WS_X + (size_t)MTOT * D * 4;
constexpr size_t WS_Y = WS_H + (size_t)MTOT * D * 2;
constexpr size_t WS_P = WS_Y + (size_t)MTOT * D * 4;
constexpr size_t WS_GU = WS_P + (size_t)MTOT * DINP * 2;
constexpr size_t WS_GB = WS_GU + (size_t)2176 * 64 * 128 * 2;
constexpr size_t WS_GN = WS_GB + (size_t)2176 * 128 * 128 * 2;
constexpr size_t WS_SM = WS_GN + (size_t)2176 * 128 * 128 * 2;
constexpr size_t SM_GDEC = 0, SM_MN = 16384, SM_MSC = SM_MN + 2176 * 64 * 4, SM_MM = SM_MSC + 2176 * 8, SM_LAGG = SM_MM + 2176 * 4 + 1024;
constexpr size_t WS_YC = WS_SM + SM_LAGG + (size_t)2 * 4 * NCH * 512 * 2 * 4 + 4096;
constexpr size_t WS_GATES = WS_YC;
constexpr size_t WS_END = WS_GATES + (size_t)2 * 2176 * 320 * 4 + 4096;
constexpr int LDS_BYTES = 155648;
constexpr int REP_BR = 1, REP_GU = 1, REP_DN = 1, REP_DNC = 1, REP_GEMM = 1, DRY_ROW = 0, REP_PREP = 1, REP_PREPSEQ = 1, REP_CVT = 1, REP_GDNP = 1, REP_MLP = 1, REP_LRU0 = 1, DRY_GO = 0, DRY_MO = 0, DRY_LO = 0;

struct Params { const float* in[25]; float* out; unsigned char* ws; };
struct PW { unsigned char* ws; };

#define CAS __attribute__((address_space(4)))
DEVI const float* pin(int i) { const CAS char* k = (const CAS char*)__builtin_amdgcn_kernarg_segment_ptr(); return *(const float* const volatile CAS*)(k + 8 * i); }
DEVI int opaque(int v) { asm volatile("" : "+v"(v)); return v; }
DEVI unsigned char* opq(unsigned char* p) { unsigned v = (unsigned)(size_t)(LAS unsigned char*)p; asm volatile("" : "+s"(v)); return (unsigned char*)(LAS unsigned char*)(size_t)v; }
DEVI LAS unsigned char* opql(LAS unsigned char* p) { unsigned v = (unsigned)(size_t)p; asm volatile("" : "+s"(v)); return (LAS unsigned char*)(size_t)v; }
DEVI unsigned char* opq64(unsigned char* p) { unsigned long long v = (unsigned long long)p; asm volatile("" : "+s"(v)); return (unsigned char*)v; }
#define MYTID opaque(wv * 64 + (int)__builtin_amdgcn_mbcnt_hi(~0u, __builtin_amdgcn_mbcnt_lo(~0u, 0u)))
DEVI float bf2f(bf16_t v) { return __uint_as_float(((unsigned)v) << 16); }
DEVI unsigned f2bf(float f) { unsigned u = __float_as_uint(f); return (u + 0x7fffu + ((u >> 16) & 1u)) >> 16; }
DEVI unsigned pk2(float lo, float hi) { return f2bf(lo) | (f2bf(hi) << 16); }
DEVI float sigm(float x) { return __builtin_amdgcn_rcpf(1.f + __expf(-x)); }
DEVI float silu(float x) { return x * sigm(x); }
DEVI float softplus(float x) { return x > 20.f ? x : log1pf(__expf(x)); }
DEVI float logsig(float x) { return fminf(x, 0.f) - log1pf(__expf(-fabsf(x))); }
DEVI float gelu_t(float x) { float u = 0.7978845608f * (x + 0.044715f * x * x * x); float e = __expf(2.f * u); return x * (1.f - __builtin_amdgcn_rcpf(e + 1.f)); }
DEVI float wsum(float v) { for (int o = 32; o > 0; o >>= 1) v += __shfl_xor(v, o, 64); return v; }
DEVI float wmax(float v) { for (int o = 32; o > 0; o >>= 1) v = fmaxf(v, __shfl_xor(v, o, 64)); return v; }
DEVI void unpack8(u32x4 r, float* f) {
    f[0] = __uint_as_float(r[0] << 16); f[1] = __uint_as_float(r[0] & 0xffff0000u); f[2] = __uint_as_float(r[1] << 16); f[3] = __uint_as_float(r[1] & 0xffff0000u);
    f[4] = __uint_as_float(r[2] << 16); f[5] = __uint_as_float(r[2] & 0xffff0000u); f[6] = __uint_as_float(r[3] << 16); f[7] = __uint_as_float(r[3] & 0xffff0000u);
}
DEVI u32x4 pack8(const float* f) { u32x4 r; r[0] = pk2(f[0], f[1]); r[1] = pk2(f[2], f[3]); r[2] = pk2(f[4], f[5]); r[3] = pk2(f[6], f[7]); return r; }
DEVI bf16x8 ldfrag(const bf16_t* base, int ld, int row0, int k0, int lane) { return *(const bf16x8*)(base + (row0 + (lane & 15)) * ld + k0 + (lane >> 4) * 8); }
DEVI int tix(int row, int col) { return row * 72 + ((((col >> 3) + (row >> 3)) & 7) << 3) + (col & 7); }
DEVI bf16x8 ldfragT(const bf16_t* base, int row0, int k0, int lane) { const int r = row0 + (lane & 15), lg = (k0 >> 3) + (lane >> 4); return *(const bf16x8*)(base + r * 72 + (((lg + (r >> 3)) & 7) << 3)); }
DEVI void lbar() { asm volatile("s_waitcnt lgkmcnt(0)" ::: "memory"); __builtin_amdgcn_s_barrier(); asm volatile("" ::: "memory"); }
#define MFMA16(a, b, c) __builtin_amdgcn_mfma_f32_16x16x32_bf16(a, b, c, 0, 0, 0)

namespace pg8 {
constexpr int BM = 256, BK = 64, HALF = 128, HTB = HALF * BK * 2, NXCD = 8, WGM = 8;
DEVI int lds_byte(int r, int c) { const int st = (r >> 4) * 2 + (c >> 5), rr = r & 15, cc = c & 31, ob = rr * 64 + cc * 2; return st * 1024 + (ob ^ (((ob >> 9) & 1) << 5)); }
DEVI void stage_rc(int b, int& R, int& C) { const int st = b / 1024, sb = b % 1024, swz = sb ^ (((sb >> 9) & 1) << 5); R = (st >> 1) * 16 + swz / 64; C = (st & 1) * 32 + (swz % 64) / 2; }
DEVI int perm32(int rho) { const int n = rho >> 4, i = rho & 15; return 8 * (i >> 2) + 4 * n + (i & 3); }
struct Unit { int pm, pn, z; };
struct Gemm { const bf16_t* A; const bf16_t* Bt; int nM, nN, K, lda, nz, zA0, zA1, zA2, zB; int ldb, zAstep; };
struct Order {
    int nM, nN, nwg, G, c, nz, pm0, spread;
    DEVI void init(int nM_, int nN_, int nz_, int G_, int c_, int pm0_ = 0, int spread_ = 0) { nM = nM_; nN = nN_; nwg = nM * nN; G = G_; c = c_; nz = nz_; pm0 = pm0_; spread = spread_; }
    DEVI bool next(int i, Unit& u) const {
        int ti = i, z = 0; long L;
        if (spread) { L = (long)i * G + c; if (L >= (long)nwg * nz) return false; z = (int)(L / nwg); L -= (long)z * nwg; }
        else { if (nz == 3) { ti = i / 3; z = i - ti * 3; } L = (long)ti * G + c; if (L >= nwg) return false; }
        int wgid = (int)L; { const int q = nwg / NXCD, r = nwg % NXCD, xcd = wgid % NXCD, off = wgid / NXCD; wgid = (xcd < r ? xcd * (q + 1) : r * (q + 1) + (xcd - r) * q) + off; }
        const int nig = WGM * nN, gid = wgid / nig, fm = gid * WGM, gsz = (nM - fm) < WGM ? (nM - fm) : WGM;
        u.pm = pm0 + fm + ((wgid % nig) % gsz); u.pn = (wgid % nig) / gsz; u.z = z; return true;
    }
};

template <class Epi>
DEVI void gemm_phase(LAS unsigned char* lds_in, const Gemm g, const Order& S, const Epi& E, int wv) {
    LAS unsigned char* lds = opql(lds_in);
    const int tid = MYTID, wid = __builtin_amdgcn_readfirstlane(tid >> 6), lane = tid & 63, wr = wid >> 2, wc = wid & 3, fr = lane & 15, fq = lane >> 4;
    const int K = g.K, nt = K / BK, lda = g.lda, ldb = g.ldb;
    unsigned voffA[2], voffB[2];
#pragma unroll
    for (int i = 0; i < 2; ++i) { int R, C; stage_rc(tid * 16 + i * 8192, R, C); const int Rb = Epi::PERM ? ((R & ~31) + perm32(R & 31)) : R;
        voffA[i] = (unsigned)(R * lda + C) * 2u; voffB[i] = (unsigned)(Rb * ldb + C) * 2u; }
    const size_t kstep = (size_t)(BK * 2);
    const size_t hstepA = (size_t)HALF * lda * 2, hstepB = (size_t)HALF * ldb * 2;
    const unsigned ldsw = (unsigned)wid * 1024u;
    const int aoff = lds_byte(wr * 64 + fr, fq * 8), boff = lds_byte(wc * 32 + fr, fq * 8);
#define PG8_SA(b, h) (((b) * 2 + (h)) * HTB)
#define PG8_SB(b, h) ((4 + (b) * 2 + (h)) * HTB)
#define PG8_STAGE(bufoff, gbase, voff) do { _Pragma("unroll") for (int _i = 0; _i < 2; ++_i) \
        __builtin_amdgcn_global_load_lds((const unsigned*)((const char*)(gbase) + (voff)[_i]), (LAS unsigned*)(lds + (bufoff) + ldsw + _i * 8192), 16, 0, 0); } while (0)
#define PG8_LDA(dst, b, h) do { _Pragma("unroll") for (int m = 0; m < 4; ++m) _Pragma("unroll") for (int k = 0; k < 2; ++k) dst[m][k] = *(const LAS bf16x8*)(lds + PG8_SA(b, h) + aoff + m * 2048 + k * 1024); } while (0)
#define PG8_LDB(dst, b, h) do { _Pragma("unroll") for (int n = 0; n < 2; ++n) _Pragma("unroll") for (int k = 0; k < 2; ++k) dst[n][k] = *(const LAS bf16x8*)(lds + PG8_SB(b, h) + boff + n * 2048 + k * 1024); } while (0)
#define PG8_MMA(ai, bj, At, Bt) do { __builtin_amdgcn_s_setprio(1); _Pragma("unroll") for (int m = 0; m < 4; ++m) _Pragma("unroll") for (int n = 0; n < 2; ++n) _Pragma("unroll") for (int k = 0; k < 2; ++k) \
        acc[ai][bj][m][n] = __builtin_amdgcn_mfma_f32_16x16x32_bf16(Bt[n][k], At[m][k], acc[ai][bj][m][n], 0, 0, 0); __builtin_amdgcn_s_setprio(0); } while (0)
#define PG8_WAIT_V(n) asm volatile("s_waitcnt vmcnt(" #n ")" ::: "memory")
#define PG8_WAIT_L(n) asm volatile("s_waitcnt lgkmcnt(" #n ")" ::: "memory")
#define PG8_BAR __builtin_amdgcn_s_barrier()
#define PG8_SCHED __builtin_amdgcn_sched_barrier(0)
#define PG8_PA(u) ((const char*)g.A + ((size_t)(g.nz == 3 ? ((u).z == 0 ? g.zA0 : ((u).z == 1 ? g.zA1 : g.zA2)) : (u).z * g.zAstep) + (size_t)(u).pm * BM * lda) * 2)
#define PG8_PB(u) ((const char*)g.Bt + ((size_t)(u).z * g.zB + (size_t)(u).pn * BM * ldb) * 2)
    Unit cur, nxt; int ui = 0;
    if (!S.next(0, cur)) return;
    f32x4 acc[2][2][4][2];
#pragma unroll
    for (int a = 0; a < 2; ++a)
#pragma unroll
        for (int b = 0; b < 2; ++b)
#pragma unroll
            for (int m = 0; m < 4; ++m)
#pragma unroll
                for (int n = 0; n < 2; ++n) acc[a][b][m][n] = (f32x4){0.f, 0.f, 0.f, 0.f};
    bf16x8 At[4][2], B0[2][2], B1[2][2];
    const char* cA = PG8_PA(cur); const char* cB = PG8_PB(cur);
    PG8_STAGE(PG8_SB(0, 0), cB, voffB); PG8_STAGE(PG8_SA(0, 0), cA, voffA); PG8_STAGE(PG8_SB(0, 1), cB + hstepB, voffB); PG8_STAGE(PG8_SA(0, 1), cA + hstepA, voffA);
    if (wr == 1) PG8_BAR;
    PG8_WAIT_V(4); PG8_BAR;
    PG8_STAGE(PG8_SB(1, 0), cB + kstep, voffB); PG8_STAGE(PG8_SA(1, 0), cA + kstep, voffA); PG8_STAGE(PG8_SB(1, 1), cB + hstepB + kstep, voffB);
    PG8_WAIT_V(6); PG8_BAR;
    for (;;) {
        const bool has_next = S.next(ui + 1, nxt);
        const char* nA = has_next ? PG8_PA(nxt) : cA; const char* nB = has_next ? PG8_PB(nxt) : cB;
        for (int t = 0; t < nt; t += 2) {
            const bool last = (t == nt - 2);
            const char* a1 = cA + (size_t)(t + 1) * kstep;
            const char* a2 = last ? nA : cA + (size_t)(t + 2) * kstep; const char* b2 = last ? nB : cB + (size_t)(t + 2) * kstep;
            const char* a3 = a2 + kstep; const char* b3 = b2 + kstep;
            PG8_LDB(B0, 0, 0); PG8_SCHED; PG8_LDA(At, 0, 0); PG8_STAGE(PG8_SA(1, 1), a1 + hstepA, voffA);
            PG8_WAIT_L(8); PG8_BAR; PG8_WAIT_L(0); PG8_MMA(0, 0, At, B0); PG8_BAR; PG8_SCHED;
            PG8_LDB(B1, 0, 1); PG8_STAGE(PG8_SB(0, 0), b2, voffB);
            PG8_BAR; PG8_WAIT_L(0); PG8_MMA(0, 1, At, B1); PG8_BAR;
            PG8_LDA(At, 0, 1); PG8_STAGE(PG8_SA(0, 0), a2, voffA);
            PG8_BAR; PG8_WAIT_L(0); PG8_MMA(1, 0, At, B0); PG8_BAR; PG8_SCHED;
            PG8_STAGE(PG8_SB(0, 1), b2 + hstepB, voffB);
            PG8_WAIT_V(6); PG8_BAR; PG8_MMA(1, 1, At, B1); PG8_BAR;
            PG8_LDB(B0, 1, 0); PG8_SCHED; PG8_LDA(At, 1, 0); PG8_STAGE(PG8_SA(0, 1), a2 + hstepA, voffA);
            PG8_WAIT_L(8); PG8_BAR; PG8_WAIT_L(0); PG8_MMA(0, 0, At, B0); PG8_BAR; PG8_SCHED;
            PG8_LDB(B1, 1, 1); PG8_STAGE(PG8_SB(1, 0), b3, voffB);
            PG8_BAR; PG8_WAIT_L(0); PG8_MMA(0, 1, At, B1); PG8_BAR;
            PG8_LDA(At, 1, 1); PG8_STAGE(PG8_SA(1, 0), a3, voffA);
            PG8_BAR; PG8_WAIT_L(0); PG8_MMA(1, 0, At, B0); PG8_BAR; PG8_SCHED;
            PG8_STAGE(PG8_SB(1, 1), b3 + hstepB, voffB);
            PG8_WAIT_V(6); PG8_BAR; PG8_MMA(1, 1, At, B1); PG8_BAR;
        }
        E(acc, cur, wr, wc, fr, fq);
        if (!has_next) break;
#pragma unroll
        for (int a = 0; a < 2; ++a)
#pragma unroll
            for (int b = 0; b < 2; ++b)
#pragma unroll
                for (int m = 0; m < 4; ++m)
#pragma unroll
                    for (int n = 0; n < 2; ++n) acc[a][b][m][n] = (f32x4){0.f, 0.f, 0.f, 0.f};
        cur = nxt; cA = nA; cB = nB; ++ui;
    }
    PG8_WAIT_V(0);
    if (wr == 0) PG8_BAR;
    PG8_BAR;
#undef PG8_SA
#undef PG8_SB
#undef PG8_STAGE
#undef PG8_LDA
#undef PG8_LDB
#undef PG8_MMA
#undef PG8_WAIT_V
#undef PG8_WAIT_L
#undef PG8_BAR
#undef PG8_SCHED
#undef PG8_PA
#undef PG8_PB
}

struct EpiF32 {
    static constexpr bool PERM = false;
    float* C; int ldc; int row_base; size_t zstride;
    DEVI void operator()(const f32x4 (&acc)[2][2][4][2], const Unit& u, int wr, int wc, int fr, int fq) const {
        const int row0 = u.pm * BM + wr * 64 + fr - row_base, col0 = u.pn * BM + wc * 32 + 4 * fq;
#pragma unroll
        for (int ai = 0; ai < 2; ++ai)
#pragma unroll
            for (int m = 0; m < 4; ++m) { float* rowp = C + (size_t)u.z * zstride + (size_t)(row0 + ai * HALF + m * 16) * ldc + col0;
#pragma unroll
                for (int bj = 0; bj < 2; ++bj)
#pragma unroll
                    for (int n = 0; n < 2; ++n) *(f32x4*)(rowp + bj * HALF + n * 16) = acc[ai][bj][m][n]; }
    }
};
struct EpiBf16Y {
    static constexpr bool PERM = true;
    bf16_t* O; int ldc;
    DEVI void operator()(const f32x4 (&acc)[2][2][4][2], const Unit& u, int wr, int wc, int fr, int fq) const {
        const int row0 = u.pm * BM + wr * 64 + fr;
#pragma unroll
        for (int bj = 0; bj < 2; ++bj) { const int c0 = u.pn * BM + bj * HALF + wc * 32 + 8 * fq;
#pragma unroll
            for (int ai = 0; ai < 2; ++ai)
#pragma unroll
                for (int m = 0; m < 4; ++m) { float v[8];
#pragma unroll
                    for (int n = 0; n < 2; ++n)
#pragma unroll
                        for (int i = 0; i < 4; ++i) v[n * 4 + i] = acc[ai][bj][m][n][i];
                    *(u32x4*)(O + (size_t)(row0 + ai * HALF + m * 16) * ldc + c0) = pack8(v); } }
    }
};
struct EpiAtomic {
    static constexpr bool PERM = false;
    float* C; int ldc; int row_base;
    DEVI void operator()(const f32x4 (&acc)[2][2][4][2], const Unit& u, int wr, int wc, int fr, int fq) const {
        const int row0 = u.pm * BM + wr * 64 + fr - row_base, col0 = u.pn * BM + wc * 32 + 4 * fq;
#pragma unroll
        for (int ai = 0; ai < 2; ++ai)
#pragma unroll
            for (int m = 0; m < 4; ++m) { float* rowp = C + (size_t)(row0 + ai * HALF + m * 16) * ldc + col0;
#pragma unroll
                for (int bj = 0; bj < 2; ++bj)
#pragma unroll
                    for (int n = 0; n < 2; ++n)
#pragma unroll
                        for (int e = 0; e < 4; ++e) __hip_atomic_fetch_add(rowp + bj * HALF + n * 16 + e, acc[ai][bj][m][n][e], __ATOMIC_RELAXED, __HIP_MEMORY_SCOPE_AGENT); }
    }
};
struct EpiSwiGLU {
    static constexpr bool PERM = false;
    bf16_t* O; int ldc;
    DEVI void operator()(const f32x4 (&acc)[2][2][4][2], const Unit& u, int wr, int wc, int fr, int fq) const {
        const int row0 = u.pm * BM + wr * 64 + fr, col0 = u.pn * 128 + wc * 32 + 8 * fq;
#pragma unroll
        for (int ai = 0; ai < 2; ++ai)
#pragma unroll
            for (int m = 0; m < 4; ++m) {
                float v[8];
#pragma unroll
                for (int bj = 0; bj < 2; ++bj)
#pragma unroll
                    for (int i = 0; i < 4; ++i) { const float gt = acc[ai][bj][m][0][i], up = acc[ai][bj][m][1][i]; v[bj * 4 + i] = silu(gt) * up; }
                *(u32x4*)(O + (size_t)(row0 + ai * HALF + m * 16) * ldc + col0) = pack8(v);
            }
    }
};
struct EpiInProj {
    static constexpr bool PERM = true;
    bf16_t* O; int ldc;
    DEVI void operator()(const f32x4 (&acc)[2][2][4][2], const Unit& u, int wr, int wc, int fr, int fq) const {
        const int row0 = u.pm * BM + wr * 64 + fr;
#pragma unroll
        for (int bj = 0; bj < 2; ++bj) {
            const int c0 = u.pn * BM + bj * HALF + wc * 32 + 8 * fq;
            int kind = 0;
            if (c0 >= C_MLO && c0 < C_MLG) kind = 1; else if (c0 >= C_LRY && c0 < C_DNQ) kind = 2; else if (c0 >= C_DNZ && c0 < C_DNBA) kind = 3; else if (c0 >= C_GATE) kind = 1;
#define INPROJ_STORE(FN) _Pragma("unroll") for (int ai = 0; ai < 2; ++ai) _Pragma("unroll") for (int m = 0; m < 4; ++m) { float v[8]; \
                _Pragma("unroll") for (int n = 0; n < 2; ++n) _Pragma("unroll") for (int i = 0; i < 4; ++i) { const float x = acc[ai][bj][m][n][i]; v[n * 4 + i] = FN; } \
                *(u32x4*)(O + (size_t)(row0 + ai * HALF + m * 16) * ldc + c0) = pack8(v); }
            if (kind == 0) { INPROJ_STORE(x) } else if (kind == 1) { INPROJ_STORE(sigm(x)) } else if (kind == 2) { INPROJ_STORE(gelu_t(x)) } else { INPROJ_STORE(silu(x)) }
#undef INPROJ_STORE
        }
    }
};
struct EpiBranch {
    static constexpr bool PERM = false;
    const bf16_t* P; bf16_t* T; bf16_t* U;
    DEVI void operator()(const f32x4 (&acc)[2][2][4][2], const Unit& u, int wr, int wc, int fr, int fq) const {
        const int row0 = u.pm * BM + wr * 64 + fr, col0 = u.pn * BM + wc * 32 + 4 * fq; const int z = u.z;
        bf16_t* dst = z < 2 ? T : U;
#pragma unroll
        for (int ai = 0; ai < 2; ++ai)
#pragma unroll
            for (int mh = 0; mh < 2; ++mh) {
                u32x2 gr[2][2][2], tv[2][2][2];
#pragma unroll
                for (int mm = 0; mm < 2; ++mm) { const size_t row = (size_t)(row0 + ai * HALF + (mh * 2 + mm) * 16);
#pragma unroll
                    for (int bj = 0; bj < 2; ++bj)
#pragma unroll
                        for (int n = 0; n < 2; ++n) { const int col = col0 + bj * HALF + n * 16;
                            gr[mm][bj][n] = *(const u32x2*)(P + row * DINP + C_GATE + z * D + col);
                            tv[mm][bj][n] = (u32x2){0u, 0u};
                            if (z > 0) tv[mm][bj][n] = *(const u32x2*)(T + row * D + col); } }
#pragma unroll
                for (int mm = 0; mm < 2; ++mm) { const size_t row = (size_t)(row0 + ai * HALF + (mh * 2 + mm) * 16);
#pragma unroll
                    for (int bj = 0; bj < 2; ++bj)
#pragma unroll
                        for (int n = 0; n < 2; ++n) { const int col = col0 + bj * HALF + n * 16;
                            const u32x2 g2 = gr[mm][bj][n], t2 = tv[mm][bj][n]; f32x4 a = acc[ai][bj][mh * 2 + mm][n];
                            a[0] = a[0] * __uint_as_float(g2[0] << 16) + __uint_as_float(t2[0] << 16); a[1] = a[1] * __uint_as_float(g2[0] & 0xffff0000u) + __uint_as_float(t2[0] & 0xffff0000u);
                            a[2] = a[2] * __uint_as_float(g2[1] << 16) + __uint_as_float(t2[1] << 16); a[3] = a[3] * __uint_as_float(g2[1] & 0xffff0000u) + __uint_as_float(t2[1] & 0xffff0000u);
                            u32x2 w; w[0] = pk2(a[0], a[1]); w[1] = pk2(a[2], a[3]); *(u32x2*)(dst + row * D + col) = w; } }
            }
    }
};
struct EpiBranchPart {
    static constexpr bool PERM = false;
    const bf16_t* P; float* PART;
    DEVI void operator()(const f32x4 (&acc)[2][2][4][2], const Unit& u, int wr, int wc, int fr, int fq) const {
        const int row0 = u.pm * BM + wr * 64 + fr, col0 = u.pn * BM + wc * 32 + 4 * fq; const int z = u.z;
#pragma unroll
        for (int ai = 0; ai < 2; ++ai)
#pragma unroll
            for (int mh = 0; mh < 2; ++mh) {
                u32x2 gr[2][2][2];
#pragma unroll
                for (int mm = 0; mm < 2; ++mm) { const size_t row = (size_t)(row0 + ai * HALF + (mh * 2 + mm) * 16);
#pragma unroll
                    for (int bj = 0; bj < 2; ++bj)
#pragma unroll
                        for (int n = 0; n < 2; ++n) gr[mm][bj][n] = *(const u32x2*)(P + row * DINP + C_GATE + z * D + col0 + bj * HALF + n * 16); }
#pragma unroll
                for (int mm = 0; mm < 2; ++mm) { const size_t row = (size_t)(row0 + ai * HALF + (mh * 2 + mm) * 16);
#pragma unroll
                    for (int bj = 0; bj < 2; ++bj)
#pragma unroll
                        for (int n = 0; n < 2; ++n) { const int col = col0 + bj * HALF + n * 16;
                            const u32x2 g2 = gr[mm][bj][n]; f32x4 a = acc[ai][bj][mh * 2 + mm][n];
                            a[0] *= __uint_as_float(g2[0] << 16); a[1] *= __uint_as_float(g2[0] & 0xffff0000u); a[2] *= __uint_as_float(g2[1] << 16); a[3] *= __uint_as_float(g2[1] & 0xffff0000u);
                            *(f32x4*)(PART + ((size_t)z * 1024 + (row - MLAT)) * D + col) = a; } }
            }
    }
};
}

DEVI int tok_row(bool gdn, int dir, int b, int c, int t) {
    if (c < 4) { int p = c * 64 + t; if (dir) p = 255 - p; return MLAT + b * 256 + p; }
    int p = (c - 4) * 64 + t; if (dir) p = 4095 - p;
    const int s = gdn ? ((p & 63) * 64 + (p >> 6)) : p;
    return b * 4096 + s;
}
DEVI int pos_row(bool gdn, int b, bool isctx, int p) {
    if (isctx) { if (p < 0 || p >= 256) return -1; return MLAT + b * 256 + p; }
    if (p < 0 || p >= 4096) return -1;
    const int s = gdn ? ((p & 63) * 64 + (p >> 6)) : p;
    return b * 4096 + s;
}
DEVI int dir_chunk(int dir, int j) { return dir ? (j < 4 ? 3 - j : 71 - j) : j; }

DEVI int gu_rowmap(int s) {
    const int n = s >= DFF ? 1 : 0, a = s - n * DFF, pn = a >> 7, r = a & 127, wc = r >> 5, fq = (r >> 3) & 3, bj = (r >> 2) & 1, i = r & 3;
    return 256 * pn + 128 * bj + 32 * wc + 16 * n + 4 * fq + i;
}
DEVI void cvt_tile(const float* src, int ldsrc, int Nvalid, int k0, int n0, bf16_t* dst, int lddst, int mode, float* buf, int lane) {
    f32x4 vv[16];
#pragma unroll
    for (int it = 0; it < 16; ++it) {
        const int row = it * 4 + (lane >> 4), c4 = (lane & 15) * 4;
        vv[it] = (f32x4){0.f, 0.f, 0.f, 0.f};
        if (n0 + c4 < Nvalid) vv[it] = *(const f32x4*)(src + (size_t)(k0 + row) * ldsrc + n0 + c4);
    }
#pragma unroll
    for (int it = 0; it < 16; ++it) {
        const int row = it * 4 + (lane >> 4), c4 = (lane & 15) * 4;
        float* bp = buf + row * 65 + c4; bp[0] = vv[it][0]; bp[1] = vv[it][1]; bp[2] = vv[it][2]; bp[3] = vv[it][3];
    }
    asm volatile("s_waitcnt lgkmcnt(0)" ::: "memory"); __builtin_amdgcn_wave_barrier();
#pragma unroll 2
    for (int it = 0; it < 8; ++it) {
        const int nc = it * 8 + (lane >> 3), kk = (lane & 7) * 8;
        float f[8];
#pragma unroll
        for (int e = 0; e < 8; ++e) f[e] = buf[(kk + e) * 65 + nc];
        const int drow = mode == 1 ? gu_rowmap(n0 + nc) : (n0 + nc);
        *(u32x4*)(dst + (size_t)drow * lddst + k0 + kk) = pack8(f);
    }
    asm volatile("s_waitcnt lgkmcnt(0)" ::: "memory"); __builtin_amdgcn_wave_barrier();
}
DEVI void convert_phase(const PW& pw0, int l, unsigned char* shm_in, int gwave, int nwaves, int wid, int lane) {
    const PW p{opq64(pw0.ws)};
    unsigned char* shm = opq(shm_in);
    float* buf = (float*)shm + wid * (64 * 65);
    unsigned char* ws = p.ws;
    for (int t = gwave; t < 6880; t += nwaves) {
        int r = t;
        if (r < 2816) { const int f = r / 1408; r -= f * 1408; const int kt = r / 88, ntl = r % 88;
            cvt_tile(pin(7) + ((size_t)(l * 2 + f)) * D * 2 * DFF, 2 * DFF, 2 * DFF, kt * 64, ntl * 64, (bf16_t*)(ws + WS_WGU + f * SZ_WGU), D, 1, buf, lane); continue; }
        r -= 2816;
        if (r < 1408) { const int f = r / 704; r -= f * 704; const int kt = r / 16, ntl = r % 16;
            cvt_tile(pin(8) + ((size_t)(l * 2 + f)) * DFF * D, D, D, kt * 64, ntl * 64, (bf16_t*)(ws + WS_WDN + f * SZ_WDN), DFF, 0, buf, lane); continue; }
        r -= 1408;
        if (r < 1984) { const int kt = r / 124, ntl = r % 124;
            cvt_tile(pin(9) + (size_t)l * D * C_END, C_END, C_END, kt * 64, ntl * 64, (bf16_t*)(ws + WS_WIN), D, 0, buf, lane); continue; }
        r -= 1984;
        if (r < 384) { const int n = r / 128; r -= n * 128; const int kt = r / 16, ntl = r % 16;
            cvt_tile(pin(23) + ((size_t)(l * 3 + n)) * 512 * D, D, D, kt * 64, ntl * 64, (bf16_t*)(ws + WS_WBR) + (size_t)n * D * 512, 512, 0, buf, lane); continue; }
        r -= 384;
        if (r < 256) { const int kt = r / 16, ntl = r % 16;
            cvt_tile(pin(24) + (size_t)l * D * D, D, D, kt * 64, ntl * 64, (bf16_t*)(ws + WS_WOUT), D, 0, buf, lane); continue; }
        r -= 256;
        { const int gate = r >> 4, dn = r & 15;
            cvt_tile(pin(gate ? 16 : 14) + ((size_t)l * 16 + dn) * 4096, 64, 64, 0, 0, (bf16_t*)(ws + WS_WLRU) + (size_t)(gate * 16 + dn) * 4096, 64, 0, buf, lane); }
    }
}

DEVI void mod_phase(const PW& pw0, unsigned char* shm_in, int wv) {
    const PW p{opq64(pw0.ws)};
    unsigned char* shm = opq(shm_in);
    float* sC = (float*)shm;
    float* red = sC + 5 * 1024;
    const int tid = MYTID;
    __syncthreads();
    for (int i = tid; i < 5 * 1024; i += 512) { const int v = i >> 10, k = i & 1023; const float x = v < 4 ? pin(1)[v * 1024 + k] : pin(3)[k]; sC[i] = silu(x); }
    __syncthreads();
    float* MOD = (float*)(p.ws + WS_MOD);
    const int cgp = tid & 15, is = tid >> 4;
    for (int task = blockIdx.x; task < DEPTH * 144; task += gridDim.x) {
        const int l = task / 144, col0 = (task % 144) * 64;
        float acc[5][4];
#pragma unroll
        for (int v = 0; v < 5; ++v)
#pragma unroll
            for (int e = 0; e < 4; ++e) acc[v][e] = 0.f;
        const float* wp = pin(4) + ((size_t)l * 1024 + is * 32) * 9216 + col0 + cgp * 4;
#pragma unroll 16
        for (int r = 0; r < 32; ++r) {
            const f32x4 w = *(const f32x4*)(wp + (size_t)r * 9216);
#pragma unroll
            for (int v = 0; v < 5; ++v) { const float s = sC[v * 1024 + is * 32 + r];
#pragma unroll
                for (int e = 0; e < 4; ++e) acc[v][e] += s * w[e]; }
        }
#pragma unroll
        for (int v = 0; v < 5; ++v)
#pragma unroll
            for (int e = 0; e < 4; ++e) red[tid * 20 + v * 4 + e] = acc[v][e];
        __syncthreads();
        if (tid < 320) { const int v = tid >> 6, c = tid & 63; float s = 0.f;
            for (int k = 0; k < 32; ++k) s += red[(k * 16 + (c >> 2)) * 20 + v * 4 + (c & 3)];
            MOD[((size_t)(l * 5 + v)) * 9216 + col0 + c] = s + pin(5)[(size_t)l * 9216 + col0 + c]; }
        __syncthreads();
    }
}

DEVI void rowwise_phase(const PW& pw0, int mode, int nrows, int l, int kgate, float coef, int gpost_i, int ln, int gpre_i, int kshift, int nzc, int gwave, int nwaves, int lane, int dry = 0) {
    const PW p{opq64(pw0.ws)};
      bf16_t* X = (bf16_t*)(p.ws + WS_X); bf16_t* Xw = dry ? (bf16_t*)(p.ws + WS_GN) : X; const float* Y0 = (const float*)(p.ws + WS_Y); const float* YC = (const float*)(p.ws + WS_GB); bf16_t* H = dry ? (bf16_t*)(p.ws + WS_GU) : (bf16_t*)(p.ws + WS_H);
    const float* MOD = (const float*)(p.ws + WS_MOD);
    const int co = lane * 4;
    u32x2 yq[4]; u32x2 xq[4];
#pragma unroll
    for (int i = 0; i < 4; ++i) { yq[i] = (u32x2){0u, 0u}; xq[i] = (u32x2){0u, 0u}; }
    if (mode != 0 && gwave < nrows && gwave < MLAT) {
#pragma unroll
        for (int i = 0; i < 4; ++i) { yq[i] = *(const u32x2*)((const bf16_t*)Y0 + (size_t)gwave * D + co + 256 * i); xq[i] = *(const u32x2*)(X + (size_t)gwave * D + co + 256 * i); }
    }
    for (int row = gwave; row < nrows; row += nwaves) {
        const int v = row < MLAT ? (row >> 12) : 4;
        f32x4 x[4], y[4];
        f32x4 pg[4], pm[4], qg[4], qa[4], qs[4];
        if (mode == 0) {
            const float* src = row < MLAT ? pin(0) + (size_t)row * D : pin(2) + (size_t)(row - MLAT) * D;
#pragma unroll
            for (int i = 0; i < 4; ++i) x[i] = *(const f32x4*)(src + co + 256 * i);
        {
            const float* gp = pin(6) + ((size_t)l * 6 + gpost_i) * D; const float* gt = MOD + ((size_t)(l * 5 + v) * 9 + kgate) * D;
            const float* gq = pin(6) + ((size_t)ln * 6 + gpre_i) * D; const float* sh = MOD + ((size_t)(ln * 5 + v) * 9 + kshift) * D; const float* sc = sh + D;
#pragma unroll
            for (int i = 0; i < 4; ++i) { pg[i] = *(const f32x4*)(gp + co + 256 * i); pm[i] = *(const f32x4*)(gt + co + 256 * i);
                qg[i] = *(const f32x4*)(gq + co + 256 * i); qa[i] = *(const f32x4*)(sh + co + 256 * i); qs[i] = *(const f32x4*)(sc + co + 256 * i); }
        }
        } else {
            if (row >= MLAT) {
                const float* Y = YC + (size_t)(row - MLAT) * D;
#pragma unroll
                for (int ih = 0; ih < 2; ++ih) {
                    f32x4 t[11][2];
#pragma unroll
                    for (int z = 0; z < 11; ++z)
#pragma unroll
                        for (int i2 = 0; i2 < 2; ++i2) t[z][i2] = z < nzc ? *(const f32x4*)(Y + (size_t)z * 1024 * D + co + 256 * (ih * 2 + i2)) : (f32x4){0.f, 0.f, 0.f, 0.f};
#pragma unroll
                    for (int i2 = 0; i2 < 2; ++i2) { f32x4 a = t[0][i2];
#pragma unroll
                        for (int z = 1; z < 11; ++z) a = a + t[z][i2];
                        y[ih * 2 + i2] = a; }
                }
#pragma unroll
                for (int i = 0; i < 4; ++i) { const u32x2 r3 = *(const u32x2*)(X + (size_t)row * D + co + 256 * i); x[i] = (f32x4){__uint_as_float(r3[0] << 16), __uint_as_float(r3[0] & 0xffff0000u), __uint_as_float(r3[1] << 16), __uint_as_float(r3[1] & 0xffff0000u)}; }
            } else {
#pragma unroll
                for (int i = 0; i < 4; ++i) { const u32x2 r2 = yq[i]; { const u32x2 r3 = xq[i]; x[i] = (f32x4){__uint_as_float(r3[0] << 16), __uint_as_float(r3[0] & 0xffff0000u), __uint_as_float(r3[1] << 16), __uint_as_float(r3[1] & 0xffff0000u)}; }
                    y[i] = (f32x4){__uint_as_float(r2[0] << 16), __uint_as_float(r2[0] & 0xffff0000u), __uint_as_float(r2[1] << 16), __uint_as_float(r2[1] & 0xffff0000u)}; }
            }
        {
            const float* gp = pin(6) + ((size_t)l * 6 + gpost_i) * D; const float* gt = MOD + ((size_t)(l * 5 + v) * 9 + kgate) * D;
            const float* gq = pin(6) + ((size_t)ln * 6 + gpre_i) * D; const float* sh = MOD + ((size_t)(ln * 5 + v) * 9 + kshift) * D; const float* sc = sh + D;
#pragma unroll
            for (int i = 0; i < 4; ++i) { pg[i] = *(const f32x4*)(gp + co + 256 * i); pm[i] = *(const f32x4*)(gt + co + 256 * i);
                qg[i] = *(const f32x4*)(gq + co + 256 * i); qa[i] = *(const f32x4*)(sh + co + 256 * i); qs[i] = *(const f32x4*)(sc + co + 256 * i); }
        }
            const int nxt = row + nwaves;
            if (nxt < nrows && nxt < MLAT) {
#pragma unroll
                for (int i = 0; i < 4; ++i) { yq[i] = *(const u32x2*)((const bf16_t*)Y0 + (size_t)nxt * D + co + 256 * i); xq[i] = *(const u32x2*)(X + (size_t)nxt * D + co + 256 * i); }
            }
            float ss = 0.f;
#pragma unroll
            for (int i = 0; i < 4; ++i) ss += y[i][0] * y[i][0] + y[i][1] * y[i][1] + y[i][2] * y[i][2] + y[i][3] * y[i][3];
            ss = wsum(ss); const float rs = rsqrtf(ss * (1.f / D) + EPS) * coef;
#pragma unroll
            for (int i = 0; i < 4; ++i) x[i] = x[i] + pm[i] * (y[i] * rs * pg[i]);
        }
        if (mode == 2) {
#pragma unroll
            for (int i = 0; i < 4; ++i) *(f32x4*)((float*)pin(25) + (size_t)row * D + co + 256 * i) = x[i];
            continue;
        }
#pragma unroll
        for (int i = 0; i < 4; ++i) { u32x2 w; w[0] = pk2(x[i][0], x[i][1]); w[1] = pk2(x[i][2], x[i][3]); *(u32x2*)(Xw + (size_t)row * D + co + 256 * i) = w; }
        float ss = 0.f;
#pragma unroll
        for (int i = 0; i < 4; ++i) ss += x[i][0] * x[i][0] + x[i][1] * x[i][1] + x[i][2] * x[i][2] + x[i][3] * x[i][3];
        ss = wsum(ss); const float rs = rsqrtf(ss * (1.f / D) + EPS);
#pragma unroll
        for (int i = 0; i < 4; ++i) { const f32x4 h = x[i] * rs * qg[i] * (qs[i] + 1.f) + qa[i]; u32x2 w; w[0] = pk2(h[0], h[1]); w[1] = pk2(h[2], h[3]);
            *(u32x2*)(H + (size_t)row * D + co + 256 * i) = w; }
    }
}

DEVI void gdn_load(const bf16_t* P, const float* convw, int b, int c, int h, int dir, int want, bf16_t* sQ, bf16_t* sK, bf16_t* sKT, bf16_t* sVT, int tid) {
    const bool isctx = c < 4;
#pragma unroll
    for (int r = 0; r < 6; ++r) {
        const int task = tid + 512 * r, seg = r >> 1, rem = task & 1023, t = rem >> 4, cgp = rem & 15;
        if (seg == 0 && !(want & 1)) continue;
        if (seg == 1 && !(want & 6)) continue;
        if (seg == 2 && !(want & 8)) continue;
        int p = (isctx ? c : c - 4) * 64 + t; if (dir) p = (isctx ? 255 : 4095) - p;
        const int ch = seg * 512 + h * 128 + cgp * 8;
        float a[8];
#pragma unroll
        for (int e = 0; e < 8; ++e) a[e] = 0.f;
#pragma unroll
        for (int j = 0; j < 4; ++j) {
            const int row = pos_row(true, b, isctx, p + j - 2);
            if (row >= 0) {
                const u32x4 raw = *(const u32x4*)(P + (size_t)row * DINP + C_DNQ + ch); float x[8]; unpack8(raw, x);
                const f32x4 w0 = *(const f32x4*)(convw + j * 1536 + ch), w1 = *(const f32x4*)(convw + j * 1536 + ch + 4);
                a[0] += w0[0] * x[0]; a[1] += w0[1] * x[1]; a[2] += w0[2] * x[2]; a[3] += w0[3] * x[3];
                a[4] += w1[0] * x[4]; a[5] += w1[1] * x[5]; a[6] += w1[2] * x[6]; a[7] += w1[3] * x[7];
            }
        }
        float ss = 0.f;
#pragma unroll
        for (int e = 0; e < 8; ++e) { a[e] = silu(a[e]); ss += a[e] * a[e]; }
        if (seg < 2) {
            ss += __shfl_xor(ss, 1, 64); ss += __shfl_xor(ss, 2, 64); ss += __shfl_xor(ss, 4, 64); ss += __shfl_xor(ss, 8, 64);
            float inv = rsqrtf(ss + EPS); if (seg == 0) inv *= 0.08838834764831845f;
#pragma unroll
            for (int e = 0; e < 8; ++e) a[e] *= inv;
        }
        if (seg == 0) *(u32x4*)(sQ + t * 136 + cgp * 8) = pack8(a);
        else if (seg == 1) {
            if (want & 2) *(u32x4*)(sK + t * 136 + cgp * 8) = pack8(a);
            if (want & 4) {
#pragma unroll
                for (int e = 0; e < 8; ++e) sKT[tix(cgp * 8 + e, t)] = (bf16_t)f2bf(a[e]); }
        } else {
#pragma unroll
            for (int e = 0; e < 8; ++e) sVT[tix(cgp * 8 + e, t)] = (bf16_t)f2bf(a[e]);
        }
    }
}
struct GdnRaw { u32x4 r[4][4]; float g; };
DEVI void gdn_ld_issue(const bf16_t* P, const float* gates, int b, int c, int h, int dir, int seg_lo, GdnRaw& R, int tid) {
    const bool isctx = c < 4;
#pragma unroll
    for (int tk = 0; tk < 4; ++tk) {
        const int r = seg_lo * 2 + tk, task = tid + 512 * r, seg = r >> 1, rem = task & 1023, t = rem >> 4, cgp = rem & 15;
        int p = (isctx ? c : c - 4) * 64 + t; if (dir) p = (isctx ? 255 : 4095) - p;
        const int ch = seg * 512 + h * 128 + cgp * 8;
#pragma unroll
        for (int j = 0; j < 4; ++j) { const int row = pos_row(true, b, isctx, p + j - 2); R.r[tk][j] = (u32x4){0u, 0u, 0u, 0u};
            if (row >= 0) R.r[tk][j] = *(const u32x4*)(P + (size_t)row * DINP + C_DNQ + ch); }
    }
    R.g = 0.f; if (tid < 257) R.g = gates[tid];
}
DEVI void gdn_ld_finish(const GdnRaw& R, const float* convw, int h, int seg_lo, int want, bf16_t* sQ, bf16_t* sK, bf16_t* sKT, bf16_t* sVT, float* sc, int tid) {
#pragma unroll
    for (int tk = 0; tk < 4; ++tk) {
        const int r = seg_lo * 2 + tk, task = tid + 512 * r, seg = r >> 1, rem = task & 1023, t = rem >> 4, cgp = rem & 15;
        const int ch = seg * 512 + h * 128 + cgp * 8;
        float a[8];
#pragma unroll
        for (int e = 0; e < 8; ++e) a[e] = 0.f;
#pragma unroll
        for (int j = 0; j < 4; ++j) {
            float x[8]; unpack8(R.r[tk][j], x);
            const f32x4 w0 = *(const f32x4*)(convw + j * 1536 + ch), w1 = *(const f32x4*)(convw + j * 1536 + ch + 4);
            a[0] += w0[0] * x[0]; a[1] += w0[1] * x[1]; a[2] += w0[2] * x[2]; a[3] += w0[3] * x[3];
            a[4] += w1[0] * x[4]; a[5] += w1[1] * x[5]; a[6] += w1[2] * x[6]; a[7] += w1[3] * x[7];
        }
        float ss = 0.f;
#pragma unroll
        for (int e = 0; e < 8; ++e) { a[e] = silu(a[e]); ss += a[e] * a[e]; }
        if (seg < 2) {
            ss += __shfl_xor(ss, 1, 64); ss += __shfl_xor(ss, 2, 64); ss += __shfl_xor(ss, 4, 64); ss += __shfl_xor(ss, 8, 64);
            float inv = rsqrtf(ss + EPS); if (seg == 0) inv *= 0.08838834764831845f;
#pragma unroll
            for (int e = 0; e < 8; ++e) a[e] *= inv;
        }
        if (seg == 0) *(u32x4*)(sQ + t * 136 + cgp * 8) = pack8(a);
        else if (seg == 1) {
            if (want & 2) *(u32x4*)(sK + t * 136 + cgp * 8) = pack8(a);
            if (want & 4) {
#pragma unroll
                for (int e = 0; e < 8; ++e) sKT[tix(cgp * 8 + e, t)] = (bf16_t)f2bf(a[e]); }
        } else {
#pragma unroll
            for (int e = 0; e < 8; ++e) sVT[tix(cgp * 8 + e, t)] = (bf16_t)f2bf(a[e]);
        }
    }
    if (tid < 257) sc[tid] = R.g;
}
DEVI void gdn_gates(const PW& p, const bf16_t* P, int l, int b, int c, int h, int dir, float* sc, int lane) {
    const int row = tok_row(true, dir, b, c, lane);
    const float bb = bf2f(P[(size_t)row * DINP + C_DNBA + dir * 4 + h]), aa = bf2f(P[(size_t)row * DINP + C_DNBA + 8 + dir * 4 + h]);
    const float beta = sigm(bb);
    const float g = -__expf(pin(20)[l * 8 + dir * 4 + h]) * softplus(aa + pin(21)[l * 8 + dir * 4 + h]);
    float G = g;
#pragma unroll
    for (int o = 1; o < 64; o <<= 1) { const float t = __shfl_up(G, o, 64); if (lane >= o) G += t; }
    const float GT = __shfl(G, 63, 64);
    sc[lane] = G; sc[64 + lane] = beta; sc[128 + lane] = __expf(G); sc[192 + lane] = __expf(GT - G); if (lane == 0) sc[256] = __expf(GT);
}

DEVI void gdn_prep_all(const PW& pw0, int l, int first, int G, unsigned char* shm_in, int wv) {
    GdnRaw R;
    if (first < 2176) { const PW p{opq64(pw0.ws)}; const int tid = MYTID; const int c = first % NCH, h = (first / NCH) & 3, b = (first / (NCH * 4)) & 3, dir = first / (NCH * 16);
        gdn_ld_issue((const bf16_t*)(p.ws + WS_P), (const float*)(p.ws + WS_GATES) + (size_t)first * 320, b, c, h, dir, 1, R, tid); }
#pragma unroll 1
    for (int item = first; item < 2176; item += G) {
    const PW p{opq64(pw0.ws)};
    unsigned char* shm = opq(shm_in);
    const int tid = MYTID, wid = __builtin_amdgcn_readfirstlane(tid >> 6), lane = tid & 63, fr = lane & 15, fq = lane >> 4;
    const bf16_t* P = (const bf16_t*)(p.ws + WS_P);
    const float* GATES = (const float*)(p.ws + WS_GATES);
    const int h = (item / NCH) & 3;
    bf16_t* sK = (bf16_t*)shm;
    bf16_t* sKT = (bf16_t*)(shm + 17408);
    bf16_t* sVT = (bf16_t*)(shm + 35840);
    float* sTm = (float*)(shm + 54272);
    bf16_t* sT1 = (bf16_t*)(shm + 71680);
    bf16_t* sT2 = (bf16_t*)(shm + 80896);
    bf16_t* sWT = (bf16_t*)(shm + 90112);
    bf16_t* sUT = (bf16_t*)(shm + 108544);
    float* sc = (float*)(shm + 126976);
    gdn_ld_finish(R, pin(19) + (size_t)l * 4 * 1536, h, 1, 2 | 4 | 8, nullptr, sK, sKT, sVT, sc, tid);
    __builtin_amdgcn_sched_barrier(0);
    { const int nxt = item + G; if (nxt < 2176) { const int c2 = nxt % NCH, h2 = (nxt / NCH) & 3, b2 = (nxt / (NCH * 4)) & 3, dir2 = nxt / (NCH * 16); gdn_ld_issue(P, GATES + (size_t)nxt * 320, b2, c2, h2, dir2, 1, R, opaque(tid)); } }
    __builtin_amdgcn_sched_barrier(0);
    lbar();
#pragma unroll
    for (int ti = 0; ti < 2; ++ti) {
        const int tile = wid * 2 + ti, mt = tile >> 2, nt = tile & 3;
        f32x4 acc = (f32x4){0.f, 0.f, 0.f, 0.f};
#pragma unroll
        for (int kk = 0; kk < 4; ++kk) acc = MFMA16(ldfrag(sK, 136, mt * 16, kk * 32, lane), ldfrag(sK, 136, nt * 16, kk * 32, lane), acc);
        const int s = nt * 16 + fr;
#pragma unroll
        for (int j = 0; j < 4; ++j) { const int t = mt * 16 + fq * 4 + j; sTm[t * 68 + s] = s < t ? sc[64 + t] * acc[j] * __expf(sc[t] - sc[s]) : 0.f; }
    }
    lbar();
    float* tmpY = (float*)sWT;
    if (wid < 4) {
        const int o = wid * 16, c = lane & 15;
        int lz; asm volatile("v_mov_b32 %0, 0" : "=v"(lz));
        const float* tm = sTm + lz;
        float x[16];
#pragma unroll
        for (int t = 0; t < 16; ++t) {
            float v = -sTm[(o + t) * 68 + o + c];
#pragma unroll
            for (int s4 = 0; s4 < (t + 3) / 4; ++s4) {
                const f32x4 a = *(const f32x4*)(tm + (o + t) * 68 + o + s4 * 4);
#pragma unroll
                for (int e = 0; e < 4; ++e) if (s4 * 4 + e < t) v -= a[e] * x[s4 * 4 + e];
            }
            x[t] = v;
        }
        asm volatile("s_waitcnt lgkmcnt(0)" ::: "memory");
        if (lane < 16) {
#pragma unroll
            for (int t = 0; t < 16; ++t) sTm[(o + t) * 68 + o + c] = x[t] + (t == c ? 1.f : 0.f);
        }
    }
    lbar();
    {
        const int blk = tid >> 8, r = (tid >> 4) & 15, c = tid & 15, ib = (blk ? 3 : 1) * 16, jb = ib - 16;
        float y = 0.f;
#pragma unroll
        for (int s2 = 0; s2 < 16; ++s2) y += sTm[(ib + r) * 68 + jb + s2] * sTm[(jb + s2) * 68 + jb + c];
        tmpY[blk * 272 + r * 17 + c] = y;
        lbar();
        float z = 0.f;
#pragma unroll
        for (int s2 = 0; s2 < 16; ++s2) z += sTm[(ib + r) * 68 + ib + s2] * tmpY[blk * 272 + s2 * 17 + c];
        sTm[(ib + r) * 68 + jb + c] = -z;
    }
    lbar();
    {
        float y[2];
#pragma unroll
        for (int u = 0; u < 2; ++u) { const int o = tid + 512 * u, r = o >> 5, c = o & 31; float a = 0.f;
#pragma unroll 8
            for (int s2 = 0; s2 < 32; ++s2) a += sTm[(32 + r) * 68 + s2] * sTm[s2 * 68 + c];
            y[u] = a; }
#pragma unroll
        for (int u = 0; u < 2; ++u) { const int o = tid + 512 * u, r = o >> 5, c = o & 31; tmpY[r * 33 + c] = y[u]; }
        lbar();
#pragma unroll
        for (int u = 0; u < 2; ++u) { const int o = tid + 512 * u, r = o >> 5, c = o & 31; float a = 0.f;
#pragma unroll 8
            for (int s2 = 0; s2 < 32; ++s2) a += sTm[(32 + r) * 68 + 32 + s2] * tmpY[s2 * 33 + c];
            y[u] = a; }
#pragma unroll
        for (int u = 0; u < 2; ++u) { const int o = tid + 512 * u, r = o >> 5, c = o & 31; sTm[(32 + r) * 68 + c] = -y[u]; }
    }
    lbar();
#pragma unroll
    for (int u = 0; u < 8; ++u) {
        const int o = tid + 512 * u, t = o >> 6, s2 = o & 63; const float xv = sTm[t * 68 + s2], bt = sc[64 + s2];
        sT1[t * 72 + s2] = (bf16_t)f2bf(xv * bt * sc[128 + s2]); sT2[t * 72 + s2] = (bf16_t)f2bf(xv * bt);
    }
    lbar();
    bf16_t* GW = (bf16_t*)(p.ws + WS_H) + (size_t)item * 64 * 128;
    bf16_t* GU = (bf16_t*)(p.ws + WS_GU) + (size_t)item * 64 * 128;
    {
        const int tid2 = opaque(tid), lane = tid2 & 63, fr = lane & 15, fq = lane >> 4;
        const int mt = wid;
#pragma unroll
        for (int nt = 0; nt < 4; ++nt) {
            f32x4 aw = (f32x4){0.f, 0.f, 0.f, 0.f}, au = aw;
#pragma unroll
            for (int kk = 0; kk < 2; ++kk) { aw = MFMA16(ldfragT(sKT, mt * 16, kk * 32, lane), ldfrag(sT1, 72, nt * 16, kk * 32, lane), aw);
                au = MFMA16(ldfragT(sVT, mt * 16, kk * 32, lane), ldfrag(sT2, 72, nt * 16, kk * 32, lane), au); }
            const int t = nt * 16 + fr, r0 = mt * 16 + fq * 4; const float dec = sc[192 + t];
            u32x2 w; w[0] = pk2(aw[0], aw[1]); w[1] = pk2(aw[2], aw[3]); *(u32x2*)(GW + t * 128 + r0) = w;
            w[0] = pk2(au[0], au[1]); w[1] = pk2(au[2], au[3]); *(u32x2*)(GU + t * 128 + r0) = w;
#pragma unroll
            for (int j = 0; j < 4; ++j) { sWT[tix(r0 + j, t)] = (bf16_t)f2bf(aw[j] * dec); sUT[tix(r0 + j, t)] = (bf16_t)f2bf(au[j] * dec); }
        }
    }
    lbar();
    bf16_t* GB = (bf16_t*)(p.ws + WS_GB) + (size_t)item * 128 * 128;
    bf16_t* GN = (bf16_t*)(p.ws + WS_GN) + (size_t)item * 128 * 128;
    {
        const int tid2 = opaque(tid), lane = tid2 & 63, fr = lane & 15, fq = lane >> 4;
        const int mt = wid;
#pragma unroll
        for (int nt = 0; nt < 8; ++nt) {
            f32x4 ab = (f32x4){0.f, 0.f, 0.f, 0.f}, an = ab;
#pragma unroll
            for (int kk = 0; kk < 2; ++kk) { ab = MFMA16(ldfragT(sWT, mt * 16, kk * 32, lane), ldfragT(sKT, nt * 16, kk * 32, lane), ab);
                an = MFMA16(ldfragT(sKT, mt * 16, kk * 32, lane), ldfragT(sUT, nt * 16, kk * 32, lane), an); }
            const int cc = nt * 16 + fr, r0 = mt * 16 + fq * 4;
            u32x2 w; w[0] = pk2(-ab[0], -ab[1]); w[1] = pk2(-ab[2], -ab[3]); *(u32x2*)(GB + cc * 128 + r0) = w;
            w[0] = pk2(an[0], an[1]); w[1] = pk2(an[2], an[3]); *(u32x2*)(GN + cc * 128 + r0) = w;
        }
    }
    if (tid == 0) ((float*)(p.ws + WS_SM + SM_GDEC))[item] = sc[256];
    lbar();
    }
}

DEVI void gdn_seq_unit(const PW& pw0, int unit, unsigned char* shm_in, int wv) {
    const PW p{opq64(pw0.ws)};
    unsigned char* shm = opq(shm_in);
    const int tid = MYTID, wid = __builtin_amdgcn_readfirstlane(tid >> 6), lane = tid & 63, fr = lane & 15, fq = lane >> 4;
    const int chain = unit >> 3, es = unit & 7;
    bf16_t* sS = (bf16_t*)shm;
    const bf16_t* GB = (const bf16_t*)(p.ws + WS_GB) + (size_t)chain * NCH * 16384;
    bf16_t* GN = (bf16_t*)(p.ws + WS_GN) + (size_t)chain * NCH * 16384;
    const float* GDEC = (const float*)(p.ws + WS_SM + SM_GDEC) + chain * NCH;
    f32x4 acc = (f32x4){0.f, 0.f, 0.f, 0.f};
    constexpr int PF = 4;
    bf16x8 an[PF][4]; u32x2 nn[PF]; float dn[PF];
    const size_t aoff = (size_t)(wid * 16 + fr) * 128 + fq * 8, noff = (size_t)(es * 16 + fr) * 128 + wid * 16 + fq * 4;
#pragma unroll
    for (int u = 0; u < PF; ++u) {
#pragma unroll
        for (int kk = 0; kk < 4; ++kk) an[u][kk] = *(const bf16x8*)(GB + (size_t)u * 16384 + aoff + kk * 32);
        nn[u] = *(const u32x2*)(GN + (size_t)u * 16384 + noff); dn[u] = GDEC[u];
    }
#pragma unroll 1
    for (int c0 = 0; c0 < NCH; c0 += PF) {
#pragma unroll
        for (int u = 0; u < PF; ++u) {
            const int c = c0 + u;
            bf16x8 a[4]; const u32x2 ncur = nn[u]; const float dcur = dn[u];
#pragma unroll
            for (int kk = 0; kk < 4; ++kk) a[kk] = an[u][kk];
            u32x2 sw; sw[0] = pk2(acc[0], acc[1]); sw[1] = pk2(acc[2], acc[3]);
            bf16_t* sb = sS + (c & 1) * (16 * 136);
            *(u32x2*)(sb + fr * 136 + wid * 16 + fq * 4) = sw;
            *(u32x2*)(GN + (size_t)c * 16384 + noff) = sw;
            if (c + PF < NCH) {
#pragma unroll
                for (int kk = 0; kk < 4; ++kk) an[u][kk] = *(const bf16x8*)(GB + (size_t)(c + PF) * 16384 + aoff + kk * 32);
                nn[u] = *(const u32x2*)(GN + (size_t)(c + PF) * 16384 + noff); dn[u] = GDEC[c + PF];
            }
            lbar();
            acc[0] = dcur * acc[0] + __uint_as_float(ncur[0] << 16); acc[1] = dcur * acc[1] + __uint_as_float(ncur[0] & 0xffff0000u);
            acc[2] = dcur * acc[2] + __uint_as_float(ncur[1] << 16); acc[3] = dcur * acc[3] + __uint_as_float(ncur[1] & 0xffff0000u);
#pragma unroll
            for (int kk = 0; kk < 4; ++kk) acc = MFMA16(a[kk], ldfrag(sb, 136, 0, kk * 32, lane), acc);
        }
    }
    lbar();
}

struct GdnOutRaw { GdnRaw L; u32x4 st[4]; u32x4 w[2]; u32x2 ur[4]; };
DEVI void gdn_out_issue(const PW& p, int item, int dir, GdnOutRaw& R, int tid) {
    const int lane = tid & 63, fr = lane & 15, fq = lane >> 4, wid = tid >> 6;
    const int j = item % NCH, h = (item / NCH) & 3, b = item / (NCH * 4);
    const int c = dir_chunk(dir, j);
    const int it2 = ((dir * 4 + b) * 4 + h) * NCH + c;
    gdn_ld_issue((const bf16_t*)(p.ws + WS_P), (const float*)(p.ws + WS_GATES) + (size_t)it2 * 320, b, c, h, dir, 0, R.L, tid);
    const bf16_t* GS = (const bf16_t*)(p.ws + WS_GN) + (size_t)it2 * 16384;
    const bf16_t* GW = (const bf16_t*)(p.ws + WS_H) + (size_t)it2 * 8192;
    const bf16_t* GU = (const bf16_t*)(p.ws + WS_GU) + (size_t)it2 * 8192;
#pragma unroll
    for (int r = 0; r < 4; ++r) { const int idx = tid + 512 * r, row = idx >> 4, cg8 = (idx & 15) * 8; R.st[r] = *(const u32x4*)(GS + row * 128 + cg8); }
#pragma unroll
    for (int r = 0; r < 2; ++r) { const int idx = tid + 512 * r, row = idx >> 4, cg8 = (idx & 15) * 8; R.w[r] = *(const u32x4*)(GW + row * 128 + cg8); }
#pragma unroll
    for (int nt = 0; nt < 4; ++nt) R.ur[nt] = *(const u32x2*)(GU + (nt * 16 + fr) * 128 + wid * 16 + fq * 4);
}
DEVI void gdn_out_all(const PW& pw0, int l, int first, int G, bool skipctx, unsigned char* shm_in, int wv) {
    const int dry = 0;
    GdnOutRaw R;
    int item = first;
    while (item < 1088 && skipctx && (item % NCH) < 4) item += G;
    if (item < 1088) { const PW p{opq64(pw0.ws)}; gdn_out_issue(p, item, 0, R, MYTID); }
#pragma unroll 1
    while (item < 1088) {
    int nitem = item + G;
    while (nitem < 1088 && skipctx && (nitem % NCH) < 4) nitem += G;
#pragma unroll 1
    for (int dir = 0; dir < 2; ++dir) {
        const PW p{opq64(pw0.ws)};
        unsigned char* shm = opq(shm_in);
        const int tid = MYTID, wid = __builtin_amdgcn_readfirstlane(tid >> 6), lane = tid & 63, fr = lane & 15, fq = lane >> 4;
        const int j = item % NCH, h = (item / NCH) & 3, b = item / (NCH * 4);
        bf16_t* P = (bf16_t*)(p.ws + WS_P);
        bf16_t* sQ = (bf16_t*)shm;
        bf16_t* sK = (bf16_t*)(shm + 17408);
        bf16_t* sST = (bf16_t*)(shm + 34816);
        bf16_t* sW = (bf16_t*)(shm + 69632);
        bf16_t* sVN = (bf16_t*)(shm + 87040);
        bf16_t* sA2 = (bf16_t*)(shm + 105472);
        float* sO = (float*)(shm + 114688);
        float* sc = (float*)(shm + 148480);
        gdn_ld_finish(R.L, pin(19) + (size_t)l * 4 * 1536, h, 0, 1 | 2, sQ, sK, nullptr, nullptr, sc, tid);
#pragma unroll
        for (int r = 0; r < 4; ++r) { const int idx = tid + 512 * r, row = idx >> 4, cg8 = (idx & 15) * 8; *(u32x4*)(sST + row * 136 + cg8) = R.st[r]; }
#pragma unroll
        for (int r = 0; r < 2; ++r) { const int idx = tid + 512 * r, row = idx >> 4, cg8 = (idx & 15) * 8; *(u32x4*)(sW + row * 136 + cg8) = R.w[r]; }
        u32x2 ur4[4];
#pragma unroll
        for (int nt = 0; nt < 4; ++nt) ur4[nt] = R.ur[nt];
        __builtin_amdgcn_sched_barrier(0);
        if (dir == 0) gdn_out_issue(p, item, 1, R, opaque(tid)); else if (nitem < 1088) gdn_out_issue(p, nitem, 0, R, opaque(tid));
        __builtin_amdgcn_sched_barrier(0);
        lbar();
        {
            const int mt = wid;
#pragma unroll
            for (int nt = 0; nt < 4; ++nt) {
                const u32x2 ur = ur4[nt];
                f32x4 a = (f32x4){0.f, 0.f, 0.f, 0.f};
#pragma unroll
                for (int kk = 0; kk < 4; ++kk) a = MFMA16(ldfrag(sST, 136, mt * 16, kk * 32, lane), ldfrag(sW, 136, nt * 16, kk * 32, lane), a);
                const int t = nt * 16 + fr, e0 = mt * 16 + fq * 4;
                sVN[(e0 + 0) * 72 + t] = (bf16_t)f2bf(__uint_as_float(ur[0] << 16) - a[0]); sVN[(e0 + 1) * 72 + t] = (bf16_t)f2bf(__uint_as_float(ur[0] & 0xffff0000u) - a[1]);
                sVN[(e0 + 2) * 72 + t] = (bf16_t)f2bf(__uint_as_float(ur[1] << 16) - a[2]); sVN[(e0 + 3) * 72 + t] = (bf16_t)f2bf(__uint_as_float(ur[1] & 0xffff0000u) - a[3]);
            }
#pragma unroll
            for (int ti = 0; ti < 2; ++ti) {
                const int tile = wid * 2 + ti, m2 = tile >> 2, n2 = tile & 3;
                f32x4 a = (f32x4){0.f, 0.f, 0.f, 0.f};
#pragma unroll
                for (int kk = 0; kk < 4; ++kk) a = MFMA16(ldfrag(sQ, 136, m2 * 16, kk * 32, lane), ldfrag(sK, 136, n2 * 16, kk * 32, lane), a);
                const int s = n2 * 16 + fr;
#pragma unroll
                for (int jj = 0; jj < 4; ++jj) { const int t = m2 * 16 + fq * 4 + jj; sA2[t * 72 + s] = (bf16_t)f2bf(s <= t ? a[jj] * __expf(sc[t] - sc[s]) : 0.f); }
            }
        }
        lbar();
        {
            const int nt = wid;
#pragma unroll
            for (int mt = 0; mt < 4; ++mt) {
                f32x4 a = (f32x4){0.f, 0.f, 0.f, 0.f};
#pragma unroll
                for (int kk = 0; kk < 4; ++kk) a = MFMA16(ldfrag(sQ, 136, mt * 16, kk * 32, lane), ldfrag(sST, 136, nt * 16, kk * 32, lane), a);
#pragma unroll
                for (int jj = 0; jj < 4; ++jj) a[jj] *= sc[128 + mt * 16 + fq * 4 + jj];
#pragma unroll
                for (int kk = 0; kk < 2; ++kk) a = MFMA16(ldfrag(sA2, 72, mt * 16, kk * 32, lane), ldfrag(sVN, 72, nt * 16, kk * 32, lane), a);
                const int e = nt * 16 + fr;
#pragma unroll
                for (int jj = 0; jj < 4; ++jj) { const int t = mt * 16 + fq * 4 + jj; const int i = dir ? 63 - t : t; if (dir) sO[i * 132 + e] += a[jj]; else sO[i * 132 + e] = a[jj]; }
            }
        }
        lbar();
    }
    {
        const PW p{opq64(pw0.ws)};
        unsigned char* shm = opq(shm_in);
        const int tid = MYTID;
        const int j = item % NCH, h = (item / NCH) & 3, b = item / (NCH * 4);
        bf16_t* P = (bf16_t*)(p.ws + WS_P);
        float* sO = (float*)(shm + 114688);
    {
        const int i = tid >> 3, e0 = (tid & 7) * 16;
        float v[16], ss = 0.f;
#pragma unroll
        for (int e = 0; e < 16; ++e) { v[e] = sO[i * 132 + e0 + e]; ss += v[e] * v[e]; }
        ss += __shfl_xor(ss, 1, 64); ss += __shfl_xor(ss, 2, 64); ss += __shfl_xor(ss, 4, 64);
        const float rs = rsqrtf(ss * (1.f / 128.f) + EPS);
        const int row = tok_row(true, 0, b, j, i);
        bf16_t* zp = P + (size_t)row * DINP + C_DNZ + h * 128 + e0;
        const float* g = pin(22) + l * 128 + e0;
#pragma unroll
        for (int half = 0; half < 2; ++half) {
            float z[8]; unpack8(*(const u32x4*)(zp + half * 8), z); float o[8];
#pragma unroll
            for (int e = 0; e < 8; ++e) o[e] = v[half * 8 + e] * rs * g[half * 8 + e] * z[e];
            bf16_t* zd = dry ? (bf16_t*)(p.ws + WS_GB) + (size_t)row * 512 + h * 128 + e0 : zp;
            *(u32x4*)(zd + half * 8) = pack8(o);
        }
    }
    lbar();
    }
    item = nitem;
    }
}

DEVI float ml_gates(const PW& p, const bf16_t* P, int l, int b, int c, int h, int dir, float* sc, int lane) {
    const int row = tok_row(false, dir, b, c, lane);
    const float ig = bf2f(P[(size_t)row * DINP + C_MLG + dir * 4 + h]) + pin(10)[l * 16 + dir * 4 + h];
    const float fg = bf2f(P[(size_t)row * DINP + C_MLG + (2 + dir) * 4 + h]) + pin(10)[l * 16 + (2 + dir) * 4 + h];
    float bb = logsig(fg);
#pragma unroll
    for (int o = 1; o < 64; o <<= 1) { const float t = __shfl_up(bb, o, 64); if (lane >= o) bb += t; }
    sc[lane] = bb; sc[64 + lane] = ig;
    return __shfl(bb, 63, 64);
}
struct MlPrepRaw { u32x4 k; u32x4 v[2]; float w[2]; float g; };
DEVI void ml_prep_issue(const PW& p, int item, MlPrepRaw& R, int tid) {
    const int c = item % NCH, h = (item / NCH) & 3, b = (item / (NCH * 4)) & 3, dir = item / (NCH * 16);
    const bf16_t* P = (const bf16_t*)(p.ws + WS_P);
    const float* gp = (const float*)(p.ws + WS_GATES) + (size_t)(2176 + item) * 320;
    { const int t = tid >> 3, cg8 = (tid & 7) * 8; const int row = tok_row(false, dir, b, c, t); R.k = *(const u32x4*)(P + (size_t)row * DINP + C_MLK + h * 64 + cg8); }
#pragma unroll
    for (int r = 0; r < 2; ++r) { const int idx = tid + 512 * r, t = idx >> 4, cg8 = (idx & 15) * 8; const int row = tok_row(false, dir, b, c, t);
        R.v[r] = *(const u32x4*)(P + (size_t)row * DINP + C_MLV + h * 128 + cg8); R.w[r] = gp[128 + t]; }
    R.g = gp[128 + (tid & 63)];
}
DEVI void ml_prep_all(const PW& pw0, int l, int first, int G, unsigned char* shm_in, int wv) {
    MlPrepRaw R;
    if (first < 2176) { const PW p{opq64(pw0.ws)}; ml_prep_issue(p, first, R, MYTID); }
#pragma unroll 1
    for (int item = first; item < 2176; item += G) {
    const PW p{opq64(pw0.ws)};
    unsigned char* shm = opq(shm_in);
    const int tid = MYTID, wid = __builtin_amdgcn_readfirstlane(tid >> 6), lane = tid & 63, fr = lane & 15, fq = lane >> 4;
    bf16_t* sKT = (bf16_t*)shm;
    bf16_t* sVT = (bf16_t*)(shm + 9216);
    float* sc = (float*)(shm + 27648);
    if (tid < 64) sc[128 + tid] = R.g;
    {
        const int t = tid >> 3, cg8 = (tid & 7) * 8;
        float x[8]; unpack8(R.k, x);
#pragma unroll
        for (int e = 0; e < 8; ++e) sKT[tix(cg8 + e, t)] = (bf16_t)f2bf(x[e]);
    }
#pragma unroll
    for (int r = 0; r < 2; ++r) {
        const int idx = tid + 512 * r, t = idx >> 4, cg8 = (idx & 15) * 8;
        float x[8]; unpack8(R.v[r], x); const float w = R.w[r];
#pragma unroll
        for (int e = 0; e < 8; ++e) sVT[tix(cg8 + e, t)] = (bf16_t)f2bf(x[e] * w);
    }
    __builtin_amdgcn_sched_barrier(0);
    if (item + G < 2176) ml_prep_issue(p, item + G, R, opaque(tid));
    __builtin_amdgcn_sched_barrier(0);
    lbar();
    bf16_t* KV = (bf16_t*)(p.ws + WS_Y) + (size_t)item * 8192;
    {
        const int nt = wid;
#pragma unroll
        for (int mt = 0; mt < 4; ++mt) {
            f32x4 a = (f32x4){0.f, 0.f, 0.f, 0.f};
#pragma unroll
            for (int kk = 0; kk < 2; ++kk) a = MFMA16(ldfragT(sKT, mt * 16, kk * 32, lane), ldfragT(sVT, nt * 16, kk * 32, lane), a);
            { u32x2 w; w[0] = pk2(a[0], a[1]); w[1] = pk2(a[2], a[3]); *(u32x2*)(KV + (nt * 16 + fr) * 64 + mt * 16 + fq * 4) = w; }
        }
    }
    {
        const int d = tid >> 3, t0 = (tid & 7) * 8; float s = 0.f;
#pragma unroll
        for (int t = 0; t < 8; ++t) s += sc[128 + t0 + t] * bf2f(sKT[tix(d, t0 + t)]);
        s += __shfl_xor(s, 1, 64); s += __shfl_xor(s, 2, 64); s += __shfl_xor(s, 4, 64);
        if ((tid & 7) == 0) ((float*)(p.ws + WS_SM + SM_MN))[item * 64 + d] = s; }
    lbar();
    }
}
DEVI void ml_seq(const PW& pw0, int gtid, int nthreads) {
    const PW p{opq64(pw0.ws)};
    const float* MSC = (const float*)(p.ws + WS_SM + SM_MSC);
    float* MM = (float*)(p.ws + WS_SM + SM_MM);
    for (int g = gtid; g < 32 * 4096 + 32 * 32; g += nthreads) {
        const bool isn = g >= 32 * 4096; const int gg = isn ? g - 32 * 4096 : g;
        const int chain = isn ? gg >> 5 : gg >> 12, e2 = isn ? gg & 31 : gg & 4095;
        float m = 0.f; f32x2 C = (f32x2){0.f, 0.f};
        if (isn) {
            float* base = (float*)(p.ws + WS_SM + SM_MN) + (size_t)chain * NCH * 64 + e2 * 2;
            for (int c0 = 0; c0 < NCH; c0 += 17) {
                f32x2 kv[17]; f32x2 sc[17];
#pragma unroll
                for (int u = 0; u < 17; ++u) { kv[u] = *(const f32x2*)(base + (size_t)(c0 + u) * 64); sc[u] = *(const f32x2*)(MSC + (chain * NCH + c0 + u) * 2); }
#pragma unroll
                for (int u = 0; u < 17; ++u) {
                    *(f32x2*)(base + (size_t)(c0 + u) * 64) = C;
                    const float mn = fmaxf(sc[u][0] + m, sc[u][1]);
                    const float a = __expf(sc[u][0] + m - mn), s2 = __expf(sc[u][1] - mn);
                    C = C * a + kv[u] * s2; m = mn;
                }
            }
        } else {
            unsigned* base = (unsigned*)((bf16_t*)(p.ws + WS_Y) + (size_t)chain * NCH * 8192 + e2 * 2);
            for (int c0 = 0; c0 < NCH; c0 += 17) {
                unsigned kv[17]; f32x2 sc[17];
#pragma unroll
                for (int u = 0; u < 17; ++u) { kv[u] = base[(size_t)(c0 + u) * 4096]; sc[u] = *(const f32x2*)(MSC + (chain * NCH + c0 + u) * 2); }
#pragma unroll
                for (int u = 0; u < 17; ++u) {
                    base[(size_t)(c0 + u) * 4096] = pk2(C[0], C[1]);
                    if (e2 == 0) MM[chain * NCH + c0 + u] = m;
                    const float mn = fmaxf(sc[u][0] + m, sc[u][1]);
                    const float a = __expf(sc[u][0] + m - mn), s2 = __expf(sc[u][1] - mn);
                    C[0] = C[0] * a + __uint_as_float(kv[u] << 16) * s2; C[1] = C[1] * a + __uint_as_float(kv[u] & 0xffff0000u) * s2; m = mn;
                }
            }
        }
    }
}
struct MlOutRaw { u32x4 q, k, v[2]; u32x4 ct[2]; float gb, gi, gpm, m, n; };
DEVI void ml_out_issue(const PW& p, int item, int dir, MlOutRaw& R, int tid) {
    const int lane = tid & 63;
    const int j = item % NCH, h = (item / NCH) & 3, b = item / (NCH * 4);
    const int c = dir_chunk(dir, j);
    const int it2 = ((dir * 4 + b) * 4 + h) * NCH + c;
    const bf16_t* P = (const bf16_t*)(p.ws + WS_P);
    { const int t = tid >> 3, cg8 = (tid & 7) * 8; const int row = tok_row(false, dir, b, c, t);
      R.q = *(const u32x4*)(P + (size_t)row * DINP + C_MLQ + h * 64 + cg8); R.k = *(const u32x4*)(P + (size_t)row * DINP + C_MLK + h * 64 + cg8); }
#pragma unroll
    for (int r = 0; r < 2; ++r) { const int idx = tid + 512 * r, t = idx >> 4, cg8 = (idx & 15) * 8; const int row = tok_row(false, dir, b, c, t);
        R.v[r] = *(const u32x4*)(P + (size_t)row * DINP + C_MLV + h * 128 + cg8); }
    const bf16_t* CT = (const bf16_t*)(p.ws + WS_Y) + (size_t)it2 * 8192;
#pragma unroll
    for (int r = 0; r < 2; ++r) { const int idx = tid + 512 * r, e = idx >> 3, d8 = (idx & 7) * 8; R.ct[r] = *(const u32x4*)(CT + e * 64 + d8); }
    const float* gp = (const float*)(p.ws + WS_GATES) + (size_t)(2176 + it2) * 320;
    R.gb = gp[lane]; R.gi = gp[64 + lane]; R.gpm = gp[192 + lane];
    R.m = ((const float*)(p.ws + WS_SM + SM_MM))[it2]; R.n = ((const float*)(p.ws + WS_SM + SM_MN))[it2 * 64 + lane];
}
DEVI void ml_out_all(const PW& pw0, int l, int first, int G, bool skipctx, unsigned char* shm_in, int wv) {
    const int dry = 0;
    MlOutRaw R;
    int item = first;
    while (item < 1088 && skipctx && (item % NCH) < 4) item += G;
    if (item < 1088) { const PW p{opq64(pw0.ws)}; ml_out_issue(p, item, 0, R, MYTID); }
#pragma unroll 1
    while (item < 1088) {
    int nitem = item + G;
    while (nitem < 1088 && skipctx && (nitem % NCH) < 4) nitem += G;
#pragma unroll 1
    for (int dir = 0; dir < 2; ++dir) {
        const PW p{opq64(pw0.ws)};
        unsigned char* shm = opq(shm_in);
        const int tid = MYTID, wid = __builtin_amdgcn_readfirstlane(tid >> 6), lane = tid & 63, fr = lane & 15, fq = lane >> 4;
        bf16_t* sQ = (bf16_t*)shm;
        bf16_t* sK = (bf16_t*)(shm + 9216);
        bf16_t* sVT = (bf16_t*)(shm + 18432);
        bf16_t* sCT = (bf16_t*)(shm + 36864);
        bf16_t* sS = (bf16_t*)(shm + 55296);
        float* sO = (float*)(shm + 64512);
        float* sc = (float*)(shm + 98304);
        if (wid == 0) {
            const float m = R.m, bb = R.gb, pm = R.gpm;
            sc[lane] = bb; sc[64 + lane] = R.gi;
            const float mt = bb + fmaxf(m, pm);
            sc[128 + lane] = mt; sc[192 + lane] = __expf(bb + m - mt);
            sc[320 + lane] = R.n;
        }
        {
            const int t = tid >> 3, cg8 = (tid & 7) * 8;
            float x[8]; unpack8(R.q, x);
#pragma unroll
            for (int e = 0; e < 8; ++e) x[e] *= 0.125f;
            *(u32x4*)(sQ + t * 72 + cg8) = pack8(x);
            *(u32x4*)(sK + t * 72 + cg8) = R.k;
        }
#pragma unroll
        for (int r = 0; r < 2; ++r) {
            const int idx = tid + 512 * r, t = idx >> 4, cg8 = (idx & 15) * 8;
            float x[8]; unpack8(R.v[r], x);
#pragma unroll
            for (int e = 0; e < 8; ++e) sVT[tix(cg8 + e, t)] = (bf16_t)f2bf(x[e]);
        }
#pragma unroll
        for (int r = 0; r < 2; ++r) { const int idx = tid + 512 * r, e = idx >> 3, d8 = (idx & 7) * 8; *(u32x4*)(sCT + e * 72 + d8) = R.ct[r]; }
        __builtin_amdgcn_sched_barrier(0);
        if (dir == 0) ml_out_issue(p, item, 1, R, opaque(tid)); else if (nitem < 1088) ml_out_issue(p, nitem, 0, R, opaque(tid));
        __builtin_amdgcn_sched_barrier(0);
        lbar();
#pragma unroll
        for (int ti = 0; ti < 2; ++ti) {
            const int tile = wid * 2 + ti, m2 = tile >> 2, n2 = tile & 3;
            f32x4 a = (f32x4){0.f, 0.f, 0.f, 0.f};
#pragma unroll
            for (int kk = 0; kk < 2; ++kk) a = MFMA16(ldfrag(sQ, 72, m2 * 16, kk * 32, lane), ldfrag(sK, 72, n2 * 16, kk * 32, lane), a);
            const int s = n2 * 16 + fr;
#pragma unroll
            for (int jj = 0; jj < 4; ++jj) { const int t = m2 * 16 + fq * 4 + jj;
                sS[t * 72 + s] = (bf16_t)f2bf(s <= t ? a[jj] * __expf(sc[t] - sc[s] + sc[64 + s] - sc[128 + t]) : 0.f); }
        }
        lbar();
        {
            const int t = tid >> 3, s0 = (tid & 7) * 8; float ds = 0.f, qn = 0.f;
#pragma unroll
            for (int s2 = 0; s2 < 8; ++s2) { ds += bf2f(sS[t * 72 + s0 + s2]); qn += bf2f(sQ[t * 72 + s0 + s2]) * sc[320 + s0 + s2]; }
            ds += __shfl_xor(ds, 1, 64); ds += __shfl_xor(ds, 2, 64); ds += __shfl_xor(ds, 4, 64);
            qn += __shfl_xor(qn, 1, 64); qn += __shfl_xor(qn, 2, 64); qn += __shfl_xor(qn, 4, 64);
            const float den = ds + sc[192 + t] * qn;
            if ((tid & 7) == 0) sc[256 + t] = 1.f / fmaxf(fabsf(den), __expf(-sc[128 + t]));
        }
        lbar();
        {
            const int nt = wid;
#pragma unroll
            for (int mt = 0; mt < 4; ++mt) {
                f32x4 a = (f32x4){0.f, 0.f, 0.f, 0.f};
#pragma unroll
                for (int kk = 0; kk < 2; ++kk) a = MFMA16(ldfrag(sQ, 72, mt * 16, kk * 32, lane), ldfrag(sCT, 72, nt * 16, kk * 32, lane), a);
#pragma unroll
                for (int jj = 0; jj < 4; ++jj) a[jj] *= sc[192 + mt * 16 + fq * 4 + jj];
#pragma unroll
                for (int kk = 0; kk < 2; ++kk) a = MFMA16(ldfrag(sS, 72, mt * 16, kk * 32, lane), ldfragT(sVT, nt * 16, kk * 32, lane), a);
                const int e = nt * 16 + fr;
#pragma unroll
                for (int jj = 0; jj < 4; ++jj) { const int t = mt * 16 + fq * 4 + jj; const int i = dir ? 63 - t : t; const float hv = a[jj] * sc[256 + t];
                    if (dir) sO[i * 132 + e] += hv; else sO[i * 132 + e] = hv; }
            }
        }
        lbar();
    }
    {
        const PW p{opq64(pw0.ws)};
        unsigned char* shm = opq(shm_in);
        const int tid = MYTID;
        const int j = item % NCH, h = (item / NCH) & 3, b = item / (NCH * 4);
        bf16_t* P = (bf16_t*)(p.ws + WS_P);
        float* sO = (float*)(shm + 64512);
    {
        const int i = tid >> 3, e0 = (tid & 7) * 16;
        float v[16], ss = 0.f;
#pragma unroll
        for (int e = 0; e < 16; ++e) { v[e] = sO[i * 132 + e0 + e]; ss += v[e] * v[e]; }
        ss += __shfl_xor(ss, 1, 64); ss += __shfl_xor(ss, 2, 64); ss += __shfl_xor(ss, 4, 64);
        const float rs = rsqrtf(ss * (1.f / 128.f) + EPS);
        const int row = tok_row(false, 0, b, j, i);
        bf16_t* op = P + (size_t)row * DINP + C_MLO + h * 128 + e0;
        const float* g = pin(11) + l * 512 + h * 128 + e0;
#pragma unroll
        for (int half = 0; half < 2; ++half) {
            float z[8]; unpack8(*(const u32x4*)(op + half * 8), z); float o[8];
#pragma unroll
            for (int e = 0; e < 8; ++e) o[e] = v[half * 8 + e] * rs * g[half * 8 + e] * z[e];
            bf16_t* od = dry ? (bf16_t*)(p.ws + WS_GB) + (size_t)row * 512 + h * 128 + e0 : op;
            *(u32x4*)(od + half * 8) = pack8(o);
        }
    }
    lbar();
    }
    item = nitem;
    }
}

DEVI void lru_item(const PW& pw0, int l, int item, int mode, unsigned char* shm_in, int wv, int dry = 0) {
    const PW p{opq64(pw0.ws)};
    unsigned char* shm = opq(shm_in);
    const int tid = MYTID, wid = __builtin_amdgcn_readfirstlane(tid >> 6), lane = tid & 63, fr = lane & 15, fq = lane >> 4;
    const int half = item & 1, j = (item >> 1) % NCH, b = (item >> 1) / NCH; const bool isctx = j < 4;
    bf16_t* P = (bf16_t*)(p.ws + WS_P);
    bf16_t* sX = (bf16_t*)shm;
    const int p0 = (isctx ? j : j - 4) * 64;
    const float* cw = pin(12) + (size_t)l * 4 * 512; const float* cb = pin(13) + (size_t)l * 512;
    {
        const int ch = lane * 8, i0 = wid * 8;
        f32x4 w[4][2];
#pragma unroll
        for (int jj = 0; jj < 4; ++jj) { w[jj][0] = *(const f32x4*)(cw + jj * 512 + ch); w[jj][1] = *(const f32x4*)(cw + jj * 512 + ch + 4); }
        const f32x4 b0 = *(const f32x4*)(cb + ch), b1 = *(const f32x4*)(cb + ch + 4);
        u32x4 raw[11];
#pragma unroll
        for (int r = 0; r < 11; ++r) { const int row = pos_row(false, b, isctx, p0 + i0 + r - 2);
            raw[r] = (u32x4){0u, 0u, 0u, 0u}; if (row >= 0) raw[r] = *(const u32x4*)(P + (size_t)row * DINP + C_LRX + ch); }
#pragma unroll
        for (int i = 0; i < 8; ++i) {
            float a[8] = {b0[0], b0[1], b0[2], b0[3], b1[0], b1[1], b1[2], b1[3]};
#pragma unroll
            for (int jj = 0; jj < 4; ++jj) { float x[8]; unpack8(raw[i + jj], x);
#pragma unroll
                for (int e = 0; e < 4; ++e) { a[e] += w[jj][0][e] * x[e]; a[4 + e] += w[jj][1][e] * x[4 + e]; } }
            *(u32x4*)(sX + (i0 + i) * 520 + ch) = pack8(a);
        }
    }
    lbar();
    const int blk = wid;
    const bf16_t* WL = (const bf16_t*)(p.ws + WS_WLRU);
    float* LAGG = (float*)(p.ws + WS_SM + SM_LAGG);
#pragma unroll 1
    for (int nn = 0; nn < 2; ++nn) {
        const int n4 = half * 2 + nn;
        const int ch = blk * 64 + n4 * 16 + fr;
        float hsum[4][4];
#pragma unroll
        for (int mt = 0; mt < 4; ++mt)
#pragma unroll
            for (int jj = 0; jj < 4; ++jj) hsum[mt][jj] = 0.f;
#pragma unroll
        for (int dir = 0; dir < 2; ++dir) {
            const bf16_t* wa = WL + (size_t)(0 * 16 + dir * 8 + blk) * 4096 + (n4 * 16 + fr) * 64 + fq * 8;
            const bf16_t* wx = WL + (size_t)(1 * 16 + dir * 8 + blk) * 4096 + (n4 * 16 + fr) * 64 + fq * 8;
            bf16x8 ba[2], bx[2];
#pragma unroll
            for (int kk = 0; kk < 2; ++kk) { ba[kk] = *(const bf16x8*)(wa + kk * 32); bx[kk] = *(const bf16x8*)(wx + kk * 32); }
            const int c = dir_chunk(dir, j);
            const size_t aidx = (((size_t)dir * 4 + b) * NCH + c) * 512 + ch;
            const float hin0 = mode ? LAGG[aidx * 2] : 0.f;
            const float bias_a = pin(15)[(size_t)l * 1024 + dir * 512 + ch], bias_x = pin(17)[(size_t)l * 1024 + dir * 512 + ch];
            const float cl = -8.f * softplus(-pin(18)[(size_t)l * 1024 + dir * 512 + ch]);
            float av[4][4], bv[4][4];
#pragma unroll
            for (int mt = 0; mt < 4; ++mt) {
                f32x4 aa = (f32x4){0.f, 0.f, 0.f, 0.f}, ax = aa;
#pragma unroll
                for (int kk = 0; kk < 2; ++kk) { const bf16x8 af = ldfrag(sX, 520, mt * 16, blk * 64 + kk * 32, lane); aa = MFMA16(af, ba[kk], aa); ax = MFMA16(af, bx[kk], ax); }
#pragma unroll
                for (int jj = 0; jj < 4; ++jj) {
                    const int t = mt * 16 + fq * 4 + jj;
                    const float rr = sigm(aa[jj] + bias_a), ii = sigm(ax[jj] + bias_x), la = cl * rr;
                    const float ea = __expf(la);
                    av[mt][jj] = ea;
                    bv[mt][jj] = __builtin_amdgcn_sqrtf(fmaxf(1.f - ea * ea, 0.f)) * ii * bf2f(sX[t * 520 + ch]);
                }
            }
            float hin = hin0;
            float Pc = 1.f, Hc = 0.f;
#pragma unroll
            for (int mi = 0; mi < 4; ++mi) {
                const int mt = dir ? 3 - mi : mi;
                float Pl = 1.f, Hl = 0.f;
#pragma unroll
                for (int ji = 0; ji < 4; ++ji) { const int jj = dir ? 3 - ji : ji; Pl = av[mt][jj] * Pl; Hl = av[mt][jj] * Hl + bv[mt][jj]; }
                float Pq[4], Hq[4];
#pragma unroll
                for (int q = 0; q < 4; ++q) { Pq[q] = __shfl(Pl, fr + 16 * q, 64); Hq[q] = __shfl(Hl, fr + 16 * q, 64); }
                if (mode == 0) {
#pragma unroll
                    for (int qi = 0; qi < 4; ++qi) { const int q = dir ? 3 - qi : qi; Hc = Pq[q] * Hc + Hq[q]; Pc = Pq[q] * Pc; }
                } else {
                    float hh = hin;
                    float hme = hin;
#pragma unroll
                    for (int qi = 0; qi < 4; ++qi) { const int q = dir ? 3 - qi : qi; if (q == fq) hme = hh; hh = Pq[q] * hh + Hq[q]; }
                    hin = hh;
#pragma unroll
                    for (int ji = 0; ji < 4; ++ji) { const int jj = dir ? 3 - ji : ji; hme = av[mt][jj] * hme + bv[mt][jj]; hsum[mt][jj] += hme; }
                }
            }
            if (mode == 0 && fq == 0) { LAGG[aidx * 2] = Pc; LAGG[aidx * 2 + 1] = Hc; }
        }
        if (mode == 1) {
#pragma unroll
            for (int mt = 0; mt < 4; ++mt)
#pragma unroll
                for (int jj = 0; jj < 4; ++jj) { const int i = mt * 16 + fq * 4 + jj; const int row = pos_row(false, b, isctx, p0 + i);
                    hsum[mt][jj] *= bf2f(P[(size_t)row * DINP + C_LRY + ch]); }
#pragma unroll
            for (int mt = 0; mt < 4; ++mt)
#pragma unroll
                for (int jj = 0; jj < 4; ++jj) { const int i = mt * 16 + fq * 4 + jj; const int row = pos_row(false, b, isctx, p0 + i);
                    bf16_t* yp = P + (size_t)row * DINP + C_LRY + ch; bf16_t* yd = dry ? (bf16_t*)(p.ws + WS_GB) + (size_t)row * 512 + ch : yp; *yd = (bf16_t)f2bf(hsum[mt][jj]); }
        }
    }
    lbar();
}
DEVI void lru_seq(const PW& pw0, int gtid, int nthreads) {
    const PW p{opq64(pw0.ws)};
    float* LAGG = (float*)(p.ws + WS_SM + SM_LAGG);
    for (int g = gtid; g < 4096; g += nthreads) {
        const int ch = g & 511, db = g >> 9;
        float h = 0.f;
        for (int c0 = 0; c0 < NCH; c0 += 17) {
            f32x2 v[17];
#pragma unroll
            for (int u = 0; u < 17; ++u) v[u] = *(const f32x2*)(LAGG + (((size_t)db * NCH + c0 + u) * 512 + ch) * 2);
#pragma unroll
            for (int u = 0; u < 17; ++u) { LAGG[(((size_t)db * NCH + c0 + u) * 512 + ch) * 2] = h; h = v[u][0] * h + v[u][1]; }
        }
    }
}

DEVI void gate_phase(const PW& pw0, int l, int gwave, int nwaves, int lane) {
    const PW p{opq64(pw0.ws)};
    const bf16_t* P = (const bf16_t*)(p.ws + WS_P);
    float* GT = (float*)(p.ws + WS_GATES);
    for (int w = gwave; w < 4352; w += nwaves) {
        const int kind = w >= 2176 ? 1 : 0, item = kind ? w - 2176 : w;
        const int c = item % NCH, h = (item / NCH) & 3, b = (item / (NCH * 4)) & 3, dir = item / (NCH * 16);
        float* gp = GT + (size_t)(kind * 2176 + item) * 320;
        if (kind == 0) gdn_gates(p, P, l, b, c, h, dir, gp, lane);
        else {
            const int row = tok_row(false, dir, b, c, lane);
            const float ig = bf2f(P[(size_t)row * DINP + C_MLG + dir * 4 + h]) + pin(10)[l * 16 + dir * 4 + h];
            const float fg = bf2f(P[(size_t)row * DINP + C_MLG + (2 + dir) * 4 + h]) + pin(10)[l * 16 + (2 + dir) * 4 + h];
            float bb = logsig(fg);
#pragma unroll
            for (int o = 1; o < 64; o <<= 1) { const float t = __shfl_up(bb, o, 64); if (lane >= o) bb += t; }
            const float bT = __shfl(bb, 63, 64);
            const float lw = bT - bb + ig;
            const float Mc = wmax(lw);
            float pm = ig - bb;
#pragma unroll
            for (int o = 1; o < 64; o <<= 1) { const float t = __shfl_up(pm, o, 64); if (lane >= o) pm = fmaxf(pm, t); }
            gp[lane] = bb; gp[64 + lane] = ig; gp[128 + lane] = __expf(lw - Mc); gp[192 + lane] = pm;
            if (lane == 0) { float* msc = (float*)(p.ws + WS_SM + SM_MSC) + item * 2; msc[0] = bT; msc[1] = Mc; }
        }
    }
}

#define XB_TMO      128
#define XB_XCNT(j)  (256  + 64 * (j))
#define XB_XSUB(j)  (1280 + 64 * (j))
#define XB_XGEN(j)  (2304 + 64 * (j))
#define XB_TOP      3328
#define XB_TOPGEN   3392
#define XCD_BAR_WORDS 3456
#define XB_SPIN_CAP (1u << 22)
DEVI unsigned xb_ld(unsigned* p)              { return __hip_atomic_load(p, __ATOMIC_RELAXED, __HIP_MEMORY_SCOPE_AGENT); }
DEVI unsigned xb_add(unsigned* p, unsigned v) { return __hip_atomic_fetch_add(p, v, __ATOMIC_RELAXED, __HIP_MEMORY_SCOPE_AGENT); }
DEVI unsigned xb_xcc_id() { return (unsigned)__builtin_amdgcn_s_getreg((3 << 11) | 20) & 0xFu; }
#define XB_SPIN(cond, bar) do { unsigned _sp = 0; while (cond) { __builtin_amdgcn_s_sleep(1); \
    if ((++_sp & 255u) == 0u) { if (xb_ld(&(bar)[XB_TMO])) break; if (_sp > XB_SPIN_CAP) { atomicAdd(&(bar)[XB_TMO], 1u); break; } } } } while (0)
DEVI void xcd_barrier_complete(unsigned* bar, unsigned x, unsigned G, unsigned& nloc, unsigned& nx) {
    unsigned sum, cnt, mine, sp = 0u;
    for (;;) {
        sum = 0u; cnt = 0u; mine = 0u;
#pragma unroll
        for (unsigned j = 0; j < 16; ++j) { const unsigned c = xb_ld(&bar[XB_XCNT(j)]); sum += c; cnt += (c > 0u) ? 1u : 0u; mine = (j == x) ? c : mine; }
        if (sum == G) break;
        __builtin_amdgcn_s_sleep(1);
        if ((++sp & 255u) == 0u) { if (xb_ld(&bar[XB_TMO])) break; if (sp > XB_SPIN_CAP) { atomicAdd(&bar[XB_TMO], 1u); break; } }
    }
    nloc = mine > 0u ? mine : 1u; nx = cnt > 0u ? cnt : 1u;
}
DEVI void gsync(unsigned* bar, volatile LAS unsigned* st, int G, int wv) {
    asm volatile("s_waitcnt vmcnt(0)" ::: "memory");
    __syncthreads();
    const int ln = (int)__builtin_amdgcn_mbcnt_hi(~0u, __builtin_amdgcn_mbcnt_lo(~0u, 0u));
    if (wv == 0 && ln == 0) {
        __builtin_amdgcn_s_waitcnt(0);
        const unsigned x = xb_xcc_id();
        unsigned nloc = st[0], nx = st[1];
        if (nloc == 0u) { xcd_barrier_complete(bar, x, (unsigned)G, nloc, nx); st[0] = nloc; st[1] = nx; }
        const unsigned old = xb_add(&bar[XB_XSUB(x)], 1u);
        const unsigned gen = old / nloc;
        if (old + 1u == (gen + 1u) * nloc) {
            __builtin_amdgcn_fence(__ATOMIC_RELEASE, "agent");
            asm volatile("s_waitcnt vmcnt(0)" ::: "memory");
            const unsigned og = xb_add(&bar[XB_TOP], 1u);
            const unsigned tg = og / nx;
            if (og + 1u == (tg + 1u) * nx) xb_add(&bar[XB_TOPGEN], 1u);
            else XB_SPIN(xb_ld(&bar[XB_TOPGEN]) == tg, bar);
            __builtin_amdgcn_fence(__ATOMIC_ACQUIRE, "agent");
            xb_add(&bar[XB_XGEN(x)], 1u);
            asm volatile("s_waitcnt vmcnt(0)" ::: "memory");
        } else {
            XB_SPIN(xb_ld(&bar[XB_XGEN(x)]) == gen, bar);
            __builtin_amdgcn_fence(__ATOMIC_ACQUIRE, "agent");
            asm volatile("s_waitcnt vmcnt(0)" ::: "memory");
        }
    }
    __syncthreads();
}

__global__ void __launch_bounds__(512) mega(Params p) {
    extern __shared__ __attribute__((aligned(16))) unsigned char shm[];
    cg::grid_group grid = cg::this_grid();
    const int wv = __builtin_amdgcn_readfirstlane(threadIdx.x >> 6);
    const int G = gridDim.x, nwaves = G * 8, nthreads = G * 512;
#define TIDS const int tid = MYTID, wid = tid >> 6, lane = tid & 63, gwave = blockIdx.x * 8 + wid, gtid = blockIdx.x * 512 + tid; (void)gtid; (void)gwave; (void)lane;
    LAS unsigned char* lds = (LAS unsigned char*)shm;
#define WSQ unsigned char* ws = opq64(pw.ws); bf16_t* Hb = (bf16_t*)(ws + WS_H); bf16_t* Pb = (bf16_t*)(ws + WS_P); float* Yb = (float*)(ws + WS_Y); (void)Hb; (void)Pb; (void)Yb;

    const PW pw{p.ws};
    unsigned* bar = (unsigned*)p.ws;
    volatile LAS unsigned* xst = (volatile LAS unsigned*)((LAS unsigned char*)shm + (LDS_BYTES - 16));
    if (threadIdx.x == 0) { xst[0] = 0u; xst[1] = 0u; (void)xb_add(&bar[XB_XCNT(xb_xcc_id())], 1u); }
    __syncthreads();
    for (int rep = 0; rep < REP_CVT; ++rep) {
    mod_phase(pw, shm, wv);
    { TIDS convert_phase(pw, 0, shm, gwave, nwaves, wid, lane); }
    }
    grid.sync();
    { TIDS rowwise_phase(pw, 0, MTOT, 0, 0, 0.f, 0, 0, 0, 0, 0, gwave, nwaves, lane); }
    gsync(bar, xst, G, wv);

#pragma unroll 1
    for (int l = 0; l < DEPTH; ++l) {
        const bool last = l == DEPTH - 1;
#pragma unroll 1
        for (int f = 0; f < 2; ++f) {
            if (f == 1) {
                { WSQ pg8::Gemm g{Hb, (const bf16_t*)(ws + WS_WIN), 68, 31, D, D, 1, 0, 0, 0, 0, D, 0}; pg8::Order S; S.init(68, 31, 1, G, blockIdx.x);
                  pg8::EpiInProj E{Pb, DINP}; for (int rep = 0; rep < REP_GEMM; ++rep) pg8::gemm_phase(lds, g, S, E, wv); }
                gsync(bar, xst, G, wv);
                { TIDS gate_phase(pw, l, gwave, nwaves, lane); }
                gsync(bar, xst, G, wv);
#pragma unroll 1
                for (int rep2 = 0; rep2 < REP_PREPSEQ; ++rep2) {
#pragma unroll 1
                for (int rep = 0; rep < REP_PREP; ++rep)
                {
                    gdn_prep_all(pw, l, blockIdx.x, G, shm, wv);
                    ml_prep_all(pw, l, (blockIdx.x + G / 2) % G, G, shm, wv);
                    for (int it = (blockIdx.x + G / 4) % G; it < 544; it += G) for (int r3 = 0; r3 < REP_LRU0; ++r3) lru_item(pw, l, it, 0, shm, wv);
                }
                gsync(bar, xst, G, wv);
                for (int u = blockIdx.x; u < 256; u += G) gdn_seq_unit(pw, u, shm, wv);
                { TIDS ml_seq(pw, gtid, nthreads); }
                { TIDS lru_seq(pw, gtid, nthreads); }
                gsync(bar, xst, G, wv);
                }
                gdn_out_all(pw, l, blockIdx.x, G, last, shm, wv);
                ml_out_all(pw, l, (blockIdx.x + G / 4) % G, G, last, shm, wv);
                for (int it = (blockIdx.x + G / 2) % G; it < 544; it += G) { if (last && ((it >> 1) % NCH) < 4) continue; if (DRY_LO) lru_item(pw, l, it, 1, shm, wv, 1); lru_item(pw, l, it, 1, shm, wv); }
                gsync(bar, xst, G, wv);
                const int nM = last ? 64 : 68;
                { WSQ pg8::Gemm g{Pb, (const bf16_t*)(ws + WS_WBR), 64, 4, 512, DINP, 3, C_MLO, C_LRY, C_DNZ, D * 512, 512, 0}; pg8::Order S; S.init(64, 4, 3, G, blockIdx.x);
                  pg8::EpiBranch E{Pb, (bf16_t*)Yb, Hb}; for (int rep = 0; rep < REP_BR; ++rep) pg8::gemm_phase(lds, g, S, E, wv); }
                if (!last) { WSQ pg8::Gemm g{Pb, (const bf16_t*)(ws + WS_WBR), 4, 4, 512, DINP, 3, C_MLO, C_LRY, C_DNZ, D * 512, 512, 0}; pg8::Order S; S.init(4, 4, 3, G, G - 1 - blockIdx.x, 64, 1);
                  pg8::EpiBranchPart E{Pb, (float*)(ws + WS_GB + ((size_t)32 << 20))}; pg8::gemm_phase(lds, g, S, E, wv); }
                gsync(bar, xst, G, wv);
                { WSQ pg8::Gemm g{Hb, (const bf16_t*)(ws + WS_WOUT), 64, 4, D, D, 1, 0, 0, 0, 0, D, 0}; pg8::Order S; S.init(64, 4, 1, G, blockIdx.x);
                  pg8::EpiBf16Y E{(bf16_t*)Yb, D}; for (int rep = 0; rep < REP_GEMM; ++rep) pg8::gemm_phase(lds, g, S, E, wv); }
                if (!last) { WSQ pg8::Gemm g{Hb, (const bf16_t*)(ws + WS_WOUT), 4, 4, 256, D, 4, 0, 0, 0, 256, D, 256}; pg8::Order S; S.init(4, 4, 4, G, blockIdx.x, 64, 1);
                  pg8::Unit u0;
                  if (S.next(0, u0)) {
                      TIDS const float* PART = (const float*)(ws + WS_GB + ((size_t)32 << 20));
                      const int r = tid >> 1, hc = (tid & 1) * 128;
                      const size_t off = (size_t)((u0.pm - 64) * 256 + r) * D + u0.z * 256 + hc;
                      bf16_t* up = Hb + (size_t)(u0.pm * 256 + r) * D + u0.z * 256 + hc;
#pragma unroll 1
                      for (int cb = 0; cb < 128; cb += 32) {
                          f32x4 t[3][8];
#pragma unroll
                          for (int zz = 0; zz < 3; ++zz)
#pragma unroll
                              for (int q4 = 0; q4 < 8; ++q4) t[zz][q4] = *(const f32x4*)(PART + (size_t)zz * 1024 * D + off + cb + q4 * 4);
#pragma unroll
                          for (int q4 = 0; q4 < 8; q4 += 2) { const f32x4 a = t[0][q4] + t[1][q4] + t[2][q4], b2 = t[0][q4 + 1] + t[1][q4 + 1] + t[2][q4 + 1];
                              u32x4 w; w[0] = pk2(a[0], a[1]); w[1] = pk2(a[2], a[3]); w[2] = pk2(b2[0], b2[1]); w[3] = pk2(b2[2], b2[3]); *(u32x4*)(up + cb + q4 * 4) = w; }
                      }
                  }
                  asm volatile("s_waitcnt vmcnt(0)" ::: "memory"); __syncthreads();
                  pg8::EpiF32 E{(float*)(ws + WS_GB), D, MLAT, (size_t)1024 * D}; pg8::gemm_phase(lds, g, S, E, wv); }
                gsync(bar, xst, G, wv);
                { TIDS if (DRY_ROW) { rowwise_phase(pw, 1, nM * 256, l, 5, 1.f, 3, l, 4, 6, 4, gwave, nwaves, lane, 1); } rowwise_phase(pw, 1, nM * 256, l, 5, 1.f, 3, l, 4, 6, 4, gwave, nwaves, lane); }
                gsync(bar, xst, G, wv);
            }
            const int nM = (last && f == 1) ? 64 : 68;
            { WSQ pg8::Gemm g{Hb, (const bf16_t*)(ws + WS_WGU + f * SZ_WGU), nM, 22, D, D, 1, 0, 0, 0, 0, D, 0}; pg8::Order S; S.init(nM, 22, 1, G, blockIdx.x);
              pg8::EpiSwiGLU E{Pb, DFF}; for (int rep = 0; rep < REP_GU; ++rep) pg8::gemm_phase(lds, g, S, E, wv); }
            gsync(bar, xst, G, wv);
            { WSQ pg8::Gemm g{Pb, (const bf16_t*)(ws + WS_WDN + f * SZ_WDN), 64, 4, DFF, DFF, 1, 0, 0, 0, 0, DFF, 0}; pg8::Order S; S.init(64, 4, 1, G, blockIdx.x);
              pg8::EpiBf16Y E{(bf16_t*)Yb, D}; for (int rep = 0; rep < REP_DN; ++rep) pg8::gemm_phase(lds, g, S, E, wv); }
            if (nM == 68) { WSQ pg8::Gemm g{Pb, (const bf16_t*)(ws + WS_WDN + f * SZ_WDN), 4, 4, 256, DFF, 11, 0, 0, 0, 256, DFF, 256}; pg8::Order S; S.init(4, 4, 11, G, blockIdx.x, 64, 1);
              pg8::EpiF32 E{(float*)(ws + WS_GB), D, MLAT, (size_t)1024 * D}; for (int rep = 0; rep < REP_DNC; ++rep) pg8::gemm_phase(lds, g, S, E, wv); }
            gsync(bar, xst, G, wv);
            if (f == 0) { TIDS if (DRY_ROW) { rowwise_phase(pw, 1, nM * 256, l, 2, 0.5f, 1, l, 2, 3, 11, gwave, nwaves, lane, 1); } rowwise_phase(pw, 1, nM * 256, l, 2, 0.5f, 1, l, 2, 3, 11, gwave, nwaves, lane); }
            else if (!last) { { TIDS if (DRY_ROW) { rowwise_phase(pw, 1, nM * 256, l, 8, 0.5f, 5, l + 1, 0, 0, 11, gwave, nwaves, lane, 1); } rowwise_phase(pw, 1, nM * 256, l, 8, 0.5f, 5, l + 1, 0, 0, 11, gwave, nwaves, lane); } for (int rep = 0; rep < REP_CVT; ++rep) { TIDS convert_phase(pw, l + 1, shm, gwave, nwaves, wid, lane); } }
            else { TIDS rowwise_phase(pw, 2, MLAT, l, 8, 0.5f, 5, 0, 0, 0, 0, gwave, nwaves, lane); }
            gsync(bar, xst, G, wv);
        }
    }
}

extern "C" void kernel_launch(void* const* d_in, const int* in_sizes, int n_in, void* d_out, int out_size, void* d_ws, size_t ws_size, hipStream_t stream) {
    static int grid = 0;
    if (grid == 0) {
        if (n_in != 25 || ws_size < WS_END) { fprintf(stderr, "kernel_launch: unexpected n_in %d or ws_size %zu (need %zu)\n", n_in, ws_size, (size_t)WS_END); grid = -1; return; }
        int dev = 0, cus = 0, per_cu = 0;
        hipGetDevice(&dev); hipDeviceGetAttribute(&cus, hipDeviceAttributeMultiprocessorCount, dev);
        if (hipFuncSetAttribute((const void*)mega, hipFuncAttributeMaxDynamicSharedMemorySize, LDS_BYTES) != hipSuccess) { fprintf(stderr, "kernel_launch: hipFuncSetAttribute failed\n"); grid = -1; return; }
        if (hipOccupancyMaxActiveBlocksPerMultiprocessor(&per_cu, (const void*)mega, 512, LDS_BYTES) != hipSuccess || per_cu < 1) { fprintf(stderr, "kernel_launch: occupancy query failed (%d)\n", per_cu); per_cu = 1; }
        (void)hipGetLastError();
        grid = cus * per_cu;
    }
    if (grid < 0) return;
    if (hipMemsetAsync(d_ws, 0, 16384, stream) != hipSuccess) { fprintf(stderr, "kernel_launch: memset failed\n"); return; }
    Params p{};
    for (int i = 0; i < 25; ++i) p.in[i] = (const float*)d_in[i];
    p.out = (float*)d_out; p.ws = (unsigned char*)d_ws;
    void* args[] = {&p};
    hipError_t e = hipLaunchCooperativeKernel((const void*)mega, dim3(grid), dim3(512), args, LDS_BYTES, stream);
    if (e != hipSuccess) fprintf(stderr, "cooperative launch failed: %s (grid %d)\n", hipGetErrorString(e), grid);
}
```
